# Optimizing an MI355X kernel written in HIP

```python
import jax, jax.numpy as jnp
from jax import lax
import numpy as np

D_MODEL = 2048
BATCH = 2
SEQ = 4096
DEPTH = 2

GRID_W = 64
CTX_LEN = 256
CONV_DIM = 1024
CONV_K = 3
GLA_HEADS = 4
GLA_DK = 128
GLA_DV = 256
GLA_RANK = 16
GLA_TAU = 16.0
GLA_CHUNK = 64
GLA_QK = GLA_HEADS * GLA_DK
GLA_V = GLA_HEADS * GLA_DV
NA_HEADS = 8
NA_DH = 128
NA_W = NA_HEADS * NA_DH
WIN_R = 8
WIN_C = 16
D_FF = 5632
N_EXPERTS = 8
TOP_K = 2
ROPE_BASE = 10000.0
LN_EPS = 1e-5
N_BRANCH = 3
DEEPNORM_ALPHA = (2 * DEPTH) ** 0.25
DEEPNORM_BETA = (8 * DEPTH) ** -0.25
SPLITS = [CONV_DIM, CONV_DIM, CONV_DIM, GLA_QK, GLA_QK, GLA_V, GLA_V, GLA_RANK, GLA_RANK,
          NA_W, NA_W, NA_W, N_BRANCH * D_MODEL]
IN_COLS = sum(SPLITS)

kernel_name = "hybrid_conv_gla_natten_moe_dit"


def split_cols(u):
    return jnp.split(u, np.cumsum(SPLITS)[:-1].tolist(), axis=-1)


def heads(a, h):
    return a.reshape(a.shape[0], a.shape[1], h, -1)


def layer_norm(x, g, b):
    xf = x.astype(jnp.float32)
    mu = jnp.mean(xf, -1, keepdims=True)
    var = jnp.mean(jnp.square(xf - mu), -1, keepdims=True)
    return ((xf - mu) * lax.rsqrt(var + LN_EPS)).astype(x.dtype) * g + b


def axial_rope(x):
    _, T, _, d = x.shape
    t = jnp.arange(T)
    rows = (t // GRID_W).astype(jnp.float32)
    cols = (t % GRID_W).astype(jnp.float32)
    n_freq = d // 4
    inv = 1.0 / (ROPE_BASE ** (jnp.arange(n_freq, dtype=jnp.float32) / n_freq))
    ang = jnp.concatenate([rows[:, None] * inv, cols[:, None] * inv], -1)
    cos = jnp.cos(ang)[None, :, None, :]
    sin = jnp.sin(ang)[None, :, None, :]
    xp = x.astype(jnp.float32).reshape(x.shape[:-1] + (d // 2, 2))
    x0, x1 = xp[..., 0], xp[..., 1]
    out = jnp.stack([x0 * cos - x1 * sin, x0 * sin + x1 * cos], -1)
    return out.reshape(x.shape).astype(x.dtype)


def short_conv(a_b, a_c, a_x, w):
    z = a_c * a_x
    y = lax.conv_general_dilated(z, w[:, None, :].astype(z.dtype), window_strides=(1,),
                                 padding=[(CONV_K // 2, CONV_K // 2)],
                                 dimension_numbers=('NWC', 'WIO', 'NWC'),
                                 feature_group_count=CONV_DIM)
    return a_b * y


def gla_heads(q, k, v, lr_f, lr_b, wg_f, bg_f, wg_b, bg_b):
    q = heads(q, GLA_HEADS) * (GLA_DK ** -0.5)
    k = heads(k, GLA_HEADS)
    v = heads(v, GLA_HEADS)
    g_f = heads(jax.nn.log_sigmoid((lr_f @ wg_f + bg_f).astype(jnp.float32)) / GLA_TAU, GLA_HEADS)
    g_b = heads(jax.nn.log_sigmoid((lr_b @ wg_b + bg_b).astype(jnp.float32)) / GLA_TAU, GLA_HEADS)
    return q, k, v, g_f, g_b


def gla_chunked(q, k, v, g, s0):
    Bn, T, H, _ = q.shape
    dv = v.shape[-1]
    n = T // GLA_CHUNK

    def chunks(a):
        return a.astype(jnp.float32).reshape(Bn, n, GLA_CHUNK, H, a.shape[-1]).transpose(1, 0, 3, 2, 4)

    q, k, v, g = chunks(q), chunks(k), chunks(v), chunks(g)
    b = jnp.cumsum(g, axis=3)
    b_last = b[:, :, :, -1:, :]
    q_dec = q * jnp.exp(b)
    k_inv = k * jnp.exp(-b)
    k_end = k * jnp.exp(b_last - b)
    mask = jnp.tril(jnp.ones((GLA_CHUNK, GLA_CHUNK), dtype=bool))
    att = jnp.where(mask, jnp.einsum('nbhtd,nbhsd->nbhts', q_dec, k_inv), 0.0)
    o_intra = jnp.einsum('nbhts,nbhse->nbhte', att, v)
    d_state = jnp.einsum('nbhcd,nbhce->nbhde', k_end, v)
    decay = jnp.exp(b_last[:, :, :, 0, :])[..., None]

    def step(s, inp):
        dec, ds = inp
        return dec * s + ds, s

    s_final, s_start = lax.scan(step, s0.astype(jnp.float32), (decay, d_state))
    o = o_intra + jnp.einsum('nbhtd,nbhde->nbhte', q_dec, s_start)
    return o.transpose(1, 0, 3, 2, 4).reshape(Bn, T, H, dv), s_final


def gla_output(o, r, norm_g):
    o = o * lax.rsqrt(jnp.mean(jnp.square(o), -1, keepdims=True) + LN_EPS)
    o = o.astype(r.dtype) * norm_g
    return o.reshape(r.shape) * jax.nn.silu(r)


def neighbourhood_attention(q, k, v, kc, vc, rpb):
    Bn, S, H, dh = q.shape
    rows = S // GRID_W
    wr = min(WIN_R, rows)
    qg = q.reshape(Bn, rows, GRID_W, H, dh)
    kg = k.reshape(Bn, rows, GRID_W, H, dh)
    vg = v.reshape(Bn, rows, GRID_W, H, dh)
    col = jnp.arange(GRID_W)
    col_start = jnp.clip(col - WIN_C // 2, 0, GRID_W - WIN_C)
    col_idx = col_start[:, None] + jnp.arange(WIN_C)[None, :]
    dc = col_idx - col[:, None] + (WIN_C - 1)
    n_loc = wr * WIN_C

    def row_block(r):
        rs = jnp.clip(r - wr // 2, 0, rows - wr)
        qb = lax.dynamic_index_in_dim(qg, r, axis=1, keepdims=False)
        kb = lax.dynamic_slice_in_dim(kg, rs, wr, axis=1)
        vb = lax.dynamic_slice_in_dim(vg, rs, wr, axis=1)
        kw = kb[:, :, col_idx]
        vw = vb[:, :, col_idx]
        s_loc = jnp.einsum('bqhd,brqjhd->bhqrj', qb, kw).astype(jnp.float32)
        dr = rs + jnp.arange(wr) - r + (WIN_R - 1)
        bias = rpb[:, dr][:, :, dc].transpose(0, 2, 1, 3)
        s_loc = s_loc + bias[None].astype(jnp.float32)
        s_ctx = jnp.einsum('bqhd,blhd->bhql', qb, kc).astype(jnp.float32)
        s = jnp.concatenate([s_loc.reshape(Bn, H, GRID_W, n_loc), s_ctx], -1)
        p = jax.nn.softmax(s, axis=-1).astype(v.dtype)
        p_loc = p[..., :n_loc].reshape(Bn, H, GRID_W, wr, WIN_C)
        p_ctx = p[..., n_loc:]
        return (jnp.einsum('bhqrj,brqjhd->bqhd', p_loc, vw)
                + jnp.einsum('bhql,blhd->bqhd', p_ctx, vc))

    out = lax.map(row_block, jnp.arange(rows))
    return out.transpose(1, 0, 2, 3, 4).reshape(Bn, S, H * dh)


def context_attention(q, k, v):
    s = jnp.einsum('bqhd,bkhd->bhqk', q, k).astype(jnp.float32)
    p = jax.nn.softmax(s, axis=-1).astype(v.dtype)
    o = jnp.einsum('bhqk,bkhd->bqhd', p, v)
    return o.reshape(o.shape[0], o.shape[1], -1)


def merge_branches(y_conv, y_gla, y_na, gates, w_br_conv, w_br_gla, w_br_na, gate_b, w_out):
    g = jax.nn.sigmoid(gates + gate_b)
    g_conv, g_gla, g_na = jnp.split(g, N_BRANCH, axis=-1)
    z = g_conv * (y_conv @ w_br_conv) + g_gla * (y_gla @ w_br_gla) + g_na * (y_na @ w_br_na)
    return z @ w_out


def token_mixer(hl, hc, w_in, conv_w, wg_f, bg_f, wg_b, bg_b, gla_norm_g, rpb,
                w_br_conv, w_br_gla, w_br_na, gate_b, w_out, ctx_out):
    (la_b, la_c, la_x, lq, lk, lv, lr, llf, llb, lnq, lnk, lnv, lgates) = split_cols(hl @ w_in)
    (ca_b, ca_c, ca_x, cq, ck, cv, cr, clf, clb, cnq, cnk, cnv, cgates) = split_cols(hc @ w_in)
    Bn = hl.shape[0]
    flip = lambda a: jnp.flip(a, axis=1)

    qc, kc, vc, gcf, gcb = gla_heads(cq, ck, cv, clf, clb, wg_f, bg_f, wg_b, bg_b)
    ql, kl, vl, glf, glb = gla_heads(lq, lk, lv, llf, llb, wg_f, bg_f, wg_b, bg_b)
    ql = axial_rope(ql)
    kl = axial_rope(kl)
    s0 = jnp.zeros((Bn, GLA_HEADS, GLA_DK, GLA_DV), jnp.float32)
    oc_f, st_f = gla_chunked(qc, kc, vc, gcf, s0)
    oc_b, st_b = gla_chunked(flip(qc), flip(kc), flip(vc), flip(gcb), s0)
    ol_f, _ = gla_chunked(ql, kl, vl, glf, st_f)
    ol_b, _ = gla_chunked(flip(ql), flip(kl), flip(vl), flip(glb), st_b)
    y_gla_l = gla_output(ol_f + flip(ol_b), lr, gla_norm_g)

    na_scale = NA_DH ** -0.5
    nkc = heads(cnk, NA_HEADS)
    nvc = heads(cnv, NA_HEADS)
    y_na_l = neighbourhood_attention(heads(lnq, NA_HEADS) * na_scale, heads(lnk, NA_HEADS),
                                     heads(lnv, NA_HEADS), nkc, nvc, rpb)

    y_conv_l = short_conv(la_b, la_c, la_x, conv_w)
    out_l = merge_branches(y_conv_l, y_gla_l, y_na_l, lgates, w_br_conv, w_br_gla, w_br_na, gate_b, w_out)
    if not ctx_out:
        return out_l, None

    y_gla_c = gla_output(oc_f + flip(oc_b), cr, gla_norm_g)
    y_na_c = context_attention(heads(cnq, NA_HEADS) * na_scale, nkc, nvc)
    y_conv_c = short_conv(ca_b, ca_c, ca_x, conv_w)
    out_c = merge_branches(y_conv_c, y_gla_c, y_na_c, cgates, w_br_conv, w_br_gla, w_br_na, gate_b, w_out)
    return out_l, out_c


def swiglu(h, wg, wu, wd):
    return (jax.nn.silu(h @ wg) * (h @ wu)) @ wd


def moe_swiglu(h, router, wg, wu, wd):
    shape = h.shape
    hf = h.reshape(-1, shape[-1])
    logits = (hf @ router).astype(jnp.float32)
    top_val, top_idx = lax.top_k(logits, TOP_K)
    top_w = jax.nn.softmax(top_val, axis=-1)
    combine = jnp.sum(jax.nn.one_hot(top_idx, N_EXPERTS, dtype=jnp.float32) * top_w[..., None], axis=1)
    combine = combine.astype(h.dtype)
    out = jnp.zeros_like(hf)
    for e in range(N_EXPERTS):
        out = out + combine[:, e:e + 1] * swiglu(hf, wg[e], wu[e], wd[e])
    return out.reshape(shape)


def setup_inputs(seed: int = 0) -> dict:
    key = jax.random.key(seed)
    ks = iter(jax.random.split(key, 32))
    nrm = lambda shape, scale: jax.random.normal(next(ks), shape, jnp.float32) * scale
    D = D_MODEL
    n_dense = (DEPTH + 1) // 2
    n_moe = DEPTH // 2
    beta = DEEPNORM_BETA
    return {
        "x": nrm((BATCH, SEQ, D), 1.0),
        "c": nrm((BATCH, D), 1.0),
        "ctx": nrm((BATCH, CTX_LEN, D), 1.0),
        "c_ctx": nrm((D,), 1.0),
        "ada_w": nrm((DEPTH, D, 6 * D), D ** -0.5),
        "ada_b": nrm((DEPTH, 6 * D), 0.02),
        "w_in": nrm((DEPTH, D, IN_COLS), D ** -0.5),
        "conv_w": nrm((DEPTH, CONV_K, CONV_DIM), CONV_K ** -0.5),
        "gla_wg_f": nrm((DEPTH, GLA_RANK, GLA_QK), GLA_RANK ** -0.5),
        "gla_bg_f": nrm((DEPTH, GLA_QK), 0.1),
        "gla_wg_b": nrm((DEPTH, GLA_RANK, GLA_QK), GLA_RANK ** -0.5),
        "gla_bg_b": nrm((DEPTH, GLA_QK), 0.1),
        "gla_norm_g": 1.0 + nrm((DEPTH, GLA_DV), 0.02),
        "na_rpb": nrm((DEPTH, NA_HEADS, 2 * WIN_R - 1, 2 * WIN_C - 1), 0.02),
        "w_br_conv": nrm((DEPTH, CONV_DIM, D), CONV_DIM ** -0.5 * beta),
        "w_br_gla": nrm((DEPTH, GLA_V, D), GLA_V ** -0.5 * beta),
        "w_br_na": nrm((DEPTH, NA_W, D), NA_W ** -0.5 * beta),
        "gate_b": nrm((DEPTH, N_BRANCH * D), 0.1),
        "w_out": nrm((DEPTH, D, D), D ** -0.5 * beta),
        "ln1_g": 1.0 + nrm((DEPTH, D), 0.02),
        "ln1_b": nrm((DEPTH, D), 0.02),
        "ln2_g": 1.0 + nrm((DEPTH, D), 0.02),
        "ln2_b": nrm((DEPTH, D), 0.02),
        "ffn_w_gate": nrm((n_dense, D, D_FF), D ** -0.5),
        "ffn_w_up": nrm((n_dense, D, D_FF), D ** -0.5),
        "ffn_w_down": nrm((n_dense, D_FF, D), D_FF ** -0.5 * beta),
        "moe_router": nrm((n_moe, D, N_EXPERTS), D ** -0.5),
        "moe_w_gate": nrm((n_moe, N_EXPERTS, D, D_FF), D ** -0.5),
        "moe_w_up": nrm((n_moe, N_EXPERTS, D, D_FF), D ** -0.5),
        "moe_w_down": nrm((n_moe, N_EXPERTS, D_FF, D), D_FF ** -0.5 * beta),
    }


def reference(x, c, ctx, c_ctx, ada_w, ada_b, w_in, conv_w, gla_wg_f, gla_bg_f, gla_wg_b, gla_bg_b,
              gla_norm_g, na_rpb, w_br_conv, w_br_gla, w_br_na, gate_b, w_out,
              ln1_g, ln1_b, ln2_g, ln2_b, ffn_w_gate, ffn_w_up, ffn_w_down,
              moe_router, moe_w_gate, moe_w_up, moe_w_down):
    xl, xc = x, ctx
    for i in range(DEPTH):
        last = i == DEPTH - 1
        mod_l = jax.nn.silu(c) @ ada_w[i] + ada_b[i]
        mod_c = jax.nn.silu(c_ctx) @ ada_w[i] + ada_b[i]
        sh1, sc1, g1, sh2, sc2, g2 = [m[:, None, :] for m in jnp.split(mod_l, 6, axis=-1)]
        csh1, csc1, cg1, csh2, csc2, cg2 = jnp.split(mod_c, 6, axis=-1)

        hl = xl * (1 + sc1) + sh1
        hc = xc * (1 + csc1) + csh1
        yl, yc = token_mixer(hl, hc, w_in[i], conv_w[i], gla_wg_f[i], gla_bg_f[i], gla_wg_b[i],
                             gla_bg_b[i], gla_norm_g[i], na_rpb[i], w_br_conv[i], w_br_gla[i],
                             w_br_na[i], gate_b[i], w_out[i], not last)
        xl = layer_norm(DEEPNORM_ALPHA * xl + g1 * yl, ln1_g[i], ln1_b[i])

        hl = xl * (1 + sc2) + sh2
        if i % 2 == 0:
            j = i // 2
            ffn = lambda h: swiglu(h, ffn_w_gate[j], ffn_w_up[j], ffn_w_down[j])
        else:
            j = i // 2
            ffn = lambda h: moe_swiglu(h, moe_router[j], moe_w_gate[j], moe_w_up[j], moe_w_down[j])
        xl = layer_norm(DEEPNORM_ALPHA * xl + g2 * ffn(hl), ln2_g[i], ln2_b[i])

        if not last:
            xc = layer_norm(DEEPNORM_ALPHA * xc + cg1 * yc, ln1_g[i], ln1_b[i])
            hc = xc * (1 + csc2) + csh2
            xc = layer_norm(DEEPNORM_ALPHA * xc + cg2 * ffn(hc), ln2_g[i], ln2_b[i])
    return xl
```

```cpp
#include <hip/hip_runtime.h>
#include <cstdio>

namespace pg8 {
#define PG8_LAS __attribute__((address_space(3)))
typedef unsigned short bf16_t;
typedef short bf16x8 __attribute__((ext_vector_type(8)));
typedef float f32x4 __attribute__((ext_vector_type(4)));
typedef unsigned u32x4 __attribute__((ext_vector_type(4)));
typedef unsigned u32x2 __attribute__((ext_vector_type(2)));
constexpr int BM = 256, BK = 64, HALF = 128, HTB = HALF * BK * 2  , STAGE_BYTES = 8 * HTB, NXCD = 8, WGM = 8;

__host__ __device__ __forceinline__ int lds_byte(int r, int c) { const int st = (r >> 4) * 2 + (c >> 5), rr = r & 15, cc = c & 31, ob = rr * 64 + cc * 2; return st * 1024 + (ob ^ (((ob >> 9) & 1) << 5)); }
__host__ __device__ __forceinline__ void stage_rc(int b, int& R, int& C) { const int st = b / 1024, sb = b % 1024, swz = sb ^ (((sb >> 9) & 1) << 5); R = (st >> 1) * 16 + swz / 64; C = (st & 1) * 32 + (swz % 64) / 2; }
__host__ __device__ __forceinline__ int perm32(int rho) { const int n = rho >> 4, i = rho & 15; return 8 * (i >> 2) + 4 * n + (i & 3); }

struct Unit { int pm, pn, pb; };
struct Gemm { const bf16_t* A; const bf16_t* Bt; int M, N, K; };

__device__ __forceinline__ int xcd_remap(int wgid, int nwg) { const int q = nwg / NXCD, r = nwg % NXCD, xcd = wgid % NXCD, off = wgid / NXCD; return (xcd < r ? xcd * (q + 1) : r * (q + 1) + (xcd - r) * q) + off; }
struct StaticOrder {
    int nM, nN, nwg, G, c;
    __host__ __device__ void init(int M, int N, int G_, int c_) { nM = M / BM; nN = N / BM; nwg = nM * nN; G = G_; c = c_; }
    __device__ __forceinline__ bool next(int i, Unit& u) const {
        const long L = (long)i * G + c; if (L >= nwg) return false;
        const int wgid = xcd_remap((int)L, nwg);
        const int nig = WGM * nN, gid = wgid / nig, fm = gid * WGM, gsz = (nM - fm) < WGM ? (nM - fm) : WGM;
        u.pm = fm + ((wgid % nig) % gsz); u.pn = (wgid % nig) / gsz; u.pb = u.pn; return true;
    }
    __device__ __forceinline__ void a_ready(const Unit&) const {}
    __device__ __forceinline__ void done(const Unit&) const {}
};
struct MoeOrder {
    int nN, G, c, nunits; int pp[9];
    __device__ __forceinline__ void init(const unsigned* cnt, int nN_, int G_, int c_) { nN = nN_; G = G_; c = c_; pp[0] = 0;
#pragma unroll
        for (int e = 0; e < 8; ++e) pp[e + 1] = pp[e] + (int)((cnt[e] + 255u) >> 8);
        nunits = pp[8] * nN; }
    __device__ __forceinline__ bool next(int i, Unit& u) const {
        const long L = (long)i * G + c; if (L >= nunits) return false;
        const int wgid = xcd_remap((int)L, nunits);
        int e = 0, base = 0, npe = pp[1];
#pragma unroll
        for (int k = 1; k < 8; ++k) { if (wgid >= pp[k] * nN) { e = k; base = pp[k]; npe = pp[k + 1] - pp[k]; } }
        if (npe < 1) npe = 1;
        const int local = wgid - base * nN;
        u.pm = base + local % npe; u.pn = local / npe; u.pb = e * nN + u.pn; return true;
    }
    __device__ __forceinline__ void a_ready(const Unit&) const {}
    __device__ __forceinline__ void done(const Unit&) const {}
};

__device__ __forceinline__ unsigned cvt_pk_bf16(float lo, float hi) { unsigned r; asm volatile("v_cvt_pk_bf16_f32 %0, %1, %2" : "=v"(r) : "v"(lo), "v"(hi)); return r; }
__device__ __forceinline__ float bf_lo(unsigned w) { return __uint_as_float(w << 16); }
__device__ __forceinline__ float bf_hi(unsigned w) { return __uint_as_float(w & 0xffff0000u); }
__device__ __forceinline__ float fast_sigmoid(float x) { return __builtin_amdgcn_rcpf(1.0f + __expf(-x)); }

struct EpiBf16Plain {
    static constexpr bool PERM = true, AFTER_DRAIN = false;
    bf16_t* O; int ldc;
    __device__ __forceinline__ void operator()(const f32x4 (&acc)[2][2][4][2], const Unit& u, int wr, int wc, int fr, int fq) const {
        const int row0 = u.pm * BM + wr * 64 + fr, col0 = u.pn * BM + wc * 32 + 8 * fq;
#pragma unroll
        for (int ai = 0; ai < 2; ++ai)
#pragma unroll
            for (int m = 0; m < 4; ++m) { bf16_t* rowp = O + (size_t)(row0 + ai * HALF + m * 16) * ldc + col0;
#pragma unroll
                for (int bj = 0; bj < 2; ++bj) { const f32x4 v0 = acc[ai][bj][m][0], v1 = acc[ai][bj][m][1];
                    u32x4 w; w.x = cvt_pk_bf16(v0[0], v0[1]); w.y = cvt_pk_bf16(v0[2], v0[3]); w.z = cvt_pk_bf16(v1[0], v1[1]); w.w = cvt_pk_bf16(v1[2], v1[3]);
                    *(u32x4*)(rowp + bj * HALF) = w; } }
    }
};
struct EpiF32Plain {
    static constexpr bool PERM = false, AFTER_DRAIN = false;
    float* C; int ldc;
    __device__ __forceinline__ void operator()(const f32x4 (&acc)[2][2][4][2], const Unit& u, int wr, int wc, int fr, int fq) const {
        const int row0 = u.pm * BM + wr * 64 + fr, col0 = u.pn * BM + wc * 32 + 4 * fq;
#pragma unroll
        for (int ai = 0; ai < 2; ++ai)
#pragma unroll
            for (int m = 0; m < 4; ++m) { float* rowp = C + (size_t)(row0 + ai * HALF + m * 16) * ldc + col0;
#pragma unroll
                for (int bj = 0; bj < 2; ++bj)
#pragma unroll
                    for (int n = 0; n < 2; ++n) *(f32x4*)(rowp + bj * HALF + n * 16) = acc[ai][bj][m][n]; }
    }
};
struct EpiGate {
    static constexpr bool PERM = false, AFTER_DRAIN = false;
    const bf16_t* Ug; int ldu;
    const float* gb;
    float* Z; bf16_t* ZB; int first, last;
    __device__ __forceinline__ void operator()(const f32x4 (&acc)[2][2][4][2], const Unit& u, int wr, int wc, int fr, int fq) const {
        const int row0 = u.pm * BM + wr * 64 + fr, col0 = u.pn * BM + wc * 32 + 4 * fq;
#pragma unroll
        for (int ai = 0; ai < 2; ++ai)
#pragma unroll
            for (int m = 0; m < 4; ++m) { const size_t row = (size_t)(row0 + ai * HALF + m * 16);
#pragma unroll
                for (int bj = 0; bj < 2; ++bj)
#pragma unroll
                    for (int n = 0; n < 2; ++n) { const int col = col0 + bj * HALF + n * 16;
                        const u32x2 gl = *(const u32x2*)(Ug + row * ldu + col); const f32x4 b4 = *(const f32x4*)(gb + col);
                        f32x4 v = acc[ai][bj][m][n];
                        v[0] *= fast_sigmoid(bf_lo(gl.x) + b4[0]); v[1] *= fast_sigmoid(bf_hi(gl.x) + b4[1]); v[2] *= fast_sigmoid(bf_lo(gl.y) + b4[2]); v[3] *= fast_sigmoid(bf_hi(gl.y) + b4[3]);
                        if (!first) v += *(const f32x4*)(Z + row * 2048 + col);
                        if (!last) *(f32x4*)(Z + row * 2048 + col) = v;
                        else { u32x2 w; w.x = cvt_pk_bf16(v[0], v[1]); w.y = cvt_pk_bf16(v[2], v[3]); *(u32x2*)(ZB + row * 2048 + col) = w; } } }
    }
};
struct EpiRes {
    static constexpr bool PERM = false, AFTER_DRAIN = false;
    const float* res_lat; const float* res_ctx; const float* gv; int gstride; float* out; float alpha;
    __device__ __forceinline__ void operator()(const f32x4 (&acc)[2][2][4][2], const Unit& u, int wr, int wc, int fr, int fq) const {
        const int grp = u.pm < 16 ? 0 : (u.pm < 32 ? 1 : 2);
        const float* res = u.pm < 32 ? res_lat + (size_t)u.pm * BM * 2048 : res_ctx + (size_t)(u.pm - 32) * BM * 2048;
        const float* g = gv + (size_t)grp * gstride;
        const int rl0 = wr * 64 + fr, col0 = u.pn * BM + wc * 32 + 4 * fq;
#pragma unroll
        for (int ai = 0; ai < 2; ++ai)
#pragma unroll
            for (int m = 0; m < 4; ++m) { const int rl = rl0 + ai * HALF + m * 16;
#pragma unroll
                for (int bj = 0; bj < 2; ++bj)
#pragma unroll
                    for (int n = 0; n < 2; ++n) { const int col = col0 + bj * HALF + n * 16;
                        const f32x4 r4 = *(const f32x4*)(res + (size_t)rl * 2048 + col); const f32x4 g4 = *(const f32x4*)(g + col);
                        *(f32x4*)(out + ((size_t)u.pm * BM + rl) * 2048 + col) = r4 * alpha + g4 * acc[ai][bj][m][n]; } }
    }
};
struct EpiSwiGLU {
    static constexpr bool PERM = true, AFTER_DRAIN = false;
    bf16_t* O; int ldc;
    __device__ __forceinline__ void operator()(const f32x4 (&acc)[2][2][4][2], const Unit& u, int wr, int wc, int fr, int fq) const {
        const int row0 = u.pm * BM + wr * 64 + fr, col0 = u.pn * HALF + wc * 32 + 8 * fq;
#pragma unroll
        for (int ai = 0; ai < 2; ++ai)
#pragma unroll
            for (int m = 0; m < 4; ++m) { bf16_t* rowp = O + (size_t)(row0 + ai * HALF + m * 16) * ldc + col0;
                float h[8];
#pragma unroll
                for (int n = 0; n < 2; ++n)
#pragma unroll
                    for (int j = 0; j < 4; ++j) { const float gt = acc[ai][0][m][n][j], up = acc[ai][1][m][n][j]; h[n * 4 + j] = gt * fast_sigmoid(gt) * up; }
                u32x4 w; w.x = cvt_pk_bf16(h[0], h[1]); w.y = cvt_pk_bf16(h[2], h[3]); w.z = cvt_pk_bf16(h[4], h[5]); w.w = cvt_pk_bf16(h[6], h[7]);
                *(u32x4*)rowp = w; }
    }
};

template <class Epi, class Sched, bool ALIGN_EPI = false, bool SP2 = false>
__device__ __forceinline__ void gemm_phase(PG8_LAS unsigned char* lds, const Gemm g, const Sched& S, const Epi& E) {
    int tid_ = threadIdx.x; asm volatile("" : "+v"(tid_));
    const int tid = tid_, wid = __builtin_amdgcn_readfirstlane(tid >> 6), lane = tid & 63, wr = wid >> 2, wc = wid & 3, fr = lane & 15, fq = lane >> 4;
    const int K = g.K, nt = K / BK;
    unsigned voffA[2], voffB[2];
#pragma unroll
    for (int i = 0; i < 2; ++i) { int R, C; stage_rc(tid * 16 + i * 8192, R, C); const int Rb = Epi::PERM ? ((R & ~31) + perm32(R & 31)) : R;
        voffA[i] = (unsigned)(R * K + C) * 2u; voffB[i] = (unsigned)(Rb * K + C) * 2u; }
    const size_t kstep = (size_t)(BK * 2);
    const size_t hstep = (size_t)HALF * K * 2;
    const size_t tstep = 2 * hstep;
    const unsigned ldsw = (unsigned)wid * 1024u;
    const int aoff = lds_byte(wr * 64 + fr, fq * 8), boff = lds_byte(wc * 32 + fr, fq * 8);
#define PG8_SA(b, h) (((b) * 2 + (h)) * HTB)
#define PG8_SB(b, h) ((4 + (b) * 2 + (h)) * HTB)
#define PG8_STAGE(bufoff, gbase, voff) do { _Pragma("unroll") for (int _i = 0; _i < 2; ++_i) \
        __builtin_amdgcn_global_load_lds((const unsigned*)((const char*)(gbase) + (voff)[_i]), (PG8_LAS unsigned*)(lds + (bufoff) + ldsw + _i * 8192), 16, 0, 0); } while (0)
#define PG8_LDA(dst, b, h) do { _Pragma("unroll") for (int m = 0; m < 4; ++m) _Pragma("unroll") for (int k = 0; k < 2; ++k) dst[m][k] = *(const PG8_LAS bf16x8*)(lds + PG8_SA(b, h) + aoff + m * 2048 + k * 1024); } while (0)
#define PG8_LDB(dst, b, h) do { _Pragma("unroll") for (int n = 0; n < 2; ++n) _Pragma("unroll") for (int k = 0; k < 2; ++k) dst[n][k] = *(const PG8_LAS bf16x8*)(lds + PG8_SB(b, h) + boff + n * 2048 + k * 1024); } while (0)
#define PG8_MMA(ai, bj, At, Bt) do { __builtin_amdgcn_s_setprio(1); _Pragma("unroll") for (int m = 0; m < 4; ++m) _Pragma("unroll") for (int n = 0; n < 2; ++n) _Pragma("unroll") for (int k = 0; k < 2; ++k) \
        acc[ai][bj][m][n] = __builtin_amdgcn_mfma_f32_16x16x32_bf16(Bt[n][k], At[m][k], acc[ai][bj][m][n], 0, 0, 0); __builtin_amdgcn_s_setprio(0); } while (0)
#define PG8_WAIT_V(n) asm volatile("s_waitcnt vmcnt(" #n ")" ::: "memory")
#define PG8_WAIT_L(n) asm volatile("s_waitcnt lgkmcnt(" #n ")" ::: "memory")
#define PG8_BAR __builtin_amdgcn_s_barrier()
#define PG8_SCHED __builtin_amdgcn_sched_barrier(0)
    Unit cur, nxt; int ui = 0;
    if (!S.next(0, cur)) return;
    f32x4 acc[2][2][4][2];
#pragma unroll
    for (int a = 0; a < 2; ++a)
#pragma unroll
        for (int b = 0; b < 2; ++b)
#pragma unroll
            for (int m = 0; m < 4; ++m)
#pragma unroll
                for (int n = 0; n < 2; ++n) acc[a][b][m][n] = (f32x4){0.f, 0.f, 0.f, 0.f};
    bf16x8 At[4][2], B0[2][2], B1[2][2];
    const char* cA = (const char*)g.A + (size_t)cur.pm * tstep; const char* cB = (const char*)g.Bt + (size_t)cur.pb * tstep;
    S.a_ready(cur);
    if constexpr (SP2) {
        PG8_STAGE(PG8_SB(0, 0), cB, voffB); PG8_STAGE(PG8_SB(0, 1), cB + hstep, voffB); PG8_STAGE(PG8_SA(0, 0), cA, voffA); PG8_STAGE(PG8_SA(0, 1), cA + hstep, voffA);
        if (wr == 1) PG8_BAR;
        PG8_WAIT_V(2); PG8_BAR;
        PG8_STAGE(PG8_SB(1, 0), cB + kstep, voffB); PG8_STAGE(PG8_SA(1, 0), cA + kstep, voffA); PG8_STAGE(PG8_SB(1, 1), cB + hstep + kstep, voffB);
        PG8_WAIT_V(6); PG8_BAR;
    } else {
        PG8_STAGE(PG8_SB(0, 0), cB, voffB); PG8_STAGE(PG8_SA(0, 0), cA, voffA); PG8_STAGE(PG8_SB(0, 1), cB + hstep, voffB); PG8_STAGE(PG8_SA(0, 1), cA + hstep, voffA);
        if (wr == 1) PG8_BAR;
        PG8_WAIT_V(4); PG8_BAR;
        PG8_STAGE(PG8_SB(1, 0), cB + kstep, voffB); PG8_STAGE(PG8_SA(1, 0), cA + kstep, voffA); PG8_STAGE(PG8_SB(1, 1), cB + hstep + kstep, voffB);
        PG8_WAIT_V(6); PG8_BAR;
    }
    for (;;) {
        const bool has_next = S.next(ui + 1, nxt);
        const char* nA = has_next ? (const char*)g.A + (size_t)nxt.pm * tstep : cA; const char* nB = has_next ? (const char*)g.Bt + (size_t)nxt.pb * tstep : cB;
        for (int t = 0; t < nt; t += 2) {
            const bool last = (t == nt - 2);
            const char* a1 = cA + (size_t)(t + 1) * kstep;
            const char* a2 = last ? nA : cA + (size_t)(t + 2) * kstep; const char* b2 = last ? nB : cB + (size_t)(t + 2) * kstep;
            const char* a3 = a2 + kstep; const char* b3 = b2 + kstep;
            if (last && has_next) S.a_ready(nxt);
            if constexpr (SP2) {
            PG8_LDB(B0, 0, 0); PG8_LDB(B1, 0, 1); PG8_SCHED; PG8_LDA(At, 0, 0); PG8_STAGE(PG8_SA(1, 1), a1 + hstep, voffA);
            PG8_WAIT_V(8); PG8_WAIT_L(0); PG8_BAR; PG8_MMA(0, 0, At, B0); PG8_MMA(0, 1, At, B1); PG8_BAR; PG8_SCHED;
            PG8_LDA(At, 0, 1); PG8_STAGE(PG8_SB(0, 0), b2, voffB); PG8_STAGE(PG8_SB(0, 1), b2 + hstep, voffB); PG8_STAGE(PG8_SA(0, 0), a2, voffA);
            PG8_WAIT_V(8); PG8_WAIT_L(0); PG8_BAR; PG8_MMA(1, 0, At, B0); PG8_MMA(1, 1, At, B1); PG8_BAR; PG8_SCHED;
            PG8_LDB(B0, 1, 0); PG8_LDB(B1, 1, 1); PG8_SCHED; PG8_LDA(At, 1, 0); PG8_STAGE(PG8_SA(0, 1), a2 + hstep, voffA);
            PG8_WAIT_V(8); PG8_WAIT_L(0); PG8_BAR; PG8_MMA(0, 0, At, B0); PG8_MMA(0, 1, At, B1); PG8_BAR; PG8_SCHED;
            PG8_LDA(At, 1, 1); PG8_STAGE(PG8_SB(1, 0), b3, voffB); PG8_STAGE(PG8_SB(1, 1), b3 + hstep, voffB); PG8_STAGE(PG8_SA(1, 0), a3, voffA);
            PG8_WAIT_V(8); PG8_WAIT_L(0); PG8_BAR; PG8_MMA(1, 0, At, B0); PG8_MMA(1, 1, At, B1); PG8_BAR; PG8_SCHED;
            } else {
            PG8_LDB(B0, 0, 0); PG8_SCHED; PG8_LDA(At, 0, 0); PG8_STAGE(PG8_SA(1, 1), a1 + hstep, voffA);
            PG8_WAIT_L(8); PG8_BAR; PG8_WAIT_L(0); PG8_MMA(0, 0, At, B0); PG8_BAR; PG8_SCHED;
            PG8_LDB(B1, 0, 1); PG8_STAGE(PG8_SB(0, 0), b2, voffB);
            PG8_BAR; PG8_WAIT_L(0); PG8_MMA(0, 1, At, B1); PG8_BAR;
            PG8_LDA(At, 0, 1); PG8_STAGE(PG8_SA(0, 0), a2, voffA);
            PG8_BAR; PG8_WAIT_L(0); PG8_MMA(1, 0, At, B0); PG8_BAR; PG8_SCHED;
            PG8_STAGE(PG8_SB(0, 1), b2 + hstep, voffB);
            PG8_WAIT_V(6); PG8_BAR; PG8_MMA(1, 1, At, B1); PG8_BAR;
            PG8_LDB(B0, 1, 0); PG8_SCHED; PG8_LDA(At, 1, 0); PG8_STAGE(PG8_SA(0, 1), a2 + hstep, voffA);
            PG8_WAIT_L(8); PG8_BAR; PG8_WAIT_L(0); PG8_MMA(0, 0, At, B0); PG8_BAR; PG8_SCHED;
            PG8_LDB(B1, 1, 1); PG8_STAGE(PG8_SB(1, 0), b3, voffB);
            PG8_BAR; PG8_WAIT_L(0); PG8_MMA(0, 1, At, B1); PG8_BAR;
            PG8_LDA(At, 1, 1); PG8_STAGE(PG8_SA(1, 0), a3, voffA);
            PG8_BAR; PG8_WAIT_L(0); PG8_MMA(1, 0, At, B0); PG8_BAR; PG8_SCHED;
            PG8_STAGE(PG8_SB(1, 1), b3 + hstep, voffB);
            PG8_WAIT_V(6); PG8_BAR; PG8_MMA(1, 1, At, B1); PG8_BAR;
            }
        }
        if constexpr (ALIGN_EPI) { if (wr == 0) PG8_BAR; }
        if constexpr (!Epi::AFTER_DRAIN) { E(acc, cur, wr, wc, fr, fq); S.done(cur); }
        if (!has_next) break;
#pragma unroll
        for (int a = 0; a < 2; ++a)
#pragma unroll
            for (int b = 0; b < 2; ++b)
#pragma unroll
                for (int m = 0; m < 4; ++m)
#pragma unroll
                    for (int n = 0; n < 2; ++n) acc[a][b][m][n] = (f32x4){0.f, 0.f, 0.f, 0.f};
        cur = nxt; cA = nA; cB = nB; ++ui;
        if constexpr (ALIGN_EPI) { if (wr == 1) PG8_BAR; }
    }
    PG8_WAIT_V(0);
    if constexpr (!ALIGN_EPI) { if (wr == 0) PG8_BAR; }
    PG8_BAR;
    if constexpr (Epi::AFTER_DRAIN) { E.fused(acc, cur, wr, wc, fr, fq, lds, wid, lane); S.done(cur); }
#undef PG8_SA
#undef PG8_SB
#undef PG8_STAGE
#undef PG8_LDA
#undef PG8_LDB
#undef PG8_MMA
#undef PG8_WAIT_V
#undef PG8_WAIT_L
#undef PG8_BAR
#undef PG8_SCHED
}
}

constexpr int NWAVES = 8, NTHR = 512;
constexpr int D = 2048, SEQ = 4096, NLAT = 8192, CTXL = 256, NCTX = 512, MROWS = 8704, DEPTH = 2;
constexpr int INC = 15392, NU = 15360;
constexpr int U_CB = 0, U_CC = 1024, U_CX = 2048, U_GQ = 3072, U_GK = 3584, U_GV = 4096, U_GR = 5120, U_NQ = 6144, U_NK = 7168, U_NV = 8192, U_GATE = 9216;
constexpr int LR_COL = 6144;
constexpr int FF = 5632, NGU = 2 * FF, NE = 8;
constexpr float LN_EPS = 1e-5f, ALPHA = 1.41421356237f;
constexpr int MOE_MAXP = 72;

constexpr size_t MiB = 1u << 20;
constexpr size_t WS_CTL = 0, CTL_ZERO_BYTES = 1 * MiB;
constexpr size_t WS_MOD = 1 * MiB;
constexpr size_t WS_WLR = 1 * MiB + 512 * 1024;
constexpr size_t WS_ROUTE = 2 * MiB;
constexpr size_t WS_TOK = 2 * MiB + 256 * 1024;
constexpr size_t WS_LR = 3 * MiB;
constexpr size_t WS_W = 8 * MiB;
constexpr size_t W_IN_B = (size_t)NU * D * 2, W_BR_B = (size_t)1024 * D * 2, W_OUT_B = (size_t)D * D * 2, W_LAYER_B = W_IN_B + 3 * W_BR_B + W_OUT_B;
constexpr size_t W_GU_B = (size_t)NGU * D * 2, W_D_B = (size_t)D * FF * 2, W_FFN_B = W_GU_B + W_D_B;
constexpr size_t WS_WFFN = WS_W + 2 * W_LAYER_B, WS_WMOE = WS_WFFN + W_FFN_B, WS_WEND = WS_WMOE + 8 * W_FFN_B;
constexpr size_t WS_XL = 762 * MiB;
constexpr size_t WS_H = 830 * MiB;
constexpr size_t WS_U = 864 * MiB;
constexpr size_t WS_Y = 1119 * MiB;
constexpr size_t WS_GLA = 1170 * MiB;
constexpr size_t WS_Z = 1306 * MiB;
constexpr size_t WS_ZB = 1374 * MiB;
constexpr size_t WS_PRE = 1408 * MiB;
constexpr size_t WS_END = 1476 * MiB;
static_assert(WS_WEND <= WS_XL && WS_XL + (size_t)MROWS * D * 4 <= WS_H && WS_H + (size_t)MROWS * D * 2 <= WS_U && WS_U + (size_t)MROWS * NU * 2 <= WS_Y, "ws map 1");
static_assert(WS_U + (size_t)MOE_MAXP * 256 * FF * 2 <= WS_Y && WS_Y + 3 * (size_t)MROWS * 1024 * 2 <= WS_GLA && WS_GLA + (size_t)MROWS * (4 * 512 + 2 * 1024) * 4 <= WS_Z, "ws map 2");
static_assert(WS_GLA + (size_t)MOE_MAXP * 256 * D * 2 <= WS_Z && WS_Z + (size_t)MOE_MAXP * 256 * D * 4 <= WS_END && WS_PRE + (size_t)MROWS * D * 4 <= WS_END, "ws map 3");
constexpr int CW_TMO = 0, CW_CODE = 1;
constexpr int CW_MOECNT = 64;
constexpr int CW_BAR = 4096;

constexpr int RING_OFF = 0, RING_BYTES = 131072;
constexpr int LDSCTL_OFF = RING_BYTES, MISC_OFF = LDSCTL_OFF + 320;
constexpr int LDS_BYTES = 147456;

#define GAS __attribute__((address_space(1)))
#define LAS __attribute__((address_space(3)))
typedef unsigned short bf16;
typedef unsigned v4u __attribute__((ext_vector_type(4)));
typedef unsigned v2u __attribute__((ext_vector_type(2)));
typedef float f32x4 __attribute__((ext_vector_type(4)));
typedef GAS unsigned gu32;
#define RLX_AGENT __ATOMIC_RELAXED, __HIP_MEMORY_SCOPE_AGENT
#define LDS_WAIT() asm volatile("s_waitcnt lgkmcnt(0)" ::: "memory")
#define VM_WAIT() asm volatile("s_waitcnt vmcnt(0)" ::: "memory")
__device__ __forceinline__ unsigned f2bf(float f) { unsigned u = __builtin_bit_cast(unsigned, f); return (u + 0x7fffu + ((u >> 16) & 1u)) >> 16; }
__device__ __forceinline__ unsigned pk2(float lo, float hi) { return f2bf(lo) | (f2bf(hi) << 16); }
__device__ __forceinline__ float bflo(unsigned w) { return __uint_as_float(w << 16); }
__device__ __forceinline__ float bfhi(unsigned w) { return __uint_as_float(w & 0xffff0000u); }
__device__ __forceinline__ float bf1(bf16 b) { return __uint_as_float(((unsigned)b) << 16); }
__device__ __forceinline__ float wave_sum(float v) {
#pragma unroll
    for (int o = 1; o < 64; o <<= 1) v += __shfl_xor(v, o);
    return v;
}
__device__ __forceinline__ float wave_max(float v) {
#pragma unroll
    for (int o = 1; o < 64; o <<= 1) v = fmaxf(v, __shfl_xor(v, o));
    return v;
}

#define XB_TMO      128
#define XB_XCNT(j)  (256  + 64 * (j))
#define XB_XSUB(j)  (1280 + 64 * (j))
#define XB_XGEN(j)  (2304 + 64 * (j))
#define XB_TOP      3328
#define XB_TOPGEN   3392
#define XCD_BAR_WORDS 3456
#define XB_SPIN_CAP (1u << 18)

__device__ __forceinline__ unsigned xb_ld(unsigned* p)              { return __hip_atomic_load(p, __ATOMIC_RELAXED, __HIP_MEMORY_SCOPE_AGENT); }
__device__ __forceinline__ unsigned xb_add(unsigned* p, unsigned v) { return __hip_atomic_fetch_add(p, v, __ATOMIC_RELAXED, __HIP_MEMORY_SCOPE_AGENT); }
__device__ __forceinline__ unsigned xb_xcc_id() { return (unsigned)__builtin_amdgcn_s_getreg((3 << 11) | 20) & 0xFu; }
#define XB_SPIN(cond, bar) do { unsigned _sp = 0; while (cond) { __builtin_amdgcn_s_sleep(1); \
    if ((++_sp & 255u) == 0u) { if (xb_ld(&(bar)[XB_TMO])) break; if (_sp > XB_SPIN_CAP) { atomicAdd(&(bar)[XB_TMO], 1u); break; } } } } while (0)

struct XcdBarrier {
    unsigned* bar; unsigned x; unsigned grid;
    volatile LAS unsigned* st;
};

__device__ __forceinline__ XcdBarrier xcd_barrier_post(unsigned* bar, volatile LAS unsigned* st, unsigned grid) {
    XcdBarrier b; b.grid = grid; b.bar = bar; b.x = xb_xcc_id(); b.st = st;
    if (threadIdx.x == 0) (void)xb_add(&bar[XB_XCNT(b.x)], 1u);
    return b;
}
__device__ __forceinline__ void xcd_barrier_complete(unsigned* bar, unsigned x, unsigned& nloc, unsigned& nx, unsigned b_grid) {
    const unsigned G = b_grid;
    unsigned sum, cnt, mine, sp = 0u;
    for (;;) {
        sum = 0u; cnt = 0u; mine = 0u;
#pragma unroll
        for (unsigned j = 0; j < 16; ++j) { const unsigned c = xb_ld(&bar[XB_XCNT(j)]); sum += c; cnt += (c > 0u) ? 1u : 0u; mine = (j == x) ? c : mine; }
        if (sum == G) break;
        __builtin_amdgcn_s_sleep(1);
        if ((++sp & 255u) == 0u) { if (xb_ld(&bar[XB_TMO])) break; if (sp > XB_SPIN_CAP) { atomicAdd(&bar[XB_TMO], 1u); break; } }
    }
    nloc = mine > 0u ? mine : 1u; nx = cnt > 0u ? cnt : 1u;
}

__device__ __forceinline__ void xcd_barrier(const XcdBarrier& b) {
    asm volatile("s_waitcnt vmcnt(0)" ::: "memory");
    __syncthreads();
    if (threadIdx.x == 0) {
        unsigned* bar = b.bar;
        __builtin_amdgcn_s_waitcnt(0);
        unsigned nloc = b.st[0], nx = b.st[1];
        if (nloc == 0u) { xcd_barrier_complete(bar, b.x, nloc, nx, b.grid); b.st[0] = nloc; b.st[1] = nx; }
        const unsigned old = xb_add(&bar[XB_XSUB(b.x)], 1u);
        const unsigned gen = old / nloc;
        if (old + 1u == (gen + 1u) * nloc) {
            __builtin_amdgcn_fence(__ATOMIC_RELEASE, "agent");
            asm volatile("s_waitcnt vmcnt(0)" ::: "memory");
            const unsigned og = xb_add(&bar[XB_TOP], 1u);
            const unsigned tg = og / nx;
            if (og + 1u == (tg + 1u) * nx) xb_add(&bar[XB_TOPGEN], 1u);
            else XB_SPIN(xb_ld(&bar[XB_TOPGEN]) == tg, bar);
            __builtin_amdgcn_fence(__ATOMIC_ACQUIRE, "agent");
            xb_add(&bar[XB_XGEN(b.x)], 1u);
            asm volatile("s_waitcnt vmcnt(0)" ::: "memory");
        } else {
            XB_SPIN(xb_ld(&bar[XB_XGEN(b.x)]) == gen, bar);
            __builtin_amdgcn_fence(__ATOMIC_ACQUIRE, "agent");
            asm volatile("s_waitcnt vmcnt(0)" ::: "memory");
        }
    }
    __syncthreads();
}

struct Args { const float* in[30]; float* out; unsigned char* ws; int ph_lo, ph_hi, grid, pad; };
struct Frame {
    LAS unsigned char* lds;
    volatile LAS unsigned* MISC;
    int tid, lane, wave, vcu, G, bx;
};
__device__ __forceinline__ Frame mkframe(LAS unsigned char* lds, int grid) {
    Frame F; int t = threadIdx.x; asm volatile("" : "+v"(t)); int g = grid, bx = blockIdx.x; asm volatile("" : "+s"(g), "+s"(bx));
    F.lds = lds; F.MISC = (volatile LAS unsigned*)(lds + MISC_OFF); F.tid = t; F.lane = t & 63; F.wave = __builtin_amdgcn_readfirstlane(t >> 6); F.G = g; F.bx = bx;
    F.vcu = (g % 8 == 0) ? (bx % 8) * (g / 8) + bx / 8 : bx; return F;
}
constexpr int PTAB_OFF = LDSCTL_OFF + 1024, PT_OUT = 30, PT_WS = 31;
__device__ __forceinline__ unsigned long long ldp_raw(Frame& F, int i) {
    const volatile LAS unsigned* t = (const volatile LAS unsigned*)(F.lds + PTAB_OFF) + 2 * i; const unsigned lo = t[0], hi = t[1];
    return ((unsigned long long)(unsigned)__builtin_amdgcn_readfirstlane((int)hi) << 32) | (unsigned)__builtin_amdgcn_readfirstlane((int)lo);
}
#define PIN(i) ((const float*)(const GAS float*)ldp_raw(F, (i)))
#define POUT() ((float*)(GAS float*)ldp_raw(F, PT_OUT))
#define PWS() ((unsigned char*)(GAS unsigned char*)ldp_raw(F, PT_WS))
__device__ __forceinline__ bf16* w_in_t(unsigned char* ws, int L) { return (bf16*)(ws + WS_W + (size_t)L * W_LAYER_B); }
__device__ __forceinline__ bf16* w_br_t(unsigned char* ws, int L, int b) { return (bf16*)(ws + WS_W + (size_t)L * W_LAYER_B + W_IN_B + (size_t)b * W_BR_B); }
__device__ __forceinline__ bf16* w_out_t(unsigned char* ws, int L) { return (bf16*)(ws + WS_W + (size_t)L * W_LAYER_B + W_IN_B + 3 * W_BR_B); }
__device__ __forceinline__ bf16* w_gu_t(unsigned char* ws, int e) { return (bf16*)(ws + (e < 0 ? WS_WFFN : WS_WMOE + (size_t)e * W_GU_B)); }
__device__ __forceinline__ bf16* w_d_t(unsigned char* ws, int e) { return (bf16*)(ws + (e < 0 ? WS_WFFN + W_GU_B : WS_WMOE + 8 * W_GU_B + (size_t)e * W_D_B)); }

__device__ __forceinline__ void transpose_item(const float* W, int K, int N, bf16* WT, int drow, LAS float* scr, int kb, int nb, int lane) {
    const int k0 = 64 * kb, n0 = 32 * nb;
#pragma unroll 8
    for (int i = 0; i < 32; ++i) { const int kk = 2 * i + (lane >> 5); scr[kk * 33 + (lane & 31)] = W[(size_t)(k0 + kk) * N + n0 + (lane & 31)]; }
    LDS_WAIT(); asm volatile("" ::: "memory");
    const int c = lane & 7;
#pragma unroll
    for (int j = 0; j < 4; ++j) { const int n = (lane >> 3) + 8 * j; const LAS float* s = scr + (8 * c) * 33 + n;
        v4u o; o.x = pk2(s[0 * 33], s[1 * 33]); o.y = pk2(s[2 * 33], s[3 * 33]); o.z = pk2(s[4 * 33], s[5 * 33]); o.w = pk2(s[6 * 33], s[7 * 33]);
        *(GAS v4u*)(WT + (size_t)(drow + n) * K + k0 + 8 * c) = o; }
    LDS_WAIT(); asm volatile("" ::: "memory");
}
template <int MODE> __device__ __forceinline__ void conv_matrix(Frame& F, const float* W, int K, int N, bf16* WT) {
    LAS float* scr = (LAS float*)(F.lds + RING_OFF + F.wave * 16384);
    const int gw = F.vcu * NWAVES + F.wave, NGW = F.G * NWAVES;
    const int nblk = N / 32, nitems = (K / 64) * nblk;
    for (int it = gw; it < nitems; it += NGW) {
        const int kb = it / nblk, nb = it % nblk; int drow;
        if (MODE == 0) drow = 32 * nb;
        else if (MODE == 1) { if (nb == LR_COL / 32) continue; drow = nb < LR_COL / 32 ? 32 * nb : 32 * (nb - 1); }
        else if (MODE == 2) drow = 256 * (nb >> 2) + 32 * (nb & 3);
        else drow = 256 * (nb >> 2) + 128 + 32 * (nb & 3);
        transpose_item(W, K, N, WT, drow, scr, kb, nb, F.lane);
    }
}
__device__ __forceinline__ void ada_item(Frame& F, unsigned char* ws, const float* cnd, const float* cctx, const float* ada_w, const float* ada_b, int item) {
    const int L = item / 96, c0 = (item % 96) * 128;
    LAS float* sc = (LAS float*)(F.lds + RING_OFF);
    LAS float* red = (LAS float*)(F.lds + RING_OFF + 24576);
    for (int i = F.tid; i < 3 * D; i += NTHR) { const int g = i / D, k = i % D; const float v = g < 2 ? cnd[g * D + k] : cctx[k]; sc[i] = v / (1.0f + __expf(-v)); }
    __syncthreads();
    const float* W = ada_w + (size_t)L * D * 12288 + c0 + 2 * F.lane;
    float a00 = 0.f, a01 = 0.f, a10 = 0.f, a11 = 0.f, a20 = 0.f, a21 = 0.f;
    const int kb = 256 * F.wave;
#pragma unroll 8
    for (int k = kb; k < kb + 256; ++k) { const float2 w = *(const float2*)(W + (size_t)k * 12288); const float s0 = sc[k], s1 = sc[D + k], s2 = sc[2 * D + k];
        a00 += s0 * w.x; a01 += s0 * w.y; a10 += s1 * w.x; a11 += s1 * w.y; a20 += s2 * w.x; a21 += s2 * w.y; }
    red[(F.wave * 3 + 0) * 128 + 2 * F.lane] = a00; red[(F.wave * 3 + 0) * 128 + 2 * F.lane + 1] = a01;
    red[(F.wave * 3 + 1) * 128 + 2 * F.lane] = a10; red[(F.wave * 3 + 1) * 128 + 2 * F.lane + 1] = a11;
    red[(F.wave * 3 + 2) * 128 + 2 * F.lane] = a20; red[(F.wave * 3 + 2) * 128 + 2 * F.lane + 1] = a21;
    __syncthreads();
    if (F.tid < 384) { const int g = F.tid / 128, cc = F.tid % 128; float s = 0.f;
#pragma unroll
        for (int w = 0; w < 8; ++w) s += red[(w * 3 + g) * 128 + cc];
        ((float*)(ws + WS_MOD))[((size_t)L * 3 + g) * 12288 + c0 + cc] = s + ada_b[L * 12288 + c0 + cc]; }
    __syncthreads();
}
__device__ __forceinline__ void p0a_prologue(Frame& F) {
    unsigned char* const ws = PWS();
    { const float* cnd = PIN(1); const float* cctx = PIN(3); const float* ada_w = PIN(4); const float* ada_b = PIN(5);
      for (int it = F.bx; it < 192; it += F.G) ada_item(F, ws, cnd, cctx, ada_w, ada_b, it); }
    const float* const w_in = PIN(6);
    { const int gt = F.bx * NTHR + F.tid, NGT = F.G * NTHR;
      for (int i = gt; i < DEPTH * D * 32; i += NGT) { const int o = i & 31, k = (i >> 5) % D, L = i / (32 * D); ((float*)(ws + WS_WLR))[((size_t)L * 32 + o) * D + k] = w_in[((size_t)L * D + k) * INC + LR_COL + o]; } }
    for (int L = 0; L < DEPTH; ++L) {
        conv_matrix<1>(F, w_in + (size_t)L * D * INC, D, INC, w_in_t(ws, L));
        for (int b = 0; b < 3; ++b) conv_matrix<0>(F, (b == 0 ? PIN(14) : (b == 1 ? PIN(15) : PIN(16))) + (size_t)L * 1024 * D, 1024, D, w_br_t(ws, L, b));
        conv_matrix<0>(F, PIN(18) + (size_t)L * D * D, D, D, w_out_t(ws, L));
    }
    conv_matrix<2>(F, PIN(23), D, FF, w_gu_t(ws, -1)); conv_matrix<3>(F, PIN(24), D, FF, w_gu_t(ws, -1)); conv_matrix<0>(F, PIN(25), FF, D, w_d_t(ws, -1));
    for (int e = 0; e < NE; ++e) {
        conv_matrix<2>(F, PIN(27) + (size_t)e * D * FF, D, FF, w_gu_t(ws, e)); conv_matrix<3>(F, PIN(28) + (size_t)e * D * FF, D, FF, w_gu_t(ws, e));
        conv_matrix<0>(F, PIN(29) + (size_t)e * FF * D, FF, D, w_d_t(ws, e));
    }
}

__device__ __forceinline__ int row_group(int r) { return r < SEQ ? 0 : (r < NLAT ? 1 : 2); }
__device__ __forceinline__ void load_row(const float* p, int lane, f32x4 (&v)[8]) {
#pragma unroll
    for (int j = 0; j < 8; ++j) v[j] = *(const GAS f32x4*)(p + 4 * lane + 256 * j);
}
__device__ __forceinline__ void store_row(float* p, int lane, const f32x4 (&v)[8]) {
#pragma unroll
    for (int j = 0; j < 8; ++j) *(GAS f32x4*)(p + 4 * lane + 256 * j) = v[j];
}
__device__ __forceinline__ void store_row_bf16(bf16* p, int lane, const f32x4 (&v)[8]) {
#pragma unroll
    for (int j = 0; j < 8; ++j) { v2u w; w.x = pk2(v[j][0], v[j][1]); w.y = pk2(v[j][2], v[j][3]); *(GAS v2u*)(p + 4 * lane + 256 * j) = w; }
}
__device__ __forceinline__ void modulate(f32x4 (&v)[8], const float* shift, const float* scale, int lane) {
#pragma unroll
    for (int j = 0; j < 8; ++j) { const f32x4 sh = *(const f32x4*)(shift + 4 * lane + 256 * j), sc = *(const f32x4*)(scale + 4 * lane + 256 * j); v[j] = v[j] * (sc + 1.0f) + sh; }
}
__device__ __forceinline__ void layer_norm_row(f32x4 (&v)[8], const float* g, const float* b, int lane) {
    float s = 0.f;
#pragma unroll
    for (int j = 0; j < 8; ++j) s += (v[j][0] + v[j][1]) + (v[j][2] + v[j][3]);
    const float mean = wave_sum(s) * (1.0f / D); float q = 0.f;
#pragma unroll
    for (int j = 0; j < 8; ++j) { v[j] = v[j] - mean; q += (v[j][0] * v[j][0] + v[j][1] * v[j][1]) + (v[j][2] * v[j][2] + v[j][3] * v[j][3]); }
    const float rstd = 1.0f / sqrtf(wave_sum(q) * (1.0f / D) + LN_EPS);
#pragma unroll
    for (int j = 0; j < 8; ++j) { const f32x4 g4 = *(const f32x4*)(g + 4 * lane + 256 * j), b4 = *(const f32x4*)(b + 4 * lane + 256 * j); v[j] = v[j] * rstd * g4 + b4; }
}
__device__ __forceinline__ void emit_h_lr(Frame& F, unsigned char* ws, const f32x4 (&h)[8], int r, int L) {
    store_row_bf16(((bf16*)(ws + WS_H)) + (size_t)r * D, F.lane, h);
    const float* wl = ((float*)(ws + WS_WLR)) + (size_t)L * 32 * D + 4 * F.lane; float keep = 0.f;
    for (int o = 0; o < 32; ++o) { float s = 0.f;
#pragma unroll
        for (int j = 0; j < 8; ++j) { const f32x4 w = *(const f32x4*)(wl + (size_t)o * D + 256 * j); s += (h[j][0] * w[0] + h[j][1] * w[1]) + (h[j][2] * w[2] + h[j][3] * w[3]); }
        s = wave_sum(s); if (F.lane == o) keep = s; }
    if (F.lane < 32) ((float*)(ws + WS_LR))[(size_t)r * 32 + F.lane] = keep;
}
__device__ __forceinline__ void p0b_modulate(Frame& F) {
    unsigned char* const ws = PWS(); const float* const xin = PIN(0); const float* const cin = PIN(2);
    const int gw = F.vcu * NWAVES + F.wave, NGW = F.G * NWAVES;
    for (int r = gw; r < MROWS; r += NGW) {
        f32x4 v[8]; load_row(r < NLAT ? xin + (size_t)r * D : cin + (size_t)(r - NLAT) * D, F.lane, v);
        const float* m = ((float*)(ws + WS_MOD)) + (size_t)row_group(r) * 12288;
        modulate(v, m, m + D, F.lane); emit_h_lr(F, ws, v, r, 0);
    }
}

__device__ __forceinline__ void mix_prep(Frame& F, int L) {
    unsigned char* const ws = PWS();
    const int gt = F.bx * NTHR + F.tid, NGT = F.G * NTHR;
    const float* cw = PIN(7) + (size_t)L * 3 * 1024;
    for (int i = gt; i < MROWS * 128; i += NGT) {
        const int r = i >> 7, c8 = (i & 127) * 8;
        const int t = r < NLAT ? (r & (SEQ - 1)) : ((r - NLAT) & (CTXL - 1)), T = r < NLAT ? SEQ : CTXL;
        float acc[8];
#pragma unroll
        for (int j = 0; j < 8; ++j) acc[j] = 0.f;
#pragma unroll
        for (int k = 0; k < 3; ++k) { const int tt = t + k - 1; if (tt < 0 || tt >= T) continue;
            const bf16* up = ((bf16*)(ws + WS_U)) + (size_t)(r + k - 1) * NU; const v4u a = *(const GAS v4u*)(up + U_CC + c8), b = *(const GAS v4u*)(up + U_CX + c8);
            const f32x4 w0 = *(const f32x4*)(cw + k * 1024 + c8), w1 = *(const f32x4*)(cw + k * 1024 + c8 + 4);
            acc[0] += w0[0] * bflo(a.x) * bflo(b.x); acc[1] += w0[1] * bfhi(a.x) * bfhi(b.x); acc[2] += w0[2] * bflo(a.y) * bflo(b.y); acc[3] += w0[3] * bfhi(a.y) * bfhi(b.y);
            acc[4] += w1[0] * bflo(a.z) * bflo(b.z); acc[5] += w1[1] * bfhi(a.z) * bfhi(b.z); acc[6] += w1[2] * bflo(a.w) * bflo(b.w); acc[7] += w1[3] * bfhi(a.w) * bfhi(b.w); }
        const v4u ab = *(const GAS v4u*)(((bf16*)(ws + WS_U)) + (size_t)r * NU + U_CB + c8);
        v4u o; o.x = pk2(acc[0] * bflo(ab.x), acc[1] * bfhi(ab.x)); o.y = pk2(acc[2] * bflo(ab.y), acc[3] * bfhi(ab.y)); o.z = pk2(acc[4] * bflo(ab.z), acc[5] * bfhi(ab.z)); o.w = pk2(acc[6] * bflo(ab.w), acc[7] * bfhi(ab.w));
        *(GAS v4u*)(((bf16*)(ws + WS_Y)) + (size_t)r * 1024 + c8) = o;
    }
    const float* wgf = PIN(8) + (size_t)L * 16 * 512; const float* wgb = PIN(10) + (size_t)L * 16 * 512; const float* bgf = PIN(9) + L * 512; const float* bgb = PIN(11) + L * 512;
    for (int i = gt; i < MROWS * 128; i += NGT) {
        const int r = i >> 7, d4 = (i & 127) * 4, dd = d4 & 127;
        const v2u qw = *(const GAS v2u*)(((bf16*)(ws + WS_U)) + (size_t)r * NU + U_GQ + d4), kw = *(const GAS v2u*)(((bf16*)(ws + WS_U)) + (size_t)r * NU + U_GK + d4);
        const float qs = 0.08838834764831845f;
        float q[4] = {bflo(qw.x) * qs, bfhi(qw.x) * qs, bflo(qw.y) * qs, bfhi(qw.y) * qs}, k[4] = {bflo(kw.x), bfhi(kw.x), bflo(kw.y), bfhi(kw.y)};
        if (r < NLAT) { const int t = r & (SEQ - 1);
#pragma unroll
            for (int p = 0; p < 2; ++p) { const int pi = (dd >> 1) + p; const float pos = pi < 32 ? (float)(t >> 6) : (float)(t & 63); const float inv = exp2f(-(float)(pi & 31) * 0.41524101186092029f);
                const float ang = pos * inv, cs = __cosf(ang), sn = __sinf(ang);
                const float q0 = q[2 * p], q1 = q[2 * p + 1], k0 = k[2 * p], k1 = k[2 * p + 1];
                q[2 * p] = q0 * cs - q1 * sn; q[2 * p + 1] = q0 * sn + q1 * cs; k[2 * p] = k0 * cs - k1 * sn; k[2 * p + 1] = k0 * sn + k1 * cs; } }
        *(GAS f32x4*)(((float*)(ws + WS_GLA)) + (size_t)r * 512 + d4) = (f32x4){q[0], q[1], q[2], q[3]};
        *(GAS f32x4*)(((float*)(ws + WS_GLA + (size_t)MROWS * 512 * 4)) + (size_t)r * 512 + d4) = (f32x4){k[0], k[1], k[2], k[3]};
        f32x4 zf = *(const f32x4*)(bgf + d4), zb = *(const f32x4*)(bgb + d4);
        const float* lrr = ((float*)(ws + WS_LR)) + (size_t)r * 32;
#pragma unroll
        for (int o = 0; o < 16; ++o) { const float lf = lrr[o], lb = lrr[16 + o]; zf += lf * *(const f32x4*)(wgf + o * 512 + d4); zb += lb * *(const f32x4*)(wgb + o * 512 + d4); }
        f32x4 gf, gb;
#pragma unroll
        for (int j = 0; j < 4; ++j) { gf[j] = (fminf(zf[j], 0.f) - __logf(1.0f + __expf(-fabsf(zf[j])))) * (1.0f / 16.0f); gb[j] = (fminf(zb[j], 0.f) - __logf(1.0f + __expf(-fabsf(zb[j])))) * (1.0f / 16.0f); }
        *(GAS f32x4*)(((float*)(ws + WS_GLA + (size_t)MROWS * 1024 * 4)) + (size_t)r * 512 + d4) = gf; *(GAS f32x4*)(((float*)(ws + WS_GLA + (size_t)MROWS * 1536 * 4)) + (size_t)r * 512 + d4) = gb;
    }
}
__device__ __forceinline__ int gla_row(int s, int b, int dir) { if (s < CTXL) return NLAT + CTXL * b + (dir ? CTXL - 1 - s : s); const int s2 = s - CTXL; return SEQ * b + (dir ? SEQ - 1 - s2 : s2); }
__device__ __forceinline__ void gla_naive(Frame& F) {
    unsigned char* const ws = PWS();
    const int hw = F.wave >> 2, chain = F.bx * 2 + hw, b = chain >> 3, dir = (chain >> 2) & 1, head = chain & 3;
    const int tl = F.tid & 255, e = tl;
    LAS float* buf = (LAS float*)(F.lds + RING_OFF) + hw * (16 * 384);
    const float* Gs = dir ? ((float*)(ws + WS_GLA + (size_t)MROWS * 1536 * 4)) : ((float*)(ws + WS_GLA + (size_t)MROWS * 1024 * 4)); float* O = dir ? ((float*)(ws + WS_GLA + (size_t)MROWS * 3072 * 4)) : ((float*)(ws + WS_GLA + (size_t)MROWS * 2048 * 4));
    float S[128];
#pragma unroll
    for (int d = 0; d < 128; ++d) S[d] = 0.f;
    for (int s0 = 0; s0 < CTXL + SEQ; s0 += 16) {
        __syncthreads();
        for (int i = tl; i < 16 * 384; i += 256) { const int st = i / 384, rem = i % 384, which = rem >> 7, d = rem & 127; const int r = gla_row(s0 + st, b, dir); const size_t o = (size_t)r * 512 + head * 128 + d;
            buf[i] = which == 0 ? __expf(Gs[o]) : (which == 1 ? ((float*)(ws + WS_GLA + (size_t)MROWS * 512 * 4))[o] : ((float*)(ws + WS_GLA))[o]); }
        __syncthreads();
        float vn = bf1(((bf16*)(ws + WS_U))[(size_t)gla_row(s0, b, dir) * NU + U_GV + head * 256 + e]);
        for (int st = 0; st < 16; ++st) {
            const float v = vn; const int r = gla_row(s0 + st, b, dir);
            if (st < 15) vn = bf1(((bf16*)(ws + WS_U))[(size_t)gla_row(s0 + st + 1, b, dir) * NU + U_GV + head * 256 + e]);
            const LAS f32x4* A4 = (const LAS f32x4*)(buf + st * 384); float o = 0.f;
#pragma unroll
            for (int d4 = 0; d4 < 32; ++d4) { const f32x4 a = A4[d4], k = A4[32 + d4], q = A4[64 + d4];
#pragma unroll
                for (int j = 0; j < 4; ++j) { S[4 * d4 + j] = a[j] * S[4 * d4 + j] + k[j] * v; o += q[j] * S[4 * d4 + j]; } }
            O[(size_t)r * 1024 + head * 256 + e] = o;
        }
    }
}
__device__ __forceinline__ void na_naive(Frame& F, int L) {
    unsigned char* const ws = PWS();
    const int gwv = (F.bx - 8) * NWAVES + F.wave, nwv = (F.G - 8) * NWAVES;
    LAS float* qs = (LAS float*)(F.lds + RING_OFF + 65536) + F.wave * 512; LAS float* ps = qs + 128;
    const int T_lat = NLAT * 8, T_all = T_lat + (L == 0 ? NCTX * 8 : 0);
    const float* rpb = PIN(13) + (size_t)L * 8 * 15 * 31;
    for (int task = gwv; task < T_all; task += nwv) {
        const bool isctx = task >= T_lat; const int r = isctx ? NLAT + ((task - T_lat) >> 3) : (task >> 3), h = task & 7;
        const int b = isctx ? ((r - NLAT) >> 8) : (r >> 12);
        { const unsigned qw = *(const GAS unsigned*)(((bf16*)(ws + WS_U)) + (size_t)r * NU + U_NQ + h * 128 + 2 * F.lane); qs[2 * F.lane] = bflo(qw) * 0.08838834764831845f; qs[2 * F.lane + 1] = bfhi(qw) * 0.08838834764831845f; }
        LDS_WAIT(); asm volatile("" ::: "memory");
        const int nkeys = isctx ? 256 : 384, t = r & (SEQ - 1), qr = t >> 6, qc = t & 63;
        const int rs = min(max(qr - 4, 0), 56), cs = min(max(qc - 8, 0), 48);
        float sc[6];
#pragma unroll
        for (int m = 0; m < 6; ++m) { const int j = F.lane + 64 * m; sc[m] = -INFINITY;
            if (j < nkeys) { int rk; float bias = 0.f;
                if (!isctx && j < 128) { const int kr = rs + (j >> 4), kc = cs + (j & 15); rk = b * SEQ + kr * 64 + kc; bias = rpb[(h * 15 + (kr - qr + 7)) * 31 + (kc - qc + 15)]; }
                else rk = NLAT + CTXL * b + (isctx ? j : j - 128);
                const GAS v4u* kp = (const GAS v4u*)(((bf16*)(ws + WS_U)) + (size_t)rk * NU + U_NK + h * 128); float dot = 0.f;
#pragma unroll 4
                for (int c = 0; c < 16; ++c) { const v4u kv = kp[c]; const LAS f32x4* q4 = (const LAS f32x4*)(qs + 8 * c); const f32x4 qa = q4[0], qb = q4[1];
                    dot += qa[0] * bflo(kv.x) + qa[1] * bfhi(kv.x) + qa[2] * bflo(kv.y) + qa[3] * bfhi(kv.y) + qb[0] * bflo(kv.z) + qb[1] * bfhi(kv.z) + qb[2] * bflo(kv.w) + qb[3] * bfhi(kv.w); }
                sc[m] = dot + bias; }
            asm volatile("" ::: "memory"); }
        float mx = sc[0];
#pragma unroll
        for (int m = 1; m < 6; ++m) mx = fmaxf(mx, sc[m]);
        mx = wave_max(mx); float sum = 0.f;
#pragma unroll
        for (int m = 0; m < 6; ++m) { sc[m] = (F.lane + 64 * m < nkeys) ? __expf(sc[m] - mx) : 0.f; sum += sc[m]; }
        sum = wave_sum(sum); const float inv = 1.0f / sum;
#pragma unroll
        for (int m = 0; m < 6; ++m) ps[F.lane + 64 * m] = sc[m] * inv;
        LDS_WAIT(); asm volatile("" ::: "memory");
        float a0 = 0.f, a1 = 0.f;
        for (int j = 0; j < nkeys; ++j) { int rk;
            if (!isctx && j < 128) rk = b * SEQ + (rs + (j >> 4)) * 64 + cs + (j & 15); else rk = NLAT + CTXL * b + (isctx ? j : j - 128);
            const unsigned vw = *(const GAS unsigned*)(((bf16*)(ws + WS_U)) + (size_t)rk * NU + U_NV + h * 128 + 2 * F.lane); const float p = ps[j];
            a0 += p * bflo(vw); a1 += p * bfhi(vw); }
        *(GAS unsigned*)(((bf16*)(ws + WS_Y + (size_t)MROWS * 2048 * 2)) + (size_t)r * 1024 + h * 128 + 2 * F.lane) = pk2(a0, a1);
        LDS_WAIT(); asm volatile("" ::: "memory");
    }
}
__device__ __forceinline__ void gla_out(Frame& F, int L) {
    unsigned char* const ws = PWS();
    const int gw = F.vcu * NWAVES + F.wave, NGW = F.G * NWAVES;
    const float* ng = PIN(12) + L * 256 + 4 * F.lane;
    for (int task = gw; task < MROWS * 4; task += NGW) {
        const int r = task >> 2, head = task & 3; const size_t o = (size_t)r * 1024 + head * 256 + 4 * F.lane;
        const f32x4 v = *(const GAS f32x4*)(((float*)(ws + WS_GLA + (size_t)MROWS * 2048 * 4)) + o) + *(const GAS f32x4*)(((float*)(ws + WS_GLA + (size_t)MROWS * 3072 * 4)) + o);
        const float ss = wave_sum((v[0] * v[0] + v[1] * v[1]) + (v[2] * v[2] + v[3] * v[3]));
        const float rs = 1.0f / sqrtf(ss * (1.0f / 256.0f) + LN_EPS);
        const v2u rw = *(const GAS v2u*)(((bf16*)(ws + WS_U)) + (size_t)r * NU + U_GR + head * 256 + 4 * F.lane); const f32x4 g4 = *(const f32x4*)ng;
        const float r0 = bflo(rw.x), r1 = bfhi(rw.x), r2 = bflo(rw.y), r3 = bfhi(rw.y);
        v2u w; w.x = pk2(v[0] * rs * g4[0] * (r0 / (1.0f + __expf(-r0))), v[1] * rs * g4[1] * (r1 / (1.0f + __expf(-r1))));
        w.y = pk2(v[2] * rs * g4[2] * (r2 / (1.0f + __expf(-r2))), v[3] * rs * g4[3] * (r3 / (1.0f + __expf(-r3))));
        *(GAS v2u*)(((bf16*)(ws + WS_Y + (size_t)MROWS * 1024 * 2)) + o) = w;
    }
}

__device__ __forceinline__ void ln1_phase(Frame& F, int L, int M) {
    unsigned char* const ws = PWS(); const float* const lng = PIN(19) + L * D; const float* const lnb = PIN(20) + L * D; const float* const router = PIN(26);
    const int gw = F.vcu * NWAVES + F.wave, NGW = F.G * NWAVES;
    for (int r = gw; r < M; r += NGW) {
        f32x4 v[8]; load_row(((float*)(ws + WS_PRE)) + (size_t)r * D, F.lane, v);
        layer_norm_row(v, lng, lnb, F.lane);
        store_row(((float*)(ws + WS_XL)) + (size_t)r * D, F.lane, v);
        const float* m = ((float*)(ws + WS_MOD)) + ((size_t)L * 3 + row_group(r)) * 12288;
        modulate(v, m + 3 * D, m + 4 * D, F.lane);
        store_row_bf16(((bf16*)(ws + WS_H)) + (size_t)r * D, F.lane, v);
        if (L == 1) {
            float lg[8];
#pragma unroll
            for (int e = 0; e < 8; ++e) lg[e] = 0.f;
#pragma unroll
            for (int j = 0; j < 8; ++j)
#pragma unroll
                for (int i = 0; i < 4; ++i) { const float* rp = router + (size_t)(4 * F.lane + 256 * j + i) * 8; const f32x4 w0 = *(const f32x4*)rp, w1 = *(const f32x4*)(rp + 4); const float hv = v[j][i];
                    lg[0] += hv * w0[0]; lg[1] += hv * w0[1]; lg[2] += hv * w0[2]; lg[3] += hv * w0[3]; lg[4] += hv * w1[0]; lg[5] += hv * w1[1]; lg[6] += hv * w1[2]; lg[7] += hv * w1[3]; }
#pragma unroll
            for (int e = 0; e < 8; ++e) lg[e] = wave_sum(lg[e]);
            int e0 = 0; float v0 = lg[0];
#pragma unroll
            for (int e = 1; e < 8; ++e) if (lg[e] > v0) { v0 = lg[e]; e0 = e; }
            int e1 = -1; float v1 = -INFINITY;
#pragma unroll
            for (int e = 0; e < 8; ++e) if (e != e0 && lg[e] > v1) { v1 = lg[e]; e1 = e; }
            if (F.lane == 0) {
                const float w0 = 1.0f / (1.0f + __expf(v1 - v0)), w1 = 1.0f - w0;
                const unsigned p0 = __hip_atomic_fetch_add(((gu32*)(ws + WS_CTL)) + CW_MOECNT + 64 * e0, 1u, RLX_AGENT), p1 = __hip_atomic_fetch_add(((gu32*)(ws + WS_CTL)) + CW_MOECNT + 64 * e1, 1u, RLX_AGENT);
                ((int*)(ws + WS_TOK))[e0 * NLAT + p0] = r; ((int*)(ws + WS_TOK))[e1 * NLAT + p1] = r;
                unsigned* rt = ((unsigned*)(ws + WS_ROUTE)) + (size_t)r * 8; rt[0] = e0; rt[1] = p0; rt[2] = __float_as_uint(w0); rt[3] = e1; rt[4] = p1; rt[5] = __float_as_uint(w1);
            }
        }
    }
}
__device__ __forceinline__ void moe_prefix(unsigned char* ws, unsigned (&cnt)[8], int (&pp)[9]) {
    pp[0] = 0;
#pragma unroll
    for (int e = 0; e < 8; ++e) { cnt[e] = __hip_atomic_load(((gu32*)(ws + WS_CTL)) + CW_MOECNT + 64 * e, RLX_AGENT); pp[e + 1] = pp[e] + (int)((cnt[e] + 255u) >> 8); }
}
__device__ __forceinline__ void moe_gather(Frame& F) {
    unsigned char* const ws = PWS();
    const int gw = F.vcu * NWAVES + F.wave, NGW = F.G * NWAVES;
    unsigned cnt[8]; int pp[9]; moe_prefix(ws, cnt, pp);
    for (int s = gw; s < pp[8] * 256; s += NGW) {
        const int p = s >> 8; int e = 0, base = 0; unsigned ce = cnt[0];
#pragma unroll
        for (int k = 1; k < 8; ++k) if (p >= pp[k]) { e = k; base = pp[k]; ce = cnt[k]; }
        const unsigned pos = (unsigned)(s - base * 256);
        GAS v4u* dst = (GAS v4u*)(((bf16*)(ws + WS_GLA)) + (size_t)s * D) + F.lane;
        if (pos < ce) { const int tkn = ((int*)(ws + WS_TOK))[e * NLAT + pos]; const GAS v4u* src = (const GAS v4u*)(((bf16*)(ws + WS_H)) + (size_t)tkn * D) + F.lane;
#pragma unroll
            for (int j = 0; j < 4; ++j) dst[64 * j] = src[64 * j]; }
        else {
#pragma unroll
            for (int j = 0; j < 4; ++j) dst[64 * j] = (v4u){0u, 0u, 0u, 0u}; }
    }
}
__device__ __forceinline__ void ln2_dense(Frame& F, int L) {
    unsigned char* const ws = PWS(); const float* const lng = PIN(21) + L * D; const float* const lnb = PIN(22) + L * D;
    const int gw = F.vcu * NWAVES + F.wave, NGW = F.G * NWAVES;
    for (int r = gw; r < MROWS; r += NGW) {
        f32x4 v[8]; load_row(((float*)(ws + WS_PRE)) + (size_t)r * D, F.lane, v);
        layer_norm_row(v, lng, lnb, F.lane);
        store_row(((float*)(ws + WS_XL)) + (size_t)r * D, F.lane, v);
        const float* m = ((float*)(ws + WS_MOD)) + ((size_t)(L + 1) * 3 + row_group(r)) * 12288;
        modulate(v, m, m + D, F.lane); emit_h_lr(F, ws, v, r, L + 1);
    }
}
__device__ __forceinline__ void ln2_moe(Frame& F, int L) {
    unsigned char* const ws = PWS(); const float* const lng = PIN(21) + L * D; const float* const lnb = PIN(22) + L * D; float* const outp = POUT();
    const int gw = F.vcu * NWAVES + F.wave, NGW = F.G * NWAVES;
    unsigned cnt[8]; int pp[9]; moe_prefix(ws, cnt, pp);
    for (int r = gw; r < NLAT; r += NGW) {
        const unsigned* rt = ((unsigned*)(ws + WS_ROUTE)) + (size_t)r * 8; const int e0 = rt[0], e1 = rt[3]; const float w0 = __uint_as_float(rt[2]), w1 = __uint_as_float(rt[5]);
        int b0 = 0, b1 = 0;
#pragma unroll
        for (int k = 1; k < 8; ++k) { if (e0 >= k) b0 = pp[k]; if (e1 >= k) b1 = pp[k]; }
        const size_t s0 = (size_t)b0 * 256 + rt[1], s1 = (size_t)b1 * 256 + rt[4];
        f32x4 v[8], y0[8], y1[8]; load_row(((float*)(ws + WS_XL)) + (size_t)r * D, F.lane, v); load_row(((float*)(ws + WS_Z)) + s0 * D, F.lane, y0); load_row(((float*)(ws + WS_Z)) + s1 * D, F.lane, y1);
        const float* g2 = ((float*)(ws + WS_MOD)) + ((size_t)L * 3 + row_group(r)) * 12288 + 5 * D;
#pragma unroll
        for (int j = 0; j < 8; ++j) { const f32x4 g4 = *(const f32x4*)(g2 + 4 * F.lane + 256 * j); v[j] = v[j] * ALPHA + g4 * (y0[j] * w0 + y1[j] * w1); }
        layer_norm_row(v, lng, lnb, F.lane);
        store_row(outp + (size_t)r * D, F.lane, v);
    }
}
#ifndef MK_ONE_LAUNCH
#define MK_ONE_LAUNCH 0
#endif
constexpr int PH_PER_LAYER = 11, NPH = 2 + DEPTH * PH_PER_LAYER;
enum { PL_WIN = 0, PL_MIXA, PL_MIXB, PL_MIXC, PL_BR, PL_WOUT, PL_LN1, PL_GATHER, PL_FFN1, PL_FFN2, PL_LN2 };
__device__ __forceinline__ bool in_range(int lo, int hi, int k) { asm volatile("" : "+s"(lo), "+s"(hi)); return lo <= k && k < hi; }
__global__ void __launch_bounds__(NTHR, 2) fwd_kernel(Args A) {
    __shared__ __attribute__((aligned(16))) unsigned char lds[LDS_BYTES];
    LAS unsigned char* const ldsb = (LAS unsigned char*)lds;
    { Frame F = mkframe(ldsb, A.grid);
    for (int u = F.tid; u < (LDS_BYTES - LDSCTL_OFF) / 4; u += NTHR) ((LAS unsigned*)(F.lds + LDSCTL_OFF))[u] = 0u;
    __syncthreads();
    if (F.tid < 32) { const unsigned long long p = F.tid < 30 ? (unsigned long long)A.in[F.tid] : (F.tid == 30 ? (unsigned long long)A.out : (unsigned long long)A.ws);
        ((LAS unsigned long long*)(F.lds + PTAB_OFF))[F.tid] = p; }
    __syncthreads(); }
#if MK_ONE_LAUNCH
    XcdBarrier bar; { Frame F = mkframe(ldsb, A.grid); bar = xcd_barrier_post((unsigned*)(PWS() + WS_CTL) + CW_BAR, F.MISC + 8, (unsigned)A.grid); }
#define GRID_BAR() xcd_barrier(bar)
#else
#define GRID_BAR() do { if (F.tid == 0) __hip_atomic_store((gu32*)(PWS() + WS_CTL) + CW_TMO, 0xBADBA0u, RLX_AGENT); } while (0)
#endif
    const int lo = A.ph_lo, hi = A.ph_hi;
#ifndef PHMASK
#define PHMASK 0xFFFFFFFFu
#endif
#define IN(k) in_range(lo, hi, (k))
#define EN(bit) ((PHMASK >> (bit)) & 1u)
#define SEAM(k) do { if (IN((k) + 1)) GRID_BAR(); } while (0)
    LAS unsigned char* const ring = ldsb + RING_OFF;

    if (EN(0) && IN(0)) { Frame F = mkframe(ldsb, A.grid); p0a_prologue(F); SEAM(0); }
    if (EN(1) && IN(1)) { Frame F = mkframe(ldsb, A.grid); p0b_modulate(F); SEAM(1); }
    for (int L = 0; L < DEPTH; ++L) {
        const int pb = 2 + PH_PER_LAYER * L, Mr = (L == 0) ? MROWS : NLAT;
        if (EN(2) && IN(pb + PL_WIN)) { Frame F = mkframe(ldsb, A.grid);
            unsigned char* const ws = PWS();
            pg8::Gemm g{((bf16*)(ws + WS_H)), w_in_t(ws, L), MROWS, NU, D}; pg8::StaticOrder S; S.init(MROWS, NU, F.G, F.bx);
            pg8::EpiBf16Plain E{((bf16*)(ws + WS_U)), NU};
            pg8::gemm_phase<pg8::EpiBf16Plain, pg8::StaticOrder, true, true>(ring, g, S, E);
            SEAM(pb + PL_WIN);
        }
        if (EN(3) && IN(pb + PL_MIXA)) { Frame F = mkframe(ldsb, A.grid); mix_prep(F, L); SEAM(pb + PL_MIXA); }
        if (EN(4) && IN(pb + PL_MIXB)) { Frame F = mkframe(ldsb, A.grid); if (F.bx < 8) gla_naive(F); else na_naive(F, L); SEAM(pb + PL_MIXB); }
        if (EN(5) && IN(pb + PL_MIXC)) { Frame F = mkframe(ldsb, A.grid); gla_out(F, L); SEAM(pb + PL_MIXC); }
        if (EN(6) && IN(pb + PL_BR)) { Frame F = mkframe(ldsb, A.grid);
            unsigned char* const ws = PWS(); const float* const gate_b = PIN(17) + (size_t)L * 3 * D;
            for (int b = 0; b < 3; ++b) {
                pg8::Gemm g{b == 0 ? ((bf16*)(ws + WS_Y)) : (b == 1 ? ((bf16*)(ws + WS_Y + (size_t)MROWS * 1024 * 2)) : ((bf16*)(ws + WS_Y + (size_t)MROWS * 2048 * 2))), w_br_t(ws, L, b), Mr, D, 1024}; pg8::StaticOrder S; S.init(Mr, D, F.G, F.bx);
                pg8::EpiGate E{((bf16*)(ws + WS_U)) + U_GATE + b * D, NU, gate_b + b * D, ((float*)(ws + WS_Z)), ((bf16*)(ws + WS_ZB)), b == 0, b == 2};
                pg8::gemm_phase<pg8::EpiGate, pg8::StaticOrder, true, true>(ring, g, S, E);
            }
            SEAM(pb + PL_BR);
        }
        if (EN(7) && IN(pb + PL_WOUT)) { Frame F = mkframe(ldsb, A.grid);
            unsigned char* const ws = PWS(); const float* const modL = ((float*)(ws + WS_MOD)) + (size_t)L * 3 * 12288; const float* const xin = PIN(0); const float* const cin = PIN(2);
            pg8::Gemm g{((bf16*)(ws + WS_ZB)), w_out_t(ws, L), Mr, D, D}; pg8::StaticOrder S; S.init(Mr, D, F.G, F.bx);
            pg8::EpiRes E{L == 0 ? xin : ((float*)(ws + WS_XL)), L == 0 ? cin : ((float*)(ws + WS_XL)) + (size_t)NLAT * D, modL + 2 * D, 12288, ((float*)(ws + WS_PRE)), ALPHA};
            pg8::gemm_phase<pg8::EpiRes, pg8::StaticOrder, true, true>(ring, g, S, E);
            SEAM(pb + PL_WOUT);
        }
        if (EN(8) && IN(pb + PL_LN1)) { Frame F = mkframe(ldsb, A.grid); ln1_phase(F, L, Mr); SEAM(pb + PL_LN1); }
        if (L == 0) {
            if (EN(10) && IN(pb + PL_FFN1)) { Frame F = mkframe(ldsb, A.grid);
                unsigned char* const ws = PWS();
                pg8::Gemm g{((bf16*)(ws + WS_H)), w_gu_t(ws, -1), MROWS, NGU, D}; pg8::StaticOrder S; S.init(MROWS, NGU, F.G, F.bx);
                pg8::EpiSwiGLU E{((bf16*)(ws + WS_U)), FF};
                pg8::gemm_phase<pg8::EpiSwiGLU, pg8::StaticOrder, true, true>(ring, g, S, E);
                SEAM(pb + PL_FFN1);
            }
            if (EN(11) && IN(pb + PL_FFN2)) { Frame F = mkframe(ldsb, A.grid);
                unsigned char* const ws = PWS(); const float* const modL = ((float*)(ws + WS_MOD)) + (size_t)L * 3 * 12288;
                pg8::Gemm g{((bf16*)(ws + WS_U)), w_d_t(ws, -1), MROWS, D, FF}; pg8::StaticOrder S; S.init(MROWS, D, F.G, F.bx);
                pg8::EpiRes E{((float*)(ws + WS_XL)), ((float*)(ws + WS_XL)) + (size_t)NLAT * D, modL + 5 * D, 12288, ((float*)(ws + WS_PRE)), ALPHA};
                pg8::gemm_phase<pg8::EpiRes, pg8::StaticOrder, true, true>(ring, g, S, E);
                SEAM(pb + PL_FFN2);
            }
            if (EN(12) && IN(pb + PL_LN2)) { Frame F = mkframe(ldsb, A.grid); ln2_dense(F, L); SEAM(pb + PL_LN2); }
        } else {
            if (EN(9) && IN(pb + PL_GATHER)) { Frame F = mkframe(ldsb, A.grid); moe_gather(F); SEAM(pb + PL_GATHER); }
            if (EN(10) && IN(pb + PL_FFN1)) { Frame F = mkframe(ldsb, A.grid);
                unsigned char* const ws = PWS();
                unsigned cnt[8]; int pp[9]; moe_prefix(ws, cnt, pp);
                pg8::Gemm g{((bf16*)(ws + WS_GLA)), w_gu_t(ws, 0), 0, NGU, D}; pg8::MoeOrder S; S.init(cnt, NGU / 256, F.G, F.bx);
                pg8::EpiSwiGLU E{((bf16*)(ws + WS_U)), FF};
                pg8::gemm_phase<pg8::EpiSwiGLU, pg8::MoeOrder, true, true>(ring, g, S, E);
                SEAM(pb + PL_FFN1);
            }
            if (EN(11) && IN(pb + PL_FFN2)) { Frame F = mkframe(ldsb, A.grid);
                unsigned char* const ws = PWS(); const float* const modL = ((float*)(ws + WS_MOD)) + (size_t)L * 3 * 12288;
                unsigned cnt[8]; int pp[9]; moe_prefix(ws, cnt, pp);
                pg8::Gemm g{((bf16*)(ws + WS_U)), w_d_t(ws, 0), 0, D, FF}; pg8::MoeOrder S; S.init(cnt, D / 256, F.G, F.bx);
                pg8::EpiF32Plain E{((float*)(ws + WS_Z)), D};
                pg8::gemm_phase<pg8::EpiF32Plain, pg8::MoeOrder, true, true>(ring, g, S, E);
                SEAM(pb + PL_FFN2);
            }
            if (EN(12) && IN(pb + PL_LN2)) { Frame F = mkframe(ldsb, A.grid); ln2_moe(F, L); }
        }
    }
#undef IN
#undef SEAM
}

extern "C" void kernel_launch(void* const* d_in, const int* in_sizes, int n_in, void* d_out, int out_size, void* d_ws, size_t ws_size, hipStream_t stream) {
    static int grid = 0;
    if (grid == 0) {
        if (n_in != 30 || out_size != NLAT * D || ws_size < WS_END) { fprintf(stderr, "kernel_launch: unexpected shapes (n_in %d out %d ws %zu); nothing launched\n", n_in, out_size, ws_size); grid = -1; return; }
        int dev = 0, cus = 0, per_cu = 0;
        if (hipGetDevice(&dev) != hipSuccess || hipDeviceGetAttribute(&cus, hipDeviceAttributeMultiprocessorCount, dev) != hipSuccess) { grid = -1; return; }
        if (hipOccupancyMaxActiveBlocksPerMultiprocessor(&per_cu, (const void*)fwd_kernel, NTHR, 0) != hipSuccess || per_cu < 1) { fprintf(stderr, "kernel_launch: occupancy query says %d\n", per_cu); (void)hipGetLastError(); grid = -1; return; }
        grid = cus;
    }
    if (grid < 0) return;
    (void)hipMemsetAsync((char*)d_ws + WS_CTL, 0, CTL_ZERO_BYTES, stream);
    Args a{};
    for (int i = 0; i < 30; ++i) a.in[i] = (const float*)d_in[i];
    a.out = (float*)d_out; a.ws = (unsigned char*)d_ws; a.grid = grid;
#if MK_ONE_LAUNCH
    a.ph_lo = 0; a.ph_hi = NPH;
    hipLaunchKernelGGL(fwd_kernel, dim3(grid), dim3(NTHR), 0, stream, a);
#else
#ifndef NPH_RUN
#define NPH_RUN NPH
#endif
    for (int p = 0; p < NPH_RUN; ++p) {
        if (p == 2 + PL_GATHER) continue;
        a.ph_lo = p; a.ph_hi = p + 1;
        hipLaunchKernelGGL(fwd_kernel, dim3(grid), dim3(NTHR), 0, stream, a);
    }
#endif
}
```

```cpp
#define MK_ONE_LAUNCH 1
#include <hip/hip_runtime.h>
#include <cstdio>

namespace pg8 {
#define PG8_LAS __attribute__((address_space(3)))
typedef unsigned short bf16_t;
typedef short bf16x8 __attribute__((ext_vector_type(8)));
typedef float f32x4 __attribute__((ext_vector_type(4)));
typedef unsigned u32x4 __attribute__((ext_vector_type(4)));
typedef unsigned u32x2 __attribute__((ext_vector_type(2)));
constexpr int BM = 256, BK = 64, HALF = 128, HTB = HALF * BK * 2  , STAGE_BYTES = 8 * HTB, NXCD = 8, WGM = 8;

__host__ __device__ __forceinline__ int lds_byte(int r, int c) { const int st = (r >> 4) * 2 + (c >> 5), rr = r & 15, cc = c & 31, ob = rr * 64 + cc * 2; return st * 1024 + (ob ^ (((ob >> 9) & 1) << 5)); }
__host__ __device__ __forceinline__ void stage_rc(int b, int& R, int& C) { const int st = b / 1024, sb = b % 1024, swz = sb ^ (((sb >> 9) & 1) << 5); R = (st >> 1) * 16 + swz / 64; C = (st & 1) * 32 + (swz % 64) / 2; }
__host__ __device__ __forceinline__ int perm32(int rho) { const int n = rho >> 4, i = rho & 15; return 8 * (i >> 2) + 4 * n + (i & 3); }

struct Unit { int pm, pn, pb; };
struct Gemm { const bf16_t* A; const bf16_t* Bt; int M, N, K; };

__device__ __forceinline__ int xcd_remap(int wgid, int nwg) { const int q = nwg / NXCD, r = nwg % NXCD, xcd = wgid % NXCD, off = wgid / NXCD; return (xcd < r ? xcd * (q + 1) : r * (q + 1) + (xcd - r) * q) + off; }
struct StaticOrder {
    int nM, nN, nwg, G, c;
    __host__ __device__ void init(int M, int N, int G_, int c_) { nM = M / BM; nN = N / BM; nwg = nM * nN; G = G_; c = c_; }
    __device__ __forceinline__ bool next(int i, Unit& u) const {
        const long L = (long)i * G + c; if (L >= nwg) return false;
        const int wgid = xcd_remap((int)L, nwg);
        const int nig = WGM * nN, gid = wgid / nig, fm = gid * WGM, gsz = (nM - fm) < WGM ? (nM - fm) : WGM;
        u.pm = fm + ((wgid % nig) % gsz); u.pn = (wgid % nig) / gsz; u.pb = u.pn; return true;
    }
    __device__ __forceinline__ void a_ready(const Unit&) const {}
    __device__ __forceinline__ void done(const Unit&) const {}
};
struct MoeOrder {
    int nN, G, c, nunits; int pp[9];
    __device__ __forceinline__ void init(const unsigned* cnt, int nN_, int G_, int c_) { nN = nN_; G = G_; c = c_; pp[0] = 0;
#pragma unroll
        for (int e = 0; e < 8; ++e) pp[e + 1] = pp[e] + (int)((cnt[e] + 255u) >> 8);
        nunits = pp[8] * nN; }
    __device__ __forceinline__ bool next(int i, Unit& u) const {
        const long L = (long)i * G + c; if (L >= nunits) return false;
        const int wgid = xcd_remap((int)L, nunits);
        int e = 0, base = 0, npe = pp[1];
#pragma unroll
        for (int k = 1; k < 8; ++k) { if (wgid >= pp[k] * nN) { e = k; base = pp[k]; npe = pp[k + 1] - pp[k]; } }
        if (npe < 1) npe = 1;
        const int local = wgid - base * nN;
        u.pm = base + local % npe; u.pn = local / npe; u.pb = e * nN + u.pn; return true;
    }
    __device__ __forceinline__ void a_ready(const Unit&) const {}
    __device__ __forceinline__ void done(const Unit&) const {}
};

__device__ __forceinline__ unsigned cvt_pk_bf16(float lo, float hi) { unsigned r; asm volatile("v_cvt_pk_bf16_f32 %0, %1, %2" : "=v"(r) : "v"(lo), "v"(hi)); return r; }
__device__ __forceinline__ float bf_lo(unsigned w) { return __uint_as_float(w << 16); }
__device__ __forceinline__ float bf_hi(unsigned w) { return __uint_as_float(w & 0xffff0000u); }
__device__ __forceinline__ float fast_sigmoid(float x) { return __builtin_amdgcn_rcpf(1.0f + __expf(-x)); }

struct EpiBf16Plain {
    static constexpr bool PERM = true, AFTER_DRAIN = false;
    bf16_t* O; int ldc;
    __device__ __forceinline__ void operator()(const f32x4 (&acc)[2][2][4][2], const Unit& u, int wr, int wc, int fr, int fq) const {
        const int row0 = u.pm * BM + wr * 64 + fr, col0 = u.pn * BM + wc * 32 + 8 * fq;
#pragma unroll
        for (int ai = 0; ai < 2; ++ai)
#pragma unroll
            for (int m = 0; m < 4; ++m) { bf16_t* rowp = O + (size_t)(row0 + ai * HALF + m * 16) * ldc + col0;
#pragma unroll
                for (int bj = 0; bj < 2; ++bj) { const f32x4 v0 = acc[ai][bj][m][0], v1 = acc[ai][bj][m][1];
                    u32x4 w; w.x = cvt_pk_bf16(v0[0], v0[1]); w.y = cvt_pk_bf16(v0[2], v0[3]); w.z = cvt_pk_bf16(v1[0], v1[1]); w.w = cvt_pk_bf16(v1[2], v1[3]);
                    *(u32x4*)(rowp + bj * HALF) = w; } }
    }
};
struct EpiF32Plain {
    static constexpr bool PERM = false, AFTER_DRAIN = false;
    float* C; int ldc;
    __device__ __forceinline__ void operator()(const f32x4 (&acc)[2][2][4][2], const Unit& u, int wr, int wc, int fr, int fq) const {
        const int row0 = u.pm * BM + wr * 64 + fr, col0 = u.pn * BM + wc * 32 + 4 * fq;
#pragma unroll
        for (int ai = 0; ai < 2; ++ai)
#pragma unroll
            for (int m = 0; m < 4; ++m) { float* rowp = C + (size_t)(row0 + ai * HALF + m * 16) * ldc + col0;
#pragma unroll
                for (int bj = 0; bj < 2; ++bj)
#pragma unroll
                    for (int n = 0; n < 2; ++n) *(f32x4*)(rowp + bj * HALF + n * 16) = acc[ai][bj][m][n]; }
    }
};
struct EpiGate {
    static constexpr bool PERM = false, AFTER_DRAIN = false;
    const bf16_t* Ug; int ldu;
    const float* gb;
    float* Z; bf16_t* ZB; int first, last;
    __device__ __forceinline__ void operator()(const f32x4 (&acc)[2][2][4][2], const Unit& u, int wr, int wc, int fr, int fq) const {
        const int row0 = u.pm * BM + wr * 64 + fr, col0 = u.pn * BM + wc * 32 + 4 * fq;
#pragma unroll
        for (int ai = 0; ai < 2; ++ai)
#pragma unroll
            for (int m = 0; m < 4; ++m) { const size_t row = (size_t)(row0 + ai * HALF + m * 16);
#pragma unroll
                for (int bj = 0; bj < 2; ++bj)
#pragma unroll
                    for (int n = 0; n < 2; ++n) { const int col = col0 + bj * HALF + n * 16;
                        const u32x2 gl = *(const u32x2*)(Ug + row * ldu + col); const f32x4 b4 = *(const f32x4*)(gb + col);
                        f32x4 v = acc[ai][bj][m][n];
                        v[0] *= fast_sigmoid(bf_lo(gl.x) + b4[0]); v[1] *= fast_sigmoid(bf_hi(gl.x) + b4[1]); v[2] *= fast_sigmoid(bf_lo(gl.y) + b4[2]); v[3] *= fast_sigmoid(bf_hi(gl.y) + b4[3]);
                        if (!first) v += *(const f32x4*)(Z + row * 2048 + col);
                        if (!last) *(f32x4*)(Z + row * 2048 + col) = v;
                        else { u32x2 w; w.x = cvt_pk_bf16(v[0], v[1]); w.y = cvt_pk_bf16(v[2], v[3]); *(u32x2*)(ZB + row * 2048 + col) = w; } } }
    }
};
struct EpiRes {
    static constexpr bool PERM = false, AFTER_DRAIN = false;
    const float* res_lat; const float* res_ctx; const float* gv; int gstride; float* out; float alpha;
    __device__ __forceinline__ void operator()(const f32x4 (&acc)[2][2][4][2], const Unit& u, int wr, int wc, int fr, int fq) const {
        const int grp = u.pm < 16 ? 0 : (u.pm < 32 ? 1 : 2);
        const float* res = u.pm < 32 ? res_lat + (size_t)u.pm * BM * 2048 : res_ctx + (size_t)(u.pm - 32) * BM * 2048;
        const float* g = gv + (size_t)grp * gstride;
        const int rl0 = wr * 64 + fr, col0 = u.pn * BM + wc * 32 + 4 * fq;
#pragma unroll
        for (int ai = 0; ai < 2; ++ai)
#pragma unroll
            for (int m = 0; m < 4; ++m) { const int rl = rl0 + ai * HALF + m * 16;
#pragma unroll
                for (int bj = 0; bj < 2; ++bj)
#pragma unroll
                    for (int n = 0; n < 2; ++n) { const int col = col0 + bj * HALF + n * 16;
                        const f32x4 r4 = *(const f32x4*)(res + (size_t)rl * 2048 + col); const f32x4 g4 = *(const f32x4*)(g + col);
                        *(f32x4*)(out + ((size_t)u.pm * BM + rl) * 2048 + col) = r4 * alpha + g4 * acc[ai][bj][m][n]; } }
    }
};
struct EpiSwiGLU {
    static constexpr bool PERM = true, AFTER_DRAIN = false;
    bf16_t* O; int ldc;
    __device__ __forceinline__ void operator()(const f32x4 (&acc)[2][2][4][2], const Unit& u, int wr, int wc, int fr, int fq) const {
        const int row0 = u.pm * BM + wr * 64 + fr, col0 = u.pn * HALF + wc * 32 + 8 * fq;
#pragma unroll
        for (int ai = 0; ai < 2; ++ai)
#pragma unroll
            for (int m = 0; m < 4; ++m) { bf16_t* rowp = O + (size_t)(row0 + ai * HALF + m * 16) * ldc + col0;
                float h[8];
#pragma unroll
                for (int n = 0; n < 2; ++n)
#pragma unroll
                    for (int j = 0; j < 4; ++j) { const float gt = acc[ai][0][m][n][j], up = acc[ai][1][m][n][j]; h[n * 4 + j] = gt * fast_sigmoid(gt) * up; }
                u32x4 w; w.x = cvt_pk_bf16(h[0], h[1]); w.y = cvt_pk_bf16(h[2], h[3]); w.z = cvt_pk_bf16(h[4], h[5]); w.w = cvt_pk_bf16(h[6], h[7]);
                *(u32x4*)rowp = w; }
    }
};

template <class Epi, class Sched, bool ALIGN_EPI = false, bool SP2 = false>
__device__ __forceinline__ void gemm_phase(PG8_LAS unsigned char* lds, const Gemm g, const Sched& S, const Epi& E) {
    int tid_ = threadIdx.x; asm volatile("" : "+v"(tid_));
    const int tid = tid_, wid = __builtin_amdgcn_readfirstlane(tid >> 6), lane = tid & 63, wr = wid >> 2, wc = wid & 3, fr = lane & 15, fq = lane >> 4;
    const int K = g.K, nt = K / BK;
    unsigned voffA[2], voffB[2];
#pragma unroll
    for (int i = 0; i < 2; ++i) { int R, C; stage_rc(tid * 16 + i * 8192, R, C); const int Rb = Epi::PERM ? ((R & ~31) + perm32(R & 31)) : R;
        voffA[i] = (unsigned)(R * K + C) * 2u; voffB[i] = (unsigned)(Rb * K + C) * 2u; }
    const size_t kstep = (size_t)(BK * 2);
    const size_t hstep = (size_t)HALF * K * 2;
    const size_t tstep = 2 * hstep;
    const unsigned ldsw = (unsigned)wid * 1024u;
    const int aoff = lds_byte(wr * 64 + fr, fq * 8), boff = lds_byte(wc * 32 + fr, fq * 8);
#define PG8_SA(b, h) (((b) * 2 + (h)) * HTB)
#define PG8_SB(b, h) ((4 + (b) * 2 + (h)) * HTB)
#define PG8_STAGE(bufoff, gbase, voff) do { _Pragma("unroll") for (int _i = 0; _i < 2; ++_i) \
        __builtin_amdgcn_global_load_lds((const unsigned*)((const char*)(gbase) + (voff)[_i]), (PG8_LAS unsigned*)(lds + (bufoff) + ldsw + _i * 8192), 16, 0, 0); } while (0)
#define PG8_LDA(dst, b, h) do { _Pragma("unroll") for (int m = 0; m < 4; ++m) _Pragma("unroll") for (int k = 0; k < 2; ++k) dst[m][k] = *(const PG8_LAS bf16x8*)(lds + PG8_SA(b, h) + aoff + m * 2048 + k * 1024); } while (0)
#define PG8_LDB(dst, b, h) do { _Pragma("unroll") for (int n = 0; n < 2; ++n) _Pragma("unroll") for (int k = 0; k < 2; ++k) dst[n][k] = *(const PG8_LAS bf16x8*)(lds + PG8_SB(b, h) + boff + n * 2048 + k * 1024); } while (0)
#define PG8_MMA(ai, bj, At, Bt) do { __builtin_amdgcn_s_setprio(1); _Pragma("unroll") for (int m = 0; m < 4; ++m) _Pragma("unroll") for (int n = 0; n < 2; ++n) _Pragma("unroll") for (int k = 0; k < 2; ++k) \
        acc[ai][bj][m][n] = __builtin_amdgcn_mfma_f32_16x16x32_bf16(Bt[n][k], At[m][k], acc[ai][bj][m][n], 0, 0, 0); __builtin_amdgcn_s_setprio(0); } while (0)
#define PG8_WAIT_V(n) asm volatile("s_waitcnt vmcnt(" #n ")" ::: "memory")
#define PG8_WAIT_L(n) asm volatile("s_waitcnt lgkmcnt(" #n ")" ::: "memory")
#define PG8_BAR __builtin_amdgcn_s_barrier()
#define PG8_SCHED __builtin_amdgcn_sched_barrier(0)
    Unit cur, nxt; int ui = 0;
    if (!S.next(0, cur)) return;
    f32x4 acc[2][2][4][2];
#pragma unroll
    for (int a = 0; a < 2; ++a)
#pragma unroll
        for (int b = 0; b < 2; ++b)
#pragma unroll
            for (int m = 0; m < 4; ++m)
#pragma unroll
                for (int n = 0; n < 2; ++n) acc[a][b][m][n] = (f32x4){0.f, 0.f, 0.f, 0.f};
    bf16x8 At[4][2], B0[2][2], B1[2][2];
    const char* cA = (const char*)g.A + (size_t)cur.pm * tstep; const char* cB = (const char*)g.Bt + (size_t)cur.pb * tstep;
    S.a_ready(cur);
    if constexpr (SP2) {
        PG8_STAGE(PG8_SB(0, 0), cB, voffB); PG8_STAGE(PG8_SB(0, 1), cB + hstep, voffB); PG8_STAGE(PG8_SA(0, 0), cA, voffA); PG8_STAGE(PG8_SA(0, 1), cA + hstep, voffA);
        if (wr == 1) PG8_BAR;
        PG8_WAIT_V(2); PG8_BAR;
        PG8_STAGE(PG8_SB(1, 0), cB + kstep, voffB); PG8_STAGE(PG8_SA(1, 0), cA + kstep, voffA); PG8_STAGE(PG8_SB(1, 1), cB + hstep + kstep, voffB);
        PG8_WAIT_V(6); PG8_BAR;
    } else {
        PG8_STAGE(PG8_SB(0, 0), cB, voffB); PG8_STAGE(PG8_SA(0, 0), cA, voffA); PG8_STAGE(PG8_SB(0, 1), cB + hstep, voffB); PG8_STAGE(PG8_SA(0, 1), cA + hstep, voffA);
        if (wr == 1) PG8_BAR;
        PG8_WAIT_V(4); PG8_BAR;
        PG8_STAGE(PG8_SB(1, 0), cB + kstep, voffB); PG8_STAGE(PG8_SA(1, 0), cA + kstep, voffA); PG8_STAGE(PG8_SB(1, 1), cB + hstep + kstep, voffB);
        PG8_WAIT_V(6); PG8_BAR;
    }
    for (;;) {
        const bool has_next = S.next(ui + 1, nxt);
        const char* nA = has_next ? (const char*)g.A + (size_t)nxt.pm * tstep : cA; const char* nB = has_next ? (const char*)g.Bt + (size_t)nxt.pb * tstep : cB;
        for (int t = 0; t < nt; t += 2) {
            const bool last = (t == nt - 2);
            const char* a1 = cA + (size_t)(t + 1) * kstep;
            const char* a2 = last ? nA : cA + (size_t)(t + 2) * kstep; const char* b2 = last ? nB : cB + (size_t)(t + 2) * kstep;
            const char* a3 = a2 + kstep; const char* b3 = b2 + kstep;
            if (last && has_next) S.a_ready(nxt);
            if constexpr (SP2) {
            PG8_LDB(B0, 0, 0); PG8_LDB(B1, 0, 1); PG8_SCHED; PG8_LDA(At, 0, 0); PG8_STAGE(PG8_SA(1, 1), a1 + hstep, voffA);
            PG8_WAIT_V(8); PG8_WAIT_L(0); PG8_BAR; PG8_MMA(0, 0, At, B0); PG8_MMA(0, 1, At, B1); PG8_BAR; PG8_SCHED;
            PG8_LDA(At, 0, 1); PG8_STAGE(PG8_SB(0, 0), b2, voffB); PG8_STAGE(PG8_SB(0, 1), b2 + hstep, voffB); PG8_STAGE(PG8_SA(0, 0), a2, voffA);
            PG8_WAIT_V(8); PG8_WAIT_L(0); PG8_BAR; PG8_MMA(1, 0, At, B0); PG8_MMA(1, 1, At, B1); PG8_BAR; PG8_SCHED;
            PG8_LDB(B0, 1, 0); PG8_LDB(B1, 1, 1); PG8_SCHED; PG8_LDA(At, 1, 0); PG8_STAGE(PG8_SA(0, 1), a2 + hstep, voffA);
            PG8_WAIT_V(8); PG8_WAIT_L(0); PG8_BAR; PG8_MMA(0, 0, At, B0); PG8_MMA(0, 1, At, B1); PG8_BAR; PG8_SCHED;
            PG8_LDA(At, 1, 1); PG8_STAGE(PG8_SB(1, 0), b3, voffB); PG8_STAGE(PG8_SB(1, 1), b3 + hstep, voffB); PG8_STAGE(PG8_SA(1, 0), a3, voffA);
            PG8_WAIT_V(8); PG8_WAIT_L(0); PG8_BAR; PG8_MMA(1, 0, At, B0); PG8_MMA(1, 1, At, B1); PG8_BAR; PG8_SCHED;
            } else {
            PG8_LDB(B0, 0, 0); PG8_SCHED; PG8_LDA(At, 0, 0); PG8_STAGE(PG8_SA(1, 1), a1 + hstep, voffA);
            PG8_WAIT_L(8); PG8_BAR; PG8_WAIT_L(0); PG8_MMA(0, 0, At, B0); PG8_BAR; PG8_SCHED;
            PG8_LDB(B1, 0, 1); PG8_STAGE(PG8_SB(0, 0), b2, voffB);
            PG8_BAR; PG8_WAIT_L(0); PG8_MMA(0, 1, At, B1); PG8_BAR;
            PG8_LDA(At, 0, 1); PG8_STAGE(PG8_SA(0, 0), a2, voffA);
            PG8_BAR; PG8_WAIT_L(0); PG8_MMA(1, 0, At, B0); PG8_BAR; PG8_SCHED;
            PG8_STAGE(PG8_SB(0, 1), b2 + hstep, voffB);
            PG8_WAIT_V(6); PG8_BAR; PG8_MMA(1, 1, At, B1); PG8_BAR;
            PG8_LDB(B0, 1, 0); PG8_SCHED; PG8_LDA(At, 1, 0); PG8_STAGE(PG8_SA(0, 1), a2 + hstep, voffA);
            PG8_WAIT_L(8); PG8_BAR; PG8_WAIT_L(0); PG8_MMA(0, 0, At, B0); PG8_BAR; PG8_SCHED;
            PG8_LDB(B1, 1, 1); PG8_STAGE(PG8_SB(1, 0), b3, voffB);
            PG8_BAR; PG8_WAIT_L(0); PG8_MMA(0, 1, At, B1); PG8_BAR;
            PG8_LDA(At, 1, 1); PG8_STAGE(PG8_SA(1, 0), a3, voffA);
            PG8_BAR; PG8_WAIT_L(0); PG8_MMA(1, 0, At, B0); PG8_BAR; PG8_SCHED;
            PG8_STAGE(PG8_SB(1, 1), b3 + hstep, voffB);
            PG8_WAIT_V(6); PG8_BAR; PG8_MMA(1, 1, At, B1); PG8_BAR;
            }
        }
        if constexpr (ALIGN_EPI) { if (wr == 0) PG8_BAR; }
        if constexpr (!Epi::AFTER_DRAIN) { E(acc, cur, wr, wc, fr, fq); S.done(cur); }
        if (!has_next) break;
#pragma unroll
        for (int a = 0; a < 2; ++a)
#pragma unroll
            for (int b = 0; b < 2; ++b)
#pragma unroll
                for (int m = 0; m < 4; ++m)
#pragma unroll
                    for (int n = 0; n < 2; ++n) acc[a][b][m][n] = (f32x4){0.f, 0.f, 0.f, 0.f};
        cur = nxt; cA = nA; cB = nB; ++ui;
        if constexpr (ALIGN_EPI) { if (wr == 1) PG8_BAR; }
    }
    PG8_WAIT_V(0);
    if constexpr (!ALIGN_EPI) { if (wr == 0) PG8_BAR; }
    PG8_BAR;
    if constexpr (Epi::AFTER_DRAIN) { E.fused(acc, cur, wr, wc, fr, fq, lds, wid, lane); S.done(cur); }
#undef PG8_SA
#undef PG8_SB
#undef PG8_STAGE
#undef PG8_LDA
#undef PG8_LDB
#undef PG8_MMA
#undef PG8_WAIT_V
#undef PG8_WAIT_L
#undef PG8_BAR
#undef PG8_SCHED
}
}

constexpr int NWAVES = 8, NTHR = 512;
constexpr int D = 2048, SEQ = 4096, NLAT = 8192, CTXL = 256, NCTX = 512, MROWS = 8704, DEPTH = 2;
constexpr int INC = 15392, NU = 15360;
constexpr int U_CB = 0, U_CC = 1024, U_CX = 2048, U_GQ = 3072, U_GK = 3584, U_GV = 4096, U_GR = 5120, U_NQ = 6144, U_NK = 7168, U_NV = 8192, U_GATE = 9216;
constexpr int LR_COL = 6144;
constexpr int FF = 5632, NGU = 2 * FF, NE = 8;
constexpr float LN_EPS = 1e-5f, ALPHA = 1.41421356237f;
constexpr int MOE_MAXP = 72;

constexpr size_t MiB = 1u << 20;
constexpr size_t WS_CTL = 0, CTL_ZERO_BYTES = 1 * MiB;
constexpr size_t WS_MOD = 1 * MiB;
constexpr size_t WS_WLR = 1 * MiB + 512 * 1024;
constexpr size_t WS_ROUTE = 2 * MiB;
constexpr size_t WS_TOK = 2 * MiB + 256 * 1024;
constexpr size_t WS_LR = 3 * MiB;
constexpr size_t WS_W = 8 * MiB;
constexpr size_t W_IN_B = (size_t)NU * D * 2, W_BR_B = (size_t)1024 * D * 2, W_OUT_B = (size_t)D * D * 2, W_LAYER_B = W_IN_B + 3 * W_BR_B + W_OUT_B;
constexpr size_t W_GU_B = (size_t)NGU * D * 2, W_D_B = (size_t)D * FF * 2, W_FFN_B = W_GU_B + W_D_B;
constexpr size_t WS_WFFN = WS_W + 2 * W_LAYER_B, WS_WMOE = WS_WFFN + W_FFN_B, WS_WEND = WS_WMOE + 8 * W_FFN_B;
constexpr size_t WS_XL = 762 * MiB;
constexpr size_t WS_H = 830 * MiB;
constexpr size_t WS_U = 864 * MiB;
constexpr size_t WS_Y = 1119 * MiB;
constexpr size_t WS_GLA = 1170 * MiB;
constexpr size_t WS_Z = 1306 * MiB;
constexpr size_t WS_ZB = 1374 * MiB;
constexpr size_t WS_PRE = 1408 * MiB;
constexpr size_t WS_END = 1476 * MiB;
static_assert(WS_WEND <= WS_XL && WS_XL + (size_t)MROWS * D * 4 <= WS_H && WS_H + (size_t)MROWS * D * 2 <= WS_U && WS_U + (size_t)MROWS * NU * 2 <= WS_Y, "ws map 1");
static_assert(WS_U + (size_t)MOE_MAXP * 256 * FF * 2 <= WS_Y && WS_Y + 3 * (size_t)MROWS * 1024 * 2 <= WS_GLA && WS_GLA + (size_t)MROWS * (4 * 512 + 2 * 1024) * 4 <= WS_Z, "ws map 2");
static_assert(WS_GLA + (size_t)MOE_MAXP * 256 * D * 2 <= WS_Z && WS_Z + (size_t)MOE_MAXP * 256 * D * 4 <= WS_END && WS_PRE + (size_t)MROWS * D * 4 <= WS_END, "ws map 3");
constexpr int CW_TMO = 0, CW_CODE = 1;
constexpr int CW_MOECNT = 64;
constexpr int CW_BAR = 4096;

constexpr int RING_OFF = 0, RING_BYTES = 131072;
constexpr int LDSCTL_OFF = RING_BYTES, MISC_OFF = LDSCTL_OFF + 320;
constexpr int LDS_BYTES = 147456;

#define GAS __attribute__((address_space(1)))
#define LAS __attribute__((address_space(3)))
typedef unsigned short bf16;
typedef unsigned v4u __attribute__((ext_vector_type(4)));
typedef unsigned v2u __attribute__((ext_vector_type(2)));
typedef float f32x4 __attribute__((ext_vector_type(4)));
typedef GAS unsigned gu32;
#define RLX_AGENT __ATOMIC_RELAXED, __HIP_MEMORY_SCOPE_AGENT
#define LDS_WAIT() asm volatile("s_waitcnt lgkmcnt(0)" ::: "memory")
#define VM_WAIT() asm volatile("s_waitcnt vmcnt(0)" ::: "memory")
__device__ __forceinline__ unsigned f2bf(float f) { unsigned u = __builtin_bit_cast(unsigned, f); return (u + 0x7fffu + ((u >> 16) & 1u)) >> 16; }
__device__ __forceinline__ unsigned pk2(float lo, float hi) { return f2bf(lo) | (f2bf(hi) << 16); }
__device__ __forceinline__ float bflo(unsigned w) { return __uint_as_float(w << 16); }
__device__ __forceinline__ float bfhi(unsigned w) { return __uint_as_float(w & 0xffff0000u); }
__device__ __forceinline__ float bf1(bf16 b) { return __uint_as_float(((unsigned)b) << 16); }
__device__ __forceinline__ float wave_sum(float v) {
#pragma unroll
    for (int o = 1; o < 64; o <<= 1) v += __shfl_xor(v, o);
    return v;
}
__device__ __forceinline__ float wave_max(float v) {
#pragma unroll
    for (int o = 1; o < 64; o <<= 1) v = fmaxf(v, __shfl_xor(v, o));
    return v;
}

#define XB_TMO      128
#define XB_XCNT(j)  (256  + 64 * (j))
#define XB_XSUB(j)  (1280 + 64 * (j))
#define XB_XGEN(j)  (2304 + 64 * (j))
#define XB_TOP      3328
#define XB_TOPGEN   3392
#define XCD_BAR_WORDS 3456
#define XB_SPIN_CAP (1u << 18)

__device__ __forceinline__ unsigned xb_ld(unsigned* p)              { return __hip_atomic_load(p, __ATOMIC_RELAXED, __HIP_MEMORY_SCOPE_AGENT); }
__device__ __forceinline__ unsigned xb_add(unsigned* p, unsigned v) { return __hip_atomic_fetch_add(p, v, __ATOMIC_RELAXED, __HIP_MEMORY_SCOPE_AGENT); }
__device__ __forceinline__ unsigned xb_xcc_id() { return (unsigned)__builtin_amdgcn_s_getreg((3 << 11) | 20) & 0xFu; }
#define XB_SPIN(cond, bar) do { unsigned _sp = 0; while (cond) { __builtin_amdgcn_s_sleep(1); \
    if ((++_sp & 255u) == 0u) { if (xb_ld(&(bar)[XB_TMO])) break; if (_sp > XB_SPIN_CAP) { atomicAdd(&(bar)[XB_TMO], 1u); break; } } } } while (0)

struct XcdBarrier {
    unsigned* bar; unsigned x; unsigned grid;
    volatile LAS unsigned* st;
};

__device__ __forceinline__ XcdBarrier xcd_barrier_post(unsigned* bar, volatile LAS unsigned* st, unsigned grid) {
    XcdBarrier b; b.grid = grid; b.bar = bar; b.x = xb_xcc_id(); b.st = st;
    if (threadIdx.x == 0) (void)xb_add(&bar[XB_XCNT(b.x)], 1u);
    return b;
}
__device__ __forceinline__ void xcd_barrier_complete(unsigned* bar, unsigned x, unsigned& nloc, unsigned& nx, unsigned b_grid) {
    const unsigned G = b_grid;
    unsigned sum, cnt, mine, sp = 0u;
    for (;;) {
        sum = 0u; cnt = 0u; mine = 0u;
#pragma unroll
        for (unsigned j = 0; j < 16; ++j) { const unsigned c = xb_ld(&bar[XB_XCNT(j)]); sum += c; cnt += (c > 0u) ? 1u : 0u; mine = (j == x) ? c : mine; }
        if (sum == G) break;
        __builtin_amdgcn_s_sleep(1);
        if ((++sp & 255u) == 0u) { if (xb_ld(&bar[XB_TMO])) break; if (sp > XB_SPIN_CAP) { atomicAdd(&bar[XB_TMO], 1u); break; } }
    }
    nloc = mine > 0u ? mine : 1u; nx = cnt > 0u ? cnt : 1u;
}

__device__ __forceinline__ void xcd_barrier(const XcdBarrier& b) {
    asm volatile("s_waitcnt vmcnt(0)" ::: "memory");
    __syncthreads();
    if (threadIdx.x == 0) {
        unsigned* bar = b.bar;
        __builtin_amdgcn_s_waitcnt(0);
        unsigned nloc = b.st[0], nx = b.st[1];
        if (nloc == 0u) { xcd_barrier_complete(bar, b.x, nloc, nx, b.grid); b.st[0] = nloc; b.st[1] = nx; }
        const unsigned old = xb_add(&bar[XB_XSUB(b.x)], 1u);
        const unsigned gen = old / nloc;
        if (old + 1u == (gen + 1u) * nloc) {
            __builtin_amdgcn_fence(__ATOMIC_RELEASE, "agent");
            asm volatile("s_waitcnt vmcnt(0)" ::: "memory");
            const unsigned og = xb_add(&bar[XB_TOP], 1u);
            const unsigned tg = og / nx;
            if (og + 1u == (tg + 1u) * nx) xb_add(&bar[XB_TOPGEN], 1u);
            else XB_SPIN(xb_ld(&bar[XB_TOPGEN]) == tg, bar);
            __builtin_amdgcn_fence(__ATOMIC_ACQUIRE, "agent");
            xb_add(&bar[XB_XGEN(b.x)], 1u);
            asm volatile("s_waitcnt vmcnt(0)" ::: "memory");
        } else {
            XB_SPIN(xb_ld(&bar[XB_XGEN(b.x)]) == gen, bar);
            __builtin_amdgcn_fence(__ATOMIC_ACQUIRE, "agent");
            asm volatile("s_waitcnt vmcnt(0)" ::: "memory");
        }
    }
    __syncthreads();
}

struct Args { const float* in[30]; float* out; unsigned char* ws; int ph_lo, ph_hi, grid, pad; };
struct Frame {
    LAS unsigned char* lds;
    volatile LAS unsigned* MISC;
    int tid, lane, wave, vcu, G, bx;
};
__device__ __forceinline__ Frame mkframe(LAS unsigned char* lds, int grid) {
    Frame F; int t = threadIdx.x; asm volatile("" : "+v"(t)); int g = grid, bx = blockIdx.x; asm volatile("" : "+s"(g), "+s"(bx));
    F.lds = lds; F.MISC = (volatile LAS unsigned*)(lds + MISC_OFF); F.tid = t; F.lane = t & 63; F.wave = __builtin_amdgcn_readfirstlane(t >> 6); F.G = g; F.bx = bx;
    F.vcu = (g % 8 == 0) ? (bx % 8) * (g / 8) + bx / 8 : bx; return F;
}
constexpr int PTAB_OFF = LDSCTL_OFF + 1024, PT_OUT = 30, PT_WS = 31;
__device__ __forceinline__ unsigned long long ldp_raw(Frame& F, int i) {
    const volatile LAS unsigned* t = (const volatile LAS unsigned*)(F.lds + PTAB_OFF) + 2 * i; const unsigned lo = t[0], hi = t[1];
    return ((unsigned long long)(unsigned)__builtin_amdgcn_readfirstlane((int)hi) << 32) | (unsigned)__builtin_amdgcn_readfirstlane((int)lo);
}
#define PIN(i) ((const float*)(const GAS float*)ldp_raw(F, (i)))
#define POUT() ((float*)(GAS float*)ldp_raw(F, PT_OUT))
#define PWS() ((unsigned char*)(GAS unsigned char*)ldp_raw(F, PT_WS))
__device__ __forceinline__ bf16* w_in_t(unsigned char* ws, int L) { return (bf16*)(ws + WS_W + (size_t)L * W_LAYER_B); }
__device__ __forceinline__ bf16* w_br_t(unsigned char* ws, int L, int b) { return (bf16*)(ws + WS_W + (size_t)L * W_LAYER_B + W_IN_B + (size_t)b * W_BR_B); }
__device__ __forceinline__ bf16* w_out_t(unsigned char* ws, int L) { return (bf16*)(ws + WS_W + (size_t)L * W_LAYER_B + W_IN_B + 3 * W_BR_B); }
__device__ __forceinline__ bf16* w_gu_t(unsigned char* ws, int e) { return (bf16*)(ws + (e < 0 ? WS_WFFN : WS_WMOE + (size_t)e * W_GU_B)); }
__device__ __forceinline__ bf16* w_d_t(unsigned char* ws, int e) { return (bf16*)(ws + (e < 0 ? WS_WFFN + W_GU_B : WS_WMOE + 8 * W_GU_B + (size_t)e * W_D_B)); }

__device__ __forceinline__ void transpose_item(const float* W, int K, int N, bf16* WT, int drow, LAS float* scr, int kb, int nb, int lane) {
    const int k0 = 64 * kb, n0 = 32 * nb;
#pragma unroll 8
    for (int i = 0; i < 32; ++i) { const int kk = 2 * i + (lane >> 5); scr[kk * 33 + (lane & 31)] = W[(size_t)(k0 + kk) * N + n0 + (lane & 31)]; }
    LDS_WAIT(); asm volatile("" ::: "memory");
    const int c = lane & 7;
#pragma unroll
    for (int j = 0; j < 4; ++j) { const int n = (lane >> 3) + 8 * j; const LAS float* s = scr + (8 * c) * 33 + n;
        v4u o; o.x = pk2(s[0 * 33], s[1 * 33]); o.y = pk2(s[2 * 33], s[3 * 33]); o.z = pk2(s[4 * 33], s[5 * 33]); o.w = pk2(s[6 * 33], s[7 * 33]);
        *(GAS v4u*)(WT + (size_t)(drow + n) * K + k0 + 8 * c) = o; }
    LDS_WAIT(); asm volatile("" ::: "memory");
}
template <int MODE> __device__ __forceinline__ void conv_matrix(Frame& F, const float* W, int K, int N, bf16* WT) {
    LAS float* scr = (LAS float*)(F.lds + RING_OFF + F.wave * 16384);
    const int gw = F.vcu * NWAVES + F.wave, NGW = F.G * NWAVES;
    const int nblk = N / 32, nitems = (K / 64) * nblk;
    for (int it = gw; it < nitems; it += NGW) {
        const int kb = it / nblk, nb = it % nblk; int drow;
        if (MODE == 0) drow = 32 * nb;
        else if (MODE == 1) { if (nb == LR_COL / 32) continue; drow = nb < LR_COL / 32 ? 32 * nb : 32 * (nb - 1); }
        else if (MODE == 2) drow = 256 * (nb >> 2) + 32 * (nb & 3);
        else drow = 256 * (nb >> 2) + 128 + 32 * (nb & 3);
        transpose_item(W, K, N, WT, drow, scr, kb, nb, F.lane);
    }
}
__device__ __forceinline__ void ada_item(Frame& F, unsigned char* ws, const float* cnd, const float* cctx, const float* ada_w, const float* ada_b, int item) {
    const int L = item / 96, c0 = (item % 96) * 128;
    LAS float* sc = (LAS float*)(F.lds + RING_OFF);
    LAS float* red = (LAS float*)(F.lds + RING_OFF + 24576);
    for (int i = F.tid; i < 3 * D; i += NTHR) { const int g = i / D, k = i % D; const float v = g < 2 ? cnd[g * D + k] : cctx[k]; sc[i] = v / (1.0f + __expf(-v)); }
    __syncthreads();
    const float* W = ada_w + (size_t)L * D * 12288 + c0 + 2 * F.lane;
    float a00 = 0.f, a01 = 0.f, a10 = 0.f, a11 = 0.f, a20 = 0.f, a21 = 0.f;
    const int kb = 256 * F.wave;
#pragma unroll 8
    for (int k = kb; k < kb + 256; ++k) { const float2 w = *(const float2*)(W + (size_t)k * 12288); const float s0 = sc[k], s1 = sc[D + k], s2 = sc[2 * D + k];
        a00 += s0 * w.x; a01 += s0 * w.y; a10 += s1 * w.x; a11 += s1 * w.y; a20 += s2 * w.x; a21 += s2 * w.y; }
    red[(F.wave * 3 + 0) * 128 + 2 * F.lane] = a00; red[(F.wave * 3 + 0) * 128 + 2 * F.lane + 1] = a01;
    red[(F.wave * 3 + 1) * 128 + 2 * F.lane] = a10; red[(F.wave * 3 + 1) * 128 + 2 * F.lane + 1] = a11;
    red[(F.wave * 3 + 2) * 128 + 2 * F.lane] = a20; red[(F.wave * 3 + 2) * 128 + 2 * F.lane + 1] = a21;
    __syncthreads();
    if (F.tid < 384) { const int g = F.tid / 128, cc = F.tid % 128; float s = 0.f;
#pragma unroll
        for (int w = 0; w < 8; ++w) s += red[(w * 3 + g) * 128 + cc];
        ((float*)(ws + WS_MOD))[((size_t)L * 3 + g) * 12288 + c0 + cc] = s + ada_b[L * 12288 + c0 + cc]; }
    __syncthreads();
}
__device__ __forceinline__ void p0a_prologue(Frame& F) {
    unsigned char* const ws = PWS();
    { const float* cnd = PIN(1); const float* cctx = PIN(3); const float* ada_w = PIN(4); const float* ada_b = PIN(5);
      for (int it = F.bx; it < 192; it += F.G) ada_item(F, ws, cnd, cctx, ada_w, ada_b, it); }
    const float* const w_in = PIN(6);
    { const int gt = F.bx * NTHR + F.tid, NGT = F.G * NTHR;
      for (int i = gt; i < DEPTH * D * 32; i += NGT) { const int o = i & 31, k = (i >> 5) % D, L = i / (32 * D); ((float*)(ws + WS_WLR))[((size_t)L * 32 + o) * D + k] = w_in[((size_t)L * D + k) * INC + LR_COL + o]; } }
    for (int L = 0; L < DEPTH; ++L) {
        conv_matrix<1>(F, w_in + (size_t)L * D * INC, D, INC, w_in_t(ws, L));
        for (int b = 0; b < 3; ++b) conv_matrix<0>(F, (b == 0 ? PIN(14) : (b == 1 ? PIN(15) : PIN(16))) + (size_t)L * 1024 * D, 1024, D, w_br_t(ws, L, b));
        conv_matrix<0>(F, PIN(18) + (size_t)L * D * D, D, D, w_out_t(ws, L));
    }
    conv_matrix<2>(F, PIN(23), D, FF, w_gu_t(ws, -1)); conv_matrix<3>(F, PIN(24), D, FF, w_gu_t(ws, -1)); conv_matrix<0>(F, PIN(25), FF, D, w_d_t(ws, -1));
    for (int e = 0; e < NE; ++e) {
        conv_matrix<2>(F, PIN(27) + (size_t)e * D * FF, D, FF, w_gu_t(ws, e)); conv_matrix<3>(F, PIN(28) + (size_t)e * D * FF, D, FF, w_gu_t(ws, e));
        conv_matrix<0>(F, PIN(29) + (size_t)e * FF * D, FF, D, w_d_t(ws, e));
    }
}

__device__ __forceinline__ int row_group(int r) { return r < SEQ ? 0 : (r < NLAT ? 1 : 2); }
__device__ __forceinline__ void load_row(const float* p, int lane, f32x4 (&v)[8]) {
#pragma unroll
    for (int j = 0; j < 8; ++j) v[j] = *(const GAS f32x4*)(p + 4 * lane + 256 * j);
}
__device__ __forceinline__ void store_row(float* p, int lane, const f32x4 (&v)[8]) {
#pragma unroll
    for (int j = 0; j < 8; ++j) *(GAS f32x4*)(p + 4 * lane + 256 * j) = v[j];
}
__device__ __forceinline__ void store_row_bf16(bf16* p, int lane, const f32x4 (&v)[8]) {
#pragma unroll
    for (int j = 0; j < 8; ++j) { v2u w; w.x = pk2(v[j][0], v[j][1]); w.y = pk2(v[j][2], v[j][3]); *(GAS v2u*)(p + 4 * lane + 256 * j) = w; }
}
__device__ __forceinline__ void modulate(f32x4 (&v)[8], const float* shift, const float* scale, int lane) {
#pragma unroll
    for (int j = 0; j < 8; ++j) { const f32x4 sh = *(const f32x4*)(shift + 4 * lane + 256 * j), sc = *(const f32x4*)(scale + 4 * lane + 256 * j); v[j] = v[j] * (sc + 1.0f) + sh; }
}
__device__ __forceinline__ void layer_norm_row(f32x4 (&v)[8], const float* g, const float* b, int lane) {
    float s = 0.f;
#pragma unroll
    for (int j = 0; j < 8; ++j) s += (v[j][0] + v[j][1]) + (v[j][2] + v[j][3]);
    const float mean = wave_sum(s) * (1.0f / D); float q = 0.f;
#pragma unroll
    for (int j = 0; j < 8; ++j) { v[j] = v[j] - mean; q += (v[j][0] * v[j][0] + v[j][1] * v[j][1]) + (v[j][2] * v[j][2] + v[j][3] * v[j][3]); }
    const float rstd = 1.0f / sqrtf(wave_sum(q) * (1.0f / D) + LN_EPS);
#pragma unroll
    for (int j = 0; j < 8; ++j) { const f32x4 g4 = *(const f32x4*)(g + 4 * lane + 256 * j), b4 = *(const f32x4*)(b + 4 * lane + 256 * j); v[j] = v[j] * rstd * g4 + b4; }
}
__device__ __forceinline__ void emit_h_lr(Frame& F, unsigned char* ws, const f32x4 (&h)[8], int r, int L) {
    store_row_bf16(((bf16*)(ws + WS_H)) + (size_t)r * D, F.lane, h);
    const float* wl = ((float*)(ws + WS_WLR)) + (size_t)L * 32 * D + 4 * F.lane; float keep = 0.f;
    for (int o = 0; o < 32; ++o) { float s = 0.f;
#pragma unroll
        for (int j = 0; j < 8; ++j) { const f32x4 w = *(const f32x4*)(wl + (size_t)o * D + 256 * j); s += (h[j][0] * w[0] + h[j][1] * w[1]) + (h[j][2] * w[2] + h[j][3] * w[3]); }
        s = wave_sum(s); if (F.lane == o) keep = s; }
    if (F.lane < 32) ((float*)(ws + WS_LR))[(size_t)r * 32 + F.lane] = keep;
}
__device__ __forceinline__ void p0b_modulate(Frame& F) {
    unsigned char* const ws = PWS(); const float* const xin = PIN(0); const float* const cin = PIN(2);
    const int gw = F.vcu * NWAVES + F.wave, NGW = F.G * NWAVES;
    for (int r = gw; r < MROWS; r += NGW) {
        f32x4 v[8]; load_row(r < NLAT ? xin + (size_t)r * D : cin + (size_t)(r - NLAT) * D, F.lane, v);
        const float* m = ((float*)(ws + WS_MOD)) + (size_t)row_group(r) * 12288;
        modulate(v, m, m + D, F.lane); emit_h_lr(F, ws, v, r, 0);
    }
}

__device__ __forceinline__ void mix_prep(Frame& F, int L) {
    unsigned char* const ws = PWS();
    const int gt = F.bx * NTHR + F.tid, NGT = F.G * NTHR;
    const float* cw = PIN(7) + (size_t)L * 3 * 1024;
    for (int i = gt; i < MROWS * 128; i += NGT) {
        const int r = i >> 7, c8 = (i & 127) * 8;
        const int t = r < NLAT ? (r & (SEQ - 1)) : ((r - NLAT) & (CTXL - 1)), T = r < NLAT ? SEQ : CTXL;
        float acc[8];
#pragma unroll
        for (int j = 0; j < 8; ++j) acc[j] = 0.f;
#pragma unroll
        for (int k = 0; k < 3; ++k) { const int tt = t + k - 1; if (tt < 0 || tt >= T) continue;
            const bf16* up = ((bf16*)(ws + WS_U)) + (size_t)(r + k - 1) * NU; const v4u a = *(const GAS v4u*)(up + U_CC + c8), b = *(const GAS v4u*)(up + U_CX + c8);
            const f32x4 w0 = *(const f32x4*)(cw + k * 1024 + c8), w1 = *(const f32x4*)(cw + k * 1024 + c8 + 4);
            acc[0] += w0[0] * bflo(a.x) * bflo(b.x); acc[1] += w0[1] * bfhi(a.x) * bfhi(b.x); acc[2] += w0[2] * bflo(a.y) * bflo(b.y); acc[3] += w0[3] * bfhi(a.y) * bfhi(b.y);
            acc[4] += w1[0] * bflo(a.z) * bflo(b.z); acc[5] += w1[1] * bfhi(a.z) * bfhi(b.z); acc[6] += w1[2] * bflo(a.w) * bflo(b.w); acc[7] += w1[3] * bfhi(a.w) * bfhi(b.w); }
        const v4u ab = *(const GAS v4u*)(((bf16*)(ws + WS_U)) + (size_t)r * NU + U_CB + c8);
        v4u o; o.x = pk2(acc[0] * bflo(ab.x), acc[1] * bfhi(ab.x)); o.y = pk2(acc[2] * bflo(ab.y), acc[3] * bfhi(ab.y)); o.z = pk2(acc[4] * bflo(ab.z), acc[5] * bfhi(ab.z)); o.w = pk2(acc[6] * bflo(ab.w), acc[7] * bfhi(ab.w));
        *(GAS v4u*)(((bf16*)(ws + WS_Y)) + (size_t)r * 1024 + c8) = o;
    }
    const float* wgf = PIN(8) + (size_t)L * 16 * 512; const float* wgb = PIN(10) + (size_t)L * 16 * 512; const float* bgf = PIN(9) + L * 512; const float* bgb = PIN(11) + L * 512;
    for (int i = gt; i < MROWS * 128; i += NGT) {
        const int r = i >> 7, d4 = (i & 127) * 4, dd = d4 & 127;
        const v2u qw = *(const GAS v2u*)(((bf16*)(ws + WS_U)) + (size_t)r * NU + U_GQ + d4), kw = *(const GAS v2u*)(((bf16*)(ws + WS_U)) + (size_t)r * NU + U_GK + d4);
        const float qs = 0.08838834764831845f;
        float q[4] = {bflo(qw.x) * qs, bfhi(qw.x) * qs, bflo(qw.y) * qs, bfhi(qw.y) * qs}, k[4] = {bflo(kw.x), bfhi(kw.x), bflo(kw.y), bfhi(kw.y)};
        if (r < NLAT) { const int t = r & (SEQ - 1);
#pragma unroll
            for (int p = 0; p < 2; ++p) { const int pi = (dd >> 1) + p; const float pos = pi < 32 ? (float)(t >> 6) : (float)(t & 63); const float inv = exp2f(-(float)(pi & 31) * 0.41524101186092029f);
                const float ang = pos * inv, cs = __cosf(ang), sn = __sinf(ang);
                const float q0 = q[2 * p], q1 = q[2 * p + 1], k0 = k[2 * p], k1 = k[2 * p + 1];
                q[2 * p] = q0 * cs - q1 * sn; q[2 * p + 1] = q0 * sn + q1 * cs; k[2 * p] = k0 * cs - k1 * sn; k[2 * p + 1] = k0 * sn + k1 * cs; } }
        *(GAS f32x4*)(((float*)(ws + WS_GLA)) + (size_t)r * 512 + d4) = (f32x4){q[0], q[1], q[2], q[3]};
        *(GAS f32x4*)(((float*)(ws + WS_GLA + (size_t)MROWS * 512 * 4)) + (size_t)r * 512 + d4) = (f32x4){k[0], k[1], k[2], k[3]};
        f32x4 zf = *(const f32x4*)(bgf + d4), zb = *(const f32x4*)(bgb + d4);
        const float* lrr = ((float*)(ws + WS_LR)) + (size_t)r * 32;
#pragma unroll
        for (int o = 0; o < 16; ++o) { const float lf = lrr[o], lb = lrr[16 + o]; zf += lf * *(const f32x4*)(wgf + o * 512 + d4); zb += lb * *(const f32x4*)(wgb + o * 512 + d4); }
        f32x4 gf, gb;
#pragma unroll
        for (int j = 0; j < 4; ++j) { gf[j] = (fminf(zf[j], 0.f) - __logf(1.0f + __expf(-fabsf(zf[j])))) * (1.0f / 16.0f); gb[j] = (fminf(zb[j], 0.f) - __logf(1.0f + __expf(-fabsf(zb[j])))) * (1.0f / 16.0f); }
        *(GAS f32x4*)(((float*)(ws + WS_GLA + (size_t)MROWS * 1024 * 4)) + (size_t)r * 512 + d4) = gf; *(GAS f32x4*)(((float*)(ws + WS_GLA + (size_t)MROWS * 1536 * 4)) + (size_t)r * 512 + d4) = gb;
    }
}
__device__ __forceinline__ int gla_row(int s, int b, int dir) { if (s < CTXL) return NLAT + CTXL * b + (dir ? CTXL - 1 - s : s); const int s2 = s - CTXL; return SEQ * b + (dir ? SEQ - 1 - s2 : s2); }
__device__ __forceinline__ void gla_naive(Frame& F) {
    unsigned char* const ws = PWS();
    const int hw = F.wave >> 2, chain = F.bx * 2 + hw, b = chain >> 3, dir = (chain >> 2) & 1, head = chain & 3;
    const int tl = F.tid & 255, e = tl;
    LAS float* buf = (LAS float*)(F.lds + RING_OFF) + hw * (16 * 384);
    const float* Gs = dir ? ((float*)(ws + WS_GLA + (size_t)MROWS * 1536 * 4)) : ((float*)(ws + WS_GLA + (size_t)MROWS * 1024 * 4)); float* O = dir ? ((float*)(ws + WS_GLA + (size_t)MROWS * 3072 * 4)) : ((float*)(ws + WS_GLA + (size_t)MROWS * 2048 * 4));
    float S[128];
#pragma unroll
    for (int d = 0; d < 128; ++d) S[d] = 0.f;
    for (int s0 = 0; s0 < CTXL + SEQ; s0 += 16) {
        __syncthreads();
        for (int i = tl; i < 16 * 384; i += 256) { const int st = i / 384, rem = i % 384, which = rem >> 7, d = rem & 127; const int r = gla_row(s0 + st, b, dir); const size_t o = (size_t)r * 512 + head * 128 + d;
            buf[i] = which == 0 ? __expf(Gs[o]) : (which == 1 ? ((float*)(ws + WS_GLA + (size_t)MROWS * 512 * 4))[o] : ((float*)(ws + WS_GLA))[o]); }
        __syncthreads();
        float vn = bf1(((bf16*)(ws + WS_U))[(size_t)gla_row(s0, b, dir) * NU + U_GV + head * 256 + e]);
        for (int st = 0; st < 16; ++st) {
            const float v = vn; const int r = gla_row(s0 + st, b, dir);
            if (st < 15) vn = bf1(((bf16*)(ws + WS_U))[(size_t)gla_row(s0 + st + 1, b, dir) * NU + U_GV + head * 256 + e]);
            const LAS f32x4* A4 = (const LAS f32x4*)(buf + st * 384); float o = 0.f;
#pragma unroll
            for (int d4 = 0; d4 < 32; ++d4) { const f32x4 a = A4[d4], k = A4[32 + d4], q = A4[64 + d4];
#pragma unroll
                for (int j = 0; j < 4; ++j) { S[4 * d4 + j] = a[j] * S[4 * d4 + j] + k[j] * v; o += q[j] * S[4 * d4 + j]; } }
            O[(size_t)r * 1024 + head * 256 + e] = o;
        }
    }
}
__device__ __forceinline__ void na_naive(Frame& F, int L) {
    unsigned char* const ws = PWS();
    const int gwv = (F.bx - 8) * NWAVES + F.wave, nwv = (F.G - 8) * NWAVES;
    LAS float* qs = (LAS float*)(F.lds + RING_OFF + 65536) + F.wave * 512; LAS float* ps = qs + 128;
    const int T_lat = NLAT * 8, T_all = T_lat + (L == 0 ? NCTX * 8 : 0);
    const float* rpb = PIN(13) + (size_t)L * 8 * 15 * 31;
    for (int task = gwv; task < T_all; task += nwv) {
        const bool isctx = task >= T_lat; const int r = isctx ? NLAT + ((task - T_lat) >> 3) : (task >> 3), h = task & 7;
        const int b = isctx ? ((r - NLAT) >> 8) : (r >> 12);
        { const unsigned qw = *(const GAS unsigned*)(((bf16*)(ws + WS_U)) + (size_t)r * NU + U_NQ + h * 128 + 2 * F.lane); qs[2 * F.lane] = bflo(qw) * 0.08838834764831845f; qs[2 * F.lane + 1] = bfhi(qw) * 0.08838834764831845f; }
        LDS_WAIT(); asm volatile("" ::: "memory");
        const int nkeys = isctx ? 256 : 384, t = r & (SEQ - 1), qr = t >> 6, qc = t & 63;
        const int rs = min(max(qr - 4, 0), 56), cs = min(max(qc - 8, 0), 48);
        float sc[6];
#pragma unroll
        for (int m = 0; m < 6; ++m) { const int j = F.lane + 64 * m; sc[m] = -INFINITY;
            if (j < nkeys) { int rk; float bias = 0.f;
                if (!isctx && j < 128) { const int kr = rs + (j >> 4), kc = cs + (j & 15); rk = b * SEQ + kr * 64 + kc; bias = rpb[(h * 15 + (kr - qr + 7)) * 31 + (kc - qc + 15)]; }
                else rk = NLAT + CTXL * b + (isctx ? j : j - 128);
                const GAS v4u* kp = (const GAS v4u*)(((bf16*)(ws + WS_U)) + (size_t)rk * NU + U_NK + h * 128); float dot = 0.f;
#pragma unroll 4
                for (int c = 0; c < 16; ++c) { const v4u kv = kp[c]; const LAS f32x4* q4 = (const LAS f32x4*)(qs + 8 * c); const f32x4 qa = q4[0], qb = q4[1];
                    dot += qa[0] * bflo(kv.x) + qa[1] * bfhi(kv.x) + qa[2] * bflo(kv.y) + qa[3] * bfhi(kv.y) + qb[0] * bflo(kv.z) + qb[1] * bfhi(kv.z) + qb[2] * bflo(kv.w) + qb[3] * bfhi(kv.w); }
                sc[m] = dot + bias; }
            asm volatile("" ::: "memory"); }
        float mx = sc[0];
#pragma unroll
        for (int m = 1; m < 6; ++m) mx = fmaxf(mx, sc[m]);
        mx = wave_max(mx); float sum = 0.f;
#pragma unroll
        for (int m = 0; m < 6; ++m) { sc[m] = (F.lane + 64 * m < nkeys) ? __expf(sc[m] - mx) : 0.f; sum += sc[m]; }
        sum = wave_sum(sum); const float inv = 1.0f / sum;
#pragma unroll
        for (int m = 0; m < 6; ++m) ps[F.lane + 64 * m] = sc[m] * inv;
        LDS_WAIT(); asm volatile("" ::: "memory");
        float a0 = 0.f, a1 = 0.f;
        for (int j = 0; j < nkeys; ++j) { int rk;
            if (!isctx && j < 128) rk = b * SEQ + (rs + (j >> 4)) * 64 + cs + (j & 15); else rk = NLAT + CTXL * b + (isctx ? j : j - 128);
            const unsigned vw = *(const GAS unsigned*)(((bf16*)(ws + WS_U)) + (size_t)rk * NU + U_NV + h * 128 + 2 * F.lane); const float p = ps[j];
            a0 += p * bflo(vw); a1 += p * bfhi(vw); }
        *(GAS unsigned*)(((bf16*)(ws + WS_Y + (size_t)MROWS * 2048 * 2)) + (size_t)r * 1024 + h * 128 + 2 * F.lane) = pk2(a0, a1);
        LDS_WAIT(); asm volatile("" ::: "memory");
    }
}
__device__ __forceinline__ void gla_out(Frame& F, int L) {
    unsigned char* const ws = PWS();
    const int gw = F.vcu * NWAVES + F.wave, NGW = F.G * NWAVES;
    const float* ng = PIN(12) + L * 256 + 4 * F.lane;
    for (int task = gw; task < MROWS * 4; task += NGW) {
        const int r = task >> 2, head = task & 3; const size_t o = (size_t)r * 1024 + head * 256 + 4 * F.lane;
        const f32x4 v = *(const GAS f32x4*)(((float*)(ws + WS_GLA + (size_t)MROWS * 2048 * 4)) + o) + *(const GAS f32x4*)(((float*)(ws + WS_GLA + (size_t)MROWS * 3072 * 4)) + o);
        const float ss = wave_sum((v[0] * v[0] + v[1] * v[1]) + (v[2] * v[2] + v[3] * v[3]));
        const float rs = 1.0f / sqrtf(ss * (1.0f / 256.0f) + LN_EPS);
        const v2u rw = *(const GAS v2u*)(((bf16*)(ws + WS_U)) + (size_t)r * NU + U_GR + head * 256 + 4 * F.lane); const f32x4 g4 = *(const f32x4*)ng;
        const float r0 = bflo(rw.x), r1 = bfhi(rw.x), r2 = bflo(rw.y), r3 = bfhi(rw.y);
        v2u w; w.x = pk2(v[0] * rs * g4[0] * (r0 / (1.0f + __expf(-r0))), v[1] * rs * g4[1] * (r1 / (1.0f + __expf(-r1))));
        w.y = pk2(v[2] * rs * g4[2] * (r2 / (1.0f + __expf(-r2))), v[3] * rs * g4[3] * (r3 / (1.0f + __expf(-r3))));
        *(GAS v2u*)(((bf16*)(ws + WS_Y + (size_t)MROWS * 1024 * 2)) + o) = w;
    }
}

__device__ __forceinline__ void ln1_phase(Frame& F, int L, int M) {
    unsigned char* const ws = PWS(); const float* const lng = PIN(19) + L * D; const float* const lnb = PIN(20) + L * D; const float* const router = PIN(26);
    const int gw = F.vcu * NWAVES + F.wave, NGW = F.G * NWAVES;
    for (int r = gw; r < M; r += NGW) {
        f32x4 v[8]; load_row(((float*)(ws + WS_PRE)) + (size_t)r * D, F.lane, v);
        layer_norm_row(v, lng, lnb, F.lane);
        store_row(((float*)(ws + WS_XL)) + (size_t)r * D, F.lane, v);
        const float* m = ((float*)(ws + WS_MOD)) + ((size_t)L * 3 + row_group(r)) * 12288;
        modulate(v, m + 3 * D, m + 4 * D, F.lane);
        store_row_bf16(((bf16*)(ws + WS_H)) + (size_t)r * D, F.lane, v);
        if (L == 1) {
            float lg[8];
#pragma unroll
            for (int e = 0; e < 8; ++e) lg[e] = 0.f;
#pragma unroll
            for (int j = 0; j < 8; ++j)
#pragma unroll
                for (int i = 0; i < 4; ++i) { const float* rp = router + (size_t)(4 * F.lane + 256 * j + i) * 8; const f32x4 w0 = *(const f32x4*)rp, w1 = *(const f32x4*)(rp + 4); const float hv = v[j][i];
                    lg[0] += hv * w0[0]; lg[1] += hv * w0[1]; lg[2] += hv * w0[2]; lg[3] += hv * w0[3]; lg[4] += hv * w1[0]; lg[5] += hv * w1[1]; lg[6] += hv * w1[2]; lg[7] += hv * w1[3]; }
#pragma unroll
            for (int e = 0; e < 8; ++e) lg[e] = wave_sum(lg[e]);
            int e0 = 0; float v0 = lg[0];
#pragma unroll
            for (int e = 1; e < 8; ++e) if (lg[e] > v0) { v0 = lg[e]; e0 = e; }
            int e1 = -1; float v1 = -INFINITY;
#pragma unroll
            for (int e = 0; e < 8; ++e) if (e != e0 && lg[e] > v1) { v1 = lg[e]; e1 = e; }
            if (F.lane == 0) {
                const float w0 = 1.0f / (1.0f + __expf(v1 - v0)), w1 = 1.0f - w0;
                const unsigned p0 = __hip_atomic_fetch_add(((gu32*)(ws + WS_CTL)) + CW_MOECNT + 64 * e0, 1u, RLX_AGENT), p1 = __hip_atomic_fetch_add(((gu32*)(ws + WS_CTL)) + CW_MOECNT + 64 * e1, 1u, RLX_AGENT);
                ((int*)(ws + WS_TOK))[e0 * NLAT + p0] = r; ((int*)(ws + WS_TOK))[e1 * NLAT + p1] = r;
                unsigned* rt = ((unsigned*)(ws + WS_ROUTE)) + (size_t)r * 8; rt[0] = e0; rt[1] = p0; rt[2] = __float_as_uint(w0); rt[3] = e1; rt[4] = p1; rt[5] = __float_as_uint(w1);
            }
        }
    }
}
__device__ __forceinline__ void moe_prefix(unsigned char* ws, unsigned (&cnt)[8], int (&pp)[9]) {
    pp[0] = 0;
#pragma unroll
    for (int e = 0; e < 8; ++e) { cnt[e] = __hip_atomic_load(((gu32*)(ws + WS_CTL)) + CW_MOECNT + 64 * e, RLX_AGENT); pp[e + 1] = pp[e] + (int)((cnt[e] + 255u) >> 8); }
}
__device__ __forceinline__ void moe_gather(Frame& F) {
    unsigned char* const ws = PWS();
    const int gw = F.vcu * NWAVES + F.wave, NGW = F.G * NWAVES;
    unsigned cnt[8]; int pp[9]; moe_prefix(ws, cnt, pp);
    for (int s = gw; s < pp[8] * 256; s += NGW) {
        const int p = s >> 8; int e = 0, base = 0; unsigned ce = cnt[0];
#pragma unroll
        for (int k = 1; k < 8; ++k) if (p >= pp[k]) { e = k; base = pp[k]; ce = cnt[k]; }
        const unsigned pos = (unsigned)(s - base * 256);
        GAS v4u* dst = (GAS v4u*)(((bf16*)(ws + WS_GLA)) + (size_t)s * D) + F.lane;
        if (pos < ce) { const int tkn = ((int*)(ws + WS_TOK))[e * NLAT + pos]; const GAS v4u* src = (const GAS v4u*)(((bf16*)(ws + WS_H)) + (size_t)tkn * D) + F.lane;
#pragma unroll
            for (int j = 0; j < 4; ++j) dst[64 * j] = src[64 * j]; }
        else {
#pragma unroll
            for (int j = 0; j < 4; ++j) dst[64 * j] = (v4u){0u, 0u, 0u, 0u}; }
    }
}
__device__ __forceinline__ void ln2_dense(Frame& F, int L) {
    unsigned char* const ws = PWS(); const float* const lng = PIN(21) + L * D; const float* const lnb = PIN(22) + L * D;
    const int gw = F.vcu * NWAVES + F.wave, NGW = F.G * NWAVES;
    for (int r = gw; r < MROWS; r += NGW) {
        f32x4 v[8]; load_row(((float*)(ws + WS_PRE)) + (size_t)r * D, F.lane, v);
        layer_norm_row(v, lng, lnb, F.lane);
        store_row(((float*)(ws + WS_XL)) + (size_t)r * D, F.lane, v);
        const float* m = ((float*)(ws + WS_MOD)) + ((size_t)(L + 1) * 3 + row_group(r)) * 12288;
        modulate(v, m, m + D, F.lane); emit_h_lr(F, ws, v, r, L + 1);
    }
}
__device__ __forceinline__ void ln2_moe(Frame& F, int L) {
    unsigned char* const ws = PWS(); const float* const lng = PIN(21) + L * D; const float* const lnb = PIN(22) + L * D; float* const outp = POUT();
    const int gw = F.vcu * NWAVES + F.wave, NGW = F.G * NWAVES;
    unsigned cnt[8]; int pp[9]; moe_prefix(ws, cnt, pp);
    for (int r = gw; r < NLAT; r += NGW) {
        const unsigned* rt = ((unsigned*)(ws + WS_ROUTE)) + (size_t)r * 8; const int e0 = rt[0], e1 = rt[3]; const float w0 = __uint_as_float(rt[2]), w1 = __uint_as_float(rt[5]);
        int b0 = 0, b1 = 0;
#pragma unroll
        for (int k = 1; k < 8; ++k) { if (e0 >= k) b0 = pp[k]; if (e1 >= k) b1 = pp[k]; }
        const size_t s0 = (size_t)b0 * 256 + rt[1], s1 = (size_t)b1 * 256 + rt[4];
        f32x4 v[8], y0[8], y1[8]; load_row(((float*)(ws + WS_XL)) + (size_t)r * D, F.lane, v); load_row(((float*)(ws + WS_Z)) + s0 * D, F.lane, y0); load_row(((float*)(ws + WS_Z)) + s1 * D, F.lane, y1);
        const float* g2 = ((float*)(ws + WS_MOD)) + ((size_t)L * 3 + row_group(r)) * 12288 + 5 * D;
#pragma unroll
        for (int j = 0; j < 8; ++j) { const f32x4 g4 = *(const f32x4*)(g2 + 4 * F.lane + 256 * j); v[j] = v[j] * ALPHA + g4 * (y0[j] * w0 + y1[j] * w1); }
        layer_norm_row(v, lng, lnb, F.lane);
        store_row(outp + (size_t)r * D, F.lane, v);
    }
}
#ifndef MK_ONE_LAUNCH
#define MK_ONE_LAUNCH 0
#endif
constexpr int PH_PER_LAYER = 11, NPH = 2 + DEPTH * PH_PER_LAYER;
enum { PL_WIN = 0, PL_MIXA, PL_MIXB, PL_MIXC, PL_BR, PL_WOUT, PL_LN1, PL_GATHER, PL_FFN1, PL_FFN2, PL_LN2 };
__device__ __forceinline__ bool in_range(int lo, int hi, int k) { asm volatile("" : "+s"(lo), "+s"(hi)); return lo <= k && k < hi; }
__global__ void __launch_bounds__(NTHR, 2) fwd_kernel(Args A) {
    __shared__ __attribute__((aligned(16))) unsigned char lds[LDS_BYTES];
    LAS unsigned char* const ldsb = (LAS unsigned char*)lds;
    { Frame F = mkframe(ldsb, A.grid);
    for (int u = F.tid; u < (LDS_BYTES - LDSCTL_OFF) / 4; u += NTHR) ((LAS unsigned*)(F.lds + LDSCTL_OFF))[u] = 0u;
    __syncthreads();
    if (F.tid < 32) { const unsigned long long p = F.tid < 30 ? (unsigned long long)A.in[F.tid] : (F.tid == 30 ? (unsigned long long)A.out : (unsigned long long)A.ws);
        ((LAS unsigned long long*)(F.lds + PTAB_OFF))[F.tid] = p; }
    __syncthreads(); }
#if MK_ONE_LAUNCH
    XcdBarrier bar; { Frame F = mkframe(ldsb, A.grid); bar = xcd_barrier_post((unsigned*)(PWS() + WS_CTL) + CW_BAR, F.MISC + 8, (unsigned)A.grid); }
#define GRID_BAR() xcd_barrier(bar)
#else
#define GRID_BAR() do { if (F.tid == 0) __hip_atomic_store((gu32*)(PWS() + WS_CTL) + CW_TMO, 0xBADBA0u, RLX_AGENT); } while (0)
#endif
    const int lo = A.ph_lo, hi = A.ph_hi;
#ifndef PHMASK
#define PHMASK 0xFFFFFFFFu
#endif
#define IN(k) in_range(lo, hi, (k))
#define EN(bit) ((PHMASK >> (bit)) & 1u)
#define SEAM(k) do { if (IN((k) + 1)) GRID_BAR(); } while (0)
    LAS unsigned char* const ring = ldsb + RING_OFF;

    if (EN(0) && IN(0)) { Frame F = mkframe(ldsb, A.grid); p0a_prologue(F); SEAM(0); }
    if (EN(1) && IN(1)) { Frame F = mkframe(ldsb, A.grid); p0b_modulate(F); SEAM(1); }
    for (int L = 0; L < DEPTH; ++L) {
        const int pb = 2 + PH_PER_LAYER * L, Mr = (L == 0) ? MROWS : NLAT;
        if (EN(2) && IN(pb + PL_WIN)) { Frame F = mkframe(ldsb, A.grid);
            unsigned char* const ws = PWS();
            pg8::Gemm g{((bf16*)(ws + WS_H)), w_in_t(ws, L), MROWS, NU, D}; pg8::StaticOrder S; S.init(MROWS, NU, F.G, F.bx);
            pg8::EpiBf16Plain E{((bf16*)(ws + WS_U)), NU};
            pg8::gemm_phase<pg8::EpiBf16Plain, pg8::StaticOrder, true, true>(ring, g, S, E);
            SEAM(pb + PL_WIN);
        }
        if (EN(3) && IN(pb + PL_MIXA)) { Frame F = mkframe(ldsb, A.grid); mix_prep(F, L); SEAM(pb + PL_MIXA); }
        if (EN(4) && IN(pb + PL_MIXB)) { Frame F = mkframe(ldsb, A.grid); if (F.bx < 8) gla_naive(F); else na_naive(F, L); SEAM(pb + PL_MIXB); }
        if (EN(5) && IN(pb + PL_MIXC)) { Frame F = mkframe(ldsb, A.grid); gla_out(F, L); SEAM(pb + PL_MIXC); }
        if (EN(6) && IN(pb + PL_BR)) { Frame F = mkframe(ldsb, A.grid);
            unsigned char* const ws = PWS(); const float* const gate_b = PIN(17) + (size_t)L * 3 * D;
            for (int b = 0; b < 3; ++b) {
                pg8::Gemm g{b == 0 ? ((bf16*)(ws + WS_Y)) : (b == 1 ? ((bf16*)(ws + WS_Y + (size_t)MROWS * 1024 * 2)) : ((bf16*)(ws + WS_Y + (size_t)MROWS * 2048 * 2))), w_br_t(ws, L, b), Mr, D, 1024}; pg8::StaticOrder S; S.init(Mr, D, F.G, F.bx);
                pg8::EpiGate E{((bf16*)(ws + WS_U)) + U_GATE + b * D, NU, gate_b + b * D, ((float*)(ws + WS_Z)), ((bf16*)(ws + WS_ZB)), b == 0, b == 2};
                pg8::gemm_phase<pg8::EpiGate, pg8::StaticOrder, true, true>(ring, g, S, E);
            }
            SEAM(pb + PL_BR);
        }
        if (EN(7) && IN(pb + PL_WOUT)) { Frame F = mkframe(ldsb, A.grid);
            unsigned char* const ws = PWS(); const float* const modL = ((float*)(ws + WS_MOD)) + (size_t)L * 3 * 12288; const float* const xin = PIN(0); const float* const cin = PIN(2);
            pg8::Gemm g{((bf16*)(ws + WS_ZB)), w_out_t(ws, L), Mr, D, D}; pg8::StaticOrder S; S.init(Mr, D, F.G, F.bx);
            pg8::EpiRes E{L == 0 ? xin : ((float*)(ws + WS_XL)), L == 0 ? cin : ((float*)(ws + WS_XL)) + (size_t)NLAT * D, modL + 2 * D, 12288, ((float*)(ws + WS_PRE)), ALPHA};
            pg8::gemm_phase<pg8::EpiRes, pg8::StaticOrder, true, true>(ring, g, S, E);
            SEAM(pb + PL_WOUT);
        }
        if (EN(8) && IN(pb + PL_LN1)) { Frame F = mkframe(ldsb, A.grid); ln1_phase(F, L, Mr); SEAM(pb + PL_LN1); }
        if (L == 0) {
            if (EN(10) && IN(pb + PL_FFN1)) { Frame F = mkframe(ldsb, A.grid);
                unsigned char* const ws = PWS();
                pg8::Gemm g{((bf16*)(ws + WS_H)), w_gu_t(ws, -1), MROWS, NGU, D}; pg8::StaticOrder S; S.init(MROWS, NGU, F.G, F.bx);
                pg8::EpiSwiGLU E{((bf16*)(ws + WS_U)), FF};
                pg8::gemm_phase<pg8::EpiSwiGLU, pg8::StaticOrder, true, true>(ring, g, S, E);
                SEAM(pb + PL_FFN1);
            }
            if (EN(11) && IN(pb + PL_FFN2)) { Frame F = mkframe(ldsb, A.grid);
                unsigned char* const ws = PWS(); const float* const modL = ((float*)(ws + WS_MOD)) + (size_t)L * 3 * 12288;
                pg8::Gemm g{((bf16*)(ws + WS_U)), w_d_t(ws, -1), MROWS, D, FF}; pg8::StaticOrder S; S.init(MROWS, D, F.G, F.bx);
                pg8::EpiRes E{((float*)(ws + WS_XL)), ((float*)(ws + WS_XL)) + (size_t)NLAT * D, modL + 5 * D, 12288, ((float*)(ws + WS_PRE)), ALPHA};
                pg8::gemm_phase<pg8::EpiRes, pg8::StaticOrder, true, true>(ring, g, S, E);
                SEAM(pb + PL_FFN2);
            }
            if (EN(12) && IN(pb + PL_LN2)) { Frame F = mkframe(ldsb, A.grid); ln2_dense(F, L); SEAM(pb + PL_LN2); }
        } else {
            if (EN(9) && IN(pb + PL_GATHER)) { Frame F = mkframe(ldsb, A.grid); moe_gather(F); SEAM(pb + PL_GATHER); }
            if (EN(10) && IN(pb + PL_FFN1)) { Frame F = mkframe(ldsb, A.grid);
                unsigned char* const ws = PWS();
                unsigned cnt[8]; int pp[9]; moe_prefix(ws, cnt, pp);
                pg8::Gemm g{((bf16*)(ws + WS_GLA)), w_gu_t(ws, 0), 0, NGU, D}; pg8::MoeOrder S; S.init(cnt, NGU / 256, F.G, F.bx);
                pg8::EpiSwiGLU E{((bf16*)(ws + WS_U)), FF};
                pg8::gemm_phase<pg8::EpiSwiGLU, pg8::MoeOrder, true, true>(ring, g, S, E);
                SEAM(pb + PL_FFN1);
            }
            if (EN(11) && IN(pb + PL_FFN2)) { Frame F = mkframe(ldsb, A.grid);
                unsigned char* const ws = PWS(); const float* const modL = ((float*)(ws + WS_MOD)) + (size_t)L * 3 * 12288;
                unsigned cnt[8]; int pp[9]; moe_prefix(ws, cnt, pp);
                pg8::Gemm g{((bf16*)(ws + WS_U)), w_d_t(ws, 0), 0, D, FF}; pg8::MoeOrder S; S.init(cnt, D / 256, F.G, F.bx);
                pg8::EpiF32Plain E{((float*)(ws + WS_Z)), D};
                pg8::gemm_phase<pg8::EpiF32Plain, pg8::MoeOrder, true, true>(ring, g, S, E);
                SEAM(pb + PL_FFN2);
            }
            if (EN(12) && IN(pb + PL_LN2)) { Frame F = mkframe(ldsb, A.grid); ln2_moe(F, L); }
        }
    }
#undef IN
#undef SEAM
}

extern "C" void kernel_launch(void* const* d_in, const int* in_sizes, int n_in, void* d_out, int out_size, void* d_ws, size_t ws_size, hipStream_t stream) {
    static int grid = 0;
    if (grid == 0) {
        if (n_in != 30 || out_size != NLAT * D || ws_size < WS_END) { fprintf(stderr, "kernel_launch: unexpected shapes (n_in %d out %d ws %zu); nothing launched\n", n_in, out_size, ws_size); grid = -1; return; }
        int dev = 0, cus = 0, per_cu = 0;
        if (hipGetDevice(&dev) != hipSuccess || hipDeviceGetAttribute(&cus, hipDeviceAttributeMultiprocessorCount, dev) != hipSuccess) { grid = -1; return; }
        if (hipOccupancyMaxActiveBlocksPerMultiprocessor(&per_cu, (const void*)fwd_kernel, NTHR, 0) != hipSuccess || per_cu < 1) { fprintf(stderr, "kernel_launch: occupancy query says %d\n", per_cu); (void)hipGetLastError(); grid = -1; return; }
        grid = cus;
    }
    if (grid < 0) return;
    (void)hipMemsetAsync((char*)d_ws + WS_CTL, 0, CTL_ZERO_BYTES, stream);
    Args a{};
    for (int i = 0; i < 30; ++i) a.in[i] = (const float*)d_in[i];
    a.out = (float*)d_out; a.ws = (unsigned char*)d_ws; a.grid = grid;
#if MK_ONE_LAUNCH
    a.ph_lo = 0; a.ph_hi = NPH;
    hipLaunchKernelGGL(fwd_kernel, dim3(grid), dim3(NTHR), 0, stream, a);
#else
#ifndef NPH_RUN
#define NPH_RUN NPH
#endif
    for (int p = 0; p < NPH_RUN; ++p) {
        if (p == 2 + PL_GATHER) continue;
        a.ph_lo = p; a.ph_hi = p + 1;
        hipLaunchKernelGGL(fwd_kernel, dim3(grid), dim3(NTHR), 0, stream, a);
    }
#endif
}
```

```cpp
#define MK_ONE_LAUNCH 1
#include <hip/hip_runtime.h>
#include <cstdio>

namespace pg8 {
#define PG8_LAS __attribute__((address_space(3)))
typedef unsigned short bf16_t;
typedef short bf16x8 __attribute__((ext_vector_type(8)));
typedef float f32x4 __attribute__((ext_vector_type(4)));
typedef unsigned u32x4 __attribute__((ext_vector_type(4)));
typedef unsigned u32x2 __attribute__((ext_vector_type(2)));
constexpr int BM = 256, BK = 64, HALF = 128, HTB = HALF * BK * 2  , STAGE_BYTES = 8 * HTB, NXCD = 8, WGM = 8;

__host__ __device__ __forceinline__ int lds_byte(int r, int c) { const int st = (r >> 4) * 2 + (c >> 5), rr = r & 15, cc = c & 31, ob = rr * 64 + cc * 2; return st * 1024 + (ob ^ (((ob >> 9) & 1) << 5)); }
__host__ __device__ __forceinline__ void stage_rc(int b, int& R, int& C) { const int st = b / 1024, sb = b % 1024, swz = sb ^ (((sb >> 9) & 1) << 5); R = (st >> 1) * 16 + swz / 64; C = (st & 1) * 32 + (swz % 64) / 2; }
__host__ __device__ __forceinline__ int perm32(int rho) { const int n = rho >> 4, i = rho & 15; return 8 * (i >> 2) + 4 * n + (i & 3); }

struct Unit { int pm, pn, pb; };
struct Gemm { const bf16_t* A; const bf16_t* Bt; int M, N, K; };

__device__ __forceinline__ int xcd_remap(int wgid, int nwg) { const int q = nwg / NXCD, r = nwg % NXCD, xcd = wgid % NXCD, off = wgid / NXCD; return (xcd < r ? xcd * (q + 1) : r * (q + 1) + (xcd - r) * q) + off; }
struct StaticOrder {
    int nM, nN, nwg, G, c;
    __host__ __device__ void init(int M, int N, int G_, int c_) { nM = M / BM; nN = N / BM; nwg = nM * nN; G = G_; c = c_; }
    __device__ __forceinline__ bool next(int i, Unit& u) const {
        const long L = (long)i * G + c; if (L >= nwg) return false;
        const int wgid = xcd_remap((int)L, nwg);
        const int nig = WGM * nN, gid = wgid / nig, fm = gid * WGM, gsz = (nM - fm) < WGM ? (nM - fm) : WGM;
        u.pm = fm + ((wgid % nig) % gsz); u.pn = (wgid % nig) / gsz; u.pb = u.pn; return true;
    }
    __device__ __forceinline__ void a_ready(const Unit&) const {}
    __device__ __forceinline__ void done(const Unit&) const {}
};
struct MoeOrder {
    int nN, G, c, nunits; int pp[9];
    __device__ __forceinline__ void init(const unsigned* cnt, int nN_, int G_, int c_) { nN = nN_; G = G_; c = c_; pp[0] = 0;
#pragma unroll
        for (int e = 0; e < 8; ++e) pp[e + 1] = pp[e] + (int)((cnt[e] + 255u) >> 8);
        nunits = pp[8] * nN; }
    __device__ __forceinline__ bool next(int i, Unit& u) const {
        const long L = (long)i * G + c; if (L >= nunits) return false;
        const int wgid = xcd_remap((int)L, nunits);
        int e = 0, base = 0, npe = pp[1];
#pragma unroll
        for (int k = 1; k < 8; ++k) { if (wgid >= pp[k] * nN) { e = k; base = pp[k]; npe = pp[k + 1] - pp[k]; } }
        if (npe < 1) npe = 1;
        const int local = wgid - base * nN;
        u.pm = base + local % npe; u.pn = local / npe; u.pb = e * nN + u.pn; return true;
    }
    __device__ __forceinline__ void a_ready(const Unit&) const {}
    __device__ __forceinline__ void done(const Unit&) const {}
};

__device__ __forceinline__ unsigned cvt_pk_bf16(float lo, float hi) { unsigned r; asm volatile("v_cvt_pk_bf16_f32 %0, %1, %2" : "=v"(r) : "v"(lo), "v"(hi)); return r; }
__device__ __forceinline__ float bf_lo(unsigned w) { return __uint_as_float(w << 16); }
__device__ __forceinline__ float bf_hi(unsigned w) { return __uint_as_float(w & 0xffff0000u); }
__device__ __forceinline__ float fast_sigmoid(float x) { return __builtin_amdgcn_rcpf(1.0f + __expf(-x)); }

struct EpiBf16Plain {
    static constexpr bool PERM = true, AFTER_DRAIN = false;
    bf16_t* O; int ldc;
    __device__ __forceinline__ void operator()(const f32x4 (&acc)[2][2][4][2], const Unit& u, int wr, int wc, int fr, int fq) const {
        const int row0 = u.pm * BM + wr * 64 + fr, col0 = u.pn * BM + wc * 32 + 8 * fq;
#pragma unroll
        for (int ai = 0; ai < 2; ++ai)
#pragma unroll
            for (int m = 0; m < 4; ++m) { bf16_t* rowp = O + (size_t)(row0 + ai * HALF + m * 16) * ldc + col0;
#pragma unroll
                for (int bj = 0; bj < 2; ++bj) { const f32x4 v0 = acc[ai][bj][m][0], v1 = acc[ai][bj][m][1];
                    u32x4 w; w.x = cvt_pk_bf16(v0[0], v0[1]); w.y = cvt_pk_bf16(v0[2], v0[3]); w.z = cvt_pk_bf16(v1[0], v1[1]); w.w = cvt_pk_bf16(v1[2], v1[3]);
                    *(u32x4*)(rowp + bj * HALF) = w; } }
    }
};
struct EpiU {
    static constexpr bool PERM = true, AFTER_DRAIN = false;
    bf16_t* O; int ldc;
    __device__ __forceinline__ void operator()(const f32x4 (&acc)[2][2][4][2], const Unit& u, int wr, int wc, int fr, int fq) const {
        const int row0 = u.pm * BM + wr * 64 + fr, col0 = u.pn * BM + wc * 32 + 8 * fq;
        const bool is_gq = (u.pn == 12 || u.pn == 13), is_gk = (u.pn == 14 || u.pn == 15), is_nq = (u.pn >= 24 && u.pn < 28);
        const float sc = (is_gq || is_nq) ? 0.08838834764831845f : 1.0f;
        const bool rope = (is_gq || is_gk) && u.pm < 32;
        float inv[4];
#pragma unroll
        for (int j = 0; j < 4; ++j) inv[j] = exp2f(-(float)((16 * wc + 4 * fq + j) & 31) * 0.41524101186092029f);
#pragma unroll
        for (int ai = 0; ai < 2; ++ai)
#pragma unroll
            for (int m = 0; m < 4; ++m) { const int row = row0 + ai * HALF + m * 16; bf16_t* rowp = O + (size_t)row * ldc + col0;
                const int t = row & 4095; const float pos = (wc < 2) ? (float)(t >> 6) : (float)(t & 63);
                float cs[4], sn[4];
                if (rope) {
#pragma unroll
                    for (int j = 0; j < 4; ++j) { const float ang = pos * inv[j]; cs[j] = __cosf(ang); sn[j] = __sinf(ang); } }
#pragma unroll
                for (int bj = 0; bj < 2; ++bj) { f32x4 v0 = acc[ai][bj][m][0] * sc, v1 = acc[ai][bj][m][1] * sc;
                    if (rope) { const f32x4 a = v0, b = v1;
                        v0[0] = a[0] * cs[0] - a[1] * sn[0]; v0[1] = a[0] * sn[0] + a[1] * cs[0]; v0[2] = a[2] * cs[1] - a[3] * sn[1]; v0[3] = a[2] * sn[1] + a[3] * cs[1];
                        v1[0] = b[0] * cs[2] - b[1] * sn[2]; v1[1] = b[0] * sn[2] + b[1] * cs[2]; v1[2] = b[2] * cs[3] - b[3] * sn[3]; v1[3] = b[2] * sn[3] + b[3] * cs[3]; }
                    u32x4 w; w.x = cvt_pk_bf16(v0[0], v0[1]); w.y = cvt_pk_bf16(v0[2], v0[3]); w.z = cvt_pk_bf16(v1[0], v1[1]); w.w = cvt_pk_bf16(v1[2], v1[3]);
                    *(u32x4*)(rowp + bj * HALF) = w; } }
    }
};
struct EpiF32Plain {
    static constexpr bool PERM = false, AFTER_DRAIN = false;
    float* C; int ldc;
    __device__ __forceinline__ void operator()(const f32x4 (&acc)[2][2][4][2], const Unit& u, int wr, int wc, int fr, int fq) const {
        const int row0 = u.pm * BM + wr * 64 + fr, col0 = u.pn * BM + wc * 32 + 4 * fq;
#pragma unroll
        for (int ai = 0; ai < 2; ++ai)
#pragma unroll
            for (int m = 0; m < 4; ++m) { float* rowp = C + (size_t)(row0 + ai * HALF + m * 16) * ldc + col0;
#pragma unroll
                for (int bj = 0; bj < 2; ++bj)
#pragma unroll
                    for (int n = 0; n < 2; ++n) *(f32x4*)(rowp + bj * HALF + n * 16) = acc[ai][bj][m][n]; }
    }
};
struct EpiGate {
    static constexpr bool PERM = false, AFTER_DRAIN = false;
    const bf16_t* Ug; int ldu;
    const float* gb;
    float* Z; bf16_t* ZB; int first, last;
    __device__ __forceinline__ void operator()(const f32x4 (&acc)[2][2][4][2], const Unit& u, int wr, int wc, int fr, int fq) const {
        const int row0 = u.pm * BM + wr * 64 + fr, col0 = u.pn * BM + wc * 32 + 4 * fq;
#pragma unroll
        for (int ai = 0; ai < 2; ++ai)
#pragma unroll
            for (int m = 0; m < 4; ++m) { const size_t row = (size_t)(row0 + ai * HALF + m * 16);
#pragma unroll
                for (int bj = 0; bj < 2; ++bj)
#pragma unroll
                    for (int n = 0; n < 2; ++n) { const int col = col0 + bj * HALF + n * 16;
                        const u32x2 gl = *(const u32x2*)(Ug + row * ldu + col); const f32x4 b4 = *(const f32x4*)(gb + col);
                        f32x4 v = acc[ai][bj][m][n];
                        v[0] *= fast_sigmoid(bf_lo(gl.x) + b4[0]); v[1] *= fast_sigmoid(bf_hi(gl.x) + b4[1]); v[2] *= fast_sigmoid(bf_lo(gl.y) + b4[2]); v[3] *= fast_sigmoid(bf_hi(gl.y) + b4[3]);
                        if (!first) v += *(const f32x4*)(Z + row * 2048 + col);
                        if (!last) *(f32x4*)(Z + row * 2048 + col) = v;
                        else { u32x2 w; w.x = cvt_pk_bf16(v[0], v[1]); w.y = cvt_pk_bf16(v[2], v[3]); *(u32x2*)(ZB + row * 2048 + col) = w; } } }
    }
};
struct EpiRes {
    static constexpr bool PERM = false, AFTER_DRAIN = false;
    const float* res_lat; const float* res_ctx; const float* gv; int gstride; float* out; float alpha;
    __device__ __forceinline__ void operator()(const f32x4 (&acc)[2][2][4][2], const Unit& u, int wr, int wc, int fr, int fq) const {
        const int grp = u.pm < 16 ? 0 : (u.pm < 32 ? 1 : 2);
        const float* res = u.pm < 32 ? res_lat + (size_t)u.pm * BM * 2048 : res_ctx + (size_t)(u.pm - 32) * BM * 2048;
        const float* g = gv + (size_t)grp * gstride;
        const int rl0 = wr * 64 + fr, col0 = u.pn * BM + wc * 32 + 4 * fq;
#pragma unroll
        for (int ai = 0; ai < 2; ++ai)
#pragma unroll
            for (int m = 0; m < 4; ++m) { const int rl = rl0 + ai * HALF + m * 16;
#pragma unroll
                for (int bj = 0; bj < 2; ++bj)
#pragma unroll
                    for (int n = 0; n < 2; ++n) { const int col = col0 + bj * HALF + n * 16;
                        const f32x4 r4 = *(const f32x4*)(res + (size_t)rl * 2048 + col); const f32x4 g4 = *(const f32x4*)(g + col);
                        *(f32x4*)(out + ((size_t)u.pm * BM + rl) * 2048 + col) = r4 * alpha + g4 * acc[ai][bj][m][n]; } }
    }
};
struct EpiSwiGLU {
    static constexpr bool PERM = true, AFTER_DRAIN = false;
    bf16_t* O; int ldc;
    __device__ __forceinline__ void operator()(const f32x4 (&acc)[2][2][4][2], const Unit& u, int wr, int wc, int fr, int fq) const {
        const int row0 = u.pm * BM + wr * 64 + fr, col0 = u.pn * HALF + wc * 32 + 8 * fq;
#pragma unroll
        for (int ai = 0; ai < 2; ++ai)
#pragma unroll
            for (int m = 0; m < 4; ++m) { bf16_t* rowp = O + (size_t)(row0 + ai * HALF + m * 16) * ldc + col0;
                float h[8];
#pragma unroll
                for (int n = 0; n < 2; ++n)
#pragma unroll
                    for (int j = 0; j < 4; ++j) { const float gt = acc[ai][0][m][n][j], up = acc[ai][1][m][n][j]; h[n * 4 + j] = gt * fast_sigmoid(gt) * up; }
                u32x4 w; w.x = cvt_pk_bf16(h[0], h[1]); w.y = cvt_pk_bf16(h[2], h[3]); w.z = cvt_pk_bf16(h[4], h[5]); w.w = cvt_pk_bf16(h[6], h[7]);
                *(u32x4*)rowp = w; }
    }
};

template <class Epi, class Sched, bool ALIGN_EPI = false, bool SP2 = false>
__device__ __forceinline__ void gemm_phase(PG8_LAS unsigned char* lds, const Gemm g, const Sched& S, const Epi& E) {
    int tid_ = threadIdx.x; asm volatile("" : "+v"(tid_));
    const int tid = tid_, wid = __builtin_amdgcn_readfirstlane(tid >> 6), lane = tid & 63, wr = wid >> 2, wc = wid & 3, fr = lane & 15, fq = lane >> 4;
    const int K = g.K, nt = K / BK;
    unsigned voffA[2], voffB[2];
#pragma unroll
    for (int i = 0; i < 2; ++i) { int R, C; stage_rc(tid * 16 + i * 8192, R, C); const int Rb = Epi::PERM ? ((R & ~31) + perm32(R & 31)) : R;
        voffA[i] = (unsigned)(R * K + C) * 2u; voffB[i] = (unsigned)(Rb * K + C) * 2u; }
    const size_t kstep = (size_t)(BK * 2);
    const size_t hstep = (size_t)HALF * K * 2;
    const size_t tstep = 2 * hstep;
    const unsigned ldsw = (unsigned)wid * 1024u;
    const int aoff = lds_byte(wr * 64 + fr, fq * 8), boff = lds_byte(wc * 32 + fr, fq * 8);
#define PG8_SA(b, h) (((b) * 2 + (h)) * HTB)
#define PG8_SB(b, h) ((4 + (b) * 2 + (h)) * HTB)
#define PG8_STAGE(bufoff, gbase, voff) do { _Pragma("unroll") for (int _i = 0; _i < 2; ++_i) \
        __builtin_amdgcn_global_load_lds((const unsigned*)((const char*)(gbase) + (voff)[_i]), (PG8_LAS unsigned*)(lds + (bufoff) + ldsw + _i * 8192), 16, 0, 0); } while (0)
#define PG8_LDA(dst, b, h) do { _Pragma("unroll") for (int m = 0; m < 4; ++m) _Pragma("unroll") for (int k = 0; k < 2; ++k) dst[m][k] = *(const PG8_LAS bf16x8*)(lds + PG8_SA(b, h) + aoff + m * 2048 + k * 1024); } while (0)
#define PG8_LDB(dst, b, h) do { _Pragma("unroll") for (int n = 0; n < 2; ++n) _Pragma("unroll") for (int k = 0; k < 2; ++k) dst[n][k] = *(const PG8_LAS bf16x8*)(lds + PG8_SB(b, h) + boff + n * 2048 + k * 1024); } while (0)
#define PG8_MMA(ai, bj, At, Bt) do { __builtin_amdgcn_s_setprio(1); _Pragma("unroll") for (int m = 0; m < 4; ++m) _Pragma("unroll") for (int n = 0; n < 2; ++n) _Pragma("unroll") for (int k = 0; k < 2; ++k) \
        acc[ai][bj][m][n] = __builtin_amdgcn_mfma_f32_16x16x32_bf16(Bt[n][k], At[m][k], acc[ai][bj][m][n], 0, 0, 0); __builtin_amdgcn_s_setprio(0); } while (0)
#define PG8_WAIT_V(n) asm volatile("s_waitcnt vmcnt(" #n ")" ::: "memory")
#define PG8_WAIT_L(n) asm volatile("s_waitcnt lgkmcnt(" #n ")" ::: "memory")
#define PG8_BAR __builtin_amdgcn_s_barrier()
#define PG8_SCHED __builtin_amdgcn_sched_barrier(0)
    Unit cur, nxt; int ui = 0;
    if (!S.next(0, cur)) return;
    f32x4 acc[2][2][4][2];
#pragma unroll
    for (int a = 0; a < 2; ++a)
#pragma unroll
        for (int b = 0; b < 2; ++b)
#pragma unroll
            for (int m = 0; m < 4; ++m)
#pragma unroll
                for (int n = 0; n < 2; ++n) acc[a][b][m][n] = (f32x4){0.f, 0.f, 0.f, 0.f};
    bf16x8 At[4][2], B0[2][2], B1[2][2];
    const char* cA = (const char*)g.A + (size_t)cur.pm * tstep; const char* cB = (const char*)g.Bt + (size_t)cur.pb * tstep;
    S.a_ready(cur);
    if constexpr (SP2) {
        PG8_STAGE(PG8_SB(0, 0), cB, voffB); PG8_STAGE(PG8_SB(0, 1), cB + hstep, voffB); PG8_STAGE(PG8_SA(0, 0), cA, voffA); PG8_STAGE(PG8_SA(0, 1), cA + hstep, voffA);
        if (wr == 1) PG8_BAR;
        PG8_WAIT_V(2); PG8_BAR;
        PG8_STAGE(PG8_SB(1, 0), cB + kstep, voffB); PG8_STAGE(PG8_SA(1, 0), cA + kstep, voffA); PG8_STAGE(PG8_SB(1, 1), cB + hstep + kstep, voffB);
        PG8_WAIT_V(6); PG8_BAR;
    } else {
        PG8_STAGE(PG8_SB(0, 0), cB, voffB); PG8_STAGE(PG8_SA(0, 0), cA, voffA); PG8_STAGE(PG8_SB(0, 1), cB + hstep, voffB); PG8_STAGE(PG8_SA(0, 1), cA + hstep, voffA);
        if (wr == 1) PG8_BAR;
        PG8_WAIT_V(4); PG8_BAR;
        PG8_STAGE(PG8_SB(1, 0), cB + kstep, voffB); PG8_STAGE(PG8_SA(1, 0), cA + kstep, voffA); PG8_STAGE(PG8_SB(1, 1), cB + hstep + kstep, voffB);
        PG8_WAIT_V(6); PG8_BAR;
    }
    for (;;) {
        const bool has_next = S.next(ui + 1, nxt);
        const char* nA = has_next ? (const char*)g.A + (size_t)nxt.pm * tstep : cA; const char* nB = has_next ? (const char*)g.Bt + (size_t)nxt.pb * tstep : cB;
        for (int t = 0; t < nt; t += 2) {
            const bool last = (t == nt - 2);
            const char* a1 = cA + (size_t)(t + 1) * kstep;
            const char* a2 = last ? nA : cA + (size_t)(t + 2) * kstep; const char* b2 = last ? nB : cB + (size_t)(t + 2) * kstep;
            const char* a3 = a2 + kstep; const char* b3 = b2 + kstep;
            if (last && has_next) S.a_ready(nxt);
            if constexpr (SP2) {
            PG8_LDB(B0, 0, 0); PG8_LDB(B1, 0, 1); PG8_SCHED; PG8_LDA(At, 0, 0); PG8_STAGE(PG8_SA(1, 1), a1 + hstep, voffA);
            PG8_WAIT_V(8); PG8_WAIT_L(0); PG8_BAR; PG8_MMA(0, 0, At, B0); PG8_MMA(0, 1, At, B1); PG8_BAR; PG8_SCHED;
            PG8_LDA(At, 0, 1); PG8_STAGE(PG8_SB(0, 0), b2, voffB); PG8_STAGE(PG8_SB(0, 1), b2 + hstep, voffB); PG8_STAGE(PG8_SA(0, 0), a2, voffA);
            PG8_WAIT_V(8); PG8_WAIT_L(0); PG8_BAR; PG8_MMA(1, 0, At, B0); PG8_MMA(1, 1, At, B1); PG8_BAR; PG8_SCHED;
            PG8_LDB(B0, 1, 0); PG8_LDB(B1, 1, 1); PG8_SCHED; PG8_LDA(At, 1, 0); PG8_STAGE(PG8_SA(0, 1), a2 + hstep, voffA);
            PG8_WAIT_V(8); PG8_WAIT_L(0); PG8_BAR; PG8_MMA(0, 0, At, B0); PG8_MMA(0, 1, At, B1); PG8_BAR; PG8_SCHED;
            PG8_LDA(At, 1, 1); PG8_STAGE(PG8_SB(1, 0), b3, voffB); PG8_STAGE(PG8_SB(1, 1), b3 + hstep, voffB); PG8_STAGE(PG8_SA(1, 0), a3, voffA);
            PG8_WAIT_V(8); PG8_WAIT_L(0); PG8_BAR; PG8_MMA(1, 0, At, B0); PG8_MMA(1, 1, At, B1); PG8_BAR; PG8_SCHED;
            } else {
            PG8_LDB(B0, 0, 0); PG8_SCHED; PG8_LDA(At, 0, 0); PG8_STAGE(PG8_SA(1, 1), a1 + hstep, voffA);
            PG8_WAIT_L(8); PG8_BAR; PG8_WAIT_L(0); PG8_MMA(0, 0, At, B0); PG8_BAR; PG8_SCHED;
            PG8_LDB(B1, 0, 1); PG8_STAGE(PG8_SB(0, 0), b2, voffB);
            PG8_BAR; PG8_WAIT_L(0); PG8_MMA(0, 1, At, B1); PG8_BAR;
            PG8_LDA(At, 0, 1); PG8_STAGE(PG8_SA(0, 0), a2, voffA);
            PG8_BAR; PG8_WAIT_L(0); PG8_MMA(1, 0, At, B0); PG8_BAR; PG8_SCHED;
            PG8_STAGE(PG8_SB(0, 1), b2 + hstep, voffB);
            PG8_WAIT_V(6); PG8_BAR; PG8_MMA(1, 1, At, B1); PG8_BAR;
            PG8_LDB(B0, 1, 0); PG8_SCHED; PG8_LDA(At, 1, 0); PG8_STAGE(PG8_SA(0, 1), a2 + hstep, voffA);
            PG8_WAIT_L(8); PG8_BAR; PG8_WAIT_L(0); PG8_MMA(0, 0, At, B0); PG8_BAR; PG8_SCHED;
            PG8_LDB(B1, 1, 1); PG8_STAGE(PG8_SB(1, 0), b3, voffB);
            PG8_BAR; PG8_WAIT_L(0); PG8_MMA(0, 1, At, B1); PG8_BAR;
            PG8_LDA(At, 1, 1); PG8_STAGE(PG8_SA(1, 0), a3, voffA);
            PG8_BAR; PG8_WAIT_L(0); PG8_MMA(1, 0, At, B0); PG8_BAR; PG8_SCHED;
            PG8_STAGE(PG8_SB(1, 1), b3 + hstep, voffB);
            PG8_WAIT_V(6); PG8_BAR; PG8_MMA(1, 1, At, B1); PG8_BAR;
            }
        }
        if constexpr (ALIGN_EPI) { if (wr == 0) PG8_BAR; }
        if constexpr (!Epi::AFTER_DRAIN) { E(acc, cur, wr, wc, fr, fq); S.done(cur); }
        if (!has_next) break;
#pragma unroll
        for (int a = 0; a < 2; ++a)
#pragma unroll
            for (int b = 0; b < 2; ++b)
#pragma unroll
                for (int m = 0; m < 4; ++m)
#pragma unroll
                    for (int n = 0; n < 2; ++n) acc[a][b][m][n] = (f32x4){0.f, 0.f, 0.f, 0.f};
        cur = nxt; cA = nA; cB = nB; ++ui;
        if constexpr (ALIGN_EPI) { if (wr == 1) PG8_BAR; }
    }
    PG8_WAIT_V(0);
    if constexpr (!ALIGN_EPI) { if (wr == 0) PG8_BAR; }
    PG8_BAR;
    if constexpr (Epi::AFTER_DRAIN) { E.fused(acc, cur, wr, wc, fr, fq, lds, wid, lane); S.done(cur); }
#undef PG8_SA
#undef PG8_SB
#undef PG8_STAGE
#undef PG8_LDA
#undef PG8_LDB
#undef PG8_MMA
#undef PG8_WAIT_V
#undef PG8_WAIT_L
#undef PG8_BAR
#undef PG8_SCHED
}
}

constexpr int NWAVES = 8, NTHR = 512;
constexpr int D = 2048, SEQ = 4096, NLAT = 8192, CTXL = 256, NCTX = 512, MROWS = 8704, DEPTH = 2;
constexpr int INC = 15392, NU = 15360;
constexpr int U_CB = 0, U_CC = 1024, U_CX = 2048, U_GQ = 3072, U_GK = 3584, U_GV = 4096, U_GR = 5120, U_NQ = 6144, U_NK = 7168, U_NV = 8192, U_GATE = 9216;
constexpr int LR_COL = 6144;
constexpr int FF = 5632, NGU = 2 * FF, NE = 8;
constexpr float LN_EPS = 1e-5f, ALPHA = 1.41421356237f;
constexpr int MOE_MAXP = 72;

constexpr size_t MiB = 1u << 20;
constexpr size_t WS_CTL = 0, CTL_ZERO_BYTES = 1 * MiB;
constexpr size_t WS_MOD = 1 * MiB;
constexpr size_t WS_WLR = 1 * MiB + 512 * 1024;
constexpr size_t WS_ROUTE = 2 * MiB;
constexpr size_t WS_TOK = 2 * MiB + 256 * 1024;
constexpr size_t WS_LR = 3 * MiB;
constexpr size_t WS_W = 8 * MiB;
constexpr size_t W_IN_B = (size_t)NU * D * 2, W_BR_B = (size_t)1024 * D * 2, W_OUT_B = (size_t)D * D * 2, W_LAYER_B = W_IN_B + 3 * W_BR_B + W_OUT_B;
constexpr size_t W_GU_B = (size_t)NGU * D * 2, W_D_B = (size_t)D * FF * 2, W_FFN_B = W_GU_B + W_D_B;
constexpr size_t WS_WFFN = WS_W + 2 * W_LAYER_B, WS_WMOE = WS_WFFN + W_FFN_B, WS_WEND = WS_WMOE + 8 * W_FFN_B;
constexpr size_t WS_XL = 762 * MiB;
constexpr size_t WS_H = 830 * MiB;
constexpr size_t WS_U = 864 * MiB;
constexpr size_t WS_Y = 1119 * MiB;
constexpr size_t WS_GLA = 1170 * MiB;
constexpr size_t WS_Z = 1306 * MiB;
constexpr size_t WS_ZB = 1374 * MiB;
constexpr size_t WS_PRE = 1408 * MiB;
constexpr size_t WS_END = 1476 * MiB;
static_assert(WS_WEND <= WS_XL && WS_XL + (size_t)MROWS * D * 4 <= WS_H && WS_H + (size_t)MROWS * D * 2 <= WS_U && WS_U + (size_t)MROWS * NU * 2 <= WS_Y, "ws map 1");
static_assert(WS_U + (size_t)MOE_MAXP * 256 * FF * 2 <= WS_Y && WS_Y + 3 * (size_t)MROWS * 1024 * 2 <= WS_GLA && WS_GLA + (size_t)MROWS * (4 * 512 + 2 * 1024) * 4 <= WS_Z, "ws map 2");
static_assert(WS_GLA + (size_t)MOE_MAXP * 256 * D * 2 <= WS_Z && WS_Z + (size_t)MOE_MAXP * 256 * D * 4 <= WS_END && WS_PRE + (size_t)MROWS * D * 4 <= WS_END, "ws map 3");
constexpr int CW_TMO = 0, CW_CODE = 1;
constexpr int CW_MOECNT = 64;
constexpr int CW_BAR = 4096;

constexpr int RING_OFF = 0, RING_BYTES = 131072;
constexpr int LDSCTL_OFF = RING_BYTES, MISC_OFF = LDSCTL_OFF + 320;
constexpr int LDS_BYTES = 147456;

#define GAS __attribute__((address_space(1)))
#define LAS __attribute__((address_space(3)))
typedef unsigned short bf16;
typedef unsigned v4u __attribute__((ext_vector_type(4)));
typedef unsigned v2u __attribute__((ext_vector_type(2)));
typedef float f32x4 __attribute__((ext_vector_type(4)));
typedef GAS unsigned gu32;
#define RLX_AGENT __ATOMIC_RELAXED, __HIP_MEMORY_SCOPE_AGENT
#define LDS_WAIT() asm volatile("s_waitcnt lgkmcnt(0)" ::: "memory")
#define VM_WAIT() asm volatile("s_waitcnt vmcnt(0)" ::: "memory")
__device__ __forceinline__ unsigned f2bf(float f) { unsigned u = __builtin_bit_cast(unsigned, f); return (u + 0x7fffu + ((u >> 16) & 1u)) >> 16; }
__device__ __forceinline__ unsigned pk2(float lo, float hi) { return f2bf(lo) | (f2bf(hi) << 16); }
__device__ __forceinline__ float bflo(unsigned w) { return __uint_as_float(w << 16); }
__device__ __forceinline__ float bfhi(unsigned w) { return __uint_as_float(w & 0xffff0000u); }
__device__ __forceinline__ float bf1(bf16 b) { return __uint_as_float(((unsigned)b) << 16); }
__device__ __forceinline__ float wave_sum(float v) {
#pragma unroll
    for (int o = 1; o < 64; o <<= 1) v += __shfl_xor(v, o);
    return v;
}
__device__ __forceinline__ float wave_max(float v) {
#pragma unroll
    for (int o = 1; o < 64; o <<= 1) v = fmaxf(v, __shfl_xor(v, o));
    return v;
}

#define XB_TMO      128
#define XB_XCNT(j)  (256  + 64 * (j))
#define XB_XSUB(j)  (1280 + 64 * (j))
#define XB_XGEN(j)  (2304 + 64 * (j))
#define XB_TOP      3328
#define XB_TOPGEN   3392
#define XCD_BAR_WORDS 3456
#define XB_SPIN_CAP (1u << 18)

__device__ __forceinline__ unsigned xb_ld(unsigned* p)              { return __hip_atomic_load(p, __ATOMIC_RELAXED, __HIP_MEMORY_SCOPE_AGENT); }
__device__ __forceinline__ unsigned xb_add(unsigned* p, unsigned v) { return __hip_atomic_fetch_add(p, v, __ATOMIC_RELAXED, __HIP_MEMORY_SCOPE_AGENT); }
__device__ __forceinline__ unsigned xb_xcc_id() { return (unsigned)__builtin_amdgcn_s_getreg((3 << 11) | 20) & 0xFu; }
#define XB_SPIN(cond, bar) do { unsigned _sp = 0; while (cond) { __builtin_amdgcn_s_sleep(1); \
    if ((++_sp & 255u) == 0u) { if (xb_ld(&(bar)[XB_TMO])) break; if (_sp > XB_SPIN_CAP) { atomicAdd(&(bar)[XB_TMO], 1u); break; } } } } while (0)

struct XcdBarrier {
    unsigned* bar; unsigned x; unsigned grid;
    volatile LAS unsigned* st;
};

__device__ __forceinline__ XcdBarrier xcd_barrier_post(unsigned* bar, volatile LAS unsigned* st, unsigned grid) {
    XcdBarrier b; b.grid = grid; b.bar = bar; b.x = xb_xcc_id(); b.st = st;
    if (threadIdx.x == 0) (void)xb_add(&bar[XB_XCNT(b.x)], 1u);
    return b;
}
__device__ __forceinline__ void xcd_barrier_complete(unsigned* bar, unsigned x, unsigned& nloc, unsigned& nx, unsigned b_grid) {
    const unsigned G = b_grid;
    unsigned sum, cnt, mine, sp = 0u;
    for (;;) {
        sum = 0u; cnt = 0u; mine = 0u;
#pragma unroll
        for (unsigned j = 0; j < 16; ++j) { const unsigned c = xb_ld(&bar[XB_XCNT(j)]); sum += c; cnt += (c > 0u) ? 1u : 0u; mine = (j == x) ? c : mine; }
        if (sum == G) break;
        __builtin_amdgcn_s_sleep(1);
        if ((++sp & 255u) == 0u) { if (xb_ld(&bar[XB_TMO])) break; if (sp > XB_SPIN_CAP) { atomicAdd(&bar[XB_TMO], 1u); break; } }
    }
    nloc = mine > 0u ? mine : 1u; nx = cnt > 0u ? cnt : 1u;
}

__device__ __forceinline__ void xcd_barrier(const XcdBarrier& b) {
    asm volatile("s_waitcnt vmcnt(0)" ::: "memory");
    __syncthreads();
    if (threadIdx.x == 0) {
        unsigned* bar = b.bar;
        __builtin_amdgcn_s_waitcnt(0);
        unsigned nloc = b.st[0], nx = b.st[1];
        if (nloc == 0u) { xcd_barrier_complete(bar, b.x, nloc, nx, b.grid); b.st[0] = nloc; b.st[1] = nx; }
        const unsigned old = xb_add(&bar[XB_XSUB(b.x)], 1u);
        const unsigned gen = old / nloc;
        if (old + 1u == (gen + 1u) * nloc) {
            __builtin_amdgcn_fence(__ATOMIC_RELEASE, "agent");
            asm volatile("s_waitcnt vmcnt(0)" ::: "memory");
            const unsigned og = xb_add(&bar[XB_TOP], 1u);
            const unsigned tg = og / nx;
            if (og + 1u == (tg + 1u) * nx) xb_add(&bar[XB_TOPGEN], 1u);
            else XB_SPIN(xb_ld(&bar[XB_TOPGEN]) == tg, bar);
            __builtin_amdgcn_fence(__ATOMIC_ACQUIRE, "agent");
            xb_add(&bar[XB_XGEN(b.x)], 1u);
            asm volatile("s_waitcnt vmcnt(0)" ::: "memory");
        } else {
            XB_SPIN(xb_ld(&bar[XB_XGEN(b.x)]) == gen, bar);
            __builtin_amdgcn_fence(__ATOMIC_ACQUIRE, "agent");
            asm volatile("s_waitcnt vmcnt(0)" ::: "memory");
        }
    }
    __syncthreads();
}

struct Args { const float* in[30]; float* out; unsigned char* ws; int ph_lo, ph_hi, grid, pad; };
struct Frame {
    LAS unsigned char* lds;
    volatile LAS unsigned* MISC;
    int tid, lane, wave, vcu, G, bx;
};
__device__ __forceinline__ Frame mkframe(LAS unsigned char* lds, int grid) {
    Frame F; int t = threadIdx.x; asm volatile("" : "+v"(t)); int g = grid, bx = blockIdx.x; asm volatile("" : "+s"(g), "+s"(bx));
    F.lds = lds; F.MISC = (volatile LAS unsigned*)(lds + MISC_OFF); F.tid = t; F.lane = t & 63; F.wave = __builtin_amdgcn_readfirstlane(t >> 6); F.G = g; F.bx = bx;
    F.vcu = (g % 8 == 0) ? (bx % 8) * (g / 8) + bx / 8 : bx; return F;
}
constexpr int PTAB_OFF = LDSCTL_OFF + 1024, PT_OUT = 30, PT_WS = 31;
__device__ __forceinline__ unsigned long long ldp_raw(Frame& F, int i) {
    const volatile LAS unsigned* t = (const volatile LAS unsigned*)(F.lds + PTAB_OFF) + 2 * i; const unsigned lo = t[0], hi = t[1];
    return ((unsigned long long)(unsigned)__builtin_amdgcn_readfirstlane((int)hi) << 32) | (unsigned)__builtin_amdgcn_readfirstlane((int)lo);
}
#define PIN(i) ((const float*)(const GAS float*)ldp_raw(F, (i)))
#define POUT() ((float*)(GAS float*)ldp_raw(F, PT_OUT))
#define PWS() ((unsigned char*)(GAS unsigned char*)ldp_raw(F, PT_WS))
__device__ __forceinline__ bf16* w_in_t(unsigned char* ws, int L) { return (bf16*)(ws + WS_W + (size_t)L * W_LAYER_B); }
__device__ __forceinline__ bf16* w_br_t(unsigned char* ws, int L, int b) { return (bf16*)(ws + WS_W + (size_t)L * W_LAYER_B + W_IN_B + (size_t)b * W_BR_B); }
__device__ __forceinline__ bf16* w_out_t(unsigned char* ws, int L) { return (bf16*)(ws + WS_W + (size_t)L * W_LAYER_B + W_IN_B + 3 * W_BR_B); }
__device__ __forceinline__ bf16* w_gu_t(unsigned char* ws, int e) { return (bf16*)(ws + (e < 0 ? WS_WFFN : WS_WMOE + (size_t)e * W_GU_B)); }
__device__ __forceinline__ bf16* w_d_t(unsigned char* ws, int e) { return (bf16*)(ws + (e < 0 ? WS_WFFN + W_GU_B : WS_WMOE + 8 * W_GU_B + (size_t)e * W_D_B)); }

__device__ __forceinline__ void transpose_item(const float* W, int K, int N, bf16* WT, int drow, LAS float* scr, int kb, int nb, int lane) {
    const int k0 = 64 * kb, n0 = 32 * nb;
#pragma unroll 8
    for (int i = 0; i < 32; ++i) { const int kk = 2 * i + (lane >> 5); scr[kk * 33 + (lane & 31)] = W[(size_t)(k0 + kk) * N + n0 + (lane & 31)]; }
    LDS_WAIT(); asm volatile("" ::: "memory");
    const int c = lane & 7;
#pragma unroll
    for (int j = 0; j < 4; ++j) { const int n = (lane >> 3) + 8 * j; const LAS float* s = scr + (8 * c) * 33 + n;
        v4u o; o.x = pk2(s[0 * 33], s[1 * 33]); o.y = pk2(s[2 * 33], s[3 * 33]); o.z = pk2(s[4 * 33], s[5 * 33]); o.w = pk2(s[6 * 33], s[7 * 33]);
        *(GAS v4u*)(WT + (size_t)(drow + n) * K + k0 + 8 * c) = o; }
    LDS_WAIT(); asm volatile("" ::: "memory");
}
template <int MODE> __device__ __forceinline__ void conv_matrix(Frame& F, const float* W, int K, int N, bf16* WT) {
    LAS float* scr = (LAS float*)(F.lds + RING_OFF + F.wave * 16384);
    const int gw = F.vcu * NWAVES + F.wave, NGW = F.G * NWAVES;
    const int nblk = N / 32, nitems = (K / 64) * nblk;
    for (int it = gw; it < nitems; it += NGW) {
        const int kb = it / nblk, nb = it % nblk; int drow;
        if (MODE == 0) drow = 32 * nb;
        else if (MODE == 1) { if (nb == LR_COL / 32) continue; drow = nb < LR_COL / 32 ? 32 * nb : 32 * (nb - 1); }
        else if (MODE == 2) drow = 256 * (nb >> 2) + 32 * (nb & 3);
        else drow = 256 * (nb >> 2) + 128 + 32 * (nb & 3);
        transpose_item(W, K, N, WT, drow, scr, kb, nb, F.lane);
    }
}
__device__ __forceinline__ void ada_item(Frame& F, unsigned char* ws, const float* cnd, const float* cctx, const float* ada_w, const float* ada_b, int item) {
    const int L = item / 96, c0 = (item % 96) * 128;
    LAS float* sc = (LAS float*)(F.lds + RING_OFF);
    LAS float* red = (LAS float*)(F.lds + RING_OFF + 24576);
    for (int i = F.tid; i < 3 * D; i += NTHR) { const int g = i / D, k = i % D; const float v = g < 2 ? cnd[g * D + k] : cctx[k]; sc[i] = v / (1.0f + __expf(-v)); }
    __syncthreads();
    const float* W = ada_w + (size_t)L * D * 12288 + c0 + 2 * F.lane;
    float a00 = 0.f, a01 = 0.f, a10 = 0.f, a11 = 0.f, a20 = 0.f, a21 = 0.f;
    const int kb = 256 * F.wave;
#pragma unroll 8
    for (int k = kb; k < kb + 256; ++k) { const float2 w = *(const float2*)(W + (size_t)k * 12288); const float s0 = sc[k], s1 = sc[D + k], s2 = sc[2 * D + k];
        a00 += s0 * w.x; a01 += s0 * w.y; a10 += s1 * w.x; a11 += s1 * w.y; a20 += s2 * w.x; a21 += s2 * w.y; }
    red[(F.wave * 3 + 0) * 128 + 2 * F.lane] = a00; red[(F.wave * 3 + 0) * 128 + 2 * F.lane + 1] = a01;
    red[(F.wave * 3 + 1) * 128 + 2 * F.lane] = a10; red[(F.wave * 3 + 1) * 128 + 2 * F.lane + 1] = a11;
    red[(F.wave * 3 + 2) * 128 + 2 * F.lane] = a20; red[(F.wave * 3 + 2) * 128 + 2 * F.lane + 1] = a21;
    __syncthreads();
    if (F.tid < 384) { const int g = F.tid / 128, cc = F.tid % 128; float s = 0.f;
#pragma unroll
        for (int w = 0; w < 8; ++w) s += red[(w * 3 + g) * 128 + cc];
        ((float*)(ws + WS_MOD))[((size_t)L * 3 + g) * 12288 + c0 + cc] = s + ada_b[L * 12288 + c0 + cc]; }
    __syncthreads();
}
__device__ __forceinline__ void p0a_prologue(Frame& F) {
    unsigned char* const ws = PWS();
    { const float* cnd = PIN(1); const float* cctx = PIN(3); const float* ada_w = PIN(4); const float* ada_b = PIN(5);
      for (int it = F.bx; it < 192; it += F.G) ada_item(F, ws, cnd, cctx, ada_w, ada_b, it); }
    const float* const w_in = PIN(6);
    { const int gt = F.bx * NTHR + F.tid, NGT = F.G * NTHR;
      for (int i = gt; i < DEPTH * D * 32; i += NGT) { const int o = i & 31, k = (i >> 5) % D, L = i / (32 * D); ((float*)(ws + WS_WLR))[((size_t)L * 32 + o) * D + k] = w_in[((size_t)L * D + k) * INC + LR_COL + o]; } }
    for (int L = 0; L < DEPTH; ++L) {
        conv_matrix<1>(F, w_in + (size_t)L * D * INC, D, INC, w_in_t(ws, L));
        for (int b = 0; b < 3; ++b) conv_matrix<0>(F, (b == 0 ? PIN(14) : (b == 1 ? PIN(15) : PIN(16))) + (size_t)L * 1024 * D, 1024, D, w_br_t(ws, L, b));
        conv_matrix<0>(F, PIN(18) + (size_t)L * D * D, D, D, w_out_t(ws, L));
    }
    conv_matrix<2>(F, PIN(23), D, FF, w_gu_t(ws, -1)); conv_matrix<3>(F, PIN(24), D, FF, w_gu_t(ws, -1)); conv_matrix<0>(F, PIN(25), FF, D, w_d_t(ws, -1));
    for (int e = 0; e < NE; ++e) {
        conv_matrix<2>(F, PIN(27) + (size_t)e * D * FF, D, FF, w_gu_t(ws, e)); conv_matrix<3>(F, PIN(28) + (size_t)e * D * FF, D, FF, w_gu_t(ws, e));
        conv_matrix<0>(F, PIN(29) + (size_t)e * FF * D, FF, D, w_d_t(ws, e));
    }
}

__device__ __forceinline__ int row_group(int r) { return r < SEQ ? 0 : (r < NLAT ? 1 : 2); }
__device__ __forceinline__ void load_row(const float* p, int lane, f32x4 (&v)[8]) {
#pragma unroll
    for (int j = 0; j < 8; ++j) v[j] = *(const GAS f32x4*)(p + 4 * lane + 256 * j);
}
__device__ __forceinline__ void store_row(float* p, int lane, const f32x4 (&v)[8]) {
#pragma unroll
    for (int j = 0; j < 8; ++j) *(GAS f32x4*)(p + 4 * lane + 256 * j) = v[j];
}
__device__ __forceinline__ void store_row_bf16(bf16* p, int lane, const f32x4 (&v)[8]) {
#pragma unroll
    for (int j = 0; j < 8; ++j) { v2u w; w.x = pk2(v[j][0], v[j][1]); w.y = pk2(v[j][2], v[j][3]); *(GAS v2u*)(p + 4 * lane + 256 * j) = w; }
}
__device__ __forceinline__ void modulate(f32x4 (&v)[8], const float* shift, const float* scale, int lane) {
#pragma unroll
    for (int j = 0; j < 8; ++j) { const f32x4 sh = *(const f32x4*)(shift + 4 * lane + 256 * j), sc = *(const f32x4*)(scale + 4 * lane + 256 * j); v[j] = v[j] * (sc + 1.0f) + sh; }
}
__device__ __forceinline__ void layer_norm_row(f32x4 (&v)[8], const float* g, const float* b, int lane) {
    float s = 0.f;
#pragma unroll
    for (int j = 0; j < 8; ++j) s += (v[j][0] + v[j][1]) + (v[j][2] + v[j][3]);
    const float mean = wave_sum(s) * (1.0f / D); float q = 0.f;
#pragma unroll
    for (int j = 0; j < 8; ++j) { v[j] = v[j] - mean; q += (v[j][0] * v[j][0] + v[j][1] * v[j][1]) + (v[j][2] * v[j][2] + v[j][3] * v[j][3]); }
    const float rstd = 1.0f / sqrtf(wave_sum(q) * (1.0f / D) + LN_EPS);
#pragma unroll
    for (int j = 0; j < 8; ++j) { const f32x4 g4 = *(const f32x4*)(g + 4 * lane + 256 * j), b4 = *(const f32x4*)(b + 4 * lane + 256 * j); v[j] = v[j] * rstd * g4 + b4; }
}
__device__ __forceinline__ void emit_h_lr(Frame& F, unsigned char* ws, const f32x4 (&h)[8], int r, int L) {
    store_row_bf16(((bf16*)(ws + WS_H)) + (size_t)r * D, F.lane, h);
    const float* wl = ((float*)(ws + WS_WLR)) + (size_t)L * 32 * D + 4 * F.lane; float keep = 0.f;
    for (int o = 0; o < 32; ++o) { float s = 0.f;
#pragma unroll
        for (int j = 0; j < 8; ++j) { const f32x4 w = *(const f32x4*)(wl + (size_t)o * D + 256 * j); s += (h[j][0] * w[0] + h[j][1] * w[1]) + (h[j][2] * w[2] + h[j][3] * w[3]); }
        s = wave_sum(s); if (F.lane == o) keep = s; }
    if (F.lane < 32) ((float*)(ws + WS_LR))[(size_t)r * 32 + F.lane] = keep;
}
__device__ __forceinline__ void p0b_modulate(Frame& F) {
    unsigned char* const ws = PWS(); const float* const xin = PIN(0); const float* const cin = PIN(2);
    const int gw = F.vcu * NWAVES + F.wave, NGW = F.G * NWAVES;
    for (int r = gw; r < MROWS; r += NGW) {
        f32x4 v[8]; load_row(r < NLAT ? xin + (size_t)r * D : cin + (size_t)(r - NLAT) * D, F.lane, v);
        const float* m = ((float*)(ws + WS_MOD)) + (size_t)row_group(r) * 12288;
        modulate(v, m, m + D, F.lane); emit_h_lr(F, ws, v, r, 0);
    }
}

__device__ __forceinline__ void mix_prep(Frame& F, int L) {
    unsigned char* const ws = PWS();
    const int gt = F.bx * NTHR + F.tid, NGT = F.G * NTHR;
    const float* cw = PIN(7) + (size_t)L * 3 * 1024;
    for (int i = gt; i < MROWS * 128; i += NGT) {
        const int r = i >> 7, c8 = (i & 127) * 8;
        const int t = r < NLAT ? (r & (SEQ - 1)) : ((r - NLAT) & (CTXL - 1)), T = r < NLAT ? SEQ : CTXL;
        float acc[8];
#pragma unroll
        for (int j = 0; j < 8; ++j) acc[j] = 0.f;
#pragma unroll
        for (int k = 0; k < 3; ++k) { const int tt = t + k - 1; if (tt < 0 || tt >= T) continue;
            const bf16* up = ((bf16*)(ws + WS_U)) + (size_t)(r + k - 1) * NU; const v4u a = *(const GAS v4u*)(up + U_CC + c8), b = *(const GAS v4u*)(up + U_CX + c8);
            const f32x4 w0 = *(const f32x4*)(cw + k * 1024 + c8), w1 = *(const f32x4*)(cw + k * 1024 + c8 + 4);
            acc[0] += w0[0] * bflo(a.x) * bflo(b.x); acc[1] += w0[1] * bfhi(a.x) * bfhi(b.x); acc[2] += w0[2] * bflo(a.y) * bflo(b.y); acc[3] += w0[3] * bfhi(a.y) * bfhi(b.y);
            acc[4] += w1[0] * bflo(a.z) * bflo(b.z); acc[5] += w1[1] * bfhi(a.z) * bfhi(b.z); acc[6] += w1[2] * bflo(a.w) * bflo(b.w); acc[7] += w1[3] * bfhi(a.w) * bfhi(b.w); }
        const v4u ab = *(const GAS v4u*)(((bf16*)(ws + WS_U)) + (size_t)r * NU + U_CB + c8);
        v4u o; o.x = pk2(acc[0] * bflo(ab.x), acc[1] * bfhi(ab.x)); o.y = pk2(acc[2] * bflo(ab.y), acc[3] * bfhi(ab.y)); o.z = pk2(acc[4] * bflo(ab.z), acc[5] * bfhi(ab.z)); o.w = pk2(acc[6] * bflo(ab.w), acc[7] * bfhi(ab.w));
        *(GAS v4u*)(((bf16*)(ws + WS_Y)) + (size_t)r * 1024 + c8) = o;
    }
}
__device__ __forceinline__ void na_naive(Frame& F, int L) {
    unsigned char* const ws = PWS();
    const int gwv = F.vcu * NWAVES + F.wave, nwv = F.G * NWAVES;
    LAS float* qs = (LAS float*)(F.lds + RING_OFF + 65536) + F.wave * 512; LAS float* ps = qs + 128;
    const int T_lat = NLAT * 8, T_all = T_lat + (L == 0 ? NCTX * 8 : 0);
    const float* rpb = PIN(13) + (size_t)L * 8 * 15 * 31;
    for (int task = gwv; task < T_all; task += nwv) {
        const bool isctx = task >= T_lat; const int r = isctx ? NLAT + ((task - T_lat) >> 3) : (task >> 3), h = task & 7;
        const int b = isctx ? ((r - NLAT) >> 8) : (r >> 12);
        { const unsigned qw = *(const GAS unsigned*)(((bf16*)(ws + WS_U)) + (size_t)r * NU + U_NQ + h * 128 + 2 * F.lane); qs[2 * F.lane] = bflo(qw); qs[2 * F.lane + 1] = bfhi(qw); }
        LDS_WAIT(); asm volatile("" ::: "memory");
        const int nkeys = isctx ? 256 : 384, t = r & (SEQ - 1), qr = t >> 6, qc = t & 63;
        const int rs = min(max(qr - 4, 0), 56), cs = min(max(qc - 8, 0), 48);
        float sc[6];
#pragma unroll
        for (int m = 0; m < 6; ++m) { const int j = F.lane + 64 * m; sc[m] = -INFINITY;
            if (j < nkeys) { int rk; float bias = 0.f;
                if (!isctx && j < 128) { const int kr = rs + (j >> 4), kc = cs + (j & 15); rk = b * SEQ + kr * 64 + kc; bias = rpb[(h * 15 + (kr - qr + 7)) * 31 + (kc - qc + 15)]; }
                else rk = NLAT + CTXL * b + (isctx ? j : j - 128);
                const GAS v4u* kp = (const GAS v4u*)(((bf16*)(ws + WS_U)) + (size_t)rk * NU + U_NK + h * 128); float dot = 0.f;
#pragma unroll 4
                for (int c = 0; c < 16; ++c) { const v4u kv = kp[c]; const LAS f32x4* q4 = (const LAS f32x4*)(qs + 8 * c); const f32x4 qa = q4[0], qb = q4[1];
                    dot += qa[0] * bflo(kv.x) + qa[1] * bfhi(kv.x) + qa[2] * bflo(kv.y) + qa[3] * bfhi(kv.y) + qb[0] * bflo(kv.z) + qb[1] * bfhi(kv.z) + qb[2] * bflo(kv.w) + qb[3] * bfhi(kv.w); }
                sc[m] = dot + bias; }
            asm volatile("" ::: "memory"); }
        float mx = sc[0];
#pragma unroll
        for (int m = 1; m < 6; ++m) mx = fmaxf(mx, sc[m]);
        mx = wave_max(mx); float sum = 0.f;
#pragma unroll
        for (int m = 0; m < 6; ++m) { sc[m] = (F.lane + 64 * m < nkeys) ? __expf(sc[m] - mx) : 0.f; sum += sc[m]; }
        sum = wave_sum(sum); const float inv = 1.0f / sum;
#pragma unroll
        for (int m = 0; m < 6; ++m) ps[F.lane + 64 * m] = sc[m] * inv;
        LDS_WAIT(); asm volatile("" ::: "memory");
        float a0 = 0.f, a1 = 0.f;
        for (int j = 0; j < nkeys; ++j) { int rk;
            if (!isctx && j < 128) rk = b * SEQ + (rs + (j >> 4)) * 64 + cs + (j & 15); else rk = NLAT + CTXL * b + (isctx ? j : j - 128);
            const unsigned vw = *(const GAS unsigned*)(((bf16*)(ws + WS_U)) + (size_t)rk * NU + U_NV + h * 128 + 2 * F.lane); const float p = ps[j];
            a0 += p * bflo(vw); a1 += p * bfhi(vw); }
        *(GAS unsigned*)(((bf16*)(ws + WS_Y + (size_t)MROWS * 2048 * 2)) + (size_t)r * 1024 + h * 128 + 2 * F.lane) = pk2(a0, a1);
        LDS_WAIT(); asm volatile("" ::: "memory");
    }
}
__device__ __forceinline__ void ln1_phase(Frame& F, int L, int M) {
    unsigned char* const ws = PWS(); const float* const lng = PIN(19) + L * D; const float* const lnb = PIN(20) + L * D; const float* const router = PIN(26);
    const int gw = F.vcu * NWAVES + F.wave, NGW = F.G * NWAVES;
    for (int r = gw; r < M; r += NGW) {
        f32x4 v[8]; load_row(((float*)(ws + WS_PRE)) + (size_t)r * D, F.lane, v);
        layer_norm_row(v, lng, lnb, F.lane);
        store_row(((float*)(ws + WS_XL)) + (size_t)r * D, F.lane, v);
        const float* m = ((float*)(ws + WS_MOD)) + ((size_t)L * 3 + row_group(r)) * 12288;
        modulate(v, m + 3 * D, m + 4 * D, F.lane);
        store_row_bf16(((bf16*)(ws + WS_H)) + (size_t)r * D, F.lane, v);
        if (L == 1) {
            float lg[8];
#pragma unroll
            for (int e = 0; e < 8; ++e) lg[e] = 0.f;
#pragma unroll
            for (int j = 0; j < 8; ++j)
#pragma unroll
                for (int i = 0; i < 4; ++i) { const float* rp = router + (size_t)(4 * F.lane + 256 * j + i) * 8; const f32x4 w0 = *(const f32x4*)rp, w1 = *(const f32x4*)(rp + 4); const float hv = v[j][i];
                    lg[0] += hv * w0[0]; lg[1] += hv * w0[1]; lg[2] += hv * w0[2]; lg[3] += hv * w0[3]; lg[4] += hv * w1[0]; lg[5] += hv * w1[1]; lg[6] += hv * w1[2]; lg[7] += hv * w1[3]; }
#pragma unroll
            for (int e = 0; e < 8; ++e) lg[e] = wave_sum(lg[e]);
            int e0 = 0; float v0 = lg[0];
#pragma unroll
            for (int e = 1; e < 8; ++e) if (lg[e] > v0) { v0 = lg[e]; e0 = e; }
            int e1 = -1; float v1 = -INFINITY;
#pragma unroll
            for (int e = 0; e < 8; ++e) if (e != e0 && lg[e] > v1) { v1 = lg[e]; e1 = e; }
            if (F.lane == 0) {
                const float w0 = 1.0f / (1.0f + __expf(v1 - v0)), w1 = 1.0f - w0;
                const unsigned p0 = __hip_atomic_fetch_add(((gu32*)(ws + WS_CTL)) + CW_MOECNT + 64 * e0, 1u, RLX_AGENT), p1 = __hip_atomic_fetch_add(((gu32*)(ws + WS_CTL)) + CW_MOECNT + 64 * e1, 1u, RLX_AGENT);
                ((int*)(ws + WS_TOK))[e0 * NLAT + p0] = r; ((int*)(ws + WS_TOK))[e1 * NLAT + p1] = r;
                unsigned* rt = ((unsigned*)(ws + WS_ROUTE)) + (size_t)r * 8; rt[0] = e0; rt[1] = p0; rt[2] = __float_as_uint(w0); rt[3] = e1; rt[4] = p1; rt[5] = __float_as_uint(w1);
            }
        }
    }
}
__device__ __forceinline__ void moe_prefix(unsigned char* ws, unsigned (&cnt)[8], int (&pp)[9]) {
    pp[0] = 0;
#pragma unroll
    for (int e = 0; e < 8; ++e) { cnt[e] = __hip_atomic_load(((gu32*)(ws + WS_CTL)) + CW_MOECNT + 64 * e, RLX_AGENT); pp[e + 1] = pp[e] + (int)((cnt[e] + 255u) >> 8); }
}
__device__ __forceinline__ void moe_gather(Frame& F) {
    unsigned char* const ws = PWS();
    const int gw = F.vcu * NWAVES + F.wave, NGW = F.G * NWAVES;
    unsigned cnt[8]; int pp[9]; moe_prefix(ws, cnt, pp);
    for (int s = gw; s < pp[8] * 256; s += NGW) {
        const int p = s >> 8; int e = 0, base = 0; unsigned ce = cnt[0];
#pragma unroll
        for (int k = 1; k < 8; ++k) if (p >= pp[k]) { e = k; base = pp[k]; ce = cnt[k]; }
        const unsigned pos = (unsigned)(s - base * 256);
        GAS v4u* dst = (GAS v4u*)(((bf16*)(ws + WS_GLA)) + (size_t)s * D) + F.lane;
        if (pos < ce) { const int tkn = ((int*)(ws + WS_TOK))[e * NLAT + pos]; const GAS v4u* src = (const GAS v4u*)(((bf16*)(ws + WS_H)) + (size_t)tkn * D) + F.lane;
#pragma unroll
            for (int j = 0; j < 4; ++j) dst[64 * j] = src[64 * j]; }
        else {
#pragma unroll
            for (int j = 0; j < 4; ++j) dst[64 * j] = (v4u){0u, 0u, 0u, 0u}; }
    }
}
__device__ __forceinline__ void ln2_dense(Frame& F, int L) {
    unsigned char* const ws = PWS(); const float* const lng = PIN(21) + L * D; const float* const lnb = PIN(22) + L * D;
    const int gw = F.vcu * NWAVES + F.wave, NGW = F.G * NWAVES;
    for (int r = gw; r < MROWS; r += NGW) {
        f32x4 v[8]; load_row(((float*)(ws + WS_PRE)) + (size_t)r * D, F.lane, v);
        layer_norm_row(v, lng, lnb, F.lane);
        store_row(((float*)(ws + WS_XL)) + (size_t)r * D, F.lane, v);
        const float* m = ((float*)(ws + WS_MOD)) + ((size_t)(L + 1) * 3 + row_group(r)) * 12288;
        modulate(v, m, m + D, F.lane); emit_h_lr(F, ws, v, r, L + 1);
    }
}
__device__ __forceinline__ void ln2_moe(Frame& F, int L) {
    unsigned char* const ws = PWS(); const float* const lng = PIN(21) + L * D; const float* const lnb = PIN(22) + L * D; float* const outp = POUT();
    const int gw = F.vcu * NWAVES + F.wave, NGW = F.G * NWAVES;
    unsigned cnt[8]; int pp[9]; moe_prefix(ws, cnt, pp);
    for (int r = gw; r < NLAT; r += NGW) {
        const unsigned* rt = ((unsigned*)(ws + WS_ROUTE)) + (size_t)r * 8; const int e0 = rt[0], e1 = rt[3]; const float w0 = __uint_as_float(rt[2]), w1 = __uint_as_float(rt[5]);
        int b0 = 0, b1 = 0;
#pragma unroll
        for (int k = 1; k < 8; ++k) { if (e0 >= k) b0 = pp[k]; if (e1 >= k) b1 = pp[k]; }
        const size_t s0 = (size_t)b0 * 256 + rt[1], s1 = (size_t)b1 * 256 + rt[4];
        f32x4 v[8], y0[8], y1[8]; load_row(((float*)(ws + WS_XL)) + (size_t)r * D, F.lane, v); load_row(((float*)(ws + WS_Z)) + s0 * D, F.lane, y0); load_row(((float*)(ws + WS_Z)) + s1 * D, F.lane, y1);
        const float* g2 = ((float*)(ws + WS_MOD)) + ((size_t)L * 3 + row_group(r)) * 12288 + 5 * D;
#pragma unroll
        for (int j = 0; j < 8; ++j) { const f32x4 g4 = *(const f32x4*)(g2 + 4 * F.lane + 256 * j); v[j] = v[j] * ALPHA + g4 * (y0[j] * w0 + y1[j] * w1); }
        layer_norm_row(v, lng, lnb, F.lane);
        store_row(outp + (size_t)r * D, F.lane, v);
    }
}

constexpr int GLA_NCH = 68;
constexpr size_t GLA_DST_BYTES = (size_t)16 * GLA_NCH * 256 * 128 * 2;
#define GLA_DST(ws) ((bf16*)((ws) + WS_GLA))
#define GLA_DEC(ws) ((float*)((ws) + WS_GLA + GLA_DST_BYTES))
typedef short bf16x8v __attribute__((ext_vector_type(8)));
__device__ __forceinline__ int gla_chunk_row0(int b, int cn) { return cn < 4 ? NLAT + CTXL * b + 64 * cn : SEQ * b + 64 * (cn - 4); }
__device__ __forceinline__ int gla_scan_idx(int cn, int dir) { return dir ? (cn < 4 ? 3 - cn : 71 - cn) : cn; }
__device__ __forceinline__ float log_sigmoid16(float z) { return (fminf(z, 0.f) - __logf(1.0f + __expf(-fabsf(z)))) * (1.0f / 16.0f); }
__device__ __forceinline__ bf16x8v tr_frag(unsigned addr, unsigned pitch4) {
    v2u lo, hi;
    asm volatile("ds_read_b64_tr_b16 %0, %2\n\tds_read_b64_tr_b16 %1, %3\n\ts_waitcnt lgkmcnt(0)" : "=&v"(lo), "=&v"(hi) : "v"(addr), "v"(addr + pitch4) : "memory");
    v4u r; r.x = lo.x; r.y = lo.y; r.z = hi.x; r.w = hi.y; return __builtin_bit_cast(bf16x8v, r);
}
__device__ __forceinline__ unsigned lds_addr(LAS unsigned char* p) { return (unsigned)(size_t)p; }
constexpr int GL_BC = 0;
constexpr int GL_TOT = 65536;
constexpr int GL_V = 71680;
constexpr int GL_A = 105472;
constexpr int GL_STG = 105472;
constexpr int GL_RED = 124928;
constexpr int GL_QK_PITCH = 272, GL_V_PITCH = 528, GL_A_PITCH = 144;
static_assert(GL_STG + 25600 <= RING_BYTES && GL_V + 64 * GL_V_PITCH <= GL_A && GL_TOT + 4096 + 1024 <= GL_V && 4 * 64 * GL_QK_PITCH <= GL_V, "GLA LDS map");

__device__ __forceinline__ void gla_decays(Frame& F, unsigned char* ws, const float* wgf, const float* bgf, const float* wgb, const float* bgb, int row0, int h, int d0, int d1) {
    LAS float* lr = (LAS float*)(F.lds + GL_STG); LAS float* wg = lr + 64 * 32; LAS float* bg = wg + 2 * 16 * 128;
    LAS float* bc = (LAS float*)(F.lds + GL_BC); LAS float* tot = (LAS float*)(F.lds + GL_TOT);
    { const int t = F.tid >> 3, o4 = (F.tid & 7) * 4; *(LAS f32x4*)(lr + t * 32 + o4) = *(const GAS f32x4*)(((float*)(ws + WS_LR)) + (size_t)(row0 + t) * 32 + o4); }
    for (int i = F.tid; i < 1024; i += NTHR) { const int dir = i >> 9, o = (i >> 5) & 15, d4 = (i & 31) * 4; *(LAS f32x4*)(wg + (dir * 16 + o) * 128 + d4) = *(const GAS f32x4*)((dir ? wgb : wgf) + o * 512 + h * 128 + d4); }
    if (F.tid < 64) { const int dir = F.tid >> 5, d4 = (F.tid & 31) * 4; *(LAS f32x4*)(bg + dir * 128 + d4) = *(const GAS f32x4*)((dir ? bgb : bgf) + h * 128 + d4); }
    __syncthreads();
    { const int t = F.tid >> 3, dg = (F.tid & 7) * 16;
      for (int dir = d0; dir < d1; ++dir) {
          f32x4 z[4];
#pragma unroll
          for (int j = 0; j < 4; ++j) z[j] = *(LAS f32x4*)(bg + dir * 128 + dg + 4 * j);
#pragma unroll
          for (int o = 0; o < 16; ++o) { const float l = lr[t * 32 + dir * 16 + o];
#pragma unroll
              for (int j = 0; j < 4; ++j) z[j] += l * *(LAS f32x4*)(wg + (dir * 16 + o) * 128 + dg + 4 * j); }
#pragma unroll
          for (int j = 0; j < 4; ++j) { f32x4 g; g[0] = log_sigmoid16(z[j][0]); g[1] = log_sigmoid16(z[j][1]); g[2] = log_sigmoid16(z[j][2]); g[3] = log_sigmoid16(z[j][3]); *(LAS f32x4*)(bc + dir * 8192 + t * 128 + dg + 4 * j) = g; } } }
    __syncthreads();
    { const int d = F.tid & 127, seg = F.tid >> 7;
      for (int dir = d0; dir < d1; ++dir) { float a = 0.f;
#pragma unroll
          for (int i = 0; i < 16; ++i) { const int s = seg * 16 + i, t = dir ? 63 - s : s; a += bc[dir * 8192 + t * 128 + d]; bc[dir * 8192 + t * 128 + d] = a; }
          tot[(dir * 4 + seg) * 128 + d] = a; } }
    __syncthreads();
    { const int d = F.tid & 127, seg = F.tid >> 7;
      for (int dir = d0; dir < d1; ++dir) { float pre = 0.f, all = 0.f;
#pragma unroll
          for (int s2 = 0; s2 < 4; ++s2) { const float v = tot[(dir * 4 + s2) * 128 + d]; all += v; if (s2 < seg) pre += v; }
          if (seg == 0) tot[1024 + dir * 128 + d] = all;
          if (seg > 0) {
#pragma unroll
              for (int i = 0; i < 16; ++i) { const int s = seg * 16 + i, t = dir ? 63 - s : s; bc[dir * 8192 + t * 128 + d] += pre; } } } }
    __syncthreads();
}
__device__ __forceinline__ void gla_stage_v(Frame& F, const bf16* U, int row0, int h) {
#pragma unroll
    for (int i = 0; i < 4; ++i) { const int p = F.tid + NTHR * i, t = p >> 5, e8 = (p & 31) * 8;
        *(LAS v4u*)(F.lds + GL_V + t * GL_V_PITCH + e8 * 2) = *(const GAS v4u*)(U + (size_t)(row0 + t) * NU + U_GV + h * 256 + e8); }
}
__device__ __forceinline__ void gla_g1(Frame& F, int L) {
    unsigned char* const ws = PWS(); const bf16* U = (const bf16*)(ws + WS_U);
    const float* wgf = PIN(8) + (size_t)L * 16 * 512; const float* bgf = PIN(9) + L * 512; const float* wgb = PIN(10) + (size_t)L * 16 * 512; const float* bgb = PIN(11) + L * 512;
    const int g = F.lane >> 4, q4 = (F.lane & 15) >> 2, p = F.lane & 3, l15 = F.lane & 15;
    for (int task = F.vcu; task < 16 * GLA_NCH; task += F.G) {
        const int cn = task % GLA_NCH, ch = task / GLA_NCH, h = ch & 3, dir = (ch >> 2) & 1, b = ch >> 3;
        const int row0 = gla_chunk_row0(b, cn), n = gla_scan_idx(cn, dir);
        __syncthreads();
        gla_stage_v(F, U, row0, h);
        v4u kp[2];
#pragma unroll
        for (int i = 0; i < 2; ++i) { const int pc = F.tid + NTHR * i, t = pc >> 4, d8 = (pc & 15) * 8; kp[i] = *(const GAS v4u*)(U + (size_t)(row0 + t) * NU + U_GK + h * 128 + d8); }
        gla_decays(F, ws, wgf, bgf, wgb, bgb, row0, h, dir, dir + 1);
        LAS float* bc = (LAS float*)(F.lds + GL_BC) + dir * 8192; LAS float* bl = (LAS float*)(F.lds + GL_TOT) + 1024 + dir * 128;
        if (F.tid < 128) GLA_DEC(ws)[((size_t)ch * GLA_NCH + n) * 128 + F.tid] = __expf(bl[F.tid]);
        LAS unsigned char* ke = F.lds + GL_BC + (dir ? 0 : 32768);
#pragma unroll
        for (int i = 0; i < 2; ++i) { const int pc = F.tid + NTHR * i, t = pc >> 4, d8 = (pc & 15) * 8;
            const f32x4 b0 = *(LAS f32x4*)(bc + t * 128 + d8), b1 = *(LAS f32x4*)(bc + t * 128 + d8 + 4), l0 = *(LAS f32x4*)(bl + d8), l1 = *(LAS f32x4*)(bl + d8 + 4);
            v4u o; o.x = pk2(bflo(kp[i].x) * __expf(l0[0] - b0[0]), bfhi(kp[i].x) * __expf(l0[1] - b0[1])); o.y = pk2(bflo(kp[i].y) * __expf(l0[2] - b0[2]), bfhi(kp[i].y) * __expf(l0[3] - b0[3]));
            o.z = pk2(bflo(kp[i].z) * __expf(l1[0] - b1[0]), bfhi(kp[i].z) * __expf(l1[1] - b1[1])); o.w = pk2(bflo(kp[i].w) * __expf(l1[2] - b1[2]), bfhi(kp[i].w) * __expf(l1[3] - b1[3]));
            *(LAS v4u*)(ke + t * GL_QK_PITCH + d8 * 2) = o; }
        __syncthreads();
        f32x4 acc[8][2];
#pragma unroll
        for (int mt = 0; mt < 8; ++mt) { acc[mt][0] = (f32x4){0.f, 0.f, 0.f, 0.f}; acc[mt][1] = (f32x4){0.f, 0.f, 0.f, 0.f}; }
        const unsigned ke_a = lds_addr(ke) + GL_QK_PITCH * (8 * g + q4) + 8 * p, v_a = lds_addr(F.lds + GL_V) + GL_V_PITCH * (8 * g + q4) + 8 * p + 2 * (32 * F.wave);
#pragma unroll
        for (int ks = 0; ks < 2; ++ks) {
            bf16x8v bv[2];
#pragma unroll
            for (int nt = 0; nt < 2; ++nt) bv[nt] = tr_frag(v_a + GL_V_PITCH * 32 * ks + 32 * nt, GL_V_PITCH * 4);
#pragma unroll
            for (int mt = 0; mt < 8; ++mt) { const bf16x8v av = tr_frag(ke_a + GL_QK_PITCH * 32 * ks + 32 * mt, GL_QK_PITCH * 4);
                acc[mt][0] = __builtin_amdgcn_mfma_f32_16x16x32_bf16(av, bv[0], acc[mt][0], 0, 0, 0); acc[mt][1] = __builtin_amdgcn_mfma_f32_16x16x32_bf16(av, bv[1], acc[mt][1], 0, 0, 0); } }
        bf16* dst = GLA_DST(ws) + ((size_t)ch * GLA_NCH + n) * 256 * 128;
#pragma unroll
        for (int mt = 0; mt < 8; ++mt)
#pragma unroll
            for (int nt = 0; nt < 2; ++nt) { const int e = 32 * F.wave + 16 * nt + l15, d = 16 * mt + 4 * g; v2u w; w.x = pk2(acc[mt][nt][0], acc[mt][nt][1]); w.y = pk2(acc[mt][nt][2], acc[mt][nt][3]);
                *(GAS v2u*)(dst + (size_t)e * 128 + d) = w; }
    }
}
__device__ __forceinline__ void gla_g2(Frame& F) {
    unsigned char* const ws = PWS();
    const int NT = F.G * NTHR;
    for (int idx = F.bx * NTHR + F.tid; idx < 16 * 256 * 32; idx += NT) {
        const int ch = idx >> 13, e = (idx >> 5) & 255, d4 = (idx & 31) * 4;
        bf16* p = GLA_DST(ws) + (size_t)ch * GLA_NCH * 32768 + (size_t)e * 128 + d4; const float* dc = GLA_DEC(ws) + (size_t)ch * GLA_NCH * 128 + d4;
        f32x4 S = {0.f, 0.f, 0.f, 0.f};
#pragma unroll 4
        for (int n = 0; n < GLA_NCH; ++n) { const v2u x = *(const GAS v2u*)(p + (size_t)n * 32768); const f32x4 a = *(const GAS f32x4*)(dc + n * 128);
            v2u w; w.x = pk2(S[0], S[1]); w.y = pk2(S[2], S[3]); *(GAS v2u*)(p + (size_t)n * 32768) = w;
            S[0] = a[0] * S[0] + bflo(x.x); S[1] = a[1] * S[1] + bfhi(x.x); S[2] = a[2] * S[2] + bflo(x.y); S[3] = a[3] * S[3] + bfhi(x.y); }
    }
}
__device__ __forceinline__ void gla_g3(Frame& F, int L) {
    unsigned char* const ws = PWS(); const bf16* U = (const bf16*)(ws + WS_U);
    const float* wgf = PIN(8) + (size_t)L * 16 * 512; const float* bgf = PIN(9) + L * 512; const float* wgb = PIN(10) + (size_t)L * 16 * 512; const float* bgb = PIN(11) + L * 512;
    const float* ng = PIN(12) + L * 256;
    const int g = F.lane >> 4, q4 = (F.lane & 15) >> 2, p = F.lane & 3, l15 = F.lane & 15;
    for (int task = F.vcu; task < 8 * GLA_NCH; task += F.G) {
        const int cn = task % GLA_NCH, bh = task / GLA_NCH, h = bh & 3, b = bh >> 2;
        const int row0 = gla_chunk_row0(b, cn);
        __syncthreads();
        gla_stage_v(F, U, row0, h);
        v4u kp[2], qp[2];
#pragma unroll
        for (int i = 0; i < 2; ++i) { const int pc = F.tid + NTHR * i, t = pc >> 4, d8 = (pc & 15) * 8; const bf16* up = U + (size_t)(row0 + t) * NU + h * 128 + d8; kp[i] = *(const GAS v4u*)(up + U_GK); qp[i] = *(const GAS v4u*)(up + U_GQ); }
        gla_decays(F, ws, wgf, bgf, wgb, bgb, row0, h, 0, 2);
        v4u im[2][4];
        { LAS float* bc = (LAS float*)(F.lds + GL_BC);
#pragma unroll
          for (int i = 0; i < 2; ++i) { const int pc = F.tid + NTHR * i, t = pc >> 4, d8 = (pc & 15) * 8;
#pragma unroll
              for (int dir = 0; dir < 2; ++dir) { const f32x4 b0 = *(LAS f32x4*)(bc + dir * 8192 + t * 128 + d8), b1 = *(LAS f32x4*)(bc + dir * 8192 + t * 128 + d8 + 4);
                  float ep[8], en[8];
#pragma unroll
                  for (int j = 0; j < 4; ++j) { ep[j] = __expf(b0[j]); ep[4 + j] = __expf(b1[j]); en[j] = __expf(-b0[j]); en[4 + j] = __expf(-b1[j]); }
                  v4u qo, ko;
                  qo.x = pk2(bflo(qp[i].x) * ep[0], bfhi(qp[i].x) * ep[1]); qo.y = pk2(bflo(qp[i].y) * ep[2], bfhi(qp[i].y) * ep[3]); qo.z = pk2(bflo(qp[i].z) * ep[4], bfhi(qp[i].z) * ep[5]); qo.w = pk2(bflo(qp[i].w) * ep[6], bfhi(qp[i].w) * ep[7]);
                  ko.x = pk2(bflo(kp[i].x) * en[0], bfhi(kp[i].x) * en[1]); ko.y = pk2(bflo(kp[i].y) * en[2], bfhi(kp[i].y) * en[3]); ko.z = pk2(bflo(kp[i].z) * en[4], bfhi(kp[i].z) * en[5]); ko.w = pk2(bflo(kp[i].w) * en[6], bfhi(kp[i].w) * en[7]);
                  im[i][2 * dir] = qo; im[i][2 * dir + 1] = ko; } } }
        __syncthreads();
#pragma unroll
        for (int i = 0; i < 2; ++i) { const int pc = F.tid + NTHR * i, t = pc >> 4, d8 = (pc & 15) * 8;
#pragma unroll
            for (int k = 0; k < 4; ++k) *(LAS v4u*)(F.lds + GL_BC + k * 64 * GL_QK_PITCH + t * GL_QK_PITCH + d8 * 2) = im[i][k]; }
        __syncthreads();
        { const int dir = F.wave >> 2, nt = F.wave & 3;
          LAS unsigned char* qi = F.lds + GL_BC + (2 * dir) * 64 * GL_QK_PITCH; LAS unsigned char* ki = qi + 64 * GL_QK_PITCH;
          bf16x8v qf[4];
#pragma unroll
          for (int ks = 0; ks < 4; ++ks) qf[ks] = *(LAS bf16x8v*)(qi + (16 * nt + l15) * GL_QK_PITCH + (32 * ks + 8 * g) * 2);
#pragma unroll
          for (int mt = 0; mt < 4; ++mt) { f32x4 a = {0.f, 0.f, 0.f, 0.f};
              const bool live = dir ? (mt >= nt) : (mt <= nt);
              if (live) {
#pragma unroll
                  for (int ks = 0; ks < 4; ++ks) { const bf16x8v kf = *(LAS bf16x8v*)(ki + (16 * mt + l15) * GL_QK_PITCH + (32 * ks + 8 * g) * 2); a = __builtin_amdgcn_mfma_f32_16x16x32_bf16(kf, qf[ks], a, 0, 0, 0); } }
              const int tau = 16 * nt + l15, s0 = 16 * mt + 4 * g;
#pragma unroll
              for (int i = 0; i < 4; ++i) { const bool keep = dir ? (s0 + i >= tau) : (s0 + i <= tau); if (!keep) a[i] = 0.f; }
              v2u w; w.x = pk2(a[0], a[1]); w.y = pk2(a[2], a[3]);
              *(LAS v2u*)(F.lds + GL_A + dir * 64 * GL_A_PITCH + tau * GL_A_PITCH + s0 * 2) = w; } }
        __syncthreads();
        f32x4 acc[2][4];
#pragma unroll
        for (int mt = 0; mt < 2; ++mt)
#pragma unroll
            for (int nt = 0; nt < 4; ++nt) acc[mt][nt] = (f32x4){0.f, 0.f, 0.f, 0.f};
        { const unsigned v_a = lds_addr(F.lds + GL_V) + GL_V_PITCH * (8 * g + q4) + 8 * p + 2 * (32 * F.wave);
#pragma unroll
          for (int ks = 0; ks < 2; ++ks) { bf16x8v vf[2];
#pragma unroll
              for (int mt = 0; mt < 2; ++mt) vf[mt] = tr_frag(v_a + GL_V_PITCH * 32 * ks + 32 * mt, GL_V_PITCH * 4);
#pragma unroll
              for (int dir = 0; dir < 2; ++dir)
#pragma unroll
                  for (int nt = 0; nt < 4; ++nt) { const bf16x8v af = *(LAS bf16x8v*)(F.lds + GL_A + dir * 64 * GL_A_PITCH + (16 * nt + l15) * GL_A_PITCH + (32 * ks + 8 * g) * 2);
                      acc[0][nt] = __builtin_amdgcn_mfma_f32_16x16x32_bf16(vf[0], af, acc[0][nt], 0, 0, 0); acc[1][nt] = __builtin_amdgcn_mfma_f32_16x16x32_bf16(vf[1], af, acc[1][nt], 0, 0, 0); } } }
#pragma unroll
        for (int dir = 0; dir < 2; ++dir) { const int ch = (b * 2 + dir) * 4 + h, n = gla_scan_idx(cn, dir);
            const bf16* st = GLA_DST(ws) + ((size_t)ch * GLA_NCH + n) * 32768; LAS unsigned char* qi = F.lds + GL_BC + (2 * dir) * 64 * GL_QK_PITCH;
#pragma unroll
            for (int ks = 0; ks < 4; ++ks) { bf16x8v sf[2];
#pragma unroll
                for (int mt = 0; mt < 2; ++mt) sf[mt] = __builtin_bit_cast(bf16x8v, *(const GAS v4u*)(st + (size_t)(32 * F.wave + 16 * mt + l15) * 128 + 32 * ks + 8 * g));
#pragma unroll
                for (int nt = 0; nt < 4; ++nt) { const bf16x8v qf = *(LAS bf16x8v*)(qi + (16 * nt + l15) * GL_QK_PITCH + (32 * ks + 8 * g) * 2);
                    acc[0][nt] = __builtin_amdgcn_mfma_f32_16x16x32_bf16(sf[0], qf, acc[0][nt], 0, 0, 0); acc[1][nt] = __builtin_amdgcn_mfma_f32_16x16x32_bf16(sf[1], qf, acc[1][nt], 0, 0, 0); } } }
        LAS float* red = (LAS float*)(F.lds + GL_RED);
#pragma unroll
        for (int nt = 0; nt < 4; ++nt) { float s = 0.f;
#pragma unroll
            for (int mt = 0; mt < 2; ++mt)
#pragma unroll
                for (int i = 0; i < 4; ++i) s += acc[mt][nt][i] * acc[mt][nt][i];
            s += __shfl_xor(s, 16); s += __shfl_xor(s, 32);
            if (g == 0) red[F.wave * 64 + 16 * nt + l15] = s; }
        __syncthreads();
#pragma unroll
        for (int nt = 0; nt < 4; ++nt) { const int tau = 16 * nt + l15; float s = 0.f;
#pragma unroll
            for (int w = 0; w < 8; ++w) s += red[w * 64 + tau];
            const float rs = 1.0f / sqrtf(s * (1.0f / 256.0f) + LN_EPS); const size_t row = (size_t)(row0 + tau);
#pragma unroll
            for (int mt = 0; mt < 2; ++mt) { const int e = 32 * F.wave + 16 * mt + 4 * g;
                const v2u rw = *(const GAS v2u*)(U + row * NU + U_GR + h * 256 + e); const f32x4 g4 = *(const f32x4*)(ng + e);
                const float r0 = bflo(rw.x), r1 = bfhi(rw.x), r2 = bflo(rw.y), r3 = bfhi(rw.y);
                v2u w; w.x = pk2(acc[mt][nt][0] * rs * g4[0] * (r0 / (1.0f + __expf(-r0))), acc[mt][nt][1] * rs * g4[1] * (r1 / (1.0f + __expf(-r1))));
                w.y = pk2(acc[mt][nt][2] * rs * g4[2] * (r2 / (1.0f + __expf(-r2))), acc[mt][nt][3] * rs * g4[3] * (r3 / (1.0f + __expf(-r3))));
                *(GAS v2u*)(((bf16*)(ws + WS_Y + (size_t)MROWS * 1024 * 2)) + row * 1024 + h * 256 + e) = w; } }
    }
}
#ifndef MK_ONE_LAUNCH
#define MK_ONE_LAUNCH 0
#endif
constexpr int PH_PER_LAYER = 11, NPH = 2 + DEPTH * PH_PER_LAYER;
enum { PL_WIN = 0, PL_MIXA, PL_MIXB, PL_MIXC, PL_BR, PL_WOUT, PL_LN1, PL_GATHER, PL_FFN1, PL_FFN2, PL_LN2 };
__device__ __forceinline__ bool in_range(int lo, int hi, int k) { asm volatile("" : "+s"(lo), "+s"(hi)); return lo <= k && k < hi; }
__global__ void __launch_bounds__(NTHR, 2) fwd_kernel(Args A) {
    __shared__ __attribute__((aligned(16))) unsigned char lds[LDS_BYTES];
    LAS unsigned char* const ldsb = (LAS unsigned char*)lds;
    { Frame F = mkframe(ldsb, A.grid);
    for (int u = F.tid; u < (LDS_BYTES - LDSCTL_OFF) / 4; u += NTHR) ((LAS unsigned*)(F.lds + LDSCTL_OFF))[u] = 0u;
    __syncthreads();
    if (F.tid < 32) { const unsigned long long p = F.tid < 30 ? (unsigned long long)A.in[F.tid] : (F.tid == 30 ? (unsigned long long)A.out : (unsigned long long)A.ws);
        ((LAS unsigned long long*)(F.lds + PTAB_OFF))[F.tid] = p; }
    __syncthreads(); }
#if MK_ONE_LAUNCH
    XcdBarrier bar; { Frame F = mkframe(ldsb, A.grid); bar = xcd_barrier_post((unsigned*)(PWS() + WS_CTL) + CW_BAR, F.MISC + 8, (unsigned)A.grid); }
#define GRID_BAR() xcd_barrier(bar)
#else
#define GRID_BAR() do { if (F.tid == 0) __hip_atomic_store((gu32*)(PWS() + WS_CTL) + CW_TMO, 0xBADBA0u, RLX_AGENT); } while (0)
#endif
    const int lo = A.ph_lo, hi = A.ph_hi;
#ifndef PHMASK
#define PHMASK 0xFFFFFFFFu
#endif
#define IN(k) in_range(lo, hi, (k))
#define EN(bit) ((PHMASK >> (bit)) & 1u)
#define SEAM(k) do { if (IN((k) + 1)) GRID_BAR(); } while (0)
    LAS unsigned char* const ring = ldsb + RING_OFF;

    if (EN(0) && IN(0)) { Frame F = mkframe(ldsb, A.grid); p0a_prologue(F); SEAM(0); }
    if (EN(1) && IN(1)) { Frame F = mkframe(ldsb, A.grid); p0b_modulate(F); SEAM(1); }
    for (int L = 0; L < DEPTH; ++L) {
        const int pb = 2 + PH_PER_LAYER * L, Mr = (L == 0) ? MROWS : NLAT;
        if (EN(2) && IN(pb + PL_WIN)) { Frame F = mkframe(ldsb, A.grid);
            unsigned char* const ws = PWS();
            pg8::Gemm g{((bf16*)(ws + WS_H)), w_in_t(ws, L), MROWS, NU, D}; pg8::StaticOrder S; S.init(MROWS, NU, F.G, F.bx);
            pg8::EpiU E{((bf16*)(ws + WS_U)), NU};
            pg8::gemm_phase<pg8::EpiU, pg8::StaticOrder, true, true>(ring, g, S, E);
            SEAM(pb + PL_WIN);
        }
        if (EN(3) && IN(pb + PL_MIXA)) { Frame F = mkframe(ldsb, A.grid); gla_g1(F, L); mix_prep(F, L); SEAM(pb + PL_MIXA); }
        if (EN(4) && IN(pb + PL_MIXB)) { Frame F = mkframe(ldsb, A.grid); gla_g2(F); na_naive(F, L); SEAM(pb + PL_MIXB); }
        if (EN(5) && IN(pb + PL_MIXC)) { Frame F = mkframe(ldsb, A.grid); gla_g3(F, L); SEAM(pb + PL_MIXC); }
        if (EN(6) && IN(pb + PL_BR)) { Frame F = mkframe(ldsb, A.grid);
            unsigned char* const ws = PWS(); const float* const gate_b = PIN(17) + (size_t)L * 3 * D;
            for (int b = 0; b < 3; ++b) {
                pg8::Gemm g{b == 0 ? ((bf16*)(ws + WS_Y)) : (b == 1 ? ((bf16*)(ws + WS_Y + (size_t)MROWS * 1024 * 2)) : ((bf16*)(ws + WS_Y + (size_t)MROWS * 2048 * 2))), w_br_t(ws, L, b), Mr, D, 1024}; pg8::StaticOrder S; S.init(Mr, D, F.G, F.bx);
                pg8::EpiGate E{((bf16*)(ws + WS_U)) + U_GATE + b * D, NU, gate_b + b * D, ((float*)(ws + WS_Z)), ((bf16*)(ws + WS_ZB)), b == 0, b == 2};
                pg8::gemm_phase<pg8::EpiGate, pg8::StaticOrder, true, true>(ring, g, S, E);
            }
            SEAM(pb + PL_BR);
        }
        if (EN(7) && IN(pb + PL_WOUT)) { Frame F = mkframe(ldsb, A.grid);
            unsigned char* const ws = PWS(); const float* const modL = ((float*)(ws + WS_MOD)) + (size_t)L * 3 * 12288; const float* const xin = PIN(0); const float* const cin = PIN(2);
            pg8::Gemm g{((bf16*)(ws + WS_ZB)), w_out_t(ws, L), Mr, D, D}; pg8::StaticOrder S; S.init(Mr, D, F.G, F.bx);
            pg8::EpiRes E{L == 0 ? xin : ((float*)(ws + WS_XL)), L == 0 ? cin : ((float*)(ws + WS_XL)) + (size_t)NLAT * D, modL + 2 * D, 12288, ((float*)(ws + WS_PRE)), ALPHA};
            pg8::gemm_phase<pg8::EpiRes, pg8::StaticOrder, true, true>(ring, g, S, E);
            SEAM(pb + PL_WOUT);
        }
        if (EN(8) && IN(pb + PL_LN1)) { Frame F = mkframe(ldsb, A.grid); ln1_phase(F, L, Mr); SEAM(pb + PL_LN1); }
        if (L == 0) {
            if (EN(10) && IN(pb + PL_FFN1)) { Frame F = mkframe(ldsb, A.grid);
                unsigned char* const ws = PWS();
                pg8::Gemm g{((bf16*)(ws + WS_H)), w_gu_t(ws, -1), MROWS, NGU, D}; pg8::StaticOrder S; S.init(MROWS, NGU, F.G, F.bx);
                pg8::EpiSwiGLU E{((bf16*)(ws + WS_U)), FF};
                pg8::gemm_phase<pg8::EpiSwiGLU, pg8::StaticOrder, true, true>(ring, g, S, E);
                SEAM(pb + PL_FFN1);
            }
            if (EN(11) && IN(pb + PL_FFN2)) { Frame F = mkframe(ldsb, A.grid);
                unsigned char* const ws = PWS(); const float* const modL = ((float*)(ws + WS_MOD)) + (size_t)L * 3 * 12288;
                pg8::Gemm g{((bf16*)(ws + WS_U)), w_d_t(ws, -1), MROWS, D, FF}; pg8::StaticOrder S; S.init(MROWS, D, F.G, F.bx);
                pg8::EpiRes E{((float*)(ws + WS_XL)), ((float*)(ws + WS_XL)) + (size_t)NLAT * D, modL + 5 * D, 12288, ((float*)(ws + WS_PRE)), ALPHA};
                pg8::gemm_phase<pg8::EpiRes, pg8::StaticOrder, true, true>(ring, g, S, E);
                SEAM(pb + PL_FFN2);
            }
            if (EN(12) && IN(pb + PL_LN2)) { Frame F = mkframe(ldsb, A.grid); ln2_dense(F, L); SEAM(pb + PL_LN2); }
        } else {
            if (EN(9) && IN(pb + PL_GATHER)) { Frame F = mkframe(ldsb, A.grid); moe_gather(F); SEAM(pb + PL_GATHER); }
            if (EN(10) && IN(pb + PL_FFN1)) { Frame F = mkframe(ldsb, A.grid);
                unsigned char* const ws = PWS();
                unsigned cnt[8]; int pp[9]; moe_prefix(ws, cnt, pp);
                pg8::Gemm g{((bf16*)(ws + WS_GLA)), w_gu_t(ws, 0), 0, NGU, D}; pg8::MoeOrder S; S.init(cnt, NGU / 256, F.G, F.bx);
                pg8::EpiSwiGLU E{((bf16*)(ws + WS_U)), FF};
                pg8::gemm_phase<pg8::EpiSwiGLU, pg8::MoeOrder, true, true>(ring, g, S, E);
                SEAM(pb + PL_FFN1);
            }
            if (EN(11) && IN(pb + PL_FFN2)) { Frame F = mkframe(ldsb, A.grid);
                unsigned char* const ws = PWS(); const float* const modL = ((float*)(ws + WS_MOD)) + (size_t)L * 3 * 12288;
                unsigned cnt[8]; int pp[9]; moe_prefix(ws, cnt, pp);
                pg8::Gemm g{((bf16*)(ws + WS_U)), w_d_t(ws, 0), 0, D, FF}; pg8::MoeOrder S; S.init(cnt, D / 256, F.G, F.bx);
                pg8::EpiF32Plain E{((float*)(ws + WS_Z)), D};
                pg8::gemm_phase<pg8::EpiF32Plain, pg8::MoeOrder, true, true>(ring, g, S, E);
                SEAM(pb + PL_FFN2);
            }
            if (EN(12) && IN(pb + PL_LN2)) { Frame F = mkframe(ldsb, A.grid); ln2_moe(F, L); }
        }
    }
#undef IN
#undef SEAM
}

extern "C" void kernel_launch(void* const* d_in, const int* in_sizes, int n_in, void* d_out, int out_size, void* d_ws, size_t ws_size, hipStream_t stream) {
    static int grid = 0;
    if (grid == 0) {
        if (n_in != 30 || out_size != NLAT * D || ws_size < WS_END) { fprintf(stderr, "kernel_launch: unexpected shapes (n_in %d out %d ws %zu); nothing launched\n", n_in, out_size, ws_size); grid = -1; return; }
        int dev = 0, cus = 0, per_cu = 0;
        if (hipGetDevice(&dev) != hipSuccess || hipDeviceGetAttribute(&cus, hipDeviceAttributeMultiprocessorCount, dev) != hipSuccess) { grid = -1; return; }
        if (hipOccupancyMaxActiveBlocksPerMultiprocessor(&per_cu, (const void*)fwd_kernel, NTHR, 0) != hipSuccess || per_cu < 1) { fprintf(stderr, "kernel_launch: occupancy query says %d\n", per_cu); (void)hipGetLastError(); grid = -1; return; }
        grid = cus;
    }
    if (grid < 0) return;
    (void)hipMemsetAsync((char*)d_ws + WS_CTL, 0, CTL_ZERO_BYTES, stream);
    Args a{};
    for (int i = 0; i < 30; ++i) a.in[i] = (const float*)d_in[i];
    a.out = (float*)d_out; a.ws = (unsigned char*)d_ws; a.grid = grid;
#if MK_ONE_LAUNCH
    a.ph_lo = 0; a.ph_hi = NPH;
    hipLaunchKernelGGL(fwd_kernel, dim3(grid), dim3(NTHR), 0, stream, a);
#else
#ifndef NPH_RUN
#define NPH_RUN NPH
#endif
    for (int p = 0; p < NPH_RUN; ++p) {
        if (p == 2 + PL_GATHER) continue;
        a.ph_lo = p; a.ph_hi = p + 1;
        hipLaunchKernelGGL(fwd_kernel, dim3(grid), dim3(NTHR), 0, stream, a);
    }
#endif
}
```

```cpp
#define MK_ONE_LAUNCH 1
#include <hip/hip_runtime.h>
#include <cstdio>

namespace pg8 {
#define PG8_LAS __attribute__((address_space(3)))
typedef unsigned short bf16_t;
typedef short bf16x8 __attribute__((ext_vector_type(8)));
typedef float f32x4 __attribute__((ext_vector_type(4)));
typedef unsigned u32x4 __attribute__((ext_vector_type(4)));
typedef unsigned u32x2 __attribute__((ext_vector_type(2)));
constexpr int BM = 256, BK = 64, HALF = 128, HTB = HALF * BK * 2  , STAGE_BYTES = 8 * HTB, NXCD = 8, WGM = 8;

__host__ __device__ __forceinline__ int lds_byte(int r, int c) { const int st = (r >> 4) * 2 + (c >> 5), rr = r & 15, cc = c & 31, ob = rr * 64 + cc * 2; return st * 1024 + (ob ^ (((ob >> 9) & 1) << 5)); }
__host__ __device__ __forceinline__ void stage_rc(int b, int& R, int& C) { const int st = b / 1024, sb = b % 1024, swz = sb ^ (((sb >> 9) & 1) << 5); R = (st >> 1) * 16 + swz / 64; C = (st & 1) * 32 + (swz % 64) / 2; }
__host__ __device__ __forceinline__ int perm32(int rho) { const int n = rho >> 4, i = rho & 15; return 8 * (i >> 2) + 4 * n + (i & 3); }

struct Unit { int pm, pn, pb; };
struct Gemm { const bf16_t* A; const bf16_t* Bt; int M, N, K; };

__device__ __forceinline__ int xcd_remap(int wgid, int nwg) { const int q = nwg / NXCD, r = nwg % NXCD, xcd = wgid % NXCD, off = wgid / NXCD; return (xcd < r ? xcd * (q + 1) : r * (q + 1) + (xcd - r) * q) + off; }
struct StaticOrder {
    int nM, nN, nwg, G, c;
    __host__ __device__ void init(int M, int N, int G_, int c_) { nM = M / BM; nN = N / BM; nwg = nM * nN; G = G_; c = c_; }
    __device__ __forceinline__ bool next(int i, Unit& u) const {
        const long L = (long)i * G + c; if (L >= nwg) return false;
        const int wgid = xcd_remap((int)L, nwg);
        const int nig = WGM * nN, gid = wgid / nig, fm = gid * WGM, gsz = (nM - fm) < WGM ? (nM - fm) : WGM;
        u.pm = fm + ((wgid % nig) % gsz); u.pn = (wgid % nig) / gsz; u.pb = u.pn; return true;
    }
    __device__ __forceinline__ void a_ready(const Unit&) const {}
    __device__ __forceinline__ void done(const Unit&) const {}
};
struct MoeOrder {
    int nN, G, c, nunits; int pp[9];
    __device__ __forceinline__ void init(const unsigned* cnt, int nN_, int G_, int c_) { nN = nN_; G = G_; c = c_; pp[0] = 0;
#pragma unroll
        for (int e = 0; e < 8; ++e) pp[e + 1] = pp[e] + (int)((cnt[e] + 255u) >> 8);
        nunits = pp[8] * nN; }
    __device__ __forceinline__ bool next(int i, Unit& u) const {
        const long L = (long)i * G + c; if (L >= nunits) return false;
        const int wgid = xcd_remap((int)L, nunits);
        int e = 0, base = 0, npe = pp[1];
#pragma unroll
        for (int k = 1; k < 8; ++k) { if (wgid >= pp[k] * nN) { e = k; base = pp[k]; npe = pp[k + 1] - pp[k]; } }
        if (npe < 1) npe = 1;
        const int local = wgid - base * nN;
        u.pm = base + local % npe; u.pn = local / npe; u.pb = e * nN + u.pn; return true;
    }
    __device__ __forceinline__ void a_ready(const Unit&) const {}
    __device__ __forceinline__ void done(const Unit&) const {}
};

__device__ __forceinline__ unsigned cvt_pk_bf16(float lo, float hi) { unsigned r; asm volatile("v_cvt_pk_bf16_f32 %0, %1, %2" : "=v"(r) : "v"(lo), "v"(hi)); return r; }
__device__ __forceinline__ float bf_lo(unsigned w) { return __uint_as_float(w << 16); }
__device__ __forceinline__ float bf_hi(unsigned w) { return __uint_as_float(w & 0xffff0000u); }
__device__ __forceinline__ float fast_sigmoid(float x) { return __builtin_amdgcn_rcpf(1.0f + __expf(-x)); }

struct EpiBf16Plain {
    static constexpr bool PERM = true, AFTER_DRAIN = false;
    bf16_t* O; int ldc;
    __device__ __forceinline__ void operator()(const f32x4 (&acc)[2][2][4][2], const Unit& u, int wr, int wc, int fr, int fq) const {
        const int row0 = u.pm * BM + wr * 64 + fr, col0 = u.pn * BM + wc * 32 + 8 * fq;
#pragma unroll
        for (int ai = 0; ai < 2; ++ai)
#pragma unroll
            for (int m = 0; m < 4; ++m) { bf16_t* rowp = O + (size_t)(row0 + ai * HALF + m * 16) * ldc + col0;
#pragma unroll
                for (int bj = 0; bj < 2; ++bj) { const f32x4 v0 = acc[ai][bj][m][0], v1 = acc[ai][bj][m][1];
                    u32x4 w; w.x = cvt_pk_bf16(v0[0], v0[1]); w.y = cvt_pk_bf16(v0[2], v0[3]); w.z = cvt_pk_bf16(v1[0], v1[1]); w.w = cvt_pk_bf16(v1[2], v1[3]);
                    *(u32x4*)(rowp + bj * HALF) = w; } }
    }
};
struct EpiU {
    static constexpr bool PERM = true, AFTER_DRAIN = false;
    bf16_t* O; int ldc;
    __device__ __forceinline__ void operator()(const f32x4 (&acc)[2][2][4][2], const Unit& u, int wr, int wc, int fr, int fq) const {
        const int row0 = u.pm * BM + wr * 64 + fr, col0 = u.pn * BM + wc * 32 + 8 * fq;
        const bool is_gq = (u.pn == 12 || u.pn == 13), is_gk = (u.pn == 14 || u.pn == 15), is_nq = (u.pn >= 24 && u.pn < 28);
        const float sc = (is_gq || is_nq) ? 0.08838834764831845f : 1.0f;
        const bool rope = (is_gq || is_gk) && u.pm < 32;
        float inv[4];
#pragma unroll
        for (int j = 0; j < 4; ++j) inv[j] = exp2f(-(float)((16 * wc + 4 * fq + j) & 31) * 0.41524101186092029f);
#pragma unroll
        for (int ai = 0; ai < 2; ++ai)
#pragma unroll
            for (int m = 0; m < 4; ++m) { const int row = row0 + ai * HALF + m * 16; bf16_t* rowp = O + (size_t)row * ldc + col0;
                const int t = row & 4095; const float pos = (wc < 2) ? (float)(t >> 6) : (float)(t & 63);
                float cs[4], sn[4];
                if (rope) {
#pragma unroll
                    for (int j = 0; j < 4; ++j) { const float ang = pos * inv[j]; cs[j] = __cosf(ang); sn[j] = __sinf(ang); } }
#pragma unroll
                for (int bj = 0; bj < 2; ++bj) { f32x4 v0 = acc[ai][bj][m][0] * sc, v1 = acc[ai][bj][m][1] * sc;
                    if (rope) { const f32x4 a = v0, b = v1;
                        v0[0] = a[0] * cs[0] - a[1] * sn[0]; v0[1] = a[0] * sn[0] + a[1] * cs[0]; v0[2] = a[2] * cs[1] - a[3] * sn[1]; v0[3] = a[2] * sn[1] + a[3] * cs[1];
                        v1[0] = b[0] * cs[2] - b[1] * sn[2]; v1[1] = b[0] * sn[2] + b[1] * cs[2]; v1[2] = b[2] * cs[3] - b[3] * sn[3]; v1[3] = b[2] * sn[3] + b[3] * cs[3]; }
                    u32x4 w; w.x = cvt_pk_bf16(v0[0], v0[1]); w.y = cvt_pk_bf16(v0[2], v0[3]); w.z = cvt_pk_bf16(v1[0], v1[1]); w.w = cvt_pk_bf16(v1[2], v1[3]);
                    *(u32x4*)(rowp + bj * HALF) = w; } }
    }
};
struct EpiF32Plain {
    static constexpr bool PERM = false, AFTER_DRAIN = false;
    float* C; int ldc;
    __device__ __forceinline__ void operator()(const f32x4 (&acc)[2][2][4][2], const Unit& u, int wr, int wc, int fr, int fq) const {
        const int row0 = u.pm * BM + wr * 64 + fr, col0 = u.pn * BM + wc * 32 + 4 * fq;
#pragma unroll
        for (int ai = 0; ai < 2; ++ai)
#pragma unroll
            for (int m = 0; m < 4; ++m) { float* rowp = C + (size_t)(row0 + ai * HALF + m * 16) * ldc + col0;
#pragma unroll
                for (int bj = 0; bj < 2; ++bj)
#pragma unroll
                    for (int n = 0; n < 2; ++n) *(f32x4*)(rowp + bj * HALF + n * 16) = acc[ai][bj][m][n]; }
    }
};
struct EpiGate {
    static constexpr bool PERM = false, AFTER_DRAIN = false;
    const bf16_t* Ug; int ldu;
    const float* gb;
    float* Z; bf16_t* ZB; int first, last;
    __device__ __forceinline__ void operator()(const f32x4 (&acc)[2][2][4][2], const Unit& u, int wr, int wc, int fr, int fq) const {
        const int row0 = u.pm * BM + wr * 64 + fr, col0 = u.pn * BM + wc * 32 + 4 * fq;
#pragma unroll
        for (int ai = 0; ai < 2; ++ai)
#pragma unroll
            for (int m = 0; m < 4; ++m) { const size_t row = (size_t)(row0 + ai * HALF + m * 16);
#pragma unroll
                for (int bj = 0; bj < 2; ++bj)
#pragma unroll
                    for (int n = 0; n < 2; ++n) { const int col = col0 + bj * HALF + n * 16;
                        const u32x2 gl = *(const u32x2*)(Ug + row * ldu + col); const f32x4 b4 = *(const f32x4*)(gb + col);
                        f32x4 v = acc[ai][bj][m][n];
                        v[0] *= fast_sigmoid(bf_lo(gl.x) + b4[0]); v[1] *= fast_sigmoid(bf_hi(gl.x) + b4[1]); v[2] *= fast_sigmoid(bf_lo(gl.y) + b4[2]); v[3] *= fast_sigmoid(bf_hi(gl.y) + b4[3]);
                        if (!first) v += *(const f32x4*)(Z + row * 2048 + col);
                        if (!last) *(f32x4*)(Z + row * 2048 + col) = v;
                        else { u32x2 w; w.x = cvt_pk_bf16(v[0], v[1]); w.y = cvt_pk_bf16(v[2], v[3]); *(u32x2*)(ZB + row * 2048 + col) = w; } } }
    }
};
struct EpiRes {
    static constexpr bool PERM = false, AFTER_DRAIN = false;
    const float* res_lat; const float* res_ctx; const float* gv; int gstride; float* out; float alpha;
    __device__ __forceinline__ void operator()(const f32x4 (&acc)[2][2][4][2], const Unit& u, int wr, int wc, int fr, int fq) const {
        const int grp = u.pm < 16 ? 0 : (u.pm < 32 ? 1 : 2);
        const float* res = u.pm < 32 ? res_lat + (size_t)u.pm * BM * 2048 : res_ctx + (size_t)(u.pm - 32) * BM * 2048;
        const float* g = gv + (size_t)grp * gstride;
        const int rl0 = wr * 64 + fr, col0 = u.pn * BM + wc * 32 + 4 * fq;
#pragma unroll
        for (int ai = 0; ai < 2; ++ai)
#pragma unroll
            for (int m = 0; m < 4; ++m) { const int rl = rl0 + ai * HALF + m * 16;
#pragma unroll
                for (int bj = 0; bj < 2; ++bj)
#pragma unroll
                    for (int n = 0; n < 2; ++n) { const int col = col0 + bj * HALF + n * 16;
                        const f32x4 r4 = *(const f32x4*)(res + (size_t)rl * 2048 + col); const f32x4 g4 = *(const f32x4*)(g + col);
                        *(f32x4*)(out + ((size_t)u.pm * BM + rl) * 2048 + col) = r4 * alpha + g4 * acc[ai][bj][m][n]; } }
    }
};
struct EpiSwiGLU {
    static constexpr bool PERM = true, AFTER_DRAIN = false;
    bf16_t* O; int ldc;
    __device__ __forceinline__ void operator()(const f32x4 (&acc)[2][2][4][2], const Unit& u, int wr, int wc, int fr, int fq) const {
        const int row0 = u.pm * BM + wr * 64 + fr, col0 = u.pn * HALF + wc * 32 + 8 * fq;
#pragma unroll
        for (int ai = 0; ai < 2; ++ai)
#pragma unroll
            for (int m = 0; m < 4; ++m) { bf16_t* rowp = O + (size_t)(row0 + ai * HALF + m * 16) * ldc + col0;
                float h[8];
#pragma unroll
                for (int n = 0; n < 2; ++n)
#pragma unroll
                    for (int j = 0; j < 4; ++j) { const float gt = acc[ai][0][m][n][j], up = acc[ai][1][m][n][j]; h[n * 4 + j] = gt * fast_sigmoid(gt) * up; }
                u32x4 w; w.x = cvt_pk_bf16(h[0], h[1]); w.y = cvt_pk_bf16(h[2], h[3]); w.z = cvt_pk_bf16(h[4], h[5]); w.w = cvt_pk_bf16(h[6], h[7]);
                *(u32x4*)rowp = w; }
    }
};

template <class Epi, class Sched, bool ALIGN_EPI = false, bool SP2 = false>
__device__ __forceinline__ void gemm_phase(PG8_LAS unsigned char* lds, const Gemm g, const Sched& S, const Epi& E) {
    int tid_ = threadIdx.x; asm volatile("" : "+v"(tid_));
    const int tid = tid_, wid = __builtin_amdgcn_readfirstlane(tid >> 6), lane = tid & 63, wr = wid >> 2, wc = wid & 3, fr = lane & 15, fq = lane >> 4;
    const int K = g.K, nt = K / BK;
    unsigned voffA[2], voffB[2];
#pragma unroll
    for (int i = 0; i < 2; ++i) { int R, C; stage_rc(tid * 16 + i * 8192, R, C); const int Rb = Epi::PERM ? ((R & ~31) + perm32(R & 31)) : R;
        voffA[i] = (unsigned)(R * K + C) * 2u; voffB[i] = (unsigned)(Rb * K + C) * 2u; }
    const size_t kstep = (size_t)(BK * 2);
    const size_t hstep = (size_t)HALF * K * 2;
    const size_t tstep = 2 * hstep;
    const unsigned ldsw = (unsigned)wid * 1024u;
    const int aoff = lds_byte(wr * 64 + fr, fq * 8), boff = lds_byte(wc * 32 + fr, fq * 8);
#define PG8_SA(b, h) (((b) * 2 + (h)) * HTB)
#define PG8_SB(b, h) ((4 + (b) * 2 + (h)) * HTB)
#define PG8_STAGE(bufoff, gbase, voff) do { _Pragma("unroll") for (int _i = 0; _i < 2; ++_i) \
        __builtin_amdgcn_global_load_lds((const unsigned*)((const char*)(gbase) + (voff)[_i]), (PG8_LAS unsigned*)(lds + (bufoff) + ldsw + _i * 8192), 16, 0, 0); } while (0)
#define PG8_LDA(dst, b, h) do { _Pragma("unroll") for (int m = 0; m < 4; ++m) _Pragma("unroll") for (int k = 0; k < 2; ++k) dst[m][k] = *(const PG8_LAS bf16x8*)(lds + PG8_SA(b, h) + aoff + m * 2048 + k * 1024); } while (0)
#define PG8_LDB(dst, b, h) do { _Pragma("unroll") for (int n = 0; n < 2; ++n) _Pragma("unroll") for (int k = 0; k < 2; ++k) dst[n][k] = *(const PG8_LAS bf16x8*)(lds + PG8_SB(b, h) + boff + n * 2048 + k * 1024); } while (0)
#define PG8_MMA(ai, bj, At, Bt) do { __builtin_amdgcn_s_setprio(1); _Pragma("unroll") for (int m = 0; m < 4; ++m) _Pragma("unroll") for (int n = 0; n < 2; ++n) _Pragma("unroll") for (int k = 0; k < 2; ++k) \
        acc[ai][bj][m][n] = __builtin_amdgcn_mfma_f32_16x16x32_bf16(Bt[n][k], At[m][k], acc[ai][bj][m][n], 0, 0, 0); __builtin_amdgcn_s_setprio(0); } while (0)
#define PG8_WAIT_V(n) asm volatile("s_waitcnt vmcnt(" #n ")" ::: "memory")
#define PG8_WAIT_L(n) asm volatile("s_waitcnt lgkmcnt(" #n ")" ::: "memory")
#define PG8_BAR __builtin_amdgcn_s_barrier()
#define PG8_SCHED __builtin_amdgcn_sched_barrier(0)
    Unit cur, nxt; int ui = 0;
    if (!S.next(0, cur)) return;
    f32x4 acc[2][2][4][2];
#pragma unroll
    for (int a = 0; a < 2; ++a)
#pragma unroll
        for (int b = 0; b < 2; ++b)
#pragma unroll
            for (int m = 0; m < 4; ++m)
#pragma unroll
                for (int n = 0; n < 2; ++n) acc[a][b][m][n] = (f32x4){0.f, 0.f, 0.f, 0.f};
    bf16x8 At[4][2], B0[2][2], B1[2][2];
    const char* cA = (const char*)g.A + (size_t)cur.pm * tstep; const char* cB = (const char*)g.Bt + (size_t)cur.pb * tstep;
    S.a_ready(cur);
    if constexpr (SP2) {
        PG8_STAGE(PG8_SB(0, 0), cB, voffB); PG8_STAGE(PG8_SB(0, 1), cB + hstep, voffB); PG8_STAGE(PG8_SA(0, 0), cA, voffA); PG8_STAGE(PG8_SA(0, 1), cA + hstep, voffA);
        if (wr == 1) PG8_BAR;
        PG8_WAIT_V(2); PG8_BAR;
        PG8_STAGE(PG8_SB(1, 0), cB + kstep, voffB); PG8_STAGE(PG8_SA(1, 0), cA + kstep, voffA); PG8_STAGE(PG8_SB(1, 1), cB + hstep + kstep, voffB);
        PG8_WAIT_V(6); PG8_BAR;
    } else {
        PG8_STAGE(PG8_SB(0, 0), cB, voffB); PG8_STAGE(PG8_SA(0, 0), cA, voffA); PG8_STAGE(PG8_SB(0, 1), cB + hstep, voffB); PG8_STAGE(PG8_SA(0, 1), cA + hstep, voffA);
        if (wr == 1) PG8_BAR;
        PG8_WAIT_V(4); PG8_BAR;
        PG8_STAGE(PG8_SB(1, 0), cB + kstep, voffB); PG8_STAGE(PG8_SA(1, 0), cA + kstep, voffA); PG8_STAGE(PG8_SB(1, 1), cB + hstep + kstep, voffB);
        PG8_WAIT_V(6); PG8_BAR;
    }
    for (;;) {
        const bool has_next = S.next(ui + 1, nxt);
        const char* nA = has_next ? (const char*)g.A + (size_t)nxt.pm * tstep : cA; const char* nB = has_next ? (const char*)g.Bt + (size_t)nxt.pb * tstep : cB;
        for (int t = 0; t < nt; t += 2) {
            const bool last = (t == nt - 2);
            const char* a1 = cA + (size_t)(t + 1) * kstep;
            const char* a2 = last ? nA : cA + (size_t)(t + 2) * kstep; const char* b2 = last ? nB : cB + (size_t)(t + 2) * kstep;
            const char* a3 = a2 + kstep; const char* b3 = b2 + kstep;
            if (last && has_next) S.a_ready(nxt);
            if constexpr (SP2) {
            PG8_LDB(B0, 0, 0); PG8_LDB(B1, 0, 1); PG8_SCHED; PG8_LDA(At, 0, 0); PG8_STAGE(PG8_SA(1, 1), a1 + hstep, voffA);
            PG8_WAIT_V(8); PG8_WAIT_L(0); PG8_BAR; PG8_MMA(0, 0, At, B0); PG8_MMA(0, 1, At, B1); PG8_BAR; PG8_SCHED;
            PG8_LDA(At, 0, 1); PG8_STAGE(PG8_SB(0, 0), b2, voffB); PG8_STAGE(PG8_SB(0, 1), b2 + hstep, voffB); PG8_STAGE(PG8_SA(0, 0), a2, voffA);
            PG8_WAIT_V(8); PG8_WAIT_L(0); PG8_BAR; PG8_MMA(1, 0, At, B0); PG8_MMA(1, 1, At, B1); PG8_BAR; PG8_SCHED;
            PG8_LDB(B0, 1, 0); PG8_LDB(B1, 1, 1); PG8_SCHED; PG8_LDA(At, 1, 0); PG8_STAGE(PG8_SA(0, 1), a2 + hstep, voffA);
            PG8_WAIT_V(8); PG8_WAIT_L(0); PG8_BAR; PG8_MMA(0, 0, At, B0); PG8_MMA(0, 1, At, B1); PG8_BAR; PG8_SCHED;
            PG8_LDA(At, 1, 1); PG8_STAGE(PG8_SB(1, 0), b3, voffB); PG8_STAGE(PG8_SB(1, 1), b3 + hstep, voffB); PG8_STAGE(PG8_SA(1, 0), a3, voffA);
            PG8_WAIT_V(8); PG8_WAIT_L(0); PG8_BAR; PG8_MMA(1, 0, At, B0); PG8_MMA(1, 1, At, B1); PG8_BAR; PG8_SCHED;
            } else {
            PG8_LDB(B0, 0, 0); PG8_SCHED; PG8_LDA(At, 0, 0); PG8_STAGE(PG8_SA(1, 1), a1 + hstep, voffA);
            PG8_WAIT_L(8); PG8_BAR; PG8_WAIT_L(0); PG8_MMA(0, 0, At, B0); PG8_BAR; PG8_SCHED;
            PG8_LDB(B1, 0, 1); PG8_STAGE(PG8_SB(0, 0), b2, voffB);
            PG8_BAR; PG8_WAIT_L(0); PG8_MMA(0, 1, At, B1); PG8_BAR;
            PG8_LDA(At, 0, 1); PG8_STAGE(PG8_SA(0, 0), a2, voffA);
            PG8_BAR; PG8_WAIT_L(0); PG8_MMA(1, 0, At, B0); PG8_BAR; PG8_SCHED;
            PG8_STAGE(PG8_SB(0, 1), b2 + hstep, voffB);
            PG8_WAIT_V(6); PG8_BAR; PG8_MMA(1, 1, At, B1); PG8_BAR;
            PG8_LDB(B0, 1, 0); PG8_SCHED; PG8_LDA(At, 1, 0); PG8_STAGE(PG8_SA(0, 1), a2 + hstep, voffA);
            PG8_WAIT_L(8); PG8_BAR; PG8_WAIT_L(0); PG8_MMA(0, 0, At, B0); PG8_BAR; PG8_SCHED;
            PG8_LDB(B1, 1, 1); PG8_STAGE(PG8_SB(1, 0), b3, voffB);
            PG8_BAR; PG8_WAIT_L(0); PG8_MMA(0, 1, At, B1); PG8_BAR;
            PG8_LDA(At, 1, 1); PG8_STAGE(PG8_SA(1, 0), a3, voffA);
            PG8_BAR; PG8_WAIT_L(0); PG8_MMA(1, 0, At, B0); PG8_BAR; PG8_SCHED;
            PG8_STAGE(PG8_SB(1, 1), b3 + hstep, voffB);
            PG8_WAIT_V(6); PG8_BAR; PG8_MMA(1, 1, At, B1); PG8_BAR;
            }
        }
        if constexpr (ALIGN_EPI) { if (wr == 0) PG8_BAR; }
        if constexpr (!Epi::AFTER_DRAIN) { E(acc, cur, wr, wc, fr, fq); S.done(cur); }
        if (!has_next) break;
#pragma unroll
        for (int a = 0; a < 2; ++a)
#pragma unroll
            for (int b = 0; b < 2; ++b)
#pragma unroll
                for (int m = 0; m < 4; ++m)
#pragma unroll
                    for (int n = 0; n < 2; ++n) acc[a][b][m][n] = (f32x4){0.f, 0.f, 0.f, 0.f};
        cur = nxt; cA = nA; cB = nB; ++ui;
        if constexpr (ALIGN_EPI) { if (wr == 1) PG8_BAR; }
    }
    PG8_WAIT_V(0);
    if constexpr (!ALIGN_EPI) { if (wr == 0) PG8_BAR; }
    PG8_BAR;
    if constexpr (Epi::AFTER_DRAIN) { E.fused(acc, cur, wr, wc, fr, fq, lds, wid, lane); S.done(cur); }
#undef PG8_SA
#undef PG8_SB
#undef PG8_STAGE
#undef PG8_LDA
#undef PG8_LDB
#undef PG8_MMA
#undef PG8_WAIT_V
#undef PG8_WAIT_L
#undef PG8_BAR
#undef PG8_SCHED
}
}

constexpr int NWAVES = 8, NTHR = 512;
constexpr int D = 2048, SEQ = 4096, NLAT = 8192, CTXL = 256, NCTX = 512, MROWS = 8704, DEPTH = 2;
constexpr int INC = 15392, NU = 15360;
constexpr int U_CB = 0, U_CC = 1024, U_CX = 2048, U_GQ = 3072, U_GK = 3584, U_GV = 4096, U_GR = 5120, U_NQ = 6144, U_NK = 7168, U_NV = 8192, U_GATE = 9216;
constexpr int LR_COL = 6144;
constexpr int FF = 5632, NGU = 2 * FF, NE = 8;
constexpr float LN_EPS = 1e-5f, ALPHA = 1.41421356237f;
constexpr int MOE_MAXP = 72;

constexpr size_t MiB = 1u << 20;
constexpr size_t WS_CTL = 0, CTL_ZERO_BYTES = 1 * MiB;
constexpr size_t WS_MOD = 1 * MiB;
constexpr size_t WS_WLR = 1 * MiB + 512 * 1024;
constexpr size_t WS_ROUTE = 2 * MiB;
constexpr size_t WS_TOK = 2 * MiB + 256 * 1024;
constexpr size_t WS_LR = 3 * MiB;
constexpr size_t WS_W = 8 * MiB;
constexpr size_t W_IN_B = (size_t)NU * D * 2, W_BR_B = (size_t)1024 * D * 2, W_OUT_B = (size_t)D * D * 2, W_LAYER_B = W_IN_B + 3 * W_BR_B + W_OUT_B;
constexpr size_t W_GU_B = (size_t)NGU * D * 2, W_D_B = (size_t)D * FF * 2, W_FFN_B = W_GU_B + W_D_B;
constexpr size_t WS_WFFN = WS_W + 2 * W_LAYER_B, WS_WMOE = WS_WFFN + W_FFN_B, WS_WEND = WS_WMOE + 8 * W_FFN_B;
constexpr size_t WS_XL = 762 * MiB;
constexpr size_t WS_H = 830 * MiB;
constexpr size_t WS_U = 864 * MiB;
constexpr size_t WS_Y = 1119 * MiB;
constexpr size_t WS_GLA = 1170 * MiB;
constexpr size_t WS_Z = 1306 * MiB;
constexpr size_t WS_ZB = 1374 * MiB;
constexpr size_t WS_PRE = 1408 * MiB;
constexpr size_t WS_END = 1476 * MiB;
static_assert(WS_WEND <= WS_XL && WS_XL + (size_t)MROWS * D * 4 <= WS_H && WS_H + (size_t)MROWS * D * 2 <= WS_U && WS_U + (size_t)MROWS * NU * 2 <= WS_Y, "ws map 1");
static_assert(WS_U + (size_t)MOE_MAXP * 256 * FF * 2 <= WS_Y && WS_Y + 3 * (size_t)MROWS * 1024 * 2 <= WS_GLA && WS_GLA + (size_t)MROWS * (4 * 512 + 2 * 1024) * 4 <= WS_Z, "ws map 2");
static_assert(WS_GLA + (size_t)MOE_MAXP * 256 * D * 2 <= WS_Z && WS_Z + (size_t)MOE_MAXP * 256 * D * 4 <= WS_END && WS_PRE + (size_t)MROWS * D * 4 <= WS_END, "ws map 3");
constexpr int CW_TMO = 0, CW_CODE = 1;
constexpr int CW_MOECNT = 64;
constexpr int CW_BAR = 4096;

constexpr int RING_OFF = 0, RING_BYTES = 131072;
constexpr int LDSCTL_OFF = RING_BYTES, MISC_OFF = LDSCTL_OFF + 320;
constexpr int LDS_BYTES = 147456;

#define GAS __attribute__((address_space(1)))
#define LAS __attribute__((address_space(3)))
typedef unsigned short bf16;
typedef unsigned v4u __attribute__((ext_vector_type(4)));
typedef unsigned v2u __attribute__((ext_vector_type(2)));
typedef float f32x4 __attribute__((ext_vector_type(4)));
typedef GAS unsigned gu32;
#define RLX_AGENT __ATOMIC_RELAXED, __HIP_MEMORY_SCOPE_AGENT
#define LDS_WAIT() asm volatile("s_waitcnt lgkmcnt(0)" ::: "memory")
#define VM_WAIT() asm volatile("s_waitcnt vmcnt(0)" ::: "memory")
__device__ __forceinline__ unsigned f2bf(float f) { unsigned u = __builtin_bit_cast(unsigned, f); return (u + 0x7fffu + ((u >> 16) & 1u)) >> 16; }
__device__ __forceinline__ unsigned pk2(float lo, float hi) { return f2bf(lo) | (f2bf(hi) << 16); }
__device__ __forceinline__ float bflo(unsigned w) { return __uint_as_float(w << 16); }
__device__ __forceinline__ float bfhi(unsigned w) { return __uint_as_float(w & 0xffff0000u); }
__device__ __forceinline__ float bf1(bf16 b) { return __uint_as_float(((unsigned)b) << 16); }
__device__ __forceinline__ float wave_sum(float v) {
#pragma unroll
    for (int o = 1; o < 64; o <<= 1) v += __shfl_xor(v, o);
    return v;
}
__device__ __forceinline__ float wave_max(float v) {
#pragma unroll
    for (int o = 1; o < 64; o <<= 1) v = fmaxf(v, __shfl_xor(v, o));
    return v;
}

#define XB_TMO      128
#define XB_XCNT(j)  (256  + 64 * (j))
#define XB_XSUB(j)  (1280 + 64 * (j))
#define XB_XGEN(j)  (2304 + 64 * (j))
#define XB_TOP      3328
#define XB_TOPGEN   3392
#define XCD_BAR_WORDS 3456
#define XB_SPIN_CAP (1u << 18)

__device__ __forceinline__ unsigned xb_ld(unsigned* p)              { return __hip_atomic_load(p, __ATOMIC_RELAXED, __HIP_MEMORY_SCOPE_AGENT); }
__device__ __forceinline__ unsigned xb_add(unsigned* p, unsigned v) { return __hip_atomic_fetch_add(p, v, __ATOMIC_RELAXED, __HIP_MEMORY_SCOPE_AGENT); }
__device__ __forceinline__ unsigned xb_xcc_id() { return (unsigned)__builtin_amdgcn_s_getreg((3 << 11) | 20) & 0xFu; }
#define XB_SPIN(cond, bar) do { unsigned _sp = 0; while (cond) { __builtin_amdgcn_s_sleep(1); \
    if ((++_sp & 255u) == 0u) { if (xb_ld(&(bar)[XB_TMO])) break; if (_sp > XB_SPIN_CAP) { atomicAdd(&(bar)[XB_TMO], 1u); break; } } } } while (0)

struct XcdBarrier {
    unsigned* bar; unsigned x; unsigned grid;
    volatile LAS unsigned* st;
};

__device__ __forceinline__ XcdBarrier xcd_barrier_post(unsigned* bar, volatile LAS unsigned* st, unsigned grid) {
    XcdBarrier b; b.grid = grid; b.bar = bar; b.x = xb_xcc_id(); b.st = st;
    if (threadIdx.x == 0) (void)xb_add(&bar[XB_XCNT(b.x)], 1u);
    return b;
}
__device__ __forceinline__ void xcd_barrier_complete(unsigned* bar, unsigned x, unsigned& nloc, unsigned& nx, unsigned b_grid) {
    const unsigned G = b_grid;
    unsigned sum, cnt, mine, sp = 0u;
    for (;;) {
        sum = 0u; cnt = 0u; mine = 0u;
#pragma unroll
        for (unsigned j = 0; j < 16; ++j) { const unsigned c = xb_ld(&bar[XB_XCNT(j)]); sum += c; cnt += (c > 0u) ? 1u : 0u; mine = (j == x) ? c : mine; }
        if (sum == G) break;
        __builtin_amdgcn_s_sleep(1);
        if ((++sp & 255u) == 0u) { if (xb_ld(&bar[XB_TMO])) break; if (sp > XB_SPIN_CAP) { atomicAdd(&bar[XB_TMO], 1u); break; } }
    }
    nloc = mine > 0u ? mine : 1u; nx = cnt > 0u ? cnt : 1u;
}

__device__ __forceinline__ void xcd_barrier(const XcdBarrier& b) {
    asm volatile("s_waitcnt vmcnt(0)" ::: "memory");
    __syncthreads();
    if (threadIdx.x == 0) {
        unsigned* bar = b.bar;
        __builtin_amdgcn_s_waitcnt(0);
        unsigned nloc = b.st[0], nx = b.st[1];
        if (nloc == 0u) { xcd_barrier_complete(bar, b.x, nloc, nx, b.grid); b.st[0] = nloc; b.st[1] = nx; }
        const unsigned old = xb_add(&bar[XB_XSUB(b.x)], 1u);
        const unsigned gen = old / nloc;
        if (old + 1u == (gen + 1u) * nloc) {
            __builtin_amdgcn_fence(__ATOMIC_RELEASE, "agent");
            asm volatile("s_waitcnt vmcnt(0)" ::: "memory");
            const unsigned og = xb_add(&bar[XB_TOP], 1u);
            const unsigned tg = og / nx;
            if (og + 1u == (tg + 1u) * nx) xb_add(&bar[XB_TOPGEN], 1u);
            else XB_SPIN(xb_ld(&bar[XB_TOPGEN]) == tg, bar);
            __builtin_amdgcn_fence(__ATOMIC_ACQUIRE, "agent");
            xb_add(&bar[XB_XGEN(b.x)], 1u);
            asm volatile("s_waitcnt vmcnt(0)" ::: "memory");
        } else {
            XB_SPIN(xb_ld(&bar[XB_XGEN(b.x)]) == gen, bar);
            __builtin_amdgcn_fence(__ATOMIC_ACQUIRE, "agent");
            asm volatile("s_waitcnt vmcnt(0)" ::: "memory");
        }
    }
    __syncthreads();
}

struct Args { const float* in[30]; float* out; unsigned char* ws; int ph_lo, ph_hi, grid, pad; };
struct Frame {
    LAS unsigned char* lds;
    volatile LAS unsigned* MISC;
    int tid, lane, wave, vcu, G, bx;
};
__device__ __forceinline__ Frame mkframe(LAS unsigned char* lds, int grid) {
    Frame F; int t = threadIdx.x; asm volatile("" : "+v"(t)); int g = grid, bx = blockIdx.x; asm volatile("" : "+s"(g), "+s"(bx));
    F.lds = lds; F.MISC = (volatile LAS unsigned*)(lds + MISC_OFF); F.tid = t; F.lane = t & 63; F.wave = __builtin_amdgcn_readfirstlane(t >> 6); F.G = g; F.bx = bx;
    F.vcu = (g % 8 == 0) ? (bx % 8) * (g / 8) + bx / 8 : bx; return F;
}
constexpr int PTAB_OFF = LDSCTL_OFF + 1024, PT_OUT = 30, PT_WS = 31;
__device__ __forceinline__ unsigned long long ldp_raw(Frame& F, int i) {
    const volatile LAS unsigned* t = (const volatile LAS unsigned*)(F.lds + PTAB_OFF) + 2 * i; const unsigned lo = t[0], hi = t[1];
    return ((unsigned long long)(unsigned)__builtin_amdgcn_readfirstlane((int)hi) << 32) | (unsigned)__builtin_amdgcn_readfirstlane((int)lo);
}
#define PIN(i) ((const float*)(const GAS float*)ldp_raw(F, (i)))
#define POUT() ((float*)(GAS float*)ldp_raw(F, PT_OUT))
#define PWS() ((unsigned char*)(GAS unsigned char*)ldp_raw(F, PT_WS))
__device__ __forceinline__ bf16* w_in_t(unsigned char* ws, int L) { return (bf16*)(ws + WS_W + (size_t)L * W_LAYER_B); }
__device__ __forceinline__ bf16* w_br_t(unsigned char* ws, int L, int b) { return (bf16*)(ws + WS_W + (size_t)L * W_LAYER_B + W_IN_B + (size_t)b * W_BR_B); }
__device__ __forceinline__ bf16* w_out_t(unsigned char* ws, int L) { return (bf16*)(ws + WS_W + (size_t)L * W_LAYER_B + W_IN_B + 3 * W_BR_B); }
__device__ __forceinline__ bf16* w_gu_t(unsigned char* ws, int e) { return (bf16*)(ws + (e < 0 ? WS_WFFN : WS_WMOE + (size_t)e * W_GU_B)); }
__device__ __forceinline__ bf16* w_d_t(unsigned char* ws, int e) { return (bf16*)(ws + (e < 0 ? WS_WFFN + W_GU_B : WS_WMOE + 8 * W_GU_B + (size_t)e * W_D_B)); }

__device__ __forceinline__ void transpose_item(const float* W, int K, int N, bf16* WT, int drow, LAS float* scr, int kb, int nb, int lane) {
    const int k0 = 64 * kb, n0 = 32 * nb;
#pragma unroll 8
    for (int i = 0; i < 32; ++i) { const int kk = 2 * i + (lane >> 5); scr[kk * 33 + (lane & 31)] = W[(size_t)(k0 + kk) * N + n0 + (lane & 31)]; }
    LDS_WAIT(); asm volatile("" ::: "memory");
    const int c = lane & 7;
#pragma unroll
    for (int j = 0; j < 4; ++j) { const int n = (lane >> 3) + 8 * j; const LAS float* s = scr + (8 * c) * 33 + n;
        v4u o; o.x = pk2(s[0 * 33], s[1 * 33]); o.y = pk2(s[2 * 33], s[3 * 33]); o.z = pk2(s[4 * 33], s[5 * 33]); o.w = pk2(s[6 * 33], s[7 * 33]);
        *(GAS v4u*)(WT + (size_t)(drow + n) * K + k0 + 8 * c) = o; }
    LDS_WAIT(); asm volatile("" ::: "memory");
}
template <int MODE> __device__ __forceinline__ void conv_matrix(Frame& F, const float* W, int K, int N, bf16* WT) {
    LAS float* scr = (LAS float*)(F.lds + RING_OFF + F.wave * 16384);
    const int gw = F.vcu * NWAVES + F.wave, NGW = F.G * NWAVES;
    const int nblk = N / 32, nitems = (K / 64) * nblk;
    for (int it = gw; it < nitems; it += NGW) {
        const int kb = it / nblk, nb = it % nblk; int drow;
        if (MODE == 0) drow = 32 * nb;
        else if (MODE == 1) { if (nb == LR_COL / 32) continue; drow = nb < LR_COL / 32 ? 32 * nb : 32 * (nb - 1); }
        else if (MODE == 2) drow = 256 * (nb >> 2) + 32 * (nb & 3);
        else drow = 256 * (nb >> 2) + 128 + 32 * (nb & 3);
        transpose_item(W, K, N, WT, drow, scr, kb, nb, F.lane);
    }
}
__device__ __forceinline__ void ada_item(Frame& F, unsigned char* ws, const float* cnd, const float* cctx, const float* ada_w, const float* ada_b, int item) {
    const int L = item / 96, c0 = (item % 96) * 128;
    LAS float* sc = (LAS float*)(F.lds + RING_OFF);
    LAS float* red = (LAS float*)(F.lds + RING_OFF + 24576);
    for (int i = F.tid; i < 3 * D; i += NTHR) { const int g = i / D, k = i % D; const float v = g < 2 ? cnd[g * D + k] : cctx[k]; sc[i] = v / (1.0f + __expf(-v)); }
    __syncthreads();
    const float* W = ada_w + (size_t)L * D * 12288 + c0 + 2 * F.lane;
    float a00 = 0.f, a01 = 0.f, a10 = 0.f, a11 = 0.f, a20 = 0.f, a21 = 0.f;
    const int kb = 256 * F.wave;
#pragma unroll 8
    for (int k = kb; k < kb + 256; ++k) { const float2 w = *(const float2*)(W + (size_t)k * 12288); const float s0 = sc[k], s1 = sc[D + k], s2 = sc[2 * D + k];
        a00 += s0 * w.x; a01 += s0 * w.y; a10 += s1 * w.x; a11 += s1 * w.y; a20 += s2 * w.x; a21 += s2 * w.y; }
    red[(F.wave * 3 + 0) * 128 + 2 * F.lane] = a00; red[(F.wave * 3 + 0) * 128 + 2 * F.lane + 1] = a01;
    red[(F.wave * 3 + 1) * 128 + 2 * F.lane] = a10; red[(F.wave * 3 + 1) * 128 + 2 * F.lane + 1] = a11;
    red[(F.wave * 3 + 2) * 128 + 2 * F.lane] = a20; red[(F.wave * 3 + 2) * 128 + 2 * F.lane + 1] = a21;
    __syncthreads();
    if (F.tid < 384) { const int g = F.tid / 128, cc = F.tid % 128; float s = 0.f;
#pragma unroll
        for (int w = 0; w < 8; ++w) s += red[(w * 3 + g) * 128 + cc];
        ((float*)(ws + WS_MOD))[((size_t)L * 3 + g) * 12288 + c0 + cc] = s + ada_b[L * 12288 + c0 + cc]; }
    __syncthreads();
}
__device__ __forceinline__ void p0a_prologue(Frame& F) {
    unsigned char* const ws = PWS();
    { const float* cnd = PIN(1); const float* cctx = PIN(3); const float* ada_w = PIN(4); const float* ada_b = PIN(5);
      for (int it = F.bx; it < 192; it += F.G) ada_item(F, ws, cnd, cctx, ada_w, ada_b, it); }
    const float* const w_in = PIN(6);
    { const int gt = F.bx * NTHR + F.tid, NGT = F.G * NTHR;
      for (int i = gt; i < DEPTH * D * 32; i += NGT) { const int o = i & 31, k = (i >> 5) % D, L = i / (32 * D); ((float*)(ws + WS_WLR))[((size_t)L * 32 + o) * D + k] = w_in[((size_t)L * D + k) * INC + LR_COL + o]; } }
    for (int L = 0; L < DEPTH; ++L) {
        conv_matrix<1>(F, w_in + (size_t)L * D * INC, D, INC, w_in_t(ws, L));
        for (int b = 0; b < 3; ++b) conv_matrix<0>(F, (b == 0 ? PIN(14) : (b == 1 ? PIN(15) : PIN(16))) + (size_t)L * 1024 * D, 1024, D, w_br_t(ws, L, b));
        conv_matrix<0>(F, PIN(18) + (size_t)L * D * D, D, D, w_out_t(ws, L));
    }
    conv_matrix<2>(F, PIN(23), D, FF, w_gu_t(ws, -1)); conv_matrix<3>(F, PIN(24), D, FF, w_gu_t(ws, -1)); conv_matrix<0>(F, PIN(25), FF, D, w_d_t(ws, -1));
    for (int e = 0; e < NE; ++e) {
        conv_matrix<2>(F, PIN(27) + (size_t)e * D * FF, D, FF, w_gu_t(ws, e)); conv_matrix<3>(F, PIN(28) + (size_t)e * D * FF, D, FF, w_gu_t(ws, e));
        conv_matrix<0>(F, PIN(29) + (size_t)e * FF * D, FF, D, w_d_t(ws, e));
    }
}

__device__ __forceinline__ int row_group(int r) { return r < SEQ ? 0 : (r < NLAT ? 1 : 2); }
__device__ __forceinline__ void load_row(const float* p, int lane, f32x4 (&v)[8]) {
#pragma unroll
    for (int j = 0; j < 8; ++j) v[j] = *(const GAS f32x4*)(p + 4 * lane + 256 * j);
}
__device__ __forceinline__ void store_row(float* p, int lane, const f32x4 (&v)[8]) {
#pragma unroll
    for (int j = 0; j < 8; ++j) *(GAS f32x4*)(p + 4 * lane + 256 * j) = v[j];
}
__device__ __forceinline__ void store_row_bf16(bf16* p, int lane, const f32x4 (&v)[8]) {
#pragma unroll
    for (int j = 0; j < 8; ++j) { v2u w; w.x = pk2(v[j][0], v[j][1]); w.y = pk2(v[j][2], v[j][3]); *(GAS v2u*)(p + 4 * lane + 256 * j) = w; }
}
__device__ __forceinline__ void modulate(f32x4 (&v)[8], const float* shift, const float* scale, int lane) {
#pragma unroll
    for (int j = 0; j < 8; ++j) { const f32x4 sh = *(const f32x4*)(shift + 4 * lane + 256 * j), sc = *(const f32x4*)(scale + 4 * lane + 256 * j); v[j] = v[j] * (sc + 1.0f) + sh; }
}
__device__ __forceinline__ void layer_norm_row(f32x4 (&v)[8], const float* g, const float* b, int lane) {
    float s = 0.f;
#pragma unroll
    for (int j = 0; j < 8; ++j) s += (v[j][0] + v[j][1]) + (v[j][2] + v[j][3]);
    const float mean = wave_sum(s) * (1.0f / D); float q = 0.f;
#pragma unroll
    for (int j = 0; j < 8; ++j) { v[j] = v[j] - mean; q += (v[j][0] * v[j][0] + v[j][1] * v[j][1]) + (v[j][2] * v[j][2] + v[j][3] * v[j][3]); }
    const float rstd = 1.0f / sqrtf(wave_sum(q) * (1.0f / D) + LN_EPS);
#pragma unroll
    for (int j = 0; j < 8; ++j) { const f32x4 g4 = *(const f32x4*)(g + 4 * lane + 256 * j), b4 = *(const f32x4*)(b + 4 * lane + 256 * j); v[j] = v[j] * rstd * g4 + b4; }
}
__device__ __forceinline__ void emit_h_lr(Frame& F, unsigned char* ws, const f32x4 (&h)[8], int r, int L) {
    store_row_bf16(((bf16*)(ws + WS_H)) + (size_t)r * D, F.lane, h);
    const float* wl = ((float*)(ws + WS_WLR)) + (size_t)L * 32 * D + 4 * F.lane; float keep = 0.f;
    for (int o = 0; o < 32; ++o) { float s = 0.f;
#pragma unroll
        for (int j = 0; j < 8; ++j) { const f32x4 w = *(const f32x4*)(wl + (size_t)o * D + 256 * j); s += (h[j][0] * w[0] + h[j][1] * w[1]) + (h[j][2] * w[2] + h[j][3] * w[3]); }
        s = wave_sum(s); if (F.lane == o) keep = s; }
    if (F.lane < 32) ((float*)(ws + WS_LR))[(size_t)r * 32 + F.lane] = keep;
}
__device__ __forceinline__ void p0b_modulate(Frame& F) {
    unsigned char* const ws = PWS(); const float* const xin = PIN(0); const float* const cin = PIN(2);
    const int gw = F.vcu * NWAVES + F.wave, NGW = F.G * NWAVES;
    for (int r = gw; r < MROWS; r += NGW) {
        f32x4 v[8]; load_row(r < NLAT ? xin + (size_t)r * D : cin + (size_t)(r - NLAT) * D, F.lane, v);
        const float* m = ((float*)(ws + WS_MOD)) + (size_t)row_group(r) * 12288;
        modulate(v, m, m + D, F.lane); emit_h_lr(F, ws, v, r, 0);
    }
}

__device__ __forceinline__ void mix_prep(Frame& F, int L) {
    unsigned char* const ws = PWS();
    const int gt = F.bx * NTHR + F.tid, NGT = F.G * NTHR;
    const float* cw = PIN(7) + (size_t)L * 3 * 1024;
    for (int i = gt; i < MROWS * 128; i += NGT) {
        const int r = i >> 7, c8 = (i & 127) * 8;
        const int t = r < NLAT ? (r & (SEQ - 1)) : ((r - NLAT) & (CTXL - 1)), T = r < NLAT ? SEQ : CTXL;
        float acc[8];
#pragma unroll
        for (int j = 0; j < 8; ++j) acc[j] = 0.f;
#pragma unroll
        for (int k = 0; k < 3; ++k) { const int tt = t + k - 1; if (tt < 0 || tt >= T) continue;
            const bf16* up = ((bf16*)(ws + WS_U)) + (size_t)(r + k - 1) * NU; const v4u a = *(const GAS v4u*)(up + U_CC + c8), b = *(const GAS v4u*)(up + U_CX + c8);
            const f32x4 w0 = *(const f32x4*)(cw + k * 1024 + c8), w1 = *(const f32x4*)(cw + k * 1024 + c8 + 4);
            acc[0] += w0[0] * bflo(a.x) * bflo(b.x); acc[1] += w0[1] * bfhi(a.x) * bfhi(b.x); acc[2] += w0[2] * bflo(a.y) * bflo(b.y); acc[3] += w0[3] * bfhi(a.y) * bfhi(b.y);
            acc[4] += w1[0] * bflo(a.z) * bflo(b.z); acc[5] += w1[1] * bfhi(a.z) * bfhi(b.z); acc[6] += w1[2] * bflo(a.w) * bflo(b.w); acc[7] += w1[3] * bfhi(a.w) * bfhi(b.w); }
        const v4u ab = *(const GAS v4u*)(((bf16*)(ws + WS_U)) + (size_t)r * NU + U_CB + c8);
        v4u o; o.x = pk2(acc[0] * bflo(ab.x), acc[1] * bfhi(ab.x)); o.y = pk2(acc[2] * bflo(ab.y), acc[3] * bfhi(ab.y)); o.z = pk2(acc[4] * bflo(ab.z), acc[5] * bfhi(ab.z)); o.w = pk2(acc[6] * bflo(ab.w), acc[7] * bfhi(ab.w));
        *(GAS v4u*)(((bf16*)(ws + WS_Y)) + (size_t)r * 1024 + c8) = o;
    }
}
__device__ __forceinline__ void ln1_phase(Frame& F, int L, int M) {
    unsigned char* const ws = PWS(); const float* const lng = PIN(19) + L * D; const float* const lnb = PIN(20) + L * D; const float* const router = PIN(26);
    const int gw = F.vcu * NWAVES + F.wave, NGW = F.G * NWAVES;
    for (int r = gw; r < M; r += NGW) {
        f32x4 v[8]; load_row(((float*)(ws + WS_PRE)) + (size_t)r * D, F.lane, v);
        layer_norm_row(v, lng, lnb, F.lane);
        store_row(((float*)(ws + WS_XL)) + (size_t)r * D, F.lane, v);
        const float* m = ((float*)(ws + WS_MOD)) + ((size_t)L * 3 + row_group(r)) * 12288;
        modulate(v, m + 3 * D, m + 4 * D, F.lane);
        store_row_bf16(((bf16*)(ws + WS_H)) + (size_t)r * D, F.lane, v);
        if (L == 1) {
            float lg[8];
#pragma unroll
            for (int e = 0; e < 8; ++e) lg[e] = 0.f;
#pragma unroll
            for (int j = 0; j < 8; ++j)
#pragma unroll
                for (int i = 0; i < 4; ++i) { const float* rp = router + (size_t)(4 * F.lane + 256 * j + i) * 8; const f32x4 w0 = *(const f32x4*)rp, w1 = *(const f32x4*)(rp + 4); const float hv = v[j][i];
                    lg[0] += hv * w0[0]; lg[1] += hv * w0[1]; lg[2] += hv * w0[2]; lg[3] += hv * w0[3]; lg[4] += hv * w1[0]; lg[5] += hv * w1[1]; lg[6] += hv * w1[2]; lg[7] += hv * w1[3]; }
#pragma unroll
            for (int e = 0; e < 8; ++e) lg[e] = wave_sum(lg[e]);
            int e0 = 0; float v0 = lg[0];
#pragma unroll
            for (int e = 1; e < 8; ++e) if (lg[e] > v0) { v0 = lg[e]; e0 = e; }
            int e1 = -1; float v1 = -INFINITY;
#pragma unroll
            for (int e = 0; e < 8; ++e) if (e != e0 && lg[e] > v1) { v1 = lg[e]; e1 = e; }
            if (F.lane == 0) {
                const float w0 = 1.0f / (1.0f + __expf(v1 - v0)), w1 = 1.0f - w0;
                const unsigned p0 = __hip_atomic_fetch_add(((gu32*)(ws + WS_CTL)) + CW_MOECNT + 64 * e0, 1u, RLX_AGENT), p1 = __hip_atomic_fetch_add(((gu32*)(ws + WS_CTL)) + CW_MOECNT + 64 * e1, 1u, RLX_AGENT);
                ((int*)(ws + WS_TOK))[e0 * NLAT + p0] = r; ((int*)(ws + WS_TOK))[e1 * NLAT + p1] = r;
                unsigned* rt = ((unsigned*)(ws + WS_ROUTE)) + (size_t)r * 8; rt[0] = e0; rt[1] = p0; rt[2] = __float_as_uint(w0); rt[3] = e1; rt[4] = p1; rt[5] = __float_as_uint(w1);
            }
        }
    }
}
__device__ __forceinline__ void moe_prefix(unsigned char* ws, unsigned (&cnt)[8], int (&pp)[9]) {
    pp[0] = 0;
#pragma unroll
    for (int e = 0; e < 8; ++e) { cnt[e] = __hip_atomic_load(((gu32*)(ws + WS_CTL)) + CW_MOECNT + 64 * e, RLX_AGENT); pp[e + 1] = pp[e] + (int)((cnt[e] + 255u) >> 8); }
}
__device__ __forceinline__ void moe_gather(Frame& F) {
    unsigned char* const ws = PWS();
    const int gw = F.vcu * NWAVES + F.wave, NGW = F.G * NWAVES;
    unsigned cnt[8]; int pp[9]; moe_prefix(ws, cnt, pp);
    for (int s = gw; s < pp[8] * 256; s += NGW) {
        const int p = s >> 8; int e = 0, base = 0; unsigned ce = cnt[0];
#pragma unroll
        for (int k = 1; k < 8; ++k) if (p >= pp[k]) { e = k; base = pp[k]; ce = cnt[k]; }
        const unsigned pos = (unsigned)(s - base * 256);
        GAS v4u* dst = (GAS v4u*)(((bf16*)(ws + WS_GLA)) + (size_t)s * D) + F.lane;
        if (pos < ce) { const int tkn = ((int*)(ws + WS_TOK))[e * NLAT + pos]; const GAS v4u* src = (const GAS v4u*)(((bf16*)(ws + WS_H)) + (size_t)tkn * D) + F.lane;
#pragma unroll
            for (int j = 0; j < 4; ++j) dst[64 * j] = src[64 * j]; }
        else {
#pragma unroll
            for (int j = 0; j < 4; ++j) dst[64 * j] = (v4u){0u, 0u, 0u, 0u}; }
    }
}
__device__ __forceinline__ void ln2_dense(Frame& F, int L) {
    unsigned char* const ws = PWS(); const float* const lng = PIN(21) + L * D; const float* const lnb = PIN(22) + L * D;
    const int gw = F.vcu * NWAVES + F.wave, NGW = F.G * NWAVES;
    for (int r = gw; r < MROWS; r += NGW) {
        f32x4 v[8]; load_row(((float*)(ws + WS_PRE)) + (size_t)r * D, F.lane, v);
        layer_norm_row(v, lng, lnb, F.lane);
        store_row(((float*)(ws + WS_XL)) + (size_t)r * D, F.lane, v);
        const float* m = ((float*)(ws + WS_MOD)) + ((size_t)(L + 1) * 3 + row_group(r)) * 12288;
        modulate(v, m, m + D, F.lane); emit_h_lr(F, ws, v, r, L + 1);
    }
}
__device__ __forceinline__ void ln2_moe(Frame& F, int L) {
    unsigned char* const ws = PWS(); const float* const lng = PIN(21) + L * D; const float* const lnb = PIN(22) + L * D; float* const outp = POUT();
    const int gw = F.vcu * NWAVES + F.wave, NGW = F.G * NWAVES;
    unsigned cnt[8]; int pp[9]; moe_prefix(ws, cnt, pp);
    for (int r = gw; r < NLAT; r += NGW) {
        const unsigned* rt = ((unsigned*)(ws + WS_ROUTE)) + (size_t)r * 8; const int e0 = rt[0], e1 = rt[3]; const float w0 = __uint_as_float(rt[2]), w1 = __uint_as_float(rt[5]);
        int b0 = 0, b1 = 0;
#pragma unroll
        for (int k = 1; k < 8; ++k) { if (e0 >= k) b0 = pp[k]; if (e1 >= k) b1 = pp[k]; }
        const size_t s0 = (size_t)b0 * 256 + rt[1], s1 = (size_t)b1 * 256 + rt[4];
        f32x4 v[8], y0[8], y1[8]; load_row(((float*)(ws + WS_XL)) + (size_t)r * D, F.lane, v); load_row(((float*)(ws + WS_Z)) + s0 * D, F.lane, y0); load_row(((float*)(ws + WS_Z)) + s1 * D, F.lane, y1);
        const float* g2 = ((float*)(ws + WS_MOD)) + ((size_t)L * 3 + row_group(r)) * 12288 + 5 * D;
#pragma unroll
        for (int j = 0; j < 8; ++j) { const f32x4 g4 = *(const f32x4*)(g2 + 4 * F.lane + 256 * j); v[j] = v[j] * ALPHA + g4 * (y0[j] * w0 + y1[j] * w1); }
        layer_norm_row(v, lng, lnb, F.lane);
        store_row(outp + (size_t)r * D, F.lane, v);
    }
}

constexpr int GLA_NCH = 68;
constexpr size_t GLA_DST_BYTES = (size_t)16 * GLA_NCH * 256 * 128 * 2;
#define GLA_DST(ws) ((bf16*)((ws) + WS_GLA))
#define GLA_DEC(ws) ((float*)((ws) + WS_GLA + GLA_DST_BYTES))
typedef short bf16x8v __attribute__((ext_vector_type(8)));
__device__ __forceinline__ int gla_chunk_row0(int b, int cn) { return cn < 4 ? NLAT + CTXL * b + 64 * cn : SEQ * b + 64 * (cn - 4); }
__device__ __forceinline__ int gla_scan_idx(int cn, int dir) { return dir ? (cn < 4 ? 3 - cn : 71 - cn) : cn; }
__device__ __forceinline__ float log_sigmoid16(float z) { return (fminf(z, 0.f) - __logf(1.0f + __expf(-fabsf(z)))) * (1.0f / 16.0f); }
__device__ __forceinline__ bf16x8v tr_frag(unsigned addr, unsigned pitch4) {
    v2u lo, hi;
    asm volatile("ds_read_b64_tr_b16 %0, %2\n\tds_read_b64_tr_b16 %1, %3\n\ts_waitcnt lgkmcnt(0)" : "=&v"(lo), "=&v"(hi) : "v"(addr), "v"(addr + pitch4) : "memory");
    v4u r; r.x = lo.x; r.y = lo.y; r.z = hi.x; r.w = hi.y; return __builtin_bit_cast(bf16x8v, r);
}
__device__ __forceinline__ unsigned lds_addr(LAS unsigned char* p) { return (unsigned)(size_t)p; }
constexpr int GL_BC = 0;
constexpr int GL_TOT = 65536;
constexpr int GL_V = 71680;
constexpr int GL_A = 105472;
constexpr int GL_STG = 105472;
constexpr int GL_RED = 124928;
constexpr int GL_QK_PITCH = 272, GL_V_PITCH = 528, GL_A_PITCH = 144;
static_assert(GL_STG + 25600 <= RING_BYTES && GL_V + 64 * GL_V_PITCH <= GL_A && GL_TOT + 4096 + 1024 <= GL_V && 4 * 64 * GL_QK_PITCH <= GL_V, "GLA LDS map");

__device__ __forceinline__ void gla_decays(Frame& F, unsigned char* ws, const float* wgf, const float* bgf, const float* wgb, const float* bgb, int row0, int h, int d0, int d1) {
    LAS float* lr = (LAS float*)(F.lds + GL_STG); LAS float* wg = lr + 64 * 32; LAS float* bg = wg + 2 * 16 * 128;
    LAS float* bc = (LAS float*)(F.lds + GL_BC); LAS float* tot = (LAS float*)(F.lds + GL_TOT);
    { const int t = F.tid >> 3, o4 = (F.tid & 7) * 4; *(LAS f32x4*)(lr + t * 32 + o4) = *(const GAS f32x4*)(((float*)(ws + WS_LR)) + (size_t)(row0 + t) * 32 + o4); }
    for (int i = F.tid; i < 1024; i += NTHR) { const int dir = i >> 9, o = (i >> 5) & 15, d4 = (i & 31) * 4; *(LAS f32x4*)(wg + (dir * 16 + o) * 128 + d4) = *(const GAS f32x4*)((dir ? wgb : wgf) + o * 512 + h * 128 + d4); }
    if (F.tid < 64) { const int dir = F.tid >> 5, d4 = (F.tid & 31) * 4; *(LAS f32x4*)(bg + dir * 128 + d4) = *(const GAS f32x4*)((dir ? bgb : bgf) + h * 128 + d4); }
    __syncthreads();
    { const int t = F.tid >> 3, dg = (F.tid & 7) * 16;
      for (int dir = d0; dir < d1; ++dir) {
          f32x4 z[4];
#pragma unroll
          for (int j = 0; j < 4; ++j) z[j] = *(LAS f32x4*)(bg + dir * 128 + dg + 4 * j);
#pragma unroll
          for (int o = 0; o < 16; ++o) { const float l = lr[t * 32 + dir * 16 + o];
#pragma unroll
              for (int j = 0; j < 4; ++j) z[j] += l * *(LAS f32x4*)(wg + (dir * 16 + o) * 128 + dg + 4 * j); }
#pragma unroll
          for (int j = 0; j < 4; ++j) { f32x4 g; g[0] = log_sigmoid16(z[j][0]); g[1] = log_sigmoid16(z[j][1]); g[2] = log_sigmoid16(z[j][2]); g[3] = log_sigmoid16(z[j][3]); *(LAS f32x4*)(bc + dir * 8192 + t * 128 + dg + 4 * j) = g; } } }
    __syncthreads();
    { const int d = F.tid & 127, seg = F.tid >> 7;
      for (int dir = d0; dir < d1; ++dir) { float a = 0.f;
#pragma unroll
          for (int i = 0; i < 16; ++i) { const int s = seg * 16 + i, t = dir ? 63 - s : s; a += bc[dir * 8192 + t * 128 + d]; bc[dir * 8192 + t * 128 + d] = a; }
          tot[(dir * 4 + seg) * 128 + d] = a; } }
    __syncthreads();
    { const int d = F.tid & 127, seg = F.tid >> 7;
      for (int dir = d0; dir < d1; ++dir) { float pre = 0.f, all = 0.f;
#pragma unroll
          for (int s2 = 0; s2 < 4; ++s2) { const float v = tot[(dir * 4 + s2) * 128 + d]; all += v; if (s2 < seg) pre += v; }
          if (seg == 0) tot[1024 + dir * 128 + d] = all;
          if (seg > 0) {
#pragma unroll
              for (int i = 0; i < 16; ++i) { const int s = seg * 16 + i, t = dir ? 63 - s : s; bc[dir * 8192 + t * 128 + d] += pre; } } } }
    __syncthreads();
}
__device__ __forceinline__ void gla_stage_v(Frame& F, const bf16* U, int row0, int h) {
#pragma unroll
    for (int i = 0; i < 4; ++i) { const int p = F.tid + NTHR * i, t = p >> 5, e8 = (p & 31) * 8;
        *(LAS v4u*)(F.lds + GL_V + t * GL_V_PITCH + e8 * 2) = *(const GAS v4u*)(U + (size_t)(row0 + t) * NU + U_GV + h * 256 + e8); }
}
__device__ __forceinline__ void gla_g1(Frame& F, int L) {
    unsigned char* const ws = PWS(); const bf16* U = (const bf16*)(ws + WS_U);
    const float* wgf = PIN(8) + (size_t)L * 16 * 512; const float* bgf = PIN(9) + L * 512; const float* wgb = PIN(10) + (size_t)L * 16 * 512; const float* bgb = PIN(11) + L * 512;
    const int g = F.lane >> 4, q4 = (F.lane & 15) >> 2, p = F.lane & 3, l15 = F.lane & 15;
    for (int task = F.vcu; task < 16 * GLA_NCH; task += F.G) {
        const int cn = task % GLA_NCH, ch = task / GLA_NCH, h = ch & 3, dir = (ch >> 2) & 1, b = ch >> 3;
        const int row0 = gla_chunk_row0(b, cn), n = gla_scan_idx(cn, dir);
        __syncthreads();
        gla_stage_v(F, U, row0, h);
        v4u kp[2];
#pragma unroll
        for (int i = 0; i < 2; ++i) { const int pc = F.tid + NTHR * i, t = pc >> 4, d8 = (pc & 15) * 8; kp[i] = *(const GAS v4u*)(U + (size_t)(row0 + t) * NU + U_GK + h * 128 + d8); }
        gla_decays(F, ws, wgf, bgf, wgb, bgb, row0, h, dir, dir + 1);
        LAS float* bc = (LAS float*)(F.lds + GL_BC) + dir * 8192; LAS float* bl = (LAS float*)(F.lds + GL_TOT) + 1024 + dir * 128;
        if (F.tid < 128) GLA_DEC(ws)[((size_t)ch * GLA_NCH + n) * 128 + F.tid] = __expf(bl[F.tid]);
        LAS unsigned char* ke = F.lds + GL_BC + (dir ? 0 : 32768);
#pragma unroll
        for (int i = 0; i < 2; ++i) { const int pc = F.tid + NTHR * i, t = pc >> 4, d8 = (pc & 15) * 8;
            const f32x4 b0 = *(LAS f32x4*)(bc + t * 128 + d8), b1 = *(LAS f32x4*)(bc + t * 128 + d8 + 4), l0 = *(LAS f32x4*)(bl + d8), l1 = *(LAS f32x4*)(bl + d8 + 4);
            v4u o; o.x = pk2(bflo(kp[i].x) * __expf(l0[0] - b0[0]), bfhi(kp[i].x) * __expf(l0[1] - b0[1])); o.y = pk2(bflo(kp[i].y) * __expf(l0[2] - b0[2]), bfhi(kp[i].y) * __expf(l0[3] - b0[3]));
            o.z = pk2(bflo(kp[i].z) * __expf(l1[0] - b1[0]), bfhi(kp[i].z) * __expf(l1[1] - b1[1])); o.w = pk2(bflo(kp[i].w) * __expf(l1[2] - b1[2]), bfhi(kp[i].w) * __expf(l1[3] - b1[3]));
            *(LAS v4u*)(ke + t * GL_QK_PITCH + d8 * 2) = o; }
        __syncthreads();
        f32x4 acc[8][2];
#pragma unroll
        for (int mt = 0; mt < 8; ++mt) { acc[mt][0] = (f32x4){0.f, 0.f, 0.f, 0.f}; acc[mt][1] = (f32x4){0.f, 0.f, 0.f, 0.f}; }
        const unsigned ke_a = lds_addr(ke) + GL_QK_PITCH * (8 * g + q4) + 8 * p, v_a = lds_addr(F.lds + GL_V) + GL_V_PITCH * (8 * g + q4) + 8 * p + 2 * (32 * F.wave);
#pragma unroll
        for (int ks = 0; ks < 2; ++ks) {
            bf16x8v bv[2];
#pragma unroll
            for (int nt = 0; nt < 2; ++nt) bv[nt] = tr_frag(v_a + GL_V_PITCH * 32 * ks + 32 * nt, GL_V_PITCH * 4);
#pragma unroll
            for (int mt = 0; mt < 8; ++mt) { const bf16x8v av = tr_frag(ke_a + GL_QK_PITCH * 32 * ks + 32 * mt, GL_QK_PITCH * 4);
                acc[mt][0] = __builtin_amdgcn_mfma_f32_16x16x32_bf16(av, bv[0], acc[mt][0], 0, 0, 0); acc[mt][1] = __builtin_amdgcn_mfma_f32_16x16x32_bf16(av, bv[1], acc[mt][1], 0, 0, 0); } }
        bf16* dst = GLA_DST(ws) + ((size_t)ch * GLA_NCH + n) * 256 * 128;
#pragma unroll
        for (int mt = 0; mt < 8; ++mt)
#pragma unroll
            for (int nt = 0; nt < 2; ++nt) { const int e = 32 * F.wave + 16 * nt + l15, d = 16 * mt + 4 * g; v2u w; w.x = pk2(acc[mt][nt][0], acc[mt][nt][1]); w.y = pk2(acc[mt][nt][2], acc[mt][nt][3]);
                *(GAS v2u*)(dst + (size_t)e * 128 + d) = w; }
    }
}
__device__ __forceinline__ void gla_g2(Frame& F) {
    unsigned char* const ws = PWS();
    const int NT = F.G * NTHR;
    for (int idx = F.bx * NTHR + F.tid; idx < 16 * 256 * 32; idx += NT) {
        const int ch = idx >> 13, e = (idx >> 5) & 255, d4 = (idx & 31) * 4;
        bf16* p = GLA_DST(ws) + (size_t)ch * GLA_NCH * 32768 + (size_t)e * 128 + d4; const float* dc = GLA_DEC(ws) + (size_t)ch * GLA_NCH * 128 + d4;
        f32x4 S = {0.f, 0.f, 0.f, 0.f};
#pragma unroll 4
        for (int n = 0; n < GLA_NCH; ++n) { const v2u x = *(const GAS v2u*)(p + (size_t)n * 32768); const f32x4 a = *(const GAS f32x4*)(dc + n * 128);
            v2u w; w.x = pk2(S[0], S[1]); w.y = pk2(S[2], S[3]); *(GAS v2u*)(p + (size_t)n * 32768) = w;
            S[0] = a[0] * S[0] + bflo(x.x); S[1] = a[1] * S[1] + bfhi(x.x); S[2] = a[2] * S[2] + bflo(x.y); S[3] = a[3] * S[3] + bfhi(x.y); }
    }
}
__device__ __forceinline__ void gla_g3(Frame& F, int L) {
    unsigned char* const ws = PWS(); const bf16* U = (const bf16*)(ws + WS_U);
    const float* wgf = PIN(8) + (size_t)L * 16 * 512; const float* bgf = PIN(9) + L * 512; const float* wgb = PIN(10) + (size_t)L * 16 * 512; const float* bgb = PIN(11) + L * 512;
    const float* ng = PIN(12) + L * 256;
    const int g = F.lane >> 4, q4 = (F.lane & 15) >> 2, p = F.lane & 3, l15 = F.lane & 15;
    for (int task = F.vcu; task < 8 * GLA_NCH; task += F.G) {
        const int cn = task % GLA_NCH, bh = task / GLA_NCH, h = bh & 3, b = bh >> 2;
        const int row0 = gla_chunk_row0(b, cn);
        __syncthreads();
        gla_stage_v(F, U, row0, h);
        v4u kp[2], qp[2];
#pragma unroll
        for (int i = 0; i < 2; ++i) { const int pc = F.tid + NTHR * i, t = pc >> 4, d8 = (pc & 15) * 8; const bf16* up = U + (size_t)(row0 + t) * NU + h * 128 + d8; kp[i] = *(const GAS v4u*)(up + U_GK); qp[i] = *(const GAS v4u*)(up + U_GQ); }
        gla_decays(F, ws, wgf, bgf, wgb, bgb, row0, h, 0, 2);
        v4u im[2][4];
        { LAS float* bc = (LAS float*)(F.lds + GL_BC);
#pragma unroll
          for (int i = 0; i < 2; ++i) { const int pc = F.tid + NTHR * i, t = pc >> 4, d8 = (pc & 15) * 8;
#pragma unroll
              for (int dir = 0; dir < 2; ++dir) { const f32x4 b0 = *(LAS f32x4*)(bc + dir * 8192 + t * 128 + d8), b1 = *(LAS f32x4*)(bc + dir * 8192 + t * 128 + d8 + 4);
                  float ep[8], en[8];
#pragma unroll
                  for (int j = 0; j < 4; ++j) { ep[j] = __expf(b0[j]); ep[4 + j] = __expf(b1[j]); en[j] = __expf(-b0[j]); en[4 + j] = __expf(-b1[j]); }
                  v4u qo, ko;
                  qo.x = pk2(bflo(qp[i].x) * ep[0], bfhi(qp[i].x) * ep[1]); qo.y = pk2(bflo(qp[i].y) * ep[2], bfhi(qp[i].y) * ep[3]); qo.z = pk2(bflo(qp[i].z) * ep[4], bfhi(qp[i].z) * ep[5]); qo.w = pk2(bflo(qp[i].w) * ep[6], bfhi(qp[i].w) * ep[7]);
                  ko.x = pk2(bflo(kp[i].x) * en[0], bfhi(kp[i].x) * en[1]); ko.y = pk2(bflo(kp[i].y) * en[2], bfhi(kp[i].y) * en[3]); ko.z = pk2(bflo(kp[i].z) * en[4], bfhi(kp[i].z) * en[5]); ko.w = pk2(bflo(kp[i].w) * en[6], bfhi(kp[i].w) * en[7]);
                  im[i][2 * dir] = qo; im[i][2 * dir + 1] = ko; } } }
        __syncthreads();
#pragma unroll
        for (int i = 0; i < 2; ++i) { const int pc = F.tid + NTHR * i, t = pc >> 4, d8 = (pc & 15) * 8;
#pragma unroll
            for (int k = 0; k < 4; ++k) *(LAS v4u*)(F.lds + GL_BC + k * 64 * GL_QK_PITCH + t * GL_QK_PITCH + d8 * 2) = im[i][k]; }
        __syncthreads();
        { const int dir = F.wave >> 2, nt = F.wave & 3;
          LAS unsigned char* qi = F.lds + GL_BC + (2 * dir) * 64 * GL_QK_PITCH; LAS unsigned char* ki = qi + 64 * GL_QK_PITCH;
          bf16x8v qf[4];
#pragma unroll
          for (int ks = 0; ks < 4; ++ks) qf[ks] = *(LAS bf16x8v*)(qi + (16 * nt + l15) * GL_QK_PITCH + (32 * ks + 8 * g) * 2);
#pragma unroll
          for (int mt = 0; mt < 4; ++mt) { f32x4 a = {0.f, 0.f, 0.f, 0.f};
              const bool live = dir ? (mt >= nt) : (mt <= nt);
              if (live) {
#pragma unroll
                  for (int ks = 0; ks < 4; ++ks) { const bf16x8v kf = *(LAS bf16x8v*)(ki + (16 * mt + l15) * GL_QK_PITCH + (32 * ks + 8 * g) * 2); a = __builtin_amdgcn_mfma_f32_16x16x32_bf16(kf, qf[ks], a, 0, 0, 0); } }
              const int tau = 16 * nt + l15, s0 = 16 * mt + 4 * g;
#pragma unroll
              for (int i = 0; i < 4; ++i) { const bool keep = dir ? (s0 + i >= tau) : (s0 + i <= tau); if (!keep) a[i] = 0.f; }
              v2u w; w.x = pk2(a[0], a[1]); w.y = pk2(a[2], a[3]);
              *(LAS v2u*)(F.lds + GL_A + dir * 64 * GL_A_PITCH + tau * GL_A_PITCH + s0 * 2) = w; } }
        __syncthreads();
        f32x4 acc[2][4];
#pragma unroll
        for (int mt = 0; mt < 2; ++mt)
#pragma unroll
            for (int nt = 0; nt < 4; ++nt) acc[mt][nt] = (f32x4){0.f, 0.f, 0.f, 0.f};
        { const unsigned v_a = lds_addr(F.lds + GL_V) + GL_V_PITCH * (8 * g + q4) + 8 * p + 2 * (32 * F.wave);
#pragma unroll
          for (int ks = 0; ks < 2; ++ks) { bf16x8v vf[2];
#pragma unroll
              for (int mt = 0; mt < 2; ++mt) vf[mt] = tr_frag(v_a + GL_V_PITCH * 32 * ks + 32 * mt, GL_V_PITCH * 4);
#pragma unroll
              for (int dir = 0; dir < 2; ++dir)
#pragma unroll
                  for (int nt = 0; nt < 4; ++nt) { const bf16x8v af = *(LAS bf16x8v*)(F.lds + GL_A + dir * 64 * GL_A_PITCH + (16 * nt + l15) * GL_A_PITCH + (32 * ks + 8 * g) * 2);
                      acc[0][nt] = __builtin_amdgcn_mfma_f32_16x16x32_bf16(vf[0], af, acc[0][nt], 0, 0, 0); acc[1][nt] = __builtin_amdgcn_mfma_f32_16x16x32_bf16(vf[1], af, acc[1][nt], 0, 0, 0); } } }
#pragma unroll
        for (int dir = 0; dir < 2; ++dir) { const int ch = (b * 2 + dir) * 4 + h, n = gla_scan_idx(cn, dir);
            const bf16* st = GLA_DST(ws) + ((size_t)ch * GLA_NCH + n) * 32768; LAS unsigned char* qi = F.lds + GL_BC + (2 * dir) * 64 * GL_QK_PITCH;
#pragma unroll
            for (int ks = 0; ks < 4; ++ks) { bf16x8v sf[2];
#pragma unroll
                for (int mt = 0; mt < 2; ++mt) sf[mt] = __builtin_bit_cast(bf16x8v, *(const GAS v4u*)(st + (size_t)(32 * F.wave + 16 * mt + l15) * 128 + 32 * ks + 8 * g));
#pragma unroll
                for (int nt = 0; nt < 4; ++nt) { const bf16x8v qf = *(LAS bf16x8v*)(qi + (16 * nt + l15) * GL_QK_PITCH + (32 * ks + 8 * g) * 2);
                    acc[0][nt] = __builtin_amdgcn_mfma_f32_16x16x32_bf16(sf[0], qf, acc[0][nt], 0, 0, 0); acc[1][nt] = __builtin_amdgcn_mfma_f32_16x16x32_bf16(sf[1], qf, acc[1][nt], 0, 0, 0); } } }
        LAS float* red = (LAS float*)(F.lds + GL_RED);
#pragma unroll
        for (int nt = 0; nt < 4; ++nt) { float s = 0.f;
#pragma unroll
            for (int mt = 0; mt < 2; ++mt)
#pragma unroll
                for (int i = 0; i < 4; ++i) s += acc[mt][nt][i] * acc[mt][nt][i];
            s += __shfl_xor(s, 16); s += __shfl_xor(s, 32);
            if (g == 0) red[F.wave * 64 + 16 * nt + l15] = s; }
        __syncthreads();
#pragma unroll
        for (int nt = 0; nt < 4; ++nt) { const int tau = 16 * nt + l15; float s = 0.f;
#pragma unroll
            for (int w = 0; w < 8; ++w) s += red[w * 64 + tau];
            const float rs = 1.0f / sqrtf(s * (1.0f / 256.0f) + LN_EPS); const size_t row = (size_t)(row0 + tau);
#pragma unroll
            for (int mt = 0; mt < 2; ++mt) { const int e = 32 * F.wave + 16 * mt + 4 * g;
                const v2u rw = *(const GAS v2u*)(U + row * NU + U_GR + h * 256 + e); const f32x4 g4 = *(const f32x4*)(ng + e);
                const float r0 = bflo(rw.x), r1 = bfhi(rw.x), r2 = bflo(rw.y), r3 = bfhi(rw.y);
                v2u w; w.x = pk2(acc[mt][nt][0] * rs * g4[0] * (r0 / (1.0f + __expf(-r0))), acc[mt][nt][1] * rs * g4[1] * (r1 / (1.0f + __expf(-r1))));
                w.y = pk2(acc[mt][nt][2] * rs * g4[2] * (r2 / (1.0f + __expf(-r2))), acc[mt][nt][3] * rs * g4[3] * (r3 / (1.0f + __expf(-r3))));
                *(GAS v2u*)(((bf16*)(ws + WS_Y + (size_t)MROWS * 1024 * 2)) + row * 1024 + h * 256 + e) = w; } }
    }
}

constexpr int NA_VPITCH = 272, NA_VIMG = 32 * NA_VPITCH;
__device__ __forceinline__ void na_mfma(Frame& F, int L) {
    unsigned char* const ws = PWS(); const bf16* U = (const bf16*)(ws + WS_U); bf16* YN = (bf16*)(ws + WS_Y + (size_t)MROWS * 2048 * 2);
    const float* rpbL = PIN(13) + (size_t)L * 8 * 15 * 31;
    const int g = F.lane >> 4, q4 = (F.lane & 15) >> 2, p = F.lane & 3, l15 = F.lane & 15;
    LAS unsigned char* vimg = F.lds + RING_OFF + F.wave * NA_VIMG;
    const unsigned v_a = lds_addr(vimg) + NA_VPITCH * (4 * g + q4) + 8 * p;
    const int gw = F.vcu * NWAVES + F.wave, NGW = F.G * NWAVES;
    const int T_lat = 2 * 8 * 64 * 4, T_all = T_lat + (L == 0 ? 2 * 8 * 16 : 0);
    for (int task = gw; task < T_all; task += NGW) {
        const bool isctx = task >= T_lat;
        int b, h, r = 0, c0 = 0, qrow0;
        if (!isctx) { const int ct = task & 3; r = (task >> 2) & 63; h = (task >> 8) & 7; b = task >> 11; c0 = 16 * ct; qrow0 = b * SEQ + r * 64 + c0; }
        else { const int tt = task - T_lat, qt = tt & 15; h = (tt >> 4) & 7; b = tt >> 7; qrow0 = NLAT + CTXL * b + 16 * qt; }
        const int rs = min(max(r - 4, 0), 56), kc0 = min(max(c0 - 8, 0), 32);
        const int ctx0 = NLAT + CTXL * b;
        const int kb_lo = isctx ? 8 : 0;
        bf16x8v qf[4];
#pragma unroll
        for (int ks = 0; ks < 4; ++ks) qf[ks] = __builtin_bit_cast(bf16x8v, *(const GAS v4u*)(U + (size_t)(qrow0 + l15) * NU + U_NQ + h * 128 + 32 * ks + 8 * g));
        f32x4 s[32];
#pragma unroll
        for (int kb = 0; kb < 16; ++kb) {
            if (kb >= kb_lo) {
                const int tok0 = kb < 8 ? b * SEQ + (rs + kb) * 64 + kc0 : ctx0 + 32 * (kb - 8);
#pragma unroll
                for (int hf = 0; hf < 2; ++hf) { const bf16* kp = U + (size_t)(tok0 + 16 * hf + l15) * NU + U_NK + h * 128 + 8 * g; f32x4 a = {0.f, 0.f, 0.f, 0.f};
#pragma unroll
                    for (int ks = 0; ks < 4; ++ks) { const bf16x8v kf = __builtin_bit_cast(bf16x8v, *(const GAS v4u*)(kp + 32 * ks)); a = __builtin_amdgcn_mfma_f32_16x16x32_bf16(kf, qf[ks], a, 0, 0, 0); }
                    s[2 * kb + hf] = a; }
                asm volatile("" ::: "memory");
            } else { s[2 * kb] = (f32x4){-INFINITY, -INFINITY, -INFINITY, -INFINITY}; s[2 * kb + 1] = s[2 * kb]; }
        }
        if (!isctx) {
            const int qc = c0 + l15, cs = min(max(qc - 8, 0), 48); const float* rp = rpbL + (size_t)h * 15 * 31;
#pragma unroll
            for (int kt = 0; kt < 16; ++kt) { const int kr = rs + (kt >> 1);
#pragma unroll
                for (int i = 0; i < 4; ++i) { const int kc = kc0 + (kt & 1) * 16 + 4 * g + i; const bool ok = kc >= cs && kc <= cs + 15;
                    const float bias = ok ? rp[(kr - r + 7) * 31 + (kc - qc + 15)] : 0.f; s[kt][i] = ok ? s[kt][i] + bias : -INFINITY; } }
        }
        float mx = -INFINITY;
#pragma unroll
        for (int kt = 0; kt < 32; ++kt) mx = fmaxf(mx, fmaxf(fmaxf(s[kt][0], s[kt][1]), fmaxf(s[kt][2], s[kt][3])));
        mx = fmaxf(mx, __shfl_xor(mx, 16)); mx = fmaxf(mx, __shfl_xor(mx, 32));
        float sum = 0.f;
#pragma unroll
        for (int kt = 0; kt < 32; ++kt) {
#pragma unroll
            for (int i = 0; i < 4; ++i) { const float e = __expf(s[kt][i] - mx); s[kt][i] = e; sum += e; } }
        sum += __shfl_xor(sum, 16); sum += __shfl_xor(sum, 32);
        const float inv = 1.0f / sum;
        f32x4 o[8];
#pragma unroll
        for (int mt = 0; mt < 8; ++mt) o[mt] = (f32x4){0.f, 0.f, 0.f, 0.f};
#pragma unroll
        for (int kb = 0; kb < 16; ++kb) {
            if (kb >= kb_lo) {
                const int tok0 = kb < 8 ? b * SEQ + (rs + kb) * 64 + kc0 : ctx0 + 32 * (kb - 8);
#pragma unroll
                for (int hb = 0; hb < 2; ++hb) { v4u vv[4];
#pragma unroll
                    for (int i = 0; i < 4; ++i) { const int id = F.lane + 64 * (4 * hb + i); vv[i] = *(const GAS v4u*)(U + (size_t)(tok0 + (id >> 4)) * NU + U_NV + h * 128 + (id & 15) * 8); }
#pragma unroll
                    for (int i = 0; i < 4; ++i) { const int id = F.lane + 64 * (4 * hb + i); *(LAS v4u*)(vimg + (id >> 4) * NA_VPITCH + (id & 15) * 16) = vv[i]; }
                    asm volatile("" ::: "memory"); }
                v4u pw; pw.x = pk2(s[2 * kb][0], s[2 * kb][1]); pw.y = pk2(s[2 * kb][2], s[2 * kb][3]); pw.z = pk2(s[2 * kb + 1][0], s[2 * kb + 1][1]); pw.w = pk2(s[2 * kb + 1][2], s[2 * kb + 1][3]);
                const bf16x8v pf = __builtin_bit_cast(bf16x8v, pw);
                asm volatile("s_waitcnt lgkmcnt(0)" ::: "memory");
#pragma unroll
                for (int mt = 0; mt < 8; ++mt) { const bf16x8v vf = tr_frag(v_a + 32 * mt, NA_VPITCH * 16); o[mt] = __builtin_amdgcn_mfma_f32_16x16x32_bf16(vf, pf, o[mt], 0, 0, 0); }
            }
        }
        bf16* yp = YN + (size_t)(qrow0 + l15) * 1024 + h * 128 + 4 * g;
#pragma unroll
        for (int mt = 0; mt < 8; ++mt) { v2u w; w.x = pk2(o[mt][0] * inv, o[mt][1] * inv); w.y = pk2(o[mt][2] * inv, o[mt][3] * inv); *(GAS v2u*)(yp + 16 * mt) = w; }
    }
}
#ifndef MK_ONE_LAUNCH
#define MK_ONE_LAUNCH 0
#endif
constexpr int PH_PER_LAYER = 11, NPH = 2 + DEPTH * PH_PER_LAYER;
enum { PL_WIN = 0, PL_MIXA, PL_MIXB, PL_MIXC, PL_BR, PL_WOUT, PL_LN1, PL_GATHER, PL_FFN1, PL_FFN2, PL_LN2 };
__device__ __forceinline__ bool in_range(int lo, int hi, int k) { asm volatile("" : "+s"(lo), "+s"(hi)); return lo <= k && k < hi; }
__global__ void __launch_bounds__(NTHR, 2) fwd_kernel(Args A) {
    __shared__ __attribute__((aligned(16))) unsigned char lds[LDS_BYTES];
    LAS unsigned char* const ldsb = (LAS unsigned char*)lds;
    { Frame F = mkframe(ldsb, A.grid);
    for (int u = F.tid; u < (LDS_BYTES - LDSCTL_OFF) / 4; u += NTHR) ((LAS unsigned*)(F.lds + LDSCTL_OFF))[u] = 0u;
    __syncthreads();
    if (F.tid < 32) { const unsigned long long p = F.tid < 30 ? (unsigned long long)A.in[F.tid] : (F.tid == 30 ? (unsigned long long)A.out : (unsigned long long)A.ws);
        ((LAS unsigned long long*)(F.lds + PTAB_OFF))[F.tid] = p; }
    __syncthreads(); }
#if MK_ONE_LAUNCH
    XcdBarrier bar; { Frame F = mkframe(ldsb, A.grid); bar = xcd_barrier_post((unsigned*)(PWS() + WS_CTL) + CW_BAR, F.MISC + 8, (unsigned)A.grid); }
#define GRID_BAR() xcd_barrier(bar)
#else
#define GRID_BAR() do { if (F.tid == 0) __hip_atomic_store((gu32*)(PWS() + WS_CTL) + CW_TMO, 0xBADBA0u, RLX_AGENT); } while (0)
#endif
    const int lo = A.ph_lo, hi = A.ph_hi;
#ifndef PHMASK
#define PHMASK 0xFFFFFFFFu
#endif
#define IN(k) in_range(lo, hi, (k))
#define EN(bit) ((PHMASK >> (bit)) & 1u)
#define SEAM(k) do { if (IN((k) + 1)) GRID_BAR(); } while (0)
    LAS unsigned char* const ring = ldsb + RING_OFF;

    if (EN(0) && IN(0)) { Frame F = mkframe(ldsb, A.grid); p0a_prologue(F); SEAM(0); }
    if (EN(1) && IN(1)) { Frame F = mkframe(ldsb, A.grid); p0b_modulate(F); SEAM(1); }
    for (int L = 0; L < DEPTH; ++L) {
        const int pb = 2 + PH_PER_LAYER * L, Mr = (L == 0) ? MROWS : NLAT;
        if (EN(2) && IN(pb + PL_WIN)) { Frame F = mkframe(ldsb, A.grid);
            unsigned char* const ws = PWS();
            pg8::Gemm g{((bf16*)(ws + WS_H)), w_in_t(ws, L), MROWS, NU, D}; pg8::StaticOrder S; S.init(MROWS, NU, F.G, F.bx);
            pg8::EpiU E{((bf16*)(ws + WS_U)), NU};
            pg8::gemm_phase<pg8::EpiU, pg8::StaticOrder, true, true>(ring, g, S, E);
            SEAM(pb + PL_WIN);
        }
        if (EN(3) && IN(pb + PL_MIXA)) { Frame F = mkframe(ldsb, A.grid); gla_g1(F, L); mix_prep(F, L); SEAM(pb + PL_MIXA); }
        if (EN(4) && IN(pb + PL_MIXB)) { Frame F = mkframe(ldsb, A.grid); gla_g2(F); na_mfma(F, L); SEAM(pb + PL_MIXB); }
        if (EN(5) && IN(pb + PL_MIXC)) { Frame F = mkframe(ldsb, A.grid); gla_g3(F, L); SEAM(pb + PL_MIXC); }
        if (EN(6) && IN(pb + PL_BR)) { Frame F = mkframe(ldsb, A.grid);
            unsigned char* const ws = PWS(); const float* const gate_b = PIN(17) + (size_t)L * 3 * D;
            for (int b = 0; b < 3; ++b) {
                pg8::Gemm g{b == 0 ? ((bf16*)(ws + WS_Y)) : (b == 1 ? ((bf16*)(ws + WS_Y + (size_t)MROWS * 1024 * 2)) : ((bf16*)(ws + WS_Y + (size_t)MROWS * 2048 * 2))), w_br_t(ws, L, b), Mr, D, 1024}; pg8::StaticOrder S; S.init(Mr, D, F.G, F.bx);
                pg8::EpiGate E{((bf16*)(ws + WS_U)) + U_GATE + b * D, NU, gate_b + b * D, ((float*)(ws + WS_Z)), ((bf16*)(ws + WS_ZB)), b == 0, b == 2};
                pg8::gemm_phase<pg8::EpiGate, pg8::StaticOrder, true, true>(ring, g, S, E);
            }
            SEAM(pb + PL_BR);
        }
        if (EN(7) && IN(pb + PL_WOUT)) { Frame F = mkframe(ldsb, A.grid);
            unsigned char* const ws = PWS(); const float* const modL = ((float*)(ws + WS_MOD)) + (size_t)L * 3 * 12288; const float* const xin = PIN(0); const float* const cin = PIN(2);
            pg8::Gemm g{((bf16*)(ws + WS_ZB)), w_out_t(ws, L), Mr, D, D}; pg8::StaticOrder S; S.init(Mr, D, F.G, F.bx);
            pg8::EpiRes E{L == 0 ? xin : ((float*)(ws + WS_XL)), L == 0 ? cin : ((float*)(ws + WS_XL)) + (size_t)NLAT * D, modL + 2 * D, 12288, ((float*)(ws + WS_PRE)), ALPHA};
            pg8::gemm_phase<pg8::EpiRes, pg8::StaticOrder, true, true>(ring, g, S, E);
            SEAM(pb + PL_WOUT);
        }
        if (EN(8) && IN(pb + PL_LN1)) { Frame F = mkframe(ldsb, A.grid); ln1_phase(F, L, Mr); SEAM(pb + PL_LN1); }
        if (L == 0) {
            if (EN(10) && IN(pb + PL_FFN1)) { Frame F = mkframe(ldsb, A.grid);
                unsigned char* const ws = PWS();
                pg8::Gemm g{((bf16*)(ws + WS_H)), w_gu_t(ws, -1), MROWS, NGU, D}; pg8::StaticOrder S; S.init(MROWS, NGU, F.G, F.bx);
                pg8::EpiSwiGLU E{((bf16*)(ws + WS_U)), FF};
                pg8::gemm_phase<pg8::EpiSwiGLU, pg8::StaticOrder, true, true>(ring, g, S, E);
                SEAM(pb + PL_FFN1);
            }
            if (EN(11) && IN(pb + PL_FFN2)) { Frame F = mkframe(ldsb, A.grid);
                unsigned char* const ws = PWS(); const float* const modL = ((float*)(ws + WS_MOD)) + (size_t)L * 3 * 12288;
                pg8::Gemm g{((bf16*)(ws + WS_U)), w_d_t(ws, -1), MROWS, D, FF}; pg8::StaticOrder S; S.init(MROWS, D, F.G, F.bx);
                pg8::EpiRes E{((float*)(ws + WS_XL)), ((float*)(ws + WS_XL)) + (size_t)NLAT * D, modL + 5 * D, 12288, ((float*)(ws + WS_PRE)), ALPHA};
                pg8::gemm_phase<pg8::EpiRes, pg8::StaticOrder, true, true>(ring, g, S, E);
                SEAM(pb + PL_FFN2);
            }
            if (EN(12) && IN(pb + PL_LN2)) { Frame F = mkframe(ldsb, A.grid); ln2_dense(F, L); SEAM(pb + PL_LN2); }
        } else {
            if (EN(9) && IN(pb + PL_GATHER)) { Frame F = mkframe(ldsb, A.grid); moe_gather(F); SEAM(pb + PL_GATHER); }
            if (EN(10) && IN(pb + PL_FFN1)) { Frame F = mkframe(ldsb, A.grid);
                unsigned char* const ws = PWS();
                unsigned cnt[8]; int pp[9]; moe_prefix(ws, cnt, pp);
                pg8::Gemm g{((bf16*)(ws + WS_GLA)), w_gu_t(ws, 0), 0, NGU, D}; pg8::MoeOrder S; S.init(cnt, NGU / 256, F.G, F.bx);
                pg8::EpiSwiGLU E{((bf16*)(ws + WS_U)), FF};
                pg8::gemm_phase<pg8::EpiSwiGLU, pg8::MoeOrder, true, true>(ring, g, S, E);
                SEAM(pb + PL_FFN1);
            }
            if (EN(11) && IN(pb + PL_FFN2)) { Frame F = mkframe(ldsb, A.grid);
                unsigned char* const ws = PWS(); const float* const modL = ((float*)(ws + WS_MOD)) + (size_t)L * 3 * 12288;
                unsigned cnt[8]; int pp[9]; moe_prefix(ws, cnt, pp);
                pg8::Gemm g{((bf16*)(ws + WS_U)), w_d_t(ws, 0), 0, D, FF}; pg8::MoeOrder S; S.init(cnt, D / 256, F.G, F.bx);
                pg8::EpiF32Plain E{((float*)(ws + WS_Z)), D};
                pg8::gemm_phase<pg8::EpiF32Plain, pg8::MoeOrder, true, true>(ring, g, S, E);
                SEAM(pb + PL_FFN2);
            }
            if (EN(12) && IN(pb + PL_LN2)) { Frame F = mkframe(ldsb, A.grid); ln2_moe(F, L); }
        }
    }
#undef IN
#undef SEAM
}

extern "C" void kernel_launch(void* const* d_in, const int* in_sizes, int n_in, void* d_out, int out_size, void* d_ws, size_t ws_size, hipStream_t stream) {
    static int grid = 0;
    if (grid == 0) {
        if (n_in != 30 || out_size != NLAT * D || ws_size < WS_END) { fprintf(stderr, "kernel_launch: unexpected shapes (n_in %d out %d ws %zu); nothing launched\n", n_in, out_size, ws_size); grid = -1; return; }
        int dev = 0, cus = 0, per_cu = 0;
        if (hipGetDevice(&dev) != hipSuccess || hipDeviceGetAttribute(&cus, hipDeviceAttributeMultiprocessorCount, dev) != hipSuccess) { grid = -1; return; }
        if (hipOccupancyMaxActiveBlocksPerMultiprocessor(&per_cu, (const void*)fwd_kernel, NTHR, 0) != hipSuccess || per_cu < 1) { fprintf(stderr, "kernel_launch: occupancy query says %d\n", per_cu); (void)hipGetLastError(); grid = -1; return; }
        grid = cus;
    }
    if (grid < 0) return;
    (void)hipMemsetAsync((char*)d_ws + WS_CTL, 0, CTL_ZERO_BYTES, stream);
    Args a{};
    for (int i = 0; i < 30; ++i) a.in[i] = (const float*)d_in[i];
    a.out = (float*)d_out; a.ws = (unsigned char*)d_ws; a.grid = grid;
#if MK_ONE_LAUNCH
    a.ph_lo = 0; a.ph_hi = NPH;
    hipLaunchKernelGGL(fwd_kernel, dim3(grid), dim3(NTHR), 0, stream, a);
#else
#ifndef NPH_RUN
#define NPH_RUN NPH
#endif
    for (int p = 0; p < NPH_RUN; ++p) {
        if (p == 2 + PL_GATHER) continue;
        a.ph_lo = p; a.ph_hi = p + 1;
        hipLaunchKernelGGL(fwd_kernel, dim3(grid), dim3(NTHR), 0, stream, a);
    }
#endif
}
```

```cpp
#define MK_ONE_LAUNCH 1
#include <hip/hip_runtime.h>
#include <cstdio>

namespace pg8 {
#define PG8_LAS __attribute__((address_space(3)))
typedef unsigned short bf16_t;
typedef short bf16x8 __attribute__((ext_vector_type(8)));
typedef float f32x4 __attribute__((ext_vector_type(4)));
typedef unsigned u32x4 __attribute__((ext_vector_type(4)));
typedef unsigned u32x2 __attribute__((ext_vector_type(2)));
constexpr int BM = 256, BK = 64, HALF = 128, HTB = HALF * BK * 2  , STAGE_BYTES = 8 * HTB, NXCD = 8, WGM = 8;

__host__ __device__ __forceinline__ int lds_byte(int r, int c) { const int st = (r >> 4) * 2 + (c >> 5), rr = r & 15, cc = c & 31, ob = rr * 64 + cc * 2; return st * 1024 + (ob ^ (((ob >> 9) & 1) << 5)); }
__host__ __device__ __forceinline__ void stage_rc(int b, int& R, int& C) { const int st = b / 1024, sb = b % 1024, swz = sb ^ (((sb >> 9) & 1) << 5); R = (st >> 1) * 16 + swz / 64; C = (st & 1) * 32 + (swz % 64) / 2; }
__host__ __device__ __forceinline__ int perm32(int rho) { const int n = rho >> 4, i = rho & 15; return 8 * (i >> 2) + 4 * n + (i & 3); }

struct Unit { int pm, pn, pa, pb, ko, aux; };
struct Gemm { const bf16_t* A; const bf16_t* Bt; int K, KT; };

__device__ __forceinline__ int xcd_remap(int wgid, int nwg) { const int q = nwg / NXCD, r = nwg % NXCD, xcd = wgid % NXCD, off = wgid / NXCD; return (xcd < r ? xcd * (q + 1) : r * (q + 1) + (xcd - r) * q) + off; }
struct StaticOrder {
    int nM, nN, nwg, G, c;
    __host__ __device__ void init(int M, int N, int G_, int c_) { nM = M / BM; nN = N / BM; nwg = nM * nN; G = G_; c = c_; }
    __device__ __forceinline__ bool next(int i, Unit& u) const {
        const long L = (long)i * G + c; if (L >= nwg) return false;
        const int wgid = xcd_remap((int)L, nwg);
        const int nig = WGM * nN, gid = wgid / nig, fm = gid * WGM, gsz = (nM - fm) < WGM ? (nM - fm) : WGM;
        u.pm = fm + ((wgid % nig) % gsz); u.pn = (wgid % nig) / gsz; u.pa = u.pm; u.pb = u.pn; u.ko = 0; u.aux = 0; return true;
    }
    __device__ __forceinline__ void a_ready(const Unit&) const {}
    __device__ __forceinline__ void done(const Unit&) const {}
};
struct MoeOrder {
    int nN, G, c, nunits; int pp[9];
    __device__ __forceinline__ void init(const unsigned* cnt, int nN_, int G_, int c_) { nN = nN_; G = G_; c = c_; pp[0] = 0;
#pragma unroll
        for (int e = 0; e < 8; ++e) pp[e + 1] = pp[e] + (int)((cnt[e] + 255u) >> 8);
        nunits = pp[8] * nN; }
    __device__ __forceinline__ bool next(int i, Unit& u) const {
        const long L = (long)i * G + c; if (L >= nunits) return false;
        const int wgid = xcd_remap((int)L, nunits);
        int e = 0, base = 0, npe = pp[1];
#pragma unroll
        for (int k = 1; k < 8; ++k) { if (wgid >= pp[k] * nN) { e = k; base = pp[k]; npe = pp[k + 1] - pp[k]; } }
        if (npe < 1) npe = 1;
        const int local = wgid - base * nN;
        u.pm = base + local % npe; u.pn = local / npe; u.pa = u.pm; u.pb = e * nN + u.pn; u.ko = 0; u.aux = 0; return true;
    }
    __device__ __forceinline__ void a_ready(const Unit&) const {}
    __device__ __forceinline__ void done(const Unit&) const {}
};

struct BranchOrder {
    StaticOrder S; int apanels, bpanels;
    __device__ __forceinline__ void init(int M, int N, int G_, int c_, int apan, int bpan) { S.init(M, N, G_, c_); apanels = apan; bpanels = bpan; }
    __device__ __forceinline__ bool next(int i, Unit& u) const { const int j = i / 3, b = i - 3 * j; if (!S.next(j, u)) return false; u.pa = b * apanels + u.pm; u.pb = b * bpanels + u.pn; u.aux = b; return true; }
    __device__ __forceinline__ void a_ready(const Unit&) const {}
    __device__ __forceinline__ void done(const Unit&) const {}
};
struct SplitOrder {
    int pm0, nN, nsplit, KT, G, c, rot;
    __device__ __forceinline__ void init(int pm0_, int nN_, int nsplit_, int KT_, int G_, int c_, int rot_) { pm0 = pm0_; nN = nN_; nsplit = nsplit_; KT = KT_; G = G_; c = c_; rot = rot_; }
    __device__ __forceinline__ bool next(int i, Unit& u) const {
        int cc = c - rot; if (cc < 0) cc += G;
        const long L = (long)i * G + cc; if (L >= 2 * nN * nsplit) return false;
        const int s = (int)L % nsplit, tile = (int)L / nsplit;
        u.pm = pm0 + tile / nN; u.pn = tile % nN; u.pa = u.pm; u.pb = u.pn; u.ko = s * KT; u.aux = s; return true;
    }
    __device__ __forceinline__ void a_ready(const Unit&) const {}
    __device__ __forceinline__ void done(const Unit&) const {}
};

__device__ __forceinline__ unsigned cvt_pk_bf16(float lo, float hi) { unsigned r; asm volatile("v_cvt_pk_bf16_f32 %0, %1, %2" : "=v"(r) : "v"(lo), "v"(hi)); return r; }
__device__ __forceinline__ float bf_lo(unsigned w) { return __uint_as_float(w << 16); }
__device__ __forceinline__ float bf_hi(unsigned w) { return __uint_as_float(w & 0xffff0000u); }
__device__ __forceinline__ float fast_sigmoid(float x) { return __builtin_amdgcn_rcpf(1.0f + __expf(-x)); }

struct EpiBf16Plain {
    static constexpr bool PERM = true, AFTER_DRAIN = false;
    bf16_t* O; int ldc;
    __device__ __forceinline__ void operator()(const f32x4 (&acc)[2][2][4][2], const Unit& u, int wr, int wc, int fr, int fq) const {
        const int row0 = u.pm * BM + wr * 64 + fr, col0 = u.pn * BM + wc * 32 + 8 * fq;
#pragma unroll
        for (int ai = 0; ai < 2; ++ai)
#pragma unroll
            for (int m = 0; m < 4; ++m) { bf16_t* rowp = O + (size_t)(row0 + ai * HALF + m * 16) * ldc + col0;
#pragma unroll
                for (int bj = 0; bj < 2; ++bj) { const f32x4 v0 = acc[ai][bj][m][0], v1 = acc[ai][bj][m][1];
                    u32x4 w; w.x = cvt_pk_bf16(v0[0], v0[1]); w.y = cvt_pk_bf16(v0[2], v0[3]); w.z = cvt_pk_bf16(v1[0], v1[1]); w.w = cvt_pk_bf16(v1[2], v1[3]);
                    *(u32x4*)(rowp + bj * HALF) = w; } }
    }
};
struct EpiU {
    static constexpr bool PERM = true, AFTER_DRAIN = false;
    bf16_t* O; int ldc;
    __device__ __forceinline__ void operator()(const f32x4 (&acc)[2][2][4][2], const Unit& u, int wr, int wc, int fr, int fq) const {
        const int row0 = u.pm * BM + wr * 64 + fr, col0 = u.pn * BM + wc * 32 + 8 * fq;
        const bool is_gq = (u.pn == 12 || u.pn == 13), is_gk = (u.pn == 14 || u.pn == 15), is_nq = (u.pn >= 24 && u.pn < 28);
        const float sc = (is_gq || is_nq) ? 0.08838834764831845f : 1.0f;
        const bool rope = (is_gq || is_gk) && u.pm < 32;
        float inv[4];
#pragma unroll
        for (int j = 0; j < 4; ++j) inv[j] = exp2f(-(float)((16 * wc + 4 * fq + j) & 31) * 0.41524101186092029f);
#pragma unroll
        for (int ai = 0; ai < 2; ++ai)
#pragma unroll
            for (int m = 0; m < 4; ++m) { const int row = row0 + ai * HALF + m * 16; bf16_t* rowp = O + (size_t)row * ldc + col0;
                const int t = row & 4095; const float pos = (wc < 2) ? (float)(t >> 6) : (float)(t & 63);
                float cs[4], sn[4];
                if (rope) {
#pragma unroll
                    for (int j = 0; j < 4; ++j) { const float ang = pos * inv[j]; cs[j] = __cosf(ang); sn[j] = __sinf(ang); } }
#pragma unroll
                for (int bj = 0; bj < 2; ++bj) { f32x4 v0 = acc[ai][bj][m][0] * sc, v1 = acc[ai][bj][m][1] * sc;
                    if (rope) { const f32x4 a = v0, b = v1;
                        v0[0] = a[0] * cs[0] - a[1] * sn[0]; v0[1] = a[0] * sn[0] + a[1] * cs[0]; v0[2] = a[2] * cs[1] - a[3] * sn[1]; v0[3] = a[2] * sn[1] + a[3] * cs[1];
                        v1[0] = b[0] * cs[2] - b[1] * sn[2]; v1[1] = b[0] * sn[2] + b[1] * cs[2]; v1[2] = b[2] * cs[3] - b[3] * sn[3]; v1[3] = b[2] * sn[3] + b[3] * cs[3]; }
                    u32x4 w; w.x = cvt_pk_bf16(v0[0], v0[1]); w.y = cvt_pk_bf16(v0[2], v0[3]); w.z = cvt_pk_bf16(v1[0], v1[1]); w.w = cvt_pk_bf16(v1[2], v1[3]);
                    *(u32x4*)(rowp + bj * HALF) = w; } }
    }
};
struct EpiF32Plain {
    static constexpr bool PERM = false, AFTER_DRAIN = false;
    float* C; int ldc;
    __device__ __forceinline__ void operator()(const f32x4 (&acc)[2][2][4][2], const Unit& u, int wr, int wc, int fr, int fq) const {
        const int row0 = u.pm * BM + wr * 64 + fr, col0 = u.pn * BM + wc * 32 + 4 * fq;
#pragma unroll
        for (int ai = 0; ai < 2; ++ai)
#pragma unroll
            for (int m = 0; m < 4; ++m) { float* rowp = C + (size_t)(row0 + ai * HALF + m * 16) * ldc + col0;
#pragma unroll
                for (int bj = 0; bj < 2; ++bj)
#pragma unroll
                    for (int n = 0; n < 2; ++n) *(f32x4*)(rowp + bj * HALF + n * 16) = acc[ai][bj][m][n]; }
    }
};
struct EpiPartial {
    static constexpr bool PERM = false, AFTER_DRAIN = false;
    float* P; int pm0;
    __device__ __forceinline__ void operator()(const f32x4 (&acc)[2][2][4][2], const Unit& u, int wr, int wc, int fr, int fq) const {
        const int row0 = (u.pm - pm0) * BM + wr * 64 + fr, col0 = u.pn * BM + wc * 32 + 4 * fq; float* base = P + (size_t)u.aux * 512 * 2048;
#pragma unroll
        for (int ai = 0; ai < 2; ++ai)
#pragma unroll
            for (int m = 0; m < 4; ++m) { float* rowp = base + (size_t)(row0 + ai * HALF + m * 16) * 2048 + col0;
#pragma unroll
                for (int bj = 0; bj < 2; ++bj)
#pragma unroll
                    for (int n = 0; n < 2; ++n) *(f32x4*)(rowp + bj * HALF + n * 16) = acc[ai][bj][m][n]; }
    }
};
struct EpiGate {
    static constexpr bool PERM = false, AFTER_DRAIN = false;
    const bf16_t* Ug; int ldu;
    const float* gb;
    float* Z; bf16_t* ZB;
    __device__ __forceinline__ void operator()(const f32x4 (&acc)[2][2][4][2], const Unit& u, int wr, int wc, int fr, int fq) const {
        const int row0 = u.pm * BM + wr * 64 + fr, col0 = u.pn * BM + wc * 32 + 4 * fq; const bool first = u.aux == 0, last = u.aux == 2;
        const bf16_t* Ub = Ug + 2048 * u.aux; const float* gbb = gb + 2048 * u.aux;
#pragma unroll
        for (int ai = 0; ai < 2; ++ai)
#pragma unroll
            for (int m = 0; m < 4; ++m) { const size_t row = (size_t)(row0 + ai * HALF + m * 16);
#pragma unroll
                for (int bj = 0; bj < 2; ++bj)
#pragma unroll
                    for (int n = 0; n < 2; ++n) { const int col = col0 + bj * HALF + n * 16;
                        const u32x2 gl = *(const u32x2*)(Ub + row * ldu + col); const f32x4 b4 = *(const f32x4*)(gbb + col);
                        f32x4 v = acc[ai][bj][m][n];
                        v[0] *= fast_sigmoid(bf_lo(gl.x) + b4[0]); v[1] *= fast_sigmoid(bf_hi(gl.x) + b4[1]); v[2] *= fast_sigmoid(bf_lo(gl.y) + b4[2]); v[3] *= fast_sigmoid(bf_hi(gl.y) + b4[3]);
                        if (!first) v += *(const f32x4*)(Z + row * 2048 + col);
                        if (!last) *(f32x4*)(Z + row * 2048 + col) = v;
                        else { u32x2 w; w.x = cvt_pk_bf16(v[0], v[1]); w.y = cvt_pk_bf16(v[2], v[3]); *(u32x2*)(ZB + row * 2048 + col) = w; } }
                asm volatile("" ::: "memory"); }
    }
};
struct EpiRes {
    static constexpr bool PERM = false, AFTER_DRAIN = false;
    const float* res_lat; const float* res_ctx; const float* gv; int gstride; float* out; float alpha;
    __device__ __forceinline__ void operator()(const f32x4 (&acc)[2][2][4][2], const Unit& u, int wr, int wc, int fr, int fq) const {
        const int grp = u.pm < 16 ? 0 : (u.pm < 32 ? 1 : 2);
        const float* res = u.pm < 32 ? res_lat + (size_t)u.pm * BM * 2048 : res_ctx + (size_t)(u.pm - 32) * BM * 2048;
        const float* g = gv + (size_t)grp * gstride;
        const int rl0 = wr * 64 + fr, col0 = u.pn * BM + wc * 32 + 4 * fq;
#pragma unroll
        for (int ai = 0; ai < 2; ++ai)
#pragma unroll
            for (int m = 0; m < 4; ++m) { const int rl = rl0 + ai * HALF + m * 16;
#pragma unroll
                for (int bj = 0; bj < 2; ++bj)
#pragma unroll
                    for (int n = 0; n < 2; ++n) { const int col = col0 + bj * HALF + n * 16;
                        const f32x4 r4 = *(const f32x4*)(res + (size_t)rl * 2048 + col); const f32x4 g4 = *(const f32x4*)(g + col);
                        *(f32x4*)(out + ((size_t)u.pm * BM + rl) * 2048 + col) = r4 * alpha + g4 * acc[ai][bj][m][n]; }
                asm volatile("" ::: "memory"); }
    }
};
struct EpiSwiGLU {
    static constexpr bool PERM = true, AFTER_DRAIN = false;
    bf16_t* O; int ldc;
    __device__ __forceinline__ void operator()(const f32x4 (&acc)[2][2][4][2], const Unit& u, int wr, int wc, int fr, int fq) const {
        const int row0 = u.pm * BM + wr * 64 + fr, col0 = u.pn * HALF + wc * 32 + 8 * fq;
#pragma unroll
        for (int ai = 0; ai < 2; ++ai)
#pragma unroll
            for (int m = 0; m < 4; ++m) { bf16_t* rowp = O + (size_t)(row0 + ai * HALF + m * 16) * ldc + col0;
                float h[8];
#pragma unroll
                for (int n = 0; n < 2; ++n)
#pragma unroll
                    for (int j = 0; j < 4; ++j) { const float gt = acc[ai][0][m][n][j], up = acc[ai][1][m][n][j]; h[n * 4 + j] = gt * fast_sigmoid(gt) * up; }
                u32x4 w; w.x = cvt_pk_bf16(h[0], h[1]); w.y = cvt_pk_bf16(h[2], h[3]); w.z = cvt_pk_bf16(h[4], h[5]); w.w = cvt_pk_bf16(h[6], h[7]);
                *(u32x4*)rowp = w; }
    }
};

template <class Epi, class Sched, bool ALIGN_EPI = false, bool SP2 = false>
__device__ __forceinline__ void gemm_phase(PG8_LAS unsigned char* lds, const Gemm g, const Sched& S, const Epi& E) {
    int tid_ = threadIdx.x; asm volatile("" : "+v"(tid_));
    const int tid = tid_, wid = __builtin_amdgcn_readfirstlane(tid >> 6), lane = tid & 63, wr = wid >> 2, wc = wid & 3, fr = lane & 15, fq = lane >> 4;
    const int K = g.K, nt = g.KT / BK;
    unsigned voffA[2], voffB[2];
#pragma unroll
    for (int i = 0; i < 2; ++i) { int R, C; stage_rc(tid * 16 + i * 8192, R, C); const int Rb = Epi::PERM ? ((R & ~31) + perm32(R & 31)) : R;
        voffA[i] = (unsigned)(R * K + C) * 2u; voffB[i] = (unsigned)(Rb * K + C) * 2u; }
    const size_t kstep = (size_t)(BK * 2);
    const size_t hstep = (size_t)HALF * K * 2;
    const size_t tstep = 2 * hstep;
    const unsigned ldsw = (unsigned)wid * 1024u;
    const int aoff = lds_byte(wr * 64 + fr, fq * 8), boff = lds_byte(wc * 32 + fr, fq * 8);
#define PG8_SA(b, h) (((b) * 2 + (h)) * HTB)
#define PG8_SB(b, h) ((4 + (b) * 2 + (h)) * HTB)
#define PG8_STAGE(bufoff, gbase, voff) do { _Pragma("unroll") for (int _i = 0; _i < 2; ++_i) \
        __builtin_amdgcn_global_load_lds((const unsigned*)((const char*)(gbase) + (voff)[_i]), (PG8_LAS unsigned*)(lds + (bufoff) + ldsw + _i * 8192), 16, 0, 0); } while (0)
#define PG8_LDA(dst, b, h) do { _Pragma("unroll") for (int m = 0; m < 4; ++m) _Pragma("unroll") for (int k = 0; k < 2; ++k) dst[m][k] = *(const PG8_LAS bf16x8*)(lds + PG8_SA(b, h) + aoff + m * 2048 + k * 1024); } while (0)
#define PG8_LDB(dst, b, h) do { _Pragma("unroll") for (int n = 0; n < 2; ++n) _Pragma("unroll") for (int k = 0; k < 2; ++k) dst[n][k] = *(const PG8_LAS bf16x8*)(lds + PG8_SB(b, h) + boff + n * 2048 + k * 1024); } while (0)
#define PG8_MMA(ai, bj, At, Bt) do { __builtin_amdgcn_s_setprio(1); _Pragma("unroll") for (int m = 0; m < 4; ++m) _Pragma("unroll") for (int n = 0; n < 2; ++n) _Pragma("unroll") for (int k = 0; k < 2; ++k) \
        acc[ai][bj][m][n] = __builtin_amdgcn_mfma_f32_16x16x32_bf16(Bt[n][k], At[m][k], acc[ai][bj][m][n], 0, 0, 0); __builtin_amdgcn_s_setprio(0); } while (0)
#define PG8_WAIT_V(n) asm volatile("s_waitcnt vmcnt(" #n ")" ::: "memory")
#define PG8_WAIT_L(n) asm volatile("s_waitcnt lgkmcnt(" #n ")" ::: "memory")
#define PG8_BAR __builtin_amdgcn_s_barrier()
#define PG8_SCHED __builtin_amdgcn_sched_barrier(0)
    Unit cur, nxt; int ui = 0;
    if (!S.next(0, cur)) return;
    f32x4 acc[2][2][4][2];
#pragma unroll
    for (int a = 0; a < 2; ++a)
#pragma unroll
        for (int b = 0; b < 2; ++b)
#pragma unroll
            for (int m = 0; m < 4; ++m)
#pragma unroll
                for (int n = 0; n < 2; ++n) acc[a][b][m][n] = (f32x4){0.f, 0.f, 0.f, 0.f};
    bf16x8 At[4][2], B0[2][2], B1[2][2];
    const char* cA = (const char*)g.A + (size_t)cur.pa * tstep + (size_t)cur.ko * 2; const char* cB = (const char*)g.Bt + (size_t)cur.pb * tstep + (size_t)cur.ko * 2;
    S.a_ready(cur);
    if constexpr (SP2) {
        PG8_STAGE(PG8_SB(0, 0), cB, voffB); PG8_STAGE(PG8_SB(0, 1), cB + hstep, voffB); PG8_STAGE(PG8_SA(0, 0), cA, voffA); PG8_STAGE(PG8_SA(0, 1), cA + hstep, voffA);
        if (wr == 1) PG8_BAR;
        PG8_WAIT_V(2); PG8_BAR;
        PG8_STAGE(PG8_SB(1, 0), cB + kstep, voffB); PG8_STAGE(PG8_SA(1, 0), cA + kstep, voffA); PG8_STAGE(PG8_SB(1, 1), cB + hstep + kstep, voffB);
        PG8_WAIT_V(6); PG8_BAR;
    } else {
        PG8_STAGE(PG8_SB(0, 0), cB, voffB); PG8_STAGE(PG8_SA(0, 0), cA, voffA); PG8_STAGE(PG8_SB(0, 1), cB + hstep, voffB); PG8_STAGE(PG8_SA(0, 1), cA + hstep, voffA);
        if (wr == 1) PG8_BAR;
        PG8_WAIT_V(4); PG8_BAR;
        PG8_STAGE(PG8_SB(1, 0), cB + kstep, voffB); PG8_STAGE(PG8_SA(1, 0), cA + kstep, voffA); PG8_STAGE(PG8_SB(1, 1), cB + hstep + kstep, voffB);
        PG8_WAIT_V(6); PG8_BAR;
    }
    for (;;) {
        const bool has_next = S.next(ui + 1, nxt);
        const char* nA = has_next ? (const char*)g.A + (size_t)nxt.pa * tstep + (size_t)nxt.ko * 2 : cA; const char* nB = has_next ? (const char*)g.Bt + (size_t)nxt.pb * tstep + (size_t)nxt.ko * 2 : cB;
        for (int t = 0; t < nt; t += 2) {
            const bool last = (t == nt - 2);
            const char* a1 = cA + (size_t)(t + 1) * kstep;
            const char* a2 = last ? nA : cA + (size_t)(t + 2) * kstep; const char* b2 = last ? nB : cB + (size_t)(t + 2) * kstep;
            const char* a3 = a2 + kstep; const char* b3 = b2 + kstep;
            if (last && has_next) S.a_ready(nxt);
            if constexpr (SP2) {
            PG8_LDB(B0, 0, 0); PG8_LDB(B1, 0, 1); PG8_SCHED; PG8_LDA(At, 0, 0); PG8_STAGE(PG8_SA(1, 1), a1 + hstep, voffA);
            PG8_WAIT_V(8); PG8_WAIT_L(0); PG8_BAR; PG8_MMA(0, 0, At, B0); PG8_MMA(0, 1, At, B1); PG8_BAR; PG8_SCHED;
            PG8_LDA(At, 0, 1); PG8_STAGE(PG8_SB(0, 0), b2, voffB); PG8_STAGE(PG8_SB(0, 1), b2 + hstep, voffB); PG8_STAGE(PG8_SA(0, 0), a2, voffA);
            PG8_WAIT_V(8); PG8_WAIT_L(0); PG8_BAR; PG8_MMA(1, 0, At, B0); PG8_MMA(1, 1, At, B1); PG8_BAR; PG8_SCHED;
            PG8_LDB(B0, 1, 0); PG8_LDB(B1, 1, 1); PG8_SCHED; PG8_LDA(At, 1, 0); PG8_STAGE(PG8_SA(0, 1), a2 + hstep, voffA);
            PG8_WAIT_V(8); PG8_WAIT_L(0); PG8_BAR; PG8_MMA(0, 0, At, B0); PG8_MMA(0, 1, At, B1); PG8_BAR; PG8_SCHED;
            PG8_LDA(At, 1, 1); PG8_STAGE(PG8_SB(1, 0), b3, voffB); PG8_STAGE(PG8_SB(1, 1), b3 + hstep, voffB); PG8_STAGE(PG8_SA(1, 0), a3, voffA);
            PG8_WAIT_V(8); PG8_WAIT_L(0); PG8_BAR; PG8_MMA(1, 0, At, B0); PG8_MMA(1, 1, At, B1); PG8_BAR; PG8_SCHED;
            } else {
            PG8_LDB(B0, 0, 0); PG8_SCHED; PG8_LDA(At, 0, 0); PG8_STAGE(PG8_SA(1, 1), a1 + hstep, voffA);
            PG8_WAIT_L(8); PG8_BAR; PG8_WAIT_L(0); PG8_MMA(0, 0, At, B0); PG8_BAR; PG8_SCHED;
            PG8_LDB(B1, 0, 1); PG8_STAGE(PG8_SB(0, 0), b2, voffB);
            PG8_BAR; PG8_WAIT_L(0); PG8_MMA(0, 1, At, B1); PG8_BAR;
            PG8_LDA(At, 0, 1); PG8_STAGE(PG8_SA(0, 0), a2, voffA);
            PG8_BAR; PG8_WAIT_L(0); PG8_MMA(1, 0, At, B0); PG8_BAR; PG8_SCHED;
            PG8_STAGE(PG8_SB(0, 1), b2 + hstep, voffB);
            PG8_WAIT_V(6); PG8_BAR; PG8_MMA(1, 1, At, B1); PG8_BAR;
            PG8_LDB(B0, 1, 0); PG8_SCHED; PG8_LDA(At, 1, 0); PG8_STAGE(PG8_SA(0, 1), a2 + hstep, voffA);
            PG8_WAIT_L(8); PG8_BAR; PG8_WAIT_L(0); PG8_MMA(0, 0, At, B0); PG8_BAR; PG8_SCHED;
            PG8_LDB(B1, 1, 1); PG8_STAGE(PG8_SB(1, 0), b3, voffB);
            PG8_BAR; PG8_WAIT_L(0); PG8_MMA(0, 1, At, B1); PG8_BAR;
            PG8_LDA(At, 1, 1); PG8_STAGE(PG8_SA(1, 0), a3, voffA);
            PG8_BAR; PG8_WAIT_L(0); PG8_MMA(1, 0, At, B0); PG8_BAR; PG8_SCHED;
            PG8_STAGE(PG8_SB(1, 1), b3 + hstep, voffB);
            PG8_WAIT_V(6); PG8_BAR; PG8_MMA(1, 1, At, B1); PG8_BAR;
            }
        }
        if constexpr (ALIGN_EPI) { if (wr == 0) PG8_BAR; }
        if constexpr (!Epi::AFTER_DRAIN) { E(acc, cur, wr, wc, fr, fq); S.done(cur); }
        if (!has_next) break;
#pragma unroll
        for (int a = 0; a < 2; ++a)
#pragma unroll
            for (int b = 0; b < 2; ++b)
#pragma unroll
                for (int m = 0; m < 4; ++m)
#pragma unroll
                    for (int n = 0; n < 2; ++n) acc[a][b][m][n] = (f32x4){0.f, 0.f, 0.f, 0.f};
        cur = nxt; cA = nA; cB = nB; ++ui;
        if constexpr (ALIGN_EPI) { if (wr == 1) PG8_BAR; }
    }
    PG8_WAIT_V(0);
    if constexpr (!ALIGN_EPI) { if (wr == 0) PG8_BAR; }
    PG8_BAR;
    if constexpr (Epi::AFTER_DRAIN) { E.fused(acc, cur, wr, wc, fr, fq, lds, wid, lane); S.done(cur); }
#undef PG8_SA
#undef PG8_SB
#undef PG8_STAGE
#undef PG8_LDA
#undef PG8_LDB
#undef PG8_MMA
#undef PG8_WAIT_V
#undef PG8_WAIT_L
#undef PG8_BAR
#undef PG8_SCHED
}
}

constexpr int NWAVES = 8, NTHR = 512;
constexpr int D = 2048, SEQ = 4096, NLAT = 8192, CTXL = 256, NCTX = 512, MROWS = 8704, DEPTH = 2;
constexpr int INC = 15392, NU = 15360;
constexpr int U_CB = 0, U_CC = 1024, U_CX = 2048, U_GQ = 3072, U_GK = 3584, U_GV = 4096, U_GR = 5120, U_NQ = 6144, U_NK = 7168, U_NV = 8192, U_GATE = 9216;
constexpr int LR_COL = 6144;
constexpr int FF = 5632, NGU = 2 * FF, NE = 8;
constexpr float LN_EPS = 1e-5f, ALPHA = 1.41421356237f;
constexpr int MOE_MAXP = 72;

constexpr size_t MiB = 1u << 20;
constexpr size_t WS_CTL = 0, CTL_ZERO_BYTES = 1 * MiB;
constexpr size_t WS_MOD = 1 * MiB;
constexpr size_t WS_WLR = 1 * MiB + 512 * 1024;
constexpr size_t WS_ROUTE = 2 * MiB;
constexpr size_t WS_TOK = 2 * MiB + 256 * 1024;
constexpr size_t WS_LR = 3 * MiB;
constexpr size_t WS_W = 8 * MiB;
constexpr size_t W_IN_B = (size_t)NU * D * 2, W_BR_B = (size_t)1024 * D * 2, W_OUT_B = (size_t)D * D * 2, W_LAYER_B = W_IN_B + 3 * W_BR_B + W_OUT_B;
constexpr size_t W_GU_B = (size_t)NGU * D * 2, W_D_B = (size_t)D * FF * 2, W_FFN_B = W_GU_B + W_D_B;
constexpr size_t WS_WFFN = WS_W + 2 * W_LAYER_B, WS_WMOE = WS_WFFN + W_FFN_B, WS_WEND = WS_WMOE + 8 * W_FFN_B;
constexpr size_t WS_XL = 762 * MiB;
constexpr size_t WS_H = 830 * MiB;
constexpr size_t WS_U = 864 * MiB;
constexpr size_t WS_Y = 1119 * MiB;
constexpr size_t WS_GLA = 1170 * MiB;
constexpr size_t WS_Z = 1306 * MiB;
constexpr size_t WS_ZB = 1374 * MiB;
constexpr size_t WS_PRE = 1408 * MiB;
constexpr size_t WS_PART = 1476 * MiB;
constexpr size_t WS_END = 1520 * MiB;
static_assert(WS_WEND <= WS_XL && WS_XL + (size_t)MROWS * D * 4 <= WS_H && WS_H + (size_t)MROWS * D * 2 <= WS_U && WS_U + (size_t)MROWS * NU * 2 <= WS_Y, "ws map 1");
static_assert(WS_U + (size_t)MOE_MAXP * 256 * FF * 2 <= WS_Y && WS_Y + 3 * (size_t)MROWS * 1024 * 2 <= WS_GLA && WS_GLA + (size_t)MROWS * (4 * 512 + 2 * 1024) * 4 <= WS_Z, "ws map 2");
static_assert(WS_GLA + (size_t)MOE_MAXP * 256 * D * 2 <= WS_Z && WS_Z + (size_t)MOE_MAXP * 256 * D * 4 <= WS_END && WS_PRE + (size_t)MROWS * D * 4 <= WS_END, "ws map 3");
constexpr int CW_TMO = 0, CW_CODE = 1;
constexpr int CW_MOECNT = 64;
constexpr int CW_BAR = 4096;

constexpr int RING_OFF = 0, RING_BYTES = 131072;
constexpr int LDSCTL_OFF = RING_BYTES, MISC_OFF = LDSCTL_OFF + 320;
constexpr int LDS_BYTES = 147456;

#define GAS __attribute__((address_space(1)))
#define LAS __attribute__((address_space(3)))
typedef unsigned short bf16;
typedef unsigned v4u __attribute__((ext_vector_type(4)));
typedef unsigned v2u __attribute__((ext_vector_type(2)));
typedef float f32x4 __attribute__((ext_vector_type(4)));
typedef GAS unsigned gu32;
typedef short bf16x8v __attribute__((ext_vector_type(8)));
#define RLX_AGENT __ATOMIC_RELAXED, __HIP_MEMORY_SCOPE_AGENT
#define LDS_WAIT() asm volatile("s_waitcnt lgkmcnt(0)" ::: "memory")
#define VM_WAIT() asm volatile("s_waitcnt vmcnt(0)" ::: "memory")
__device__ __forceinline__ unsigned f2bf(float f) { unsigned u = __builtin_bit_cast(unsigned, f); return (u + 0x7fffu + ((u >> 16) & 1u)) >> 16; }
__device__ __forceinline__ unsigned pk2(float lo, float hi) { return f2bf(lo) | (f2bf(hi) << 16); }
__device__ __forceinline__ float bflo(unsigned w) { return __uint_as_float(w << 16); }
__device__ __forceinline__ float bfhi(unsigned w) { return __uint_as_float(w & 0xffff0000u); }
__device__ __forceinline__ float bf1(bf16 b) { return __uint_as_float(((unsigned)b) << 16); }
__device__ __forceinline__ float wave_sum(float v) {
#pragma unroll
    for (int o = 1; o < 64; o <<= 1) v += __shfl_xor(v, o);
    return v;
}
__device__ __forceinline__ float wave_max(float v) {
#pragma unroll
    for (int o = 1; o < 64; o <<= 1) v = fmaxf(v, __shfl_xor(v, o));
    return v;
}

#define XB_TMO      128
#define XB_XCNT(j)  (256  + 64 * (j))
#define XB_XSUB(j)  (1280 + 64 * (j))
#define XB_XGEN(j)  (2304 + 64 * (j))
#define XB_TOP      3328
#define XB_TOPGEN   3392
#define XCD_BAR_WORDS 3456
#define XB_SPIN_CAP (1u << 18)

__device__ __forceinline__ unsigned xb_ld(unsigned* p)              { return __hip_atomic_load(p, __ATOMIC_RELAXED, __HIP_MEMORY_SCOPE_AGENT); }
__device__ __forceinline__ unsigned xb_add(unsigned* p, unsigned v) { return __hip_atomic_fetch_add(p, v, __ATOMIC_RELAXED, __HIP_MEMORY_SCOPE_AGENT); }
__device__ __forceinline__ unsigned xb_xcc_id() { return (unsigned)__builtin_amdgcn_s_getreg((3 << 11) | 20) & 0xFu; }
#define XB_SPIN(cond, bar) do { unsigned _sp = 0; while (cond) { __builtin_amdgcn_s_sleep(1); \
    if ((++_sp & 255u) == 0u) { if (xb_ld(&(bar)[XB_TMO])) break; if (_sp > XB_SPIN_CAP) { atomicAdd(&(bar)[XB_TMO], 1u); break; } } } } while (0)

struct XcdBarrier {
    unsigned* bar; unsigned x; unsigned grid;
    volatile LAS unsigned* st;
};

__device__ __forceinline__ XcdBarrier xcd_barrier_post(unsigned* bar, volatile LAS unsigned* st, unsigned grid) {
    XcdBarrier b; b.grid = grid; b.bar = bar; b.x = xb_xcc_id(); b.st = st;
    if (threadIdx.x == 0) (void)xb_add(&bar[XB_XCNT(b.x)], 1u);
    return b;
}
__device__ __forceinline__ void xcd_barrier_complete(unsigned* bar, unsigned x, unsigned& nloc, unsigned& nx, unsigned b_grid) {
    const unsigned G = b_grid;
    unsigned sum, cnt, mine, sp = 0u;
    for (;;) {
        sum = 0u; cnt = 0u; mine = 0u;
#pragma unroll
        for (unsigned j = 0; j < 16; ++j) { const unsigned c = xb_ld(&bar[XB_XCNT(j)]); sum += c; cnt += (c > 0u) ? 1u : 0u; mine = (j == x) ? c : mine; }
        if (sum == G) break;
        __builtin_amdgcn_s_sleep(1);
        if ((++sp & 255u) == 0u) { if (xb_ld(&bar[XB_TMO])) break; if (sp > XB_SPIN_CAP) { atomicAdd(&bar[XB_TMO], 1u); break; } }
    }
    nloc = mine > 0u ? mine : 1u; nx = cnt > 0u ? cnt : 1u;
}

__device__ __forceinline__ void xcd_barrier(const XcdBarrier& b) {
    asm volatile("s_waitcnt vmcnt(0)" ::: "memory");
    __syncthreads();
    if (threadIdx.x == 0) {
        unsigned* bar = b.bar;
        __builtin_amdgcn_s_waitcnt(0);
        unsigned nloc = b.st[0], nx = b.st[1];
        if (nloc == 0u) { xcd_barrier_complete(bar, b.x, nloc, nx, b.grid); b.st[0] = nloc; b.st[1] = nx; }
        const unsigned old = xb_add(&bar[XB_XSUB(b.x)], 1u);
        const unsigned gen = old / nloc;
        if (old + 1u == (gen + 1u) * nloc) {
            __builtin_amdgcn_fence(__ATOMIC_RELEASE, "agent");
            asm volatile("s_waitcnt vmcnt(0)" ::: "memory");
            const unsigned og = xb_add(&bar[XB_TOP], 1u);
            const unsigned tg = og / nx;
            if (og + 1u == (tg + 1u) * nx) xb_add(&bar[XB_TOPGEN], 1u);
            else XB_SPIN(xb_ld(&bar[XB_TOPGEN]) == tg, bar);
            __builtin_amdgcn_fence(__ATOMIC_ACQUIRE, "agent");
            xb_add(&bar[XB_XGEN(b.x)], 1u);
            asm volatile("s_waitcnt vmcnt(0)" ::: "memory");
        } else {
            XB_SPIN(xb_ld(&bar[XB_XGEN(b.x)]) == gen, bar);
            __builtin_amdgcn_fence(__ATOMIC_ACQUIRE, "agent");
            asm volatile("s_waitcnt vmcnt(0)" ::: "memory");
        }
    }
    __syncthreads();
}

struct Args { const float* in[30]; float* out; unsigned char* ws; int ph_lo, ph_hi, grid, pad; };
struct Frame {
    LAS unsigned char* lds;
    volatile LAS unsigned* MISC;
    int tid, lane, wave, vcu, G, bx;
};
__device__ __forceinline__ Frame mkframe(LAS unsigned char* lds, int grid) {
    Frame F; int t = threadIdx.x; asm volatile("" : "+v"(t)); int g = grid, bx = blockIdx.x; asm volatile("" : "+s"(g), "+s"(bx));
    F.lds = lds; F.MISC = (volatile LAS unsigned*)(lds + MISC_OFF); F.tid = t; F.lane = t & 63; F.wave = __builtin_amdgcn_readfirstlane(t >> 6); F.G = g; F.bx = bx;
    F.vcu = (g % 8 == 0) ? (bx % 8) * (g / 8) + bx / 8 : bx; return F;
}
constexpr int PTAB_OFF = LDSCTL_OFF + 1024, PT_OUT = 30, PT_WS = 31;
__device__ __forceinline__ unsigned long long ldp_raw(Frame& F, int i) {
    const volatile LAS unsigned* t = (const volatile LAS unsigned*)(F.lds + PTAB_OFF) + 2 * i; const unsigned lo = t[0], hi = t[1];
    return ((unsigned long long)(unsigned)__builtin_amdgcn_readfirstlane((int)hi) << 32) | (unsigned)__builtin_amdgcn_readfirstlane((int)lo);
}
#define PIN(i) ((const float*)(const GAS float*)ldp_raw(F, (i)))
#define POUT() ((float*)(GAS float*)ldp_raw(F, PT_OUT))
#define PWS() ((unsigned char*)(GAS unsigned char*)ldp_raw(F, PT_WS))
__device__ __forceinline__ bf16* w_in_t(unsigned char* ws, int L) { return (bf16*)(ws + WS_W + (size_t)L * W_LAYER_B); }
__device__ __forceinline__ bf16* w_br_t(unsigned char* ws, int L, int b) { return (bf16*)(ws + WS_W + (size_t)L * W_LAYER_B + W_IN_B + (size_t)b * W_BR_B); }
__device__ __forceinline__ bf16* w_out_t(unsigned char* ws, int L) { return (bf16*)(ws + WS_W + (size_t)L * W_LAYER_B + W_IN_B + 3 * W_BR_B); }
__device__ __forceinline__ bf16* w_gu_t(unsigned char* ws, int e) { return (bf16*)(ws + (e < 0 ? WS_WFFN : WS_WMOE + (size_t)e * W_GU_B)); }
__device__ __forceinline__ bf16* w_d_t(unsigned char* ws, int e) { return (bf16*)(ws + (e < 0 ? WS_WFFN + W_GU_B : WS_WMOE + 8 * W_GU_B + (size_t)e * W_D_B)); }

__device__ __forceinline__ void transpose_item(const float* W, int K, int N, bf16* WT, int drow, LAS float* scr, int kb, int nb, int lane) {
    const int k0 = 64 * kb, n0 = 32 * nb;
#pragma unroll 8
    for (int i = 0; i < 32; ++i) { const int kk = 2 * i + (lane >> 5); scr[kk * 33 + (lane & 31)] = W[(size_t)(k0 + kk) * N + n0 + (lane & 31)]; }
    LDS_WAIT(); asm volatile("" ::: "memory");
    const int c = lane & 7;
#pragma unroll
    for (int j = 0; j < 4; ++j) { const int n = (lane >> 3) + 8 * j; const LAS float* s = scr + (8 * c) * 33 + n;
        v4u o; o.x = pk2(s[0 * 33], s[1 * 33]); o.y = pk2(s[2 * 33], s[3 * 33]); o.z = pk2(s[4 * 33], s[5 * 33]); o.w = pk2(s[6 * 33], s[7 * 33]);
        *(GAS v4u*)(WT + (size_t)(drow + n) * K + k0 + 8 * c) = o; }
    LDS_WAIT(); asm volatile("" ::: "memory");
}
template <int MODE> __device__ __forceinline__ void conv_matrix(Frame& F, const float* W, int K, int N, bf16* WT) {
    LAS float* scr = (LAS float*)(F.lds + RING_OFF + F.wave * 16384);
    const int gw = F.vcu * NWAVES + F.wave, NGW = F.G * NWAVES;
    const int nblk = N / 32, nitems = (K / 64) * nblk;
    for (int it = gw; it < nitems; it += NGW) {
        const int kb = it / nblk, nb = it % nblk; int drow;
        if (MODE == 0) drow = 32 * nb;
        else if (MODE == 1) { if (nb == LR_COL / 32) continue; drow = nb < LR_COL / 32 ? 32 * nb : 32 * (nb - 1); }
        else if (MODE == 2) drow = 256 * (nb >> 2) + 32 * (nb & 3);
        else drow = 256 * (nb >> 2) + 128 + 32 * (nb & 3);
        transpose_item(W, K, N, WT, drow, scr, kb, nb, F.lane);
    }
}
__device__ __forceinline__ void ada_item(Frame& F, unsigned char* ws, const float* cnd, const float* cctx, const float* ada_w, const float* ada_b, int item) {
    const int L = item / 96, c0 = (item % 96) * 128;
    LAS float* sc = (LAS float*)(F.lds + RING_OFF);
    LAS float* red = (LAS float*)(F.lds + RING_OFF + 24576);
    for (int i = F.tid; i < 3 * D; i += NTHR) { const int g = i / D, k = i % D; const float v = g < 2 ? cnd[g * D + k] : cctx[k]; sc[i] = v / (1.0f + __expf(-v)); }
    __syncthreads();
    const float* W = ada_w + (size_t)L * D * 12288 + c0 + 2 * F.lane;
    float a00 = 0.f, a01 = 0.f, a10 = 0.f, a11 = 0.f, a20 = 0.f, a21 = 0.f;
    const int kb = 256 * F.wave;
#pragma unroll 8
    for (int k = kb; k < kb + 256; ++k) { const float2 w = *(const float2*)(W + (size_t)k * 12288); const float s0 = sc[k], s1 = sc[D + k], s2 = sc[2 * D + k];
        a00 += s0 * w.x; a01 += s0 * w.y; a10 += s1 * w.x; a11 += s1 * w.y; a20 += s2 * w.x; a21 += s2 * w.y; }
    red[(F.wave * 3 + 0) * 128 + 2 * F.lane] = a00; red[(F.wave * 3 + 0) * 128 + 2 * F.lane + 1] = a01;
    red[(F.wave * 3 + 1) * 128 + 2 * F.lane] = a10; red[(F.wave * 3 + 1) * 128 + 2 * F.lane + 1] = a11;
    red[(F.wave * 3 + 2) * 128 + 2 * F.lane] = a20; red[(F.wave * 3 + 2) * 128 + 2 * F.lane + 1] = a21;
    __syncthreads();
    if (F.tid < 384) { const int g = F.tid / 128, cc = F.tid % 128; float s = 0.f;
#pragma unroll
        for (int w = 0; w < 8; ++w) s += red[(w * 3 + g) * 128 + cc];
        ((float*)(ws + WS_MOD))[((size_t)L * 3 + g) * 12288 + c0 + cc] = s + ada_b[L * 12288 + c0 + cc]; }
    __syncthreads();
}
__device__ __forceinline__ void p0a_prologue(Frame& F) {
    unsigned char* const ws = PWS();
    { const float* cnd = PIN(1); const float* cctx = PIN(3); const float* ada_w = PIN(4); const float* ada_b = PIN(5);
      for (int it = F.bx; it < 192; it += F.G) ada_item(F, ws, cnd, cctx, ada_w, ada_b, it); }
    const float* const w_in = PIN(6);
    { const int gt = F.bx * NTHR + F.tid, NGT = F.G * NTHR;
      for (int i = gt; i < DEPTH * D * 32; i += NGT) { const int o = i & 31, k = (i >> 5) % D, L = i / (32 * D); ((bf16*)(ws + WS_WLR))[((size_t)L * 32 + o) * D + k] = (bf16)f2bf(w_in[((size_t)L * D + k) * INC + LR_COL + o]); } }
    for (int L = 0; L < DEPTH; ++L) {
        conv_matrix<1>(F, w_in + (size_t)L * D * INC, D, INC, w_in_t(ws, L));
        for (int b = 0; b < 3; ++b) conv_matrix<0>(F, (b == 0 ? PIN(14) : (b == 1 ? PIN(15) : PIN(16))) + (size_t)L * 1024 * D, 1024, D, w_br_t(ws, L, b));
        conv_matrix<0>(F, PIN(18) + (size_t)L * D * D, D, D, w_out_t(ws, L));
    }
    conv_matrix<2>(F, PIN(23), D, FF, w_gu_t(ws, -1)); conv_matrix<3>(F, PIN(24), D, FF, w_gu_t(ws, -1)); conv_matrix<0>(F, PIN(25), FF, D, w_d_t(ws, -1));
    for (int e = 0; e < NE; ++e) {
        conv_matrix<2>(F, PIN(27) + (size_t)e * D * FF, D, FF, w_gu_t(ws, e)); conv_matrix<3>(F, PIN(28) + (size_t)e * D * FF, D, FF, w_gu_t(ws, e));
        conv_matrix<0>(F, PIN(29) + (size_t)e * FF * D, FF, D, w_d_t(ws, e));
    }
}

__device__ __forceinline__ int row_group(int r) { return r < SEQ ? 0 : (r < NLAT ? 1 : 2); }
__device__ __forceinline__ void load_row(const float* p, int lane, f32x4 (&v)[8]) {
#pragma unroll
    for (int j = 0; j < 8; ++j) v[j] = *(const GAS f32x4*)(p + 4 * lane + 256 * j);
}
__device__ __forceinline__ void store_row(float* p, int lane, const f32x4 (&v)[8]) {
#pragma unroll
    for (int j = 0; j < 8; ++j) *(GAS f32x4*)(p + 4 * lane + 256 * j) = v[j];
}
__device__ __forceinline__ void store_row_bf16(bf16* p, int lane, const f32x4 (&v)[8]) {
#pragma unroll
    for (int j = 0; j < 8; ++j) { v2u w; w.x = pk2(v[j][0], v[j][1]); w.y = pk2(v[j][2], v[j][3]); *(GAS v2u*)(p + 4 * lane + 256 * j) = w; }
}
__device__ __forceinline__ void modulate(f32x4 (&v)[8], const float* shift, const float* scale, int lane) {
#pragma unroll
    for (int j = 0; j < 8; ++j) { const f32x4 sh = *(const f32x4*)(shift + 4 * lane + 256 * j), sc = *(const f32x4*)(scale + 4 * lane + 256 * j); v[j] = v[j] * (sc + 1.0f) + sh; }
}
__device__ __forceinline__ void layer_norm_row(f32x4 (&v)[8], const float* g, const float* b, int lane) {
    float s = 0.f;
#pragma unroll
    for (int j = 0; j < 8; ++j) s += (v[j][0] + v[j][1]) + (v[j][2] + v[j][3]);
    const float mean = wave_sum(s) * (1.0f / D); float q = 0.f;
#pragma unroll
    for (int j = 0; j < 8; ++j) { v[j] = v[j] - mean; q += (v[j][0] * v[j][0] + v[j][1] * v[j][1]) + (v[j][2] * v[j][2] + v[j][3] * v[j][3]); }
    const float rstd = 1.0f / sqrtf(wave_sum(q) * (1.0f / D) + LN_EPS);
#pragma unroll
    for (int j = 0; j < 8; ++j) { const f32x4 g4 = *(const f32x4*)(g + 4 * lane + 256 * j), b4 = *(const f32x4*)(b + 4 * lane + 256 * j); v[j] = v[j] * rstd * g4 + b4; }
}
__device__ __forceinline__ void lr_tiles(Frame& F, int L) {
    unsigned char* const ws = PWS(); const bf16* H = (const bf16*)(ws + WS_H); const bf16* W = (const bf16*)(ws + WS_WLR) + (size_t)L * 32 * D; float* LRo = (float*)(ws + WS_LR);
    const int g = F.lane >> 4, l15 = F.lane & 15, gw = F.vcu * NWAVES + F.wave, NGW = F.G * NWAVES;
    for (int task = gw; task < MROWS / 16; task += NGW) {
        const bf16* ap = H + (size_t)(16 * task + l15) * D + 8 * g; const bf16* bp = W + (size_t)l15 * D + 8 * g;
        f32x4 a0 = {0.f, 0.f, 0.f, 0.f}, a1 = {0.f, 0.f, 0.f, 0.f};
#pragma unroll 8
        for (int ks = 0; ks < D / 32; ++ks) { const bf16x8v af = __builtin_bit_cast(bf16x8v, *(const GAS v4u*)(ap + 32 * ks)), b0 = __builtin_bit_cast(bf16x8v, *(const GAS v4u*)(bp + 32 * ks)), b1 = __builtin_bit_cast(bf16x8v, *(const GAS v4u*)(bp + (size_t)16 * D + 32 * ks));
            a0 = __builtin_amdgcn_mfma_f32_16x16x32_bf16(af, b0, a0, 0, 0, 0); a1 = __builtin_amdgcn_mfma_f32_16x16x32_bf16(af, b1, a1, 0, 0, 0); }
#pragma unroll
        for (int i = 0; i < 4; ++i) { float* o = LRo + (size_t)(16 * task + 4 * g + i) * 32 + l15; o[0] = a0[i]; o[16] = a1[i]; }
    }
}
__device__ __forceinline__ void p0b_modulate(Frame& F) {
    unsigned char* const ws = PWS(); const float* const xin = PIN(0); const float* const cin = PIN(2);
    const int gw = F.vcu * NWAVES + F.wave, NGW = F.G * NWAVES;
    for (int r = gw; r < MROWS; r += NGW) {
        f32x4 v[8]; load_row(r < NLAT ? xin + (size_t)r * D : cin + (size_t)(r - NLAT) * D, F.lane, v);
        const float* m = ((float*)(ws + WS_MOD)) + (size_t)row_group(r) * 12288;
        modulate(v, m, m + D, F.lane); store_row_bf16(((bf16*)(ws + WS_H)) + (size_t)r * D, F.lane, v);
    }
}

__device__ __forceinline__ void mix_prep(Frame& F, int L) {
    unsigned char* const ws = PWS();
    const int gt = F.bx * NTHR + F.tid, NGT = F.G * NTHR;
    const float* cw = PIN(7) + (size_t)L * 3 * 1024;
    for (int i = gt; i < MROWS * 128; i += NGT) {
        const int r = i >> 7, c8 = (i & 127) * 8;
        const int t = r < NLAT ? (r & (SEQ - 1)) : ((r - NLAT) & (CTXL - 1)), T = r < NLAT ? SEQ : CTXL;
        float acc[8];
#pragma unroll
        for (int j = 0; j < 8; ++j) acc[j] = 0.f;
#pragma unroll
        for (int k = 0; k < 3; ++k) { const int tt = t + k - 1; if (tt < 0 || tt >= T) continue;
            const bf16* up = ((bf16*)(ws + WS_U)) + (size_t)(r + k - 1) * NU; const v4u a = *(const GAS v4u*)(up + U_CC + c8), b = *(const GAS v4u*)(up + U_CX + c8);
            const f32x4 w0 = *(const f32x4*)(cw + k * 1024 + c8), w1 = *(const f32x4*)(cw + k * 1024 + c8 + 4);
            acc[0] += w0[0] * bflo(a.x) * bflo(b.x); acc[1] += w0[1] * bfhi(a.x) * bfhi(b.x); acc[2] += w0[2] * bflo(a.y) * bflo(b.y); acc[3] += w0[3] * bfhi(a.y) * bfhi(b.y);
            acc[4] += w1[0] * bflo(a.z) * bflo(b.z); acc[5] += w1[1] * bfhi(a.z) * bfhi(b.z); acc[6] += w1[2] * bflo(a.w) * bflo(b.w); acc[7] += w1[3] * bfhi(a.w) * bfhi(b.w); }
        const v4u ab = *(const GAS v4u*)(((bf16*)(ws + WS_U)) + (size_t)r * NU + U_CB + c8);
        v4u o; o.x = pk2(acc[0] * bflo(ab.x), acc[1] * bfhi(ab.x)); o.y = pk2(acc[2] * bflo(ab.y), acc[3] * bfhi(ab.y)); o.z = pk2(acc[4] * bflo(ab.z), acc[5] * bfhi(ab.z)); o.w = pk2(acc[6] * bflo(ab.w), acc[7] * bfhi(ab.w));
        *(GAS v4u*)(((bf16*)(ws + WS_Y)) + (size_t)r * 1024 + c8) = o;
    }
}
__device__ __forceinline__ void sum_partials(f32x4 (&v)[8], const float* P, int ns, const float* res, const float* gvec, int lane) {
#pragma unroll
    for (int j = 0; j < 8; ++j) v[j] = (f32x4){0.f, 0.f, 0.f, 0.f};
    for (int s = 0; s < ns; ++s) {
#pragma unroll
        for (int j = 0; j < 8; ++j) v[j] += *(const GAS f32x4*)(P + (size_t)s * 512 * D + 4 * lane + 256 * j); }
#pragma unroll
    for (int j = 0; j < 8; ++j) { const f32x4 r4 = *(const GAS f32x4*)(res + 4 * lane + 256 * j), g4 = *(const f32x4*)(gvec + 4 * lane + 256 * j); v[j] = r4 * ALPHA + g4 * v[j]; }
}
__device__ __forceinline__ void ln1_phase(Frame& F, int L, int M) {
    unsigned char* const ws = PWS(); const float* const lng = PIN(19) + L * D; const float* const lnb = PIN(20) + L * D; const float* const router = PIN(26); const float* const cin = PIN(2);
    const int gw = F.vcu * NWAVES + F.wave, NGW = F.G * NWAVES;
    for (int r = gw; r < M; r += NGW) {
        const float* m = ((float*)(ws + WS_MOD)) + ((size_t)L * 3 + row_group(r)) * 12288;
        f32x4 v[8];
        if (r < NLAT) load_row(((float*)(ws + WS_PRE)) + (size_t)r * D, F.lane, v);
        else sum_partials(v, ((float*)(ws + WS_PART)) + (size_t)(r - NLAT) * D, 8, cin + (size_t)(r - NLAT) * D, m + 2 * D, F.lane);
        layer_norm_row(v, lng, lnb, F.lane);
        store_row(((float*)(ws + WS_XL)) + (size_t)r * D, F.lane, v);
        modulate(v, m + 3 * D, m + 4 * D, F.lane);
        store_row_bf16(((bf16*)(ws + WS_H)) + (size_t)r * D, F.lane, v);
        if (L == 1) {
            float lg[8];
#pragma unroll
            for (int e = 0; e < 8; ++e) lg[e] = 0.f;
#pragma unroll
            for (int j = 0; j < 8; ++j)
#pragma unroll
                for (int i = 0; i < 4; ++i) { const float* rp = router + (size_t)(4 * F.lane + 256 * j + i) * 8; const f32x4 w0 = *(const f32x4*)rp, w1 = *(const f32x4*)(rp + 4); const float hv = v[j][i];
                    lg[0] += hv * w0[0]; lg[1] += hv * w0[1]; lg[2] += hv * w0[2]; lg[3] += hv * w0[3]; lg[4] += hv * w1[0]; lg[5] += hv * w1[1]; lg[6] += hv * w1[2]; lg[7] += hv * w1[3]; }
#pragma unroll
            for (int e = 0; e < 8; ++e) lg[e] = wave_sum(lg[e]);
            int e0 = 0; float v0 = lg[0];
#pragma unroll
            for (int e = 1; e < 8; ++e) if (lg[e] > v0) { v0 = lg[e]; e0 = e; }
            int e1 = -1; float v1 = -INFINITY;
#pragma unroll
            for (int e = 0; e < 8; ++e) if (e != e0 && lg[e] > v1) { v1 = lg[e]; e1 = e; }
            if (F.lane == 0) {
                const float w0 = 1.0f / (1.0f + __expf(v1 - v0)), w1 = 1.0f - w0;
                const unsigned p0 = __hip_atomic_fetch_add(((gu32*)(ws + WS_CTL)) + CW_MOECNT + 64 * e0, 1u, RLX_AGENT), p1 = __hip_atomic_fetch_add(((gu32*)(ws + WS_CTL)) + CW_MOECNT + 64 * e1, 1u, RLX_AGENT);
                ((int*)(ws + WS_TOK))[e0 * NLAT + p0] = r; ((int*)(ws + WS_TOK))[e1 * NLAT + p1] = r;
                unsigned* rt = ((unsigned*)(ws + WS_ROUTE)) + (size_t)r * 8; rt[0] = e0; rt[1] = p0; rt[2] = __float_as_uint(w0); rt[3] = e1; rt[4] = p1; rt[5] = __float_as_uint(w1);
            }
        }
    }
}
__device__ __forceinline__ void moe_prefix(unsigned char* ws, unsigned (&cnt)[8], int (&pp)[9]) {
    pp[0] = 0;
#pragma unroll
    for (int e = 0; e < 8; ++e) { cnt[e] = __hip_atomic_load(((gu32*)(ws + WS_CTL)) + CW_MOECNT + 64 * e, RLX_AGENT); pp[e + 1] = pp[e] + (int)((cnt[e] + 255u) >> 8); }
}
__device__ __forceinline__ void moe_gather(Frame& F) {
    unsigned char* const ws = PWS();
    const int gw = F.vcu * NWAVES + F.wave, NGW = F.G * NWAVES;
    unsigned cnt[8]; int pp[9]; moe_prefix(ws, cnt, pp);
    for (int s = gw; s < pp[8] * 256; s += NGW) {
        const int p = s >> 8; int e = 0, base = 0; unsigned ce = cnt[0];
#pragma unroll
        for (int k = 1; k < 8; ++k) if (p >= pp[k]) { e = k; base = pp[k]; ce = cnt[k]; }
        const unsigned pos = (unsigned)(s - base * 256);
        GAS v4u* dst = (GAS v4u*)(((bf16*)(ws + WS_GLA)) + (size_t)s * D) + F.lane;
        if (pos < ce) { const int tkn = ((int*)(ws + WS_TOK))[e * NLAT + pos]; const GAS v4u* src = (const GAS v4u*)(((bf16*)(ws + WS_H)) + (size_t)tkn * D) + F.lane;
#pragma unroll
            for (int j = 0; j < 4; ++j) dst[64 * j] = src[64 * j]; }
        else {
#pragma unroll
            for (int j = 0; j < 4; ++j) dst[64 * j] = (v4u){0u, 0u, 0u, 0u}; }
    }
}
__device__ __forceinline__ void ln2_dense(Frame& F, int L) {
    unsigned char* const ws = PWS(); const float* const lng = PIN(21) + L * D; const float* const lnb = PIN(22) + L * D;
    const int gw = F.vcu * NWAVES + F.wave, NGW = F.G * NWAVES;
    for (int r = gw; r < MROWS; r += NGW) {
        f32x4 v[8];
        if (r < NLAT) load_row(((float*)(ws + WS_PRE)) + (size_t)r * D, F.lane, v);
        else sum_partials(v, ((float*)(ws + WS_PART)) + (size_t)(r - NLAT) * D, 11, ((float*)(ws + WS_XL)) + (size_t)r * D, ((float*)(ws + WS_MOD)) + ((size_t)L * 3 + 2) * 12288 + 5 * D, F.lane);
        layer_norm_row(v, lng, lnb, F.lane);
        store_row(((float*)(ws + WS_XL)) + (size_t)r * D, F.lane, v);
        const float* m = ((float*)(ws + WS_MOD)) + ((size_t)(L + 1) * 3 + row_group(r)) * 12288;
        modulate(v, m, m + D, F.lane); store_row_bf16(((bf16*)(ws + WS_H)) + (size_t)r * D, F.lane, v);
    }
}
__device__ __forceinline__ void ln2_moe(Frame& F, int L) {
    unsigned char* const ws = PWS(); const float* const lng = PIN(21) + L * D; const float* const lnb = PIN(22) + L * D; float* const outp = POUT();
    const int gw = F.vcu * NWAVES + F.wave, NGW = F.G * NWAVES;
    unsigned cnt[8]; int pp[9]; moe_prefix(ws, cnt, pp);
    for (int r = gw; r < NLAT; r += NGW) {
        const unsigned* rt = ((unsigned*)(ws + WS_ROUTE)) + (size_t)r * 8; const int e0 = rt[0], e1 = rt[3]; const float w0 = __uint_as_float(rt[2]), w1 = __uint_as_float(rt[5]);
        int b0 = 0, b1 = 0;
#pragma unroll
        for (int k = 1; k < 8; ++k) { if (e0 >= k) b0 = pp[k]; if (e1 >= k) b1 = pp[k]; }
        const size_t s0 = (size_t)b0 * 256 + rt[1], s1 = (size_t)b1 * 256 + rt[4];
        f32x4 v[8], y0[8], y1[8]; load_row(((float*)(ws + WS_XL)) + (size_t)r * D, F.lane, v); load_row(((float*)(ws + WS_Z)) + s0 * D, F.lane, y0); load_row(((float*)(ws + WS_Z)) + s1 * D, F.lane, y1);
        const float* g2 = ((float*)(ws + WS_MOD)) + ((size_t)L * 3 + row_group(r)) * 12288 + 5 * D;
#pragma unroll
        for (int j = 0; j < 8; ++j) { const f32x4 g4 = *(const f32x4*)(g2 + 4 * F.lane + 256 * j); v[j] = v[j] * ALPHA + g4 * (y0[j] * w0 + y1[j] * w1); }
        layer_norm_row(v, lng, lnb, F.lane);
        store_row(outp + (size_t)r * D, F.lane, v);
    }
}

constexpr int GLA_NCH = 68;
constexpr size_t GLA_DST_BYTES = (size_t)16 * GLA_NCH * 256 * 128 * 2;
#define GLA_DST(ws) ((bf16*)((ws) + WS_GLA))
#define GLA_DEC(ws) ((float*)((ws) + WS_GLA + GLA_DST_BYTES))
__device__ __forceinline__ int gla_chunk_row0(int b, int cn) { return cn < 4 ? NLAT + CTXL * b + 64 * cn : SEQ * b + 64 * (cn - 4); }
__device__ __forceinline__ int gla_scan_idx(int cn, int dir) { return dir ? (cn < 4 ? 3 - cn : 71 - cn) : cn; }
__device__ __forceinline__ float log_sigmoid16(float z) { return (fminf(z, 0.f) - __logf(1.0f + __expf(-fabsf(z)))) * (1.0f / 16.0f); }
__device__ __forceinline__ bf16x8v tr_frag(unsigned addr, unsigned pitch4) {
    v2u lo, hi;
    asm volatile("ds_read_b64_tr_b16 %0, %2\n\tds_read_b64_tr_b16 %1, %3\n\ts_waitcnt lgkmcnt(0)" : "=&v"(lo), "=&v"(hi) : "v"(addr), "v"(addr + pitch4) : "memory");
    v4u r; r.x = lo.x; r.y = lo.y; r.z = hi.x; r.w = hi.y; return __builtin_bit_cast(bf16x8v, r);
}
__device__ __forceinline__ unsigned lds_addr(LAS unsigned char* p) { return (unsigned)(size_t)p; }
constexpr int GL_BC = 0;
constexpr int GL_TOT = 65536;
constexpr int GL_V = 71680;
constexpr int GL_A = 105472;
constexpr int GL_STG = 105472;
constexpr int GL_RED = 124928;
constexpr int GL_QK_PITCH = 272, GL_V_PITCH = 528, GL_A_PITCH = 144;
static_assert(GL_STG + 25600 <= RING_BYTES && GL_V + 64 * GL_V_PITCH <= GL_A && GL_TOT + 4096 + 1024 <= GL_V && 4 * 64 * GL_QK_PITCH <= GL_V, "GLA LDS map");

__device__ __forceinline__ void gla_decays(Frame& F, unsigned char* ws, const float* wgf, const float* bgf, const float* wgb, const float* bgb, int row0, int h, int d0, int d1) {
    LAS float* lr = (LAS float*)(F.lds + GL_STG); LAS float* wg = lr + 64 * 32; LAS float* bg = wg + 2 * 16 * 128;
    LAS float* bc = (LAS float*)(F.lds + GL_BC); LAS float* tot = (LAS float*)(F.lds + GL_TOT);
    { const int t = F.tid >> 3, o4 = (F.tid & 7) * 4; *(LAS f32x4*)(lr + t * 32 + o4) = *(const GAS f32x4*)(((float*)(ws + WS_LR)) + (size_t)(row0 + t) * 32 + o4); }
    for (int i = F.tid; i < 1024; i += NTHR) { const int dir = i >> 9, o = (i >> 5) & 15, d4 = (i & 31) * 4; *(LAS f32x4*)(wg + (dir * 16 + o) * 128 + d4) = *(const GAS f32x4*)((dir ? wgb : wgf) + o * 512 + h * 128 + d4); }
    if (F.tid < 64) { const int dir = F.tid >> 5, d4 = (F.tid & 31) * 4; *(LAS f32x4*)(bg + dir * 128 + d4) = *(const GAS f32x4*)((dir ? bgb : bgf) + h * 128 + d4); }
    __syncthreads();
    { const int t = F.tid >> 3, dg = (F.tid & 7) * 16;
      for (int dir = d0; dir < d1; ++dir) {
          f32x4 z[4];
#pragma unroll
          for (int j = 0; j < 4; ++j) z[j] = *(LAS f32x4*)(bg + dir * 128 + dg + 4 * j);
#pragma unroll
          for (int o = 0; o < 16; ++o) { const float l = lr[t * 32 + dir * 16 + o];
#pragma unroll
              for (int j = 0; j < 4; ++j) z[j] += l * *(LAS f32x4*)(wg + (dir * 16 + o) * 128 + dg + 4 * j); }
#pragma unroll
          for (int j = 0; j < 4; ++j) { f32x4 g; g[0] = log_sigmoid16(z[j][0]); g[1] = log_sigmoid16(z[j][1]); g[2] = log_sigmoid16(z[j][2]); g[3] = log_sigmoid16(z[j][3]); *(LAS f32x4*)(bc + dir * 8192 + t * 128 + dg + 4 * j) = g; } } }
    __syncthreads();
    { const int d = F.tid & 127, seg = F.tid >> 7;
      for (int dir = d0; dir < d1; ++dir) { float a = 0.f;
#pragma unroll
          for (int i = 0; i < 16; ++i) { const int s = seg * 16 + i, t = dir ? 63 - s : s; a += bc[dir * 8192 + t * 128 + d]; bc[dir * 8192 + t * 128 + d] = a; }
          tot[(dir * 4 + seg) * 128 + d] = a; } }
    __syncthreads();
    { const int d = F.tid & 127, seg = F.tid >> 7;
      for (int dir = d0; dir < d1; ++dir) { float pre = 0.f, all = 0.f;
#pragma unroll
          for (int s2 = 0; s2 < 4; ++s2) { const float v = tot[(dir * 4 + s2) * 128 + d]; all += v; if (s2 < seg) pre += v; }
          if (seg == 0) tot[1024 + dir * 128 + d] = all;
          if (seg > 0) {
#pragma unroll
              for (int i = 0; i < 16; ++i) { const int s = seg * 16 + i, t = dir ? 63 - s : s; bc[dir * 8192 + t * 128 + d] += pre; } } } }
    __syncthreads();
}
__device__ __forceinline__ void gla_stage_v(Frame& F, const bf16* U, int row0, int h) {
#pragma unroll
    for (int i = 0; i < 4; ++i) { const int p = F.tid + NTHR * i, t = p >> 5, e8 = (p & 31) * 8;
        *(LAS v4u*)(F.lds + GL_V + t * GL_V_PITCH + e8 * 2) = *(const GAS v4u*)(U + (size_t)(row0 + t) * NU + U_GV + h * 256 + e8); }
}
__device__ __forceinline__ void gla_g1(Frame& F, int L) {
    unsigned char* const ws = PWS(); const bf16* U = (const bf16*)(ws + WS_U);
    const float* wgf = PIN(8) + (size_t)L * 16 * 512; const float* bgf = PIN(9) + L * 512; const float* wgb = PIN(10) + (size_t)L * 16 * 512; const float* bgb = PIN(11) + L * 512;
    const int g = F.lane >> 4, q4 = (F.lane & 15) >> 2, p = F.lane & 3, l15 = F.lane & 15;
    for (int task = F.vcu; task < 16 * GLA_NCH; task += F.G) {
        const int cn = task % GLA_NCH, ch = task / GLA_NCH, h = ch & 3, dir = (ch >> 2) & 1, b = ch >> 3;
        const int row0 = gla_chunk_row0(b, cn), n = gla_scan_idx(cn, dir);
        __syncthreads();
        gla_stage_v(F, U, row0, h);
        v4u kp[2];
#pragma unroll
        for (int i = 0; i < 2; ++i) { const int pc = F.tid + NTHR * i, t = pc >> 4, d8 = (pc & 15) * 8; kp[i] = *(const GAS v4u*)(U + (size_t)(row0 + t) * NU + U_GK + h * 128 + d8); }
        gla_decays(F, ws, wgf, bgf, wgb, bgb, row0, h, dir, dir + 1);
        LAS float* bc = (LAS float*)(F.lds + GL_BC) + dir * 8192; LAS float* bl = (LAS float*)(F.lds + GL_TOT) + 1024 + dir * 128;
        if (F.tid < 128) GLA_DEC(ws)[((size_t)ch * GLA_NCH + n) * 128 + F.tid] = __expf(bl[F.tid]);
        LAS unsigned char* ke = F.lds + GL_BC + (dir ? 0 : 32768);
#pragma unroll
        for (int i = 0; i < 2; ++i) { const int pc = F.tid + NTHR * i, t = pc >> 4, d8 = (pc & 15) * 8;
            const f32x4 b0 = *(LAS f32x4*)(bc + t * 128 + d8), b1 = *(LAS f32x4*)(bc + t * 128 + d8 + 4), l0 = *(LAS f32x4*)(bl + d8), l1 = *(LAS f32x4*)(bl + d8 + 4);
            v4u o; o.x = pk2(bflo(kp[i].x) * __expf(l0[0] - b0[0]), bfhi(kp[i].x) * __expf(l0[1] - b0[1])); o.y = pk2(bflo(kp[i].y) * __expf(l0[2] - b0[2]), bfhi(kp[i].y) * __expf(l0[3] - b0[3]));
            o.z = pk2(bflo(kp[i].z) * __expf(l1[0] - b1[0]), bfhi(kp[i].z) * __expf(l1[1] - b1[1])); o.w = pk2(bflo(kp[i].w) * __expf(l1[2] - b1[2]), bfhi(kp[i].w) * __expf(l1[3] - b1[3]));
            *(LAS v4u*)(ke + t * GL_QK_PITCH + d8 * 2) = o; }
        __syncthreads();
        f32x4 acc[8][2];
#pragma unroll
        for (int mt = 0; mt < 8; ++mt) { acc[mt][0] = (f32x4){0.f, 0.f, 0.f, 0.f}; acc[mt][1] = (f32x4){0.f, 0.f, 0.f, 0.f}; }
        const unsigned ke_a = lds_addr(ke) + GL_QK_PITCH * (8 * g + q4) + 8 * p, v_a = lds_addr(F.lds + GL_V) + GL_V_PITCH * (8 * g + q4) + 8 * p + 2 * (32 * F.wave);
#pragma unroll
        for (int ks = 0; ks < 2; ++ks) {
            bf16x8v bv[2];
#pragma unroll
            for (int nt = 0; nt < 2; ++nt) bv[nt] = tr_frag(v_a + GL_V_PITCH * 32 * ks + 32 * nt, GL_V_PITCH * 4);
#pragma unroll
            for (int mt = 0; mt < 8; ++mt) { const bf16x8v av = tr_frag(ke_a + GL_QK_PITCH * 32 * ks + 32 * mt, GL_QK_PITCH * 4);
                acc[mt][0] = __builtin_amdgcn_mfma_f32_16x16x32_bf16(av, bv[0], acc[mt][0], 0, 0, 0); acc[mt][1] = __builtin_amdgcn_mfma_f32_16x16x32_bf16(av, bv[1], acc[mt][1], 0, 0, 0); } }
        bf16* dst = GLA_DST(ws) + ((size_t)ch * GLA_NCH + n) * 256 * 128;
#pragma unroll
        for (int mt = 0; mt < 8; ++mt)
#pragma unroll
            for (int nt = 0; nt < 2; ++nt) { const int e = 32 * F.wave + 16 * nt + l15, d = 16 * mt + 4 * g; v2u w; w.x = pk2(acc[mt][nt][0], acc[mt][nt][1]); w.y = pk2(acc[mt][nt][2], acc[mt][nt][3]);
                *(GAS v2u*)(dst + (size_t)e * 128 + d) = w; }
    }
}
__device__ __forceinline__ void gla_g2(Frame& F) {
    unsigned char* const ws = PWS();
    const int NT = F.G * NTHR;
    for (int idx = F.bx * NTHR + F.tid; idx < 16 * 256 * 32; idx += NT) {
        const int ch = idx >> 13, e = (idx >> 5) & 255, d4 = (idx & 31) * 4;
        bf16* p = GLA_DST(ws) + (size_t)ch * GLA_NCH * 32768 + (size_t)e * 128 + d4; const float* dc = GLA_DEC(ws) + (size_t)ch * GLA_NCH * 128 + d4;
        f32x4 S = {0.f, 0.f, 0.f, 0.f};
#pragma unroll 4
        for (int n = 0; n < GLA_NCH; ++n) { const v2u x = *(const GAS v2u*)(p + (size_t)n * 32768); const f32x4 a = *(const GAS f32x4*)(dc + n * 128);
            v2u w; w.x = pk2(S[0], S[1]); w.y = pk2(S[2], S[3]); *(GAS v2u*)(p + (size_t)n * 32768) = w;
            S[0] = a[0] * S[0] + bflo(x.x); S[1] = a[1] * S[1] + bfhi(x.x); S[2] = a[2] * S[2] + bflo(x.y); S[3] = a[3] * S[3] + bfhi(x.y); }
    }
}
__device__ __forceinline__ void gla_g3(Frame& F, int L) {
    unsigned char* const ws = PWS(); const bf16* U = (const bf16*)(ws + WS_U);
    const float* wgf = PIN(8) + (size_t)L * 16 * 512; const float* bgf = PIN(9) + L * 512; const float* wgb = PIN(10) + (size_t)L * 16 * 512; const float* bgb = PIN(11) + L * 512;
    const float* ng = PIN(12) + L * 256;
    const int g = F.lane >> 4, q4 = (F.lane & 15) >> 2, p = F.lane & 3, l15 = F.lane & 15;
    for (int task = F.vcu; task < 8 * GLA_NCH; task += F.G) {
        const int cn = task % GLA_NCH, bh = task / GLA_NCH, h = bh & 3, b = bh >> 2;
        const int row0 = gla_chunk_row0(b, cn);
        __syncthreads();
        gla_stage_v(F, U, row0, h);
        v4u kp[2], qp[2];
#pragma unroll
        for (int i = 0; i < 2; ++i) { const int pc = F.tid + NTHR * i, t = pc >> 4, d8 = (pc & 15) * 8; const bf16* up = U + (size_t)(row0 + t) * NU + h * 128 + d8; kp[i] = *(const GAS v4u*)(up + U_GK); qp[i] = *(const GAS v4u*)(up + U_GQ); }
        gla_decays(F, ws, wgf, bgf, wgb, bgb, row0, h, 0, 2);
        v4u im[2][4];
        { LAS float* bc = (LAS float*)(F.lds + GL_BC);
#pragma unroll
          for (int i = 0; i < 2; ++i) { const int pc = F.tid + NTHR * i, t = pc >> 4, d8 = (pc & 15) * 8;
#pragma unroll
              for (int dir = 0; dir < 2; ++dir) { const f32x4 b0 = *(LAS f32x4*)(bc + dir * 8192 + t * 128 + d8), b1 = *(LAS f32x4*)(bc + dir * 8192 + t * 128 + d8 + 4);
                  float ep[8], en[8];
#pragma unroll
                  for (int j = 0; j < 4; ++j) { ep[j] = __expf(b0[j]); ep[4 + j] = __expf(b1[j]); en[j] = __expf(-b0[j]); en[4 + j] = __expf(-b1[j]); }
                  v4u qo, ko;
                  qo.x = pk2(bflo(qp[i].x) * ep[0], bfhi(qp[i].x) * ep[1]); qo.y = pk2(bflo(qp[i].y) * ep[2], bfhi(qp[i].y) * ep[3]); qo.z = pk2(bflo(qp[i].z) * ep[4], bfhi(qp[i].z) * ep[5]); qo.w = pk2(bflo(qp[i].w) * ep[6], bfhi(qp[i].w) * ep[7]);
                  ko.x = pk2(bflo(kp[i].x) * en[0], bfhi(kp[i].x) * en[1]); ko.y = pk2(bflo(kp[i].y) * en[2], bfhi(kp[i].y) * en[3]); ko.z = pk2(bflo(kp[i].z) * en[4], bfhi(kp[i].z) * en[5]); ko.w = pk2(bflo(kp[i].w) * en[6], bfhi(kp[i].w) * en[7]);
                  im[i][2 * dir] = qo; im[i][2 * dir + 1] = ko; } } }
        __syncthreads();
#pragma unroll
        for (int i = 0; i < 2; ++i) { const int pc = F.tid + NTHR * i, t = pc >> 4, d8 = (pc & 15) * 8;
#pragma unroll
            for (int k = 0; k < 4; ++k) *(LAS v4u*)(F.lds + GL_BC + k * 64 * GL_QK_PITCH + t * GL_QK_PITCH + d8 * 2) = im[i][k]; }
        __syncthreads();
        { const int dir = F.wave >> 2, nt = F.wave & 3;
          LAS unsigned char* qi = F.lds + GL_BC + (2 * dir) * 64 * GL_QK_PITCH; LAS unsigned char* ki = qi + 64 * GL_QK_PITCH;
          bf16x8v qf[4];
#pragma unroll
          for (int ks = 0; ks < 4; ++ks) qf[ks] = *(LAS bf16x8v*)(qi + (16 * nt + l15) * GL_QK_PITCH + (32 * ks + 8 * g) * 2);
#pragma unroll
          for (int mt = 0; mt < 4; ++mt) { f32x4 a = {0.f, 0.f, 0.f, 0.f};
              const bool live = dir ? (mt >= nt) : (mt <= nt);
              if (live) {
#pragma unroll
                  for (int ks = 0; ks < 4; ++ks) { const bf16x8v kf = *(LAS bf16x8v*)(ki + (16 * mt + l15) * GL_QK_PITCH + (32 * ks + 8 * g) * 2); a = __builtin_amdgcn_mfma_f32_16x16x32_bf16(kf, qf[ks], a, 0, 0, 0); } }
              const int tau = 16 * nt + l15, s0 = 16 * mt + 4 * g;
#pragma unroll
              for (int i = 0; i < 4; ++i) { const bool keep = dir ? (s0 + i >= tau) : (s0 + i <= tau); if (!keep) a[i] = 0.f; }
              v2u w; w.x = pk2(a[0], a[1]); w.y = pk2(a[2], a[3]);
              *(LAS v2u*)(F.lds + GL_A + dir * 64 * GL_A_PITCH + tau * GL_A_PITCH + s0 * 2) = w; } }
        __syncthreads();
        f32x4 acc[2][4];
#pragma unroll
        for (int mt = 0; mt < 2; ++mt)
#pragma unroll
            for (int nt = 0; nt < 4; ++nt) acc[mt][nt] = (f32x4){0.f, 0.f, 0.f, 0.f};
        { const unsigned v_a = lds_addr(F.lds + GL_V) + GL_V_PITCH * (8 * g + q4) + 8 * p + 2 * (32 * F.wave);
#pragma unroll
          for (int ks = 0; ks < 2; ++ks) { bf16x8v vf[2];
#pragma unroll
              for (int mt = 0; mt < 2; ++mt) vf[mt] = tr_frag(v_a + GL_V_PITCH * 32 * ks + 32 * mt, GL_V_PITCH * 4);
#pragma unroll
              for (int dir = 0; dir < 2; ++dir)
#pragma unroll
                  for (int nt = 0; nt < 4; ++nt) { const bf16x8v af = *(LAS bf16x8v*)(F.lds + GL_A + dir * 64 * GL_A_PITCH + (16 * nt + l15) * GL_A_PITCH + (32 * ks + 8 * g) * 2);
                      acc[0][nt] = __builtin_amdgcn_mfma_f32_16x16x32_bf16(vf[0], af, acc[0][nt], 0, 0, 0); acc[1][nt] = __builtin_amdgcn_mfma_f32_16x16x32_bf16(vf[1], af, acc[1][nt], 0, 0, 0); } } }
#pragma unroll
        for (int dir = 0; dir < 2; ++dir) { const int ch = (b * 2 + dir) * 4 + h, n = gla_scan_idx(cn, dir);
            const bf16* st = GLA_DST(ws) + ((size_t)ch * GLA_NCH + n) * 32768; LAS unsigned char* qi = F.lds + GL_BC + (2 * dir) * 64 * GL_QK_PITCH;
#pragma unroll
            for (int ks = 0; ks < 4; ++ks) { bf16x8v sf[2];
#pragma unroll
                for (int mt = 0; mt < 2; ++mt) sf[mt] = __builtin_bit_cast(bf16x8v, *(const GAS v4u*)(st + (size_t)(32 * F.wave + 16 * mt + l15) * 128 + 32 * ks + 8 * g));
#pragma unroll
                for (int nt = 0; nt < 4; ++nt) { const bf16x8v qf = *(LAS bf16x8v*)(qi + (16 * nt + l15) * GL_QK_PITCH + (32 * ks + 8 * g) * 2);
                    acc[0][nt] = __builtin_amdgcn_mfma_f32_16x16x32_bf16(sf[0], qf, acc[0][nt], 0, 0, 0); acc[1][nt] = __builtin_amdgcn_mfma_f32_16x16x32_bf16(sf[1], qf, acc[1][nt], 0, 0, 0); } } }
        LAS float* red = (LAS float*)(F.lds + GL_RED);
#pragma unroll
        for (int nt = 0; nt < 4; ++nt) { float s = 0.f;
#pragma unroll
            for (int mt = 0; mt < 2; ++mt)
#pragma unroll
                for (int i = 0; i < 4; ++i) s += acc[mt][nt][i] * acc[mt][nt][i];
            s += __shfl_xor(s, 16); s += __shfl_xor(s, 32);
            if (g == 0) red[F.wave * 64 + 16 * nt + l15] = s; }
        __syncthreads();
#pragma unroll
        for (int nt = 0; nt < 4; ++nt) { const int tau = 16 * nt + l15; float s = 0.f;
#pragma unroll
            for (int w = 0; w < 8; ++w) s += red[w * 64 + tau];
            const float rs = 1.0f / sqrtf(s * (1.0f / 256.0f) + LN_EPS); const size_t row = (size_t)(row0 + tau);
#pragma unroll
            for (int mt = 0; mt < 2; ++mt) { const int e = 32 * F.wave + 16 * mt + 4 * g;
                const v2u rw = *(const GAS v2u*)(U + row * NU + U_GR + h * 256 + e); const f32x4 g4 = *(const f32x4*)(ng + e);
                const float r0 = bflo(rw.x), r1 = bfhi(rw.x), r2 = bflo(rw.y), r3 = bfhi(rw.y);
                v2u w; w.x = pk2(acc[mt][nt][0] * rs * g4[0] * (r0 / (1.0f + __expf(-r0))), acc[mt][nt][1] * rs * g4[1] * (r1 / (1.0f + __expf(-r1))));
                w.y = pk2(acc[mt][nt][2] * rs * g4[2] * (r2 / (1.0f + __expf(-r2))), acc[mt][nt][3] * rs * g4[3] * (r3 / (1.0f + __expf(-r3))));
                *(GAS v2u*)(((bf16*)(ws + WS_Y + (size_t)MROWS * 1024 * 2)) + row * 1024 + h * 256 + e) = w; } }
    }
}

constexpr int NA_VPITCH = 272, NA_VIMG = 32 * NA_VPITCH;
__device__ __forceinline__ void na_mfma(Frame& F, int L) {
    unsigned char* const ws = PWS(); const bf16* U = (const bf16*)(ws + WS_U); bf16* YN = (bf16*)(ws + WS_Y + (size_t)MROWS * 2048 * 2);
    const float* rpbL = PIN(13) + (size_t)L * 8 * 15 * 31;
    const int g = F.lane >> 4, q4 = (F.lane & 15) >> 2, p = F.lane & 3, l15 = F.lane & 15;
    LAS unsigned char* vimg = F.lds + RING_OFF + F.wave * NA_VIMG;
    const unsigned v_a = lds_addr(vimg) + NA_VPITCH * (4 * g + q4) + 8 * p;
    const int gw = F.vcu * NWAVES + F.wave, NGW = F.G * NWAVES;
    const int T_lat = 2 * 8 * 64 * 4, T_all = T_lat + (L == 0 ? 2 * 8 * 16 : 0);
    for (int task = gw; task < T_all; task += NGW) {
        const bool isctx = task >= T_lat;
        int b, h, r = 0, c0 = 0, qrow0;
        if (!isctx) { const int ct = task & 3; r = (task >> 2) & 63; h = (task >> 8) & 7; b = task >> 11; c0 = 16 * ct; qrow0 = b * SEQ + r * 64 + c0; }
        else { const int tt = task - T_lat, qt = tt & 15; h = (tt >> 4) & 7; b = tt >> 7; qrow0 = NLAT + CTXL * b + 16 * qt; }
        const int rs = min(max(r - 4, 0), 56), kc0 = min(max(c0 - 8, 0), 32);
        const int ctx0 = NLAT + CTXL * b;
        const int kb_lo = isctx ? 8 : 0;
        bf16x8v qf[4];
#pragma unroll
        for (int ks = 0; ks < 4; ++ks) qf[ks] = __builtin_bit_cast(bf16x8v, *(const GAS v4u*)(U + (size_t)(qrow0 + l15) * NU + U_NQ + h * 128 + 32 * ks + 8 * g));
        f32x4 s[32];
#pragma unroll
        for (int kb = 0; kb < 16; ++kb) {
            if (kb >= kb_lo) {
                const int tok0 = kb < 8 ? b * SEQ + (rs + kb) * 64 + kc0 : ctx0 + 32 * (kb - 8);
#pragma unroll
                for (int hf = 0; hf < 2; ++hf) { const bf16* kp = U + (size_t)(tok0 + 16 * hf + l15) * NU + U_NK + h * 128 + 8 * g; f32x4 a = {0.f, 0.f, 0.f, 0.f};
#pragma unroll
                    for (int ks = 0; ks < 4; ++ks) { const bf16x8v kf = __builtin_bit_cast(bf16x8v, *(const GAS v4u*)(kp + 32 * ks)); a = __builtin_amdgcn_mfma_f32_16x16x32_bf16(kf, qf[ks], a, 0, 0, 0); }
                    s[2 * kb + hf] = a; }
                asm volatile("" ::: "memory");
            } else { s[2 * kb] = (f32x4){-INFINITY, -INFINITY, -INFINITY, -INFINITY}; s[2 * kb + 1] = s[2 * kb]; }
        }
        if (!isctx) {
            const int qc = c0 + l15, cs = min(max(qc - 8, 0), 48); const float* rp = rpbL + (size_t)h * 15 * 31;
#pragma unroll
            for (int kt = 0; kt < 16; ++kt) { const int kr = rs + (kt >> 1);
#pragma unroll
                for (int i = 0; i < 4; ++i) { const int kc = kc0 + (kt & 1) * 16 + 4 * g + i; const bool ok = kc >= cs && kc <= cs + 15;
                    const float bias = ok ? rp[(kr - r + 7) * 31 + (kc - qc + 15)] : 0.f; s[kt][i] = ok ? s[kt][i] + bias : -INFINITY; } }
        }
        float mx = -INFINITY;
#pragma unroll
        for (int kt = 0; kt < 32; ++kt) mx = fmaxf(mx, fmaxf(fmaxf(s[kt][0], s[kt][1]), fmaxf(s[kt][2], s[kt][3])));
        mx = fmaxf(mx, __shfl_xor(mx, 16)); mx = fmaxf(mx, __shfl_xor(mx, 32));
        float sum = 0.f;
#pragma unroll
        for (int kt = 0; kt < 32; ++kt) {
#pragma unroll
            for (int i = 0; i < 4; ++i) { const float e = __expf(s[kt][i] - mx); s[kt][i] = e; sum += e; } }
        sum += __shfl_xor(sum, 16); sum += __shfl_xor(sum, 32);
        const float inv = 1.0f / sum;
        f32x4 o[8];
#pragma unroll
        for (int mt = 0; mt < 8; ++mt) o[mt] = (f32x4){0.f, 0.f, 0.f, 0.f};
#pragma unroll
        for (int kb = 0; kb < 16; ++kb) {
            if (kb >= kb_lo) {
                const int tok0 = kb < 8 ? b * SEQ + (rs + kb) * 64 + kc0 : ctx0 + 32 * (kb - 8);
#pragma unroll
                for (int hb = 0; hb < 2; ++hb) { v4u vv[4];
#pragma unroll
                    for (int i = 0; i < 4; ++i) { const int id = F.lane + 64 * (4 * hb + i); vv[i] = *(const GAS v4u*)(U + (size_t)(tok0 + (id >> 4)) * NU + U_NV + h * 128 + (id & 15) * 8); }
#pragma unroll
                    for (int i = 0; i < 4; ++i) { const int id = F.lane + 64 * (4 * hb + i); *(LAS v4u*)(vimg + (id >> 4) * NA_VPITCH + (id & 15) * 16) = vv[i]; }
                    asm volatile("" ::: "memory"); }
                v4u pw; pw.x = pk2(s[2 * kb][0], s[2 * kb][1]); pw.y = pk2(s[2 * kb][2], s[2 * kb][3]); pw.z = pk2(s[2 * kb + 1][0], s[2 * kb + 1][1]); pw.w = pk2(s[2 * kb + 1][2], s[2 * kb + 1][3]);
                const bf16x8v pf = __builtin_bit_cast(bf16x8v, pw);
                asm volatile("s_waitcnt lgkmcnt(0)" ::: "memory");
#pragma unroll
                for (int mt = 0; mt < 8; ++mt) { const bf16x8v vf = tr_frag(v_a + 32 * mt, NA_VPITCH * 16); o[mt] = __builtin_amdgcn_mfma_f32_16x16x32_bf16(vf, pf, o[mt], 0, 0, 0); }
            }
        }
        bf16* yp = YN + (size_t)(qrow0 + l15) * 1024 + h * 128 + 4 * g;
#pragma unroll
        for (int mt = 0; mt < 8; ++mt) { v2u w; w.x = pk2(o[mt][0] * inv, o[mt][1] * inv); w.y = pk2(o[mt][2] * inv, o[mt][3] * inv); *(GAS v2u*)(yp + 16 * mt) = w; }
    }
}
#ifndef MK_ONE_LAUNCH
#define MK_ONE_LAUNCH 0
#endif
constexpr int PH_PER_LAYER = 11, NPH = 2 + DEPTH * PH_PER_LAYER;
enum { PL_WIN = 0, PL_MIXA, PL_MIXB, PL_MIXC, PL_BR, PL_WOUT, PL_LN1, PL_GATHER, PL_FFN1, PL_FFN2, PL_LN2 };
__device__ __forceinline__ bool in_range(int lo, int hi, int k) { asm volatile("" : "+s"(lo), "+s"(hi)); return lo <= k && k < hi; }
#ifndef PHMASK
#define PHMASK 0xFFFFFFFFu
#endif
#define IN(k) in_range(lo, hi, (k))
#define EN(bit) ((PHMASK >> (bit)) & 1u)
#ifndef DUPMASK
#define DUPMASK 0u
#endif
#define DUP(bit) ((DUPMASK >> (bit)) & 1u)
#define SEAM(k) do { if (IN((k) + 1)) GRID_BAR(); } while (0)
#if MK_ONE_LAUNCH
#define GRID_BAR() xcd_barrier(bar)
#else
#define GRID_BAR() do { if (F.tid == 0) __hip_atomic_store((gu32*)(PWS() + WS_CTL) + CW_TMO, 0xBADBA0u, RLX_AGENT); } while (0)
#endif
template <int L> __device__ __forceinline__ void layer_phases(const Args& A, LAS unsigned char* const ldsb, const XcdBarrier& bar, const int lo, const int hi) {
    LAS unsigned char* const ring = ldsb + RING_OFF;
        const int pb = 2 + PH_PER_LAYER * L, Mr = (L == 0) ? MROWS : NLAT;
        if (EN(2) && IN(pb + PL_WIN)) { Frame F = mkframe(ldsb, A.grid);
            unsigned char* const ws = PWS();
            lr_tiles(F, L);
            pg8::Gemm g{((bf16*)(ws + WS_H)), w_in_t(ws, L), D, D}; pg8::StaticOrder S; S.init(MROWS, NU, F.G, F.bx);
            pg8::EpiU E{((bf16*)(ws + WS_U)), NU};
            pg8::gemm_phase<pg8::EpiU, pg8::StaticOrder, true, true>(ring, g, S, E);
            SEAM(pb + PL_WIN);
        }
        if (EN(3) && IN(pb + PL_MIXA)) { Frame F = mkframe(ldsb, A.grid); gla_g1(F, L); mix_prep(F, L); if (DUP(3)) { __syncthreads(); gla_g1(F, L); mix_prep(F, L); } SEAM(pb + PL_MIXA); }
        if (EN(4) && IN(pb + PL_MIXB)) { Frame F = mkframe(ldsb, A.grid); gla_g2(F); na_mfma(F, L); if (DUP(4)) { __syncthreads(); na_mfma(F, L); } if (DUP(13)) { VM_WAIT(); __syncthreads(); gla_g2(F); } SEAM(pb + PL_MIXB); }
        if (EN(5) && IN(pb + PL_MIXC)) { Frame F = mkframe(ldsb, A.grid); gla_g3(F, L); if (DUP(5)) { __syncthreads(); gla_g3(F, L); } SEAM(pb + PL_MIXC); }
        if (EN(6) && IN(pb + PL_BR)) { Frame F = mkframe(ldsb, A.grid);
            unsigned char* const ws = PWS(); const float* const gate_b = PIN(17) + (size_t)L * 3 * D;
            pg8::Gemm g{((bf16*)(ws + WS_Y)), w_br_t(ws, L, 0), 1024, 1024}; pg8::BranchOrder S; S.init(Mr, D, F.G, F.bx, MROWS / 256, D / 256);
            pg8::EpiGate E{((bf16*)(ws + WS_U)) + U_GATE, NU, gate_b, ((float*)(ws + WS_Z)), ((bf16*)(ws + WS_ZB))};
            pg8::gemm_phase<pg8::EpiGate, pg8::BranchOrder, true, true>(ring, g, S, E);
            SEAM(pb + PL_BR);
        }
        if (EN(7) && IN(pb + PL_WOUT)) { Frame F = mkframe(ldsb, A.grid);
            unsigned char* const ws = PWS(); const float* const modL = ((float*)(ws + WS_MOD)) + (size_t)L * 3 * 12288; const float* const xin = PIN(0); const float* const cin = PIN(2);
            { pg8::Gemm g{((bf16*)(ws + WS_ZB)), w_out_t(ws, L), D, D}; pg8::StaticOrder S; S.init(NLAT, D, F.G, F.bx);
              pg8::EpiRes E{L == 0 ? xin : ((float*)(ws + WS_XL)), cin, modL + 2 * D, 12288, ((float*)(ws + WS_PRE)), ALPHA};
              pg8::gemm_phase<pg8::EpiRes, pg8::StaticOrder, true, true>(ring, g, S, E); }
            if (L == 0) {
              pg8::Gemm g{((bf16*)(ws + WS_ZB)), w_out_t(ws, L), D, 256}; pg8::SplitOrder S; S.init(NLAT / 256, D / 256, 8, 256, F.G, F.bx, 0);
              pg8::EpiPartial E{((float*)(ws + WS_PART)), NLAT / 256};
              pg8::gemm_phase<pg8::EpiPartial, pg8::SplitOrder, true, true>(ring, g, S, E); }
            SEAM(pb + PL_WOUT);
        }
        if (EN(8) && IN(pb + PL_LN1)) { Frame F = mkframe(ldsb, A.grid); ln1_phase(F, L, Mr); SEAM(pb + PL_LN1); }
        if (L == 0) {
            if (EN(10) && IN(pb + PL_FFN1)) { Frame F = mkframe(ldsb, A.grid);
                unsigned char* const ws = PWS();
                pg8::Gemm g{((bf16*)(ws + WS_H)), w_gu_t(ws, -1), D, D}; pg8::StaticOrder S; S.init(MROWS, NGU, F.G, F.bx);
                pg8::EpiSwiGLU E{((bf16*)(ws + WS_U)), FF};
                pg8::gemm_phase<pg8::EpiSwiGLU, pg8::StaticOrder, true, true>(ring, g, S, E);
                SEAM(pb + PL_FFN1);
            }
            if (EN(11) && IN(pb + PL_FFN2)) { Frame F = mkframe(ldsb, A.grid);
                unsigned char* const ws = PWS(); const float* const modL = ((float*)(ws + WS_MOD)) + (size_t)L * 3 * 12288;
                { pg8::Gemm g{((bf16*)(ws + WS_U)), w_d_t(ws, -1), FF, FF}; pg8::StaticOrder S; S.init(NLAT, D, F.G, F.bx);
                  pg8::EpiRes E{((float*)(ws + WS_XL)), ((float*)(ws + WS_XL)) + (size_t)NLAT * D, modL + 5 * D, 12288, ((float*)(ws + WS_PRE)), ALPHA};
                  pg8::gemm_phase<pg8::EpiRes, pg8::StaticOrder, true, true>(ring, g, S, E); }
                { pg8::Gemm g{((bf16*)(ws + WS_U)), w_d_t(ws, -1), FF, 512}; pg8::SplitOrder S; S.init(NLAT / 256, D / 256, 11, 512, F.G, F.bx, 0);
                  pg8::EpiPartial E{((float*)(ws + WS_PART)), NLAT / 256};
                  pg8::gemm_phase<pg8::EpiPartial, pg8::SplitOrder, true, true>(ring, g, S, E); }
                SEAM(pb + PL_FFN2);
            }
            if (EN(12) && IN(pb + PL_LN2)) { Frame F = mkframe(ldsb, A.grid); ln2_dense(F, L); if (DUP(12)) { __syncthreads(); ln2_dense(F, L); } SEAM(pb + PL_LN2); }
        } else {
            if (EN(9) && IN(pb + PL_GATHER)) { Frame F = mkframe(ldsb, A.grid); moe_gather(F); SEAM(pb + PL_GATHER); }
            if (EN(10) && IN(pb + PL_FFN1)) { Frame F = mkframe(ldsb, A.grid);
                unsigned char* const ws = PWS();
                unsigned cnt[8]; int pp[9]; moe_prefix(ws, cnt, pp);
                pg8::Gemm g{((bf16*)(ws + WS_GLA)), w_gu_t(ws, 0), D, D}; pg8::MoeOrder S; S.init(cnt, NGU / 256, F.G, F.bx);
                pg8::EpiSwiGLU E{((bf16*)(ws + WS_U)), FF};
                pg8::gemm_phase<pg8::EpiSwiGLU, pg8::MoeOrder, true, true>(ring, g, S, E);
                SEAM(pb + PL_FFN1);
            }
            if (EN(11) && IN(pb + PL_FFN2)) { Frame F = mkframe(ldsb, A.grid);
                unsigned char* const ws = PWS(); const float* const modL = ((float*)(ws + WS_MOD)) + (size_t)L * 3 * 12288;
                unsigned cnt[8]; int pp[9]; moe_prefix(ws, cnt, pp);
                pg8::Gemm g{((bf16*)(ws + WS_U)), w_d_t(ws, 0), FF, FF}; pg8::MoeOrder S; S.init(cnt, D / 256, F.G, F.bx);
                pg8::EpiF32Plain E{((float*)(ws + WS_Z)), D};
                pg8::gemm_phase<pg8::EpiF32Plain, pg8::MoeOrder, true, true>(ring, g, S, E);
                SEAM(pb + PL_FFN2);
            }
            if (EN(12) && IN(pb + PL_LN2)) { Frame F = mkframe(ldsb, A.grid); ln2_moe(F, L); }
        }
    }
__global__ void __launch_bounds__(NTHR, 2) fwd_kernel(Args A) {
    __shared__ __attribute__((aligned(16))) unsigned char lds[LDS_BYTES];
    LAS unsigned char* const ldsb = (LAS unsigned char*)lds;
    { Frame F = mkframe(ldsb, A.grid);
    for (int u = F.tid; u < (LDS_BYTES - LDSCTL_OFF) / 4; u += NTHR) ((LAS unsigned*)(F.lds + LDSCTL_OFF))[u] = 0u;
    __syncthreads();
    if (F.tid < 32) { const unsigned long long p = F.tid < 30 ? (unsigned long long)A.in[F.tid] : (F.tid == 30 ? (unsigned long long)A.out : (unsigned long long)A.ws);
        ((LAS unsigned long long*)(F.lds + PTAB_OFF))[F.tid] = p; }
    __syncthreads(); }
#if MK_ONE_LAUNCH
    XcdBarrier bar; { Frame F = mkframe(ldsb, A.grid); bar = xcd_barrier_post((unsigned*)(PWS() + WS_CTL) + CW_BAR, F.MISC + 8, (unsigned)A.grid); }
#else
    XcdBarrier bar; bar.bar = nullptr; bar.x = 0; bar.grid = 0; bar.st = nullptr;
#endif
    const int lo = A.ph_lo, hi = A.ph_hi;
    LAS unsigned char* const ring = ldsb + RING_OFF;

    if (EN(0) && IN(0)) { Frame F = mkframe(ldsb, A.grid); p0a_prologue(F); if (DUP(0)) { __syncthreads(); p0a_prologue(F); } SEAM(0); }
    if (EN(1) && IN(1)) { Frame F = mkframe(ldsb, A.grid); p0b_modulate(F); if (DUP(1)) { __syncthreads(); p0b_modulate(F); } SEAM(1); }
    layer_phases<0>(A, ldsb, bar, lo, hi);
    layer_phases<1>(A, ldsb, bar, lo, hi);
}

extern "C" void kernel_launch(void* const* d_in, const int* in_sizes, int n_in, void* d_out, int out_size, void* d_ws, size_t ws_size, hipStream_t stream) {
    static int grid = 0;
    if (grid == 0) {
        if (n_in != 30 || out_size != NLAT * D || ws_size < WS_END) { fprintf(stderr, "kernel_launch: unexpected shapes (n_in %d out %d ws %zu); nothing launched\n", n_in, out_size, ws_size); grid = -1; return; }
        int dev = 0, cus = 0, per_cu = 0;
        if (hipGetDevice(&dev) != hipSuccess || hipDeviceGetAttribute(&cus, hipDeviceAttributeMultiprocessorCount, dev) != hipSuccess) { grid = -1; return; }
        if (hipOccupancyMaxActiveBlocksPerMultiprocessor(&per_cu, (const void*)fwd_kernel, NTHR, 0) != hipSuccess || per_cu < 1) { fprintf(stderr, "kernel_launch: occupancy query says %d\n", per_cu); (void)hipGetLastError(); grid = -1; return; }
        grid = cus;
    }
    if (grid < 0) return;
    (void)hipMemsetAsync((char*)d_ws + WS_CTL, 0, CTL_ZERO_BYTES, stream);
    Args a{};
    for (int i = 0; i < 30; ++i) a.in[i] = (const float*)d_in[i];
    a.out = (float*)d_out; a.ws = (unsigned char*)d_ws; a.grid = grid;
#if MK_ONE_LAUNCH
    a.ph_lo = 0; a.ph_hi = NPH;
    hipLaunchKernelGGL(fwd_kernel, dim3(grid), dim3(NTHR), 0, stream, a);
#else
#ifndef NPH_RUN
#define NPH_RUN NPH
#endif
    for (int p = 0; p < NPH_RUN; ++p) {
        if (p == 2 + PL_GATHER) continue;
        a.ph_lo = p; a.ph_hi = p + 1;
        hipLaunchKernelGGL(fwd_kernel, dim3(grid), dim3(NTHR), 0, stream, a);
    }
#endif
}
```

```cpp
#define MK_ONE_LAUNCH 1
#include <hip/hip_runtime.h>
#include <cstdio>

namespace pg8 {
#define PG8_LAS __attribute__((address_space(3)))
typedef unsigned short bf16_t;
typedef short bf16x8 __attribute__((ext_vector_type(8)));
typedef float f32x4 __attribute__((ext_vector_type(4)));
typedef unsigned u32x4 __attribute__((ext_vector_type(4)));
typedef unsigned u32x2 __attribute__((ext_vector_type(2)));
typedef int i32x4 __attribute__((ext_vector_type(4)));
typedef int i32x8 __attribute__((ext_vector_type(8)));
constexpr int BM = 256, BK = 64, HALF = 128, HTB = HALF * BK * 2  , STAGE_BYTES = 8 * HTB, NXCD = 8, WGM = 8;

__host__ __device__ __forceinline__ int lds_byte(int r, int c) { const int st = (r >> 4) * 2 + (c >> 5), rr = r & 15, cc = c & 31, ob = rr * 64 + cc * 2; return st * 1024 + (ob ^ (((ob >> 9) & 1) << 5)); }
__host__ __device__ __forceinline__ void stage_rc(int b, int& R, int& C) { const int st = b / 1024, sb = b % 1024, swz = sb ^ (((sb >> 9) & 1) << 5); R = (st >> 1) * 16 + swz / 64; C = (st & 1) * 32 + (swz % 64) / 2; }
__host__ __device__ __forceinline__ int perm32(int rho) { const int n = rho >> 4, i = rho & 15; return 8 * (i >> 2) + 4 * n + (i & 3); }

struct Unit { int pm, pn, pa, pb, ko, aux; };
struct Gemm { const bf16_t* A; const bf16_t* Bt; int K, KT; };

__device__ __forceinline__ int xcd_remap(int wgid, int nwg) { const int q = nwg / NXCD, r = nwg % NXCD, xcd = wgid % NXCD, off = wgid / NXCD; return (xcd < r ? xcd * (q + 1) : r * (q + 1) + (xcd - r) * q) + off; }
struct StaticOrder {
    int nM, nN, nwg, G, c;
    __host__ __device__ void init(int M, int N, int G_, int c_) { nM = M / BM; nN = N / BM; nwg = nM * nN; G = G_; c = c_; }
    __device__ __forceinline__ bool next(int i, Unit& u) const {
        const long L = (long)i * G + c; if (L >= nwg) return false;
        const int wgid = xcd_remap((int)L, nwg);
        const int nig = WGM * nN, gid = wgid / nig, fm = gid * WGM, gsz = (nM - fm) < WGM ? (nM - fm) : WGM;
        u.pm = fm + ((wgid % nig) % gsz); u.pn = (wgid % nig) / gsz; u.pa = u.pm; u.pb = u.pn; u.ko = 0; u.aux = 0; return true;
    }
    __device__ __forceinline__ void a_ready(const Unit&) const {}
    __device__ __forceinline__ void done(const Unit&) const {}
};
struct MoeOrder {
    int nN, G, c, nunits; int pp[9];
    __device__ __forceinline__ void init(const unsigned* cnt, int nN_, int G_, int c_) { nN = nN_; G = G_; c = c_; pp[0] = 0;
#pragma unroll
        for (int e = 0; e < 8; ++e) pp[e + 1] = pp[e] + (int)((cnt[e] + 255u) >> 8);
        nunits = pp[8] * nN; }
    __device__ __forceinline__ bool next(int i, Unit& u) const {
        const long L = (long)i * G + c; if (L >= nunits) return false;
        const int wgid = xcd_remap((int)L, nunits);
        int e = 0, base = 0, npe = pp[1];
#pragma unroll
        for (int k = 1; k < 8; ++k) { if (wgid >= pp[k] * nN) { e = k; base = pp[k]; npe = pp[k + 1] - pp[k]; } }
        if (npe < 1) npe = 1;
        const int local = wgid - base * nN;
        u.pm = base + local % npe; u.pn = local / npe; u.pa = u.pm; u.pb = e * nN + u.pn; u.ko = 0; u.aux = 0; return true;
    }
    __device__ __forceinline__ void a_ready(const Unit&) const {}
    __device__ __forceinline__ void done(const Unit&) const {}
};

struct BranchOrder {
    StaticOrder S; int apanels, bpanels;
    __device__ __forceinline__ void init(int M, int N, int G_, int c_, int apan, int bpan) { S.init(M, N, G_, c_); apanels = apan; bpanels = bpan; }
    __device__ __forceinline__ bool next(int i, Unit& u) const { const int j = i / 3, b = i - 3 * j; if (!S.next(j, u)) return false; u.pa = b * apanels + u.pm; u.pb = b * bpanels + u.pn; u.aux = b; return true; }
    __device__ __forceinline__ void a_ready(const Unit&) const {}
    __device__ __forceinline__ void done(const Unit&) const {}
};
struct SplitOrder {
    int pm0, nN, nsplit, KT, G, c, rot;
    __device__ __forceinline__ void init(int pm0_, int nN_, int nsplit_, int KT_, int G_, int c_, int rot_) { pm0 = pm0_; nN = nN_; nsplit = nsplit_; KT = KT_; G = G_; c = c_; rot = rot_; }
    __device__ __forceinline__ bool next(int i, Unit& u) const {
        int cc = c - rot; if (cc < 0) cc += G;
        const long L = (long)i * G + cc; if (L >= 2 * nN * nsplit) return false;
        const int s = (int)L % nsplit, tile = (int)L / nsplit;
        u.pm = pm0 + tile / nN; u.pn = tile % nN; u.pa = u.pm; u.pb = u.pn; u.ko = s * KT; u.aux = s; return true;
    }
    __device__ __forceinline__ void a_ready(const Unit&) const {}
    __device__ __forceinline__ void done(const Unit&) const {}
};

__device__ __forceinline__ unsigned cvt_pk_bf16(float lo, float hi) { unsigned r; asm volatile("v_cvt_pk_bf16_f32 %0, %1, %2" : "=v"(r) : "v"(lo), "v"(hi)); return r; }
__device__ __forceinline__ unsigned pk_fp8x4(float a, float b, float c, float d) { int v = __builtin_amdgcn_cvt_pk_fp8_f32(a, b, 0, false); v = __builtin_amdgcn_cvt_pk_fp8_f32(c, d, v, true); return (unsigned)v; }
__device__ __forceinline__ float clamp448(float x) { return fminf(fmaxf(x, -448.0f), 448.0f); }
__device__ __forceinline__ float bf_lo(unsigned w) { return __uint_as_float(w << 16); }
__device__ __forceinline__ float bf_hi(unsigned w) { return __uint_as_float(w & 0xffff0000u); }
__device__ __forceinline__ float fast_sigmoid(float x) { return __builtin_amdgcn_rcpf(1.0f + __expf(-x)); }

struct EpiBf16Plain {
    static constexpr bool PERM = true, AFTER_DRAIN = false;
    bf16_t* O; int ldc;
    __device__ __forceinline__ void operator()(const f32x4 (&acc)[2][2][4][2], const Unit& u, int wr, int wc, int fr, int fq) const {
        const int row0 = u.pm * BM + wr * 64 + fr, col0 = u.pn * BM + wc * 32 + 8 * fq;
#pragma unroll
        for (int ai = 0; ai < 2; ++ai)
#pragma unroll
            for (int m = 0; m < 4; ++m) { bf16_t* rowp = O + (size_t)(row0 + ai * HALF + m * 16) * ldc + col0;
#pragma unroll
                for (int bj = 0; bj < 2; ++bj) { const f32x4 v0 = acc[ai][bj][m][0], v1 = acc[ai][bj][m][1];
                    u32x4 w; w.x = cvt_pk_bf16(v0[0], v0[1]); w.y = cvt_pk_bf16(v0[2], v0[3]); w.z = cvt_pk_bf16(v1[0], v1[1]); w.w = cvt_pk_bf16(v1[2], v1[3]);
                    *(u32x4*)(rowp + bj * HALF) = w; } }
    }
};
struct EpiU {
    static constexpr bool PERM = true, AFTER_DRAIN = false;
    bf16_t* O; int ldc;
    __device__ __forceinline__ void operator()(const f32x4 (&acc)[2][2][4][2], const Unit& u, int wr, int wc, int fr, int fq) const {
        const int row0 = u.pm * BM + wr * 64 + fr, col0 = u.pn * BM + wc * 32 + 8 * fq;
        const bool is_gq = (u.pn == 12 || u.pn == 13), is_gk = (u.pn == 14 || u.pn == 15), is_nq = (u.pn >= 24 && u.pn < 28);
        const float sc = (is_gq || is_nq) ? 0.08838834764831845f : 1.0f;
        const bool rope = (is_gq || is_gk) && u.pm < 32;
        float inv[4];
#pragma unroll
        for (int j = 0; j < 4; ++j) inv[j] = exp2f(-(float)((16 * wc + 4 * fq + j) & 31) * 0.41524101186092029f);
#pragma unroll
        for (int ai = 0; ai < 2; ++ai)
#pragma unroll
            for (int m = 0; m < 4; ++m) { const int row = row0 + ai * HALF + m * 16; bf16_t* rowp = O + (size_t)row * ldc + col0;
                const int t = row & 4095; const float pos = (wc < 2) ? (float)(t >> 6) : (float)(t & 63);
                float cs[4], sn[4];
                if (rope) {
#pragma unroll
                    for (int j = 0; j < 4; ++j) { const float ang = pos * inv[j]; cs[j] = __cosf(ang); sn[j] = __sinf(ang); } }
#pragma unroll
                for (int bj = 0; bj < 2; ++bj) { f32x4 v0 = acc[ai][bj][m][0] * sc, v1 = acc[ai][bj][m][1] * sc;
                    if (rope) { const f32x4 a = v0, b = v1;
                        v0[0] = a[0] * cs[0] - a[1] * sn[0]; v0[1] = a[0] * sn[0] + a[1] * cs[0]; v0[2] = a[2] * cs[1] - a[3] * sn[1]; v0[3] = a[2] * sn[1] + a[3] * cs[1];
                        v1[0] = b[0] * cs[2] - b[1] * sn[2]; v1[1] = b[0] * sn[2] + b[1] * cs[2]; v1[2] = b[2] * cs[3] - b[3] * sn[3]; v1[3] = b[2] * sn[3] + b[3] * cs[3]; }
                    u32x4 w; w.x = cvt_pk_bf16(v0[0], v0[1]); w.y = cvt_pk_bf16(v0[2], v0[3]); w.z = cvt_pk_bf16(v1[0], v1[1]); w.w = cvt_pk_bf16(v1[2], v1[3]);
                    *(u32x4*)(rowp + bj * HALF) = w; } }
    }
};
struct EpiF32Plain {
    static constexpr bool PERM = false, AFTER_DRAIN = false;
    float* C; int ldc; float oscale;
    __device__ __forceinline__ void operator()(const f32x4 (&acc)[2][2][4][2], const Unit& u, int wr, int wc, int fr, int fq) const {
        const int row0 = u.pm * BM + wr * 64 + fr, col0 = u.pn * BM + wc * 32 + 4 * fq;
#pragma unroll
        for (int ai = 0; ai < 2; ++ai)
#pragma unroll
            for (int m = 0; m < 4; ++m) { float* rowp = C + (size_t)(row0 + ai * HALF + m * 16) * ldc + col0;
#pragma unroll
                for (int bj = 0; bj < 2; ++bj)
#pragma unroll
                    for (int n = 0; n < 2; ++n) *(f32x4*)(rowp + bj * HALF + n * 16) = acc[ai][bj][m][n] * oscale; }
    }
};
template <bool SC> struct EpiPartial {
    static constexpr bool PERM = false, AFTER_DRAIN = false;
    float* P; int pm0; float oscale;
    __device__ __forceinline__ void operator()(const f32x4 (&acc)[2][2][4][2], const Unit& u, int wr, int wc, int fr, int fq) const {
        const int row0 = (u.pm - pm0) * BM + wr * 64 + fr, col0 = u.pn * BM + wc * 32 + 4 * fq; float* base = P + (size_t)u.aux * 512 * 2048;
#pragma unroll
        for (int ai = 0; ai < 2; ++ai)
#pragma unroll
            for (int m = 0; m < 4; ++m) { float* rowp = base + (size_t)(row0 + ai * HALF + m * 16) * 2048 + col0;
#pragma unroll
                for (int bj = 0; bj < 2; ++bj)
#pragma unroll
                    for (int n = 0; n < 2; ++n) *(f32x4*)(rowp + bj * HALF + n * 16) = SC ? acc[ai][bj][m][n] * oscale : acc[ai][bj][m][n]; }
    }
};
struct EpiGate {
    static constexpr bool PERM = false, AFTER_DRAIN = false;
    const bf16_t* Ug; int ldu;
    const float* gb;
    float* Z; bf16_t* ZB;
    __device__ __forceinline__ void operator()(const f32x4 (&acc)[2][2][4][2], const Unit& u, int wr, int wc, int fr, int fq) const {
        const int row0 = u.pm * BM + wr * 64 + fr, col0 = u.pn * BM + wc * 32 + 4 * fq; const bool first = u.aux == 0, last = u.aux == 2;
        const bf16_t* Ub = Ug + 2048 * u.aux; const float* gbb = gb + 2048 * u.aux;
#pragma unroll
        for (int ai = 0; ai < 2; ++ai)
#pragma unroll
            for (int m = 0; m < 4; ++m) { const size_t row = (size_t)(row0 + ai * HALF + m * 16);
#pragma unroll
                for (int bj = 0; bj < 2; ++bj)
#pragma unroll
                    for (int n = 0; n < 2; ++n) { const int col = col0 + bj * HALF + n * 16;
                        const u32x2 gl = *(const u32x2*)(Ub + row * ldu + col); const f32x4 b4 = *(const f32x4*)(gbb + col);
                        f32x4 v = acc[ai][bj][m][n];
                        v[0] *= fast_sigmoid(bf_lo(gl.x) + b4[0]); v[1] *= fast_sigmoid(bf_hi(gl.x) + b4[1]); v[2] *= fast_sigmoid(bf_lo(gl.y) + b4[2]); v[3] *= fast_sigmoid(bf_hi(gl.y) + b4[3]);
                        if (!first) v += *(const f32x4*)(Z + row * 2048 + col);
                        if (!last) *(f32x4*)(Z + row * 2048 + col) = v;
                        else { u32x2 w; w.x = cvt_pk_bf16(v[0], v[1]); w.y = cvt_pk_bf16(v[2], v[3]); *(u32x2*)(ZB + row * 2048 + col) = w; } }
                asm volatile("" ::: "memory"); }
    }
};
template <bool SC> struct EpiRes {
    static constexpr bool PERM = false, AFTER_DRAIN = false;
    const float* res_lat; const float* res_ctx; const float* gv; int gstride; float* out; float alpha, oscale;
    __device__ __forceinline__ void operator()(const f32x4 (&acc)[2][2][4][2], const Unit& u, int wr, int wc, int fr, int fq) const {
        const int grp = u.pm < 16 ? 0 : (u.pm < 32 ? 1 : 2);
        const float* res = u.pm < 32 ? res_lat + (size_t)u.pm * BM * 2048 : res_ctx + (size_t)(u.pm - 32) * BM * 2048;
        const float* g = gv + (size_t)grp * gstride;
        const int rl0 = wr * 64 + fr, col0 = u.pn * BM + wc * 32 + 4 * fq;
#pragma unroll
        for (int ai = 0; ai < 2; ++ai)
#pragma unroll
            for (int m = 0; m < 4; ++m) { const int rl = rl0 + ai * HALF + m * 16;
#pragma unroll
                for (int bj = 0; bj < 2; ++bj)
#pragma unroll
                    for (int n = 0; n < 2; ++n) { const int col = col0 + bj * HALF + n * 16;
                        const f32x4 r4 = *(const f32x4*)(res + (size_t)rl * 2048 + col); const f32x4 g4 = *(const f32x4*)(g + col);
                        *(f32x4*)(out + ((size_t)u.pm * BM + rl) * 2048 + col) = r4 * alpha + g4 * (SC ? acc[ai][bj][m][n] * oscale : acc[ai][bj][m][n]); }
                asm volatile("" ::: "memory"); }
    }
};
struct EpiSwiGLU {
    static constexpr bool PERM = true, AFTER_DRAIN = false;
    bf16_t* O; int ldc;
    __device__ __forceinline__ void operator()(const f32x4 (&acc)[2][2][4][2], const Unit& u, int wr, int wc, int fr, int fq) const {
        const int row0 = u.pm * BM + wr * 64 + fr, col0 = u.pn * HALF + wc * 32 + 8 * fq;
#pragma unroll
        for (int ai = 0; ai < 2; ++ai)
#pragma unroll
            for (int m = 0; m < 4; ++m) { bf16_t* rowp = O + (size_t)(row0 + ai * HALF + m * 16) * ldc + col0;
                float h[8];
#pragma unroll
                for (int n = 0; n < 2; ++n)
#pragma unroll
                    for (int j = 0; j < 4; ++j) { const float gt = acc[ai][0][m][n][j], up = acc[ai][1][m][n][j]; h[n * 4 + j] = gt * fast_sigmoid(gt) * up; }
                u32x4 w; w.x = cvt_pk_bf16(h[0], h[1]); w.y = cvt_pk_bf16(h[2], h[3]); w.z = cvt_pk_bf16(h[4], h[5]); w.w = cvt_pk_bf16(h[6], h[7]);
                *(u32x4*)rowp = w; }
    }
};
struct EpiSwiGLU8 {
    static constexpr bool PERM = true, AFTER_DRAIN = false;
    unsigned char* O; int ldc; float oscale, hscale;
    __device__ __forceinline__ void operator()(const f32x4 (&acc)[2][2][4][2], const Unit& u, int wr, int wc, int fr, int fq) const {
        const int row0 = u.pm * BM + wr * 64 + fr, col0 = u.pn * HALF + wc * 32 + 8 * fq;
#pragma unroll
        for (int ai = 0; ai < 2; ++ai)
#pragma unroll
            for (int m = 0; m < 4; ++m) { unsigned char* rowp = O + (size_t)(row0 + ai * HALF + m * 16) * ldc + col0;
                float h[8];
#pragma unroll
                for (int n = 0; n < 2; ++n)
#pragma unroll
                    for (int j = 0; j < 4; ++j) { const float gt = acc[ai][0][m][n][j] * oscale, up = acc[ai][1][m][n][j] * oscale; h[n * 4 + j] = clamp448(gt * fast_sigmoid(gt) * up * hscale); }
                u32x2 w; w.x = pk_fp8x4(h[0], h[1], h[2], h[3]); w.y = pk_fp8x4(h[4], h[5], h[6], h[7]);
                *(u32x2*)rowp = w; }
    }
};

template <class Epi, class Sched, bool ALIGN_EPI = false, bool SP2 = false, bool F8 = false>
__device__ __forceinline__ void gemm_phase(PG8_LAS unsigned char* lds, const Gemm g, const Sched& S, const Epi& E) {
    int tid_ = threadIdx.x; asm volatile("" : "+v"(tid_));
    const int tid = tid_, wid = __builtin_amdgcn_readfirstlane(tid >> 6), lane = tid & 63, wr = wid >> 2, wc = wid & 3, fr = lane & 15, fq = lane >> 4;
    const int K = g.K, nt = g.KT / BK;
    unsigned voffA[2], voffB[2];
#pragma unroll
    for (int i = 0; i < 2; ++i) { int R, C; stage_rc(tid * 16 + i * 8192, R, C); const int Rb = Epi::PERM ? ((R & ~31) + perm32(R & 31)) : R;
        voffA[i] = (unsigned)(R * K + C) * 2u; voffB[i] = (unsigned)(Rb * K + C) * 2u; }
    const size_t kstep = (size_t)(BK * 2);
    const size_t hstep = (size_t)HALF * K * 2;
    const size_t tstep = 2 * hstep;
    const unsigned ldsw = (unsigned)wid * 1024u;
    const int aoff = lds_byte(wr * 64 + fr, fq * 8), boff = lds_byte(wc * 32 + fr, fq * 8);
#define PG8_SA(b, h) (((b) * 2 + (h)) * HTB)
#define PG8_SB(b, h) ((4 + (b) * 2 + (h)) * HTB)
#define PG8_STAGE(bufoff, gbase, voff) do { _Pragma("unroll") for (int _i = 0; _i < 2; ++_i) \
        __builtin_amdgcn_global_load_lds((const unsigned*)((const char*)(gbase) + (voff)[_i]), (PG8_LAS unsigned*)(lds + (bufoff) + ldsw + _i * 8192), 16, 0, 0); } while (0)
#define PG8_CAT(p) __builtin_shufflevector(*(const PG8_LAS i32x4*)(p), *(const PG8_LAS i32x4*)((p) + 1024), 0, 1, 2, 3, 4, 5, 6, 7)
#define PG8_LDA(dst, b, h) do { _Pragma("unroll") for (int m = 0; m < 4; ++m) { if constexpr (F8) dst##8[m] = PG8_CAT(lds + PG8_SA(b, h) + aoff + m * 2048); else { _Pragma("unroll") for (int k = 0; k < 2; ++k) dst[m][k] = *(const PG8_LAS bf16x8*)(lds + PG8_SA(b, h) + aoff + m * 2048 + k * 1024); } } } while (0)
#define PG8_LDB(dst, b, h) do { _Pragma("unroll") for (int n = 0; n < 2; ++n) { if constexpr (F8) dst##8[n] = PG8_CAT(lds + PG8_SB(b, h) + boff + n * 2048); else { _Pragma("unroll") for (int k = 0; k < 2; ++k) dst[n][k] = *(const PG8_LAS bf16x8*)(lds + PG8_SB(b, h) + boff + n * 2048 + k * 1024); } } } while (0)
#define PG8_MMA(ai, bj, At, Bt) do { __builtin_amdgcn_s_setprio(1); _Pragma("unroll") for (int m = 0; m < 4; ++m) _Pragma("unroll") for (int n = 0; n < 2; ++n) { \
        if constexpr (F8) asm volatile("v_mfma_scale_f32_16x16x128_f8f6f4 %0, %1, %2, %0, %3, %3 op_sel_hi:[0,0,0]" : "+v"(acc[ai][bj][m][n]) : "v"(Bt##8[n]), "v"(At##8[m]), "v"(f8one));   \
        else { _Pragma("unroll") for (int k = 0; k < 2; ++k) acc[ai][bj][m][n] = __builtin_amdgcn_mfma_f32_16x16x32_bf16(Bt[n][k], At[m][k], acc[ai][bj][m][n], 0, 0, 0); } } \
        __builtin_amdgcn_s_setprio(0); } while (0)
#define PG8_WAIT_V(n) asm volatile("s_waitcnt vmcnt(" #n ")" ::: "memory")
#define PG8_WAIT_L(n) asm volatile("s_waitcnt lgkmcnt(" #n ")" ::: "memory")
#define PG8_BAR __builtin_amdgcn_s_barrier()
#define PG8_SCHED __builtin_amdgcn_sched_barrier(0)
    Unit cur, nxt; int ui = 0;
    if (!S.next(0, cur)) return;
    f32x4 acc[2][2][4][2];
#pragma unroll
    for (int a = 0; a < 2; ++a)
#pragma unroll
        for (int b = 0; b < 2; ++b)
#pragma unroll
            for (int m = 0; m < 4; ++m)
#pragma unroll
                for (int n = 0; n < 2; ++n) acc[a][b][m][n] = (f32x4){0.f, 0.f, 0.f, 0.f};
    const int f8one = 0x7f7f7f7f;
    bf16x8 At[4][2], B0[2][2], B1[2][2];
    i32x8 At8[4], B08[2], B18[2];
    const char* cA = (const char*)g.A + (size_t)cur.pa * tstep + (size_t)cur.ko * 2; const char* cB = (const char*)g.Bt + (size_t)cur.pb * tstep + (size_t)cur.ko * 2;
    S.a_ready(cur);
    if constexpr (SP2) {
        PG8_STAGE(PG8_SB(0, 0), cB, voffB); PG8_STAGE(PG8_SB(0, 1), cB + hstep, voffB); PG8_STAGE(PG8_SA(0, 0), cA, voffA); PG8_STAGE(PG8_SA(0, 1), cA + hstep, voffA);
        if (wr == 1) PG8_BAR;
        PG8_WAIT_V(2); PG8_BAR;
        PG8_STAGE(PG8_SB(1, 0), cB + kstep, voffB); PG8_STAGE(PG8_SA(1, 0), cA + kstep, voffA); PG8_STAGE(PG8_SB(1, 1), cB + hstep + kstep, voffB);
        PG8_WAIT_V(6); PG8_BAR;
    } else {
        PG8_STAGE(PG8_SB(0, 0), cB, voffB); PG8_STAGE(PG8_SA(0, 0), cA, voffA); PG8_STAGE(PG8_SB(0, 1), cB + hstep, voffB); PG8_STAGE(PG8_SA(0, 1), cA + hstep, voffA);
        if (wr == 1) PG8_BAR;
        PG8_WAIT_V(4); PG8_BAR;
        PG8_STAGE(PG8_SB(1, 0), cB + kstep, voffB); PG8_STAGE(PG8_SA(1, 0), cA + kstep, voffA); PG8_STAGE(PG8_SB(1, 1), cB + hstep + kstep, voffB);
        PG8_WAIT_V(6); PG8_BAR;
    }
    for (;;) {
        const bool has_next = S.next(ui + 1, nxt);
        const char* nA = has_next ? (const char*)g.A + (size_t)nxt.pa * tstep + (size_t)nxt.ko * 2 : cA; const char* nB = has_next ? (const char*)g.Bt + (size_t)nxt.pb * tstep + (size_t)nxt.ko * 2 : cB;
        for (int t = 0; t < nt; t += 2) {
            const bool last = (t == nt - 2);
            const char* a1 = cA + (size_t)(t + 1) * kstep;
            const char* a2 = last ? nA : cA + (size_t)(t + 2) * kstep; const char* b2 = last ? nB : cB + (size_t)(t + 2) * kstep;
            const char* a3 = a2 + kstep; const char* b3 = b2 + kstep;
            if (last && has_next) S.a_ready(nxt);
            if constexpr (SP2) {
            PG8_LDB(B0, 0, 0); PG8_LDB(B1, 0, 1); PG8_SCHED; PG8_LDA(At, 0, 0); PG8_STAGE(PG8_SA(1, 1), a1 + hstep, voffA);
            PG8_WAIT_V(8); PG8_WAIT_L(0); PG8_BAR; PG8_MMA(0, 0, At, B0); PG8_MMA(0, 1, At, B1); PG8_BAR; PG8_SCHED;
            PG8_LDA(At, 0, 1); PG8_STAGE(PG8_SB(0, 0), b2, voffB); PG8_STAGE(PG8_SB(0, 1), b2 + hstep, voffB); PG8_STAGE(PG8_SA(0, 0), a2, voffA);
            PG8_WAIT_V(8); PG8_WAIT_L(0); PG8_BAR; PG8_MMA(1, 0, At, B0); PG8_MMA(1, 1, At, B1); PG8_BAR; PG8_SCHED;
            PG8_LDB(B0, 1, 0); PG8_LDB(B1, 1, 1); PG8_SCHED; PG8_LDA(At, 1, 0); PG8_STAGE(PG8_SA(0, 1), a2 + hstep, voffA);
            PG8_WAIT_V(8); PG8_WAIT_L(0); PG8_BAR; PG8_MMA(0, 0, At, B0); PG8_MMA(0, 1, At, B1); PG8_BAR; PG8_SCHED;
            PG8_LDA(At, 1, 1); PG8_STAGE(PG8_SB(1, 0), b3, voffB); PG8_STAGE(PG8_SB(1, 1), b3 + hstep, voffB); PG8_STAGE(PG8_SA(1, 0), a3, voffA);
            PG8_WAIT_V(8); PG8_WAIT_L(0); PG8_BAR; PG8_MMA(1, 0, At, B0); PG8_MMA(1, 1, At, B1); PG8_BAR; PG8_SCHED;
            } else {
            PG8_LDB(B0, 0, 0); PG8_SCHED; PG8_LDA(At, 0, 0); PG8_STAGE(PG8_SA(1, 1), a1 + hstep, voffA);
            PG8_WAIT_L(8); PG8_BAR; PG8_WAIT_L(0); PG8_MMA(0, 0, At, B0); PG8_BAR; PG8_SCHED;
            PG8_LDB(B1, 0, 1); PG8_STAGE(PG8_SB(0, 0), b2, voffB);
            PG8_BAR; PG8_WAIT_L(0); PG8_MMA(0, 1, At, B1); PG8_BAR;
            PG8_LDA(At, 0, 1); PG8_STAGE(PG8_SA(0, 0), a2, voffA);
            PG8_BAR; PG8_WAIT_L(0); PG8_MMA(1, 0, At, B0); PG8_BAR; PG8_SCHED;
            PG8_STAGE(PG8_SB(0, 1), b2 + hstep, voffB);
            PG8_WAIT_V(6); PG8_BAR; PG8_MMA(1, 1, At, B1); PG8_BAR;
            PG8_LDB(B0, 1, 0); PG8_SCHED; PG8_LDA(At, 1, 0); PG8_STAGE(PG8_SA(0, 1), a2 + hstep, voffA);
            PG8_WAIT_L(8); PG8_BAR; PG8_WAIT_L(0); PG8_MMA(0, 0, At, B0); PG8_BAR; PG8_SCHED;
            PG8_LDB(B1, 1, 1); PG8_STAGE(PG8_SB(1, 0), b3, voffB);
            PG8_BAR; PG8_WAIT_L(0); PG8_MMA(0, 1, At, B1); PG8_BAR;
            PG8_LDA(At, 1, 1); PG8_STAGE(PG8_SA(1, 0), a3, voffA);
            PG8_BAR; PG8_WAIT_L(0); PG8_MMA(1, 0, At, B0); PG8_BAR; PG8_SCHED;
            PG8_STAGE(PG8_SB(1, 1), b3 + hstep, voffB);
            PG8_WAIT_V(6); PG8_BAR; PG8_MMA(1, 1, At, B1); PG8_BAR;
            }
        }
        if constexpr (F8) asm volatile("s_nop 15\n\ts_nop 15\n\ts_nop 15" ::: "memory");
        if constexpr (ALIGN_EPI) { if (wr == 0) PG8_BAR; }
        if constexpr (!Epi::AFTER_DRAIN) { E(acc, cur, wr, wc, fr, fq); S.done(cur); }
        if (!has_next) break;
#pragma unroll
        for (int a = 0; a < 2; ++a)
#pragma unroll
            for (int b = 0; b < 2; ++b)
#pragma unroll
                for (int m = 0; m < 4; ++m)
#pragma unroll
                    for (int n = 0; n < 2; ++n) acc[a][b][m][n] = (f32x4){0.f, 0.f, 0.f, 0.f};
        cur = nxt; cA = nA; cB = nB; ++ui;
        if constexpr (ALIGN_EPI) { if (wr == 1) PG8_BAR; }
    }
    PG8_WAIT_V(0);
    if constexpr (!ALIGN_EPI) { if (wr == 0) PG8_BAR; }
    PG8_BAR;
    if constexpr (Epi::AFTER_DRAIN) { E.fused(acc, cur, wr, wc, fr, fq, lds, wid, lane); S.done(cur); }
#undef PG8_SA
#undef PG8_SB
#undef PG8_STAGE
#undef PG8_CAT
#undef PG8_LDA
#undef PG8_LDB
#undef PG8_MMA
#undef PG8_WAIT_V
#undef PG8_WAIT_L
#undef PG8_BAR
#undef PG8_SCHED
}
}

constexpr int NWAVES = 8, NTHR = 512;
constexpr int D = 2048, SEQ = 4096, NLAT = 8192, CTXL = 256, NCTX = 512, MROWS = 8704, DEPTH = 2;
constexpr int INC = 15392, NU = 15360;
constexpr int U_CB = 0, U_CC = 1024, U_CX = 2048, U_GQ = 3072, U_GK = 3584, U_GV = 4096, U_GR = 5120, U_NQ = 6144, U_NK = 7168, U_NV = 8192, U_GATE = 9216;
constexpr int LR_COL = 6144;
constexpr int FF = 5632, NGU = 2 * FF, NE = 8;
constexpr float LN_EPS = 1e-5f, ALPHA = 1.41421356237f;
constexpr float FSC_WGU = 64.0f, FSC_WD = 128.0f, FSC_HID = 4.0f;
constexpr int MOE_MAXP = 72;

constexpr size_t MiB = 1u << 20;
constexpr size_t WS_CTL = 0, CTL_ZERO_BYTES = 1 * MiB;
constexpr size_t WS_MOD = 1 * MiB;
constexpr size_t WS_WLR = 1 * MiB + 512 * 1024;
constexpr size_t WS_ROUTE = 2 * MiB;
constexpr size_t WS_TOK = 2 * MiB + 256 * 1024;
constexpr size_t WS_LR = 3 * MiB;
constexpr size_t WS_W = 8 * MiB;
constexpr size_t W_IN_B = (size_t)NU * D * 2, W_BR_B = (size_t)1024 * D * 2, W_OUT_B = (size_t)D * D * 2, W_LAYER_B = W_IN_B + 3 * W_BR_B + W_OUT_B;
constexpr size_t W_GU_B = (size_t)NGU * D * 2, W_D_B = (size_t)D * FF * 2, W_FFN_B = W_GU_B + W_D_B;
constexpr size_t WS_WFFN = WS_W + 2 * W_LAYER_B, WS_WMOE = WS_WFFN + W_FFN_B, WS_WEND = WS_WMOE + 8 * W_FFN_B;
constexpr size_t WS_XL = 762 * MiB;
constexpr size_t WS_H = 830 * MiB;
constexpr size_t WS_U = 864 * MiB;
constexpr size_t WS_Y = 1119 * MiB;
constexpr size_t WS_GLA = 1170 * MiB;
constexpr size_t WS_Z = 1306 * MiB;
constexpr size_t WS_ZB = 1374 * MiB;
constexpr size_t WS_PRE = 1408 * MiB;
constexpr size_t WS_PART = 1476 * MiB;
constexpr size_t WS_END = 1520 * MiB;
static_assert(WS_WEND <= WS_XL && WS_XL + (size_t)MROWS * D * 4 <= WS_H && WS_H + (size_t)MROWS * D * 2 <= WS_U && WS_U + (size_t)MROWS * NU * 2 <= WS_Y, "ws map 1");
static_assert(WS_U + (size_t)MOE_MAXP * 256 * FF * 2 <= WS_Y && WS_Y + 3 * (size_t)MROWS * 1024 * 2 <= WS_GLA && WS_GLA + (size_t)MROWS * (4 * 512 + 2 * 1024) * 4 <= WS_Z, "ws map 2");
static_assert(WS_GLA + (size_t)MOE_MAXP * 256 * D * 2 <= WS_Z && WS_Z + (size_t)MOE_MAXP * 256 * D * 4 <= WS_END && WS_PRE + (size_t)MROWS * D * 4 <= WS_END, "ws map 3");
constexpr int CW_TMO = 0, CW_CODE = 1;
constexpr int CW_MOECNT = 64;
constexpr int CW_BAR = 4096;

constexpr int RING_OFF = 0, RING_BYTES = 131072;
constexpr int LDSCTL_OFF = RING_BYTES, MISC_OFF = LDSCTL_OFF + 320;
constexpr int LDS_BYTES = 147456;

#define GAS __attribute__((address_space(1)))
#define LAS __attribute__((address_space(3)))
typedef unsigned short bf16;
typedef unsigned v4u __attribute__((ext_vector_type(4)));
typedef unsigned v2u __attribute__((ext_vector_type(2)));
typedef float f32x4 __attribute__((ext_vector_type(4)));
typedef GAS unsigned gu32;
typedef short bf16x8v __attribute__((ext_vector_type(8)));
#define RLX_AGENT __ATOMIC_RELAXED, __HIP_MEMORY_SCOPE_AGENT
#define LDS_WAIT() asm volatile("s_waitcnt lgkmcnt(0)" ::: "memory")
#define VM_WAIT() asm volatile("s_waitcnt vmcnt(0)" ::: "memory")
__device__ __forceinline__ unsigned f2bf(float f) { unsigned u = __builtin_bit_cast(unsigned, f); return (u + 0x7fffu + ((u >> 16) & 1u)) >> 16; }
__device__ __forceinline__ unsigned pk2(float lo, float hi) { return f2bf(lo) | (f2bf(hi) << 16); }
__device__ __forceinline__ float bflo(unsigned w) { return __uint_as_float(w << 16); }
__device__ __forceinline__ float bfhi(unsigned w) { return __uint_as_float(w & 0xffff0000u); }
__device__ __forceinline__ float bf1(bf16 b) { return __uint_as_float(((unsigned)b) << 16); }
__device__ __forceinline__ float wave_sum(float v) {
#pragma unroll
    for (int o = 1; o < 64; o <<= 1) v += __shfl_xor(v, o);
    return v;
}
__device__ __forceinline__ float wave_max(float v) {
#pragma unroll
    for (int o = 1; o < 64; o <<= 1) v = fmaxf(v, __shfl_xor(v, o));
    return v;
}

#define XB_TMO      128
#define XB_XCNT(j)  (256  + 64 * (j))
#define XB_XSUB(j)  (1280 + 64 * (j))
#define XB_XGEN(j)  (2304 + 64 * (j))
#define XB_TOP      3328
#define XB_TOPGEN   3392
#define XCD_BAR_WORDS 3456
#define XB_SPIN_CAP (1u << 18)

__device__ __forceinline__ unsigned xb_ld(unsigned* p)              { return __hip_atomic_load(p, __ATOMIC_RELAXED, __HIP_MEMORY_SCOPE_AGENT); }
__device__ __forceinline__ unsigned xb_add(unsigned* p, unsigned v) { return __hip_atomic_fetch_add(p, v, __ATOMIC_RELAXED, __HIP_MEMORY_SCOPE_AGENT); }
__device__ __forceinline__ unsigned xb_xcc_id() { return (unsigned)__builtin_amdgcn_s_getreg((3 << 11) | 20) & 0xFu; }
#define XB_SPIN(cond, bar) do { unsigned _sp = 0; while (cond) { __builtin_amdgcn_s_sleep(1); \
    if ((++_sp & 255u) == 0u) { if (xb_ld(&(bar)[XB_TMO])) break; if (_sp > XB_SPIN_CAP) { atomicAdd(&(bar)[XB_TMO], 1u); break; } } } } while (0)

struct XcdBarrier {
    unsigned* bar; unsigned x; unsigned grid;
    volatile LAS unsigned* st;
};

__device__ __forceinline__ XcdBarrier xcd_barrier_post(unsigned* bar, volatile LAS unsigned* st, unsigned grid) {
    XcdBarrier b; b.grid = grid; b.bar = bar; b.x = xb_xcc_id(); b.st = st;
    if (threadIdx.x == 0) (void)xb_add(&bar[XB_XCNT(b.x)], 1u);
    return b;
}
__device__ __forceinline__ void xcd_barrier_complete(unsigned* bar, unsigned x, unsigned& nloc, unsigned& nx, unsigned b_grid) {
    const unsigned G = b_grid;
    unsigned sum, cnt, mine, sp = 0u;
    for (;;) {
        sum = 0u; cnt = 0u; mine = 0u;
#pragma unroll
        for (unsigned j = 0; j < 16; ++j) { const unsigned c = xb_ld(&bar[XB_XCNT(j)]); sum += c; cnt += (c > 0u) ? 1u : 0u; mine = (j == x) ? c : mine; }
        if (sum == G) break;
        __builtin_amdgcn_s_sleep(1);
        if ((++sp & 255u) == 0u) { if (xb_ld(&bar[XB_TMO])) break; if (sp > XB_SPIN_CAP) { atomicAdd(&bar[XB_TMO], 1u); break; } }
    }
    nloc = mine > 0u ? mine : 1u; nx = cnt > 0u ? cnt : 1u;
}

__device__ __forceinline__ void xcd_barrier(const XcdBarrier& b) {
    asm volatile("s_waitcnt vmcnt(0)" ::: "memory");
    __syncthreads();
    if (threadIdx.x == 0) {
        unsigned* bar = b.bar;
        __builtin_amdgcn_s_waitcnt(0);
        unsigned nloc = b.st[0], nx = b.st[1];
        if (nloc == 0u) { xcd_barrier_complete(bar, b.x, nloc, nx, b.grid); b.st[0] = nloc; b.st[1] = nx; }
        const unsigned old = xb_add(&bar[XB_XSUB(b.x)], 1u);
        const unsigned gen = old / nloc;
        if (old + 1u == (gen + 1u) * nloc) {
            __builtin_amdgcn_fence(__ATOMIC_RELEASE, "agent");
            asm volatile("s_waitcnt vmcnt(0)" ::: "memory");
            const unsigned og = xb_add(&bar[XB_TOP], 1u);
            const unsigned tg = og / nx;
            if (og + 1u == (tg + 1u) * nx) xb_add(&bar[XB_TOPGEN], 1u);
            else XB_SPIN(xb_ld(&bar[XB_TOPGEN]) == tg, bar);
            __builtin_amdgcn_fence(__ATOMIC_ACQUIRE, "agent");
            xb_add(&bar[XB_XGEN(b.x)], 1u);
            asm volatile("s_waitcnt vmcnt(0)" ::: "memory");
        } else {
            XB_SPIN(xb_ld(&bar[XB_XGEN(b.x)]) == gen, bar);
            __builtin_amdgcn_fence(__ATOMIC_ACQUIRE, "agent");
            asm volatile("s_waitcnt vmcnt(0)" ::: "memory");
        }
    }
    __syncthreads();
}

struct Args { const float* in[30]; float* out; unsigned char* ws; int ph_lo, ph_hi, grid, pad; };
struct Frame {
    LAS unsigned char* lds;
    volatile LAS unsigned* MISC;
    int tid, lane, wave, vcu, G, bx;
};
__device__ __forceinline__ Frame mkframe(LAS unsigned char* lds, int grid) {
    Frame F; int t = threadIdx.x; asm volatile("" : "+v"(t)); int g = grid, bx = blockIdx.x; asm volatile("" : "+s"(g), "+s"(bx));
    F.lds = lds; F.MISC = (volatile LAS unsigned*)(lds + MISC_OFF); F.tid = t; F.lane = t & 63; F.wave = __builtin_amdgcn_readfirstlane(t >> 6); F.G = g; F.bx = bx;
    F.vcu = (g % 8 == 0) ? (bx % 8) * (g / 8) + bx / 8 : bx; return F;
}
constexpr int PTAB_OFF = LDSCTL_OFF + 1024, PT_OUT = 30, PT_WS = 31;
__device__ __forceinline__ unsigned long long ldp_raw(Frame& F, int i) {
    const volatile LAS unsigned* t = (const volatile LAS unsigned*)(F.lds + PTAB_OFF) + 2 * i; const unsigned lo = t[0], hi = t[1];
    return ((unsigned long long)(unsigned)__builtin_amdgcn_readfirstlane((int)hi) << 32) | (unsigned)__builtin_amdgcn_readfirstlane((int)lo);
}
#define PIN(i) ((const float*)(const GAS float*)ldp_raw(F, (i)))
#define POUT() ((float*)(GAS float*)ldp_raw(F, PT_OUT))
#define PWS() ((unsigned char*)(GAS unsigned char*)ldp_raw(F, PT_WS))
__device__ __forceinline__ bf16* w_in_t(unsigned char* ws, int L) { return (bf16*)(ws + WS_W + (size_t)L * W_LAYER_B); }
__device__ __forceinline__ bf16* w_br_t(unsigned char* ws, int L, int b) { return (bf16*)(ws + WS_W + (size_t)L * W_LAYER_B + W_IN_B + (size_t)b * W_BR_B); }
__device__ __forceinline__ bf16* w_out_t(unsigned char* ws, int L) { return (bf16*)(ws + WS_W + (size_t)L * W_LAYER_B + W_IN_B + 3 * W_BR_B); }
__device__ __forceinline__ unsigned char* w_gu_t(unsigned char* ws, int e) { return ws + (e < 0 ? WS_WFFN : WS_WMOE + (size_t)e * (W_GU_B / 2)); }
__device__ __forceinline__ unsigned char* w_d_t(unsigned char* ws, int e) { return ws + (e < 0 ? WS_WFFN + W_GU_B : WS_WMOE + 8 * W_GU_B + (size_t)e * (W_D_B / 2)); }

__device__ __forceinline__ void transpose_item(const float* W, int K, int N, bf16* WT, int drow, LAS float* scr, int kb, int nb, int lane) {
    const int k0 = 64 * kb, n0 = 32 * nb;
#pragma unroll 8
    for (int i = 0; i < 32; ++i) { const int kk = 2 * i + (lane >> 5); scr[kk * 33 + (lane & 31)] = W[(size_t)(k0 + kk) * N + n0 + (lane & 31)]; }
    LDS_WAIT(); asm volatile("" ::: "memory");
    const int c = lane & 7;
#pragma unroll
    for (int j = 0; j < 4; ++j) { const int n = (lane >> 3) + 8 * j; const LAS float* s = scr + (8 * c) * 33 + n;
        v4u o; o.x = pk2(s[0 * 33], s[1 * 33]); o.y = pk2(s[2 * 33], s[3 * 33]); o.z = pk2(s[4 * 33], s[5 * 33]); o.w = pk2(s[6 * 33], s[7 * 33]);
        *(GAS v4u*)(WT + (size_t)(drow + n) * K + k0 + 8 * c) = o; }
    LDS_WAIT(); asm volatile("" ::: "memory");
}
__device__ __forceinline__ void transpose_item8(const float* W, int K, int N, unsigned char* WT, int drow, LAS float* scr, int kb, int nb, int lane, float sc) {
    const int k0 = 64 * kb, n0 = 32 * nb;
#pragma unroll 8
    for (int i = 0; i < 32; ++i) { const int kk = 2 * i + (lane >> 5); scr[kk * 33 + (lane & 31)] = W[(size_t)(k0 + kk) * N + n0 + (lane & 31)]; }
    LDS_WAIT(); asm volatile("" ::: "memory");
    const int c = lane & 7;
#pragma unroll
    for (int j = 0; j < 4; ++j) { const int n = (lane >> 3) + 8 * j; const LAS float* s = scr + (8 * c) * 33 + n;
        v2u o; o.x = pg8::pk_fp8x4(s[0 * 33] * sc, s[1 * 33] * sc, s[2 * 33] * sc, s[3 * 33] * sc); o.y = pg8::pk_fp8x4(s[4 * 33] * sc, s[5 * 33] * sc, s[6 * 33] * sc, s[7 * 33] * sc);
        *(GAS v2u*)(WT + (size_t)(drow + n) * K + k0 + 8 * c) = o; }
    LDS_WAIT(); asm volatile("" ::: "memory");
}
template <int MODE> __device__ __forceinline__ void conv_matrix8(Frame& F, const float* W, int K, int N, unsigned char* WT, float sc) {
    LAS float* scr = (LAS float*)(F.lds + RING_OFF + F.wave * 16384);
    const int gw = F.vcu * NWAVES + F.wave, NGW = F.G * NWAVES;
    const int nblk = N / 32, nitems = (K / 64) * nblk;
    for (int it = gw; it < nitems; it += NGW) {
        const int kb = it / nblk, nb = it % nblk; int drow;
        if (MODE == 0) drow = 32 * nb;
        else if (MODE == 2) drow = 256 * (nb >> 2) + 32 * (nb & 3);
        else drow = 256 * (nb >> 2) + 128 + 32 * (nb & 3);
        transpose_item8(W, K, N, WT, drow, scr, kb, nb, F.lane, sc);
    }
}
template <int MODE> __device__ __forceinline__ void conv_matrix(Frame& F, const float* W, int K, int N, bf16* WT) {
    LAS float* scr = (LAS float*)(F.lds + RING_OFF + F.wave * 16384);
    const int gw = F.vcu * NWAVES + F.wave, NGW = F.G * NWAVES;
    const int nblk = N / 32, nitems = (K / 64) * nblk;
    for (int it = gw; it < nitems; it += NGW) {
        const int kb = it / nblk, nb = it % nblk; int drow;
        if (MODE == 0) drow = 32 * nb;
        else if (MODE == 1) { if (nb == LR_COL / 32) continue; drow = nb < LR_COL / 32 ? 32 * nb : 32 * (nb - 1); }
        else if (MODE == 2) drow = 256 * (nb >> 2) + 32 * (nb & 3);
        else drow = 256 * (nb >> 2) + 128 + 32 * (nb & 3);
        transpose_item(W, K, N, WT, drow, scr, kb, nb, F.lane);
    }
}
__device__ __forceinline__ void ada_item(Frame& F, unsigned char* ws, const float* cnd, const float* cctx, const float* ada_w, const float* ada_b, int item) {
    const int L = item / 96, c0 = (item % 96) * 128;
    LAS float* sc = (LAS float*)(F.lds + RING_OFF);
    LAS float* red = (LAS float*)(F.lds + RING_OFF + 24576);
    for (int i = F.tid; i < 3 * D; i += NTHR) { const int g = i / D, k = i % D; const float v = g < 2 ? cnd[g * D + k] : cctx[k]; sc[i] = v / (1.0f + __expf(-v)); }
    __syncthreads();
    const float* W = ada_w + (size_t)L * D * 12288 + c0 + 2 * F.lane;
    float a00 = 0.f, a01 = 0.f, a10 = 0.f, a11 = 0.f, a20 = 0.f, a21 = 0.f;
    const int kb = 256 * F.wave;
#pragma unroll 8
    for (int k = kb; k < kb + 256; ++k) { const float2 w = *(const float2*)(W + (size_t)k * 12288); const float s0 = sc[k], s1 = sc[D + k], s2 = sc[2 * D + k];
        a00 += s0 * w.x; a01 += s0 * w.y; a10 += s1 * w.x; a11 += s1 * w.y; a20 += s2 * w.x; a21 += s2 * w.y; }
    red[(F.wave * 3 + 0) * 128 + 2 * F.lane] = a00; red[(F.wave * 3 + 0) * 128 + 2 * F.lane + 1] = a01;
    red[(F.wave * 3 + 1) * 128 + 2 * F.lane] = a10; red[(F.wave * 3 + 1) * 128 + 2 * F.lane + 1] = a11;
    red[(F.wave * 3 + 2) * 128 + 2 * F.lane] = a20; red[(F.wave * 3 + 2) * 128 + 2 * F.lane + 1] = a21;
    __syncthreads();
    if (F.tid < 384) { const int g = F.tid / 128, cc = F.tid % 128; float s = 0.f;
#pragma unroll
        for (int w = 0; w < 8; ++w) s += red[(w * 3 + g) * 128 + cc];
        ((float*)(ws + WS_MOD))[((size_t)L * 3 + g) * 12288 + c0 + cc] = s + ada_b[L * 12288 + c0 + cc]; }
    __syncthreads();
}
__device__ __forceinline__ void p0a_prologue(Frame& F) {
    unsigned char* const ws = PWS();
    { const float* cnd = PIN(1); const float* cctx = PIN(3); const float* ada_w = PIN(4); const float* ada_b = PIN(5);
      for (int it = F.bx; it < 192; it += F.G) ada_item(F, ws, cnd, cctx, ada_w, ada_b, it); }
    const float* const w_in = PIN(6);
    { const int gt = F.bx * NTHR + F.tid, NGT = F.G * NTHR;
      for (int i = gt; i < DEPTH * D * 32; i += NGT) { const int o = i & 31, k = (i >> 5) % D, L = i / (32 * D); ((bf16*)(ws + WS_WLR))[((size_t)L * 32 + o) * D + k] = (bf16)f2bf(w_in[((size_t)L * D + k) * INC + LR_COL + o]); } }
    for (int L = 0; L < DEPTH; ++L) {
        conv_matrix<1>(F, w_in + (size_t)L * D * INC, D, INC, w_in_t(ws, L));
        for (int b = 0; b < 3; ++b) conv_matrix<0>(F, (b == 0 ? PIN(14) : (b == 1 ? PIN(15) : PIN(16))) + (size_t)L * 1024 * D, 1024, D, w_br_t(ws, L, b));
        conv_matrix<0>(F, PIN(18) + (size_t)L * D * D, D, D, w_out_t(ws, L));
    }
    conv_matrix<2>(F, PIN(23), D, FF, (bf16*)w_gu_t(ws, -1)); conv_matrix<3>(F, PIN(24), D, FF, (bf16*)w_gu_t(ws, -1)); conv_matrix<0>(F, PIN(25), FF, D, (bf16*)w_d_t(ws, -1));
    for (int e = 0; e < NE; ++e) {
        conv_matrix8<2>(F, PIN(27) + (size_t)e * D * FF, D, FF, w_gu_t(ws, e), FSC_WGU); conv_matrix8<3>(F, PIN(28) + (size_t)e * D * FF, D, FF, w_gu_t(ws, e), FSC_WGU);
        conv_matrix8<0>(F, PIN(29) + (size_t)e * FF * D, FF, D, w_d_t(ws, e), FSC_WD);
    }
}

__device__ __forceinline__ int row_group(int r) { return r < SEQ ? 0 : (r < NLAT ? 1 : 2); }
__device__ __forceinline__ void load_row(const float* p, int lane, f32x4 (&v)[8]) {
#pragma unroll
    for (int j = 0; j < 8; ++j) v[j] = *(const GAS f32x4*)(p + 4 * lane + 256 * j);
}
__device__ __forceinline__ void store_row(float* p, int lane, const f32x4 (&v)[8]) {
#pragma unroll
    for (int j = 0; j < 8; ++j) *(GAS f32x4*)(p + 4 * lane + 256 * j) = v[j];
}
__device__ __forceinline__ void store_row_bf16(bf16* p, int lane, const f32x4 (&v)[8]) {
#pragma unroll
    for (int j = 0; j < 8; ++j) { v2u w; w.x = pk2(v[j][0], v[j][1]); w.y = pk2(v[j][2], v[j][3]); *(GAS v2u*)(p + 4 * lane + 256 * j) = w; }
}
__device__ __forceinline__ void store_row_fp8(unsigned char* p, int lane, const f32x4 (&v)[8]) {
#pragma unroll
    for (int j = 0; j < 8; ++j) *(GAS unsigned*)(p + 4 * lane + 256 * j) = pg8::pk_fp8x4(pg8::clamp448(v[j][0]), pg8::clamp448(v[j][1]), pg8::clamp448(v[j][2]), pg8::clamp448(v[j][3]));
}
__device__ __forceinline__ void modulate(f32x4 (&v)[8], const float* shift, const float* scale, int lane) {
#pragma unroll
    for (int j = 0; j < 8; ++j) { const f32x4 sh = *(const f32x4*)(shift + 4 * lane + 256 * j), sc = *(const f32x4*)(scale + 4 * lane + 256 * j); v[j] = v[j] * (sc + 1.0f) + sh; }
}
__device__ __forceinline__ void layer_norm_row(f32x4 (&v)[8], const float* g, const float* b, int lane) {
    float s = 0.f;
#pragma unroll
    for (int j = 0; j < 8; ++j) s += (v[j][0] + v[j][1]) + (v[j][2] + v[j][3]);
    const float mean = wave_sum(s) * (1.0f / D); float q = 0.f;
#pragma unroll
    for (int j = 0; j < 8; ++j) { v[j] = v[j] - mean; q += (v[j][0] * v[j][0] + v[j][1] * v[j][1]) + (v[j][2] * v[j][2] + v[j][3] * v[j][3]); }
    const float rstd = 1.0f / sqrtf(wave_sum(q) * (1.0f / D) + LN_EPS);
#pragma unroll
    for (int j = 0; j < 8; ++j) { const f32x4 g4 = *(const f32x4*)(g + 4 * lane + 256 * j), b4 = *(const f32x4*)(b + 4 * lane + 256 * j); v[j] = v[j] * rstd * g4 + b4; }
}
__device__ __forceinline__ void lr_tiles(Frame& F, int L) {
    unsigned char* const ws = PWS(); const bf16* H = (const bf16*)(ws + WS_H); const bf16* W = (const bf16*)(ws + WS_WLR) + (size_t)L * 32 * D; float* LRo = (float*)(ws + WS_LR);
    const int g = F.lane >> 4, l15 = F.lane & 15, gw = F.vcu * NWAVES + F.wave, NGW = F.G * NWAVES;
    for (int task = gw; task < MROWS / 16; task += NGW) {
        const bf16* ap = H + (size_t)(16 * task + l15) * D + 8 * g; const bf16* bp = W + (size_t)l15 * D + 8 * g;
        f32x4 a0 = {0.f, 0.f, 0.f, 0.f}, a1 = {0.f, 0.f, 0.f, 0.f};
#pragma unroll 8
        for (int ks = 0; ks < D / 32; ++ks) { const bf16x8v af = __builtin_bit_cast(bf16x8v, *(const GAS v4u*)(ap + 32 * ks)), b0 = __builtin_bit_cast(bf16x8v, *(const GAS v4u*)(bp + 32 * ks)), b1 = __builtin_bit_cast(bf16x8v, *(const GAS v4u*)(bp + (size_t)16 * D + 32 * ks));
            a0 = __builtin_amdgcn_mfma_f32_16x16x32_bf16(af, b0, a0, 0, 0, 0); a1 = __builtin_amdgcn_mfma_f32_16x16x32_bf16(af, b1, a1, 0, 0, 0); }
#pragma unroll
        for (int i = 0; i < 4; ++i) { float* o = LRo + (size_t)(16 * task + 4 * g + i) * 32 + l15; o[0] = a0[i]; o[16] = a1[i]; }
    }
}
__device__ __forceinline__ void p0b_modulate(Frame& F) {
    unsigned char* const ws = PWS(); const float* const xin = PIN(0); const float* const cin = PIN(2);
    const int gw = F.vcu * NWAVES + F.wave, NGW = F.G * NWAVES;
    for (int r = gw; r < MROWS; r += NGW) {
        f32x4 v[8]; load_row(r < NLAT ? xin + (size_t)r * D : cin + (size_t)(r - NLAT) * D, F.lane, v);
        const float* m = ((float*)(ws + WS_MOD)) + (size_t)row_group(r) * 12288;
        modulate(v, m, m + D, F.lane); store_row_bf16(((bf16*)(ws + WS_H)) + (size_t)r * D, F.lane, v);
    }
}

__device__ __forceinline__ void mix_prep(Frame& F, int L) {
    unsigned char* const ws = PWS();
    const int gt = F.bx * NTHR + F.tid, NGT = F.G * NTHR;
    const float* cw = PIN(7) + (size_t)L * 3 * 1024;
    for (int i = gt; i < MROWS * 128; i += NGT) {
        const int r = i >> 7, c8 = (i & 127) * 8;
        const int t = r < NLAT ? (r & (SEQ - 1)) : ((r - NLAT) & (CTXL - 1)), T = r < NLAT ? SEQ : CTXL;
        float acc[8];
#pragma unroll
        for (int j = 0; j < 8; ++j) acc[j] = 0.f;
#pragma unroll
        for (int k = 0; k < 3; ++k) { const int tt = t + k - 1; if (tt < 0 || tt >= T) continue;
            const bf16* up = ((bf16*)(ws + WS_U)) + (size_t)(r + k - 1) * NU; const v4u a = *(const GAS v4u*)(up + U_CC + c8), b = *(const GAS v4u*)(up + U_CX + c8);
            const f32x4 w0 = *(const f32x4*)(cw + k * 1024 + c8), w1 = *(const f32x4*)(cw + k * 1024 + c8 + 4);
            acc[0] += w0[0] * bflo(a.x) * bflo(b.x); acc[1] += w0[1] * bfhi(a.x) * bfhi(b.x); acc[2] += w0[2] * bflo(a.y) * bflo(b.y); acc[3] += w0[3] * bfhi(a.y) * bfhi(b.y);
            acc[4] += w1[0] * bflo(a.z) * bflo(b.z); acc[5] += w1[1] * bfhi(a.z) * bfhi(b.z); acc[6] += w1[2] * bflo(a.w) * bflo(b.w); acc[7] += w1[3] * bfhi(a.w) * bfhi(b.w); }
        const v4u ab = *(const GAS v4u*)(((bf16*)(ws + WS_U)) + (size_t)r * NU + U_CB + c8);
        v4u o; o.x = pk2(acc[0] * bflo(ab.x), acc[1] * bfhi(ab.x)); o.y = pk2(acc[2] * bflo(ab.y), acc[3] * bfhi(ab.y)); o.z = pk2(acc[4] * bflo(ab.z), acc[5] * bfhi(ab.z)); o.w = pk2(acc[6] * bflo(ab.w), acc[7] * bfhi(ab.w));
        *(GAS v4u*)(((bf16*)(ws + WS_Y)) + (size_t)r * 1024 + c8) = o;
    }
}
__device__ __forceinline__ void sum_partials(f32x4 (&v)[8], const float* P, int ns, const float* res, const float* gvec, int lane) {
#pragma unroll
    for (int j = 0; j < 8; ++j) v[j] = (f32x4){0.f, 0.f, 0.f, 0.f};
    for (int s = 0; s < ns; ++s) {
#pragma unroll
        for (int j = 0; j < 8; ++j) v[j] += *(const GAS f32x4*)(P + (size_t)s * 512 * D + 4 * lane + 256 * j); }
#pragma unroll
    for (int j = 0; j < 8; ++j) { const f32x4 r4 = *(const GAS f32x4*)(res + 4 * lane + 256 * j), g4 = *(const f32x4*)(gvec + 4 * lane + 256 * j); v[j] = r4 * ALPHA + g4 * v[j]; }
}
__device__ __forceinline__ void ln1_phase(Frame& F, int L, int M) {
    unsigned char* const ws = PWS(); const float* const lng = PIN(19) + L * D; const float* const lnb = PIN(20) + L * D; const float* const router = PIN(26); const float* const cin = PIN(2);
    const int gw = F.vcu * NWAVES + F.wave, NGW = F.G * NWAVES;
    for (int r = gw; r < M; r += NGW) {
        const float* m = ((float*)(ws + WS_MOD)) + ((size_t)L * 3 + row_group(r)) * 12288;
        f32x4 v[8];
        if (r < NLAT) load_row(((float*)(ws + WS_PRE)) + (size_t)r * D, F.lane, v);
        else sum_partials(v, ((float*)(ws + WS_PART)) + (size_t)(r - NLAT) * D, 8, cin + (size_t)(r - NLAT) * D, m + 2 * D, F.lane);
        layer_norm_row(v, lng, lnb, F.lane);
        store_row(((float*)(ws + WS_XL)) + (size_t)r * D, F.lane, v);
        modulate(v, m + 3 * D, m + 4 * D, F.lane);
        if (L == 0) store_row_bf16(((bf16*)(ws + WS_H)) + (size_t)r * D, F.lane, v); else store_row_fp8(ws + WS_H + (size_t)r * D, F.lane, v);
        if (L == 1) {
            float lg[8];
#pragma unroll
            for (int e = 0; e < 8; ++e) lg[e] = 0.f;
#pragma unroll
            for (int j = 0; j < 8; ++j)
#pragma unroll
                for (int i = 0; i < 4; ++i) { const float* rp = router + (size_t)(4 * F.lane + 256 * j + i) * 8; const f32x4 w0 = *(const f32x4*)rp, w1 = *(const f32x4*)(rp + 4); const float hv = v[j][i];
                    lg[0] += hv * w0[0]; lg[1] += hv * w0[1]; lg[2] += hv * w0[2]; lg[3] += hv * w0[3]; lg[4] += hv * w1[0]; lg[5] += hv * w1[1]; lg[6] += hv * w1[2]; lg[7] += hv * w1[3]; }
#pragma unroll
            for (int e = 0; e < 8; ++e) lg[e] = wave_sum(lg[e]);
            int e0 = 0; float v0 = lg[0];
#pragma unroll
            for (int e = 1; e < 8; ++e) if (lg[e] > v0) { v0 = lg[e]; e0 = e; }
            int e1 = -1; float v1 = -INFINITY;
#pragma unroll
            for (int e = 0; e < 8; ++e) if (e != e0 && lg[e] > v1) { v1 = lg[e]; e1 = e; }
            if (F.lane == 0) {
                const float w0 = 1.0f / (1.0f + __expf(v1 - v0)), w1 = 1.0f - w0;
                const unsigned p0 = __hip_atomic_fetch_add(((gu32*)(ws + WS_CTL)) + CW_MOECNT + 64 * e0, 1u, RLX_AGENT), p1 = __hip_atomic_fetch_add(((gu32*)(ws + WS_CTL)) + CW_MOECNT + 64 * e1, 1u, RLX_AGENT);
                ((int*)(ws + WS_TOK))[e0 * NLAT + p0] = r; ((int*)(ws + WS_TOK))[e1 * NLAT + p1] = r;
                unsigned* rt = ((unsigned*)(ws + WS_ROUTE)) + (size_t)r * 8; rt[0] = e0; rt[1] = p0; rt[2] = __float_as_uint(w0); rt[3] = e1; rt[4] = p1; rt[5] = __float_as_uint(w1);
            }
        }
    }
}
__device__ __forceinline__ void moe_prefix(unsigned char* ws, unsigned (&cnt)[8], int (&pp)[9]) {
    pp[0] = 0;
#pragma unroll
    for (int e = 0; e < 8; ++e) { cnt[e] = __hip_atomic_load(((gu32*)(ws + WS_CTL)) + CW_MOECNT + 64 * e, RLX_AGENT); pp[e + 1] = pp[e] + (int)((cnt[e] + 255u) >> 8); }
}
__device__ __forceinline__ void moe_gather(Frame& F) {
    unsigned char* const ws = PWS();
    const int gw = F.vcu * NWAVES + F.wave, NGW = F.G * NWAVES;
    unsigned cnt[8]; int pp[9]; moe_prefix(ws, cnt, pp);
    for (int s = gw; s < pp[8] * 256; s += NGW) {
        const int p = s >> 8; int e = 0, base = 0; unsigned ce = cnt[0];
#pragma unroll
        for (int k = 1; k < 8; ++k) if (p >= pp[k]) { e = k; base = pp[k]; ce = cnt[k]; }
        const unsigned pos = (unsigned)(s - base * 256);
        GAS v4u* dst = (GAS v4u*)(ws + WS_GLA + (size_t)s * D) + F.lane;
        if (pos < ce) { const int tkn = ((int*)(ws + WS_TOK))[e * NLAT + pos]; const GAS v4u* src = (const GAS v4u*)(ws + WS_H + (size_t)tkn * D) + F.lane;
#pragma unroll
            for (int j = 0; j < 2; ++j) dst[64 * j] = src[64 * j]; }
        else {
#pragma unroll
            for (int j = 0; j < 2; ++j) dst[64 * j] = (v4u){0u, 0u, 0u, 0u}; }
    }
}
__device__ __forceinline__ void ln2_dense(Frame& F, int L) {
    unsigned char* const ws = PWS(); const float* const lng = PIN(21) + L * D; const float* const lnb = PIN(22) + L * D;
    const int gw = F.vcu * NWAVES + F.wave, NGW = F.G * NWAVES;
    for (int r = gw; r < MROWS; r += NGW) {
        f32x4 v[8];
        if (r < NLAT) load_row(((float*)(ws + WS_PRE)) + (size_t)r * D, F.lane, v);
        else sum_partials(v, ((float*)(ws + WS_PART)) + (size_t)(r - NLAT) * D, 11, ((float*)(ws + WS_XL)) + (size_t)r * D, ((float*)(ws + WS_MOD)) + ((size_t)L * 3 + 2) * 12288 + 5 * D, F.lane);
        layer_norm_row(v, lng, lnb, F.lane);
        store_row(((float*)(ws + WS_XL)) + (size_t)r * D, F.lane, v);
        const float* m = ((float*)(ws + WS_MOD)) + ((size_t)(L + 1) * 3 + row_group(r)) * 12288;
        modulate(v, m, m + D, F.lane); store_row_bf16(((bf16*)(ws + WS_H)) + (size_t)r * D, F.lane, v);
    }
}
__device__ __forceinline__ void ln2_moe(Frame& F, int L) {
    unsigned char* const ws = PWS(); const float* const lng = PIN(21) + L * D; const float* const lnb = PIN(22) + L * D; float* const outp = POUT();
    const int gw = F.vcu * NWAVES + F.wave, NGW = F.G * NWAVES;
    unsigned cnt[8]; int pp[9]; moe_prefix(ws, cnt, pp);
    for (int r = gw; r < NLAT; r += NGW) {
        const unsigned* rt = ((unsigned*)(ws + WS_ROUTE)) + (size_t)r * 8; const int e0 = rt[0], e1 = rt[3]; const float w0 = __uint_as_float(rt[2]), w1 = __uint_as_float(rt[5]);
        int b0 = 0, b1 = 0;
#pragma unroll
        for (int k = 1; k < 8; ++k) { if (e0 >= k) b0 = pp[k]; if (e1 >= k) b1 = pp[k]; }
        const size_t s0 = (size_t)b0 * 256 + rt[1], s1 = (size_t)b1 * 256 + rt[4];
        f32x4 v[8], y0[8], y1[8]; load_row(((float*)(ws + WS_XL)) + (size_t)r * D, F.lane, v); load_row(((float*)(ws + WS_Z)) + s0 * D, F.lane, y0); load_row(((float*)(ws + WS_Z)) + s1 * D, F.lane, y1);
        const float* g2 = ((float*)(ws + WS_MOD)) + ((size_t)L * 3 + row_group(r)) * 12288 + 5 * D;
#pragma unroll
        for (int j = 0; j < 8; ++j) { const f32x4 g4 = *(const f32x4*)(g2 + 4 * F.lane + 256 * j); v[j] = v[j] * ALPHA + g4 * (y0[j] * w0 + y1[j] * w1); }
        layer_norm_row(v, lng, lnb, F.lane);
        store_row(outp + (size_t)r * D, F.lane, v);
    }
}

constexpr int GLA_NCH = 68;
constexpr size_t GLA_DST_BYTES = (size_t)16 * GLA_NCH * 256 * 128 * 2;
#define GLA_DST(ws) ((bf16*)((ws) + WS_GLA))
#define GLA_DEC(ws) ((float*)((ws) + WS_GLA + GLA_DST_BYTES))
__device__ __forceinline__ int gla_chunk_row0(int b, int cn) { return cn < 4 ? NLAT + CTXL * b + 64 * cn : SEQ * b + 64 * (cn - 4); }
__device__ __forceinline__ int gla_scan_idx(int cn, int dir) { return dir ? (cn < 4 ? 3 - cn : 71 - cn) : cn; }
__device__ __forceinline__ float log_sigmoid16(float z) { return (fminf(z, 0.f) - __logf(1.0f + __expf(-fabsf(z)))) * (1.0f / 16.0f); }
__device__ __forceinline__ bf16x8v tr_frag(unsigned addr, unsigned pitch4) {
    v2u lo, hi;
    asm volatile("ds_read_b64_tr_b16 %0, %2\n\tds_read_b64_tr_b16 %1, %3\n\ts_waitcnt lgkmcnt(0)" : "=&v"(lo), "=&v"(hi) : "v"(addr), "v"(addr + pitch4) : "memory");
    v4u r; r.x = lo.x; r.y = lo.y; r.z = hi.x; r.w = hi.y; return __builtin_bit_cast(bf16x8v, r);
}
__device__ __forceinline__ unsigned lds_addr(LAS unsigned char* p) { return (unsigned)(size_t)p; }
constexpr int GL_BC = 0;
constexpr int GL_TOT = 65536;
constexpr int GL_V = 71680;
constexpr int GL_A = 105472;
constexpr int GL_STG = 105472;
constexpr int GL_RED = 124928;
constexpr int GL_QK_PITCH = 272, GL_V_PITCH = 528, GL_A_PITCH = 144;
static_assert(GL_STG + 25600 <= RING_BYTES && GL_V + 64 * GL_V_PITCH <= GL_A && GL_TOT + 4096 + 1024 <= GL_V && 4 * 64 * GL_QK_PITCH <= GL_V, "GLA LDS map");

__device__ __forceinline__ void gla_decays(Frame& F, unsigned char* ws, const float* wgf, const float* bgf, const float* wgb, const float* bgb, int row0, int h, int d0, int d1) {
    LAS float* lr = (LAS float*)(F.lds + GL_STG); LAS float* wg = lr + 64 * 32; LAS float* bg = wg + 2 * 16 * 128;
    LAS float* bc = (LAS float*)(F.lds + GL_BC); LAS float* tot = (LAS float*)(F.lds + GL_TOT);
    { const int t = F.tid >> 3, o4 = (F.tid & 7) * 4; *(LAS f32x4*)(lr + t * 32 + o4) = *(const GAS f32x4*)(((float*)(ws + WS_LR)) + (size_t)(row0 + t) * 32 + o4); }
    for (int i = F.tid; i < 1024; i += NTHR) { const int dir = i >> 9, o = (i >> 5) & 15, d4 = (i & 31) * 4; *(LAS f32x4*)(wg + (dir * 16 + o) * 128 + d4) = *(const GAS f32x4*)((dir ? wgb : wgf) + o * 512 + h * 128 + d4); }
    if (F.tid < 64) { const int dir = F.tid >> 5, d4 = (F.tid & 31) * 4; *(LAS f32x4*)(bg + dir * 128 + d4) = *(const GAS f32x4*)((dir ? bgb : bgf) + h * 128 + d4); }
    __syncthreads();
    { const int t = F.tid >> 3, dg = (F.tid & 7) * 16;
      for (int dir = d0; dir < d1; ++dir) {
          f32x4 z[4];
#pragma unroll
          for (int j = 0; j < 4; ++j) z[j] = *(LAS f32x4*)(bg + dir * 128 + dg + 4 * j);
#pragma unroll
          for (int o = 0; o < 16; ++o) { const float l = lr[t * 32 + dir * 16 + o];
#pragma unroll
              for (int j = 0; j < 4; ++j) z[j] += l * *(LAS f32x4*)(wg + (dir * 16 + o) * 128 + dg + 4 * j); }
#pragma unroll
          for (int j = 0; j < 4; ++j) { f32x4 g; g[0] = log_sigmoid16(z[j][0]); g[1] = log_sigmoid16(z[j][1]); g[2] = log_sigmoid16(z[j][2]); g[3] = log_sigmoid16(z[j][3]); *(LAS f32x4*)(bc + dir * 8192 + t * 128 + dg + 4 * j) = g; } } }
    __syncthreads();
    { const int d = F.tid & 127, seg = F.tid >> 7;
      for (int dir = d0; dir < d1; ++dir) { float a = 0.f;
#pragma unroll
          for (int i = 0; i < 16; ++i) { const int s = seg * 16 + i, t = dir ? 63 - s : s; a += bc[dir * 8192 + t * 128 + d]; bc[dir * 8192 + t * 128 + d] = a; }
          tot[(dir * 4 + seg) * 128 + d] = a; } }
    __syncthreads();
    { const int d = F.tid & 127, seg = F.tid >> 7;
      for (int dir = d0; dir < d1; ++dir) { float pre = 0.f, all = 0.f;
#pragma unroll
          for (int s2 = 0; s2 < 4; ++s2) { const float v = tot[(dir * 4 + s2) * 128 + d]; all += v; if (s2 < seg) pre += v; }
          if (seg == 0) tot[1024 + dir * 128 + d] = all;
          if (seg > 0) {
#pragma unroll
              for (int i = 0; i < 16; ++i) { const int s = seg * 16 + i, t = dir ? 63 - s : s; bc[dir * 8192 + t * 128 + d] += pre; } } } }
    __syncthreads();
}
__device__ __forceinline__ void gla_stage_v(Frame& F, const bf16* U, int row0, int h) {
#pragma unroll
    for (int i = 0; i < 4; ++i) { const int p = F.tid + NTHR * i, t = p >> 5, e8 = (p & 31) * 8;
        *(LAS v4u*)(F.lds + GL_V + t * GL_V_PITCH + e8 * 2) = *(const GAS v4u*)(U + (size_t)(row0 + t) * NU + U_GV + h * 256 + e8); }
}
__device__ __forceinline__ void gla_g1(Frame& F, int L) {
    unsigned char* const ws = PWS(); const bf16* U = (const bf16*)(ws + WS_U);
    const float* wgf = PIN(8) + (size_t)L * 16 * 512; const float* bgf = PIN(9) + L * 512; const float* wgb = PIN(10) + (size_t)L * 16 * 512; const float* bgb = PIN(11) + L * 512;
    const int g = F.lane >> 4, q4 = (F.lane & 15) >> 2, p = F.lane & 3, l15 = F.lane & 15;
    for (int task = F.vcu; task < 16 * GLA_NCH; task += F.G) {
        const int cn = task % GLA_NCH, ch = task / GLA_NCH, h = ch & 3, dir = (ch >> 2) & 1, b = ch >> 3;
        const int row0 = gla_chunk_row0(b, cn), n = gla_scan_idx(cn, dir);
        __syncthreads();
        gla_stage_v(F, U, row0, h);
        v4u kp[2];
#pragma unroll
        for (int i = 0; i < 2; ++i) { const int pc = F.tid + NTHR * i, t = pc >> 4, d8 = (pc & 15) * 8; kp[i] = *(const GAS v4u*)(U + (size_t)(row0 + t) * NU + U_GK + h * 128 + d8); }
        gla_decays(F, ws, wgf, bgf, wgb, bgb, row0, h, dir, dir + 1);
        LAS float* bc = (LAS float*)(F.lds + GL_BC) + dir * 8192; LAS float* bl = (LAS float*)(F.lds + GL_TOT) + 1024 + dir * 128;
        if (F.tid < 128) GLA_DEC(ws)[((size_t)ch * GLA_NCH + n) * 128 + F.tid] = __expf(bl[F.tid]);
        LAS unsigned char* ke = F.lds + GL_BC + (dir ? 0 : 32768);
#pragma unroll
        for (int i = 0; i < 2; ++i) { const int pc = F.tid + NTHR * i, t = pc >> 4, d8 = (pc & 15) * 8;
            const f32x4 b0 = *(LAS f32x4*)(bc + t * 128 + d8), b1 = *(LAS f32x4*)(bc + t * 128 + d8 + 4), l0 = *(LAS f32x4*)(bl + d8), l1 = *(LAS f32x4*)(bl + d8 + 4);
            v4u o; o.x = pk2(bflo(kp[i].x) * __expf(l0[0] - b0[0]), bfhi(kp[i].x) * __expf(l0[1] - b0[1])); o.y = pk2(bflo(kp[i].y) * __expf(l0[2] - b0[2]), bfhi(kp[i].y) * __expf(l0[3] - b0[3]));
            o.z = pk2(bflo(kp[i].z) * __expf(l1[0] - b1[0]), bfhi(kp[i].z) * __expf(l1[1] - b1[1])); o.w = pk2(bflo(kp[i].w) * __expf(l1[2] - b1[2]), bfhi(kp[i].w) * __expf(l1[3] - b1[3]));
            *(LAS v4u*)(ke + t * GL_QK_PITCH + d8 * 2) = o; }
        __syncthreads();
        f32x4 acc[8][2];
#pragma unroll
        for (int mt = 0; mt < 8; ++mt) { acc[mt][0] = (f32x4){0.f, 0.f, 0.f, 0.f}; acc[mt][1] = (f32x4){0.f, 0.f, 0.f, 0.f}; }
        const unsigned ke_a = lds_addr(ke) + GL_QK_PITCH * (8 * g + q4) + 8 * p, v_a = lds_addr(F.lds + GL_V) + GL_V_PITCH * (8 * g + q4) + 8 * p + 2 * (32 * F.wave);
#pragma unroll
        for (int ks = 0; ks < 2; ++ks) {
            bf16x8v bv[2];
#pragma unroll
            for (int nt = 0; nt < 2; ++nt) bv[nt] = tr_frag(v_a + GL_V_PITCH * 32 * ks + 32 * nt, GL_V_PITCH * 4);
#pragma unroll
            for (int mt = 0; mt < 8; ++mt) { const bf16x8v av = tr_frag(ke_a + GL_QK_PITCH * 32 * ks + 32 * mt, GL_QK_PITCH * 4);
                acc[mt][0] = __builtin_amdgcn_mfma_f32_16x16x32_bf16(av, bv[0], acc[mt][0], 0, 0, 0); acc[mt][1] = __builtin_amdgcn_mfma_f32_16x16x32_bf16(av, bv[1], acc[mt][1], 0, 0, 0); } }
        bf16* dst = GLA_DST(ws) + ((size_t)ch * GLA_NCH + n) * 256 * 128;
#pragma unroll
        for (int mt = 0; mt < 8; ++mt)
#pragma unroll
            for (int nt = 0; nt < 2; ++nt) { const int e = 32 * F.wave + 16 * nt + l15, d = 16 * mt + 4 * g; v2u w; w.x = pk2(acc[mt][nt][0], acc[mt][nt][1]); w.y = pk2(acc[mt][nt][2], acc[mt][nt][3]);
                *(GAS v2u*)(dst + (size_t)e * 128 + d) = w; }
    }
}
__device__ __forceinline__ void gla_g2(Frame& F) {
    unsigned char* const ws = PWS();
    const int NT = F.G * NTHR;
    for (int idx = F.bx * NTHR + F.tid; idx < 16 * 256 * 32; idx += NT) {
        const int ch = idx >> 13, e = (idx >> 5) & 255, d4 = (idx & 31) * 4;
        bf16* p = GLA_DST(ws) + (size_t)ch * GLA_NCH * 32768 + (size_t)e * 128 + d4; const float* dc = GLA_DEC(ws) + (size_t)ch * GLA_NCH * 128 + d4;
        f32x4 S = {0.f, 0.f, 0.f, 0.f};
#pragma unroll 4
        for (int n = 0; n < GLA_NCH; ++n) { const v2u x = *(const GAS v2u*)(p + (size_t)n * 32768); const f32x4 a = *(const GAS f32x4*)(dc + n * 128);
            v2u w; w.x = pk2(S[0], S[1]); w.y = pk2(S[2], S[3]); *(GAS v2u*)(p + (size_t)n * 32768) = w;
            S[0] = a[0] * S[0] + bflo(x.x); S[1] = a[1] * S[1] + bfhi(x.x); S[2] = a[2] * S[2] + bflo(x.y); S[3] = a[3] * S[3] + bfhi(x.y); }
    }
}
__device__ __forceinline__ void gla_g3(Frame& F, int L) {
    unsigned char* const ws = PWS(); const bf16* U = (const bf16*)(ws + WS_U);
    const float* wgf = PIN(8) + (size_t)L * 16 * 512; const float* bgf = PIN(9) + L * 512; const float* wgb = PIN(10) + (size_t)L * 16 * 512; const float* bgb = PIN(11) + L * 512;
    const float* ng = PIN(12) + L * 256;
    const int g = F.lane >> 4, q4 = (F.lane & 15) >> 2, p = F.lane & 3, l15 = F.lane & 15;
    for (int task = F.vcu; task < 8 * GLA_NCH; task += F.G) {
        const int cn = task % GLA_NCH, bh = task / GLA_NCH, h = bh & 3, b = bh >> 2;
        const int row0 = gla_chunk_row0(b, cn);
        __syncthreads();
        gla_stage_v(F, U, row0, h);
        v4u kp[2], qp[2];
#pragma unroll
        for (int i = 0; i < 2; ++i) { const int pc = F.tid + NTHR * i, t = pc >> 4, d8 = (pc & 15) * 8; const bf16* up = U + (size_t)(row0 + t) * NU + h * 128 + d8; kp[i] = *(const GAS v4u*)(up + U_GK); qp[i] = *(const GAS v4u*)(up + U_GQ); }
        gla_decays(F, ws, wgf, bgf, wgb, bgb, row0, h, 0, 2);
        v4u im[2][4];
        { LAS float* bc = (LAS float*)(F.lds + GL_BC);
#pragma unroll
          for (int i = 0; i < 2; ++i) { const int pc = F.tid + NTHR * i, t = pc >> 4, d8 = (pc & 15) * 8;
#pragma unroll
              for (int dir = 0; dir < 2; ++dir) { const f32x4 b0 = *(LAS f32x4*)(bc + dir * 8192 + t * 128 + d8), b1 = *(LAS f32x4*)(bc + dir * 8192 + t * 128 + d8 + 4);
                  float ep[8], en[8];
#pragma unroll
                  for (int j = 0; j < 4; ++j) { ep[j] = __expf(b0[j]); ep[4 + j] = __expf(b1[j]); en[j] = __expf(-b0[j]); en[4 + j] = __expf(-b1[j]); }
                  v4u qo, ko;
                  qo.x = pk2(bflo(qp[i].x) * ep[0], bfhi(qp[i].x) * ep[1]); qo.y = pk2(bflo(qp[i].y) * ep[2], bfhi(qp[i].y) * ep[3]); qo.z = pk2(bflo(qp[i].z) * ep[4], bfhi(qp[i].z) * ep[5]); qo.w = pk2(bflo(qp[i].w) * ep[6], bfhi(qp[i].w) * ep[7]);
                  ko.x = pk2(bflo(kp[i].x) * en[0], bfhi(kp[i].x) * en[1]); ko.y = pk2(bflo(kp[i].y) * en[2], bfhi(kp[i].y) * en[3]); ko.z = pk2(bflo(kp[i].z) * en[4], bfhi(kp[i].z) * en[5]); ko.w = pk2(bflo(kp[i].w) * en[6], bfhi(kp[i].w) * en[7]);
                  im[i][2 * dir] = qo; im[i][2 * dir + 1] = ko; } } }
        __syncthreads();
#pragma unroll
        for (int i = 0; i < 2; ++i) { const int pc = F.tid + NTHR * i, t = pc >> 4, d8 = (pc & 15) * 8;
#pragma unroll
            for (int k = 0; k < 4; ++k) *(LAS v4u*)(F.lds + GL_BC + k * 64 * GL_QK_PITCH + t * GL_QK_PITCH + d8 * 2) = im[i][k]; }
        __syncthreads();
        { const int dir = F.wave >> 2, nt = F.wave & 3;
          LAS unsigned char* qi = F.lds + GL_BC + (2 * dir) * 64 * GL_QK_PITCH; LAS unsigned char* ki = qi + 64 * GL_QK_PITCH;
          bf16x8v qf[4];
#pragma unroll
          for (int ks = 0; ks < 4; ++ks) qf[ks] = *(LAS bf16x8v*)(qi + (16 * nt + l15) * GL_QK_PITCH + (32 * ks + 8 * g) * 2);
#pragma unroll
          for (int mt = 0; mt < 4; ++mt) { f32x4 a = {0.f, 0.f, 0.f, 0.f};
              const bool live = dir ? (mt >= nt) : (mt <= nt);
              if (live) {
#pragma unroll
                  for (int ks = 0; ks < 4; ++ks) { const bf16x8v kf = *(LAS bf16x8v*)(ki + (16 * mt + l15) * GL_QK_PITCH + (32 * ks + 8 * g) * 2); a = __builtin_amdgcn_mfma_f32_16x16x32_bf16(kf, qf[ks], a, 0, 0, 0); } }
              const int tau = 16 * nt + l15, s0 = 16 * mt + 4 * g;
#pragma unroll
              for (int i = 0; i < 4; ++i) { const bool keep = dir ? (s0 + i >= tau) : (s0 + i <= tau); if (!keep) a[i] = 0.f; }
              v2u w; w.x = pk2(a[0], a[1]); w.y = pk2(a[2], a[3]);
              *(LAS v2u*)(F.lds + GL_A + dir * 64 * GL_A_PITCH + tau * GL_A_PITCH + s0 * 2) = w; } }
        __syncthreads();
        f32x4 acc[2][4];
#pragma unroll
        for (int mt = 0; mt < 2; ++mt)
#pragma unroll
            for (int nt = 0; nt < 4; ++nt) acc[mt][nt] = (f32x4){0.f, 0.f, 0.f, 0.f};
        { const unsigned v_a = lds_addr(F.lds + GL_V) + GL_V_PITCH * (8 * g + q4) + 8 * p + 2 * (32 * F.wave);
#pragma unroll
          for (int ks = 0; ks < 2; ++ks) { bf16x8v vf[2];
#pragma unroll
              for (int mt = 0; mt < 2; ++mt) vf[mt] = tr_frag(v_a + GL_V_PITCH * 32 * ks + 32 * mt, GL_V_PITCH * 4);
#pragma unroll
              for (int dir = 0; dir < 2; ++dir)
#pragma unroll
                  for (int nt = 0; nt < 4; ++nt) { const bf16x8v af = *(LAS bf16x8v*)(F.lds + GL_A + dir * 64 * GL_A_PITCH + (16 * nt + l15) * GL_A_PITCH + (32 * ks + 8 * g) * 2);
                      acc[0][nt] = __builtin_amdgcn_mfma_f32_16x16x32_bf16(vf[0], af, acc[0][nt], 0, 0, 0); acc[1][nt] = __builtin_amdgcn_mfma_f32_16x16x32_bf16(vf[1], af, acc[1][nt], 0, 0, 0); } } }
#pragma unroll
        for (int dir = 0; dir < 2; ++dir) { const int ch = (b * 2 + dir) * 4 + h, n = gla_scan_idx(cn, dir);
            const bf16* st = GLA_DST(ws) + ((size_t)ch * GLA_NCH + n) * 32768; LAS unsigned char* qi = F.lds + GL_BC + (2 * dir) * 64 * GL_QK_PITCH;
#pragma unroll
            for (int ks = 0; ks < 4; ++ks) { bf16x8v sf[2];
#pragma unroll
                for (int mt = 0; mt < 2; ++mt) sf[mt] = __builtin_bit_cast(bf16x8v, *(const GAS v4u*)(st + (size_t)(32 * F.wave + 16 * mt + l15) * 128 + 32 * ks + 8 * g));
#pragma unroll
                for (int nt = 0; nt < 4; ++nt) { const bf16x8v qf = *(LAS bf16x8v*)(qi + (16 * nt + l15) * GL_QK_PITCH + (32 * ks + 8 * g) * 2);
                    acc[0][nt] = __builtin_amdgcn_mfma_f32_16x16x32_bf16(sf[0], qf, acc[0][nt], 0, 0, 0); acc[1][nt] = __builtin_amdgcn_mfma_f32_16x16x32_bf16(sf[1], qf, acc[1][nt], 0, 0, 0); } } }
        LAS float* red = (LAS float*)(F.lds + GL_RED);
#pragma unroll
        for (int nt = 0; nt < 4; ++nt) { float s = 0.f;
#pragma unroll
            for (int mt = 0; mt < 2; ++mt)
#pragma unroll
                for (int i = 0; i < 4; ++i) s += acc[mt][nt][i] * acc[mt][nt][i];
            s += __shfl_xor(s, 16); s += __shfl_xor(s, 32);
            if (g == 0) red[F.wave * 64 + 16 * nt + l15] = s; }
        __syncthreads();
#pragma unroll
        for (int nt = 0; nt < 4; ++nt) { const int tau = 16 * nt + l15; float s = 0.f;
#pragma unroll
            for (int w = 0; w < 8; ++w) s += red[w * 64 + tau];
            const float rs = 1.0f / sqrtf(s * (1.0f / 256.0f) + LN_EPS); const size_t row = (size_t)(row0 + tau);
#pragma unroll
            for (int mt = 0; mt < 2; ++mt) { const int e = 32 * F.wave + 16 * mt + 4 * g;
                const v2u rw = *(const GAS v2u*)(U + row * NU + U_GR + h * 256 + e); const f32x4 g4 = *(const f32x4*)(ng + e);
                const float r0 = bflo(rw.x), r1 = bfhi(rw.x), r2 = bflo(rw.y), r3 = bfhi(rw.y);
                v2u w; w.x = pk2(acc[mt][nt][0] * rs * g4[0] * (r0 / (1.0f + __expf(-r0))), acc[mt][nt][1] * rs * g4[1] * (r1 / (1.0f + __expf(-r1))));
                w.y = pk2(acc[mt][nt][2] * rs * g4[2] * (r2 / (1.0f + __expf(-r2))), acc[mt][nt][3] * rs * g4[3] * (r3 / (1.0f + __expf(-r3))));
                *(GAS v2u*)(((bf16*)(ws + WS_Y + (size_t)MROWS * 1024 * 2)) + row * 1024 + h * 256 + e) = w; } }
    }
}

constexpr int NA_VPITCH = 272, NA_VIMG = 32 * NA_VPITCH;
__device__ __forceinline__ void na_mfma(Frame& F, int L) {
    unsigned char* const ws = PWS(); const bf16* U = (const bf16*)(ws + WS_U); bf16* YN = (bf16*)(ws + WS_Y + (size_t)MROWS * 2048 * 2);
    const float* rpbL = PIN(13) + (size_t)L * 8 * 15 * 31;
    const int g = F.lane >> 4, q4 = (F.lane & 15) >> 2, p = F.lane & 3, l15 = F.lane & 15;
    LAS unsigned char* vimg = F.lds + RING_OFF + F.wave * NA_VIMG;
    const unsigned v_a = lds_addr(vimg) + NA_VPITCH * (4 * g + q4) + 8 * p;
    const int gw = F.vcu * NWAVES + F.wave, NGW = F.G * NWAVES;
    const int T_lat = 2 * 8 * 64 * 4, T_all = T_lat + (L == 0 ? 2 * 8 * 16 : 0);
    for (int task = gw; task < T_all; task += NGW) {
        const bool isctx = task >= T_lat;
        int b, h, r = 0, c0 = 0, qrow0;
        if (!isctx) { const int ct = task & 3; r = (task >> 2) & 63; h = (task >> 8) & 7; b = task >> 11; c0 = 16 * ct; qrow0 = b * SEQ + r * 64 + c0; }
        else { const int tt = task - T_lat, qt = tt & 15; h = (tt >> 4) & 7; b = tt >> 7; qrow0 = NLAT + CTXL * b + 16 * qt; }
        const int rs = min(max(r - 4, 0), 56), kc0 = min(max(c0 - 8, 0), 32);
        const int ctx0 = NLAT + CTXL * b;
        const int kb_lo = isctx ? 8 : 0;
        bf16x8v qf[4];
#pragma unroll
        for (int ks = 0; ks < 4; ++ks) qf[ks] = __builtin_bit_cast(bf16x8v, *(const GAS v4u*)(U + (size_t)(qrow0 + l15) * NU + U_NQ + h * 128 + 32 * ks + 8 * g));
        f32x4 s[32];
#pragma unroll
        for (int kb = 0; kb < 16; ++kb) {
            if (kb >= kb_lo) {
                const int tok0 = kb < 8 ? b * SEQ + (rs + kb) * 64 + kc0 : ctx0 + 32 * (kb - 8);
#pragma unroll
                for (int hf = 0; hf < 2; ++hf) { const bf16* kp = U + (size_t)(tok0 + 16 * hf + l15) * NU + U_NK + h * 128 + 8 * g; f32x4 a = {0.f, 0.f, 0.f, 0.f};
#pragma unroll
                    for (int ks = 0; ks < 4; ++ks) { const bf16x8v kf = __builtin_bit_cast(bf16x8v, *(const GAS v4u*)(kp + 32 * ks)); a = __builtin_amdgcn_mfma_f32_16x16x32_bf16(kf, qf[ks], a, 0, 0, 0); }
                    s[2 * kb + hf] = a; }
                asm volatile("" ::: "memory");
            } else { s[2 * kb] = (f32x4){-INFINITY, -INFINITY, -INFINITY, -INFINITY}; s[2 * kb + 1] = s[2 * kb]; }
        }
        if (!isctx) {
            const int qc = c0 + l15, cs = min(max(qc - 8, 0), 48); const float* rp = rpbL + (size_t)h * 15 * 31;
#pragma unroll
            for (int kt = 0; kt < 16; ++kt) { const int kr = rs + (kt >> 1);
#pragma unroll
                for (int i = 0; i < 4; ++i) { const int kc = kc0 + (kt & 1) * 16 + 4 * g + i; const bool ok = kc >= cs && kc <= cs + 15;
                    const float bias = ok ? rp[(kr - r + 7) * 31 + (kc - qc + 15)] : 0.f; s[kt][i] = ok ? s[kt][i] + bias : -INFINITY; } }
        }
        float mx = -INFINITY;
#pragma unroll
        for (int kt = 0; kt < 32; ++kt) mx = fmaxf(mx, fmaxf(fmaxf(s[kt][0], s[kt][1]), fmaxf(s[kt][2], s[kt][3])));
        mx = fmaxf(mx, __shfl_xor(mx, 16)); mx = fmaxf(mx, __shfl_xor(mx, 32));
        float sum = 0.f;
#pragma unroll
        for (int kt = 0; kt < 32; ++kt) {
#pragma unroll
            for (int i = 0; i < 4; ++i) { const float e = __expf(s[kt][i] - mx); s[kt][i] = e; sum += e; } }
        sum += __shfl_xor(sum, 16); sum += __shfl_xor(sum, 32);
        const float inv = 1.0f / sum;
        f32x4 o[8];
#pragma unroll
        for (int mt = 0; mt < 8; ++mt) o[mt] = (f32x4){0.f, 0.f, 0.f, 0.f};
#pragma unroll
        for (int kb = 0; kb < 16; ++kb) {
            if (kb >= kb_lo) {
                const int tok0 = kb < 8 ? b * SEQ + (rs + kb) * 64 + kc0 : ctx0 + 32 * (kb - 8);
#pragma unroll
                for (int hb = 0; hb < 2; ++hb) { v4u vv[4];
#pragma unroll
                    for (int i = 0; i < 4; ++i) { const int id = F.lane + 64 * (4 * hb + i); vv[i] = *(const GAS v4u*)(U + (size_t)(tok0 + (id >> 4)) * NU + U_NV + h * 128 + (id & 15) * 8); }
#pragma unroll
                    for (int i = 0; i < 4; ++i) { const int id = F.lane + 64 * (4 * hb + i); *(LAS v4u*)(vimg + (id >> 4) * NA_VPITCH + (id & 15) * 16) = vv[i]; }
                    asm volatile("" ::: "memory"); }
                v4u pw; pw.x = pk2(s[2 * kb][0], s[2 * kb][1]); pw.y = pk2(s[2 * kb][2], s[2 * kb][3]); pw.z = pk2(s[2 * kb + 1][0], s[2 * kb + 1][1]); pw.w = pk2(s[2 * kb + 1][2], s[2 * kb + 1][3]);
                const bf16x8v pf = __builtin_bit_cast(bf16x8v, pw);
                asm volatile("s_waitcnt lgkmcnt(0)" ::: "memory");
#pragma unroll
                for (int mt = 0; mt < 8; ++mt) { const bf16x8v vf = tr_frag(v_a + 32 * mt, NA_VPITCH * 16); o[mt] = __builtin_amdgcn_mfma_f32_16x16x32_bf16(vf, pf, o[mt], 0, 0, 0); }
            }
        }
        bf16* yp = YN + (size_t)(qrow0 + l15) * 1024 + h * 128 + 4 * g;
#pragma unroll
        for (int mt = 0; mt < 8; ++mt) { v2u w; w.x = pk2(o[mt][0] * inv, o[mt][1] * inv); w.y = pk2(o[mt][2] * inv, o[mt][3] * inv); *(GAS v2u*)(yp + 16 * mt) = w; }
    }
}
#ifndef MK_ONE_LAUNCH
#define MK_ONE_LAUNCH 0
#endif
constexpr int PH_PER_LAYER = 11, NPH = 2 + DEPTH * PH_PER_LAYER;
enum { PL_WIN = 0, PL_MIXA, PL_MIXB, PL_MIXC, PL_BR, PL_WOUT, PL_LN1, PL_GATHER, PL_FFN1, PL_FFN2, PL_LN2 };
__device__ __forceinline__ bool in_range(int lo, int hi, int k) { asm volatile("" : "+s"(lo), "+s"(hi)); return lo <= k && k < hi; }
#ifndef PHMASK
#define PHMASK 0xFFFFFFFFu
#endif
#define IN(k) in_range(lo, hi, (k))
#define EN(bit) ((PHMASK >> (bit)) & 1u)
#ifndef DUPMASK
#define DUPMASK 0u
#endif
#define DUP(bit) ((DUPMASK >> (bit)) & 1u)
#define SEAM(k) do { if (IN((k) + 1)) GRID_BAR(); } while (0)
#if MK_ONE_LAUNCH
#define GRID_BAR() xcd_barrier(bar)
#else
#define GRID_BAR() do { if (F.tid == 0) __hip_atomic_store((gu32*)(PWS() + WS_CTL) + CW_TMO, 0xBADBA0u, RLX_AGENT); } while (0)
#endif
template <int L> __device__ __forceinline__ void layer_phases(const Args& A, LAS unsigned char* const ldsb, const XcdBarrier& bar, const int lo, const int hi) {
    LAS unsigned char* const ring = ldsb + RING_OFF;
        const int pb = 2 + PH_PER_LAYER * L, Mr = (L == 0) ? MROWS : NLAT;
        if (EN(2) && IN(pb + PL_WIN)) { Frame F = mkframe(ldsb, A.grid);
            unsigned char* const ws = PWS();
            lr_tiles(F, L);
            pg8::Gemm g{((bf16*)(ws + WS_H)), w_in_t(ws, L), D, D}; pg8::StaticOrder S; S.init(MROWS, NU, F.G, F.bx);
            pg8::EpiU E{((bf16*)(ws + WS_U)), NU};
            pg8::gemm_phase<pg8::EpiU, pg8::StaticOrder, true, true>(ring, g, S, E);
            SEAM(pb + PL_WIN);
        }
        if (EN(3) && IN(pb + PL_MIXA)) { Frame F = mkframe(ldsb, A.grid); gla_g1(F, L); mix_prep(F, L); if (DUP(3)) { __syncthreads(); gla_g1(F, L); mix_prep(F, L); } SEAM(pb + PL_MIXA); }
        if (EN(4) && IN(pb + PL_MIXB)) { Frame F = mkframe(ldsb, A.grid); gla_g2(F); na_mfma(F, L); if (DUP(4)) { __syncthreads(); na_mfma(F, L); } if (DUP(13)) { VM_WAIT(); __syncthreads(); gla_g2(F); } SEAM(pb + PL_MIXB); }
        if (EN(5) && IN(pb + PL_MIXC)) { Frame F = mkframe(ldsb, A.grid); gla_g3(F, L); if (DUP(5)) { __syncthreads(); gla_g3(F, L); } SEAM(pb + PL_MIXC); }
        if (EN(6) && IN(pb + PL_BR)) { Frame F = mkframe(ldsb, A.grid);
            unsigned char* const ws = PWS(); const float* const gate_b = PIN(17) + (size_t)L * 3 * D;
            pg8::Gemm g{((bf16*)(ws + WS_Y)), w_br_t(ws, L, 0), 1024, 1024}; pg8::BranchOrder S; S.init(Mr, D, F.G, F.bx, MROWS / 256, D / 256);
            pg8::EpiGate E{((bf16*)(ws + WS_U)) + U_GATE, NU, gate_b, ((float*)(ws + WS_Z)), ((bf16*)(ws + WS_ZB))};
            pg8::gemm_phase<pg8::EpiGate, pg8::BranchOrder, true, true>(ring, g, S, E);
            SEAM(pb + PL_BR);
        }
        if (EN(7) && IN(pb + PL_WOUT)) { Frame F = mkframe(ldsb, A.grid);
            unsigned char* const ws = PWS(); const float* const modL = ((float*)(ws + WS_MOD)) + (size_t)L * 3 * 12288; const float* const xin = PIN(0); const float* const cin = PIN(2);
            { pg8::Gemm g{((bf16*)(ws + WS_ZB)), w_out_t(ws, L), D, D}; pg8::StaticOrder S; S.init(NLAT, D, F.G, F.bx);
              pg8::EpiRes<false> E{L == 0 ? xin : ((float*)(ws + WS_XL)), cin, modL + 2 * D, 12288, ((float*)(ws + WS_PRE)), ALPHA, 1.0f};
              pg8::gemm_phase<pg8::EpiRes<false>, pg8::StaticOrder, true, true>(ring, g, S, E); }
            if (L == 0) {
              pg8::Gemm g{((bf16*)(ws + WS_ZB)), w_out_t(ws, L), D, 256}; pg8::SplitOrder S; S.init(NLAT / 256, D / 256, 8, 256, F.G, F.bx, 0);
              pg8::EpiPartial<false> E{((float*)(ws + WS_PART)), NLAT / 256, 1.0f};
              pg8::gemm_phase<pg8::EpiPartial<false>, pg8::SplitOrder, false, false>(ring, g, S, E); }
            SEAM(pb + PL_WOUT);
        }
        if (EN(8) && IN(pb + PL_LN1)) { Frame F = mkframe(ldsb, A.grid); ln1_phase(F, L, Mr); SEAM(pb + PL_LN1); }
        if (L == 0) {
            if (EN(10) && IN(pb + PL_FFN1)) { Frame F = mkframe(ldsb, A.grid);
                unsigned char* const ws = PWS();
                pg8::Gemm g{((bf16*)(ws + WS_H)), (const bf16*)w_gu_t(ws, -1), D, D}; pg8::StaticOrder S; S.init(MROWS, NGU, F.G, F.bx);
                pg8::EpiSwiGLU E{((bf16*)(ws + WS_U)), FF};
                pg8::gemm_phase<pg8::EpiSwiGLU, pg8::StaticOrder, true, true>(ring, g, S, E);
                SEAM(pb + PL_FFN1);
            }
            if (EN(11) && IN(pb + PL_FFN2)) { Frame F = mkframe(ldsb, A.grid);
                unsigned char* const ws = PWS(); const float* const modL = ((float*)(ws + WS_MOD)) + (size_t)L * 3 * 12288;
                { pg8::Gemm g{((bf16*)(ws + WS_U)), (const bf16*)w_d_t(ws, -1), FF, FF}; pg8::StaticOrder S; S.init(NLAT, D, F.G, F.bx);
                  pg8::EpiRes<false> E{((float*)(ws + WS_XL)), ((float*)(ws + WS_XL)) + (size_t)NLAT * D, modL + 5 * D, 12288, ((float*)(ws + WS_PRE)), ALPHA, 1.0f};
                  pg8::gemm_phase<pg8::EpiRes<false>, pg8::StaticOrder, true, true>(ring, g, S, E); }
                { pg8::Gemm g{((bf16*)(ws + WS_U)), (const bf16*)w_d_t(ws, -1), FF, 512}; pg8::SplitOrder S; S.init(NLAT / 256, D / 256, 11, 512, F.G, F.bx, 0);
                  pg8::EpiPartial<false> E{((float*)(ws + WS_PART)), NLAT / 256, 1.0f};
                  pg8::gemm_phase<pg8::EpiPartial<false>, pg8::SplitOrder, false, false>(ring, g, S, E); }
                SEAM(pb + PL_FFN2);
            }
            if (EN(12) && IN(pb + PL_LN2)) { Frame F = mkframe(ldsb, A.grid); ln2_dense(F, L); if (DUP(12)) { __syncthreads(); ln2_dense(F, L); } SEAM(pb + PL_LN2); }
        } else {
            if (EN(9) && IN(pb + PL_GATHER)) { Frame F = mkframe(ldsb, A.grid); moe_gather(F); SEAM(pb + PL_GATHER); }
            if (EN(10) && IN(pb + PL_FFN1)) { Frame F = mkframe(ldsb, A.grid);
                unsigned char* const ws = PWS();
                unsigned cnt[8]; int pp[9]; moe_prefix(ws, cnt, pp);
                pg8::Gemm g{((bf16*)(ws + WS_GLA)), (const bf16*)w_gu_t(ws, 0), D / 2, D / 2}; pg8::MoeOrder S; S.init(cnt, NGU / 256, F.G, F.bx);
                pg8::EpiSwiGLU8 E{ws + WS_U, FF, 1.0f / FSC_WGU, FSC_HID};
                pg8::gemm_phase<pg8::EpiSwiGLU8, pg8::MoeOrder, true, true, true>(ring, g, S, E);
                SEAM(pb + PL_FFN1);
            }
            if (EN(11) && IN(pb + PL_FFN2)) { Frame F = mkframe(ldsb, A.grid);
                unsigned char* const ws = PWS(); const float* const modL = ((float*)(ws + WS_MOD)) + (size_t)L * 3 * 12288;
                unsigned cnt[8]; int pp[9]; moe_prefix(ws, cnt, pp);
                pg8::Gemm g{((bf16*)(ws + WS_U)), (const bf16*)w_d_t(ws, 0), FF / 2, FF / 2}; pg8::MoeOrder S; S.init(cnt, D / 256, F.G, F.bx);
                pg8::EpiF32Plain E{((float*)(ws + WS_Z)), D, 1.0f / (FSC_HID * FSC_WD)};
                pg8::gemm_phase<pg8::EpiF32Plain, pg8::MoeOrder, true, true, true>(ring, g, S, E);
                SEAM(pb + PL_FFN2);
            }
            if (EN(12) && IN(pb + PL_LN2)) { Frame F = mkframe(ldsb, A.grid); ln2_moe(F, L); }
        }
    }
__global__ void __launch_bounds__(NTHR, 2) fwd_kernel(Args A) {
    __shared__ __attribute__((aligned(16))) unsigned char lds[LDS_BYTES];
    LAS unsigned char* const ldsb = (LAS unsigned char*)lds;
    { Frame F = mkframe(ldsb, A.grid);
    for (int u = F.tid; u < (LDS_BYTES - LDSCTL_OFF) / 4; u += NTHR) ((LAS unsigned*)(F.lds + LDSCTL_OFF))[u] = 0u;
    __syncthreads();
    if (F.tid < 32) { const unsigned long long p = F.tid < 30 ? (unsigned long long)A.in[F.tid] : (F.tid == 30 ? (unsigned long long)A.out : (unsigned long long)A.ws);
        ((LAS unsigned long long*)(F.lds + PTAB_OFF))[F.tid] = p; }
    __syncthreads(); }
#if MK_ONE_LAUNCH
    XcdBarrier bar; { Frame F = mkframe(ldsb, A.grid); bar = xcd_barrier_post((unsigned*)(PWS() + WS_CTL) + CW_BAR, F.MISC + 8, (unsigned)A.grid); }
#else
    XcdBarrier bar; bar.bar = nullptr; bar.x = 0; bar.grid = 0; bar.st = nullptr;
#endif
    const int lo = A.ph_lo, hi = A.ph_hi;
    LAS unsigned char* const ring = ldsb + RING_OFF;

    if (EN(0) && IN(0)) { Frame F = mkframe(ldsb, A.grid); p0a_prologue(F); if (DUP(0)) { __syncthreads(); p0a_prologue(F); } SEAM(0); }
    if (EN(1) && IN(1)) { Frame F = mkframe(ldsb, A.grid); p0b_modulate(F); if (DUP(1)) { __syncthreads(); p0b_modulate(F); } SEAM(1); }
    layer_phases<0>(A, ldsb, bar, lo, hi);
    layer_phases<1>(A, ldsb, bar, lo, hi);
}

extern "C" void kernel_launch(void* const* d_in, const int* in_sizes, int n_in, void* d_out, int out_size, void* d_ws, size_t ws_size, hipStream_t stream) {
    static int grid = 0;
    if (grid == 0) {
        if (n_in != 30 || out_size != NLAT * D || ws_size < WS_END) { fprintf(stderr, "kernel_launch: unexpected shapes (n_in %d out %d ws %zu); nothing launched\n", n_in, out_size, ws_size); grid = -1; return; }
        int dev = 0, cus = 0, per_cu = 0;
        if (hipGetDevice(&dev) != hipSuccess || hipDeviceGetAttribute(&cus, hipDeviceAttributeMultiprocessorCount, dev) != hipSuccess) { grid = -1; return; }
        if (hipOccupancyMaxActiveBlocksPerMultiprocessor(&per_cu, (const void*)fwd_kernel, NTHR, 0) != hipSuccess || per_cu < 1) { fprintf(stderr, "kernel_launch: occupancy query says %d\n", per_cu); (void)hipGetLastError(); grid = -1; return; }
        grid = cus;
    }
    if (grid < 0) return;
    (void)hipMemsetAsync((char*)d_ws + WS_CTL, 0, CTL_ZERO_BYTES, stream);
    Args a{};
    for (int i = 0; i < 30; ++i) a.in[i] = (const float*)d_in[i];
    a.out = (float*)d_out; a.ws = (unsigned char*)d_ws; a.grid = grid;
#if MK_ONE_LAUNCH
    a.ph_lo = 0; a.ph_hi = NPH;
    hipLaunchKernelGGL(fwd_kernel, dim3(grid), dim3(NTHR), 0, stream, a);
#else
#ifndef NPH_RUN
#define NPH_RUN NPH
#endif
    for (int p = 0; p < NPH_RUN; ++p) {
        if (p == 2 + PL_GATHER) continue;
        a.ph_lo = p; a.ph_hi = p + 1;
        hipLaunchKernelGGL(fwd_kernel, dim3(grid), dim3(NTHR), 0, stream, a);
    }
#endif
}
```

```cpp
#define MK_ONE_LAUNCH 1
#include <hip/hip_runtime.h>
#include <cstdio>

namespace pg8 {
#define PG8_LAS __attribute__((address_space(3)))
typedef unsigned short bf16_t;
typedef short bf16x8 __attribute__((ext_vector_type(8)));
typedef float f32x4 __attribute__((ext_vector_type(4)));
typedef unsigned u32x4 __attribute__((ext_vector_type(4)));
typedef unsigned u32x2 __attribute__((ext_vector_type(2)));
typedef int i32x4 __attribute__((ext_vector_type(4)));
typedef int i32x8 __attribute__((ext_vector_type(8)));
constexpr int BM = 256, BK = 64, HALF = 128, HTB = HALF * BK * 2  , STAGE_BYTES = 8 * HTB, NXCD = 8, WGM = 8;

__host__ __device__ __forceinline__ int lds_byte(int r, int c) { const int st = (r >> 4) * 2 + (c >> 5), rr = r & 15, cc = c & 31, ob = rr * 64 + cc * 2; return st * 1024 + (ob ^ (((ob >> 9) & 1) << 5)); }
__host__ __device__ __forceinline__ void stage_rc(int b, int& R, int& C) { const int st = b / 1024, sb = b % 1024, swz = sb ^ (((sb >> 9) & 1) << 5); R = (st >> 1) * 16 + swz / 64; C = (st & 1) * 32 + (swz % 64) / 2; }
__host__ __device__ __forceinline__ int perm32(int rho) { const int n = rho >> 4, i = rho & 15; return 8 * (i >> 2) + 4 * n + (i & 3); }

struct Unit { int pm, pn, pa, pb, ko, aux; };
struct Gemm { const bf16_t* A; const bf16_t* Bt; int K, KT; };

__device__ __forceinline__ int xcd_remap(int wgid, int nwg) { const int q = nwg / NXCD, r = nwg % NXCD, xcd = wgid % NXCD, off = wgid / NXCD; return (xcd < r ? xcd * (q + 1) : r * (q + 1) + (xcd - r) * q) + off; }
struct StaticOrder {
    int nM, nN, nwg, G, c;
    __host__ __device__ void init(int M, int N, int G_, int c_) { nM = M / BM; nN = N / BM; nwg = nM * nN; G = G_; c = c_; }
    __device__ __forceinline__ bool next(int i, Unit& u) const {
        const long L = (long)i * G + c; if (L >= nwg) return false;
        const int wgid = xcd_remap((int)L, nwg);
        const int nig = WGM * nN, gid = wgid / nig, fm = gid * WGM, gsz = (nM - fm) < WGM ? (nM - fm) : WGM;
        u.pm = fm + ((wgid % nig) % gsz); u.pn = (wgid % nig) / gsz; u.pa = u.pm; u.pb = u.pn; u.ko = 0; u.aux = 0; return true;
    }
    __device__ __forceinline__ void a_ready(const Unit&) const {}
    __device__ __forceinline__ void done(const Unit&) const {}
};
struct MoeOrder {
    int nN, G, c, nunits; int pp[9];
    __device__ __forceinline__ void init(const unsigned* cnt, int nN_, int G_, int c_) { nN = nN_; G = G_; c = c_; pp[0] = 0;
#pragma unroll
        for (int e = 0; e < 8; ++e) pp[e + 1] = pp[e] + (int)((cnt[e] + 255u) >> 8);
        nunits = pp[8] * nN; }
    __device__ __forceinline__ bool next(int i, Unit& u) const {
        const long L = (long)i * G + c; if (L >= nunits) return false;
        const int wgid = xcd_remap((int)L, nunits);
        int e = 0, base = 0, npe = pp[1];
#pragma unroll
        for (int k = 1; k < 8; ++k) { if (wgid >= pp[k] * nN) { e = k; base = pp[k]; npe = pp[k + 1] - pp[k]; } }
        if (npe < 1) npe = 1;
        const int local = wgid - base * nN;
        u.pm = base + local % npe; u.pn = local / npe; u.pa = u.pm; u.pb = e * nN + u.pn; u.ko = 0; u.aux = 0; return true;
    }
    __device__ __forceinline__ void a_ready(const Unit&) const {}
    __device__ __forceinline__ void done(const Unit&) const {}
};

struct BranchOrder {
    StaticOrder S; int apanels, bpanels;
    __device__ __forceinline__ void init(int M, int N, int G_, int c_, int apan, int bpan) { S.init(M, N, G_, c_); apanels = apan; bpanels = bpan; }
    __device__ __forceinline__ bool next(int i, Unit& u) const { const int j = i / 3, b = i - 3 * j; if (!S.next(j, u)) return false; u.pa = b * apanels + u.pm; u.pb = b * bpanels + u.pn; u.aux = b; return true; }
    __device__ __forceinline__ void a_ready(const Unit&) const {}
    __device__ __forceinline__ void done(const Unit&) const {}
};
struct SplitOrder {
    int pm0, nN, nsplit, KT, G, c, rot;
    __device__ __forceinline__ void init(int pm0_, int nN_, int nsplit_, int KT_, int G_, int c_, int rot_) { pm0 = pm0_; nN = nN_; nsplit = nsplit_; KT = KT_; G = G_; c = c_; rot = rot_; }
    __device__ __forceinline__ bool next(int i, Unit& u) const {
        int cc = c - rot; if (cc < 0) cc += G;
        const long L = (long)i * G + cc; if (L >= 2 * nN * nsplit) return false;
        const int s = (int)L % nsplit, tile = (int)L / nsplit;
        u.pm = pm0 + tile / nN; u.pn = tile % nN; u.pa = u.pm; u.pb = u.pn; u.ko = s * KT; u.aux = s; return true;
    }
    __device__ __forceinline__ void a_ready(const Unit&) const {}
    __device__ __forceinline__ void done(const Unit&) const {}
};

__device__ __forceinline__ unsigned cvt_pk_bf16(float lo, float hi) { unsigned r; asm volatile("v_cvt_pk_bf16_f32 %0, %1, %2" : "=v"(r) : "v"(lo), "v"(hi)); return r; }
__device__ __forceinline__ unsigned pk_fp8x4(float a, float b, float c, float d) { int v = __builtin_amdgcn_cvt_pk_fp8_f32(a, b, 0, false); v = __builtin_amdgcn_cvt_pk_fp8_f32(c, d, v, true); return (unsigned)v; }
__device__ __forceinline__ float clamp448(float x) { return fminf(fmaxf(x, -448.0f), 448.0f); }
__device__ __forceinline__ float bf_lo(unsigned w) { return __uint_as_float(w << 16); }
__device__ __forceinline__ float bf_hi(unsigned w) { return __uint_as_float(w & 0xffff0000u); }
__device__ __forceinline__ float fast_sigmoid(float x) { return __builtin_amdgcn_rcpf(1.0f + __expf(-x)); }

struct EpiBf16Plain {
    static constexpr bool PERM = true, AFTER_DRAIN = false;
    bf16_t* O; int ldc;
    __device__ __forceinline__ void operator()(const f32x4 (&acc)[2][2][4][2], const Unit& u, int wr, int wc, int fr, int fq) const {
        const int row0 = u.pm * BM + wr * 64 + fr, col0 = u.pn * BM + wc * 32 + 8 * fq;
#pragma unroll
        for (int ai = 0; ai < 2; ++ai)
#pragma unroll
            for (int m = 0; m < 4; ++m) { bf16_t* rowp = O + (size_t)(row0 + ai * HALF + m * 16) * ldc + col0;
#pragma unroll
                for (int bj = 0; bj < 2; ++bj) { const f32x4 v0 = acc[ai][bj][m][0], v1 = acc[ai][bj][m][1];
                    u32x4 w; w.x = cvt_pk_bf16(v0[0], v0[1]); w.y = cvt_pk_bf16(v0[2], v0[3]); w.z = cvt_pk_bf16(v1[0], v1[1]); w.w = cvt_pk_bf16(v1[2], v1[3]);
                    *(u32x4*)(rowp + bj * HALF) = w; } }
    }
};
struct EpiU {
    static constexpr bool PERM = true, AFTER_DRAIN = false;
    bf16_t* O; int ldc;
    __device__ __forceinline__ void operator()(const f32x4 (&acc)[2][2][4][2], const Unit& u, int wr, int wc, int fr, int fq) const {
        const int row0 = u.pm * BM + wr * 64 + fr, col0 = u.pn * BM + wc * 32 + 8 * fq;
        const bool is_gq = (u.pn == 12 || u.pn == 13), is_gk = (u.pn == 14 || u.pn == 15), is_nq = (u.pn >= 24 && u.pn < 28);
        const float sc = (is_gq || is_nq) ? 0.08838834764831845f : 1.0f;
        const bool rope = (is_gq || is_gk) && u.pm < 32;
        float inv[4];
#pragma unroll
        for (int j = 0; j < 4; ++j) inv[j] = exp2f(-(float)((16 * wc + 4 * fq + j) & 31) * 0.41524101186092029f);
#pragma unroll
        for (int ai = 0; ai < 2; ++ai)
#pragma unroll
            for (int m = 0; m < 4; ++m) { const int row = row0 + ai * HALF + m * 16; bf16_t* rowp = O + (size_t)row * ldc + col0;
                const int t = row & 4095; const float pos = (wc < 2) ? (float)(t >> 6) : (float)(t & 63);
                float cs[4], sn[4];
                if (rope) {
#pragma unroll
                    for (int j = 0; j < 4; ++j) { const float ang = pos * inv[j]; cs[j] = __cosf(ang); sn[j] = __sinf(ang); } }
#pragma unroll
                for (int bj = 0; bj < 2; ++bj) { f32x4 v0 = acc[ai][bj][m][0] * sc, v1 = acc[ai][bj][m][1] * sc;
                    if (rope) { const f32x4 a = v0, b = v1;
                        v0[0] = a[0] * cs[0] - a[1] * sn[0]; v0[1] = a[0] * sn[0] + a[1] * cs[0]; v0[2] = a[2] * cs[1] - a[3] * sn[1]; v0[3] = a[2] * sn[1] + a[3] * cs[1];
                        v1[0] = b[0] * cs[2] - b[1] * sn[2]; v1[1] = b[0] * sn[2] + b[1] * cs[2]; v1[2] = b[2] * cs[3] - b[3] * sn[3]; v1[3] = b[2] * sn[3] + b[3] * cs[3]; }
                    u32x4 w; w.x = cvt_pk_bf16(v0[0], v0[1]); w.y = cvt_pk_bf16(v0[2], v0[3]); w.z = cvt_pk_bf16(v1[0], v1[1]); w.w = cvt_pk_bf16(v1[2], v1[3]);
                    *(u32x4*)(rowp + bj * HALF) = w; } }
    }
};
struct EpiF32Plain {
    static constexpr bool PERM = false, AFTER_DRAIN = false;
    float* C; int ldc; float oscale;
    __device__ __forceinline__ void operator()(const f32x4 (&acc)[2][2][4][2], const Unit& u, int wr, int wc, int fr, int fq) const {
        const int row0 = u.pm * BM + wr * 64 + fr, col0 = u.pn * BM + wc * 32 + 4 * fq;
#pragma unroll
        for (int ai = 0; ai < 2; ++ai)
#pragma unroll
            for (int m = 0; m < 4; ++m) { float* rowp = C + (size_t)(row0 + ai * HALF + m * 16) * ldc + col0;
#pragma unroll
                for (int bj = 0; bj < 2; ++bj)
#pragma unroll
                    for (int n = 0; n < 2; ++n) *(f32x4*)(rowp + bj * HALF + n * 16) = acc[ai][bj][m][n] * oscale; }
    }
};
template <bool SC> struct EpiPartial {
    static constexpr bool PERM = false, AFTER_DRAIN = false;
    float* P; int pm0; float oscale;
    __device__ __forceinline__ void operator()(const f32x4 (&acc)[2][2][4][2], const Unit& u, int wr, int wc, int fr, int fq) const {
        const int row0 = (u.pm - pm0) * BM + wr * 64 + fr, col0 = u.pn * BM + wc * 32 + 4 * fq; float* base = P + (size_t)u.aux * 512 * 2048;
#pragma unroll
        for (int ai = 0; ai < 2; ++ai)
#pragma unroll
            for (int m = 0; m < 4; ++m) { float* rowp = base + (size_t)(row0 + ai * HALF + m * 16) * 2048 + col0;
#pragma unroll
                for (int bj = 0; bj < 2; ++bj)
#pragma unroll
                    for (int n = 0; n < 2; ++n) *(f32x4*)(rowp + bj * HALF + n * 16) = SC ? acc[ai][bj][m][n] * oscale : acc[ai][bj][m][n]; }
    }
};
struct EpiGate {
    static constexpr bool PERM = false, AFTER_DRAIN = false;
    const bf16_t* Ug; int ldu;
    const float* gb;
    float* Z; bf16_t* ZB;
    __device__ __forceinline__ void operator()(const f32x4 (&acc)[2][2][4][2], const Unit& u, int wr, int wc, int fr, int fq) const {
        const int row0 = u.pm * BM + wr * 64 + fr, col0 = u.pn * BM + wc * 32 + 4 * fq; const bool first = u.aux == 0, last = u.aux == 2;
        const bf16_t* Ub = Ug + 2048 * u.aux; const float* gbb = gb + 2048 * u.aux;
#pragma unroll
        for (int ai = 0; ai < 2; ++ai)
#pragma unroll
            for (int m = 0; m < 4; ++m) { const size_t row = (size_t)(row0 + ai * HALF + m * 16);
#pragma unroll
                for (int bj = 0; bj < 2; ++bj)
#pragma unroll
                    for (int n = 0; n < 2; ++n) { const int col = col0 + bj * HALF + n * 16;
                        const u32x2 gl = *(const u32x2*)(Ub + row * ldu + col); const f32x4 b4 = *(const f32x4*)(gbb + col);
                        f32x4 v = acc[ai][bj][m][n];
                        v[0] *= fast_sigmoid(bf_lo(gl.x) + b4[0]); v[1] *= fast_sigmoid(bf_hi(gl.x) + b4[1]); v[2] *= fast_sigmoid(bf_lo(gl.y) + b4[2]); v[3] *= fast_sigmoid(bf_hi(gl.y) + b4[3]);
                        if (!first) v += *(const f32x4*)(Z + row * 2048 + col);
                        if (!last) *(f32x4*)(Z + row * 2048 + col) = v;
                        else { u32x2 w; w.x = cvt_pk_bf16(v[0], v[1]); w.y = cvt_pk_bf16(v[2], v[3]); *(u32x2*)(ZB + row * 2048 + col) = w; } }
                asm volatile("" ::: "memory"); }
    }
};
template <bool SC> struct EpiRes {
    static constexpr bool PERM = false, AFTER_DRAIN = false;
    const float* res_lat; const float* res_ctx; const float* gv; int gstride; float* out; float alpha, oscale;
    __device__ __forceinline__ void operator()(const f32x4 (&acc)[2][2][4][2], const Unit& u, int wr, int wc, int fr, int fq) const {
        const int grp = u.pm < 16 ? 0 : (u.pm < 32 ? 1 : 2);
        const float* res = u.pm < 32 ? res_lat + (size_t)u.pm * BM * 2048 : res_ctx + (size_t)(u.pm - 32) * BM * 2048;
        const float* g = gv + (size_t)grp * gstride;
        const int rl0 = wr * 64 + fr, col0 = u.pn * BM + wc * 32 + 4 * fq;
#pragma unroll
        for (int ai = 0; ai < 2; ++ai)
#pragma unroll
            for (int m = 0; m < 4; ++m) { const int rl = rl0 + ai * HALF + m * 16;
#pragma unroll
                for (int bj = 0; bj < 2; ++bj)
#pragma unroll
                    for (int n = 0; n < 2; ++n) { const int col = col0 + bj * HALF + n * 16;
                        const f32x4 r4 = *(const f32x4*)(res + (size_t)rl * 2048 + col); const f32x4 g4 = *(const f32x4*)(g + col);
                        *(f32x4*)(out + ((size_t)u.pm * BM + rl) * 2048 + col) = r4 * alpha + g4 * (SC ? acc[ai][bj][m][n] * oscale : acc[ai][bj][m][n]); }
                asm volatile("" ::: "memory"); }
    }
};
struct EpiSwiGLU {
    static constexpr bool PERM = true, AFTER_DRAIN = false;
    bf16_t* O; int ldc;
    __device__ __forceinline__ void operator()(const f32x4 (&acc)[2][2][4][2], const Unit& u, int wr, int wc, int fr, int fq) const {
        const int row0 = u.pm * BM + wr * 64 + fr, col0 = u.pn * HALF + wc * 32 + 8 * fq;
#pragma unroll
        for (int ai = 0; ai < 2; ++ai)
#pragma unroll
            for (int m = 0; m < 4; ++m) { bf16_t* rowp = O + (size_t)(row0 + ai * HALF + m * 16) * ldc + col0;
                float h[8];
#pragma unroll
                for (int n = 0; n < 2; ++n)
#pragma unroll
                    for (int j = 0; j < 4; ++j) { const float gt = acc[ai][0][m][n][j], up = acc[ai][1][m][n][j]; h[n * 4 + j] = gt * fast_sigmoid(gt) * up; }
                u32x4 w; w.x = cvt_pk_bf16(h[0], h[1]); w.y = cvt_pk_bf16(h[2], h[3]); w.z = cvt_pk_bf16(h[4], h[5]); w.w = cvt_pk_bf16(h[6], h[7]);
                *(u32x4*)rowp = w; }
    }
};
struct EpiSwiGLU8 {
    static constexpr bool PERM = true, AFTER_DRAIN = false;
    unsigned char* O; int ldc; float oscale, hscale;
    __device__ __forceinline__ void operator()(const f32x4 (&acc)[2][2][4][2], const Unit& u, int wr, int wc, int fr, int fq) const {
        const int row0 = u.pm * BM + wr * 64 + fr, col0 = u.pn * HALF + wc * 32 + 8 * fq;
#pragma unroll
        for (int ai = 0; ai < 2; ++ai)
#pragma unroll
            for (int m = 0; m < 4; ++m) { unsigned char* rowp = O + (size_t)(row0 + ai * HALF + m * 16) * ldc + col0;
                float h[8];
#pragma unroll
                for (int n = 0; n < 2; ++n)
#pragma unroll
                    for (int j = 0; j < 4; ++j) { const float gt = acc[ai][0][m][n][j] * oscale, up = acc[ai][1][m][n][j] * oscale; h[n * 4 + j] = clamp448(gt * fast_sigmoid(gt) * up * hscale); }
                u32x2 w; w.x = pk_fp8x4(h[0], h[1], h[2], h[3]); w.y = pk_fp8x4(h[4], h[5], h[6], h[7]);
                *(u32x2*)rowp = w; }
    }
};

template <class Epi, class Sched, bool ALIGN_EPI = false, bool SP2 = false, bool F8 = false>
__device__ __forceinline__ void gemm_phase(PG8_LAS unsigned char* lds, const Gemm g, const Sched& S, const Epi& E) {
    int tid_ = threadIdx.x; asm volatile("" : "+v"(tid_));
    const int tid = tid_, wid = __builtin_amdgcn_readfirstlane(tid >> 6), lane = tid & 63, wr = wid >> 2, wc = wid & 3, fr = lane & 15, fq = lane >> 4;
    const int K = g.K, nt = g.KT / BK;
    unsigned voffA[2], voffB[2];
#pragma unroll
    for (int i = 0; i < 2; ++i) { int R, C; stage_rc(tid * 16 + i * 8192, R, C); const int Rb = Epi::PERM ? ((R & ~31) + perm32(R & 31)) : R;
        voffA[i] = (unsigned)(R * K + C) * 2u; voffB[i] = (unsigned)(Rb * K + C) * 2u; }
    const size_t kstep = (size_t)(BK * 2);
    const size_t hstep = (size_t)HALF * K * 2;
    const size_t tstep = 2 * hstep;
    const unsigned ldsw = (unsigned)wid * 1024u;
    const int aoff = lds_byte(wr * 64 + fr, fq * 8), boff = lds_byte(wc * 32 + fr, fq * 8);
#define PG8_SA(b, h) (((b) * 2 + (h)) * HTB)
#define PG8_SB(b, h) ((4 + (b) * 2 + (h)) * HTB)
#define PG8_STAGE(bufoff, gbase, voff) do { _Pragma("unroll") for (int _i = 0; _i < 2; ++_i) \
        __builtin_amdgcn_global_load_lds((const unsigned*)((const char*)(gbase) + (voff)[_i]), (PG8_LAS unsigned*)(lds + (bufoff) + ldsw + _i * 8192), 16, 0, 0); } while (0)
#define PG8_CAT(p) __builtin_shufflevector(*(const PG8_LAS i32x4*)(p), *(const PG8_LAS i32x4*)((p) + 1024), 0, 1, 2, 3, 4, 5, 6, 7)
#define PG8_LDA(dst, b, h) do { _Pragma("unroll") for (int m = 0; m < 4; ++m) { if constexpr (F8) dst##8[m] = PG8_CAT(lds + PG8_SA(b, h) + aoff + m * 2048); else { _Pragma("unroll") for (int k = 0; k < 2; ++k) dst[m][k] = *(const PG8_LAS bf16x8*)(lds + PG8_SA(b, h) + aoff + m * 2048 + k * 1024); } } } while (0)
#define PG8_LDB(dst, b, h) do { _Pragma("unroll") for (int n = 0; n < 2; ++n) { if constexpr (F8) dst##8[n] = PG8_CAT(lds + PG8_SB(b, h) + boff + n * 2048); else { _Pragma("unroll") for (int k = 0; k < 2; ++k) dst[n][k] = *(const PG8_LAS bf16x8*)(lds + PG8_SB(b, h) + boff + n * 2048 + k * 1024); } } } while (0)
#define PG8_MMA(ai, bj, At, Bt) do { __builtin_amdgcn_s_setprio(1); _Pragma("unroll") for (int m = 0; m < 4; ++m) _Pragma("unroll") for (int n = 0; n < 2; ++n) { \
        if constexpr (F8) asm volatile("v_mfma_scale_f32_16x16x128_f8f6f4 %0, %1, %2, %0, %3, %3 op_sel_hi:[0,0,0]" : "+v"(acc[ai][bj][m][n]) : "v"(Bt##8[n]), "v"(At##8[m]), "v"(f8one));   \
        else { _Pragma("unroll") for (int k = 0; k < 2; ++k) acc[ai][bj][m][n] = __builtin_amdgcn_mfma_f32_16x16x32_bf16(Bt[n][k], At[m][k], acc[ai][bj][m][n], 0, 0, 0); } } \
        __builtin_amdgcn_s_setprio(0); } while (0)
#define PG8_WAIT_V(n) asm volatile("s_waitcnt vmcnt(" #n ")" ::: "memory")
#define PG8_WAIT_L(n) asm volatile("s_waitcnt lgkmcnt(" #n ")" ::: "memory")
#define PG8_BAR __builtin_amdgcn_s_barrier()
#define PG8_SCHED __builtin_amdgcn_sched_barrier(0)
    Unit cur, nxt; int ui = 0;
    if (!S.next(0, cur)) return;
    f32x4 acc[2][2][4][2];
#pragma unroll
    for (int a = 0; a < 2; ++a)
#pragma unroll
        for (int b = 0; b < 2; ++b)
#pragma unroll
            for (int m = 0; m < 4; ++m)
#pragma unroll
                for (int n = 0; n < 2; ++n) acc[a][b][m][n] = (f32x4){0.f, 0.f, 0.f, 0.f};
    const int f8one = 0x7f7f7f7f;
    bf16x8 At[4][2], B0[2][2], B1[2][2];
    i32x8 At8[4], B08[2], B18[2];
    const char* cA = (const char*)g.A + (size_t)cur.pa * tstep + (size_t)cur.ko * 2; const char* cB = (const char*)g.Bt + (size_t)cur.pb * tstep + (size_t)cur.ko * 2;
    S.a_ready(cur);
    if constexpr (SP2) {
        PG8_STAGE(PG8_SB(0, 0), cB, voffB); PG8_STAGE(PG8_SB(0, 1), cB + hstep, voffB); PG8_STAGE(PG8_SA(0, 0), cA, voffA); PG8_STAGE(PG8_SA(0, 1), cA + hstep, voffA);
        if (wr == 1) PG8_BAR;
        PG8_WAIT_V(2); PG8_BAR;
        PG8_STAGE(PG8_SB(1, 0), cB + kstep, voffB); PG8_STAGE(PG8_SA(1, 0), cA + kstep, voffA); PG8_STAGE(PG8_SB(1, 1), cB + hstep + kstep, voffB);
        PG8_WAIT_V(6); PG8_BAR;
    } else {
        PG8_STAGE(PG8_SB(0, 0), cB, voffB); PG8_STAGE(PG8_SA(0, 0), cA, voffA); PG8_STAGE(PG8_SB(0, 1), cB + hstep, voffB); PG8_STAGE(PG8_SA(0, 1), cA + hstep, voffA);
        if (wr == 1) PG8_BAR;
        PG8_WAIT_V(4); PG8_BAR;
        PG8_STAGE(PG8_SB(1, 0), cB + kstep, voffB); PG8_STAGE(PG8_SA(1, 0), cA + kstep, voffA); PG8_STAGE(PG8_SB(1, 1), cB + hstep + kstep, voffB);
        PG8_WAIT_V(6); PG8_BAR;
    }
    for (;;) {
        const bool has_next = S.next(ui + 1, nxt);
        const char* nA = has_next ? (const char*)g.A + (size_t)nxt.pa * tstep + (size_t)nxt.ko * 2 : cA; const char* nB = has_next ? (const char*)g.Bt + (size_t)nxt.pb * tstep + (size_t)nxt.ko * 2 : cB;
        for (int t = 0; t < nt; t += 2) {
            const bool last = (t == nt - 2);
            const char* a1 = cA + (size_t)(t + 1) * kstep;
            const char* a2 = last ? nA : cA + (size_t)(t + 2) * kstep; const char* b2 = last ? nB : cB + (size_t)(t + 2) * kstep;
            const char* a3 = a2 + kstep; const char* b3 = b2 + kstep;
            if (last && has_next) S.a_ready(nxt);
            if constexpr (SP2) {
            PG8_LDB(B0, 0, 0); PG8_LDB(B1, 0, 1); PG8_SCHED; PG8_LDA(At, 0, 0); PG8_STAGE(PG8_SA(1, 1), a1 + hstep, voffA);
            PG8_WAIT_V(8); PG8_WAIT_L(0); PG8_BAR; PG8_MMA(0, 0, At, B0); PG8_MMA(0, 1, At, B1); PG8_BAR; PG8_SCHED;
            PG8_LDA(At, 0, 1); PG8_STAGE(PG8_SB(0, 0), b2, voffB); PG8_STAGE(PG8_SB(0, 1), b2 + hstep, voffB); PG8_STAGE(PG8_SA(0, 0), a2, voffA);
            PG8_WAIT_V(8); PG8_WAIT_L(0); PG8_BAR; PG8_MMA(1, 0, At, B0); PG8_MMA(1, 1, At, B1); PG8_BAR; PG8_SCHED;
            PG8_LDB(B0, 1, 0); PG8_LDB(B1, 1, 1); PG8_SCHED; PG8_LDA(At, 1, 0); PG8_STAGE(PG8_SA(0, 1), a2 + hstep, voffA);
            PG8_WAIT_V(8); PG8_WAIT_L(0); PG8_BAR; PG8_MMA(0, 0, At, B0); PG8_MMA(0, 1, At, B1); PG8_BAR; PG8_SCHED;
            PG8_LDA(At, 1, 1); PG8_STAGE(PG8_SB(1, 0), b3, voffB); PG8_STAGE(PG8_SB(1, 1), b3 + hstep, voffB); PG8_STAGE(PG8_SA(1, 0), a3, voffA);
            PG8_WAIT_V(8); PG8_WAIT_L(0); PG8_BAR; PG8_MMA(1, 0, At, B0); PG8_MMA(1, 1, At, B1); PG8_BAR; PG8_SCHED;
            } else {
            PG8_LDB(B0, 0, 0); PG8_SCHED; PG8_LDA(At, 0, 0); PG8_STAGE(PG8_SA(1, 1), a1 + hstep, voffA);
            PG8_WAIT_L(8); PG8_BAR; PG8_WAIT_L(0); PG8_MMA(0, 0, At, B0); PG8_BAR; PG8_SCHED;
            PG8_LDB(B1, 0, 1); PG8_STAGE(PG8_SB(0, 0), b2, voffB);
            PG8_BAR; PG8_WAIT_L(0); PG8_MMA(0, 1, At, B1); PG8_BAR;
            PG8_LDA(At, 0, 1); PG8_STAGE(PG8_SA(0, 0), a2, voffA);
            PG8_BAR; PG8_WAIT_L(0); PG8_MMA(1, 0, At, B0); PG8_BAR; PG8_SCHED;
            PG8_STAGE(PG8_SB(0, 1), b2 + hstep, voffB);
            PG8_WAIT_V(6); PG8_BAR; PG8_MMA(1, 1, At, B1); PG8_BAR;
            PG8_LDB(B0, 1, 0); PG8_SCHED; PG8_LDA(At, 1, 0); PG8_STAGE(PG8_SA(0, 1), a2 + hstep, voffA);
            PG8_WAIT_L(8); PG8_BAR; PG8_WAIT_L(0); PG8_MMA(0, 0, At, B0); PG8_BAR; PG8_SCHED;
            PG8_LDB(B1, 1, 1); PG8_STAGE(PG8_SB(1, 0), b3, voffB);
            PG8_BAR; PG8_WAIT_L(0); PG8_MMA(0, 1, At, B1); PG8_BAR;
            PG8_LDA(At, 1, 1); PG8_STAGE(PG8_SA(1, 0), a3, voffA);
            PG8_BAR; PG8_WAIT_L(0); PG8_MMA(1, 0, At, B0); PG8_BAR; PG8_SCHED;
            PG8_STAGE(PG8_SB(1, 1), b3 + hstep, voffB);
            PG8_WAIT_V(6); PG8_BAR; PG8_MMA(1, 1, At, B1); PG8_BAR;
            }
        }
        if constexpr (F8) asm volatile("s_nop 15\n\ts_nop 15\n\ts_nop 15" ::: "memory");
        if constexpr (ALIGN_EPI) { if (wr == 0) PG8_BAR; }
        if constexpr (!Epi::AFTER_DRAIN) { E(acc, cur, wr, wc, fr, fq); S.done(cur); }
        if (!has_next) break;
#pragma unroll
        for (int a = 0; a < 2; ++a)
#pragma unroll
            for (int b = 0; b < 2; ++b)
#pragma unroll
                for (int m = 0; m < 4; ++m)
#pragma unroll
                    for (int n = 0; n < 2; ++n) acc[a][b][m][n] = (f32x4){0.f, 0.f, 0.f, 0.f};
        cur = nxt; cA = nA; cB = nB; ++ui;
        if constexpr (ALIGN_EPI) { if (wr == 1) PG8_BAR; }
    }
    PG8_WAIT_V(0);
    if constexpr (!ALIGN_EPI) { if (wr == 0) PG8_BAR; }
    PG8_BAR;
    if constexpr (Epi::AFTER_DRAIN) { E.fused(acc, cur, wr, wc, fr, fq, lds, wid, lane); S.done(cur); }
#undef PG8_SA
#undef PG8_SB
#undef PG8_STAGE
#undef PG8_CAT
#undef PG8_LDA
#undef PG8_LDB
#undef PG8_MMA
#undef PG8_WAIT_V
#undef PG8_WAIT_L
#undef PG8_BAR
#undef PG8_SCHED
}
}

constexpr int NWAVES = 8, NTHR = 512;
constexpr int D = 2048, SEQ = 4096, NLAT = 8192, CTXL = 256, NCTX = 512, MROWS = 8704, DEPTH = 2;
constexpr int INC = 15392, NU = 15360;
constexpr int U_CB = 0, U_CC = 1024, U_CX = 2048, U_GQ = 3072, U_GK = 3584, U_GV = 4096, U_GR = 5120, U_NQ = 6144, U_NK = 7168, U_NV = 8192, U_GATE = 9216;
constexpr int LR_COL = 6144;
constexpr int FF = 5632, NGU = 2 * FF, NE = 8;
constexpr float LN_EPS = 1e-5f, ALPHA = 1.41421356237f;
constexpr float FSC_WGU = 64.0f, FSC_WD = 128.0f, FSC_HID = 4.0f;
constexpr int MOE_MAXP = 72;

constexpr size_t MiB = 1u << 20;
constexpr size_t WS_CTL = 0, CTL_ZERO_BYTES = 1 * MiB;
constexpr size_t WS_MOD = 1 * MiB;
constexpr size_t WS_WLR = 1 * MiB + 512 * 1024;
constexpr size_t WS_ROUTE = 2 * MiB;
constexpr size_t WS_TOK = 2 * MiB + 256 * 1024;
constexpr size_t WS_LR = 3 * MiB;
constexpr size_t WS_W = 8 * MiB;
constexpr size_t W_IN_B = (size_t)NU * D * 2, W_BR_B = (size_t)1024 * D * 2, W_OUT_B = (size_t)D * D * 2, W_LAYER_B = W_IN_B + 3 * W_BR_B + W_OUT_B;
constexpr size_t W_GU_B = (size_t)NGU * D * 2, W_D_B = (size_t)D * FF * 2, W_FFN_B = W_GU_B + W_D_B;
constexpr size_t WS_WFFN = WS_W + 2 * W_LAYER_B, WS_WMOE = WS_WFFN + W_FFN_B, WS_WEND = WS_WMOE + 8 * W_FFN_B;
constexpr size_t WS_XL = 762 * MiB;
constexpr size_t WS_H = 830 * MiB;
constexpr size_t WS_U = 864 * MiB;
constexpr size_t WS_Y = 1119 * MiB;
constexpr size_t WS_GLA = 1170 * MiB;
constexpr size_t WS_Z = 1306 * MiB;
constexpr size_t WS_ZB = 1374 * MiB;
constexpr size_t WS_PRE = 1408 * MiB;
constexpr size_t WS_PART = 1476 * MiB;
constexpr size_t WS_END = 1520 * MiB;
static_assert(WS_WEND <= WS_XL && WS_XL + (size_t)MROWS * D * 4 <= WS_H && WS_H + (size_t)MROWS * D * 2 <= WS_U && WS_U + (size_t)MROWS * NU * 2 <= WS_Y, "ws map 1");
static_assert(WS_U + (size_t)MOE_MAXP * 256 * FF * 2 <= WS_Y && WS_Y + 3 * (size_t)MROWS * 1024 * 2 <= WS_GLA && WS_GLA + (size_t)MROWS * (4 * 512 + 2 * 1024) * 4 <= WS_Z, "ws map 2");
static_assert(WS_GLA + (size_t)MOE_MAXP * 256 * D * 2 <= WS_Z && WS_Z + (size_t)MOE_MAXP * 256 * D * 4 <= WS_END && WS_PRE + (size_t)MROWS * D * 4 <= WS_END, "ws map 3");
constexpr int CW_TMO = 0, CW_CODE = 1;
constexpr int CW_MOECNT = 64;
constexpr int CW_BAR = 4096;

constexpr int RING_OFF = 0, RING_BYTES = 131072;
constexpr int LDSCTL_OFF = RING_BYTES, MISC_OFF = LDSCTL_OFF + 320;
constexpr int LDS_BYTES = 147456;

#define GAS __attribute__((address_space(1)))
#define LAS __attribute__((address_space(3)))
typedef unsigned short bf16;
typedef unsigned v4u __attribute__((ext_vector_type(4)));
typedef unsigned v2u __attribute__((ext_vector_type(2)));
typedef float f32x4 __attribute__((ext_vector_type(4)));
typedef GAS unsigned gu32;
typedef short bf16x8v __attribute__((ext_vector_type(8)));
#define RLX_AGENT __ATOMIC_RELAXED, __HIP_MEMORY_SCOPE_AGENT
#define LDS_WAIT() asm volatile("s_waitcnt lgkmcnt(0)" ::: "memory")
#define VM_WAIT() asm volatile("s_waitcnt vmcnt(0)" ::: "memory")
__device__ __forceinline__ unsigned f2bf(float f) { unsigned u = __builtin_bit_cast(unsigned, f); return (u + 0x7fffu + ((u >> 16) & 1u)) >> 16; }
__device__ __forceinline__ unsigned pk2(float lo, float hi) { return f2bf(lo) | (f2bf(hi) << 16); }
__device__ __forceinline__ float bflo(unsigned w) { return __uint_as_float(w << 16); }
__device__ __forceinline__ float bfhi(unsigned w) { return __uint_as_float(w & 0xffff0000u); }
__device__ __forceinline__ float bf1(bf16 b) { return __uint_as_float(((unsigned)b) << 16); }
__device__ __forceinline__ float wave_sum(float v) {
#pragma unroll
    for (int o = 1; o < 64; o <<= 1) v += __shfl_xor(v, o);
    return v;
}
__device__ __forceinline__ float wave_max(float v) {
#pragma unroll
    for (int o = 1; o < 64; o <<= 1) v = fmaxf(v, __shfl_xor(v, o));
    return v;
}

#define XB_TMO      128
#define XB_XCNT(j)  (256  + 64 * (j))
#define XB_XSUB(j)  (1280 + 64 * (j))
#define XB_XGEN(j)  (2304 + 64 * (j))
#define XB_TOP      3328
#define XB_TOPGEN   3392
#define XCD_BAR_WORDS 3456
#define XB_SPIN_CAP (1u << 18)

__device__ __forceinline__ unsigned xb_ld(unsigned* p)              { return __hip_atomic_load(p, __ATOMIC_RELAXED, __HIP_MEMORY_SCOPE_AGENT); }
__device__ __forceinline__ unsigned xb_add(unsigned* p, unsigned v) { return __hip_atomic_fetch_add(p, v, __ATOMIC_RELAXED, __HIP_MEMORY_SCOPE_AGENT); }
__device__ __forceinline__ unsigned xb_xcc_id() { return (unsigned)__builtin_amdgcn_s_getreg((3 << 11) | 20) & 0xFu; }
#define XB_SPIN(cond, bar) do { unsigned _sp = 0; while (cond) { __builtin_amdgcn_s_sleep(1); \
    if ((++_sp & 255u) == 0u) { if (xb_ld(&(bar)[XB_TMO])) break; if (_sp > XB_SPIN_CAP) { atomicAdd(&(bar)[XB_TMO], 1u); break; } } } } while (0)

struct XcdBarrier {
    unsigned* bar; unsigned x; unsigned grid;
    volatile LAS unsigned* st;
};

__device__ __forceinline__ XcdBarrier xcd_barrier_post(unsigned* bar, volatile LAS unsigned* st, unsigned grid) {
    XcdBarrier b; b.grid = grid; b.bar = bar; b.x = xb_xcc_id(); b.st = st;
    if (threadIdx.x == 0) (void)xb_add(&bar[XB_XCNT(b.x)], 1u);
    return b;
}
__device__ __forceinline__ void xcd_barrier_complete(unsigned* bar, unsigned x, unsigned& nloc, unsigned& nx, unsigned b_grid) {
    const unsigned G = b_grid;
    unsigned sum, cnt, mine, sp = 0u;
    for (;;) {
        sum = 0u; cnt = 0u; mine = 0u;
#pragma unroll
        for (unsigned j = 0; j < 16; ++j) { const unsigned c = xb_ld(&bar[XB_XCNT(j)]); sum += c; cnt += (c > 0u) ? 1u : 0u; mine = (j == x) ? c : mine; }
        if (sum == G) break;
        __builtin_amdgcn_s_sleep(1);
        if ((++sp & 255u) == 0u) { if (xb_ld(&bar[XB_TMO])) break; if (sp > XB_SPIN_CAP) { atomicAdd(&bar[XB_TMO], 1u); break; } }
    }
    nloc = mine > 0u ? mine : 1u; nx = cnt > 0u ? cnt : 1u;
}

__device__ __forceinline__ void xcd_barrier(const XcdBarrier& b) {
    asm volatile("s_waitcnt vmcnt(0)" ::: "memory");
    __syncthreads();
    if (threadIdx.x == 0) {
        unsigned* bar = b.bar;
        __builtin_amdgcn_s_waitcnt(0);
        unsigned nloc = b.st[0], nx = b.st[1];
        if (nloc == 0u) { xcd_barrier_complete(bar, b.x, nloc, nx, b.grid); b.st[0] = nloc; b.st[1] = nx; }
        const unsigned old = xb_add(&bar[XB_XSUB(b.x)], 1u);
        const unsigned gen = old / nloc;
        if (old + 1u == (gen + 1u) * nloc) {
            __builtin_amdgcn_fence(__ATOMIC_RELEASE, "agent");
            asm volatile("s_waitcnt vmcnt(0)" ::: "memory");
            const unsigned og = xb_add(&bar[XB_TOP], 1u);
            const unsigned tg = og / nx;
            if (og + 1u == (tg + 1u) * nx) xb_add(&bar[XB_TOPGEN], 1u);
            else XB_SPIN(xb_ld(&bar[XB_TOPGEN]) == tg, bar);
            __builtin_amdgcn_fence(__ATOMIC_ACQUIRE, "agent");
            xb_add(&bar[XB_XGEN(b.x)], 1u);
            asm volatile("s_waitcnt vmcnt(0)" ::: "memory");
        } else {
            XB_SPIN(xb_ld(&bar[XB_XGEN(b.x)]) == gen, bar);
            __builtin_amdgcn_fence(__ATOMIC_ACQUIRE, "agent");
            asm volatile("s_waitcnt vmcnt(0)" ::: "memory");
        }
    }
    __syncthreads();
}

struct Args { const float* in[30]; float* out; unsigned char* ws; int ph_lo, ph_hi, grid, pad; };
struct Frame {
    LAS unsigned char* lds;
    volatile LAS unsigned* MISC;
    int tid, lane, wave, vcu, G, bx;
};
__device__ __forceinline__ Frame mkframe(LAS unsigned char* lds, int grid) {
    Frame F; int t = threadIdx.x; asm volatile("" : "+v"(t)); int g = grid, bx = blockIdx.x; asm volatile("" : "+s"(g), "+s"(bx));
    F.lds = lds; F.MISC = (volatile LAS unsigned*)(lds + MISC_OFF); F.tid = t; F.lane = t & 63; F.wave = __builtin_amdgcn_readfirstlane(t >> 6); F.G = g; F.bx = bx;
    F.vcu = (g % 8 == 0) ? (bx % 8) * (g / 8) + bx / 8 : bx; return F;
}
constexpr int PTAB_OFF = LDSCTL_OFF + 1024, PT_OUT = 30, PT_WS = 31;
__device__ __forceinline__ unsigned long long ldp_raw(Frame& F, int i) {
    const volatile LAS unsigned* t = (const volatile LAS unsigned*)(F.lds + PTAB_OFF) + 2 * i; const unsigned lo = t[0], hi = t[1];
    return ((unsigned long long)(unsigned)__builtin_amdgcn_readfirstlane((int)hi) << 32) | (unsigned)__builtin_amdgcn_readfirstlane((int)lo);
}
#define PIN(i) ((const float*)(const GAS float*)ldp_raw(F, (i)))
#define POUT() ((float*)(GAS float*)ldp_raw(F, PT_OUT))
#define PWS() ((unsigned char*)(GAS unsigned char*)ldp_raw(F, PT_WS))
__device__ __forceinline__ bf16* w_in_t(unsigned char* ws, int L) { return (bf16*)(ws + WS_W + (size_t)L * W_LAYER_B); }
__device__ __forceinline__ bf16* w_br_t(unsigned char* ws, int L, int b) { return (bf16*)(ws + WS_W + (size_t)L * W_LAYER_B + W_IN_B + (size_t)b * W_BR_B); }
__device__ __forceinline__ bf16* w_out_t(unsigned char* ws, int L) { return (bf16*)(ws + WS_W + (size_t)L * W_LAYER_B + W_IN_B + 3 * W_BR_B); }
__device__ __forceinline__ unsigned char* w_gu_t(unsigned char* ws, int e) { return ws + (e < 0 ? WS_WFFN : WS_WMOE + (size_t)e * (W_GU_B / 2)); }
__device__ __forceinline__ unsigned char* w_d_t(unsigned char* ws, int e) { return ws + (e < 0 ? WS_WFFN + W_GU_B : WS_WMOE + 8 * W_GU_B + (size_t)e * (W_D_B / 2)); }

template <int MODE> __device__ __forceinline__ int conv_drow(int nb) {
    if (MODE == 0) return 32 * nb;
    if (MODE == 1) return nb < LR_COL / 32 ? 32 * nb : 32 * (nb - 1);
    if (MODE == 2) return 256 * (nb >> 2) + 32 * (nb & 3);
    return 256 * (nb >> 2) + 128 + 32 * (nb & 3);
}
__device__ __forceinline__ void conv_load(const float* W, int N, int nblk, int it, int lane, f32x4 (&w)[8]) {
    const int kb = it / nblk, nb = it % nblk; const float* p = W + (size_t)(64 * kb + (lane >> 3)) * N + 32 * nb + (lane & 7) * 4;
#pragma unroll
    for (int i = 0; i < 8; ++i) w[i] = *(const GAS f32x4*)(p + (size_t)(8 * i) * N);
}
template <int MODE, bool F8> __device__ __forceinline__ void conv_matrix_t(Frame& F, const float* W, int K, int N, void* WT, float sc) {
    LAS float* scr = (LAS float*)(F.lds + RING_OFF + F.wave * 16384);
    const int gw = F.vcu * NWAVES + F.wave, NGW = F.G * NWAVES, lane = F.lane;
    const int nblk = N / 32, nitems = (K / 64) * nblk;
    f32x4 w[8];
    if (gw < nitems) conv_load(W, N, nblk, gw, lane, w);
    for (int it = gw; it < nitems; it += NGW) {
        f32x4 wn[8]; const int itn = it + NGW;
        if (itn < nitems) conv_load(W, N, nblk, itn, lane, wn);
        const int kb = it / nblk, nb = it % nblk, k0 = 64 * kb;
        if (!(MODE == 1 && nb == LR_COL / 32)) {
            const int drow = conv_drow<MODE>(nb);
#pragma unroll
            for (int i = 0; i < 8; ++i) { LAS float* s = scr + (8 * i + (lane >> 3)) * 33 + (lane & 7) * 4; s[0] = w[i][0]; s[1] = w[i][1]; s[2] = w[i][2]; s[3] = w[i][3]; }
            LDS_WAIT(); asm volatile("" ::: "memory");
            const int c = lane & 7;
#pragma unroll
            for (int j = 0; j < 4; ++j) { const int n = (lane >> 3) + 8 * j; const LAS float* s = scr + (8 * c) * 33 + n;
                if (F8) { v2u o; o.x = pg8::pk_fp8x4(s[0 * 33] * sc, s[1 * 33] * sc, s[2 * 33] * sc, s[3 * 33] * sc); o.y = pg8::pk_fp8x4(s[4 * 33] * sc, s[5 * 33] * sc, s[6 * 33] * sc, s[7 * 33] * sc);
                    *(GAS v2u*)((unsigned char*)WT + (size_t)(drow + n) * K + k0 + 8 * c) = o; }
                else { v4u o; o.x = pk2(s[0 * 33], s[1 * 33]); o.y = pk2(s[2 * 33], s[3 * 33]); o.z = pk2(s[4 * 33], s[5 * 33]); o.w = pk2(s[6 * 33], s[7 * 33]);
                    *(GAS v4u*)((bf16*)WT + (size_t)(drow + n) * K + k0 + 8 * c) = o; } }
            LDS_WAIT(); asm volatile("" ::: "memory");
        }
#pragma unroll
        for (int i = 0; i < 8; ++i) w[i] = wn[i];
    }
}
template <int MODE> __device__ __forceinline__ void conv_matrix8(Frame& F, const float* W, int K, int N, unsigned char* WT, float sc) { conv_matrix_t<MODE, true>(F, W, K, N, WT, sc); }
template <int MODE> __device__ __forceinline__ void conv_matrix(Frame& F, const float* W, int K, int N, bf16* WT) { conv_matrix_t<MODE, false>(F, W, K, N, WT, 1.0f); }
__device__ __forceinline__ void ada_item(Frame& F, unsigned char* ws, const float* cnd, const float* cctx, const float* ada_w, const float* ada_b, int item) {
    const int L = item / 96, c0 = (item % 96) * 128;
    LAS float* sc = (LAS float*)(F.lds + RING_OFF);
    LAS float* red = (LAS float*)(F.lds + RING_OFF + 24576);
    for (int i = F.tid; i < 3 * D; i += NTHR) { const int g = i / D, k = i % D; const float v = g < 2 ? cnd[g * D + k] : cctx[k]; sc[i] = v / (1.0f + __expf(-v)); }
    __syncthreads();
    const float* W = ada_w + (size_t)L * D * 12288 + c0 + 2 * F.lane;
    float a00 = 0.f, a01 = 0.f, a10 = 0.f, a11 = 0.f, a20 = 0.f, a21 = 0.f;
    const int kb = 256 * F.wave;
#pragma unroll 8
    for (int k = kb; k < kb + 256; ++k) { const float2 w = *(const float2*)(W + (size_t)k * 12288); const float s0 = sc[k], s1 = sc[D + k], s2 = sc[2 * D + k];
        a00 += s0 * w.x; a01 += s0 * w.y; a10 += s1 * w.x; a11 += s1 * w.y; a20 += s2 * w.x; a21 += s2 * w.y; }
    red[(F.wave * 3 + 0) * 128 + 2 * F.lane] = a00; red[(F.wave * 3 + 0) * 128 + 2 * F.lane + 1] = a01;
    red[(F.wave * 3 + 1) * 128 + 2 * F.lane] = a10; red[(F.wave * 3 + 1) * 128 + 2 * F.lane + 1] = a11;
    red[(F.wave * 3 + 2) * 128 + 2 * F.lane] = a20; red[(F.wave * 3 + 2) * 128 + 2 * F.lane + 1] = a21;
    __syncthreads();
    if (F.tid < 384) { const int g = F.tid / 128, cc = F.tid % 128; float s = 0.f;
#pragma unroll
        for (int w = 0; w < 8; ++w) s += red[(w * 3 + g) * 128 + cc];
        ((float*)(ws + WS_MOD))[((size_t)L * 3 + g) * 12288 + c0 + cc] = s + ada_b[L * 12288 + c0 + cc]; }
    __syncthreads();
}
__device__ __forceinline__ void p0a_prologue(Frame& F) {
    unsigned char* const ws = PWS();
    { const float* cnd = PIN(1); const float* cctx = PIN(3); const float* ada_w = PIN(4); const float* ada_b = PIN(5);
      for (int it = F.bx; it < 192; it += F.G) ada_item(F, ws, cnd, cctx, ada_w, ada_b, it); }
    const float* const w_in = PIN(6);
    { const int gt = F.bx * NTHR + F.tid, NGT = F.G * NTHR;
      for (int i = gt; i < DEPTH * D * 32; i += NGT) { const int o = i & 31, k = (i >> 5) % D, L = i / (32 * D); ((bf16*)(ws + WS_WLR))[((size_t)L * 32 + o) * D + k] = (bf16)f2bf(w_in[((size_t)L * D + k) * INC + LR_COL + o]); } }
    for (int L = 0; L < DEPTH; ++L) {
        conv_matrix<1>(F, w_in + (size_t)L * D * INC, D, INC, w_in_t(ws, L));
        for (int b = 0; b < 3; ++b) conv_matrix<0>(F, (b == 0 ? PIN(14) : (b == 1 ? PIN(15) : PIN(16))) + (size_t)L * 1024 * D, 1024, D, w_br_t(ws, L, b));
        conv_matrix<0>(F, PIN(18) + (size_t)L * D * D, D, D, w_out_t(ws, L));
    }
    conv_matrix<2>(F, PIN(23), D, FF, (bf16*)w_gu_t(ws, -1)); conv_matrix<3>(F, PIN(24), D, FF, (bf16*)w_gu_t(ws, -1)); conv_matrix<0>(F, PIN(25), FF, D, (bf16*)w_d_t(ws, -1));
    for (int e = 0; e < NE; ++e) {
        conv_matrix8<2>(F, PIN(27) + (size_t)e * D * FF, D, FF, w_gu_t(ws, e), FSC_WGU); conv_matrix8<3>(F, PIN(28) + (size_t)e * D * FF, D, FF, w_gu_t(ws, e), FSC_WGU);
        conv_matrix8<0>(F, PIN(29) + (size_t)e * FF * D, FF, D, w_d_t(ws, e), FSC_WD);
    }
}

__device__ __forceinline__ int row_group(int r) { return r < SEQ ? 0 : (r < NLAT ? 1 : 2); }
__device__ __forceinline__ void load_row(const float* p, int lane, f32x4 (&v)[8]) {
#pragma unroll
    for (int j = 0; j < 8; ++j) v[j] = *(const GAS f32x4*)(p + 4 * lane + 256 * j);
}
__device__ __forceinline__ void store_row(float* p, int lane, const f32x4 (&v)[8]) {
#pragma unroll
    for (int j = 0; j < 8; ++j) *(GAS f32x4*)(p + 4 * lane + 256 * j) = v[j];
}
__device__ __forceinline__ void store_row_bf16(bf16* p, int lane, const f32x4 (&v)[8]) {
#pragma unroll
    for (int j = 0; j < 8; ++j) { v2u w; w.x = pk2(v[j][0], v[j][1]); w.y = pk2(v[j][2], v[j][3]); *(GAS v2u*)(p + 4 * lane + 256 * j) = w; }
}
__device__ __forceinline__ void store_row_fp8(unsigned char* p, int lane, const f32x4 (&v)[8]) {
#pragma unroll
    for (int j = 0; j < 8; ++j) *(GAS unsigned*)(p + 4 * lane + 256 * j) = pg8::pk_fp8x4(pg8::clamp448(v[j][0]), pg8::clamp448(v[j][1]), pg8::clamp448(v[j][2]), pg8::clamp448(v[j][3]));
}
__device__ __forceinline__ void modulate(f32x4 (&v)[8], const float* shift, const float* scale, int lane) {
#pragma unroll
    for (int j = 0; j < 8; ++j) { const f32x4 sh = *(const f32x4*)(shift + 4 * lane + 256 * j), sc = *(const f32x4*)(scale + 4 * lane + 256 * j); v[j] = v[j] * (sc + 1.0f) + sh; }
}
__device__ __forceinline__ void layer_norm_row(f32x4 (&v)[8], const float* g, const float* b, int lane) {
    float s = 0.f;
#pragma unroll
    for (int j = 0; j < 8; ++j) s += (v[j][0] + v[j][1]) + (v[j][2] + v[j][3]);
    const float mean = wave_sum(s) * (1.0f / D); float q = 0.f;
#pragma unroll
    for (int j = 0; j < 8; ++j) { v[j] = v[j] - mean; q += (v[j][0] * v[j][0] + v[j][1] * v[j][1]) + (v[j][2] * v[j][2] + v[j][3] * v[j][3]); }
    const float rstd = 1.0f / sqrtf(wave_sum(q) * (1.0f / D) + LN_EPS);
#pragma unroll
    for (int j = 0; j < 8; ++j) { const f32x4 g4 = *(const f32x4*)(g + 4 * lane + 256 * j), b4 = *(const f32x4*)(b + 4 * lane + 256 * j); v[j] = v[j] * rstd * g4 + b4; }
}
__device__ __forceinline__ void lr_tiles(Frame& F, int L) {
    unsigned char* const ws = PWS(); const bf16* H = (const bf16*)(ws + WS_H); const bf16* W = (const bf16*)(ws + WS_WLR) + (size_t)L * 32 * D; float* LRo = (float*)(ws + WS_LR);
    const int g = F.lane >> 4, l15 = F.lane & 15, gw = F.vcu * NWAVES + F.wave, NGW = F.G * NWAVES;
    for (int task = gw; task < MROWS / 16; task += NGW) {
        const bf16* ap = H + (size_t)(16 * task + l15) * D + 8 * g; const bf16* bp = W + (size_t)l15 * D + 8 * g;
        f32x4 a0 = {0.f, 0.f, 0.f, 0.f}, a1 = {0.f, 0.f, 0.f, 0.f};
#pragma unroll 8
        for (int ks = 0; ks < D / 32; ++ks) { const bf16x8v af = __builtin_bit_cast(bf16x8v, *(const GAS v4u*)(ap + 32 * ks)), b0 = __builtin_bit_cast(bf16x8v, *(const GAS v4u*)(bp + 32 * ks)), b1 = __builtin_bit_cast(bf16x8v, *(const GAS v4u*)(bp + (size_t)16 * D + 32 * ks));
            a0 = __builtin_amdgcn_mfma_f32_16x16x32_bf16(af, b0, a0, 0, 0, 0); a1 = __builtin_amdgcn_mfma_f32_16x16x32_bf16(af, b1, a1, 0, 0, 0); }
#pragma unroll
        for (int i = 0; i < 4; ++i) { float* o = LRo + (size_t)(16 * task + 4 * g + i) * 32 + l15; o[0] = a0[i]; o[16] = a1[i]; }
    }
}
__device__ __forceinline__ void p0b_modulate(Frame& F) {
    unsigned char* const ws = PWS(); const float* const xin = PIN(0); const float* const cin = PIN(2);
    const int gw = F.vcu * NWAVES + F.wave, NGW = F.G * NWAVES;
    for (int r = gw; r < MROWS; r += NGW) {
        f32x4 v[8]; load_row(r < NLAT ? xin + (size_t)r * D : cin + (size_t)(r - NLAT) * D, F.lane, v);
        const float* m = ((float*)(ws + WS_MOD)) + (size_t)row_group(r) * 12288;
        modulate(v, m, m + D, F.lane); store_row_bf16(((bf16*)(ws + WS_H)) + (size_t)r * D, F.lane, v);
    }
}

__device__ __forceinline__ void mix_prep(Frame& F, int L) {
    unsigned char* const ws = PWS();
    const int gt = F.bx * NTHR + F.tid, NGT = F.G * NTHR;
    const float* cw = PIN(7) + (size_t)L * 3 * 1024;
    for (int i = gt; i < MROWS * 128; i += NGT) {
        const int r = i >> 7, c8 = (i & 127) * 8;
        const int t = r < NLAT ? (r & (SEQ - 1)) : ((r - NLAT) & (CTXL - 1)), T = r < NLAT ? SEQ : CTXL;
        float acc[8];
#pragma unroll
        for (int j = 0; j < 8; ++j) acc[j] = 0.f;
#pragma unroll
        for (int k = 0; k < 3; ++k) { const int tt = t + k - 1; if (tt < 0 || tt >= T) continue;
            const bf16* up = ((bf16*)(ws + WS_U)) + (size_t)(r + k - 1) * NU; const v4u a = *(const GAS v4u*)(up + U_CC + c8), b = *(const GAS v4u*)(up + U_CX + c8);
            const f32x4 w0 = *(const f32x4*)(cw + k * 1024 + c8), w1 = *(const f32x4*)(cw + k * 1024 + c8 + 4);
            acc[0] += w0[0] * bflo(a.x) * bflo(b.x); acc[1] += w0[1] * bfhi(a.x) * bfhi(b.x); acc[2] += w0[2] * bflo(a.y) * bflo(b.y); acc[3] += w0[3] * bfhi(a.y) * bfhi(b.y);
            acc[4] += w1[0] * bflo(a.z) * bflo(b.z); acc[5] += w1[1] * bfhi(a.z) * bfhi(b.z); acc[6] += w1[2] * bflo(a.w) * bflo(b.w); acc[7] += w1[3] * bfhi(a.w) * bfhi(b.w); }
        const v4u ab = *(const GAS v4u*)(((bf16*)(ws + WS_U)) + (size_t)r * NU + U_CB + c8);
        v4u o; o.x = pk2(acc[0] * bflo(ab.x), acc[1] * bfhi(ab.x)); o.y = pk2(acc[2] * bflo(ab.y), acc[3] * bfhi(ab.y)); o.z = pk2(acc[4] * bflo(ab.z), acc[5] * bfhi(ab.z)); o.w = pk2(acc[6] * bflo(ab.w), acc[7] * bfhi(ab.w));
        *(GAS v4u*)(((bf16*)(ws + WS_Y)) + (size_t)r * 1024 + c8) = o;
    }
}
__device__ __forceinline__ void sum_partials(f32x4 (&v)[8], const float* P, int ns, const float* res, const float* gvec, int lane) {
#pragma unroll
    for (int j = 0; j < 8; ++j) v[j] = (f32x4){0.f, 0.f, 0.f, 0.f};
    for (int s = 0; s < ns; ++s) {
#pragma unroll
        for (int j = 0; j < 8; ++j) v[j] += *(const GAS f32x4*)(P + (size_t)s * 512 * D + 4 * lane + 256 * j); }
#pragma unroll
    for (int j = 0; j < 8; ++j) { const f32x4 r4 = *(const GAS f32x4*)(res + 4 * lane + 256 * j), g4 = *(const f32x4*)(gvec + 4 * lane + 256 * j); v[j] = r4 * ALPHA + g4 * v[j]; }
}
__device__ __forceinline__ void ln1_phase(Frame& F, int L, int M) {
    unsigned char* const ws = PWS(); const float* const lng = PIN(19) + L * D; const float* const lnb = PIN(20) + L * D; const float* const router = PIN(26); const float* const cin = PIN(2);
    const int gw = F.vcu * NWAVES + F.wave, NGW = F.G * NWAVES;
    for (int r = gw; r < M; r += NGW) {
        const float* m = ((float*)(ws + WS_MOD)) + ((size_t)L * 3 + row_group(r)) * 12288;
        f32x4 v[8];
        if (r < NLAT) load_row(((float*)(ws + WS_PRE)) + (size_t)r * D, F.lane, v);
        else sum_partials(v, ((float*)(ws + WS_PART)) + (size_t)(r - NLAT) * D, 8, cin + (size_t)(r - NLAT) * D, m + 2 * D, F.lane);
        layer_norm_row(v, lng, lnb, F.lane);
        store_row(((float*)(ws + WS_XL)) + (size_t)r * D, F.lane, v);
        modulate(v, m + 3 * D, m + 4 * D, F.lane);
        if (L == 0) store_row_bf16(((bf16*)(ws + WS_H)) + (size_t)r * D, F.lane, v); else store_row_fp8(ws + WS_H + (size_t)r * D, F.lane, v);
        if (L == 1) {
            float lg[8];
#pragma unroll
            for (int e = 0; e < 8; ++e) lg[e] = 0.f;
#pragma unroll
            for (int j = 0; j < 8; ++j)
#pragma unroll
                for (int i = 0; i < 4; ++i) { const float* rp = router + (size_t)(4 * F.lane + 256 * j + i) * 8; const f32x4 w0 = *(const f32x4*)rp, w1 = *(const f32x4*)(rp + 4); const float hv = v[j][i];
                    lg[0] += hv * w0[0]; lg[1] += hv * w0[1]; lg[2] += hv * w0[2]; lg[3] += hv * w0[3]; lg[4] += hv * w1[0]; lg[5] += hv * w1[1]; lg[6] += hv * w1[2]; lg[7] += hv * w1[3]; }
#pragma unroll
            for (int e = 0; e < 8; ++e) lg[e] = wave_sum(lg[e]);
            int e0 = 0; float v0 = lg[0];
#pragma unroll
            for (int e = 1; e < 8; ++e) if (lg[e] > v0) { v0 = lg[e]; e0 = e; }
            int e1 = -1; float v1 = -INFINITY;
#pragma unroll
            for (int e = 0; e < 8; ++e) if (e != e0 && lg[e] > v1) { v1 = lg[e]; e1 = e; }
            if (F.lane == 0) {
                const float w0 = 1.0f / (1.0f + __expf(v1 - v0)), w1 = 1.0f - w0;
                const unsigned p0 = __hip_atomic_fetch_add(((gu32*)(ws + WS_CTL)) + CW_MOECNT + 64 * e0, 1u, RLX_AGENT), p1 = __hip_atomic_fetch_add(((gu32*)(ws + WS_CTL)) + CW_MOECNT + 64 * e1, 1u, RLX_AGENT);
                ((int*)(ws + WS_TOK))[e0 * NLAT + p0] = r; ((int*)(ws + WS_TOK))[e1 * NLAT + p1] = r;
                unsigned* rt = ((unsigned*)(ws + WS_ROUTE)) + (size_t)r * 8; rt[0] = e0; rt[1] = p0; rt[2] = __float_as_uint(w0); rt[3] = e1; rt[4] = p1; rt[5] = __float_as_uint(w1);
            }
        }
    }
}
__device__ __forceinline__ void moe_prefix(unsigned char* ws, unsigned (&cnt)[8], int (&pp)[9]) {
    pp[0] = 0;
#pragma unroll
    for (int e = 0; e < 8; ++e) { cnt[e] = __hip_atomic_load(((gu32*)(ws + WS_CTL)) + CW_MOECNT + 64 * e, RLX_AGENT); pp[e + 1] = pp[e] + (int)((cnt[e] + 255u) >> 8); }
}
__device__ __forceinline__ void moe_gather(Frame& F) {
    unsigned char* const ws = PWS();
    const int gw = F.vcu * NWAVES + F.wave, NGW = F.G * NWAVES;
    unsigned cnt[8]; int pp[9]; moe_prefix(ws, cnt, pp);
    for (int s = gw; s < pp[8] * 256; s += NGW) {
        const int p = s >> 8; int e = 0, base = 0; unsigned ce = cnt[0];
#pragma unroll
        for (int k = 1; k < 8; ++k) if (p >= pp[k]) { e = k; base = pp[k]; ce = cnt[k]; }
        const unsigned pos = (unsigned)(s - base * 256);
        GAS v4u* dst = (GAS v4u*)(ws + WS_GLA + (size_t)s * D) + F.lane;
        if (pos < ce) { const int tkn = ((int*)(ws + WS_TOK))[e * NLAT + pos]; const GAS v4u* src = (const GAS v4u*)(ws + WS_H + (size_t)tkn * D) + F.lane;
#pragma unroll
            for (int j = 0; j < 2; ++j) dst[64 * j] = src[64 * j]; }
        else {
#pragma unroll
            for (int j = 0; j < 2; ++j) dst[64 * j] = (v4u){0u, 0u, 0u, 0u}; }
    }
}
__device__ __forceinline__ void ln2_dense(Frame& F, int L) {
    unsigned char* const ws = PWS(); const float* const lng = PIN(21) + L * D; const float* const lnb = PIN(22) + L * D;
    const int gw = F.vcu * NWAVES + F.wave, NGW = F.G * NWAVES;
    for (int r = gw; r < MROWS; r += NGW) {
        f32x4 v[8];
        if (r < NLAT) load_row(((float*)(ws + WS_PRE)) + (size_t)r * D, F.lane, v);
        else sum_partials(v, ((float*)(ws + WS_PART)) + (size_t)(r - NLAT) * D, 11, ((float*)(ws + WS_XL)) + (size_t)r * D, ((float*)(ws + WS_MOD)) + ((size_t)L * 3 + 2) * 12288 + 5 * D, F.lane);
        layer_norm_row(v, lng, lnb, F.lane);
        store_row(((float*)(ws + WS_XL)) + (size_t)r * D, F.lane, v);
        const float* m = ((float*)(ws + WS_MOD)) + ((size_t)(L + 1) * 3 + row_group(r)) * 12288;
        modulate(v, m, m + D, F.lane); store_row_bf16(((bf16*)(ws + WS_H)) + (size_t)r * D, F.lane, v);
    }
}
__device__ __forceinline__ void ln2_moe(Frame& F, int L) {
    unsigned char* const ws = PWS(); const float* const lng = PIN(21) + L * D; const float* const lnb = PIN(22) + L * D; float* const outp = POUT();
    const int gw = F.vcu * NWAVES + F.wave, NGW = F.G * NWAVES;
    unsigned cnt[8]; int pp[9]; moe_prefix(ws, cnt, pp);
    for (int r = gw; r < NLAT; r += NGW) {
        const unsigned* rt = ((unsigned*)(ws + WS_ROUTE)) + (size_t)r * 8; const int e0 = rt[0], e1 = rt[3]; const float w0 = __uint_as_float(rt[2]), w1 = __uint_as_float(rt[5]);
        int b0 = 0, b1 = 0;
#pragma unroll
        for (int k = 1; k < 8; ++k) { if (e0 >= k) b0 = pp[k]; if (e1 >= k) b1 = pp[k]; }
        const size_t s0 = (size_t)b0 * 256 + rt[1], s1 = (size_t)b1 * 256 + rt[4];
        f32x4 v[8], y0[8], y1[8]; load_row(((float*)(ws + WS_XL)) + (size_t)r * D, F.lane, v); load_row(((float*)(ws + WS_Z)) + s0 * D, F.lane, y0); load_row(((float*)(ws + WS_Z)) + s1 * D, F.lane, y1);
        const float* g2 = ((float*)(ws + WS_MOD)) + ((size_t)L * 3 + row_group(r)) * 12288 + 5 * D;
#pragma unroll
        for (int j = 0; j < 8; ++j) { const f32x4 g4 = *(const f32x4*)(g2 + 4 * F.lane + 256 * j); v[j] = v[j] * ALPHA + g4 * (y0[j] * w0 + y1[j] * w1); }
        layer_norm_row(v, lng, lnb, F.lane);
        store_row(outp + (size_t)r * D, F.lane, v);
    }
}

constexpr int GLA_NCH = 68;
constexpr size_t GLA_DST_BYTES = (size_t)16 * GLA_NCH * 256 * 128 * 2;
#define GLA_DST(ws) ((bf16*)((ws) + WS_GLA))
#define GLA_DEC(ws) ((float*)((ws) + WS_GLA + GLA_DST_BYTES))
__device__ __forceinline__ int gla_chunk_row0(int b, int cn) { return cn < 4 ? NLAT + CTXL * b + 64 * cn : SEQ * b + 64 * (cn - 4); }
__device__ __forceinline__ int gla_scan_idx(int cn, int dir) { return dir ? (cn < 4 ? 3 - cn : 71 - cn) : cn; }
__device__ __forceinline__ float log_sigmoid16(float z) { return (fminf(z, 0.f) - __logf(1.0f + __expf(-fabsf(z)))) * (1.0f / 16.0f); }
__device__ __forceinline__ bf16x8v tr_frag(unsigned addr, unsigned pitch4) {
    v2u lo, hi;
    asm volatile("ds_read_b64_tr_b16 %0, %2\n\tds_read_b64_tr_b16 %1, %3\n\ts_waitcnt lgkmcnt(0)" : "=&v"(lo), "=&v"(hi) : "v"(addr), "v"(addr + pitch4) : "memory");
    v4u r; r.x = lo.x; r.y = lo.y; r.z = hi.x; r.w = hi.y; return __builtin_bit_cast(bf16x8v, r);
}
struct TrHalf { v2u lo, hi; };
__device__ __forceinline__ void tr_issue(TrHalf& f, unsigned addr, unsigned pitch4) { asm volatile("ds_read_b64_tr_b16 %0, %2\n\tds_read_b64_tr_b16 %1, %3" : "=&v"(f.lo), "=&v"(f.hi) : "v"(addr), "v"(addr + pitch4) : "memory"); }
__device__ __forceinline__ bf16x8v tr_get(const TrHalf& f) { v4u r; r.x = f.lo.x; r.y = f.lo.y; r.z = f.hi.x; r.w = f.hi.y; return __builtin_bit_cast(bf16x8v, r); }
__device__ __forceinline__ void tr_wait2(TrHalf (&f)[2]) { asm volatile("s_waitcnt lgkmcnt(0)" : "+v"(f[0].lo), "+v"(f[0].hi), "+v"(f[1].lo), "+v"(f[1].hi) :: "memory"); }
__device__ __forceinline__ void tr_wait8(TrHalf (&f)[8]) { asm volatile("s_waitcnt lgkmcnt(0)" : "+v"(f[0].lo), "+v"(f[0].hi), "+v"(f[1].lo), "+v"(f[1].hi), "+v"(f[2].lo), "+v"(f[2].hi), "+v"(f[3].lo), "+v"(f[3].hi),
    "+v"(f[4].lo), "+v"(f[4].hi), "+v"(f[5].lo), "+v"(f[5].hi), "+v"(f[6].lo), "+v"(f[6].hi), "+v"(f[7].lo), "+v"(f[7].hi) :: "memory"); }
__device__ __forceinline__ unsigned lds_addr(LAS unsigned char* p) { return (unsigned)(size_t)p; }
constexpr int GL_BC = 0;
constexpr int GL_TOT = 65536;
constexpr int GL_V = 71680;
constexpr int GL_A = 105472;
constexpr int GL_STG = 105472;
constexpr int GL_RED = 124928;
constexpr int GL_QK_PITCH = 272, GL_V_PITCH = 528, GL_A_PITCH = 144;
static_assert(GL_STG + 25600 <= RING_BYTES && GL_V + 64 * GL_V_PITCH <= GL_A && GL_TOT + 4096 + 1024 <= GL_V && 4 * 64 * GL_QK_PITCH <= GL_V, "GLA LDS map");

__device__ __forceinline__ void gla_decays(Frame& F, unsigned char* ws, const float* wgf, const float* bgf, const float* wgb, const float* bgb, int row0, int h, int d0, int d1) {
    LAS float* lr = (LAS float*)(F.lds + GL_STG); LAS float* wg = lr + 64 * 32; LAS float* bg = wg + 2 * 16 * 128;
    LAS float* bc = (LAS float*)(F.lds + GL_BC); LAS float* tot = (LAS float*)(F.lds + GL_TOT);
    { const int t = F.tid >> 3, o4 = (F.tid & 7) * 4; *(LAS f32x4*)(lr + t * 32 + o4) = *(const GAS f32x4*)(((float*)(ws + WS_LR)) + (size_t)(row0 + t) * 32 + o4); }
    for (int i = F.tid; i < 1024; i += NTHR) { const int dir = i >> 9, o = (i >> 5) & 15, d4 = (i & 31) * 4; *(LAS f32x4*)(wg + (dir * 16 + o) * 128 + d4) = *(const GAS f32x4*)((dir ? wgb : wgf) + o * 512 + h * 128 + d4); }
    if (F.tid < 64) { const int dir = F.tid >> 5, d4 = (F.tid & 31) * 4; *(LAS f32x4*)(bg + dir * 128 + d4) = *(const GAS f32x4*)((dir ? bgb : bgf) + h * 128 + d4); }
    __syncthreads();
    { const int t = F.tid >> 3, dg = (F.tid & 7) * 16;
      for (int dir = d0; dir < d1; ++dir) {
          f32x4 z[4];
#pragma unroll
          for (int j = 0; j < 4; ++j) z[j] = *(LAS f32x4*)(bg + dir * 128 + dg + 4 * j);
#pragma unroll
          for (int o = 0; o < 16; ++o) { const float l = lr[t * 32 + dir * 16 + o];
#pragma unroll
              for (int j = 0; j < 4; ++j) z[j] += l * *(LAS f32x4*)(wg + (dir * 16 + o) * 128 + dg + 4 * j); }
#pragma unroll
          for (int j = 0; j < 4; ++j) { f32x4 g; g[0] = log_sigmoid16(z[j][0]); g[1] = log_sigmoid16(z[j][1]); g[2] = log_sigmoid16(z[j][2]); g[3] = log_sigmoid16(z[j][3]); *(LAS f32x4*)(bc + dir * 8192 + t * 128 + dg + 4 * j) = g; } } }
    __syncthreads();
    { const int d = F.tid & 127, seg = F.tid >> 7;
      for (int dir = d0; dir < d1; ++dir) { float a = 0.f;
#pragma unroll
          for (int i = 0; i < 16; ++i) { const int s = seg * 16 + i, t = dir ? 63 - s : s; a += bc[dir * 8192 + t * 128 + d]; bc[dir * 8192 + t * 128 + d] = a; }
          tot[(dir * 4 + seg) * 128 + d] = a; } }
    __syncthreads();
    { const int d = F.tid & 127, seg = F.tid >> 7;
      for (int dir = d0; dir < d1; ++dir) { float pre = 0.f, all = 0.f;
#pragma unroll
          for (int s2 = 0; s2 < 4; ++s2) { const float v = tot[(dir * 4 + s2) * 128 + d]; all += v; if (s2 < seg) pre += v; }
          if (seg == 0) tot[1024 + dir * 128 + d] = all;
          if (seg > 0) {
#pragma unroll
              for (int i = 0; i < 16; ++i) { const int s = seg * 16 + i, t = dir ? 63 - s : s; bc[dir * 8192 + t * 128 + d] += pre; } } } }
    __syncthreads();
}
__device__ __forceinline__ void gla_stage_v(Frame& F, const bf16* U, int row0, int h) {
#pragma unroll
    for (int i = 0; i < 4; ++i) { const int p = F.tid + NTHR * i, t = p >> 5, e8 = (p & 31) * 8;
        *(LAS v4u*)(F.lds + GL_V + t * GL_V_PITCH + e8 * 2) = *(const GAS v4u*)(U + (size_t)(row0 + t) * NU + U_GV + h * 256 + e8); }
}
__device__ __forceinline__ void gla_g1(Frame& F, int L) {
    unsigned char* const ws = PWS(); const bf16* U = (const bf16*)(ws + WS_U);
    const float* wgf = PIN(8) + (size_t)L * 16 * 512; const float* bgf = PIN(9) + L * 512; const float* wgb = PIN(10) + (size_t)L * 16 * 512; const float* bgb = PIN(11) + L * 512;
    const int g = F.lane >> 4, q4 = (F.lane & 15) >> 2, p = F.lane & 3, l15 = F.lane & 15;
    for (int task = F.vcu; task < 16 * GLA_NCH; task += F.G) {
        const int cn = task % GLA_NCH, ch = task / GLA_NCH, h = ch & 3, dir = (ch >> 2) & 1, b = ch >> 3;
        const int row0 = gla_chunk_row0(b, cn), n = gla_scan_idx(cn, dir);
        __syncthreads();
        gla_stage_v(F, U, row0, h);
        v4u kp[2];
#pragma unroll
        for (int i = 0; i < 2; ++i) { const int pc = F.tid + NTHR * i, t = pc >> 4, d8 = (pc & 15) * 8; kp[i] = *(const GAS v4u*)(U + (size_t)(row0 + t) * NU + U_GK + h * 128 + d8); }
        gla_decays(F, ws, wgf, bgf, wgb, bgb, row0, h, dir, dir + 1);
        LAS float* bc = (LAS float*)(F.lds + GL_BC) + dir * 8192; LAS float* bl = (LAS float*)(F.lds + GL_TOT) + 1024 + dir * 128;
        if (F.tid < 128) GLA_DEC(ws)[((size_t)ch * GLA_NCH + n) * 128 + F.tid] = __expf(bl[F.tid]);
        LAS unsigned char* ke = F.lds + GL_BC + (dir ? 0 : 32768);
#pragma unroll
        for (int i = 0; i < 2; ++i) { const int pc = F.tid + NTHR * i, t = pc >> 4, d8 = (pc & 15) * 8;
            const f32x4 b0 = *(LAS f32x4*)(bc + t * 128 + d8), b1 = *(LAS f32x4*)(bc + t * 128 + d8 + 4), l0 = *(LAS f32x4*)(bl + d8), l1 = *(LAS f32x4*)(bl + d8 + 4);
            v4u o; o.x = pk2(bflo(kp[i].x) * __expf(l0[0] - b0[0]), bfhi(kp[i].x) * __expf(l0[1] - b0[1])); o.y = pk2(bflo(kp[i].y) * __expf(l0[2] - b0[2]), bfhi(kp[i].y) * __expf(l0[3] - b0[3]));
            o.z = pk2(bflo(kp[i].z) * __expf(l1[0] - b1[0]), bfhi(kp[i].z) * __expf(l1[1] - b1[1])); o.w = pk2(bflo(kp[i].w) * __expf(l1[2] - b1[2]), bfhi(kp[i].w) * __expf(l1[3] - b1[3]));
            *(LAS v4u*)(ke + t * GL_QK_PITCH + d8 * 2) = o; }
        __syncthreads();
        f32x4 acc[8][2];
#pragma unroll
        for (int mt = 0; mt < 8; ++mt) { acc[mt][0] = (f32x4){0.f, 0.f, 0.f, 0.f}; acc[mt][1] = (f32x4){0.f, 0.f, 0.f, 0.f}; }
        const unsigned ke_a = lds_addr(ke) + GL_QK_PITCH * (8 * g + q4) + 8 * p, v_a = lds_addr(F.lds + GL_V) + GL_V_PITCH * (8 * g + q4) + 8 * p + 2 * (32 * F.wave);
#pragma unroll
        for (int ks = 0; ks < 2; ++ks) {
            TrHalf bh[2], ah[8];
#pragma unroll
            for (int nt = 0; nt < 2; ++nt) tr_issue(bh[nt], v_a + GL_V_PITCH * 32 * ks + 32 * nt, GL_V_PITCH * 4);
#pragma unroll
            for (int mt = 0; mt < 8; ++mt) tr_issue(ah[mt], ke_a + GL_QK_PITCH * 32 * ks + 32 * mt, GL_QK_PITCH * 4);
            tr_wait2(bh); tr_wait8(ah);
            const bf16x8v bv0 = tr_get(bh[0]), bv1 = tr_get(bh[1]);
#pragma unroll
            for (int mt = 0; mt < 8; ++mt) { const bf16x8v av = tr_get(ah[mt]);
                acc[mt][0] = __builtin_amdgcn_mfma_f32_16x16x32_bf16(av, bv0, acc[mt][0], 0, 0, 0); acc[mt][1] = __builtin_amdgcn_mfma_f32_16x16x32_bf16(av, bv1, acc[mt][1], 0, 0, 0); } }
        bf16* dst = GLA_DST(ws) + ((size_t)ch * GLA_NCH + n) * 256 * 128;
#pragma unroll
        for (int mt = 0; mt < 8; ++mt)
#pragma unroll
            for (int nt = 0; nt < 2; ++nt) { const int e = 32 * F.wave + 16 * nt + l15, d = 16 * mt + 4 * g; v2u w; w.x = pk2(acc[mt][nt][0], acc[mt][nt][1]); w.y = pk2(acc[mt][nt][2], acc[mt][nt][3]);
                *(GAS v2u*)(dst + (size_t)e * 128 + d) = w; }
    }
}
__device__ __forceinline__ void gla_g2(Frame& F) {
    unsigned char* const ws = PWS();
    const int NT = F.G * NTHR;
    for (int idx = F.bx * NTHR + F.tid; idx < 16 * 256 * 32; idx += NT) {
        const int ch = idx >> 13, e = (idx >> 5) & 255, d4 = (idx & 31) * 4;
        bf16* p = GLA_DST(ws) + (size_t)ch * GLA_NCH * 32768 + (size_t)e * 128 + d4; const float* dc = GLA_DEC(ws) + (size_t)ch * GLA_NCH * 128 + d4;
        f32x4 S = {0.f, 0.f, 0.f, 0.f};
#pragma unroll 4
        for (int n = 0; n < GLA_NCH; ++n) { const v2u x = *(const GAS v2u*)(p + (size_t)n * 32768); const f32x4 a = *(const GAS f32x4*)(dc + n * 128);
            v2u w; w.x = pk2(S[0], S[1]); w.y = pk2(S[2], S[3]); *(GAS v2u*)(p + (size_t)n * 32768) = w;
            S[0] = a[0] * S[0] + bflo(x.x); S[1] = a[1] * S[1] + bfhi(x.x); S[2] = a[2] * S[2] + bflo(x.y); S[3] = a[3] * S[3] + bfhi(x.y); }
    }
}
__device__ __forceinline__ void gla_g3(Frame& F, int L) {
    unsigned char* const ws = PWS(); const bf16* U = (const bf16*)(ws + WS_U);
    const float* wgf = PIN(8) + (size_t)L * 16 * 512; const float* bgf = PIN(9) + L * 512; const float* wgb = PIN(10) + (size_t)L * 16 * 512; const float* bgb = PIN(11) + L * 512;
    const float* ng = PIN(12) + L * 256;
    const int g = F.lane >> 4, q4 = (F.lane & 15) >> 2, p = F.lane & 3, l15 = F.lane & 15;
    for (int task = F.vcu; task < 8 * GLA_NCH; task += F.G) {
        const int cn = task % GLA_NCH, bh = task / GLA_NCH, h = bh & 3, b = bh >> 2;
        const int row0 = gla_chunk_row0(b, cn);
        __syncthreads();
        gla_stage_v(F, U, row0, h);
        v4u kp[2], qp[2];
#pragma unroll
        for (int i = 0; i < 2; ++i) { const int pc = F.tid + NTHR * i, t = pc >> 4, d8 = (pc & 15) * 8; const bf16* up = U + (size_t)(row0 + t) * NU + h * 128 + d8; kp[i] = *(const GAS v4u*)(up + U_GK); qp[i] = *(const GAS v4u*)(up + U_GQ); }
        gla_decays(F, ws, wgf, bgf, wgb, bgb, row0, h, 0, 2);
        v4u im[2][4];
        { LAS float* bc = (LAS float*)(F.lds + GL_BC);
#pragma unroll
          for (int i = 0; i < 2; ++i) { const int pc = F.tid + NTHR * i, t = pc >> 4, d8 = (pc & 15) * 8;
#pragma unroll
              for (int dir = 0; dir < 2; ++dir) { const f32x4 b0 = *(LAS f32x4*)(bc + dir * 8192 + t * 128 + d8), b1 = *(LAS f32x4*)(bc + dir * 8192 + t * 128 + d8 + 4);
                  float ep[8], en[8];
#pragma unroll
                  for (int j = 0; j < 4; ++j) { ep[j] = __expf(b0[j]); ep[4 + j] = __expf(b1[j]); en[j] = __expf(-b0[j]); en[4 + j] = __expf(-b1[j]); }
                  v4u qo, ko;
                  qo.x = pk2(bflo(qp[i].x) * ep[0], bfhi(qp[i].x) * ep[1]); qo.y = pk2(bflo(qp[i].y) * ep[2], bfhi(qp[i].y) * ep[3]); qo.z = pk2(bflo(qp[i].z) * ep[4], bfhi(qp[i].z) * ep[5]); qo.w = pk2(bflo(qp[i].w) * ep[6], bfhi(qp[i].w) * ep[7]);
                  ko.x = pk2(bflo(kp[i].x) * en[0], bfhi(kp[i].x) * en[1]); ko.y = pk2(bflo(kp[i].y) * en[2], bfhi(kp[i].y) * en[3]); ko.z = pk2(bflo(kp[i].z) * en[4], bfhi(kp[i].z) * en[5]); ko.w = pk2(bflo(kp[i].w) * en[6], bfhi(kp[i].w) * en[7]);
                  im[i][2 * dir] = qo; im[i][2 * dir + 1] = ko; } } }
        __syncthreads();
#pragma unroll
        for (int i = 0; i < 2; ++i) { const int pc = F.tid + NTHR * i, t = pc >> 4, d8 = (pc & 15) * 8;
#pragma unroll
            for (int k = 0; k < 4; ++k) *(LAS v4u*)(F.lds + GL_BC + k * 64 * GL_QK_PITCH + t * GL_QK_PITCH + d8 * 2) = im[i][k]; }
        __syncthreads();
        { const int dir = F.wave >> 2, nt = F.wave & 3;
          LAS unsigned char* qi = F.lds + GL_BC + (2 * dir) * 64 * GL_QK_PITCH; LAS unsigned char* ki = qi + 64 * GL_QK_PITCH;
          bf16x8v qf[4];
#pragma unroll
          for (int ks = 0; ks < 4; ++ks) qf[ks] = *(LAS bf16x8v*)(qi + (16 * nt + l15) * GL_QK_PITCH + (32 * ks + 8 * g) * 2);
#pragma unroll
          for (int mt = 0; mt < 4; ++mt) { f32x4 a = {0.f, 0.f, 0.f, 0.f};
              const bool live = dir ? (mt >= nt) : (mt <= nt);
              if (live) {
#pragma unroll
                  for (int ks = 0; ks < 4; ++ks) { const bf16x8v kf = *(LAS bf16x8v*)(ki + (16 * mt + l15) * GL_QK_PITCH + (32 * ks + 8 * g) * 2); a = __builtin_amdgcn_mfma_f32_16x16x32_bf16(kf, qf[ks], a, 0, 0, 0); } }
              const int tau = 16 * nt + l15, s0 = 16 * mt + 4 * g;
#pragma unroll
              for (int i = 0; i < 4; ++i) { const bool keep = dir ? (s0 + i >= tau) : (s0 + i <= tau); if (!keep) a[i] = 0.f; }
              v2u w; w.x = pk2(a[0], a[1]); w.y = pk2(a[2], a[3]);
              *(LAS v2u*)(F.lds + GL_A + dir * 64 * GL_A_PITCH + tau * GL_A_PITCH + s0 * 2) = w; } }
        __syncthreads();
        f32x4 acc[2][4];
#pragma unroll
        for (int mt = 0; mt < 2; ++mt)
#pragma unroll
            for (int nt = 0; nt < 4; ++nt) acc[mt][nt] = (f32x4){0.f, 0.f, 0.f, 0.f};
        { const unsigned v_a = lds_addr(F.lds + GL_V) + GL_V_PITCH * (8 * g + q4) + 8 * p + 2 * (32 * F.wave);
#pragma unroll
          for (int ks = 0; ks < 2; ++ks) { TrHalf vh[2];
#pragma unroll
              for (int mt = 0; mt < 2; ++mt) tr_issue(vh[mt], v_a + GL_V_PITCH * 32 * ks + 32 * mt, GL_V_PITCH * 4);
              tr_wait2(vh); const bf16x8v vf[2] = {tr_get(vh[0]), tr_get(vh[1])};
#pragma unroll
              for (int dir = 0; dir < 2; ++dir)
#pragma unroll
                  for (int nt = 0; nt < 4; ++nt) { const bf16x8v af = *(LAS bf16x8v*)(F.lds + GL_A + dir * 64 * GL_A_PITCH + (16 * nt + l15) * GL_A_PITCH + (32 * ks + 8 * g) * 2);
                      acc[0][nt] = __builtin_amdgcn_mfma_f32_16x16x32_bf16(vf[0], af, acc[0][nt], 0, 0, 0); acc[1][nt] = __builtin_amdgcn_mfma_f32_16x16x32_bf16(vf[1], af, acc[1][nt], 0, 0, 0); } } }
#pragma unroll
        for (int dir = 0; dir < 2; ++dir) { const int ch = (b * 2 + dir) * 4 + h, n = gla_scan_idx(cn, dir);
            const bf16* st = GLA_DST(ws) + ((size_t)ch * GLA_NCH + n) * 32768; LAS unsigned char* qi = F.lds + GL_BC + (2 * dir) * 64 * GL_QK_PITCH;
#pragma unroll
            for (int ks = 0; ks < 4; ++ks) { bf16x8v sf[2];
#pragma unroll
                for (int mt = 0; mt < 2; ++mt) sf[mt] = __builtin_bit_cast(bf16x8v, *(const GAS v4u*)(st + (size_t)(32 * F.wave + 16 * mt + l15) * 128 + 32 * ks + 8 * g));
#pragma unroll
                for (int nt = 0; nt < 4; ++nt) { const bf16x8v qf = *(LAS bf16x8v*)(qi + (16 * nt + l15) * GL_QK_PITCH + (32 * ks + 8 * g) * 2);
                    acc[0][nt] = __builtin_amdgcn_mfma_f32_16x16x32_bf16(sf[0], qf, acc[0][nt], 0, 0, 0); acc[1][nt] = __builtin_amdgcn_mfma_f32_16x16x32_bf16(sf[1], qf, acc[1][nt], 0, 0, 0); } } }
        LAS float* red = (LAS float*)(F.lds + GL_RED);
#pragma unroll
        for (int nt = 0; nt < 4; ++nt) { float s = 0.f;
#pragma unroll
            for (int mt = 0; mt < 2; ++mt)
#pragma unroll
                for (int i = 0; i < 4; ++i) s += acc[mt][nt][i] * acc[mt][nt][i];
            s += __shfl_xor(s, 16); s += __shfl_xor(s, 32);
            if (g == 0) red[F.wave * 64 + 16 * nt + l15] = s; }
        __syncthreads();
#pragma unroll
        for (int nt = 0; nt < 4; ++nt) { const int tau = 16 * nt + l15; float s = 0.f;
#pragma unroll
            for (int w = 0; w < 8; ++w) s += red[w * 64 + tau];
            const float rs = 1.0f / sqrtf(s * (1.0f / 256.0f) + LN_EPS); const size_t row = (size_t)(row0 + tau);
#pragma unroll
            for (int mt = 0; mt < 2; ++mt) { const int e = 32 * F.wave + 16 * mt + 4 * g;
                const v2u rw = *(const GAS v2u*)(U + row * NU + U_GR + h * 256 + e); const f32x4 g4 = *(const f32x4*)(ng + e);
                const float r0 = bflo(rw.x), r1 = bfhi(rw.x), r2 = bflo(rw.y), r3 = bfhi(rw.y);
                v2u w; w.x = pk2(acc[mt][nt][0] * rs * g4[0] * (r0 / (1.0f + __expf(-r0))), acc[mt][nt][1] * rs * g4[1] * (r1 / (1.0f + __expf(-r1))));
                w.y = pk2(acc[mt][nt][2] * rs * g4[2] * (r2 / (1.0f + __expf(-r2))), acc[mt][nt][3] * rs * g4[3] * (r3 / (1.0f + __expf(-r3))));
                *(GAS v2u*)(((bf16*)(ws + WS_Y + (size_t)MROWS * 1024 * 2)) + row * 1024 + h * 256 + e) = w; } }
    }
}

constexpr int NA_VPITCH = 272, NA_VIMG = 32 * NA_VPITCH, NA_WAVE_LDS = 10752;
template <bool CTXQ> __device__ __forceinline__ void na_task(const bf16* U, bf16* YN, LAS unsigned char* vimg, const LAS float* rpb, int lane, int b, int h, int r, int c0, int qrow0) {
    const int g = lane >> 4, q4 = (lane & 15) >> 2, p = lane & 3, l15 = lane & 15;
    const unsigned v_a = lds_addr(vimg) + NA_VPITCH * (4 * g + q4) + 8 * p;
    const int rs = min(max(r - 4, 0), 56), kc0 = min(max(c0 - 8, 0), 32), ctx0 = NLAT + CTXL * b;
    const int qc = c0 + l15, cs = min(max(qc - 8, 0), 48);
    constexpr int KB0 = CTXQ ? 8 : 0;
    bf16x8v qf[4];
#pragma unroll
    for (int ks = 0; ks < 4; ++ks) qf[ks] = __builtin_bit_cast(bf16x8v, *(const GAS v4u*)(U + (size_t)(qrow0 + l15) * NU + U_NQ + h * 128 + 32 * ks + 8 * g));
    f32x4 o[8];
#pragma unroll
    for (int mt = 0; mt < 8; ++mt) o[mt] = (f32x4){0.f, 0.f, 0.f, 0.f};
    float mrun = -INFINITY, lrun = 0.f;
    v4u kf[8], vv[8];
    const unsigned voffK = (unsigned)((l15 * NU + 8 * g) * 2), voffV = (unsigned)(((lane >> 4) * NU + (lane & 15) * 8) * 2);
#define NA_LOAD_BLOCK(tokexpr) do { int tok_ = (tokexpr); asm volatile("" : "+s"(tok_)); \
        const GAS char* kb_ = (const GAS char*)(U + (size_t)tok_ * NU + U_NK + h * 128); const GAS char* vb_ = (const GAS char*)(U + (size_t)tok_ * NU + U_NV + h * 128); \
        _Pragma("unroll") for (int i = 0; i < 8; ++i) kf[i] = *(const GAS v4u*)(kb_ + (size_t)(i >> 2) * (16 * NU * 2) + voffK + 64 * (i & 3)); \
        _Pragma("unroll") for (int i = 0; i < 8; ++i) vv[i] = *(const GAS v4u*)(vb_ + (size_t)i * (4 * NU * 2) + voffV); } while (0)
    NA_LOAD_BLOCK(KB0 < 8 ? b * SEQ + (rs + KB0) * 64 + kc0 : ctx0 + 32 * (KB0 - 8));
#pragma unroll 1
    for (int kb = KB0; kb < 16; ++kb) {
#pragma unroll
        for (int i = 0; i < 8; ++i) { const int id = lane + 64 * i; *(LAS v4u*)(vimg + (id >> 4) * NA_VPITCH + (id & 15) * 16) = vv[i]; }
        v4u kc_[8];
#pragma unroll
        for (int i = 0; i < 8; ++i) kc_[i] = kf[i];
        if (kb + 1 < 16) NA_LOAD_BLOCK((kb + 1) < 8 ? b * SEQ + (rs + kb + 1) * 64 + kc0 : ctx0 + 32 * (kb + 1 - 8));
        f32x4 s0 = {0.f, 0.f, 0.f, 0.f}, s1 = {0.f, 0.f, 0.f, 0.f};
#pragma unroll
        for (int ks = 0; ks < 4; ++ks) { s0 = __builtin_amdgcn_mfma_f32_16x16x32_bf16(__builtin_bit_cast(bf16x8v, kc_[ks]), qf[ks], s0, 0, 0, 0); s1 = __builtin_amdgcn_mfma_f32_16x16x32_bf16(__builtin_bit_cast(bf16x8v, kc_[4 + ks]), qf[ks], s1, 0, 0, 0); }
        if (!CTXQ && kb < 8) { int drow = rs + kb - r + 7; asm volatile("" : "+s"(drow)); const LAS float* rp = rpb + drow * 31 - qc + 15;
#pragma unroll
            for (int i = 0; i < 4; ++i) { const int k0 = kc0 + 4 * g + i, k1 = k0 + 16; const bool ok0 = k0 >= cs && k0 <= cs + 15, ok1 = k1 >= cs && k1 <= cs + 15;
                const float b0 = rp[ok0 ? k0 : qc], b1 = rp[ok1 ? k1 : qc];
                s0[i] = ok0 ? s0[i] + b0 : -INFINITY; s1[i] = ok1 ? s1[i] + b1 : -INFINITY; } }
        float mloc = fmaxf(fmaxf(fmaxf(s0[0], s0[1]), fmaxf(s0[2], s0[3])), fmaxf(fmaxf(s1[0], s1[1]), fmaxf(s1[2], s1[3])));
        mloc = fmaxf(mloc, __shfl_xor(mloc, 16)); mloc = fmaxf(mloc, __shfl_xor(mloc, 32));
        const float mnew = fmaxf(mrun, mloc), alpha = __expf(mrun - mnew); mrun = mnew;
        float ps = 0.f;
#pragma unroll
        for (int i = 0; i < 4; ++i) { s0[i] = __expf(s0[i] - mnew); s1[i] = __expf(s1[i] - mnew); ps += s0[i] + s1[i]; }
        lrun = lrun * alpha + ps;
#pragma unroll
        for (int mt = 0; mt < 8; ++mt) o[mt] *= alpha;
        v4u pw; pw.x = pk2(s0[0], s0[1]); pw.y = pk2(s0[2], s0[3]); pw.z = pk2(s1[0], s1[1]); pw.w = pk2(s1[2], s1[3]);
        const bf16x8v pf = __builtin_bit_cast(bf16x8v, pw);
        TrHalf vh[8];
#pragma unroll
        for (int mt = 0; mt < 8; ++mt) tr_issue(vh[mt], v_a + 32 * mt, NA_VPITCH * 16);
        tr_wait8(vh);
#pragma unroll
        for (int mt = 0; mt < 8; ++mt) o[mt] = __builtin_amdgcn_mfma_f32_16x16x32_bf16(tr_get(vh[mt]), pf, o[mt], 0, 0, 0);
        asm volatile("" ::: "memory"); __builtin_amdgcn_sched_barrier(0);
    }
#undef NA_LOAD_BLOCK
    lrun += __shfl_xor(lrun, 16); lrun += __shfl_xor(lrun, 32);
    const float inv = 1.0f / lrun;
    bf16* yp = YN + (size_t)(qrow0 + l15) * 1024 + h * 128 + 4 * g;
#pragma unroll
    for (int mt = 0; mt < 8; ++mt) { v2u w; w.x = pk2(o[mt][0] * inv, o[mt][1] * inv); w.y = pk2(o[mt][2] * inv, o[mt][3] * inv); *(GAS v2u*)(yp + 16 * mt) = w; }
}
__device__ __forceinline__ void na_mfma(Frame& F, int L) {
    unsigned char* const ws = PWS(); const bf16* U = (const bf16*)(ws + WS_U); bf16* YN = (bf16*)(ws + WS_Y + (size_t)MROWS * 2048 * 2);
    const float* rpbL = PIN(13) + (size_t)L * 8 * 15 * 31;
    LAS unsigned char* vimg = F.lds + RING_OFF + F.wave * NA_WAVE_LDS; LAS float* rpb = (LAS float*)(vimg + NA_VIMG);
    const int gw = F.vcu * NWAVES + F.wave, NGW = F.G * NWAVES;
    int hcur = -1;
    for (int task = gw; task < 2 * 8 * 64 * 4; task += NGW) {
        const int ct = task & 3, r = (task >> 2) & 63, h = (task >> 8) & 7, b = task >> 11;
        if (h != hcur) { hcur = h; for (int i = F.lane; i < 15 * 31; i += 64) rpb[i] = rpbL[h * 15 * 31 + i]; LDS_WAIT(); asm volatile("" ::: "memory"); }
        na_task<false>(U, YN, vimg, rpb, F.lane, b, h, r, 16 * ct, b * SEQ + r * 64 + 16 * ct);
    }
    if (L == 0) for (int tt = gw; tt < 2 * 8 * 16; tt += NGW) {
        const int qt = tt & 15, h = (tt >> 4) & 7, b = tt >> 7;
        na_task<true>(U, YN, vimg, rpb, F.lane, b, h, 0, 0, NLAT + CTXL * b + 16 * qt);
    }
}
#ifndef MK_ONE_LAUNCH
#define MK_ONE_LAUNCH 0
#endif
constexpr int PH_PER_LAYER = 11, NPH = 2 + DEPTH * PH_PER_LAYER;
enum { PL_WIN = 0, PL_MIXA, PL_MIXB, PL_MIXC, PL_BR, PL_WOUT, PL_LN1, PL_GATHER, PL_FFN1, PL_FFN2, PL_LN2 };
__device__ __forceinline__ bool in_range(int lo, int hi, int k) { asm volatile("" : "+s"(lo), "+s"(hi)); return lo <= k && k < hi; }
#ifndef PHMASK
#define PHMASK 0xFFFFFFFFu
#endif
#define IN(k) in_range(lo, hi, (k))
#define EN(bit) ((PHMASK >> (bit)) & 1u)
#ifndef DUPMASK
#define DUPMASK 0u
#endif
#define DUP(bit) ((DUPMASK >> (bit)) & 1u)
#define SEAM(k) do { if (IN((k) + 1)) GRID_BAR(); } while (0)
#if MK_ONE_LAUNCH
#define GRID_BAR() xcd_barrier(bar)
#else
#define GRID_BAR() do { if (F.tid == 0) __hip_atomic_store((gu32*)(PWS() + WS_CTL) + CW_TMO, 0xBADBA0u, RLX_AGENT); } while (0)
#endif
template <int L> __device__ __forceinline__ void layer_phases(const Args& A, LAS unsigned char* const ldsb, const XcdBarrier& bar, const int lo, const int hi) {
    LAS unsigned char* const ring = ldsb + RING_OFF;
        const int pb = 2 + PH_PER_LAYER * L, Mr = (L == 0) ? MROWS : NLAT;
        if (EN(2) && IN(pb + PL_WIN)) { Frame F = mkframe(ldsb, A.grid);
            unsigned char* const ws = PWS();
            lr_tiles(F, L);
            pg8::Gemm g{((bf16*)(ws + WS_H)), w_in_t(ws, L), D, D}; pg8::StaticOrder S; S.init(MROWS, NU, F.G, F.bx);
            pg8::EpiU E{((bf16*)(ws + WS_U)), NU};
            pg8::gemm_phase<pg8::EpiU, pg8::StaticOrder, true, true>(ring, g, S, E);
            SEAM(pb + PL_WIN);
        }
        if (EN(3) && IN(pb + PL_MIXA)) { Frame F = mkframe(ldsb, A.grid); gla_g1(F, L); mix_prep(F, L); if (DUP(3)) { __syncthreads(); gla_g1(F, L); mix_prep(F, L); } SEAM(pb + PL_MIXA); }
        if (EN(4) && IN(pb + PL_MIXB)) { Frame F = mkframe(ldsb, A.grid); gla_g2(F); { int nrep = 1 + (int)DUP(4); asm volatile("" : "+s"(nrep)); for (int rep = 0; rep < nrep; ++rep) { if (rep) __syncthreads(); na_mfma(F, L); } } if (DUP(13)) { VM_WAIT(); __syncthreads(); gla_g2(F); } SEAM(pb + PL_MIXB); }
        if (EN(5) && IN(pb + PL_MIXC)) { Frame F = mkframe(ldsb, A.grid); gla_g3(F, L); if (DUP(5)) { __syncthreads(); gla_g3(F, L); } SEAM(pb + PL_MIXC); }
        if (EN(6) && IN(pb + PL_BR)) { Frame F = mkframe(ldsb, A.grid);
            unsigned char* const ws = PWS(); const float* const gate_b = PIN(17) + (size_t)L * 3 * D;
            pg8::Gemm g{((bf16*)(ws + WS_Y)), w_br_t(ws, L, 0), 1024, 1024}; pg8::BranchOrder S; S.init(Mr, D, F.G, F.bx, MROWS / 256, D / 256);
            pg8::EpiGate E{((bf16*)(ws + WS_U)) + U_GATE, NU, gate_b, ((float*)(ws + WS_Z)), ((bf16*)(ws + WS_ZB))};
            pg8::gemm_phase<pg8::EpiGate, pg8::BranchOrder, true, true>(ring, g, S, E);
            SEAM(pb + PL_BR);
        }
        if (EN(7) && IN(pb + PL_WOUT)) { Frame F = mkframe(ldsb, A.grid);
            unsigned char* const ws = PWS(); const float* const modL = ((float*)(ws + WS_MOD)) + (size_t)L * 3 * 12288; const float* const xin = PIN(0); const float* const cin = PIN(2);
            { pg8::Gemm g{((bf16*)(ws + WS_ZB)), w_out_t(ws, L), D, D}; pg8::StaticOrder S; S.init(NLAT, D, F.G, F.bx);
              pg8::EpiRes<false> E{L == 0 ? xin : ((float*)(ws + WS_XL)), cin, modL + 2 * D, 12288, ((float*)(ws + WS_PRE)), ALPHA, 1.0f};
              pg8::gemm_phase<pg8::EpiRes<false>, pg8::StaticOrder, true, true>(ring, g, S, E); }
            if (L == 0) {
              pg8::Gemm g{((bf16*)(ws + WS_ZB)), w_out_t(ws, L), D, 256}; pg8::SplitOrder S; S.init(NLAT / 256, D / 256, 8, 256, F.G, F.bx, 0);
              pg8::EpiPartial<false> E{((float*)(ws + WS_PART)), NLAT / 256, 1.0f};
              pg8::gemm_phase<pg8::EpiPartial<false>, pg8::SplitOrder, false, false>(ring, g, S, E); }
            SEAM(pb + PL_WOUT);
        }
        if (EN(8) && IN(pb + PL_LN1)) { Frame F = mkframe(ldsb, A.grid); ln1_phase(F, L, Mr); SEAM(pb + PL_LN1); }
        if (L == 0) {
            if (EN(10) && IN(pb + PL_FFN1)) { Frame F = mkframe(ldsb, A.grid);
                unsigned char* const ws = PWS();
                pg8::Gemm g{((bf16*)(ws + WS_H)), (const bf16*)w_gu_t(ws, -1), D, D}; pg8::StaticOrder S; S.init(MROWS, NGU, F.G, F.bx);
                pg8::EpiSwiGLU E{((bf16*)(ws + WS_U)), FF};
                pg8::gemm_phase<pg8::EpiSwiGLU, pg8::StaticOrder, true, true>(ring, g, S, E);
                SEAM(pb + PL_FFN1);
            }
            if (EN(11) && IN(pb + PL_FFN2)) { Frame F = mkframe(ldsb, A.grid);
                unsigned char* const ws = PWS(); const float* const modL = ((float*)(ws + WS_MOD)) + (size_t)L * 3 * 12288;
                { pg8::Gemm g{((bf16*)(ws + WS_U)), (const bf16*)w_d_t(ws, -1), FF, FF}; pg8::StaticOrder S; S.init(NLAT, D, F.G, F.bx);
                  pg8::EpiRes<false> E{((float*)(ws + WS_XL)), ((float*)(ws + WS_XL)) + (size_t)NLAT * D, modL + 5 * D, 12288, ((float*)(ws + WS_PRE)), ALPHA, 1.0f};
                  pg8::gemm_phase<pg8::EpiRes<false>, pg8::StaticOrder, true, true>(ring, g, S, E); }
                { pg8::Gemm g{((bf16*)(ws + WS_U)), (const bf16*)w_d_t(ws, -1), FF, 512}; pg8::SplitOrder S; S.init(NLAT / 256, D / 256, 11, 512, F.G, F.bx, 0);
                  pg8::EpiPartial<false> E{((float*)(ws + WS_PART)), NLAT / 256, 1.0f};
                  pg8::gemm_phase<pg8::EpiPartial<false>, pg8::SplitOrder, false, false>(ring, g, S, E); }
                SEAM(pb + PL_FFN2);
            }
            if (EN(12) && IN(pb + PL_LN2)) { Frame F = mkframe(ldsb, A.grid); ln2_dense(F, L); if (DUP(12)) { __syncthreads(); ln2_dense(F, L); } SEAM(pb + PL_LN2); }
        } else {
            if (EN(9) && IN(pb + PL_GATHER)) { Frame F = mkframe(ldsb, A.grid); moe_gather(F); SEAM(pb + PL_GATHER); }
            if (EN(10) && IN(pb + PL_FFN1)) { Frame F = mkframe(ldsb, A.grid);
                unsigned char* const ws = PWS();
                unsigned cnt[8]; int pp[9]; moe_prefix(ws, cnt, pp);
                pg8::Gemm g{((bf16*)(ws + WS_GLA)), (const bf16*)w_gu_t(ws, 0), D / 2, D / 2}; pg8::MoeOrder S; S.init(cnt, NGU / 256, F.G, F.bx);
                pg8::EpiSwiGLU8 E{ws + WS_U, FF, 1.0f / FSC_WGU, FSC_HID};
                pg8::gemm_phase<pg8::EpiSwiGLU8, pg8::MoeOrder, true, true, true>(ring, g, S, E);
                SEAM(pb + PL_FFN1);
            }
            if (EN(11) && IN(pb + PL_FFN2)) { Frame F = mkframe(ldsb, A.grid);
                unsigned char* const ws = PWS(); const float* const modL = ((float*)(ws + WS_MOD)) + (size_t)L * 3 * 12288;
                unsigned cnt[8]; int pp[9]; moe_prefix(ws, cnt, pp);
                pg8::Gemm g{((bf16*)(ws + WS_U)), (const bf16*)w_d_t(ws, 0), FF / 2, FF / 2}; pg8::MoeOrder S; S.init(cnt, D / 256, F.G, F.bx);
                pg8::EpiF32Plain E{((float*)(ws + WS_Z)), D, 1.0f / (FSC_HID * FSC_WD)};
                pg8::gemm_phase<pg8::EpiF32Plain, pg8::MoeOrder, true, true, true>(ring, g, S, E);
                SEAM(pb + PL_FFN2);
            }
            if (EN(12) && IN(pb + PL_LN2)) { Frame F = mkframe(ldsb, A.grid); ln2_moe(F, L); }
        }
    }
__global__ void __launch_bounds__(NTHR, 2) fwd_kernel(Args A) {
    __shared__ __attribute__((aligned(16))) unsigned char lds[LDS_BYTES];
    LAS unsigned char* const ldsb = (LAS unsigned char*)lds;
    { Frame F = mkframe(ldsb, A.grid);
    for (int u = F.tid; u < (LDS_BYTES - LDSCTL_OFF) / 4; u += NTHR) ((LAS unsigned*)(F.lds + LDSCTL_OFF))[u] = 0u;
    __syncthreads();
    if (F.tid < 32) { const unsigned long long p = F.tid < 30 ? (unsigned long long)A.in[F.tid] : (F.tid == 30 ? (unsigned long long)A.out : (unsigned long long)A.ws);
        ((LAS unsigned long long*)(F.lds + PTAB_OFF))[F.tid] = p; }
    __syncthreads(); }
#if MK_ONE_LAUNCH
    XcdBarrier bar; { Frame F = mkframe(ldsb, A.grid); bar = xcd_barrier_post((unsigned*)(PWS() + WS_CTL) + CW_BAR, F.MISC + 8, (unsigned)A.grid); }
#else
    XcdBarrier bar; bar.bar = nullptr; bar.x = 0; bar.grid = 0; bar.st = nullptr;
#endif
    const int lo = A.ph_lo, hi = A.ph_hi;
    LAS unsigned char* const ring = ldsb + RING_OFF;

    if (EN(0) && IN(0)) { Frame F = mkframe(ldsb, A.grid); p0a_prologue(F); if (DUP(0)) { __syncthreads(); p0a_prologue(F); } SEAM(0); }
    if (EN(1) && IN(1)) { Frame F = mkframe(ldsb, A.grid); p0b_modulate(F); if (DUP(1)) { __syncthreads(); p0b_modulate(F); } SEAM(1); }
    layer_phases<0>(A, ldsb, bar, lo, hi);
    layer_phases<1>(A, ldsb, bar, lo, hi);
}

extern "C" void kernel_launch(void* const* d_in, const int* in_sizes, int n_in, void* d_out, int out_size, void* d_ws, size_t ws_size, hipStream_t stream) {
    static int grid = 0;
    if (grid == 0) {
        if (n_in != 30 || out_size != NLAT * D || ws_size < WS_END) { fprintf(stderr, "kernel_launch: unexpected shapes (n_in %d out %d ws %zu); nothing launched\n", n_in, out_size, ws_size); grid = -1; return; }
        int dev = 0, cus = 0, per_cu = 0;
        if (hipGetDevice(&dev) != hipSuccess || hipDeviceGetAttribute(&cus, hipDeviceAttributeMultiprocessorCount, dev) != hipSuccess) { grid = -1; return; }
        if (hipOccupancyMaxActiveBlocksPerMultiprocessor(&per_cu, (const void*)fwd_kernel, NTHR, 0) != hipSuccess || per_cu < 1) { fprintf(stderr, "kernel_launch: occupancy query says %d\n", per_cu); (void)hipGetLastError(); grid = -1; return; }
        grid = cus;
    }
    if (grid < 0) return;
    (void)hipMemsetAsync((char*)d_ws + WS_CTL, 0, CTL_ZERO_BYTES, stream);
    Args a{};
    for (int i = 0; i < 30; ++i) a.in[i] = (const float*)d_in[i];
    a.out = (float*)d_out; a.ws = (unsigned char*)d_ws; a.grid = grid;
#if MK_ONE_LAUNCH
    a.ph_lo = 0; a.ph_hi = NPH;
    hipLaunchKernelGGL(fwd_kernel, dim3(grid), dim3(NTHR), 0, stream, a);
#else
#ifndef NPH_RUN
#define NPH_RUN NPH
#endif
    for (int p = 0; p < NPH_RUN; ++p) {
        if (p == 2 + PL_GATHER) continue;
        a.ph_lo = p; a.ph_hi = p + 1;
        hipLaunchKernelGGL(fwd_kernel, dim3(grid), dim3(NTHR), 0, stream, a);
    }
#endif
}
```

```cpp
#define MK_ONE_LAUNCH 1
#include <hip/hip_runtime.h>
#include <cstdio>

namespace pg8 {
#define PG8_LAS __attribute__((address_space(3)))
typedef unsigned short bf16_t;
typedef short bf16x8 __attribute__((ext_vector_type(8)));
typedef float f32x4 __attribute__((ext_vector_type(4)));
typedef unsigned u32x4 __attribute__((ext_vector_type(4)));
typedef unsigned u32x2 __attribute__((ext_vector_type(2)));
typedef int i32x4 __attribute__((ext_vector_type(4)));
typedef int i32x8 __attribute__((ext_vector_type(8)));
constexpr int BM = 256, BK = 64, HALF = 128, HTB = HALF * BK * 2  , STAGE_BYTES = 8 * HTB, NXCD = 8, WGM = 8;

__host__ __device__ __forceinline__ int lds_byte(int r, int c) { const int st = (r >> 4) * 2 + (c >> 5), rr = r & 15, cc = c & 31, ob = rr * 64 + cc * 2; return st * 1024 + (ob ^ (((ob >> 9) & 1) << 5)); }
__host__ __device__ __forceinline__ void stage_rc(int b, int& R, int& C) { const int st = b / 1024, sb = b % 1024, swz = sb ^ (((sb >> 9) & 1) << 5); R = (st >> 1) * 16 + swz / 64; C = (st & 1) * 32 + (swz % 64) / 2; }
__host__ __device__ __forceinline__ int perm32(int rho) { const int n = rho >> 4, i = rho & 15; return 8 * (i >> 2) + 4 * n + (i & 3); }

struct Unit { int pm, pn, pa, pb, ko, aux; };
struct Gemm { const bf16_t* A; const bf16_t* Bt; int K, KT; };

__device__ __forceinline__ int xcd_remap(int wgid, int nwg) { const int q = nwg / NXCD, r = nwg % NXCD, xcd = wgid % NXCD, off = wgid / NXCD; return (xcd < r ? xcd * (q + 1) : r * (q + 1) + (xcd - r) * q) + off; }
struct StaticOrder {
    int nM, nN, nwg, G, c;
    __host__ __device__ void init(int M, int N, int G_, int c_) { nM = M / BM; nN = N / BM; nwg = nM * nN; G = G_; c = c_; }
    __device__ __forceinline__ bool next(int i, Unit& u) const {
        const long L = (long)i * G + c; if (L >= nwg) return false;
        const int wgid = xcd_remap((int)L, nwg);
        const int nig = WGM * nN, gid = wgid / nig, fm = gid * WGM, gsz = (nM - fm) < WGM ? (nM - fm) : WGM;
        u.pm = fm + ((wgid % nig) % gsz); u.pn = (wgid % nig) / gsz; u.pa = u.pm; u.pb = u.pn; u.ko = 0; u.aux = 0; return true;
    }
    __device__ __forceinline__ void a_ready(const Unit&) const {}
    __device__ __forceinline__ void done(const Unit&) const {}
};
struct MoeOrder {
    int nN, G, c, nunits, abucket; int pp[9];
    __device__ __forceinline__ void init(const unsigned* cnt, int nN_, int G_, int c_, int abucket_) { nN = nN_; G = G_; c = c_; abucket = abucket_; pp[0] = 0;
#pragma unroll
        for (int e = 0; e < 8; ++e) pp[e + 1] = pp[e] + (int)((cnt[e] + 255u) >> 8);
        nunits = pp[8] * nN; }
    __device__ __forceinline__ bool next(int i, Unit& u) const {
        const long L = (long)i * G + c; if (L >= nunits) return false;
        const int wgid = xcd_remap((int)L, nunits);
        int e = 0, base = 0, npe = pp[1];
#pragma unroll
        for (int k = 1; k < 8; ++k) { if (wgid >= pp[k] * nN) { e = k; base = pp[k]; npe = pp[k + 1] - pp[k]; } }
        if (npe < 1) npe = 1;
        const int local = wgid - base * nN;
        u.pm = base + local % npe; u.pn = local / npe; u.pa = abucket ? e * abucket + local % npe : u.pm; u.pb = e * nN + u.pn; u.ko = 0; u.aux = 0; return true;
    }
    __device__ __forceinline__ void a_ready(const Unit&) const {}
    __device__ __forceinline__ void done(const Unit&) const {}
};

struct BranchOrder {
    StaticOrder S; int apanels, bpanels;
    __device__ __forceinline__ void init(int M, int N, int G_, int c_, int apan, int bpan) { S.init(M, N, G_, c_); apanels = apan; bpanels = bpan; }
    __device__ __forceinline__ bool next(int i, Unit& u) const { const int j = i / 3, b = i - 3 * j; if (!S.next(j, u)) return false; u.pa = b * apanels + u.pm; u.pb = b * bpanels + u.pn; u.aux = b; return true; }
    __device__ __forceinline__ void a_ready(const Unit&) const {}
    __device__ __forceinline__ void done(const Unit&) const {}
};
struct SplitOrder {
    int pm0, nN, nsplit, KT, G, c, rot;
    __device__ __forceinline__ void init(int pm0_, int nN_, int nsplit_, int KT_, int G_, int c_, int rot_) { pm0 = pm0_; nN = nN_; nsplit = nsplit_; KT = KT_; G = G_; c = c_; rot = rot_; }
    __device__ __forceinline__ bool next(int i, Unit& u) const {
        int cc = c - rot; if (cc < 0) cc += G;
        const long L = (long)i * G + cc; if (L >= 2 * nN * nsplit) return false;
        const int s = (int)L % nsplit, tile = (int)L / nsplit;
        u.pm = pm0 + tile / nN; u.pn = tile % nN; u.pa = u.pm; u.pb = u.pn; u.ko = s * KT; u.aux = s; return true;
    }
    __device__ __forceinline__ void a_ready(const Unit&) const {}
    __device__ __forceinline__ void done(const Unit&) const {}
};

__device__ __forceinline__ unsigned cvt_pk_bf16(float lo, float hi) { unsigned r; asm volatile("v_cvt_pk_bf16_f32 %0, %1, %2" : "=v"(r) : "v"(lo), "v"(hi)); return r; }
__device__ __forceinline__ unsigned pk_fp8x4(float a, float b, float c, float d) { int v = __builtin_amdgcn_cvt_pk_fp8_f32(a, b, 0, false); v = __builtin_amdgcn_cvt_pk_fp8_f32(c, d, v, true); return (unsigned)v; }
__device__ __forceinline__ float clamp448(float x) { return fminf(fmaxf(x, -448.0f), 448.0f); }
__device__ __forceinline__ float bf_lo(unsigned w) { return __uint_as_float(w << 16); }
__device__ __forceinline__ float bf_hi(unsigned w) { return __uint_as_float(w & 0xffff0000u); }
__device__ __forceinline__ float fast_sigmoid(float x) { return __builtin_amdgcn_rcpf(1.0f + __expf(-x)); }

struct EpiBf16Plain {
    static constexpr bool PERM = true, AFTER_DRAIN = false;
    bf16_t* O; int ldc; float oscale;
    __device__ __forceinline__ void operator()(const f32x4 (&acc)[2][2][4][2], const Unit& u, int wr, int wc, int fr, int fq) const {
        const int row0 = u.pm * BM + wr * 64 + fr, col0 = u.pn * BM + wc * 32 + 8 * fq;
#pragma unroll
        for (int ai = 0; ai < 2; ++ai)
#pragma unroll
            for (int m = 0; m < 4; ++m) { bf16_t* rowp = O + (size_t)(row0 + ai * HALF + m * 16) * ldc + col0;
#pragma unroll
                for (int bj = 0; bj < 2; ++bj) { const f32x4 v0 = acc[ai][bj][m][0] * oscale, v1 = acc[ai][bj][m][1] * oscale;
                    u32x4 w; w.x = cvt_pk_bf16(v0[0], v0[1]); w.y = cvt_pk_bf16(v0[2], v0[3]); w.z = cvt_pk_bf16(v1[0], v1[1]); w.w = cvt_pk_bf16(v1[2], v1[3]);
                    *(u32x4*)(rowp + bj * HALF) = w; } }
    }
};
struct EpiU {
    static constexpr bool PERM = true, AFTER_DRAIN = false;
    bf16_t* O; int ldc;
    __device__ __forceinline__ void operator()(const f32x4 (&acc)[2][2][4][2], const Unit& u, int wr, int wc, int fr, int fq) const {
        const int row0 = u.pm * BM + wr * 64 + fr, col0 = u.pn * BM + wc * 32 + 8 * fq;
        const bool is_gq = (u.pn == 12 || u.pn == 13), is_gk = (u.pn == 14 || u.pn == 15), is_nq = (u.pn >= 24 && u.pn < 28);
        const float sc = (is_gq || is_nq) ? 0.08838834764831845f : 1.0f;
        const bool rope = (is_gq || is_gk) && u.pm < 32;
        float inv[4];
#pragma unroll
        for (int j = 0; j < 4; ++j) inv[j] = exp2f(-(float)((16 * wc + 4 * fq + j) & 31) * 0.41524101186092029f);
#pragma unroll
        for (int ai = 0; ai < 2; ++ai)
#pragma unroll
            for (int m = 0; m < 4; ++m) { const int row = row0 + ai * HALF + m * 16; bf16_t* rowp = O + (size_t)row * ldc + col0;
                const int t = row & 4095; const float pos = (wc < 2) ? (float)(t >> 6) : (float)(t & 63);
                float cs[4], sn[4];
                if (rope) {
#pragma unroll
                    for (int j = 0; j < 4; ++j) { const float ang = pos * inv[j]; cs[j] = __cosf(ang); sn[j] = __sinf(ang); } }
#pragma unroll
                for (int bj = 0; bj < 2; ++bj) { f32x4 v0 = acc[ai][bj][m][0] * sc, v1 = acc[ai][bj][m][1] * sc;
                    if (rope) { const f32x4 a = v0, b = v1;
                        v0[0] = a[0] * cs[0] - a[1] * sn[0]; v0[1] = a[0] * sn[0] + a[1] * cs[0]; v0[2] = a[2] * cs[1] - a[3] * sn[1]; v0[3] = a[2] * sn[1] + a[3] * cs[1];
                        v1[0] = b[0] * cs[2] - b[1] * sn[2]; v1[1] = b[0] * sn[2] + b[1] * cs[2]; v1[2] = b[2] * cs[3] - b[3] * sn[3]; v1[3] = b[2] * sn[3] + b[3] * cs[3]; }
                    u32x4 w; w.x = cvt_pk_bf16(v0[0], v0[1]); w.y = cvt_pk_bf16(v0[2], v0[3]); w.z = cvt_pk_bf16(v1[0], v1[1]); w.w = cvt_pk_bf16(v1[2], v1[3]);
                    *(u32x4*)(rowp + bj * HALF) = w; } }
    }
};
struct EpiF32Plain {
    static constexpr bool PERM = false, AFTER_DRAIN = false;
    float* C; int ldc; float oscale;
    __device__ __forceinline__ void operator()(const f32x4 (&acc)[2][2][4][2], const Unit& u, int wr, int wc, int fr, int fq) const {
        const int row0 = u.pm * BM + wr * 64 + fr, col0 = u.pn * BM + wc * 32 + 4 * fq;
#pragma unroll
        for (int ai = 0; ai < 2; ++ai)
#pragma unroll
            for (int m = 0; m < 4; ++m) { float* rowp = C + (size_t)(row0 + ai * HALF + m * 16) * ldc + col0;
#pragma unroll
                for (int bj = 0; bj < 2; ++bj)
#pragma unroll
                    for (int n = 0; n < 2; ++n) *(f32x4*)(rowp + bj * HALF + n * 16) = acc[ai][bj][m][n] * oscale; }
    }
};
template <bool SC> struct EpiPartial {
    static constexpr bool PERM = false, AFTER_DRAIN = false;
    float* P; int pm0; float oscale;
    __device__ __forceinline__ void operator()(const f32x4 (&acc)[2][2][4][2], const Unit& u, int wr, int wc, int fr, int fq) const {
        const int row0 = (u.pm - pm0) * BM + wr * 64 + fr, col0 = u.pn * BM + wc * 32 + 4 * fq; float* base = P + (size_t)u.aux * 512 * 2048;
#pragma unroll
        for (int ai = 0; ai < 2; ++ai)
#pragma unroll
            for (int m = 0; m < 4; ++m) { float* rowp = base + (size_t)(row0 + ai * HALF + m * 16) * 2048 + col0;
#pragma unroll
                for (int bj = 0; bj < 2; ++bj)
#pragma unroll
                    for (int n = 0; n < 2; ++n) *(f32x4*)(rowp + bj * HALF + n * 16) = SC ? acc[ai][bj][m][n] * oscale : acc[ai][bj][m][n]; }
    }
};
struct EpiGate {
    static constexpr bool PERM = false, AFTER_DRAIN = false;
    const bf16_t* Ug; int ldu;
    const float* gb;
    bf16_t* ZB;
    __device__ __forceinline__ void operator()(const f32x4 (&acc)[2][2][4][2], const Unit& u, int wr, int wc, int fr, int fq) const {
        const int row0 = u.pm * BM + wr * 64 + fr, col0 = u.pn * BM + wc * 32 + 4 * fq; const bool first = u.aux == 0;
        const bf16_t* Ub = Ug + 2048 * u.aux + col0; const float* gbb = gb + 2048 * u.aux + col0; bf16_t* zb = ZB + col0;
        f32x4 b4[2][2];
#pragma unroll
        for (int bj = 0; bj < 2; ++bj)
#pragma unroll
            for (int n = 0; n < 2; ++n) b4[bj][n] = *(const f32x4*)(gbb + bj * HALF + n * 16);
#pragma unroll
        for (int ai = 0; ai < 2; ++ai) {
            u32x2 gl[4][2][2], zp[4][2][2];
#pragma unroll
            for (int m = 0; m < 4; ++m) { const size_t row = (size_t)(row0 + ai * HALF + m * 16);
#pragma unroll
                for (int bj = 0; bj < 2; ++bj)
#pragma unroll
                    for (int n = 0; n < 2; ++n) { gl[m][bj][n] = *(const u32x2*)(Ub + row * ldu + bj * HALF + n * 16); if (!first) zp[m][bj][n] = *(const u32x2*)(zb + row * 2048 + bj * HALF + n * 16); } }
#pragma unroll
            for (int m = 0; m < 4; ++m) { const size_t row = (size_t)(row0 + ai * HALF + m * 16);
#pragma unroll
                for (int bj = 0; bj < 2; ++bj)
#pragma unroll
                    for (int n = 0; n < 2; ++n) { const u32x2 g2 = gl[m][bj][n]; f32x4 v = acc[ai][bj][m][n];
                        v[0] *= fast_sigmoid(bf_lo(g2.x) + b4[bj][n][0]); v[1] *= fast_sigmoid(bf_hi(g2.x) + b4[bj][n][1]); v[2] *= fast_sigmoid(bf_lo(g2.y) + b4[bj][n][2]); v[3] *= fast_sigmoid(bf_hi(g2.y) + b4[bj][n][3]);
                        if (!first) { const u32x2 z2 = zp[m][bj][n]; v[0] += bf_lo(z2.x); v[1] += bf_hi(z2.x); v[2] += bf_lo(z2.y); v[3] += bf_hi(z2.y); }
                        u32x2 w; w.x = cvt_pk_bf16(v[0], v[1]); w.y = cvt_pk_bf16(v[2], v[3]); *(u32x2*)(zb + row * 2048 + bj * HALF + n * 16) = w; } }
            asm volatile("" ::: "memory"); }
    }
};
template <bool SC> struct EpiRes {
    static constexpr bool PERM = false, AFTER_DRAIN = false;
    const float* res_lat; const float* res_ctx; const float* gv; int gstride; float* out; float alpha, oscale;
    __device__ __forceinline__ void operator()(const f32x4 (&acc)[2][2][4][2], const Unit& u, int wr, int wc, int fr, int fq) const {
        const int grp = u.pm < 16 ? 0 : (u.pm < 32 ? 1 : 2);
        const int rl0 = wr * 64 + fr, col0 = u.pn * BM + wc * 32 + 4 * fq;
        const float* res = (u.pm < 32 ? res_lat + (size_t)u.pm * BM * 2048 : res_ctx + (size_t)(u.pm - 32) * BM * 2048) + col0;
        const float* g = gv + (size_t)grp * gstride + col0; float* o = out + (size_t)u.pm * BM * 2048 + col0;
        f32x4 g4[2][2];
#pragma unroll
        for (int bj = 0; bj < 2; ++bj)
#pragma unroll
            for (int n = 0; n < 2; ++n) g4[bj][n] = *(const f32x4*)(g + bj * HALF + n * 16);
#pragma unroll
        for (int q = 0; q < 4; ++q) {
            const int ai = q >> 1, m0 = (q & 1) * 2;
            f32x4 r4[2][2][2];
#pragma unroll
            for (int m = 0; m < 2; ++m)
#pragma unroll
                for (int bj = 0; bj < 2; ++bj)
#pragma unroll
                    for (int n = 0; n < 2; ++n) r4[m][bj][n] = *(const f32x4*)(res + (size_t)(rl0 + ai * HALF + (m0 + m) * 16) * 2048 + bj * HALF + n * 16);
#pragma unroll
            for (int m = 0; m < 2; ++m)
#pragma unroll
                for (int bj = 0; bj < 2; ++bj)
#pragma unroll
                    for (int n = 0; n < 2; ++n) *(f32x4*)(o + (size_t)(rl0 + ai * HALF + (m0 + m) * 16) * 2048 + bj * HALF + n * 16) = r4[m][bj][n] * alpha + g4[bj][n] * (SC ? acc[ai][bj][m0 + m][n] * oscale : acc[ai][bj][m0 + m][n]);
            asm volatile("" ::: "memory"); }
    }
};
struct EpiSwiGLU {
    static constexpr bool PERM = true, AFTER_DRAIN = false;
    bf16_t* O; int ldc;
    __device__ __forceinline__ void operator()(const f32x4 (&acc)[2][2][4][2], const Unit& u, int wr, int wc, int fr, int fq) const {
        const int row0 = u.pm * BM + wr * 64 + fr, col0 = u.pn * HALF + wc * 32 + 8 * fq;
#pragma unroll
        for (int ai = 0; ai < 2; ++ai)
#pragma unroll
            for (int m = 0; m < 4; ++m) { bf16_t* rowp = O + (size_t)(row0 + ai * HALF + m * 16) * ldc + col0;
                float h[8];
#pragma unroll
                for (int n = 0; n < 2; ++n)
#pragma unroll
                    for (int j = 0; j < 4; ++j) { const float gt = acc[ai][0][m][n][j], up = acc[ai][1][m][n][j]; h[n * 4 + j] = gt * fast_sigmoid(gt) * up; }
                u32x4 w; w.x = cvt_pk_bf16(h[0], h[1]); w.y = cvt_pk_bf16(h[2], h[3]); w.z = cvt_pk_bf16(h[4], h[5]); w.w = cvt_pk_bf16(h[6], h[7]);
                *(u32x4*)rowp = w; }
    }
};
struct EpiSwiGLU8 {
    static constexpr bool PERM = true, AFTER_DRAIN = false;
    unsigned char* O; int ldc; float oscale, hscale;
    __device__ __forceinline__ void operator()(const f32x4 (&acc)[2][2][4][2], const Unit& u, int wr, int wc, int fr, int fq) const {
        const int row0 = u.pm * BM + wr * 64 + fr, col0 = u.pn * HALF + wc * 32 + 8 * fq;
#pragma unroll
        for (int ai = 0; ai < 2; ++ai)
#pragma unroll
            for (int m = 0; m < 4; ++m) { unsigned char* rowp = O + (size_t)(row0 + ai * HALF + m * 16) * ldc + col0;
                float h[8];
#pragma unroll
                for (int n = 0; n < 2; ++n)
#pragma unroll
                    for (int j = 0; j < 4; ++j) { const float gt = acc[ai][0][m][n][j] * oscale, up = acc[ai][1][m][n][j] * oscale; h[n * 4 + j] = clamp448(gt * fast_sigmoid(gt) * up * hscale); }
                u32x2 w; w.x = pk_fp8x4(h[0], h[1], h[2], h[3]); w.y = pk_fp8x4(h[4], h[5], h[6], h[7]);
                *(u32x2*)rowp = w; }
    }
};

template <class Epi, class Sched, bool ALIGN_EPI = false, bool SP2 = false, bool F8 = false>
__device__ __forceinline__ void gemm_phase(PG8_LAS unsigned char* lds, const Gemm g, const Sched& S, const Epi& E) {
    int tid_ = threadIdx.x; asm volatile("" : "+v"(tid_));
    const int tid = tid_, wid = __builtin_amdgcn_readfirstlane(tid >> 6), lane = tid & 63, wr = wid >> 2, wc = wid & 3, fr = lane & 15, fq = lane >> 4;
    const int K = g.K, nt = g.KT / BK;
    unsigned voffA[2], voffB[2];
#pragma unroll
    for (int i = 0; i < 2; ++i) { int R, C; stage_rc(tid * 16 + i * 8192, R, C); const int Rb = Epi::PERM ? ((R & ~31) + perm32(R & 31)) : R;
        voffA[i] = (unsigned)(R * K + C) * 2u; voffB[i] = (unsigned)(Rb * K + C) * 2u; }
    const size_t kstep = (size_t)(BK * 2);
    const size_t hstep = (size_t)HALF * K * 2;
    const size_t tstep = 2 * hstep;
    const unsigned ldsw = (unsigned)wid * 1024u;
    const int aoff = lds_byte(wr * 64 + fr, fq * 8), boff = lds_byte(wc * 32 + fr, fq * 8);
#define PG8_SA(b, h) (((b) * 2 + (h)) * HTB)
#define PG8_SB(b, h) ((4 + (b) * 2 + (h)) * HTB)
#define PG8_STAGE(bufoff, gbase, voff) do { _Pragma("unroll") for (int _i = 0; _i < 2; ++_i) \
        __builtin_amdgcn_global_load_lds((const unsigned*)((const char*)(gbase) + (voff)[_i]), (PG8_LAS unsigned*)(lds + (bufoff) + ldsw + _i * 8192), 16, 0, 0); } while (0)
#define PG8_CAT(p) __builtin_shufflevector(*(const PG8_LAS i32x4*)(p), *(const PG8_LAS i32x4*)((p) + 1024), 0, 1, 2, 3, 4, 5, 6, 7)
#define PG8_LDA(dst, b, h) do { _Pragma("unroll") for (int m = 0; m < 4; ++m) { if constexpr (F8) dst##8[m] = PG8_CAT(lds + PG8_SA(b, h) + aoff + m * 2048); else { _Pragma("unroll") for (int k = 0; k < 2; ++k) dst[m][k] = *(const PG8_LAS bf16x8*)(lds + PG8_SA(b, h) + aoff + m * 2048 + k * 1024); } } } while (0)
#define PG8_LDB(dst, b, h) do { _Pragma("unroll") for (int n = 0; n < 2; ++n) { if constexpr (F8) dst##8[n] = PG8_CAT(lds + PG8_SB(b, h) + boff + n * 2048); else { _Pragma("unroll") for (int k = 0; k < 2; ++k) dst[n][k] = *(const PG8_LAS bf16x8*)(lds + PG8_SB(b, h) + boff + n * 2048 + k * 1024); } } } while (0)
#define PG8_MMA(ai, bj, At, Bt) do { __builtin_amdgcn_s_setprio(1); _Pragma("unroll") for (int m = 0; m < 4; ++m) _Pragma("unroll") for (int n = 0; n < 2; ++n) { \
        if constexpr (F8) asm volatile("v_mfma_scale_f32_16x16x128_f8f6f4 %0, %1, %2, %0, %3, %3 op_sel_hi:[0,0,0]" : "+v"(acc[ai][bj][m][n]) : "v"(Bt##8[n]), "v"(At##8[m]), "v"(f8one));   \
        else { _Pragma("unroll") for (int k = 0; k < 2; ++k) acc[ai][bj][m][n] = __builtin_amdgcn_mfma_f32_16x16x32_bf16(Bt[n][k], At[m][k], acc[ai][bj][m][n], 0, 0, 0); } } \
        __builtin_amdgcn_s_setprio(0); } while (0)
#define PG8_WAIT_V(n) asm volatile("s_waitcnt vmcnt(" #n ")" ::: "memory")
#define PG8_WAIT_L(n) asm volatile("s_waitcnt lgkmcnt(" #n ")" ::: "memory")
#define PG8_BAR __builtin_amdgcn_s_barrier()
#define PG8_SCHED __builtin_amdgcn_sched_barrier(0)
    Unit cur, nxt; int ui = 0;
    if (!S.next(0, cur)) return;
    f32x4 acc[2][2][4][2];
#pragma unroll
    for (int a = 0; a < 2; ++a)
#pragma unroll
        for (int b = 0; b < 2; ++b)
#pragma unroll
            for (int m = 0; m < 4; ++m)
#pragma unroll
                for (int n = 0; n < 2; ++n) acc[a][b][m][n] = (f32x4){0.f, 0.f, 0.f, 0.f};
    const int f8one = 0x7f7f7f7f;
    bf16x8 At[4][2], B0[2][2], B1[2][2];
    i32x8 At8[4], B08[2], B18[2];
    const char* cA = (const char*)g.A + (size_t)cur.pa * tstep + (size_t)cur.ko * 2; const char* cB = (const char*)g.Bt + (size_t)cur.pb * tstep + (size_t)cur.ko * 2;
    S.a_ready(cur);
    if constexpr (SP2) {
        PG8_STAGE(PG8_SB(0, 0), cB, voffB); PG8_STAGE(PG8_SB(0, 1), cB + hstep, voffB); PG8_STAGE(PG8_SA(0, 0), cA, voffA); PG8_STAGE(PG8_SA(0, 1), cA + hstep, voffA);
        if (wr == 1) PG8_BAR;
        PG8_WAIT_V(2); PG8_BAR;
        PG8_STAGE(PG8_SB(1, 0), cB + kstep, voffB); PG8_STAGE(PG8_SA(1, 0), cA + kstep, voffA); PG8_STAGE(PG8_SB(1, 1), cB + hstep + kstep, voffB);
        PG8_WAIT_V(6); PG8_BAR;
    } else {
        PG8_STAGE(PG8_SB(0, 0), cB, voffB); PG8_STAGE(PG8_SA(0, 0), cA, voffA); PG8_STAGE(PG8_SB(0, 1), cB + hstep, voffB); PG8_STAGE(PG8_SA(0, 1), cA + hstep, voffA);
        if (wr == 1) PG8_BAR;
        PG8_WAIT_V(4); PG8_BAR;
        PG8_STAGE(PG8_SB(1, 0), cB + kstep, voffB); PG8_STAGE(PG8_SA(1, 0), cA + kstep, voffA); PG8_STAGE(PG8_SB(1, 1), cB + hstep + kstep, voffB);
        PG8_WAIT_V(6); PG8_BAR;
    }
    for (;;) {
        const bool has_next = S.next(ui + 1, nxt);
        const char* nA = has_next ? (const char*)g.A + (size_t)nxt.pa * tstep + (size_t)nxt.ko * 2 : cA; const char* nB = has_next ? (const char*)g.Bt + (size_t)nxt.pb * tstep + (size_t)nxt.ko * 2 : cB;
        for (int t = 0; t < nt; t += 2) {
            const bool last = (t == nt - 2);
            const char* a1 = cA + (size_t)(t + 1) * kstep;
            const char* a2 = last ? nA : cA + (size_t)(t + 2) * kstep; const char* b2 = last ? nB : cB + (size_t)(t + 2) * kstep;
            const char* a3 = a2 + kstep; const char* b3 = b2 + kstep;
            if (last && has_next) S.a_ready(nxt);
            if constexpr (SP2) {
            PG8_LDB(B0, 0, 0); PG8_LDB(B1, 0, 1); PG8_SCHED; PG8_LDA(At, 0, 0); PG8_STAGE(PG8_SA(1, 1), a1 + hstep, voffA);
            PG8_WAIT_V(8); PG8_WAIT_L(0); PG8_BAR; PG8_MMA(0, 0, At, B0); PG8_MMA(0, 1, At, B1); PG8_BAR; PG8_SCHED;
            PG8_LDA(At, 0, 1); PG8_STAGE(PG8_SB(0, 0), b2, voffB); PG8_STAGE(PG8_SB(0, 1), b2 + hstep, voffB); PG8_STAGE(PG8_SA(0, 0), a2, voffA);
            PG8_WAIT_V(8); PG8_WAIT_L(0); PG8_BAR; PG8_MMA(1, 0, At, B0); PG8_MMA(1, 1, At, B1); PG8_BAR; PG8_SCHED;
            PG8_LDB(B0, 1, 0); PG8_LDB(B1, 1, 1); PG8_SCHED; PG8_LDA(At, 1, 0); PG8_STAGE(PG8_SA(0, 1), a2 + hstep, voffA);
            PG8_WAIT_V(8); PG8_WAIT_L(0); PG8_BAR; PG8_MMA(0, 0, At, B0); PG8_MMA(0, 1, At, B1); PG8_BAR; PG8_SCHED;
            PG8_LDA(At, 1, 1); PG8_STAGE(PG8_SB(1, 0), b3, voffB); PG8_STAGE(PG8_SB(1, 1), b3 + hstep, voffB); PG8_STAGE(PG8_SA(1, 0), a3, voffA);
            PG8_WAIT_V(8); PG8_WAIT_L(0); PG8_BAR; PG8_MMA(1, 0, At, B0); PG8_MMA(1, 1, At, B1); PG8_BAR; PG8_SCHED;
            } else {
            PG8_LDB(B0, 0, 0); PG8_SCHED; PG8_LDA(At, 0, 0); PG8_STAGE(PG8_SA(1, 1), a1 + hstep, voffA);
            PG8_WAIT_L(8); PG8_BAR; PG8_WAIT_L(0); PG8_MMA(0, 0, At, B0); PG8_BAR; PG8_SCHED;
            PG8_LDB(B1, 0, 1); PG8_STAGE(PG8_SB(0, 0), b2, voffB);
            PG8_BAR; PG8_WAIT_L(0); PG8_MMA(0, 1, At, B1); PG8_BAR;
            PG8_LDA(At, 0, 1); PG8_STAGE(PG8_SA(0, 0), a2, voffA);
            PG8_BAR; PG8_WAIT_L(0); PG8_MMA(1, 0, At, B0); PG8_BAR; PG8_SCHED;
            PG8_STAGE(PG8_SB(0, 1), b2 + hstep, voffB);
            PG8_WAIT_V(6); PG8_BAR; PG8_MMA(1, 1, At, B1); PG8_BAR;
            PG8_LDB(B0, 1, 0); PG8_SCHED; PG8_LDA(At, 1, 0); PG8_STAGE(PG8_SA(0, 1), a2 + hstep, voffA);
            PG8_WAIT_L(8); PG8_BAR; PG8_WAIT_L(0); PG8_MMA(0, 0, At, B0); PG8_BAR; PG8_SCHED;
            PG8_LDB(B1, 1, 1); PG8_STAGE(PG8_SB(1, 0), b3, voffB);
            PG8_BAR; PG8_WAIT_L(0); PG8_MMA(0, 1, At, B1); PG8_BAR;
            PG8_LDA(At, 1, 1); PG8_STAGE(PG8_SA(1, 0), a3, voffA);
            PG8_BAR; PG8_WAIT_L(0); PG8_MMA(1, 0, At, B0); PG8_BAR; PG8_SCHED;
            PG8_STAGE(PG8_SB(1, 1), b3 + hstep, voffB);
            PG8_WAIT_V(6); PG8_BAR; PG8_MMA(1, 1, At, B1); PG8_BAR;
            }
        }
        if constexpr (F8) asm volatile("s_nop 15\n\ts_nop 15\n\ts_nop 15" ::: "memory");
        if constexpr (ALIGN_EPI) { if (wr == 0) PG8_BAR; }
        if constexpr (!Epi::AFTER_DRAIN) { E(acc, cur, wr, wc, fr, fq); S.done(cur); }
        if (!has_next) break;
#pragma unroll
        for (int a = 0; a < 2; ++a)
#pragma unroll
            for (int b = 0; b < 2; ++b)
#pragma unroll
                for (int m = 0; m < 4; ++m)
#pragma unroll
                    for (int n = 0; n < 2; ++n) acc[a][b][m][n] = (f32x4){0.f, 0.f, 0.f, 0.f};
        cur = nxt; cA = nA; cB = nB; ++ui;
        if constexpr (ALIGN_EPI) { if (wr == 1) PG8_BAR; }
    }
    PG8_WAIT_V(0);
    if constexpr (!ALIGN_EPI) { if (wr == 0) PG8_BAR; }
    PG8_BAR;
    if constexpr (Epi::AFTER_DRAIN) { E.fused(acc, cur, wr, wc, fr, fq, lds, wid, lane); S.done(cur); }
#undef PG8_SA
#undef PG8_SB
#undef PG8_STAGE
#undef PG8_CAT
#undef PG8_LDA
#undef PG8_LDB
#undef PG8_MMA
#undef PG8_WAIT_V
#undef PG8_WAIT_L
#undef PG8_BAR
#undef PG8_SCHED
}
}

constexpr int NWAVES = 8, NTHR = 512;
constexpr int D = 2048, SEQ = 4096, NLAT = 8192, CTXL = 256, NCTX = 512, MROWS = 8704, DEPTH = 2;
constexpr int INC = 15392, NU = 15360;
constexpr int U_CB = 0, U_CC = 1024, U_CX = 2048, U_GQ = 3072, U_GK = 3584, U_GV = 4096, U_GR = 5120, U_NQ = 6144, U_NK = 7168, U_NV = 8192, U_GATE = 9216;
constexpr int LR_COL = 6144;
constexpr int FF = 5632, NGU = 2 * FF, NE = 8;
constexpr float LN_EPS = 1e-5f, ALPHA = 1.41421356237f;
constexpr float FSC_WGU = 64.0f, FSC_WD = 128.0f, FSC_HID = 4.0f;
constexpr int MOE_MAXP = 72;

constexpr size_t MiB = 1u << 20;
constexpr size_t WS_CTL = 0, CTL_ZERO_BYTES = 1 * MiB;
constexpr size_t WS_MOD = 1 * MiB;
constexpr size_t WS_WLR = 1 * MiB + 512 * 1024;
constexpr size_t WS_ROUTE = 2 * MiB;
constexpr size_t WS_TOK = 2 * MiB + 256 * 1024;
constexpr size_t WS_LR = 3 * MiB;
constexpr size_t WS_W = 8 * MiB;
constexpr size_t W_IN_B = (size_t)NU * D * 2, W_BR_B = (size_t)1024 * D * 2, W_OUT_B = (size_t)D * D * 2, W_LAYER_B = W_IN_B + 3 * W_BR_B + W_OUT_B;
constexpr size_t W_GU_B = (size_t)NGU * D * 2, W_D_B = (size_t)D * FF * 2, W_FFN_B = W_GU_B + W_D_B;
constexpr size_t WS_WFFN = WS_W + 2 * W_LAYER_B, WS_WMOE = WS_WFFN + W_FFN_B, WS_WEND = WS_WMOE + 8 * W_FFN_B;
constexpr size_t WS_XL = 762 * MiB;
constexpr size_t WS_H = 830 * MiB;
constexpr size_t WS_U = 864 * MiB;
constexpr size_t WS_Y = 1119 * MiB;
constexpr size_t WS_GLA = 1170 * MiB;
constexpr size_t WS_Z = 1306 * MiB;
constexpr size_t WS_ZB = 1374 * MiB;
constexpr size_t WS_PRE = 1408 * MiB;
constexpr size_t WS_PART = 1476 * MiB;
constexpr size_t WS_END = 1520 * MiB;
static_assert(WS_WEND <= WS_XL && WS_XL + (size_t)MROWS * D * 4 <= WS_H && WS_H + (size_t)MROWS * D * 2 <= WS_U && WS_U + (size_t)MROWS * NU * 2 <= WS_Y, "ws map 1");
static_assert(WS_U + (size_t)MOE_MAXP * 256 * FF * 2 <= WS_Y && WS_Y + 3 * (size_t)MROWS * 1024 * 2 <= WS_GLA && WS_GLA + (size_t)MROWS * (4 * 512 + 2 * 1024) * 4 <= WS_Z, "ws map 2");
static_assert(WS_GLA + (size_t)MOE_MAXP * 256 * D * 2 <= WS_Z && WS_Z + (size_t)MOE_MAXP * 256 * D * 4 <= WS_END && WS_PRE + (size_t)MROWS * D * 4 <= WS_END, "ws map 3");
constexpr int CW_TMO = 0, CW_CODE = 1;
constexpr int CW_MOECNT = 64;
constexpr int CW_BAR = 4096;

constexpr int RING_OFF = 0, RING_BYTES = 131072;
constexpr int LDSCTL_OFF = RING_BYTES, MISC_OFF = LDSCTL_OFF + 320;
constexpr int LDS_BYTES = 147456;

#define GAS __attribute__((address_space(1)))
#define LAS __attribute__((address_space(3)))
typedef unsigned short bf16;
typedef unsigned v4u __attribute__((ext_vector_type(4)));
typedef unsigned v2u __attribute__((ext_vector_type(2)));
typedef float f32x4 __attribute__((ext_vector_type(4)));
typedef GAS unsigned gu32;
typedef short bf16x8v __attribute__((ext_vector_type(8)));
#define RLX_AGENT __ATOMIC_RELAXED, __HIP_MEMORY_SCOPE_AGENT
#define LDS_WAIT() asm volatile("s_waitcnt lgkmcnt(0)" ::: "memory")
#define VM_WAIT() asm volatile("s_waitcnt vmcnt(0)" ::: "memory")
__device__ __forceinline__ unsigned f2bf(float f) { unsigned u = __builtin_bit_cast(unsigned, f); return (u + 0x7fffu + ((u >> 16) & 1u)) >> 16; }
__device__ __forceinline__ unsigned pk2(float lo, float hi) { return f2bf(lo) | (f2bf(hi) << 16); }
__device__ __forceinline__ float bflo(unsigned w) { return __uint_as_float(w << 16); }
__device__ __forceinline__ float bfhi(unsigned w) { return __uint_as_float(w & 0xffff0000u); }
__device__ __forceinline__ float bf1(bf16 b) { return __uint_as_float(((unsigned)b) << 16); }
__device__ __forceinline__ float wave_sum(float v) {
#pragma unroll
    for (int o = 1; o < 64; o <<= 1) v += __shfl_xor(v, o);
    return v;
}
__device__ __forceinline__ float wave_max(float v) {
#pragma unroll
    for (int o = 1; o < 64; o <<= 1) v = fmaxf(v, __shfl_xor(v, o));
    return v;
}

#define XB_TMO      128
#define XB_XCNT(j)  (256  + 64 * (j))
#define XB_XSUB(j)  (1280 + 64 * (j))
#define XB_XGEN(j)  (2304 + 64 * (j))
#define XB_TOP      3328
#define XB_TOPGEN   3392
#define XCD_BAR_WORDS 3456
#define XB_SPIN_CAP (1u << 18)

__device__ __forceinline__ unsigned xb_ld(unsigned* p)              { return __hip_atomic_load(p, __ATOMIC_RELAXED, __HIP_MEMORY_SCOPE_AGENT); }
__device__ __forceinline__ unsigned xb_add(unsigned* p, unsigned v) { return __hip_atomic_fetch_add(p, v, __ATOMIC_RELAXED, __HIP_MEMORY_SCOPE_AGENT); }
__device__ __forceinline__ unsigned xb_xcc_id() { return (unsigned)__builtin_amdgcn_s_getreg((3 << 11) | 20) & 0xFu; }
#define XB_SPIN(cond, bar) do { unsigned _sp = 0; while (cond) { __builtin_amdgcn_s_sleep(1); \
    if ((++_sp & 255u) == 0u) { if (xb_ld(&(bar)[XB_TMO])) break; if (_sp > XB_SPIN_CAP) { atomicAdd(&(bar)[XB_TMO], 1u); break; } } } } while (0)

struct XcdBarrier {
    unsigned* bar; unsigned x; unsigned grid;
    volatile LAS unsigned* st;
};

__device__ __forceinline__ XcdBarrier xcd_barrier_post(unsigned* bar, volatile LAS unsigned* st, unsigned grid) {
    XcdBarrier b; b.grid = grid; b.bar = bar; b.x = xb_xcc_id(); b.st = st;
    if (threadIdx.x == 0) (void)xb_add(&bar[XB_XCNT(b.x)], 1u);
    return b;
}
__device__ __forceinline__ void xcd_barrier_complete(unsigned* bar, unsigned x, unsigned& nloc, unsigned& nx, unsigned b_grid) {
    const unsigned G = b_grid;
    unsigned sum, cnt, mine, sp = 0u;
    for (;;) {
        sum = 0u; cnt = 0u; mine = 0u;
#pragma unroll
        for (unsigned j = 0; j < 16; ++j) { const unsigned c = xb_ld(&bar[XB_XCNT(j)]); sum += c; cnt += (c > 0u) ? 1u : 0u; mine = (j == x) ? c : mine; }
        if (sum == G) break;
        __builtin_amdgcn_s_sleep(1);
        if ((++sp & 255u) == 0u) { if (xb_ld(&bar[XB_TMO])) break; if (sp > XB_SPIN_CAP) { atomicAdd(&bar[XB_TMO], 1u); break; } }
    }
    nloc = mine > 0u ? mine : 1u; nx = cnt > 0u ? cnt : 1u;
}

__device__ __forceinline__ void xcd_barrier(const XcdBarrier& b) {
    asm volatile("s_waitcnt vmcnt(0)" ::: "memory");
    __syncthreads();
    if (threadIdx.x == 0) {
        unsigned* bar = b.bar;
        __builtin_amdgcn_s_waitcnt(0);
        unsigned nloc = b.st[0], nx = b.st[1];
        if (nloc == 0u) { xcd_barrier_complete(bar, b.x, nloc, nx, b.grid); b.st[0] = nloc; b.st[1] = nx; }
        const unsigned old = xb_add(&bar[XB_XSUB(b.x)], 1u);
        const unsigned gen = old / nloc;
        if (old + 1u == (gen + 1u) * nloc) {
            __builtin_amdgcn_fence(__ATOMIC_RELEASE, "agent");
            asm volatile("s_waitcnt vmcnt(0)" ::: "memory");
            const unsigned og = xb_add(&bar[XB_TOP], 1u);
            const unsigned tg = og / nx;
            if (og + 1u == (tg + 1u) * nx) xb_add(&bar[XB_TOPGEN], 1u);
            else XB_SPIN(xb_ld(&bar[XB_TOPGEN]) == tg, bar);
            __builtin_amdgcn_fence(__ATOMIC_ACQUIRE, "agent");
            xb_add(&bar[XB_XGEN(b.x)], 1u);
            asm volatile("s_waitcnt vmcnt(0)" ::: "memory");
        } else {
            XB_SPIN(xb_ld(&bar[XB_XGEN(b.x)]) == gen, bar);
            __builtin_amdgcn_fence(__ATOMIC_ACQUIRE, "agent");
            asm volatile("s_waitcnt vmcnt(0)" ::: "memory");
        }
    }
    __syncthreads();
}

struct Args { const float* in[30]; float* out; unsigned char* ws; int ph_lo, ph_hi, grid, pad; };
struct Frame {
    LAS unsigned char* lds;
    volatile LAS unsigned* MISC;
    int tid, lane, wave, vcu, G, bx;
};
__device__ __forceinline__ Frame mkframe(LAS unsigned char* lds, int grid) {
    Frame F; int t = threadIdx.x; asm volatile("" : "+v"(t)); int g = grid, bx = blockIdx.x; asm volatile("" : "+s"(g), "+s"(bx));
    F.lds = lds; F.MISC = (volatile LAS unsigned*)(lds + MISC_OFF); F.tid = t; F.lane = t & 63; F.wave = __builtin_amdgcn_readfirstlane(t >> 6); F.G = g; F.bx = bx;
    F.vcu = (g % 8 == 0) ? (bx % 8) * (g / 8) + bx / 8 : bx; return F;
}
constexpr int PTAB_OFF = LDSCTL_OFF + 1024, PT_OUT = 30, PT_WS = 31;
__device__ __forceinline__ unsigned long long ldp_raw(Frame& F, int i) {
    const volatile LAS unsigned* t = (const volatile LAS unsigned*)(F.lds + PTAB_OFF) + 2 * i; const unsigned lo = t[0], hi = t[1];
    return ((unsigned long long)(unsigned)__builtin_amdgcn_readfirstlane((int)hi) << 32) | (unsigned)__builtin_amdgcn_readfirstlane((int)lo);
}
#define PIN(i) ((const float*)(const GAS float*)ldp_raw(F, (i)))
#define POUT() ((float*)(GAS float*)ldp_raw(F, PT_OUT))
#define PWS() ((unsigned char*)(GAS unsigned char*)ldp_raw(F, PT_WS))
__device__ __forceinline__ bf16* w_in_t(unsigned char* ws, int L) { return (bf16*)(ws + WS_W + (size_t)L * W_LAYER_B); }
__device__ __forceinline__ bf16* w_br_t(unsigned char* ws, int L, int b) { return (bf16*)(ws + WS_W + (size_t)L * W_LAYER_B + W_IN_B + (size_t)b * W_BR_B); }
__device__ __forceinline__ bf16* w_out_t(unsigned char* ws, int L) { return (bf16*)(ws + WS_W + (size_t)L * W_LAYER_B + W_IN_B + 3 * W_BR_B); }
__device__ __forceinline__ unsigned char* w_gu_t(unsigned char* ws, int e) { return ws + (e < 0 ? WS_WFFN : WS_WMOE + (size_t)e * (W_GU_B / 2)); }
__device__ __forceinline__ unsigned char* w_d_t(unsigned char* ws, int e) { return ws + (e < 0 ? WS_WFFN + W_GU_B : WS_WMOE + 8 * W_GU_B + (size_t)e * (W_D_B / 2)); }

template <int MODE> __device__ __forceinline__ int conv_drow(int nb) {
    if (MODE == 0) return 32 * nb;
    if (MODE == 1) return nb < LR_COL / 32 ? 32 * nb : 32 * (nb - 1);
    if (MODE == 2) return 256 * (nb >> 2) + 32 * (nb & 3);
    return 256 * (nb >> 2) + 128 + 32 * (nb & 3);
}
__device__ __forceinline__ void conv_load(const float* W, int N, int nblk, int it, int lane, f32x4 (&w)[8]) {
    const int kb = it / nblk, nb = it % nblk; const float* p = W + (size_t)(64 * kb + (lane >> 3)) * N + 32 * nb + (lane & 7) * 4;
#pragma unroll
    for (int i = 0; i < 8; ++i) w[i] = *(const GAS f32x4*)(p + (size_t)(8 * i) * N);
}
template <int MODE, bool F8> __device__ __forceinline__ void conv_matrix_t(Frame& F, const float* W, int K, int N, void* WT, float sc) {
    LAS float* scr = (LAS float*)(F.lds + RING_OFF + F.wave * 16384);
    const int gw = F.vcu * NWAVES + F.wave, NGW = F.G * NWAVES, lane = F.lane;
    const int nblk = N / 32, nitems = (K / 64) * nblk;
    f32x4 w[8];
    if (gw < nitems) conv_load(W, N, nblk, gw, lane, w);
    for (int it = gw; it < nitems; it += NGW) {
        f32x4 wn[8]; const int itn = it + NGW;
        if (itn < nitems) conv_load(W, N, nblk, itn, lane, wn);
        const int kb = it / nblk, nb = it % nblk, k0 = 64 * kb;
        if (!(MODE == 1 && nb == LR_COL / 32)) {
            const int drow = conv_drow<MODE>(nb);
#pragma unroll
            for (int i = 0; i < 8; ++i) { LAS float* s = scr + (8 * i + (lane >> 3)) * 33 + (lane & 7) * 4; s[0] = w[i][0]; s[1] = w[i][1]; s[2] = w[i][2]; s[3] = w[i][3]; }
            LDS_WAIT(); asm volatile("" ::: "memory");
            const int c = lane & 7;
#pragma unroll
            for (int j = 0; j < 4; ++j) { const int n = (lane >> 3) + 8 * j; const LAS float* s = scr + (8 * c) * 33 + n;
                if (F8) { v2u o; o.x = pg8::pk_fp8x4(s[0 * 33] * sc, s[1 * 33] * sc, s[2 * 33] * sc, s[3 * 33] * sc); o.y = pg8::pk_fp8x4(s[4 * 33] * sc, s[5 * 33] * sc, s[6 * 33] * sc, s[7 * 33] * sc);
                    *(GAS v2u*)((unsigned char*)WT + (size_t)(drow + n) * K + k0 + 8 * c) = o; }
                else { v4u o; o.x = pk2(s[0 * 33], s[1 * 33]); o.y = pk2(s[2 * 33], s[3 * 33]); o.z = pk2(s[4 * 33], s[5 * 33]); o.w = pk2(s[6 * 33], s[7 * 33]);
                    *(GAS v4u*)((bf16*)WT + (size_t)(drow + n) * K + k0 + 8 * c) = o; } }
            LDS_WAIT(); asm volatile("" ::: "memory");
        }
#pragma unroll
        for (int i = 0; i < 8; ++i) w[i] = wn[i];
    }
}
template <int MODE> __device__ __forceinline__ void conv_matrix8(Frame& F, const float* W, int K, int N, unsigned char* WT, float sc) { conv_matrix_t<MODE, true>(F, W, K, N, WT, sc); }
template <int MODE> __device__ __forceinline__ void conv_matrix(Frame& F, const float* W, int K, int N, bf16* WT) { conv_matrix_t<MODE, false>(F, W, K, N, WT, 1.0f); }
__device__ __forceinline__ void ada_item(Frame& F, unsigned char* ws, const float* cnd, const float* cctx, const float* ada_w, const float* ada_b, int item) {
    const int L = item / 96, c0 = (item % 96) * 128;
    LAS float* sc = (LAS float*)(F.lds + RING_OFF);
    LAS float* red = (LAS float*)(F.lds + RING_OFF + 24576);
    for (int i = F.tid; i < 3 * D; i += NTHR) { const int g = i / D, k = i % D; const float v = g < 2 ? cnd[g * D + k] : cctx[k]; sc[i] = v / (1.0f + __expf(-v)); }
    __syncthreads();
    const float* W = ada_w + (size_t)L * D * 12288 + c0 + 2 * F.lane;
    float a00 = 0.f, a01 = 0.f, a10 = 0.f, a11 = 0.f, a20 = 0.f, a21 = 0.f;
    const int kb = 256 * F.wave;
#pragma unroll 8
    for (int k = kb; k < kb + 256; ++k) { const float2 w = *(const float2*)(W + (size_t)k * 12288); const float s0 = sc[k], s1 = sc[D + k], s2 = sc[2 * D + k];
        a00 += s0 * w.x; a01 += s0 * w.y; a10 += s1 * w.x; a11 += s1 * w.y; a20 += s2 * w.x; a21 += s2 * w.y; }
    red[(F.wave * 3 + 0) * 128 + 2 * F.lane] = a00; red[(F.wave * 3 + 0) * 128 + 2 * F.lane + 1] = a01;
    red[(F.wave * 3 + 1) * 128 + 2 * F.lane] = a10; red[(F.wave * 3 + 1) * 128 + 2 * F.lane + 1] = a11;
    red[(F.wave * 3 + 2) * 128 + 2 * F.lane] = a20; red[(F.wave * 3 + 2) * 128 + 2 * F.lane + 1] = a21;
    __syncthreads();
    if (F.tid < 384) { const int g = F.tid / 128, cc = F.tid % 128; float s = 0.f;
#pragma unroll
        for (int w = 0; w < 8; ++w) s += red[(w * 3 + g) * 128 + cc];
        ((float*)(ws + WS_MOD))[((size_t)L * 3 + g) * 12288 + c0 + cc] = s + ada_b[L * 12288 + c0 + cc]; }
    __syncthreads();
}
__device__ __forceinline__ void p0a_prologue(Frame& F) {
    unsigned char* const ws = PWS();
    { const float* cnd = PIN(1); const float* cctx = PIN(3); const float* ada_w = PIN(4); const float* ada_b = PIN(5);
      for (int it = F.bx; it < 192; it += F.G) ada_item(F, ws, cnd, cctx, ada_w, ada_b, it); }
    const float* const w_in = PIN(6);
    { const int gt = F.bx * NTHR + F.tid, NGT = F.G * NTHR;
      for (int i = gt; i < DEPTH * D * 32; i += NGT) { const int o = i & 31, k = (i >> 5) % D, L = i / (32 * D); ((bf16*)(ws + WS_WLR))[((size_t)L * 32 + o) * D + k] = (bf16)f2bf(w_in[((size_t)L * D + k) * INC + LR_COL + o]); } }
    for (int L = 0; L < DEPTH; ++L) {
        conv_matrix<1>(F, w_in + (size_t)L * D * INC, D, INC, w_in_t(ws, L));
        for (int b = 0; b < 3; ++b) conv_matrix<0>(F, (b == 0 ? PIN(14) : (b == 1 ? PIN(15) : PIN(16))) + (size_t)L * 1024 * D, 1024, D, w_br_t(ws, L, b));
        conv_matrix<0>(F, PIN(18) + (size_t)L * D * D, D, D, w_out_t(ws, L));
    }
    conv_matrix<2>(F, PIN(23), D, FF, (bf16*)w_gu_t(ws, -1)); conv_matrix<3>(F, PIN(24), D, FF, (bf16*)w_gu_t(ws, -1)); conv_matrix<0>(F, PIN(25), FF, D, (bf16*)w_d_t(ws, -1));
    for (int e = 0; e < NE; ++e) {
        conv_matrix8<2>(F, PIN(27) + (size_t)e * D * FF, D, FF, w_gu_t(ws, e), FSC_WGU); conv_matrix8<3>(F, PIN(28) + (size_t)e * D * FF, D, FF, w_gu_t(ws, e), FSC_WGU);
        conv_matrix8<0>(F, PIN(29) + (size_t)e * FF * D, FF, D, w_d_t(ws, e), FSC_WD);
    }
}

__device__ __forceinline__ int row_group(int r) { return r < SEQ ? 0 : (r < NLAT ? 1 : 2); }
__device__ __forceinline__ void load_row(const float* p, int lane, f32x4 (&v)[8]) {
#pragma unroll
    for (int j = 0; j < 8; ++j) v[j] = *(const GAS f32x4*)(p + 4 * lane + 256 * j);
}
__device__ __forceinline__ void load_row_bf16(const bf16* p, int lane, f32x4 (&v)[8]) {
#pragma unroll
    for (int j = 0; j < 8; ++j) { const v2u w = *(const GAS v2u*)(p + 4 * lane + 256 * j); v[j] = (f32x4){bflo(w.x), bfhi(w.x), bflo(w.y), bfhi(w.y)}; }
}
__device__ __forceinline__ void store_row(float* p, int lane, const f32x4 (&v)[8]) {
#pragma unroll
    for (int j = 0; j < 8; ++j) *(GAS f32x4*)(p + 4 * lane + 256 * j) = v[j];
}
__device__ __forceinline__ void store_row_bf16(bf16* p, int lane, const f32x4 (&v)[8]) {
#pragma unroll
    for (int j = 0; j < 8; ++j) { v2u w; w.x = pk2(v[j][0], v[j][1]); w.y = pk2(v[j][2], v[j][3]); *(GAS v2u*)(p + 4 * lane + 256 * j) = w; }
}
__device__ __forceinline__ void store_row_fp8(unsigned char* p, int lane, const f32x4 (&v)[8]) {
#pragma unroll
    for (int j = 0; j < 8; ++j) *(GAS unsigned*)(p + 4 * lane + 256 * j) = pg8::pk_fp8x4(pg8::clamp448(v[j][0]), pg8::clamp448(v[j][1]), pg8::clamp448(v[j][2]), pg8::clamp448(v[j][3]));
}
__device__ __forceinline__ void modulate(f32x4 (&v)[8], const float* shift, const float* scale, int lane) {
#pragma unroll
    for (int j = 0; j < 8; ++j) { const f32x4 sh = *(const f32x4*)(shift + 4 * lane + 256 * j), sc = *(const f32x4*)(scale + 4 * lane + 256 * j); v[j] = v[j] * (sc + 1.0f) + sh; }
}
__device__ __forceinline__ void layer_norm_row(f32x4 (&v)[8], const float* g, const float* b, int lane) {
    float s = 0.f;
#pragma unroll
    for (int j = 0; j < 8; ++j) s += (v[j][0] + v[j][1]) + (v[j][2] + v[j][3]);
    const float mean = wave_sum(s) * (1.0f / D); float q = 0.f;
#pragma unroll
    for (int j = 0; j < 8; ++j) { v[j] = v[j] - mean; q += (v[j][0] * v[j][0] + v[j][1] * v[j][1]) + (v[j][2] * v[j][2] + v[j][3] * v[j][3]); }
    const float rstd = 1.0f / sqrtf(wave_sum(q) * (1.0f / D) + LN_EPS);
#pragma unroll
    for (int j = 0; j < 8; ++j) { const f32x4 g4 = *(const f32x4*)(g + 4 * lane + 256 * j), b4 = *(const f32x4*)(b + 4 * lane + 256 * j); v[j] = v[j] * rstd * g4 + b4; }
}
__device__ __forceinline__ void lr_tiles(Frame& F, int L) {
    unsigned char* const ws = PWS(); const bf16* H = (const bf16*)(ws + WS_H); const bf16* W = (const bf16*)(ws + WS_WLR) + (size_t)L * 32 * D; float* LRo = (float*)(ws + WS_LR);
    const int g = F.lane >> 4, l15 = F.lane & 15, gw = F.vcu * NWAVES + F.wave, NGW = F.G * NWAVES;
    for (int task = gw; task < MROWS / 16; task += NGW) {
        const bf16* ap = H + (size_t)(16 * task + l15) * D + 8 * g; const bf16* bp = W + (size_t)l15 * D + 8 * g;
        f32x4 a0 = {0.f, 0.f, 0.f, 0.f}, a1 = {0.f, 0.f, 0.f, 0.f};
#pragma unroll 8
        for (int ks = 0; ks < D / 32; ++ks) { const bf16x8v af = __builtin_bit_cast(bf16x8v, *(const GAS v4u*)(ap + 32 * ks)), b0 = __builtin_bit_cast(bf16x8v, *(const GAS v4u*)(bp + 32 * ks)), b1 = __builtin_bit_cast(bf16x8v, *(const GAS v4u*)(bp + (size_t)16 * D + 32 * ks));
            a0 = __builtin_amdgcn_mfma_f32_16x16x32_bf16(af, b0, a0, 0, 0, 0); a1 = __builtin_amdgcn_mfma_f32_16x16x32_bf16(af, b1, a1, 0, 0, 0); }
#pragma unroll
        for (int i = 0; i < 4; ++i) { float* o = LRo + (size_t)(16 * task + 4 * g + i) * 32 + l15; o[0] = a0[i]; o[16] = a1[i]; }
    }
}
__device__ __forceinline__ void p0b_modulate(Frame& F) {
    unsigned char* const ws = PWS(); const float* const xin = PIN(0); const float* const cin = PIN(2);
    const int gw = F.vcu * NWAVES + F.wave, NGW = F.G * NWAVES;
    for (int r = gw; r < MROWS; r += NGW) {
        f32x4 v[8]; load_row(r < NLAT ? xin + (size_t)r * D : cin + (size_t)(r - NLAT) * D, F.lane, v);
        const float* m = ((float*)(ws + WS_MOD)) + (size_t)row_group(r) * 12288;
        modulate(v, m, m + D, F.lane); store_row_bf16(((bf16*)(ws + WS_H)) + (size_t)r * D, F.lane, v);
    }
}

__device__ __forceinline__ void mix_prep(Frame& F, int L) {
    unsigned char* const ws = PWS();
    const int gt = F.bx * NTHR + F.tid, NGT = F.G * NTHR;
    const float* cw = PIN(7) + (size_t)L * 3 * 1024;
    for (int i = gt; i < MROWS * 128; i += NGT) {
        const int r = i >> 7, c8 = (i & 127) * 8;
        const int t = r < NLAT ? (r & (SEQ - 1)) : ((r - NLAT) & (CTXL - 1)), T = r < NLAT ? SEQ : CTXL;
        float acc[8];
#pragma unroll
        for (int j = 0; j < 8; ++j) acc[j] = 0.f;
#pragma unroll
        for (int k = 0; k < 3; ++k) { const int tt = t + k - 1; if (tt < 0 || tt >= T) continue;
            const bf16* up = ((bf16*)(ws + WS_U)) + (size_t)(r + k - 1) * NU; const v4u a = *(const GAS v4u*)(up + U_CC + c8), b = *(const GAS v4u*)(up + U_CX + c8);
            const f32x4 w0 = *(const f32x4*)(cw + k * 1024 + c8), w1 = *(const f32x4*)(cw + k * 1024 + c8 + 4);
            acc[0] += w0[0] * bflo(a.x) * bflo(b.x); acc[1] += w0[1] * bfhi(a.x) * bfhi(b.x); acc[2] += w0[2] * bflo(a.y) * bflo(b.y); acc[3] += w0[3] * bfhi(a.y) * bfhi(b.y);
            acc[4] += w1[0] * bflo(a.z) * bflo(b.z); acc[5] += w1[1] * bfhi(a.z) * bfhi(b.z); acc[6] += w1[2] * bflo(a.w) * bflo(b.w); acc[7] += w1[3] * bfhi(a.w) * bfhi(b.w); }
        const v4u ab = *(const GAS v4u*)(((bf16*)(ws + WS_U)) + (size_t)r * NU + U_CB + c8);
        v4u o; o.x = pk2(acc[0] * bflo(ab.x), acc[1] * bfhi(ab.x)); o.y = pk2(acc[2] * bflo(ab.y), acc[3] * bfhi(ab.y)); o.z = pk2(acc[4] * bflo(ab.z), acc[5] * bfhi(ab.z)); o.w = pk2(acc[6] * bflo(ab.w), acc[7] * bfhi(ab.w));
        *(GAS v4u*)(((bf16*)(ws + WS_Y)) + (size_t)r * 1024 + c8) = o;
    }
}
__device__ __forceinline__ void sum_partials(f32x4 (&v)[8], const float* P, int ns, const float* res, const float* gvec, int lane) {
#pragma unroll
    for (int j = 0; j < 8; ++j) v[j] = (f32x4){0.f, 0.f, 0.f, 0.f};
    for (int s = 0; s < ns; ++s) {
#pragma unroll
        for (int j = 0; j < 8; ++j) v[j] += *(const GAS f32x4*)(P + (size_t)s * 512 * D + 4 * lane + 256 * j); }
#pragma unroll
    for (int j = 0; j < 8; ++j) { const f32x4 r4 = *(const GAS f32x4*)(res + 4 * lane + 256 * j), g4 = *(const f32x4*)(gvec + 4 * lane + 256 * j); v[j] = r4 * ALPHA + g4 * v[j]; }
}
__device__ __forceinline__ void ln1_phase(Frame& F, int L, int M) {
    unsigned char* const ws = PWS(); const float* const lng = PIN(19) + L * D; const float* const lnb = PIN(20) + L * D; const float* const router = PIN(26); const float* const cin = PIN(2);
    const int gw = F.vcu * NWAVES + F.wave, NGW = F.G * NWAVES;
    for (int r = gw; r < M; r += NGW) {
        const float* m = ((float*)(ws + WS_MOD)) + ((size_t)L * 3 + row_group(r)) * 12288;
        f32x4 v[8];
        if (r < NLAT) load_row(((float*)(ws + WS_PRE)) + (size_t)r * D, F.lane, v);
        else sum_partials(v, ((float*)(ws + WS_PART)) + (size_t)(r - NLAT) * D, 8, cin + (size_t)(r - NLAT) * D, m + 2 * D, F.lane);
        layer_norm_row(v, lng, lnb, F.lane);
        store_row(((float*)(ws + WS_XL)) + (size_t)r * D, F.lane, v);
        modulate(v, m + 3 * D, m + 4 * D, F.lane);
        if (L == 0) store_row_bf16(((bf16*)(ws + WS_H)) + (size_t)r * D, F.lane, v);
        if (L == 1) {
            float lg[8];
#pragma unroll
            for (int e = 0; e < 8; ++e) lg[e] = 0.f;
#pragma unroll
            for (int j = 0; j < 8; ++j)
#pragma unroll
                for (int i = 0; i < 4; ++i) { const float* rp = router + (size_t)(4 * F.lane + 256 * j + i) * 8; const f32x4 w0 = *(const f32x4*)rp, w1 = *(const f32x4*)(rp + 4); const float hv = v[j][i];
                    lg[0] += hv * w0[0]; lg[1] += hv * w0[1]; lg[2] += hv * w0[2]; lg[3] += hv * w0[3]; lg[4] += hv * w1[0]; lg[5] += hv * w1[1]; lg[6] += hv * w1[2]; lg[7] += hv * w1[3]; }
#pragma unroll
            for (int e = 0; e < 8; ++e) lg[e] = wave_sum(lg[e]);
            int e0 = 0; float v0 = lg[0];
#pragma unroll
            for (int e = 1; e < 8; ++e) if (lg[e] > v0) { v0 = lg[e]; e0 = e; }
            int e1 = -1; float v1 = -INFINITY;
#pragma unroll
            for (int e = 0; e < 8; ++e) if (e != e0 && lg[e] > v1) { v1 = lg[e]; e1 = e; }
            unsigned p0 = 0u, p1 = 0u;
            if (F.lane == 0) {
                const float w0 = 1.0f / (1.0f + __expf(v1 - v0)), w1 = 1.0f - w0;
                p0 = __hip_atomic_fetch_add(((gu32*)(ws + WS_CTL)) + CW_MOECNT + 64 * e0, 1u, RLX_AGENT); p1 = __hip_atomic_fetch_add(((gu32*)(ws + WS_CTL)) + CW_MOECNT + 64 * e1, 1u, RLX_AGENT);
                unsigned* rt = ((unsigned*)(ws + WS_ROUTE)) + (size_t)r * 8; rt[0] = e0; rt[1] = p0; rt[2] = __float_as_uint(w0); rt[3] = e1; rt[4] = p1; rt[5] = __float_as_uint(w1);
            }
            p0 = (unsigned)__builtin_amdgcn_readfirstlane((int)p0); p1 = (unsigned)__builtin_amdgcn_readfirstlane((int)p1);
            store_row_fp8(ws + WS_GLA + ((size_t)e0 * NLAT + p0) * D, F.lane, v); store_row_fp8(ws + WS_GLA + ((size_t)e1 * NLAT + p1) * D, F.lane, v);
        }
    }
}
__device__ __forceinline__ void moe_prefix(unsigned char* ws, unsigned (&cnt)[8], int (&pp)[9]) {
    pp[0] = 0;
#pragma unroll
    for (int e = 0; e < 8; ++e) { cnt[e] = __hip_atomic_load(((gu32*)(ws + WS_CTL)) + CW_MOECNT + 64 * e, RLX_AGENT); pp[e + 1] = pp[e] + (int)((cnt[e] + 255u) >> 8); }
}
__device__ __forceinline__ void moe_gather(Frame& F) {
    unsigned char* const ws = PWS();
    const int gw = F.vcu * NWAVES + F.wave, NGW = F.G * NWAVES;
    unsigned cnt[8]; int pp[9]; moe_prefix(ws, cnt, pp);
    for (int s = gw; s < pp[8] * 256; s += NGW) {
        const int p = s >> 8; int e = 0, base = 0; unsigned ce = cnt[0];
#pragma unroll
        for (int k = 1; k < 8; ++k) if (p >= pp[k]) { e = k; base = pp[k]; ce = cnt[k]; }
        const unsigned pos = (unsigned)(s - base * 256);
        GAS v4u* dst = (GAS v4u*)(ws + WS_GLA + (size_t)s * D) + F.lane;
        if (pos < ce) { const int tkn = ((int*)(ws + WS_TOK))[e * NLAT + pos]; const GAS v4u* src = (const GAS v4u*)(ws + WS_H + (size_t)tkn * D) + F.lane;
#pragma unroll
            for (int j = 0; j < 2; ++j) dst[64 * j] = src[64 * j]; }
        else {
#pragma unroll
            for (int j = 0; j < 2; ++j) dst[64 * j] = (v4u){0u, 0u, 0u, 0u}; }
    }
}
__device__ __forceinline__ void ln2_dense(Frame& F, int L) {
    unsigned char* const ws = PWS(); const float* const lng = PIN(21) + L * D; const float* const lnb = PIN(22) + L * D;
    const int gw = F.vcu * NWAVES + F.wave, NGW = F.G * NWAVES;
    for (int r = gw; r < MROWS; r += NGW) {
        f32x4 v[8];
        if (r < NLAT) load_row(((float*)(ws + WS_PRE)) + (size_t)r * D, F.lane, v);
        else sum_partials(v, ((float*)(ws + WS_PART)) + (size_t)(r - NLAT) * D, 11, ((float*)(ws + WS_XL)) + (size_t)r * D, ((float*)(ws + WS_MOD)) + ((size_t)L * 3 + 2) * 12288 + 5 * D, F.lane);
        layer_norm_row(v, lng, lnb, F.lane);
        store_row(((float*)(ws + WS_XL)) + (size_t)r * D, F.lane, v);
        const float* m = ((float*)(ws + WS_MOD)) + ((size_t)(L + 1) * 3 + row_group(r)) * 12288;
        modulate(v, m, m + D, F.lane); store_row_bf16(((bf16*)(ws + WS_H)) + (size_t)r * D, F.lane, v);
    }
}
__device__ __forceinline__ void ln2_moe(Frame& F, int L) {
    unsigned char* const ws = PWS(); const float* const lng = PIN(21) + L * D; const float* const lnb = PIN(22) + L * D; float* const outp = POUT();
    const int gw = F.vcu * NWAVES + F.wave, NGW = F.G * NWAVES;
    unsigned cnt[8]; int pp[9]; moe_prefix(ws, cnt, pp);
    for (int r = gw; r < NLAT; r += NGW) {
        const unsigned* rt = ((unsigned*)(ws + WS_ROUTE)) + (size_t)r * 8; const int e0 = rt[0], e1 = rt[3]; const float w0 = __uint_as_float(rt[2]), w1 = __uint_as_float(rt[5]);
        int b0 = 0, b1 = 0;
#pragma unroll
        for (int k = 1; k < 8; ++k) { if (e0 >= k) b0 = pp[k]; if (e1 >= k) b1 = pp[k]; }
        const size_t s0 = (size_t)b0 * 256 + rt[1], s1 = (size_t)b1 * 256 + rt[4];
        f32x4 v[8], y0[8], y1[8]; load_row(((float*)(ws + WS_XL)) + (size_t)r * D, F.lane, v); load_row_bf16(((bf16*)(ws + WS_Z)) + s0 * D, F.lane, y0); load_row_bf16(((bf16*)(ws + WS_Z)) + s1 * D, F.lane, y1);
        const float* g2 = ((float*)(ws + WS_MOD)) + ((size_t)L * 3 + row_group(r)) * 12288 + 5 * D;
#pragma unroll
        for (int j = 0; j < 8; ++j) { const f32x4 g4 = *(const f32x4*)(g2 + 4 * F.lane + 256 * j); v[j] = v[j] * ALPHA + g4 * (y0[j] * w0 + y1[j] * w1); }
        layer_norm_row(v, lng, lnb, F.lane);
        store_row(outp + (size_t)r * D, F.lane, v);
    }
}

constexpr int GLA_NCH = 68;
constexpr size_t GLA_DST_BYTES = (size_t)16 * GLA_NCH * 256 * 128 * 2;
#define GLA_DST(ws) ((bf16*)((ws) + WS_GLA))
#define GLA_DEC(ws) ((float*)((ws) + WS_GLA + GLA_DST_BYTES))
#define GLA_BCG(ws) ((float*)((ws) + WS_GLA + GLA_DST_BYTES + (size_t)16 * GLA_NCH * 128 * 4))
__device__ __forceinline__ int gla_chunk_row0(int b, int cn) { return cn < 4 ? NLAT + CTXL * b + 64 * cn : SEQ * b + 64 * (cn - 4); }
__device__ __forceinline__ int gla_scan_idx(int cn, int dir) { return dir ? (cn < 4 ? 3 - cn : 71 - cn) : cn; }
__device__ __forceinline__ float log_sigmoid16(float z) { return (fminf(z, 0.f) - __logf(1.0f + __expf(-fabsf(z)))) * (1.0f / 16.0f); }
__device__ __forceinline__ bf16x8v tr_frag(unsigned addr, unsigned pitch4) {
    v2u lo, hi;
    asm volatile("ds_read_b64_tr_b16 %0, %2\n\tds_read_b64_tr_b16 %1, %3\n\ts_waitcnt lgkmcnt(0)" : "=&v"(lo), "=&v"(hi) : "v"(addr), "v"(addr + pitch4) : "memory");
    v4u r; r.x = lo.x; r.y = lo.y; r.z = hi.x; r.w = hi.y; return __builtin_bit_cast(bf16x8v, r);
}
struct TrHalf { v2u lo, hi; };
__device__ __forceinline__ void tr_issue(TrHalf& f, unsigned addr, unsigned pitch4) { asm volatile("ds_read_b64_tr_b16 %0, %2\n\tds_read_b64_tr_b16 %1, %3" : "=&v"(f.lo), "=&v"(f.hi) : "v"(addr), "v"(addr + pitch4) : "memory"); }
__device__ __forceinline__ bf16x8v tr_get(const TrHalf& f) { v4u r; r.x = f.lo.x; r.y = f.lo.y; r.z = f.hi.x; r.w = f.hi.y; return __builtin_bit_cast(bf16x8v, r); }
__device__ __forceinline__ void tr_wait2(TrHalf (&f)[2]) { asm volatile("s_waitcnt lgkmcnt(0)" : "+v"(f[0].lo), "+v"(f[0].hi), "+v"(f[1].lo), "+v"(f[1].hi) :: "memory"); }
__device__ __forceinline__ void tr_wait8(TrHalf (&f)[8]) { asm volatile("s_waitcnt lgkmcnt(0)" : "+v"(f[0].lo), "+v"(f[0].hi), "+v"(f[1].lo), "+v"(f[1].hi), "+v"(f[2].lo), "+v"(f[2].hi), "+v"(f[3].lo), "+v"(f[3].hi),
    "+v"(f[4].lo), "+v"(f[4].hi), "+v"(f[5].lo), "+v"(f[5].hi), "+v"(f[6].lo), "+v"(f[6].hi), "+v"(f[7].lo), "+v"(f[7].hi) :: "memory"); }
__device__ __forceinline__ unsigned lds_addr(LAS unsigned char* p) { return (unsigned)(size_t)p; }
constexpr int GL_BC = 0;
constexpr int GL_TOT = 65536;
constexpr int GL_V = 71680;
constexpr int GL_A = 105472;
constexpr int GL_STG = 105472;
constexpr int GL_RED = 124928;
constexpr int GL_QK_PITCH = 272, GL_V_PITCH = 528, GL_A_PITCH = 144;
static_assert(GL_STG + 25600 <= RING_BYTES && GL_V + 64 * GL_V_PITCH <= GL_A && GL_TOT + 4096 + 1024 <= GL_V && 4 * 64 * GL_QK_PITCH <= GL_V, "GLA LDS map");

__device__ __forceinline__ void gla_decays(Frame& F, unsigned char* ws, const float* wgf, const float* bgf, const float* wgb, const float* bgb, int row0, int h, int d0, int d1) {
    LAS float* lr = (LAS float*)(F.lds + GL_STG); LAS float* wg = lr + 64 * 32; LAS float* bg = wg + 2 * 16 * 128;
    LAS float* bc = (LAS float*)(F.lds + GL_BC); LAS float* tot = (LAS float*)(F.lds + GL_TOT);
    { const int t = F.tid >> 3, o4 = (F.tid & 7) * 4; *(LAS f32x4*)(lr + t * 32 + o4) = *(const GAS f32x4*)(((float*)(ws + WS_LR)) + (size_t)(row0 + t) * 32 + o4); }
    for (int i = F.tid; i < 1024; i += NTHR) { const int dir = i >> 9, o = (i >> 5) & 15, d4 = (i & 31) * 4; *(LAS f32x4*)(wg + (dir * 16 + o) * 128 + d4) = *(const GAS f32x4*)((dir ? wgb : wgf) + o * 512 + h * 128 + d4); }
    if (F.tid < 64) { const int dir = F.tid >> 5, d4 = (F.tid & 31) * 4; *(LAS f32x4*)(bg + dir * 128 + d4) = *(const GAS f32x4*)((dir ? bgb : bgf) + h * 128 + d4); }
    __syncthreads();
    { const int t = F.tid >> 3, dg = (F.tid & 7) * 16;
      for (int dir = d0; dir < d1; ++dir) {
          f32x4 z[4];
#pragma unroll
          for (int j = 0; j < 4; ++j) z[j] = *(LAS f32x4*)(bg + dir * 128 + dg + 4 * j);
#pragma unroll
          for (int o = 0; o < 16; ++o) { const float l = lr[t * 32 + dir * 16 + o];
#pragma unroll
              for (int j = 0; j < 4; ++j) z[j] += l * *(LAS f32x4*)(wg + (dir * 16 + o) * 128 + dg + 4 * j); }
#pragma unroll
          for (int j = 0; j < 4; ++j) { f32x4 g; g[0] = log_sigmoid16(z[j][0]); g[1] = log_sigmoid16(z[j][1]); g[2] = log_sigmoid16(z[j][2]); g[3] = log_sigmoid16(z[j][3]); *(LAS f32x4*)(bc + dir * 8192 + t * 128 + dg + 4 * j) = g; } } }
    __syncthreads();
    { const int d = F.tid & 127, seg = F.tid >> 7;
      for (int dir = d0; dir < d1; ++dir) { float a = 0.f;
#pragma unroll
          for (int i = 0; i < 16; ++i) { const int s = seg * 16 + i, t = dir ? 63 - s : s; a += bc[dir * 8192 + t * 128 + d]; bc[dir * 8192 + t * 128 + d] = a; }
          tot[(dir * 4 + seg) * 128 + d] = a; } }
    __syncthreads();
    { const int d = F.tid & 127, seg = F.tid >> 7;
      for (int dir = d0; dir < d1; ++dir) { float pre = 0.f, all = 0.f;
#pragma unroll
          for (int s2 = 0; s2 < 4; ++s2) { const float v = tot[(dir * 4 + s2) * 128 + d]; all += v; if (s2 < seg) pre += v; }
          if (seg == 0) tot[1024 + dir * 128 + d] = all;
          if (seg > 0) {
#pragma unroll
              for (int i = 0; i < 16; ++i) { const int s = seg * 16 + i, t = dir ? 63 - s : s; bc[dir * 8192 + t * 128 + d] += pre; } } } }
    __syncthreads();
}
__device__ __forceinline__ void gla_stage_v(Frame& F, const bf16* U, int row0, int h) {
#pragma unroll
    for (int i = 0; i < 4; ++i) { const int p = F.tid + NTHR * i, t = p >> 5, e8 = (p & 31) * 8;
        *(LAS v4u*)(F.lds + GL_V + t * GL_V_PITCH + e8 * 2) = *(const GAS v4u*)(U + (size_t)(row0 + t) * NU + U_GV + h * 256 + e8); }
}
__device__ __forceinline__ void gla_g1(Frame& F, int L) {
    unsigned char* const ws = PWS(); const bf16* U = (const bf16*)(ws + WS_U);
    const float* wgf = PIN(8) + (size_t)L * 16 * 512; const float* bgf = PIN(9) + L * 512; const float* wgb = PIN(10) + (size_t)L * 16 * 512; const float* bgb = PIN(11) + L * 512;
    const int g = F.lane >> 4, q4 = (F.lane & 15) >> 2, p = F.lane & 3, l15 = F.lane & 15;
    for (int task = F.vcu; task < 16 * GLA_NCH; task += F.G) {
        const int cn = task % GLA_NCH, ch = task / GLA_NCH, h = ch & 3, dir = (ch >> 2) & 1, b = ch >> 3;
        const int row0 = gla_chunk_row0(b, cn), n = gla_scan_idx(cn, dir);
        __syncthreads();
        gla_stage_v(F, U, row0, h);
        v4u kp[2];
#pragma unroll
        for (int i = 0; i < 2; ++i) { const int pc = F.tid + NTHR * i, t = pc >> 4, d8 = (pc & 15) * 8; kp[i] = *(const GAS v4u*)(U + (size_t)(row0 + t) * NU + U_GK + h * 128 + d8); }
        gla_decays(F, ws, wgf, bgf, wgb, bgb, row0, h, dir, dir + 1);
        LAS float* bc = (LAS float*)(F.lds + GL_BC) + dir * 8192; LAS float* bl = (LAS float*)(F.lds + GL_TOT) + 1024 + dir * 128;
        if (F.tid < 128) GLA_DEC(ws)[((size_t)ch * GLA_NCH + n) * 128 + F.tid] = __expf(bl[F.tid]);
        LAS unsigned char* ke = F.lds + GL_BC + (dir ? 0 : 32768);
#pragma unroll
        for (int i = 0; i < 2; ++i) { const int pc = F.tid + NTHR * i, t = pc >> 4, d8 = (pc & 15) * 8;
            const f32x4 b0 = *(LAS f32x4*)(bc + t * 128 + d8), b1 = *(LAS f32x4*)(bc + t * 128 + d8 + 4), l0 = *(LAS f32x4*)(bl + d8), l1 = *(LAS f32x4*)(bl + d8 + 4);
            { float* bo = GLA_BCG(ws) + ((((size_t)(b * 4 + h) * GLA_NCH + cn) * 2 + dir) * 64 + t) * 128 + d8; *(GAS f32x4*)bo = b0; *(GAS f32x4*)(bo + 4) = b1; }
            v4u o; o.x = pk2(bflo(kp[i].x) * __expf(l0[0] - b0[0]), bfhi(kp[i].x) * __expf(l0[1] - b0[1])); o.y = pk2(bflo(kp[i].y) * __expf(l0[2] - b0[2]), bfhi(kp[i].y) * __expf(l0[3] - b0[3]));
            o.z = pk2(bflo(kp[i].z) * __expf(l1[0] - b1[0]), bfhi(kp[i].z) * __expf(l1[1] - b1[1])); o.w = pk2(bflo(kp[i].w) * __expf(l1[2] - b1[2]), bfhi(kp[i].w) * __expf(l1[3] - b1[3]));
            *(LAS v4u*)(ke + t * GL_QK_PITCH + d8 * 2) = o; }
        __syncthreads();
        f32x4 acc[8][2];
#pragma unroll
        for (int mt = 0; mt < 8; ++mt) { acc[mt][0] = (f32x4){0.f, 0.f, 0.f, 0.f}; acc[mt][1] = (f32x4){0.f, 0.f, 0.f, 0.f}; }
        const unsigned ke_a = lds_addr(ke) + GL_QK_PITCH * (8 * g + q4) + 8 * p, v_a = lds_addr(F.lds + GL_V) + GL_V_PITCH * (8 * g + q4) + 8 * p + 2 * (32 * F.wave);
#pragma unroll
        for (int ks = 0; ks < 2; ++ks) {
            TrHalf bh[2], ah[8];
#pragma unroll
            for (int nt = 0; nt < 2; ++nt) tr_issue(bh[nt], v_a + GL_V_PITCH * 32 * ks + 32 * nt, GL_V_PITCH * 4);
#pragma unroll
            for (int mt = 0; mt < 8; ++mt) tr_issue(ah[mt], ke_a + GL_QK_PITCH * 32 * ks + 32 * mt, GL_QK_PITCH * 4);
            tr_wait2(bh); tr_wait8(ah);
            const bf16x8v bv0 = tr_get(bh[0]), bv1 = tr_get(bh[1]);
#pragma unroll
            for (int mt = 0; mt < 8; ++mt) { const bf16x8v av = tr_get(ah[mt]);
                acc[mt][0] = __builtin_amdgcn_mfma_f32_16x16x32_bf16(av, bv0, acc[mt][0], 0, 0, 0); acc[mt][1] = __builtin_amdgcn_mfma_f32_16x16x32_bf16(av, bv1, acc[mt][1], 0, 0, 0); } }
        bf16* dst = GLA_DST(ws) + ((size_t)ch * GLA_NCH + n) * 256 * 128;
#pragma unroll
        for (int mt = 0; mt < 8; ++mt)
#pragma unroll
            for (int nt = 0; nt < 2; ++nt) { const int e = 32 * F.wave + 16 * nt + l15, d = 16 * mt + 4 * g; v2u w; w.x = pk2(acc[mt][nt][0], acc[mt][nt][1]); w.y = pk2(acc[mt][nt][2], acc[mt][nt][3]);
                *(GAS v2u*)(dst + (size_t)e * 128 + d) = w; }
    }
}
__device__ __forceinline__ void gla_g2(Frame& F) {
    unsigned char* const ws = PWS();
    const int NT = F.G * NTHR;
    for (int idx = F.bx * NTHR + F.tid; idx < 16 * 256 * 32; idx += NT) {
        const int ch = idx >> 13, e = (idx >> 5) & 255, d4 = (idx & 31) * 4;
        bf16* p = GLA_DST(ws) + (size_t)ch * GLA_NCH * 32768 + (size_t)e * 128 + d4; const float* dc = GLA_DEC(ws) + (size_t)ch * GLA_NCH * 128 + d4;
        f32x4 S = {0.f, 0.f, 0.f, 0.f};
#pragma unroll 17
        for (int n = 0; n < GLA_NCH; ++n) { const v2u x = *(const GAS v2u*)(p + (size_t)n * 32768); const f32x4 a = *(const GAS f32x4*)(dc + n * 128);
            v2u w; w.x = pk2(S[0], S[1]); w.y = pk2(S[2], S[3]); *(GAS v2u*)(p + (size_t)n * 32768) = w;
            S[0] = a[0] * S[0] + bflo(x.x); S[1] = a[1] * S[1] + bfhi(x.x); S[2] = a[2] * S[2] + bflo(x.y); S[3] = a[3] * S[3] + bfhi(x.y); }
    }
}
__device__ __forceinline__ void gla_g3(Frame& F, int L) {
    unsigned char* const ws = PWS(); const bf16* U = (const bf16*)(ws + WS_U);
    const float* wgf = PIN(8) + (size_t)L * 16 * 512; const float* bgf = PIN(9) + L * 512; const float* wgb = PIN(10) + (size_t)L * 16 * 512; const float* bgb = PIN(11) + L * 512;
    const float* ng = PIN(12) + L * 256;
    const int g = F.lane >> 4, q4 = (F.lane & 15) >> 2, p = F.lane & 3, l15 = F.lane & 15;
    for (int task = F.vcu; task < 8 * GLA_NCH; task += F.G) {
        const int cn = task % GLA_NCH, bh = task / GLA_NCH, h = bh & 3, b = bh >> 2;
        const int row0 = gla_chunk_row0(b, cn);
        __syncthreads();
        gla_stage_v(F, U, row0, h);
        v4u kp[2], qp[2];
#pragma unroll
        for (int i = 0; i < 2; ++i) { const int pc = F.tid + NTHR * i, t = pc >> 4, d8 = (pc & 15) * 8; const bf16* up = U + (size_t)(row0 + t) * NU + h * 128 + d8; kp[i] = *(const GAS v4u*)(up + U_GK); qp[i] = *(const GAS v4u*)(up + U_GQ); }
        { const float* bcg = GLA_BCG(ws) + ((size_t)(b * 4 + h) * GLA_NCH + cn) * 2 * 8192;
#pragma unroll
          for (int i = 0; i < 2; ++i) { const int pc = F.tid + NTHR * i, t = pc >> 4, d8 = (pc & 15) * 8;
#pragma unroll
              for (int dir = 0; dir < 2; ++dir) { const f32x4 b0 = *(const GAS f32x4*)(bcg + dir * 8192 + t * 128 + d8), b1 = *(const GAS f32x4*)(bcg + dir * 8192 + t * 128 + d8 + 4);
                  float ep[8], en[8];
#pragma unroll
                  for (int j = 0; j < 4; ++j) { ep[j] = __expf(b0[j]); ep[4 + j] = __expf(b1[j]); en[j] = __expf(-b0[j]); en[4 + j] = __expf(-b1[j]); }
                  v4u qo, ko;
                  qo.x = pk2(bflo(qp[i].x) * ep[0], bfhi(qp[i].x) * ep[1]); qo.y = pk2(bflo(qp[i].y) * ep[2], bfhi(qp[i].y) * ep[3]); qo.z = pk2(bflo(qp[i].z) * ep[4], bfhi(qp[i].z) * ep[5]); qo.w = pk2(bflo(qp[i].w) * ep[6], bfhi(qp[i].w) * ep[7]);
                  ko.x = pk2(bflo(kp[i].x) * en[0], bfhi(kp[i].x) * en[1]); ko.y = pk2(bflo(kp[i].y) * en[2], bfhi(kp[i].y) * en[3]); ko.z = pk2(bflo(kp[i].z) * en[4], bfhi(kp[i].z) * en[5]); ko.w = pk2(bflo(kp[i].w) * en[6], bfhi(kp[i].w) * en[7]);
                  *(LAS v4u*)(F.lds + GL_BC + (2 * dir) * 64 * GL_QK_PITCH + t * GL_QK_PITCH + d8 * 2) = qo; *(LAS v4u*)(F.lds + GL_BC + (2 * dir + 1) * 64 * GL_QK_PITCH + t * GL_QK_PITCH + d8 * 2) = ko; } } }
        __syncthreads();
        { const int dir = F.wave >> 2, nt = F.wave & 3;
          LAS unsigned char* qi = F.lds + GL_BC + (2 * dir) * 64 * GL_QK_PITCH; LAS unsigned char* ki = qi + 64 * GL_QK_PITCH;
          bf16x8v qf[4];
#pragma unroll
          for (int ks = 0; ks < 4; ++ks) qf[ks] = *(LAS bf16x8v*)(qi + (16 * nt + l15) * GL_QK_PITCH + (32 * ks + 8 * g) * 2);
#pragma unroll
          for (int mt = 0; mt < 4; ++mt) { f32x4 a = {0.f, 0.f, 0.f, 0.f};
              const bool live = dir ? (mt >= nt) : (mt <= nt);
              if (live) {
#pragma unroll
                  for (int ks = 0; ks < 4; ++ks) { const bf16x8v kf = *(LAS bf16x8v*)(ki + (16 * mt + l15) * GL_QK_PITCH + (32 * ks + 8 * g) * 2); a = __builtin_amdgcn_mfma_f32_16x16x32_bf16(kf, qf[ks], a, 0, 0, 0); } }
              const int tau = 16 * nt + l15, s0 = 16 * mt + 4 * g;
#pragma unroll
              for (int i = 0; i < 4; ++i) { const bool keep = dir ? (s0 + i >= tau) : (s0 + i <= tau); if (!keep) a[i] = 0.f; }
              v2u w; w.x = pk2(a[0], a[1]); w.y = pk2(a[2], a[3]);
              *(LAS v2u*)(F.lds + GL_A + dir * 64 * GL_A_PITCH + tau * GL_A_PITCH + s0 * 2) = w; } }
        __syncthreads();
        f32x4 acc[2][4];
#pragma unroll
        for (int mt = 0; mt < 2; ++mt)
#pragma unroll
            for (int nt = 0; nt < 4; ++nt) acc[mt][nt] = (f32x4){0.f, 0.f, 0.f, 0.f};
        { const unsigned v_a = lds_addr(F.lds + GL_V) + GL_V_PITCH * (8 * g + q4) + 8 * p + 2 * (32 * F.wave);
#pragma unroll
          for (int ks = 0; ks < 2; ++ks) { TrHalf vh[2];
#pragma unroll
              for (int mt = 0; mt < 2; ++mt) tr_issue(vh[mt], v_a + GL_V_PITCH * 32 * ks + 32 * mt, GL_V_PITCH * 4);
              tr_wait2(vh); const bf16x8v vf[2] = {tr_get(vh[0]), tr_get(vh[1])};
#pragma unroll
              for (int dir = 0; dir < 2; ++dir)
#pragma unroll
                  for (int nt = 0; nt < 4; ++nt) { const bf16x8v af = *(LAS bf16x8v*)(F.lds + GL_A + dir * 64 * GL_A_PITCH + (16 * nt + l15) * GL_A_PITCH + (32 * ks + 8 * g) * 2);
                      acc[0][nt] = __builtin_amdgcn_mfma_f32_16x16x32_bf16(vf[0], af, acc[0][nt], 0, 0, 0); acc[1][nt] = __builtin_amdgcn_mfma_f32_16x16x32_bf16(vf[1], af, acc[1][nt], 0, 0, 0); } } }
#pragma unroll
        for (int dir = 0; dir < 2; ++dir) { const int ch = (b * 2 + dir) * 4 + h, n = gla_scan_idx(cn, dir);
            const bf16* st = GLA_DST(ws) + ((size_t)ch * GLA_NCH + n) * 32768; LAS unsigned char* qi = F.lds + GL_BC + (2 * dir) * 64 * GL_QK_PITCH;
#pragma unroll
            for (int ks = 0; ks < 4; ++ks) { bf16x8v sf[2];
#pragma unroll
                for (int mt = 0; mt < 2; ++mt) sf[mt] = __builtin_bit_cast(bf16x8v, *(const GAS v4u*)(st + (size_t)(32 * F.wave + 16 * mt + l15) * 128 + 32 * ks + 8 * g));
#pragma unroll
                for (int nt = 0; nt < 4; ++nt) { const bf16x8v qf = *(LAS bf16x8v*)(qi + (16 * nt + l15) * GL_QK_PITCH + (32 * ks + 8 * g) * 2);
                    acc[0][nt] = __builtin_amdgcn_mfma_f32_16x16x32_bf16(sf[0], qf, acc[0][nt], 0, 0, 0); acc[1][nt] = __builtin_amdgcn_mfma_f32_16x16x32_bf16(sf[1], qf, acc[1][nt], 0, 0, 0); } } }
        LAS float* red = (LAS float*)(F.lds + GL_RED);
#pragma unroll
        for (int nt = 0; nt < 4; ++nt) { float s = 0.f;
#pragma unroll
            for (int mt = 0; mt < 2; ++mt)
#pragma unroll
                for (int i = 0; i < 4; ++i) s += acc[mt][nt][i] * acc[mt][nt][i];
            s += __shfl_xor(s, 16); s += __shfl_xor(s, 32);
            if (g == 0) red[F.wave * 64 + 16 * nt + l15] = s; }
        __syncthreads();
#pragma unroll
        for (int nt = 0; nt < 4; ++nt) { const int tau = 16 * nt + l15; float s = 0.f;
#pragma unroll
            for (int w = 0; w < 8; ++w) s += red[w * 64 + tau];
            const float rs = 1.0f / sqrtf(s * (1.0f / 256.0f) + LN_EPS); const size_t row = (size_t)(row0 + tau);
#pragma unroll
            for (int mt = 0; mt < 2; ++mt) { const int e = 32 * F.wave + 16 * mt + 4 * g;
                const v2u rw = *(const GAS v2u*)(U + row * NU + U_GR + h * 256 + e); const f32x4 g4 = *(const f32x4*)(ng + e);
                const float r0 = bflo(rw.x), r1 = bfhi(rw.x), r2 = bflo(rw.y), r3 = bfhi(rw.y);
                v2u w; w.x = pk2(acc[mt][nt][0] * rs * g4[0] * (r0 / (1.0f + __expf(-r0))), acc[mt][nt][1] * rs * g4[1] * (r1 / (1.0f + __expf(-r1))));
                w.y = pk2(acc[mt][nt][2] * rs * g4[2] * (r2 / (1.0f + __expf(-r2))), acc[mt][nt][3] * rs * g4[3] * (r3 / (1.0f + __expf(-r3))));
                *(GAS v2u*)(((bf16*)(ws + WS_Y + (size_t)MROWS * 1024 * 2)) + row * 1024 + h * 256 + e) = w; } }
    }
}

constexpr int NA_VPITCH = 272, NA_VIMG = 32 * NA_VPITCH, NA_WAVE_LDS = 10752;
template <bool CTXQ> __device__ __forceinline__ void na_task(const bf16* U, bf16* YN, LAS unsigned char* vimg, const LAS float* rpb, int lane, int b, int h, int r, int c0, int qrow0) {
    const int g = lane >> 4, q4 = (lane & 15) >> 2, p = lane & 3, l15 = lane & 15;
    const unsigned v_a = lds_addr(vimg) + NA_VPITCH * (4 * g + q4) + 8 * p;
    const int rs = min(max(r - 4, 0), 56), kc0 = min(max(c0 - 8, 0), 32), ctx0 = NLAT + CTXL * b;
    const int qc = c0 + l15, cs = min(max(qc - 8, 0), 48);
    constexpr int KB0 = CTXQ ? 8 : 0;
    bf16x8v qf[4];
#pragma unroll
    for (int ks = 0; ks < 4; ++ks) qf[ks] = __builtin_bit_cast(bf16x8v, *(const GAS v4u*)(U + (size_t)(qrow0 + l15) * NU + U_NQ + h * 128 + 32 * ks + 8 * g));
    f32x4 o[8];
#pragma unroll
    for (int mt = 0; mt < 8; ++mt) o[mt] = (f32x4){0.f, 0.f, 0.f, 0.f};
    float mrun = -INFINITY, lrun = 0.f;
    v4u kf[8], vv[8];
    const unsigned voffK = (unsigned)((l15 * NU + 8 * g) * 2), voffV = (unsigned)(((lane >> 4) * NU + (lane & 15) * 8) * 2);
#define NA_LOAD_BLOCK(tokexpr) do { int tok_ = (tokexpr); asm volatile("" : "+s"(tok_)); \
        const GAS char* kb_ = (const GAS char*)(U + (size_t)tok_ * NU + U_NK + h * 128); const GAS char* vb_ = (const GAS char*)(U + (size_t)tok_ * NU + U_NV + h * 128); \
        _Pragma("unroll") for (int i = 0; i < 8; ++i) kf[i] = *(const GAS v4u*)(kb_ + (size_t)(i >> 2) * (16 * NU * 2) + voffK + 64 * (i & 3)); \
        _Pragma("unroll") for (int i = 0; i < 8; ++i) vv[i] = *(const GAS v4u*)(vb_ + (size_t)i * (4 * NU * 2) + voffV); } while (0)
    NA_LOAD_BLOCK(KB0 < 8 ? b * SEQ + (rs + KB0) * 64 + kc0 : ctx0 + 32 * (KB0 - 8));
#pragma unroll 1
    for (int kb = KB0; kb < 16; ++kb) {
#pragma unroll
        for (int i = 0; i < 8; ++i) { const int id = lane + 64 * i; *(LAS v4u*)(vimg + (id >> 4) * NA_VPITCH + (id & 15) * 16) = vv[i]; }
        v4u kc_[8];
#pragma unroll
        for (int i = 0; i < 8; ++i) kc_[i] = kf[i];
        if (kb + 1 < 16) NA_LOAD_BLOCK((kb + 1) < 8 ? b * SEQ + (rs + kb + 1) * 64 + kc0 : ctx0 + 32 * (kb + 1 - 8));
        f32x4 s0 = {0.f, 0.f, 0.f, 0.f}, s1 = {0.f, 0.f, 0.f, 0.f};
#pragma unroll
        for (int ks = 0; ks < 4; ++ks) { s0 = __builtin_amdgcn_mfma_f32_16x16x32_bf16(__builtin_bit_cast(bf16x8v, kc_[ks]), qf[ks], s0, 0, 0, 0); s1 = __builtin_amdgcn_mfma_f32_16x16x32_bf16(__builtin_bit_cast(bf16x8v, kc_[4 + ks]), qf[ks], s1, 0, 0, 0); }
        if (!CTXQ && kb < 8) { int drow = rs + kb - r + 7; asm volatile("" : "+s"(drow)); const LAS float* rp = rpb + drow * 31 - qc + 15;
#pragma unroll
            for (int i = 0; i < 4; ++i) { const int k0 = kc0 + 4 * g + i, k1 = k0 + 16; const bool ok0 = k0 >= cs && k0 <= cs + 15, ok1 = k1 >= cs && k1 <= cs + 15;
                const float b0 = rp[ok0 ? k0 : qc], b1 = rp[ok1 ? k1 : qc];
                s0[i] = ok0 ? s0[i] + b0 : -INFINITY; s1[i] = ok1 ? s1[i] + b1 : -INFINITY; } }
        float mloc = fmaxf(fmaxf(fmaxf(s0[0], s0[1]), fmaxf(s0[2], s0[3])), fmaxf(fmaxf(s1[0], s1[1]), fmaxf(s1[2], s1[3])));
        mloc = fmaxf(mloc, __shfl_xor(mloc, 16)); mloc = fmaxf(mloc, __shfl_xor(mloc, 32));
        const float mnew = fmaxf(mrun, mloc), alpha = __expf(mrun - mnew); mrun = mnew;
        float ps = 0.f;
#pragma unroll
        for (int i = 0; i < 4; ++i) { s0[i] = __expf(s0[i] - mnew); s1[i] = __expf(s1[i] - mnew); ps += s0[i] + s1[i]; }
        lrun = lrun * alpha + ps;
#pragma unroll
        for (int mt = 0; mt < 8; ++mt) o[mt] *= alpha;
        v4u pw; pw.x = pk2(s0[0], s0[1]); pw.y = pk2(s0[2], s0[3]); pw.z = pk2(s1[0], s1[1]); pw.w = pk2(s1[2], s1[3]);
        const bf16x8v pf = __builtin_bit_cast(bf16x8v, pw);
        TrHalf vh[8];
#pragma unroll
        for (int mt = 0; mt < 8; ++mt) tr_issue(vh[mt], v_a + 32 * mt, NA_VPITCH * 16);
        tr_wait8(vh);
#pragma unroll
        for (int mt = 0; mt < 8; ++mt) o[mt] = __builtin_amdgcn_mfma_f32_16x16x32_bf16(tr_get(vh[mt]), pf, o[mt], 0, 0, 0);
        asm volatile("" ::: "memory"); __builtin_amdgcn_sched_barrier(0);
    }
#undef NA_LOAD_BLOCK
    lrun += __shfl_xor(lrun, 16); lrun += __shfl_xor(lrun, 32);
    const float inv = 1.0f / lrun;
    bf16* yp = YN + (size_t)(qrow0 + l15) * 1024 + h * 128 + 4 * g;
#pragma unroll
    for (int mt = 0; mt < 8; ++mt) { v2u w; w.x = pk2(o[mt][0] * inv, o[mt][1] * inv); w.y = pk2(o[mt][2] * inv, o[mt][3] * inv); *(GAS v2u*)(yp + 16 * mt) = w; }
}
__device__ __forceinline__ void na_mfma(Frame& F, int L) {
    unsigned char* const ws = PWS(); const bf16* U = (const bf16*)(ws + WS_U); bf16* YN = (bf16*)(ws + WS_Y + (size_t)MROWS * 2048 * 2);
    const float* rpbL = PIN(13) + (size_t)L * 8 * 15 * 31;
    LAS unsigned char* vimg = F.lds + RING_OFF + F.wave * NA_WAVE_LDS; LAS float* rpb = (LAS float*)(vimg + NA_VIMG);
    const int gw = F.vcu * NWAVES + F.wave, NGW = F.G * NWAVES;
    int hcur = -1;
    for (int task = gw; task < 2 * 8 * 64 * 4; task += NGW) {
        const int ct = task & 3, r = (task >> 2) & 63, h = (task >> 8) & 7, b = task >> 11;
        if (h != hcur) { hcur = h; for (int i = F.lane; i < 15 * 31; i += 64) rpb[i] = rpbL[h * 15 * 31 + i]; LDS_WAIT(); asm volatile("" ::: "memory"); }
        na_task<false>(U, YN, vimg, rpb, F.lane, b, h, r, 16 * ct, b * SEQ + r * 64 + 16 * ct);
    }
    if (L == 0) for (int tt = gw; tt < 2 * 8 * 16; tt += NGW) {
        const int qt = tt & 15, h = (tt >> 4) & 7, b = tt >> 7;
        na_task<true>(U, YN, vimg, rpb, F.lane, b, h, 0, 0, NLAT + CTXL * b + 16 * qt);
    }
}
#ifndef MK_ONE_LAUNCH
#define MK_ONE_LAUNCH 0
#endif
constexpr int PH_PER_LAYER = 11, NPH = 2 + DEPTH * PH_PER_LAYER;
enum { PL_WIN = 0, PL_MIXA, PL_MIXB, PL_MIXC, PL_BR, PL_WOUT, PL_LN1, PL_GATHER, PL_FFN1, PL_FFN2, PL_LN2 };
__device__ __forceinline__ bool in_range(int lo, int hi, int k) { asm volatile("" : "+s"(lo), "+s"(hi)); return lo <= k && k < hi; }
#ifndef PHMASK
#define PHMASK 0xFFFFFFFFu
#endif
#define IN(k) in_range(lo, hi, (k))
#define EN(bit) ((PHMASK >> (bit)) & 1u)
#ifndef DUPMASK
#define DUPMASK 0u
#endif
#define DUP(bit) ((DUPMASK >> (bit)) & 1u)
#define SEAM(k) do { if (IN((k) + 1)) GRID_BAR(); } while (0)
#if MK_ONE_LAUNCH
#define GRID_BAR() xcd_barrier(bar)
#else
#define GRID_BAR() do { if (F.tid == 0) __hip_atomic_store((gu32*)(PWS() + WS_CTL) + CW_TMO, 0xBADBA0u, RLX_AGENT); } while (0)
#endif
template <int L> __device__ __forceinline__ void layer_phases(const Args& A, LAS unsigned char* const ldsb, const XcdBarrier& bar, const int lo, const int hi) {
    LAS unsigned char* const ring = ldsb + RING_OFF;
        const int pb = 2 + PH_PER_LAYER * L, Mr = (L == 0) ? MROWS : NLAT;
        if (EN(2) && IN(pb + PL_WIN)) { Frame F = mkframe(ldsb, A.grid);
            unsigned char* const ws = PWS();
            lr_tiles(F, L);
            pg8::Gemm g{((bf16*)(ws + WS_H)), w_in_t(ws, L), D, D}; pg8::StaticOrder S; S.init(MROWS, NU, F.G, F.bx);
            pg8::EpiU E{((bf16*)(ws + WS_U)), NU};
            pg8::gemm_phase<pg8::EpiU, pg8::StaticOrder, true, true>(ring, g, S, E);
            SEAM(pb + PL_WIN);
        }
        if (EN(3) && IN(pb + PL_MIXA)) { Frame F = mkframe(ldsb, A.grid); gla_g1(F, L); mix_prep(F, L); if (DUP(3)) { __syncthreads(); gla_g1(F, L); mix_prep(F, L); } SEAM(pb + PL_MIXA); }
        if (EN(4) && IN(pb + PL_MIXB)) { Frame F = mkframe(ldsb, A.grid); gla_g2(F); { int nrep = 1 + (int)DUP(4); asm volatile("" : "+s"(nrep)); for (int rep = 0; rep < nrep; ++rep) { if (rep) __syncthreads(); na_mfma(F, L); } } if (DUP(13)) { VM_WAIT(); __syncthreads(); gla_g2(F); } SEAM(pb + PL_MIXB); }
        if (EN(5) && IN(pb + PL_MIXC)) { Frame F = mkframe(ldsb, A.grid); gla_g3(F, L); if (DUP(5)) { __syncthreads(); gla_g3(F, L); } SEAM(pb + PL_MIXC); }
        if (EN(6) && IN(pb + PL_BR)) { Frame F = mkframe(ldsb, A.grid);
            unsigned char* const ws = PWS(); const float* const gate_b = PIN(17) + (size_t)L * 3 * D;
            pg8::Gemm g{((bf16*)(ws + WS_Y)), w_br_t(ws, L, 0), 1024, 1024}; pg8::BranchOrder S; S.init(Mr, D, F.G, F.bx, MROWS / 256, D / 256);
            pg8::EpiGate E{((bf16*)(ws + WS_U)) + U_GATE, NU, gate_b, ((bf16*)(ws + WS_ZB))};
            pg8::gemm_phase<pg8::EpiGate, pg8::BranchOrder, true, true>(ring, g, S, E);
            SEAM(pb + PL_BR);
        }
        if (EN(7) && IN(pb + PL_WOUT)) { Frame F = mkframe(ldsb, A.grid);
            unsigned char* const ws = PWS(); const float* const modL = ((float*)(ws + WS_MOD)) + (size_t)L * 3 * 12288; const float* const xin = PIN(0); const float* const cin = PIN(2);
            { pg8::Gemm g{((bf16*)(ws + WS_ZB)), w_out_t(ws, L), D, D}; pg8::StaticOrder S; S.init(NLAT, D, F.G, F.bx);
              pg8::EpiRes<false> E{L == 0 ? xin : ((float*)(ws + WS_XL)), cin, modL + 2 * D, 12288, ((float*)(ws + WS_PRE)), ALPHA, 1.0f};
              pg8::gemm_phase<pg8::EpiRes<false>, pg8::StaticOrder, true, true>(ring, g, S, E); }
            if (L == 0) {
              pg8::Gemm g{((bf16*)(ws + WS_ZB)), w_out_t(ws, L), D, 256}; pg8::SplitOrder S; S.init(NLAT / 256, D / 256, 8, 256, F.G, F.bx, 0);
              pg8::EpiPartial<false> E{((float*)(ws + WS_PART)), NLAT / 256, 1.0f};
              pg8::gemm_phase<pg8::EpiPartial<false>, pg8::SplitOrder, false, false>(ring, g, S, E); }
            SEAM(pb + PL_WOUT);
        }
        if (EN(8) && IN(pb + PL_LN1)) { Frame F = mkframe(ldsb, A.grid); ln1_phase(F, L, Mr); SEAM(pb + PL_LN1); }
        if (L == 0) {
            if (EN(10) && IN(pb + PL_FFN1)) { Frame F = mkframe(ldsb, A.grid);
                unsigned char* const ws = PWS();
                pg8::Gemm g{((bf16*)(ws + WS_H)), (const bf16*)w_gu_t(ws, -1), D, D}; pg8::StaticOrder S; S.init(MROWS, NGU, F.G, F.bx);
                pg8::EpiSwiGLU E{((bf16*)(ws + WS_U)), FF};
                pg8::gemm_phase<pg8::EpiSwiGLU, pg8::StaticOrder, true, true>(ring, g, S, E);
                SEAM(pb + PL_FFN1);
            }
            if (EN(11) && IN(pb + PL_FFN2)) { Frame F = mkframe(ldsb, A.grid);
                unsigned char* const ws = PWS(); const float* const modL = ((float*)(ws + WS_MOD)) + (size_t)L * 3 * 12288;
                { pg8::Gemm g{((bf16*)(ws + WS_U)), (const bf16*)w_d_t(ws, -1), FF, FF}; pg8::StaticOrder S; S.init(NLAT, D, F.G, F.bx);
                  pg8::EpiRes<false> E{((float*)(ws + WS_XL)), ((float*)(ws + WS_XL)) + (size_t)NLAT * D, modL + 5 * D, 12288, ((float*)(ws + WS_PRE)), ALPHA, 1.0f};
                  pg8::gemm_phase<pg8::EpiRes<false>, pg8::StaticOrder, true, true>(ring, g, S, E); }
                { pg8::Gemm g{((bf16*)(ws + WS_U)), (const bf16*)w_d_t(ws, -1), FF, 512}; pg8::SplitOrder S; S.init(NLAT / 256, D / 256, 11, 512, F.G, F.bx, 0);
                  pg8::EpiPartial<false> E{((float*)(ws + WS_PART)), NLAT / 256, 1.0f};
                  pg8::gemm_phase<pg8::EpiPartial<false>, pg8::SplitOrder, false, false>(ring, g, S, E); }
                SEAM(pb + PL_FFN2);
            }
            if (EN(12) && IN(pb + PL_LN2)) { Frame F = mkframe(ldsb, A.grid); ln2_dense(F, L); if (DUP(12)) { __syncthreads(); ln2_dense(F, L); } SEAM(pb + PL_LN2); }
        } else {
            if (EN(10) && IN(pb + PL_FFN1)) { Frame F = mkframe(ldsb, A.grid);
                unsigned char* const ws = PWS();
                unsigned cnt[8]; int pp[9]; moe_prefix(ws, cnt, pp);
                pg8::Gemm g{((bf16*)(ws + WS_GLA)), (const bf16*)w_gu_t(ws, 0), D / 2, D / 2}; pg8::MoeOrder S; S.init(cnt, NGU / 256, F.G, F.bx, NLAT / 256);
                pg8::EpiSwiGLU8 E{ws + WS_U, FF, 1.0f / FSC_WGU, FSC_HID};
                pg8::gemm_phase<pg8::EpiSwiGLU8, pg8::MoeOrder, true, true, true>(ring, g, S, E);
                SEAM(pb + PL_FFN1);
            }
            if (EN(11) && IN(pb + PL_FFN2)) { Frame F = mkframe(ldsb, A.grid);
                unsigned char* const ws = PWS(); const float* const modL = ((float*)(ws + WS_MOD)) + (size_t)L * 3 * 12288;
                unsigned cnt[8]; int pp[9]; moe_prefix(ws, cnt, pp);
                pg8::Gemm g{((bf16*)(ws + WS_U)), (const bf16*)w_d_t(ws, 0), FF / 2, FF / 2}; pg8::MoeOrder S; S.init(cnt, D / 256, F.G, F.bx, 0);
                pg8::EpiBf16Plain E{((bf16*)(ws + WS_Z)), D, 1.0f / (FSC_HID * FSC_WD)};
                pg8::gemm_phase<pg8::EpiBf16Plain, pg8::MoeOrder, true, true, true>(ring, g, S, E);
                SEAM(pb + PL_FFN2);
            }
            if (EN(12) && IN(pb + PL_LN2)) { Frame F = mkframe(ldsb, A.grid); ln2_moe(F, L); }
        }
    }
__global__ void __launch_bounds__(NTHR, 2) fwd_kernel(Args A) {
    __shared__ __attribute__((aligned(16))) unsigned char lds[LDS_BYTES];
    LAS unsigned char* const ldsb = (LAS unsigned char*)lds;
    { Frame F = mkframe(ldsb, A.grid);
    for (int u = F.tid; u < (LDS_BYTES - LDSCTL_OFF) / 4; u += NTHR) ((LAS unsigned*)(F.lds + LDSCTL_OFF))[u] = 0u;
    __syncthreads();
    if (F.tid < 32) { const unsigned long long p = F.tid < 30 ? (unsigned long long)A.in[F.tid] : (F.tid == 30 ? (unsigned long long)A.out : (unsigned long long)A.ws);
        ((LAS unsigned long long*)(F.lds + PTAB_OFF))[F.tid] = p; }
    __syncthreads(); }
#if MK_ONE_LAUNCH
    XcdBarrier bar; { Frame F = mkframe(ldsb, A.grid); bar = xcd_barrier_post((unsigned*)(PWS() + WS_CTL) + CW_BAR, F.MISC + 8, (unsigned)A.grid); }
#else
    XcdBarrier bar; bar.bar = nullptr; bar.x = 0; bar.grid = 0; bar.st = nullptr;
#endif
    const int lo = A.ph_lo, hi = A.ph_hi;
    LAS unsigned char* const ring = ldsb + RING_OFF;

    if (EN(0) && IN(0)) { Frame F = mkframe(ldsb, A.grid); p0a_prologue(F); if (DUP(0)) { __syncthreads(); p0a_prologue(F); } SEAM(0); }
    if (EN(1) && IN(1)) { Frame F = mkframe(ldsb, A.grid); p0b_modulate(F); if (DUP(1)) { __syncthreads(); p0b_modulate(F); } SEAM(1); }
    layer_phases<0>(A, ldsb, bar, lo, hi);
    layer_phases<1>(A, ldsb, bar, lo, hi);
}

extern "C" void kernel_launch(void* const* d_in, const int* in_sizes, int n_in, void* d_out, int out_size, void* d_ws, size_t ws_size, hipStream_t stream) {
    static int grid = 0;
    if (grid == 0) {
        if (n_in != 30 || out_size != NLAT * D || ws_size < WS_END) { fprintf(stderr, "kernel_launch: unexpected shapes (n_in %d out %d ws %zu); nothing launched\n", n_in, out_size, ws_size); grid = -1; return; }
        int dev = 0, cus = 0, per_cu = 0;
        if (hipGetDevice(&dev) != hipSuccess || hipDeviceGetAttribute(&cus, hipDeviceAttributeMultiprocessorCount, dev) != hipSuccess) { grid = -1; return; }
        if (hipOccupancyMaxActiveBlocksPerMultiprocessor(&per_cu, (const void*)fwd_kernel, NTHR, 0) != hipSuccess || per_cu < 1) { fprintf(stderr, "kernel_launch: occupancy query says %d\n", per_cu); (void)hipGetLastError(); grid = -1; return; }
        grid = cus;
    }
    if (grid < 0) return;
    (void)hipMemsetAsync((char*)d_ws + WS_CTL, 0, CTL_ZERO_BYTES, stream);
    Args a{};
    for (int i = 0; i < 30; ++i) a.in[i] = (const float*)d_in[i];
    a.out = (float*)d_out; a.ws = (unsigned char*)d_ws; a.grid = grid;
#if MK_ONE_LAUNCH
    a.ph_lo = 0; a.ph_hi = NPH;
    hipLaunchKernelGGL(fwd_kernel, dim3(grid), dim3(NTHR), 0, stream, a);
#else
#ifndef NPH_RUN
#define NPH_RUN NPH
#endif
    for (int p = 0; p < NPH_RUN; ++p) {
        if (p == 2 + PL_GATHER || p == 2 + PH_PER_LAYER + PL_GATHER) continue;
        a.ph_lo = p; a.ph_hi = p + 1;
        hipLaunchKernelGGL(fwd_kernel, dim3(grid), dim3(NTHR), 0, stream, a);
    }
#endif
}
```

```cpp
#define MK_ONE_LAUNCH 1
#include <hip/hip_runtime.h>
#include <cstdio>

namespace pg8 {
#define PG8_LAS __attribute__((address_space(3)))
typedef unsigned short bf16_t;
typedef short bf16x8 __attribute__((ext_vector_type(8)));
typedef float f32x4 __attribute__((ext_vector_type(4)));
typedef unsigned u32x4 __attribute__((ext_vector_type(4)));
typedef unsigned u32x2 __attribute__((ext_vector_type(2)));
typedef int i32x4 __attribute__((ext_vector_type(4)));
typedef int i32x8 __attribute__((ext_vector_type(8)));
constexpr int BM = 256, BK = 64, HALF = 128, HTB = HALF * BK * 2  , STAGE_BYTES = 8 * HTB, NXCD = 8, WGM = 8;

__host__ __device__ __forceinline__ int lds_byte(int r, int c) { const int st = (r >> 4) * 2 + (c >> 5), rr = r & 15, cc = c & 31, ob = rr * 64 + cc * 2; return st * 1024 + (ob ^ (((ob >> 9) & 1) << 5)); }
__host__ __device__ __forceinline__ void stage_rc(int b, int& R, int& C) { const int st = b / 1024, sb = b % 1024, swz = sb ^ (((sb >> 9) & 1) << 5); R = (st >> 1) * 16 + swz / 64; C = (st & 1) * 32 + (swz % 64) / 2; }
__host__ __device__ __forceinline__ int perm32(int rho) { const int n = rho >> 4, i = rho & 15; return 8 * (i >> 2) + 4 * n + (i & 3); }

struct Unit { int pm, pn, pa, pb, ko, aux; };
struct Gemm { const bf16_t* A; const bf16_t* Bt; int K, KT; };

__device__ __forceinline__ int xcd_remap(int wgid, int nwg) { const int q = nwg / NXCD, r = nwg % NXCD, xcd = wgid % NXCD, off = wgid / NXCD; return (xcd < r ? xcd * (q + 1) : r * (q + 1) + (xcd - r) * q) + off; }
struct StaticOrder {
    int nM, nN, nwg, G, c;
    __host__ __device__ void init(int M, int N, int G_, int c_) { nM = M / BM; nN = N / BM; nwg = nM * nN; G = G_; c = c_; }
    __device__ __forceinline__ bool next(int i, Unit& u) const {
        const long L = (long)i * G + c; if (L >= nwg) return false;
        const int wgid = xcd_remap((int)L, nwg);
        const int nig = WGM * nN, gid = wgid / nig, fm = gid * WGM, gsz = (nM - fm) < WGM ? (nM - fm) : WGM;
        u.pm = fm + ((wgid % nig) % gsz); u.pn = (wgid % nig) / gsz; u.pa = u.pm; u.pb = u.pn; u.ko = 0; u.aux = 0; return true;
    }
    __device__ __forceinline__ void a_ready(const Unit&) const {}
    __device__ __forceinline__ void done(const Unit&) const {}
};
struct MoeOrder {
    int nN, G, c, nunits, abucket; int pp[9];
    __device__ __forceinline__ void init(const unsigned* cnt, int nN_, int G_, int c_, int abucket_) { nN = nN_; G = G_; c = c_; abucket = abucket_; pp[0] = 0;
#pragma unroll
        for (int e = 0; e < 8; ++e) pp[e + 1] = pp[e] + (int)((cnt[e] + 255u) >> 8);
        nunits = pp[8] * nN; }
    __device__ __forceinline__ bool next(int i, Unit& u) const {
        const long L = (long)i * G + c; if (L >= nunits) return false;
        const int wgid = xcd_remap((int)L, nunits);
        int e = 0, base = 0, npe = pp[1];
#pragma unroll
        for (int k = 1; k < 8; ++k) { if (wgid >= pp[k] * nN) { e = k; base = pp[k]; npe = pp[k + 1] - pp[k]; } }
        if (npe < 1) npe = 1;
        const int local = wgid - base * nN;
        u.pm = base + local % npe; u.pn = local / npe; u.pa = abucket ? e * abucket + local % npe : u.pm; u.pb = e * nN + u.pn; u.ko = 0; u.aux = 0; return true;
    }
    __device__ __forceinline__ void a_ready(const Unit&) const {}
    __device__ __forceinline__ void done(const Unit&) const {}
};

struct BranchOrder {
    StaticOrder S; int apanels, bpanels;
    __device__ __forceinline__ void init(int M, int N, int G_, int c_, int apan, int bpan) { S.init(M, N, G_, c_); apanels = apan; bpanels = bpan; }
    __device__ __forceinline__ bool next(int i, Unit& u) const { const int j = i / 3, b = i - 3 * j; if (!S.next(j, u)) return false; u.pa = b * apanels + u.pm; u.pb = b * bpanels + u.pn; u.aux = b; return true; }
    __device__ __forceinline__ void a_ready(const Unit&) const {}
    __device__ __forceinline__ void done(const Unit&) const {}
};
struct SplitOrder {
    int pm0, nN, nsplit, KT, G, c, rot;
    __device__ __forceinline__ void init(int pm0_, int nN_, int nsplit_, int KT_, int G_, int c_, int rot_) { pm0 = pm0_; nN = nN_; nsplit = nsplit_; KT = KT_; G = G_; c = c_; rot = rot_; }
    __device__ __forceinline__ bool next(int i, Unit& u) const {
        int cc = c - rot; if (cc < 0) cc += G;
        const long L = (long)i * G + cc; if (L >= 2 * nN * nsplit) return false;
        const int s = (int)L % nsplit, tile = (int)L / nsplit;
        u.pm = pm0 + tile / nN; u.pn = tile % nN; u.pa = u.pm; u.pb = u.pn; u.ko = s * KT; u.aux = s; return true;
    }
    __device__ __forceinline__ void a_ready(const Unit&) const {}
    __device__ __forceinline__ void done(const Unit&) const {}
};

__device__ __forceinline__ unsigned cvt_pk_bf16(float lo, float hi) { unsigned r; asm volatile("v_cvt_pk_bf16_f32 %0, %1, %2" : "=v"(r) : "v"(lo), "v"(hi)); return r; }
__device__ __forceinline__ unsigned pk_fp8x4(float a, float b, float c, float d) { int v = __builtin_amdgcn_cvt_pk_fp8_f32(a, b, 0, false); v = __builtin_amdgcn_cvt_pk_fp8_f32(c, d, v, true); return (unsigned)v; }
__device__ __forceinline__ float clamp448(float x) { return fminf(fmaxf(x, -448.0f), 448.0f); }
__device__ __forceinline__ float bf_lo(unsigned w) { return __uint_as_float(w << 16); }
__device__ __forceinline__ float bf_hi(unsigned w) { return __uint_as_float(w & 0xffff0000u); }
__device__ __forceinline__ float fast_sigmoid(float x) { return __builtin_amdgcn_rcpf(1.0f + __expf(-x)); }

struct EpiBf16Plain {
    static constexpr bool PERM = true, AFTER_DRAIN = false;
    bf16_t* O; int ldc; float oscale;
    __device__ __forceinline__ void operator()(const f32x4 (&acc)[2][2][4][2], const Unit& u, int wr, int wc, int fr, int fq) const {
        const int row0 = u.pm * BM + wr * 64 + fr, col0 = u.pn * BM + wc * 32 + 8 * fq;
#pragma unroll
        for (int ai = 0; ai < 2; ++ai)
#pragma unroll
            for (int m = 0; m < 4; ++m) { bf16_t* rowp = O + (size_t)(row0 + ai * HALF + m * 16) * ldc + col0;
#pragma unroll
                for (int bj = 0; bj < 2; ++bj) { const f32x4 v0 = acc[ai][bj][m][0] * oscale, v1 = acc[ai][bj][m][1] * oscale;
                    u32x4 w; w.x = cvt_pk_bf16(v0[0], v0[1]); w.y = cvt_pk_bf16(v0[2], v0[3]); w.z = cvt_pk_bf16(v1[0], v1[1]); w.w = cvt_pk_bf16(v1[2], v1[3]);
                    *(u32x4*)(rowp + bj * HALF) = w; } }
    }
};
struct EpiU {
    static constexpr bool PERM = true, AFTER_DRAIN = false;
    bf16_t* O; int ldc; float oscale;
    __device__ __forceinline__ void operator()(const f32x4 (&acc)[2][2][4][2], const Unit& u, int wr, int wc, int fr, int fq) const {
        const int row0 = u.pm * BM + wr * 64 + fr, col0 = u.pn * BM + wc * 32 + 8 * fq;
        const bool is_gq = (u.pn == 12 || u.pn == 13), is_gk = (u.pn == 14 || u.pn == 15), is_nq = (u.pn >= 24 && u.pn < 28);
        const float sc = ((is_gq || is_nq) ? 0.08838834764831845f : 1.0f) * oscale;
        const bool rope = (is_gq || is_gk) && u.pm < 32;
        float inv[4];
#pragma unroll
        for (int j = 0; j < 4; ++j) inv[j] = exp2f(-(float)((16 * wc + 4 * fq + j) & 31) * 0.41524101186092029f);
#pragma unroll
        for (int ai = 0; ai < 2; ++ai)
#pragma unroll
            for (int m = 0; m < 4; ++m) { const int row = row0 + ai * HALF + m * 16; bf16_t* rowp = O + (size_t)row * ldc + col0;
                const int t = row & 4095; const float pos = (wc < 2) ? (float)(t >> 6) : (float)(t & 63);
                float cs[4], sn[4];
                if (rope) {
#pragma unroll
                    for (int j = 0; j < 4; ++j) { const float ang = pos * inv[j]; cs[j] = __cosf(ang); sn[j] = __sinf(ang); } }
#pragma unroll
                for (int bj = 0; bj < 2; ++bj) { f32x4 v0 = acc[ai][bj][m][0] * sc, v1 = acc[ai][bj][m][1] * sc;
                    if (rope) { const f32x4 a = v0, b = v1;
                        v0[0] = a[0] * cs[0] - a[1] * sn[0]; v0[1] = a[0] * sn[0] + a[1] * cs[0]; v0[2] = a[2] * cs[1] - a[3] * sn[1]; v0[3] = a[2] * sn[1] + a[3] * cs[1];
                        v1[0] = b[0] * cs[2] - b[1] * sn[2]; v1[1] = b[0] * sn[2] + b[1] * cs[2]; v1[2] = b[2] * cs[3] - b[3] * sn[3]; v1[3] = b[2] * sn[3] + b[3] * cs[3]; }
                    u32x4 w; w.x = cvt_pk_bf16(v0[0], v0[1]); w.y = cvt_pk_bf16(v0[2], v0[3]); w.z = cvt_pk_bf16(v1[0], v1[1]); w.w = cvt_pk_bf16(v1[2], v1[3]);
                    *(u32x4*)(rowp + bj * HALF) = w; } }
    }
};
struct EpiF32Plain {
    static constexpr bool PERM = false, AFTER_DRAIN = false;
    float* C; int ldc; float oscale;
    __device__ __forceinline__ void operator()(const f32x4 (&acc)[2][2][4][2], const Unit& u, int wr, int wc, int fr, int fq) const {
        const int row0 = u.pm * BM + wr * 64 + fr, col0 = u.pn * BM + wc * 32 + 4 * fq;
#pragma unroll
        for (int ai = 0; ai < 2; ++ai)
#pragma unroll
            for (int m = 0; m < 4; ++m) { float* rowp = C + (size_t)(row0 + ai * HALF + m * 16) * ldc + col0;
#pragma unroll
                for (int bj = 0; bj < 2; ++bj)
#pragma unroll
                    for (int n = 0; n < 2; ++n) *(f32x4*)(rowp + bj * HALF + n * 16) = acc[ai][bj][m][n] * oscale; }
    }
};
template <bool SC> struct EpiPartial {
    static constexpr bool PERM = false, AFTER_DRAIN = false;
    float* P; int pm0; float oscale;
    __device__ __forceinline__ void operator()(const f32x4 (&acc)[2][2][4][2], const Unit& u, int wr, int wc, int fr, int fq) const {
        const int row0 = (u.pm - pm0) * BM + wr * 64 + fr, col0 = u.pn * BM + wc * 32 + 4 * fq; float* base = P + (size_t)u.aux * 512 * 2048;
#pragma unroll
        for (int ai = 0; ai < 2; ++ai)
#pragma unroll
            for (int m = 0; m < 4; ++m) { float* rowp = base + (size_t)(row0 + ai * HALF + m * 16) * 2048 + col0;
#pragma unroll
                for (int bj = 0; bj < 2; ++bj)
#pragma unroll
                    for (int n = 0; n < 2; ++n) *(f32x4*)(rowp + bj * HALF + n * 16) = SC ? acc[ai][bj][m][n] * oscale : acc[ai][bj][m][n]; }
    }
};
struct EpiGate {
    static constexpr bool PERM = false, AFTER_DRAIN = false;
    const bf16_t* Ug; int ldu;
    const float* gb;
    bf16_t* ZB;
    __device__ __forceinline__ void operator()(const f32x4 (&acc)[2][2][4][2], const Unit& u, int wr, int wc, int fr, int fq) const {
        const int row0 = u.pm * BM + wr * 64 + fr, col0 = u.pn * BM + wc * 32 + 4 * fq; const bool first = u.aux == 0;
        const bf16_t* Ub = Ug + 2048 * u.aux + col0; const float* gbb = gb + 2048 * u.aux + col0; bf16_t* zb = ZB + col0;
        f32x4 b4[2][2];
#pragma unroll
        for (int bj = 0; bj < 2; ++bj)
#pragma unroll
            for (int n = 0; n < 2; ++n) b4[bj][n] = *(const f32x4*)(gbb + bj * HALF + n * 16);
#pragma unroll
        for (int ai = 0; ai < 2; ++ai) {
            u32x2 gl[4][2][2], zp[4][2][2];
#pragma unroll
            for (int m = 0; m < 4; ++m) { const size_t row = (size_t)(row0 + ai * HALF + m * 16);
#pragma unroll
                for (int bj = 0; bj < 2; ++bj)
#pragma unroll
                    for (int n = 0; n < 2; ++n) { gl[m][bj][n] = *(const u32x2*)(Ub + row * ldu + bj * HALF + n * 16); if (!first) zp[m][bj][n] = *(const u32x2*)(zb + row * 2048 + bj * HALF + n * 16); } }
#pragma unroll
            for (int m = 0; m < 4; ++m) { const size_t row = (size_t)(row0 + ai * HALF + m * 16);
#pragma unroll
                for (int bj = 0; bj < 2; ++bj)
#pragma unroll
                    for (int n = 0; n < 2; ++n) { const u32x2 g2 = gl[m][bj][n]; f32x4 v = acc[ai][bj][m][n];
                        v[0] *= fast_sigmoid(bf_lo(g2.x) + b4[bj][n][0]); v[1] *= fast_sigmoid(bf_hi(g2.x) + b4[bj][n][1]); v[2] *= fast_sigmoid(bf_lo(g2.y) + b4[bj][n][2]); v[3] *= fast_sigmoid(bf_hi(g2.y) + b4[bj][n][3]);
                        if (!first) { const u32x2 z2 = zp[m][bj][n]; v[0] += bf_lo(z2.x); v[1] += bf_hi(z2.x); v[2] += bf_lo(z2.y); v[3] += bf_hi(z2.y); }
                        u32x2 w; w.x = cvt_pk_bf16(v[0], v[1]); w.y = cvt_pk_bf16(v[2], v[3]); *(u32x2*)(zb + row * 2048 + bj * HALF + n * 16) = w; } }
            asm volatile("" ::: "memory"); }
    }
};
template <bool SC> struct EpiRes {
    static constexpr bool PERM = false, AFTER_DRAIN = false;
    const float* res_lat; const float* res_ctx; const float* gv; int gstride; float* out; float alpha, oscale;
    __device__ __forceinline__ void operator()(const f32x4 (&acc)[2][2][4][2], const Unit& u, int wr, int wc, int fr, int fq) const {
        const int grp = u.pm < 16 ? 0 : (u.pm < 32 ? 1 : 2);
        const int rl0 = wr * 64 + fr, col0 = u.pn * BM + wc * 32 + 4 * fq;
        const float* res = (u.pm < 32 ? res_lat + (size_t)u.pm * BM * 2048 : res_ctx + (size_t)(u.pm - 32) * BM * 2048) + col0;
        const float* g = gv + (size_t)grp * gstride + col0; float* o = out + (size_t)u.pm * BM * 2048 + col0;
        f32x4 g4[2][2];
#pragma unroll
        for (int bj = 0; bj < 2; ++bj)
#pragma unroll
            for (int n = 0; n < 2; ++n) g4[bj][n] = *(const f32x4*)(g + bj * HALF + n * 16);
#pragma unroll
        for (int q = 0; q < 4; ++q) {
            const int ai = q >> 1, m0 = (q & 1) * 2;
            f32x4 r4[2][2][2];
#pragma unroll
            for (int m = 0; m < 2; ++m)
#pragma unroll
                for (int bj = 0; bj < 2; ++bj)
#pragma unroll
                    for (int n = 0; n < 2; ++n) r4[m][bj][n] = *(const f32x4*)(res + (size_t)(rl0 + ai * HALF + (m0 + m) * 16) * 2048 + bj * HALF + n * 16);
#pragma unroll
            for (int m = 0; m < 2; ++m)
#pragma unroll
                for (int bj = 0; bj < 2; ++bj)
#pragma unroll
                    for (int n = 0; n < 2; ++n) *(f32x4*)(o + (size_t)(rl0 + ai * HALF + (m0 + m) * 16) * 2048 + bj * HALF + n * 16) = r4[m][bj][n] * alpha + g4[bj][n] * (SC ? acc[ai][bj][m0 + m][n] * oscale : acc[ai][bj][m0 + m][n]);
            asm volatile("" ::: "memory"); }
    }
};
struct EpiSwiGLU {
    static constexpr bool PERM = true, AFTER_DRAIN = false;
    bf16_t* O; int ldc;
    __device__ __forceinline__ void operator()(const f32x4 (&acc)[2][2][4][2], const Unit& u, int wr, int wc, int fr, int fq) const {
        const int row0 = u.pm * BM + wr * 64 + fr, col0 = u.pn * HALF + wc * 32 + 8 * fq;
#pragma unroll
        for (int ai = 0; ai < 2; ++ai)
#pragma unroll
            for (int m = 0; m < 4; ++m) { bf16_t* rowp = O + (size_t)(row0 + ai * HALF + m * 16) * ldc + col0;
                float h[8];
#pragma unroll
                for (int n = 0; n < 2; ++n)
#pragma unroll
                    for (int j = 0; j < 4; ++j) { const float gt = acc[ai][0][m][n][j], up = acc[ai][1][m][n][j]; h[n * 4 + j] = gt * fast_sigmoid(gt) * up; }
                u32x4 w; w.x = cvt_pk_bf16(h[0], h[1]); w.y = cvt_pk_bf16(h[2], h[3]); w.z = cvt_pk_bf16(h[4], h[5]); w.w = cvt_pk_bf16(h[6], h[7]);
                *(u32x4*)rowp = w; }
    }
};
struct EpiSwiGLU8 {
    static constexpr bool PERM = true, AFTER_DRAIN = false;
    unsigned char* O; int ldc; float oscale, hscale;
    __device__ __forceinline__ void operator()(const f32x4 (&acc)[2][2][4][2], const Unit& u, int wr, int wc, int fr, int fq) const {
        const int row0 = u.pm * BM + wr * 64 + fr, col0 = u.pn * HALF + wc * 32 + 8 * fq;
#pragma unroll
        for (int ai = 0; ai < 2; ++ai)
#pragma unroll
            for (int m = 0; m < 4; ++m) { unsigned char* rowp = O + (size_t)(row0 + ai * HALF + m * 16) * ldc + col0;
                float h[8];
#pragma unroll
                for (int n = 0; n < 2; ++n)
#pragma unroll
                    for (int j = 0; j < 4; ++j) { const float gt = acc[ai][0][m][n][j] * oscale, up = acc[ai][1][m][n][j] * oscale; h[n * 4 + j] = clamp448(gt * fast_sigmoid(gt) * up * hscale); }
                u32x2 w; w.x = pk_fp8x4(h[0], h[1], h[2], h[3]); w.y = pk_fp8x4(h[4], h[5], h[6], h[7]);
                *(u32x2*)rowp = w; }
    }
};

template <class Epi, class Sched, bool ALIGN_EPI = false, bool SP2 = false, bool F8 = false>
__device__ __forceinline__ void gemm_phase(PG8_LAS unsigned char* lds, const Gemm g, const Sched& S, const Epi& E) {
    int tid_ = threadIdx.x; asm volatile("" : "+v"(tid_));
    const int tid = tid_, wid = __builtin_amdgcn_readfirstlane(tid >> 6), lane = tid & 63, wr = wid >> 2, wc = wid & 3, fr = lane & 15, fq = lane >> 4;
    const int K = g.K, nt = g.KT / BK;
    unsigned voffA[2], voffB[2];
#pragma unroll
    for (int i = 0; i < 2; ++i) { int R, C; stage_rc(tid * 16 + i * 8192, R, C); const int Rb = Epi::PERM ? ((R & ~31) + perm32(R & 31)) : R;
        voffA[i] = (unsigned)(R * K + C) * 2u; voffB[i] = (unsigned)(Rb * K + C) * 2u; }
    const size_t kstep = (size_t)(BK * 2);
    const size_t hstep = (size_t)HALF * K * 2;
    const size_t tstep = 2 * hstep;
    const unsigned ldsw = (unsigned)wid * 1024u;
    const int aoff = lds_byte(wr * 64 + fr, fq * 8), boff = lds_byte(wc * 32 + fr, fq * 8);
#define PG8_SA(b, h) (((b) * 2 + (h)) * HTB)
#define PG8_SB(b, h) ((4 + (b) * 2 + (h)) * HTB)
#define PG8_STAGE(bufoff, gbase, voff) do { _Pragma("unroll") for (int _i = 0; _i < 2; ++_i) \
        __builtin_amdgcn_global_load_lds((const unsigned*)((const char*)(gbase) + (voff)[_i]), (PG8_LAS unsigned*)(lds + (bufoff) + ldsw + _i * 8192), 16, 0, 0); } while (0)
#define PG8_CAT(p) __builtin_shufflevector(*(const PG8_LAS i32x4*)(p), *(const PG8_LAS i32x4*)((p) + 1024), 0, 1, 2, 3, 4, 5, 6, 7)
#define PG8_LDA(dst, b, h) do { _Pragma("unroll") for (int m = 0; m < 4; ++m) { if constexpr (F8) dst##8[m] = PG8_CAT(lds + PG8_SA(b, h) + aoff + m * 2048); else { _Pragma("unroll") for (int k = 0; k < 2; ++k) dst[m][k] = *(const PG8_LAS bf16x8*)(lds + PG8_SA(b, h) + aoff + m * 2048 + k * 1024); } } } while (0)
#define PG8_LDB(dst, b, h) do { _Pragma("unroll") for (int n = 0; n < 2; ++n) { if constexpr (F8) dst##8[n] = PG8_CAT(lds + PG8_SB(b, h) + boff + n * 2048); else { _Pragma("unroll") for (int k = 0; k < 2; ++k) dst[n][k] = *(const PG8_LAS bf16x8*)(lds + PG8_SB(b, h) + boff + n * 2048 + k * 1024); } } } while (0)
#define PG8_MMA(ai, bj, At, Bt) do { __builtin_amdgcn_s_setprio(1); _Pragma("unroll") for (int m = 0; m < 4; ++m) _Pragma("unroll") for (int n = 0; n < 2; ++n) { \
        if constexpr (F8) asm volatile("v_mfma_scale_f32_16x16x128_f8f6f4 %0, %1, %2, %0, %3, %3 op_sel_hi:[0,0,0]" : "+v"(acc[ai][bj][m][n]) : "v"(Bt##8[n]), "v"(At##8[m]), "v"(f8one));   \
        else { _Pragma("unroll") for (int k = 0; k < 2; ++k) acc[ai][bj][m][n] = __builtin_amdgcn_mfma_f32_16x16x32_bf16(Bt[n][k], At[m][k], acc[ai][bj][m][n], 0, 0, 0); } } \
        __builtin_amdgcn_s_setprio(0); } while (0)
#define PG8_WAIT_V(n) asm volatile("s_waitcnt vmcnt(" #n ")" ::: "memory")
#define PG8_WAIT_L(n) asm volatile("s_waitcnt lgkmcnt(" #n ")" ::: "memory")
#define PG8_BAR __builtin_amdgcn_s_barrier()
#define PG8_SCHED __builtin_amdgcn_sched_barrier(0)
    Unit cur, nxt; int ui = 0;
    if (!S.next(0, cur)) return;
    f32x4 acc[2][2][4][2];
#pragma unroll
    for (int a = 0; a < 2; ++a)
#pragma unroll
        for (int b = 0; b < 2; ++b)
#pragma unroll
            for (int m = 0; m < 4; ++m)
#pragma unroll
                for (int n = 0; n < 2; ++n) acc[a][b][m][n] = (f32x4){0.f, 0.f, 0.f, 0.f};
    const int f8one = 0x7f7f7f7f;
    bf16x8 At[4][2], B0[2][2], B1[2][2];
    i32x8 At8[4], B08[2], B18[2];
    const char* cA = (const char*)g.A + (size_t)cur.pa * tstep + (size_t)cur.ko * 2; const char* cB = (const char*)g.Bt + (size_t)cur.pb * tstep + (size_t)cur.ko * 2;
    S.a_ready(cur);
    if constexpr (SP2) {
        PG8_STAGE(PG8_SB(0, 0), cB, voffB); PG8_STAGE(PG8_SB(0, 1), cB + hstep, voffB); PG8_STAGE(PG8_SA(0, 0), cA, voffA); PG8_STAGE(PG8_SA(0, 1), cA + hstep, voffA);
        if (wr == 1) PG8_BAR;
        PG8_WAIT_V(2); PG8_BAR;
        PG8_STAGE(PG8_SB(1, 0), cB + kstep, voffB); PG8_STAGE(PG8_SA(1, 0), cA + kstep, voffA); PG8_STAGE(PG8_SB(1, 1), cB + hstep + kstep, voffB);
        PG8_WAIT_V(6); PG8_BAR;
    } else {
        PG8_STAGE(PG8_SB(0, 0), cB, voffB); PG8_STAGE(PG8_SA(0, 0), cA, voffA); PG8_STAGE(PG8_SB(0, 1), cB + hstep, voffB); PG8_STAGE(PG8_SA(0, 1), cA + hstep, voffA);
        if (wr == 1) PG8_BAR;
        PG8_WAIT_V(4); PG8_BAR;
        PG8_STAGE(PG8_SB(1, 0), cB + kstep, voffB); PG8_STAGE(PG8_SA(1, 0), cA + kstep, voffA); PG8_STAGE(PG8_SB(1, 1), cB + hstep + kstep, voffB);
        PG8_WAIT_V(6); PG8_BAR;
    }
    for (;;) {
        const bool has_next = S.next(ui + 1, nxt);
        const char* nA = has_next ? (const char*)g.A + (size_t)nxt.pa * tstep + (size_t)nxt.ko * 2 : cA; const char* nB = has_next ? (const char*)g.Bt + (size_t)nxt.pb * tstep + (size_t)nxt.ko * 2 : cB;
        for (int t = 0; t < nt; t += 2) {
            const bool last = (t == nt - 2);
            const char* a1 = cA + (size_t)(t + 1) * kstep;
            const char* a2 = last ? nA : cA + (size_t)(t + 2) * kstep; const char* b2 = last ? nB : cB + (size_t)(t + 2) * kstep;
            const char* a3 = a2 + kstep; const char* b3 = b2 + kstep;
            if (last && has_next) S.a_ready(nxt);
            if constexpr (SP2) {
            PG8_LDB(B0, 0, 0); PG8_LDB(B1, 0, 1); PG8_SCHED; PG8_LDA(At, 0, 0); PG8_STAGE(PG8_SA(1, 1), a1 + hstep, voffA);
            PG8_WAIT_V(8); PG8_WAIT_L(0); PG8_BAR; PG8_MMA(0, 0, At, B0); PG8_MMA(0, 1, At, B1); PG8_BAR; PG8_SCHED;
            PG8_LDA(At, 0, 1); PG8_STAGE(PG8_SB(0, 0), b2, voffB); PG8_STAGE(PG8_SB(0, 1), b2 + hstep, voffB); PG8_STAGE(PG8_SA(0, 0), a2, voffA);
            PG8_WAIT_V(8); PG8_WAIT_L(0); PG8_BAR; PG8_MMA(1, 0, At, B0); PG8_MMA(1, 1, At, B1); PG8_BAR; PG8_SCHED;
            PG8_LDB(B0, 1, 0); PG8_LDB(B1, 1, 1); PG8_SCHED; PG8_LDA(At, 1, 0); PG8_STAGE(PG8_SA(0, 1), a2 + hstep, voffA);
            PG8_WAIT_V(8); PG8_WAIT_L(0); PG8_BAR; PG8_MMA(0, 0, At, B0); PG8_MMA(0, 1, At, B1); PG8_BAR; PG8_SCHED;
            PG8_LDA(At, 1, 1); PG8_STAGE(PG8_SB(1, 0), b3, voffB); PG8_STAGE(PG8_SB(1, 1), b3 + hstep, voffB); PG8_STAGE(PG8_SA(1, 0), a3, voffA);
            PG8_WAIT_V(8); PG8_WAIT_L(0); PG8_BAR; PG8_MMA(1, 0, At, B0); PG8_MMA(1, 1, At, B1); PG8_BAR; PG8_SCHED;
            } else {
            PG8_LDB(B0, 0, 0); PG8_SCHED; PG8_LDA(At, 0, 0); PG8_STAGE(PG8_SA(1, 1), a1 + hstep, voffA);
            PG8_WAIT_L(8); PG8_BAR; PG8_WAIT_L(0); PG8_MMA(0, 0, At, B0); PG8_BAR; PG8_SCHED;
            PG8_LDB(B1, 0, 1); PG8_STAGE(PG8_SB(0, 0), b2, voffB);
            PG8_BAR; PG8_WAIT_L(0); PG8_MMA(0, 1, At, B1); PG8_BAR;
            PG8_LDA(At, 0, 1); PG8_STAGE(PG8_SA(0, 0), a2, voffA);
            PG8_BAR; PG8_WAIT_L(0); PG8_MMA(1, 0, At, B0); PG8_BAR; PG8_SCHED;
            PG8_STAGE(PG8_SB(0, 1), b2 + hstep, voffB);
            PG8_WAIT_V(6); PG8_BAR; PG8_MMA(1, 1, At, B1); PG8_BAR;
            PG8_LDB(B0, 1, 0); PG8_SCHED; PG8_LDA(At, 1, 0); PG8_STAGE(PG8_SA(0, 1), a2 + hstep, voffA);
            PG8_WAIT_L(8); PG8_BAR; PG8_WAIT_L(0); PG8_MMA(0, 0, At, B0); PG8_BAR; PG8_SCHED;
            PG8_LDB(B1, 1, 1); PG8_STAGE(PG8_SB(1, 0), b3, voffB);
            PG8_BAR; PG8_WAIT_L(0); PG8_MMA(0, 1, At, B1); PG8_BAR;
            PG8_LDA(At, 1, 1); PG8_STAGE(PG8_SA(1, 0), a3, voffA);
            PG8_BAR; PG8_WAIT_L(0); PG8_MMA(1, 0, At, B0); PG8_BAR; PG8_SCHED;
            PG8_STAGE(PG8_SB(1, 1), b3 + hstep, voffB);
            PG8_WAIT_V(6); PG8_BAR; PG8_MMA(1, 1, At, B1); PG8_BAR;
            }
        }
        if constexpr (F8) asm volatile("s_nop 15\n\ts_nop 15\n\ts_nop 15" ::: "memory");
        if constexpr (ALIGN_EPI) { if (wr == 0) PG8_BAR; }
        if constexpr (!Epi::AFTER_DRAIN) { E(acc, cur, wr, wc, fr, fq); S.done(cur); }
        if (!has_next) break;
#pragma unroll
        for (int a = 0; a < 2; ++a)
#pragma unroll
            for (int b = 0; b < 2; ++b)
#pragma unroll
                for (int m = 0; m < 4; ++m)
#pragma unroll
                    for (int n = 0; n < 2; ++n) acc[a][b][m][n] = (f32x4){0.f, 0.f, 0.f, 0.f};
        cur = nxt; cA = nA; cB = nB; ++ui;
        if constexpr (ALIGN_EPI) { if (wr == 1) PG8_BAR; }
    }
    PG8_WAIT_V(0);
    if constexpr (!ALIGN_EPI) { if (wr == 0) PG8_BAR; }
    PG8_BAR;
    if constexpr (Epi::AFTER_DRAIN) { E.fused(acc, cur, wr, wc, fr, fq, lds, wid, lane); S.done(cur); }
#undef PG8_SA
#undef PG8_SB
#undef PG8_STAGE
#undef PG8_CAT
#undef PG8_LDA
#undef PG8_LDB
#undef PG8_MMA
#undef PG8_WAIT_V
#undef PG8_WAIT_L
#undef PG8_BAR
#undef PG8_SCHED
}
}

constexpr int NWAVES = 8, NTHR = 512;
constexpr int D = 2048, SEQ = 4096, NLAT = 8192, CTXL = 256, NCTX = 512, MROWS = 8704, DEPTH = 2;
constexpr int INC = 15392, NU = 15360;
constexpr int U_CB = 0, U_CC = 1024, U_CX = 2048, U_GQ = 3072, U_GK = 3584, U_GV = 4096, U_GR = 5120, U_NQ = 6144, U_NK = 7168, U_NV = 8192, U_GATE = 9216;
constexpr int LR_COL = 6144;
constexpr int FF = 5632, NGU = 2 * FF, NE = 8;
constexpr float LN_EPS = 1e-5f, ALPHA = 1.41421356237f;
constexpr float FSC_WGU = 64.0f, FSC_WD = 128.0f, FSC_HID = 4.0f;
constexpr int MOE_MAXP = 72;

constexpr size_t MiB = 1u << 20;
constexpr size_t WS_CTL = 0, CTL_ZERO_BYTES = 1 * MiB;
constexpr size_t WS_MOD = 1 * MiB;
constexpr size_t WS_WLR = 1 * MiB + 512 * 1024;
constexpr size_t WS_ROUTE = 2 * MiB;
constexpr size_t WS_TOK = 2 * MiB + 256 * 1024;
constexpr size_t WS_LR = 3 * MiB;
constexpr size_t WS_W = 8 * MiB;
constexpr size_t W_IN_B = (size_t)NU * D * 2, W_BR_B = (size_t)1024 * D * 2, W_OUT_B = (size_t)D * D * 2, W_LAYER_B = W_IN_B + 3 * W_BR_B + W_OUT_B;
constexpr size_t W_GU_B = (size_t)NGU * D * 2, W_D_B = (size_t)D * FF * 2, W_FFN_B = W_GU_B + W_D_B;
constexpr size_t WS_WFFN = WS_W + 2 * W_LAYER_B, WS_WMOE = WS_WFFN + W_FFN_B, WS_WEND = WS_WMOE + 8 * W_FFN_B;
constexpr size_t WS_XL = 762 * MiB;
constexpr size_t WS_H = 830 * MiB;
constexpr size_t WS_U = 864 * MiB;
constexpr size_t WS_Y = 1119 * MiB;
constexpr size_t WS_GLA = 1170 * MiB;
constexpr size_t WS_Z = 1306 * MiB;
constexpr size_t WS_ZB = 1374 * MiB;
constexpr size_t WS_PRE = 1408 * MiB;
constexpr size_t WS_PART = 1476 * MiB;
constexpr size_t WS_END = 1520 * MiB;
static_assert(WS_WEND <= WS_XL && WS_XL + (size_t)MROWS * D * 4 <= WS_H && WS_H + (size_t)MROWS * D * 2 <= WS_U && WS_U + (size_t)MROWS * NU * 2 <= WS_Y, "ws map 1");
static_assert(WS_U + (size_t)MOE_MAXP * 256 * FF * 2 <= WS_Y && WS_Y + 3 * (size_t)MROWS * 1024 * 2 <= WS_GLA && WS_GLA + (size_t)MROWS * (4 * 512 + 2 * 1024) * 4 <= WS_Z, "ws map 2");
static_assert(WS_GLA + (size_t)MOE_MAXP * 256 * D * 2 <= WS_Z && WS_Z + (size_t)MOE_MAXP * 256 * D * 4 <= WS_END && WS_PRE + (size_t)MROWS * D * 4 <= WS_END, "ws map 3");
constexpr int CW_TMO = 0, CW_CODE = 1;
constexpr int CW_MOECNT = 64;
constexpr int CW_BAR = 4096;

constexpr int RING_OFF = 0, RING_BYTES = 131072;
constexpr int LDSCTL_OFF = RING_BYTES, MISC_OFF = LDSCTL_OFF + 320;
constexpr int LDS_BYTES = 147456;

#define GAS __attribute__((address_space(1)))
#define LAS __attribute__((address_space(3)))
typedef unsigned short bf16;
typedef unsigned v4u __attribute__((ext_vector_type(4)));
typedef unsigned v2u __attribute__((ext_vector_type(2)));
typedef float f32x4 __attribute__((ext_vector_type(4)));
typedef GAS unsigned gu32;
typedef short bf16x8v __attribute__((ext_vector_type(8)));
#define RLX_AGENT __ATOMIC_RELAXED, __HIP_MEMORY_SCOPE_AGENT
#define LDS_WAIT() asm volatile("s_waitcnt lgkmcnt(0)" ::: "memory")
#define VM_WAIT() asm volatile("s_waitcnt vmcnt(0)" ::: "memory")
__device__ __forceinline__ unsigned f2bf(float f) { unsigned u = __builtin_bit_cast(unsigned, f); return (u + 0x7fffu + ((u >> 16) & 1u)) >> 16; }
__device__ __forceinline__ unsigned pk2(float lo, float hi) { return f2bf(lo) | (f2bf(hi) << 16); }
__device__ __forceinline__ float bflo(unsigned w) { return __uint_as_float(w << 16); }
__device__ __forceinline__ float bfhi(unsigned w) { return __uint_as_float(w & 0xffff0000u); }
__device__ __forceinline__ float bf1(bf16 b) { return __uint_as_float(((unsigned)b) << 16); }
__device__ __forceinline__ float wave_sum(float v) {
#pragma unroll
    for (int o = 1; o < 64; o <<= 1) v += __shfl_xor(v, o);
    return v;
}
__device__ __forceinline__ float wave_max(float v) {
#pragma unroll
    for (int o = 1; o < 64; o <<= 1) v = fmaxf(v, __shfl_xor(v, o));
    return v;
}

#define XB_TMO      128
#define XB_XCNT(j)  (256  + 64 * (j))
#define XB_XSUB(j)  (1280 + 64 * (j))
#define XB_XGEN(j)  (2304 + 64 * (j))
#define XB_TOP      3328
#define XB_TOPGEN   3392
#define XCD_BAR_WORDS 3456
#define XB_SPIN_CAP (1u << 18)

__device__ __forceinline__ unsigned xb_ld(unsigned* p)              { return __hip_atomic_load(p, __ATOMIC_RELAXED, __HIP_MEMORY_SCOPE_AGENT); }
__device__ __forceinline__ unsigned xb_add(unsigned* p, unsigned v) { return __hip_atomic_fetch_add(p, v, __ATOMIC_RELAXED, __HIP_MEMORY_SCOPE_AGENT); }
__device__ __forceinline__ unsigned xb_xcc_id() { return (unsigned)__builtin_amdgcn_s_getreg((3 << 11) | 20) & 0xFu; }
#define XB_SPIN(cond, bar) do { unsigned _sp = 0; while (cond) { __builtin_amdgcn_s_sleep(1); \
    if ((++_sp & 255u) == 0u) { if (xb_ld(&(bar)[XB_TMO])) break; if (_sp > XB_SPIN_CAP) { atomicAdd(&(bar)[XB_TMO], 1u); break; } } } } while (0)

struct XcdBarrier {
    unsigned* bar; unsigned x; unsigned grid;
    volatile LAS unsigned* st;
};

__device__ __forceinline__ XcdBarrier xcd_barrier_post(unsigned* bar, volatile LAS unsigned* st, unsigned grid) {
    XcdBarrier b; b.grid = grid; b.bar = bar; b.x = xb_xcc_id(); b.st = st;
    if (threadIdx.x == 0) (void)xb_add(&bar[XB_XCNT(b.x)], 1u);
    return b;
}
__device__ __forceinline__ void xcd_barrier_complete(unsigned* bar, unsigned x, unsigned& nloc, unsigned& nx, unsigned b_grid) {
    const unsigned G = b_grid;
    unsigned sum, cnt, mine, sp = 0u;
    for (;;) {
        sum = 0u; cnt = 0u; mine = 0u;
#pragma unroll
        for (unsigned j = 0; j < 16; ++j) { const unsigned c = xb_ld(&bar[XB_XCNT(j)]); sum += c; cnt += (c > 0u) ? 1u : 0u; mine = (j == x) ? c : mine; }
        if (sum == G) break;
        __builtin_amdgcn_s_sleep(1);
        if ((++sp & 255u) == 0u) { if (xb_ld(&bar[XB_TMO])) break; if (sp > XB_SPIN_CAP) { atomicAdd(&bar[XB_TMO], 1u); break; } }
    }
    nloc = mine > 0u ? mine : 1u; nx = cnt > 0u ? cnt : 1u;
}

__device__ __forceinline__ void xcd_barrier(const XcdBarrier& b) {
    asm volatile("s_waitcnt vmcnt(0)" ::: "memory");
    __syncthreads();
    if (threadIdx.x == 0) {
        unsigned* bar = b.bar;
        __builtin_amdgcn_s_waitcnt(0);
        unsigned nloc = b.st[0], nx = b.st[1];
        if (nloc == 0u) { xcd_barrier_complete(bar, b.x, nloc, nx, b.grid); b.st[0] = nloc; b.st[1] = nx; }
        const unsigned old = xb_add(&bar[XB_XSUB(b.x)], 1u);
        const unsigned gen = old / nloc;
        if (old + 1u == (gen + 1u) * nloc) {
            __builtin_amdgcn_fence(__ATOMIC_RELEASE, "agent");
            asm volatile("s_waitcnt vmcnt(0)" ::: "memory");
            const unsigned og = xb_add(&bar[XB_TOP], 1u);
            const unsigned tg = og / nx;
            if (og + 1u == (tg + 1u) * nx) xb_add(&bar[XB_TOPGEN], 1u);
            else XB_SPIN(xb_ld(&bar[XB_TOPGEN]) == tg, bar);
            __builtin_amdgcn_fence(__ATOMIC_ACQUIRE, "agent");
            xb_add(&bar[XB_XGEN(b.x)], 1u);
            asm volatile("s_waitcnt vmcnt(0)" ::: "memory");
        } else {
            XB_SPIN(xb_ld(&bar[XB_XGEN(b.x)]) == gen, bar);
            __builtin_amdgcn_fence(__ATOMIC_ACQUIRE, "agent");
            asm volatile("s_waitcnt vmcnt(0)" ::: "memory");
        }
    }
    __syncthreads();
}

struct Args { const float* in[30]; float* out; unsigned char* ws; int ph_lo, ph_hi, grid, pad; };
struct Frame {
    LAS unsigned char* lds;
    volatile LAS unsigned* MISC;
    int tid, lane, wave, vcu, G, bx;
};
__device__ __forceinline__ Frame mkframe(LAS unsigned char* lds, int grid) {
    Frame F; int t = threadIdx.x; asm volatile("" : "+v"(t)); int g = grid, bx = blockIdx.x; asm volatile("" : "+s"(g), "+s"(bx));
    F.lds = lds; F.MISC = (volatile LAS unsigned*)(lds + MISC_OFF); F.tid = t; F.lane = t & 63; F.wave = __builtin_amdgcn_readfirstlane(t >> 6); F.G = g; F.bx = bx;
    F.vcu = (g % 8 == 0) ? (bx % 8) * (g / 8) + bx / 8 : bx; return F;
}
constexpr int PTAB_OFF = LDSCTL_OFF + 1024, PT_OUT = 30, PT_WS = 31;
__device__ __forceinline__ unsigned long long ldp_raw(Frame& F, int i) {
    const volatile LAS unsigned* t = (const volatile LAS unsigned*)(F.lds + PTAB_OFF) + 2 * i; const unsigned lo = t[0], hi = t[1];
    return ((unsigned long long)(unsigned)__builtin_amdgcn_readfirstlane((int)hi) << 32) | (unsigned)__builtin_amdgcn_readfirstlane((int)lo);
}
#define PIN(i) ((const float*)(const GAS float*)ldp_raw(F, (i)))
#define POUT() ((float*)(GAS float*)ldp_raw(F, PT_OUT))
#define PWS() ((unsigned char*)(GAS unsigned char*)ldp_raw(F, PT_WS))
__device__ __forceinline__ bf16* w_in_t(unsigned char* ws, int L) { return (bf16*)(ws + WS_W + (size_t)L * W_LAYER_B); }
__device__ __forceinline__ bf16* w_br_t(unsigned char* ws, int L, int b) { return (bf16*)(ws + WS_W + (size_t)L * W_LAYER_B + W_IN_B + (size_t)b * W_BR_B); }
__device__ __forceinline__ bf16* w_out_t(unsigned char* ws, int L) { return (bf16*)(ws + WS_W + (size_t)L * W_LAYER_B + W_IN_B + 3 * W_BR_B); }
__device__ __forceinline__ unsigned char* w_gu_t(unsigned char* ws, int e) { return ws + (e < 0 ? WS_WFFN : WS_WMOE + (size_t)e * (W_GU_B / 2)); }
__device__ __forceinline__ unsigned char* w_d_t(unsigned char* ws, int e) { return ws + (e < 0 ? WS_WFFN + W_GU_B : WS_WMOE + 8 * W_GU_B + (size_t)e * (W_D_B / 2)); }

template <int MODE> __device__ __forceinline__ int conv_drow(int nb) {
    if (MODE == 0) return 32 * nb;
    if (MODE == 1) return nb < LR_COL / 32 ? 32 * nb : 32 * (nb - 1);
    if (MODE == 2) return 256 * (nb >> 2) + 32 * (nb & 3);
    return 256 * (nb >> 2) + 128 + 32 * (nb & 3);
}
__device__ __forceinline__ void conv_load(const float* W, int N, int nblk, int it, int lane, f32x4 (&w)[8]) {
    const int kb = it / nblk, nb = it % nblk; const float* p = W + (size_t)(64 * kb + (lane >> 3)) * N + 32 * nb + (lane & 7) * 4;
#pragma unroll
    for (int i = 0; i < 8; ++i) w[i] = *(const GAS f32x4*)(p + (size_t)(8 * i) * N);
}
template <int MODE, bool F8> __device__ __forceinline__ void conv_matrix_t(Frame& F, const float* W, int K, int N, void* WT, float sc) {
    LAS float* scr = (LAS float*)(F.lds + RING_OFF + F.wave * 16384);
    const int gw = F.vcu * NWAVES + F.wave, NGW = F.G * NWAVES, lane = F.lane;
    const int nblk = N / 32, nitems = (K / 64) * nblk;
    f32x4 w[8];
    if (gw < nitems) conv_load(W, N, nblk, gw, lane, w);
    for (int it = gw; it < nitems; it += NGW) {
        f32x4 wn[8]; const int itn = it + NGW;
        if (itn < nitems) conv_load(W, N, nblk, itn, lane, wn);
        const int kb = it / nblk, nb = it % nblk, k0 = 64 * kb;
        if (!(MODE == 1 && nb == LR_COL / 32)) {
            const int drow = conv_drow<MODE>(nb);
#pragma unroll
            for (int i = 0; i < 8; ++i) { LAS float* s = scr + (8 * i + (lane >> 3)) * 33 + (lane & 7) * 4; s[0] = w[i][0]; s[1] = w[i][1]; s[2] = w[i][2]; s[3] = w[i][3]; }
            LDS_WAIT(); asm volatile("" ::: "memory");
            const int c = lane & 7;
#pragma unroll
            for (int j = 0; j < 4; ++j) { const int n = (lane >> 3) + 8 * j; const LAS float* s = scr + (8 * c) * 33 + n;
                if (F8) { v2u o; o.x = pg8::pk_fp8x4(s[0 * 33] * sc, s[1 * 33] * sc, s[2 * 33] * sc, s[3 * 33] * sc); o.y = pg8::pk_fp8x4(s[4 * 33] * sc, s[5 * 33] * sc, s[6 * 33] * sc, s[7 * 33] * sc);
                    *(GAS v2u*)((unsigned char*)WT + (size_t)(drow + n) * K + k0 + 8 * c) = o; }
                else { v4u o; o.x = pk2(s[0 * 33], s[1 * 33]); o.y = pk2(s[2 * 33], s[3 * 33]); o.z = pk2(s[4 * 33], s[5 * 33]); o.w = pk2(s[6 * 33], s[7 * 33]);
                    *(GAS v4u*)((bf16*)WT + (size_t)(drow + n) * K + k0 + 8 * c) = o; } }
            LDS_WAIT(); asm volatile("" ::: "memory");
        }
#pragma unroll
        for (int i = 0; i < 8; ++i) w[i] = wn[i];
    }
}
template <int MODE> __device__ __forceinline__ void conv_matrix8(Frame& F, const float* W, int K, int N, unsigned char* WT, float sc) { conv_matrix_t<MODE, true>(F, W, K, N, WT, sc); }
template <int MODE> __device__ __forceinline__ void conv_matrix(Frame& F, const float* W, int K, int N, bf16* WT) { conv_matrix_t<MODE, false>(F, W, K, N, WT, 1.0f); }
__device__ __forceinline__ void ada_item(Frame& F, unsigned char* ws, const float* cnd, const float* cctx, const float* ada_w, const float* ada_b, int item) {
    const int L = item / 96, c0 = (item % 96) * 128;
    LAS float* sc = (LAS float*)(F.lds + RING_OFF);
    LAS float* red = (LAS float*)(F.lds + RING_OFF + 24576);
    for (int i = F.tid; i < 3 * D; i += NTHR) { const int g = i / D, k = i % D; const float v = g < 2 ? cnd[g * D + k] : cctx[k]; sc[i] = v / (1.0f + __expf(-v)); }
    __syncthreads();
    const float* W = ada_w + (size_t)L * D * 12288 + c0 + 2 * F.lane;
    float a00 = 0.f, a01 = 0.f, a10 = 0.f, a11 = 0.f, a20 = 0.f, a21 = 0.f;
    const int kb = 256 * F.wave;
#pragma unroll 8
    for (int k = kb; k < kb + 256; ++k) { const float2 w = *(const float2*)(W + (size_t)k * 12288); const float s0 = sc[k], s1 = sc[D + k], s2 = sc[2 * D + k];
        a00 += s0 * w.x; a01 += s0 * w.y; a10 += s1 * w.x; a11 += s1 * w.y; a20 += s2 * w.x; a21 += s2 * w.y; }
    red[(F.wave * 3 + 0) * 128 + 2 * F.lane] = a00; red[(F.wave * 3 + 0) * 128 + 2 * F.lane + 1] = a01;
    red[(F.wave * 3 + 1) * 128 + 2 * F.lane] = a10; red[(F.wave * 3 + 1) * 128 + 2 * F.lane + 1] = a11;
    red[(F.wave * 3 + 2) * 128 + 2 * F.lane] = a20; red[(F.wave * 3 + 2) * 128 + 2 * F.lane + 1] = a21;
    __syncthreads();
    if (F.tid < 384) { const int g = F.tid / 128, cc = F.tid % 128; float s = 0.f;
#pragma unroll
        for (int w = 0; w < 8; ++w) s += red[(w * 3 + g) * 128 + cc];
        ((float*)(ws + WS_MOD))[((size_t)L * 3 + g) * 12288 + c0 + cc] = s + ada_b[L * 12288 + c0 + cc]; }
    __syncthreads();
}
__device__ __forceinline__ void p0a_prologue(Frame& F) {
    unsigned char* const ws = PWS();
    { const float* cnd = PIN(1); const float* cctx = PIN(3); const float* ada_w = PIN(4); const float* ada_b = PIN(5);
      for (int it = F.bx; it < 192; it += F.G) ada_item(F, ws, cnd, cctx, ada_w, ada_b, it); }
    const float* const w_in = PIN(6);
    { const int gt = F.bx * NTHR + F.tid, NGT = F.G * NTHR;
      for (int i = gt; i < DEPTH * D * 32; i += NGT) { const int o = i & 31, k = (i >> 5) % D, L = i / (32 * D); ((bf16*)(ws + WS_WLR))[((size_t)L * 32 + o) * D + k] = (bf16)f2bf(w_in[((size_t)L * D + k) * INC + LR_COL + o]); } }
    for (int L = 0; L < DEPTH; ++L) {
        if (L == 0) conv_matrix<1>(F, w_in + (size_t)L * D * INC, D, INC, w_in_t(ws, L)); else conv_matrix_t<1, true>(F, w_in + (size_t)L * D * INC, D, INC, w_in_t(ws, L), FSC_WGU);
        for (int b = 0; b < 3; ++b) conv_matrix<0>(F, (b == 0 ? PIN(14) : (b == 1 ? PIN(15) : PIN(16))) + (size_t)L * 1024 * D, 1024, D, w_br_t(ws, L, b));
        conv_matrix<0>(F, PIN(18) + (size_t)L * D * D, D, D, w_out_t(ws, L));
    }
    conv_matrix<2>(F, PIN(23), D, FF, (bf16*)w_gu_t(ws, -1)); conv_matrix<3>(F, PIN(24), D, FF, (bf16*)w_gu_t(ws, -1)); conv_matrix<0>(F, PIN(25), FF, D, (bf16*)w_d_t(ws, -1));
    for (int e = 0; e < NE; ++e) {
        conv_matrix8<2>(F, PIN(27) + (size_t)e * D * FF, D, FF, w_gu_t(ws, e), FSC_WGU); conv_matrix8<3>(F, PIN(28) + (size_t)e * D * FF, D, FF, w_gu_t(ws, e), FSC_WGU);
        conv_matrix8<0>(F, PIN(29) + (size_t)e * FF * D, FF, D, w_d_t(ws, e), FSC_WD);
    }
}

__device__ __forceinline__ int row_group(int r) { return r < SEQ ? 0 : (r < NLAT ? 1 : 2); }
__device__ __forceinline__ void load_row(const float* p, int lane, f32x4 (&v)[8]) {
#pragma unroll
    for (int j = 0; j < 8; ++j) v[j] = *(const GAS f32x4*)(p + 4 * lane + 256 * j);
}
__device__ __forceinline__ void load_row_bf16(const bf16* p, int lane, f32x4 (&v)[8]) {
#pragma unroll
    for (int j = 0; j < 8; ++j) { const v2u w = *(const GAS v2u*)(p + 4 * lane + 256 * j); v[j] = (f32x4){bflo(w.x), bfhi(w.x), bflo(w.y), bfhi(w.y)}; }
}
__device__ __forceinline__ void store_row(float* p, int lane, const f32x4 (&v)[8]) {
#pragma unroll
    for (int j = 0; j < 8; ++j) *(GAS f32x4*)(p + 4 * lane + 256 * j) = v[j];
}
__device__ __forceinline__ void store_row_bf16(bf16* p, int lane, const f32x4 (&v)[8]) {
#pragma unroll
    for (int j = 0; j < 8; ++j) { v2u w; w.x = pk2(v[j][0], v[j][1]); w.y = pk2(v[j][2], v[j][3]); *(GAS v2u*)(p + 4 * lane + 256 * j) = w; }
}
__device__ __forceinline__ void store_row_fp8(unsigned char* p, int lane, const f32x4 (&v)[8]) {
#pragma unroll
    for (int j = 0; j < 8; ++j) *(GAS unsigned*)(p + 4 * lane + 256 * j) = pg8::pk_fp8x4(pg8::clamp448(v[j][0]), pg8::clamp448(v[j][1]), pg8::clamp448(v[j][2]), pg8::clamp448(v[j][3]));
}
__device__ __forceinline__ void modulate(f32x4 (&v)[8], const float* shift, const float* scale, int lane) {
#pragma unroll
    for (int j = 0; j < 8; ++j) { const f32x4 sh = *(const f32x4*)(shift + 4 * lane + 256 * j), sc = *(const f32x4*)(scale + 4 * lane + 256 * j); v[j] = v[j] * (sc + 1.0f) + sh; }
}
__device__ __forceinline__ void layer_norm_row(f32x4 (&v)[8], const float* g, const float* b, int lane) {
    float s = 0.f;
#pragma unroll
    for (int j = 0; j < 8; ++j) s += (v[j][0] + v[j][1]) + (v[j][2] + v[j][3]);
    const float mean = wave_sum(s) * (1.0f / D); float q = 0.f;
#pragma unroll
    for (int j = 0; j < 8; ++j) { v[j] = v[j] - mean; q += (v[j][0] * v[j][0] + v[j][1] * v[j][1]) + (v[j][2] * v[j][2] + v[j][3] * v[j][3]); }
    const float rstd = 1.0f / sqrtf(wave_sum(q) * (1.0f / D) + LN_EPS);
#pragma unroll
    for (int j = 0; j < 8; ++j) { const f32x4 g4 = *(const f32x4*)(g + 4 * lane + 256 * j), b4 = *(const f32x4*)(b + 4 * lane + 256 * j); v[j] = v[j] * rstd * g4 + b4; }
}
__device__ __forceinline__ void lr_tiles(Frame& F, int L) {
    unsigned char* const ws = PWS(); const bf16* H = (const bf16*)(ws + WS_H); const bf16* W = (const bf16*)(ws + WS_WLR) + (size_t)L * 32 * D; float* LRo = (float*)(ws + WS_LR);
    const int g = F.lane >> 4, l15 = F.lane & 15, gw = F.vcu * NWAVES + F.wave, NGW = F.G * NWAVES;
    for (int task = gw; task < MROWS / 16; task += NGW) {
        const bf16* ap = H + (size_t)(16 * task + l15) * D + 8 * g; const bf16* bp = W + (size_t)l15 * D + 8 * g;
        f32x4 a0 = {0.f, 0.f, 0.f, 0.f}, a1 = {0.f, 0.f, 0.f, 0.f};
#pragma unroll 8
        for (int ks = 0; ks < D / 32; ++ks) { const bf16x8v af = __builtin_bit_cast(bf16x8v, *(const GAS v4u*)(ap + 32 * ks)), b0 = __builtin_bit_cast(bf16x8v, *(const GAS v4u*)(bp + 32 * ks)), b1 = __builtin_bit_cast(bf16x8v, *(const GAS v4u*)(bp + (size_t)16 * D + 32 * ks));
            a0 = __builtin_amdgcn_mfma_f32_16x16x32_bf16(af, b0, a0, 0, 0, 0); a1 = __builtin_amdgcn_mfma_f32_16x16x32_bf16(af, b1, a1, 0, 0, 0); }
#pragma unroll
        for (int i = 0; i < 4; ++i) { float* o = LRo + (size_t)(16 * task + 4 * g + i) * 32 + l15; o[0] = a0[i]; o[16] = a1[i]; }
    }
}
__device__ __forceinline__ void p0b_modulate(Frame& F) {
    unsigned char* const ws = PWS(); const float* const xin = PIN(0); const float* const cin = PIN(2);
    const int gw = F.vcu * NWAVES + F.wave, NGW = F.G * NWAVES;
    for (int r = gw; r < MROWS; r += NGW) {
        f32x4 v[8]; load_row(r < NLAT ? xin + (size_t)r * D : cin + (size_t)(r - NLAT) * D, F.lane, v);
        const float* m = ((float*)(ws + WS_MOD)) + (size_t)row_group(r) * 12288;
        modulate(v, m, m + D, F.lane); store_row_bf16(((bf16*)(ws + WS_H)) + (size_t)r * D, F.lane, v);
    }
}

__device__ __forceinline__ void mix_prep(Frame& F, int L) {
    unsigned char* const ws = PWS();
    const int gt = F.bx * NTHR + F.tid, NGT = F.G * NTHR;
    const float* cw = PIN(7) + (size_t)L * 3 * 1024;
    for (int i = gt; i < MROWS * 128; i += NGT) {
        const int r = i >> 7, c8 = (i & 127) * 8;
        const int t = r < NLAT ? (r & (SEQ - 1)) : ((r - NLAT) & (CTXL - 1)), T = r < NLAT ? SEQ : CTXL;
        float acc[8];
#pragma unroll
        for (int j = 0; j < 8; ++j) acc[j] = 0.f;
#pragma unroll
        for (int k = 0; k < 3; ++k) { const int tt = t + k - 1; if (tt < 0 || tt >= T) continue;
            const bf16* up = ((bf16*)(ws + WS_U)) + (size_t)(r + k - 1) * NU; const v4u a = *(const GAS v4u*)(up + U_CC + c8), b = *(const GAS v4u*)(up + U_CX + c8);
            const f32x4 w0 = *(const f32x4*)(cw + k * 1024 + c8), w1 = *(const f32x4*)(cw + k * 1024 + c8 + 4);
            acc[0] += w0[0] * bflo(a.x) * bflo(b.x); acc[1] += w0[1] * bfhi(a.x) * bfhi(b.x); acc[2] += w0[2] * bflo(a.y) * bflo(b.y); acc[3] += w0[3] * bfhi(a.y) * bfhi(b.y);
            acc[4] += w1[0] * bflo(a.z) * bflo(b.z); acc[5] += w1[1] * bfhi(a.z) * bfhi(b.z); acc[6] += w1[2] * bflo(a.w) * bflo(b.w); acc[7] += w1[3] * bfhi(a.w) * bfhi(b.w); }
        const v4u ab = *(const GAS v4u*)(((bf16*)(ws + WS_U)) + (size_t)r * NU + U_CB + c8);
        v4u o; o.x = pk2(acc[0] * bflo(ab.x), acc[1] * bfhi(ab.x)); o.y = pk2(acc[2] * bflo(ab.y), acc[3] * bfhi(ab.y)); o.z = pk2(acc[4] * bflo(ab.z), acc[5] * bfhi(ab.z)); o.w = pk2(acc[6] * bflo(ab.w), acc[7] * bfhi(ab.w));
        *(GAS v4u*)(((bf16*)(ws + WS_Y)) + (size_t)r * 1024 + c8) = o;
    }
}
__device__ __forceinline__ void sum_partials(f32x4 (&v)[8], const float* P, int ns, const float* res, const float* gvec, int lane) {
#pragma unroll
    for (int j = 0; j < 8; ++j) v[j] = (f32x4){0.f, 0.f, 0.f, 0.f};
    for (int s = 0; s < ns; ++s) {
#pragma unroll
        for (int j = 0; j < 8; ++j) v[j] += *(const GAS f32x4*)(P + (size_t)s * 512 * D + 4 * lane + 256 * j); }
#pragma unroll
    for (int j = 0; j < 8; ++j) { const f32x4 r4 = *(const GAS f32x4*)(res + 4 * lane + 256 * j), g4 = *(const f32x4*)(gvec + 4 * lane + 256 * j); v[j] = r4 * ALPHA + g4 * v[j]; }
}
__device__ __forceinline__ void ln1_phase(Frame& F, int L, int M) {
    unsigned char* const ws = PWS(); const float* const lng = PIN(19) + L * D; const float* const lnb = PIN(20) + L * D; const float* const router = PIN(26); const float* const cin = PIN(2);
    const int gw = F.vcu * NWAVES + F.wave, NGW = F.G * NWAVES;
    for (int r = gw; r < M; r += NGW) {
        const float* m = ((float*)(ws + WS_MOD)) + ((size_t)L * 3 + row_group(r)) * 12288;
        f32x4 v[8];
        if (r < NLAT) load_row(((float*)(ws + WS_PRE)) + (size_t)r * D, F.lane, v);
        else sum_partials(v, ((float*)(ws + WS_PART)) + (size_t)(r - NLAT) * D, 8, cin + (size_t)(r - NLAT) * D, m + 2 * D, F.lane);
        layer_norm_row(v, lng, lnb, F.lane);
        store_row(((float*)(ws + WS_XL)) + (size_t)r * D, F.lane, v);
        modulate(v, m + 3 * D, m + 4 * D, F.lane);
        if (L == 0) store_row_bf16(((bf16*)(ws + WS_H)) + (size_t)r * D, F.lane, v);
        if (L == 1) {
            float lg[8];
#pragma unroll
            for (int e = 0; e < 8; ++e) lg[e] = 0.f;
#pragma unroll
            for (int j = 0; j < 8; ++j)
#pragma unroll
                for (int i = 0; i < 4; ++i) { const float* rp = router + (size_t)(4 * F.lane + 256 * j + i) * 8; const f32x4 w0 = *(const f32x4*)rp, w1 = *(const f32x4*)(rp + 4); const float hv = v[j][i];
                    lg[0] += hv * w0[0]; lg[1] += hv * w0[1]; lg[2] += hv * w0[2]; lg[3] += hv * w0[3]; lg[4] += hv * w1[0]; lg[5] += hv * w1[1]; lg[6] += hv * w1[2]; lg[7] += hv * w1[3]; }
#pragma unroll
            for (int e = 0; e < 8; ++e) lg[e] = wave_sum(lg[e]);
            int e0 = 0; float v0 = lg[0];
#pragma unroll
            for (int e = 1; e < 8; ++e) if (lg[e] > v0) { v0 = lg[e]; e0 = e; }
            int e1 = -1; float v1 = -INFINITY;
#pragma unroll
            for (int e = 0; e < 8; ++e) if (e != e0 && lg[e] > v1) { v1 = lg[e]; e1 = e; }
            unsigned p0 = 0u, p1 = 0u;
            if (F.lane == 0) {
                const float w0 = 1.0f / (1.0f + __expf(v1 - v0)), w1 = 1.0f - w0;
                p0 = __hip_atomic_fetch_add(((gu32*)(ws + WS_CTL)) + CW_MOECNT + 64 * e0, 1u, RLX_AGENT); p1 = __hip_atomic_fetch_add(((gu32*)(ws + WS_CTL)) + CW_MOECNT + 64 * e1, 1u, RLX_AGENT);
                unsigned* rt = ((unsigned*)(ws + WS_ROUTE)) + (size_t)r * 8; rt[0] = e0; rt[1] = p0; rt[2] = __float_as_uint(w0); rt[3] = e1; rt[4] = p1; rt[5] = __float_as_uint(w1);
            }
            p0 = (unsigned)__builtin_amdgcn_readfirstlane((int)p0); p1 = (unsigned)__builtin_amdgcn_readfirstlane((int)p1);
            store_row_fp8(ws + WS_GLA + ((size_t)e0 * NLAT + p0) * D, F.lane, v); store_row_fp8(ws + WS_GLA + ((size_t)e1 * NLAT + p1) * D, F.lane, v);
        }
    }
}
__device__ __forceinline__ void moe_prefix(unsigned char* ws, unsigned (&cnt)[8], int (&pp)[9]) {
    pp[0] = 0;
#pragma unroll
    for (int e = 0; e < 8; ++e) { cnt[e] = __hip_atomic_load(((gu32*)(ws + WS_CTL)) + CW_MOECNT + 64 * e, RLX_AGENT); pp[e + 1] = pp[e] + (int)((cnt[e] + 255u) >> 8); }
}
__device__ __forceinline__ void moe_gather(Frame& F) {
    unsigned char* const ws = PWS();
    const int gw = F.vcu * NWAVES + F.wave, NGW = F.G * NWAVES;
    unsigned cnt[8]; int pp[9]; moe_prefix(ws, cnt, pp);
    for (int s = gw; s < pp[8] * 256; s += NGW) {
        const int p = s >> 8; int e = 0, base = 0; unsigned ce = cnt[0];
#pragma unroll
        for (int k = 1; k < 8; ++k) if (p >= pp[k]) { e = k; base = pp[k]; ce = cnt[k]; }
        const unsigned pos = (unsigned)(s - base * 256);
        GAS v4u* dst = (GAS v4u*)(ws + WS_GLA + (size_t)s * D) + F.lane;
        if (pos < ce) { const int tkn = ((int*)(ws + WS_TOK))[e * NLAT + pos]; const GAS v4u* src = (const GAS v4u*)(ws + WS_H + (size_t)tkn * D) + F.lane;
#pragma unroll
            for (int j = 0; j < 2; ++j) dst[64 * j] = src[64 * j]; }
        else {
#pragma unroll
            for (int j = 0; j < 2; ++j) dst[64 * j] = (v4u){0u, 0u, 0u, 0u}; }
    }
}
__device__ __forceinline__ void ln2_dense(Frame& F, int L) {
    unsigned char* const ws = PWS(); const float* const lng = PIN(21) + L * D; const float* const lnb = PIN(22) + L * D;
    const int gw = F.vcu * NWAVES + F.wave, NGW = F.G * NWAVES;
    for (int r = gw; r < MROWS; r += NGW) {
        f32x4 v[8];
        if (r < NLAT) load_row(((float*)(ws + WS_PRE)) + (size_t)r * D, F.lane, v);
        else sum_partials(v, ((float*)(ws + WS_PART)) + (size_t)(r - NLAT) * D, 11, ((float*)(ws + WS_XL)) + (size_t)r * D, ((float*)(ws + WS_MOD)) + ((size_t)L * 3 + 2) * 12288 + 5 * D, F.lane);
        layer_norm_row(v, lng, lnb, F.lane);
        store_row(((float*)(ws + WS_XL)) + (size_t)r * D, F.lane, v);
        const float* m = ((float*)(ws + WS_MOD)) + ((size_t)(L + 1) * 3 + row_group(r)) * 12288;
        modulate(v, m, m + D, F.lane); store_row_bf16(((bf16*)(ws + WS_H)) + (size_t)r * D, F.lane, v); store_row_fp8(ws + WS_ZB + (size_t)r * D, F.lane, v);
    }
}
__device__ __forceinline__ void ln2_moe(Frame& F, int L) {
    unsigned char* const ws = PWS(); const float* const lng = PIN(21) + L * D; const float* const lnb = PIN(22) + L * D; float* const outp = POUT();
    const int gw = F.vcu * NWAVES + F.wave, NGW = F.G * NWAVES;
    unsigned cnt[8]; int pp[9]; moe_prefix(ws, cnt, pp);
    for (int r = gw; r < NLAT; r += NGW) {
        const unsigned* rt = ((unsigned*)(ws + WS_ROUTE)) + (size_t)r * 8; const int e0 = rt[0], e1 = rt[3]; const float w0 = __uint_as_float(rt[2]), w1 = __uint_as_float(rt[5]);
        int b0 = 0, b1 = 0;
#pragma unroll
        for (int k = 1; k < 8; ++k) { if (e0 >= k) b0 = pp[k]; if (e1 >= k) b1 = pp[k]; }
        const size_t s0 = (size_t)b0 * 256 + rt[1], s1 = (size_t)b1 * 256 + rt[4];
        f32x4 v[8], y0[8], y1[8]; load_row(((float*)(ws + WS_XL)) + (size_t)r * D, F.lane, v); load_row_bf16(((bf16*)(ws + WS_Z)) + s0 * D, F.lane, y0); load_row_bf16(((bf16*)(ws + WS_Z)) + s1 * D, F.lane, y1);
        const float* g2 = ((float*)(ws + WS_MOD)) + ((size_t)L * 3 + row_group(r)) * 12288 + 5 * D;
#pragma unroll
        for (int j = 0; j < 8; ++j) { const f32x4 g4 = *(const f32x4*)(g2 + 4 * F.lane + 256 * j); v[j] = v[j] * ALPHA + g4 * (y0[j] * w0 + y1[j] * w1); }
        layer_norm_row(v, lng, lnb, F.lane);
        store_row(outp + (size_t)r * D, F.lane, v);
    }
}

constexpr int GLA_NCH = 68;
constexpr size_t GLA_DST_BYTES = (size_t)16 * GLA_NCH * 256 * 128 * 2;
#define GLA_DST(ws) ((bf16*)((ws) + WS_GLA))
#define GLA_DEC(ws) ((float*)((ws) + WS_GLA + GLA_DST_BYTES))
#define GLA_BCG(ws) ((float*)((ws) + WS_GLA + GLA_DST_BYTES + (size_t)16 * GLA_NCH * 128 * 4))
__device__ __forceinline__ int gla_chunk_row0(int b, int cn) { return cn < 4 ? NLAT + CTXL * b + 64 * cn : SEQ * b + 64 * (cn - 4); }
__device__ __forceinline__ int gla_scan_idx(int cn, int dir) { return dir ? (cn < 4 ? 3 - cn : 71 - cn) : cn; }
__device__ __forceinline__ float log_sigmoid16(float z) { return (fminf(z, 0.f) - __logf(1.0f + __expf(-fabsf(z)))) * (1.0f / 16.0f); }
__device__ __forceinline__ bf16x8v tr_frag(unsigned addr, unsigned pitch4) {
    v2u lo, hi;
    asm volatile("ds_read_b64_tr_b16 %0, %2\n\tds_read_b64_tr_b16 %1, %3\n\ts_waitcnt lgkmcnt(0)" : "=&v"(lo), "=&v"(hi) : "v"(addr), "v"(addr + pitch4) : "memory");
    v4u r; r.x = lo.x; r.y = lo.y; r.z = hi.x; r.w = hi.y; return __builtin_bit_cast(bf16x8v, r);
}
struct TrHalf { v2u lo, hi; };
__device__ __forceinline__ void tr_issue(TrHalf& f, unsigned addr, unsigned pitch4) { asm volatile("ds_read_b64_tr_b16 %0, %2\n\tds_read_b64_tr_b16 %1, %3" : "=&v"(f.lo), "=&v"(f.hi) : "v"(addr), "v"(addr + pitch4) : "memory"); }
__device__ __forceinline__ bf16x8v tr_get(const TrHalf& f) { v4u r; r.x = f.lo.x; r.y = f.lo.y; r.z = f.hi.x; r.w = f.hi.y; return __builtin_bit_cast(bf16x8v, r); }
__device__ __forceinline__ void tr_wait2(TrHalf (&f)[2]) { asm volatile("s_waitcnt lgkmcnt(0)" : "+v"(f[0].lo), "+v"(f[0].hi), "+v"(f[1].lo), "+v"(f[1].hi) :: "memory"); }
__device__ __forceinline__ void tr_wait8(TrHalf (&f)[8]) { asm volatile("s_waitcnt lgkmcnt(0)" : "+v"(f[0].lo), "+v"(f[0].hi), "+v"(f[1].lo), "+v"(f[1].hi), "+v"(f[2].lo), "+v"(f[2].hi), "+v"(f[3].lo), "+v"(f[3].hi),
    "+v"(f[4].lo), "+v"(f[4].hi), "+v"(f[5].lo), "+v"(f[5].hi), "+v"(f[6].lo), "+v"(f[6].hi), "+v"(f[7].lo), "+v"(f[7].hi) :: "memory"); }
__device__ __forceinline__ unsigned lds_addr(LAS unsigned char* p) { return (unsigned)(size_t)p; }
constexpr int GL_BC = 0;
constexpr int GL_TOT = 65536;
constexpr int GL_V = 71680;
constexpr int GL_A = 105472;
constexpr int GL_STG = 105472;
constexpr int GL_RED = 124928;
constexpr int GL_QK_PITCH = 272, GL_V_PITCH = 528, GL_A_PITCH = 144;
static_assert(GL_STG + 25600 <= RING_BYTES && GL_V + 64 * GL_V_PITCH <= GL_A && GL_TOT + 4096 + 1024 <= GL_V && 4 * 64 * GL_QK_PITCH <= GL_V, "GLA LDS map");

__device__ __forceinline__ void gla_decays(Frame& F, unsigned char* ws, const float* wgf, const float* bgf, const float* wgb, const float* bgb, int row0, int h, int d0, int d1) {
    LAS float* lr = (LAS float*)(F.lds + GL_STG); LAS float* wg = lr + 64 * 32; LAS float* bg = wg + 2 * 16 * 128;
    LAS float* bc = (LAS float*)(F.lds + GL_BC); LAS float* tot = (LAS float*)(F.lds + GL_TOT);
    { const int t = F.tid >> 3, o4 = (F.tid & 7) * 4; *(LAS f32x4*)(lr + t * 32 + o4) = *(const GAS f32x4*)(((float*)(ws + WS_LR)) + (size_t)(row0 + t) * 32 + o4); }
    for (int i = F.tid; i < 1024; i += NTHR) { const int dir = i >> 9, o = (i >> 5) & 15, d4 = (i & 31) * 4; *(LAS f32x4*)(wg + (dir * 16 + o) * 128 + d4) = *(const GAS f32x4*)((dir ? wgb : wgf) + o * 512 + h * 128 + d4); }
    if (F.tid < 64) { const int dir = F.tid >> 5, d4 = (F.tid & 31) * 4; *(LAS f32x4*)(bg + dir * 128 + d4) = *(const GAS f32x4*)((dir ? bgb : bgf) + h * 128 + d4); }
    __syncthreads();
    { const int t = F.tid >> 3, dg = (F.tid & 7) * 16;
      for (int dir = d0; dir < d1; ++dir) {
          f32x4 z[4];
#pragma unroll
          for (int j = 0; j < 4; ++j) z[j] = *(LAS f32x4*)(bg + dir * 128 + dg + 4 * j);
#pragma unroll
          for (int o = 0; o < 16; ++o) { const float l = lr[t * 32 + dir * 16 + o];
#pragma unroll
              for (int j = 0; j < 4; ++j) z[j] += l * *(LAS f32x4*)(wg + (dir * 16 + o) * 128 + dg + 4 * j); }
#pragma unroll
          for (int j = 0; j < 4; ++j) { f32x4 g; g[0] = log_sigmoid16(z[j][0]); g[1] = log_sigmoid16(z[j][1]); g[2] = log_sigmoid16(z[j][2]); g[3] = log_sigmoid16(z[j][3]); *(LAS f32x4*)(bc + dir * 8192 + t * 128 + dg + 4 * j) = g; } } }
    __syncthreads();
    { const int d = F.tid & 127, seg = F.tid >> 7;
      for (int dir = d0; dir < d1; ++dir) { float a = 0.f;
#pragma unroll
          for (int i = 0; i < 16; ++i) { const int s = seg * 16 + i, t = dir ? 63 - s : s; a += bc[dir * 8192 + t * 128 + d]; bc[dir * 8192 + t * 128 + d] = a; }
          tot[(dir * 4 + seg) * 128 + d] = a; } }
    __syncthreads();
    { const int d = F.tid & 127, seg = F.tid >> 7;
      for (int dir = d0; dir < d1; ++dir) { float pre = 0.f, all = 0.f;
#pragma unroll
          for (int s2 = 0; s2 < 4; ++s2) { const float v = tot[(dir * 4 + s2) * 128 + d]; all += v; if (s2 < seg) pre += v; }
          if (seg == 0) tot[1024 + dir * 128 + d] = all;
          if (seg > 0) {
#pragma unroll
              for (int i = 0; i < 16; ++i) { const int s = seg * 16 + i, t = dir ? 63 - s : s; bc[dir * 8192 + t * 128 + d] += pre; } } } }
    __syncthreads();
}
__device__ __forceinline__ void gla_stage_v(Frame& F, const bf16* U, int row0, int h) {
#pragma unroll
    for (int i = 0; i < 4; ++i) { const int p = F.tid + NTHR * i, t = p >> 5, e8 = (p & 31) * 8;
        *(LAS v4u*)(F.lds + GL_V + t * GL_V_PITCH + e8 * 2) = *(const GAS v4u*)(U + (size_t)(row0 + t) * NU + U_GV + h * 256 + e8); }
}
__device__ __forceinline__ void gla_g1(Frame& F, int L) {
    unsigned char* const ws = PWS(); const bf16* U = (const bf16*)(ws + WS_U);
    const float* wgf = PIN(8) + (size_t)L * 16 * 512; const float* bgf = PIN(9) + L * 512; const float* wgb = PIN(10) + (size_t)L * 16 * 512; const float* bgb = PIN(11) + L * 512;
    const int g = F.lane >> 4, q4 = (F.lane & 15) >> 2, p = F.lane & 3, l15 = F.lane & 15;
    for (int task = F.vcu; task < 16 * GLA_NCH; task += F.G) {
        const int cn = task % GLA_NCH, ch = task / GLA_NCH, h = ch & 3, dir = (ch >> 2) & 1, b = ch >> 3;
        const int row0 = gla_chunk_row0(b, cn), n = gla_scan_idx(cn, dir);
        __syncthreads();
        gla_stage_v(F, U, row0, h);
        v4u kp[2];
#pragma unroll
        for (int i = 0; i < 2; ++i) { const int pc = F.tid + NTHR * i, t = pc >> 4, d8 = (pc & 15) * 8; kp[i] = *(const GAS v4u*)(U + (size_t)(row0 + t) * NU + U_GK + h * 128 + d8); }
        gla_decays(F, ws, wgf, bgf, wgb, bgb, row0, h, dir, dir + 1);
        LAS float* bc = (LAS float*)(F.lds + GL_BC) + dir * 8192; LAS float* bl = (LAS float*)(F.lds + GL_TOT) + 1024 + dir * 128;
        if (F.tid < 128) GLA_DEC(ws)[((size_t)ch * GLA_NCH + n) * 128 + F.tid] = __expf(bl[F.tid]);
        LAS unsigned char* ke = F.lds + GL_BC + (dir ? 0 : 32768);
#pragma unroll
        for (int i = 0; i < 2; ++i) { const int pc = F.tid + NTHR * i, t = pc >> 4, d8 = (pc & 15) * 8;
            const f32x4 b0 = *(LAS f32x4*)(bc + t * 128 + d8), b1 = *(LAS f32x4*)(bc + t * 128 + d8 + 4), l0 = *(LAS f32x4*)(bl + d8), l1 = *(LAS f32x4*)(bl + d8 + 4);
            { float* bo = GLA_BCG(ws) + ((((size_t)(b * 4 + h) * GLA_NCH + cn) * 2 + dir) * 64 + t) * 128 + d8; *(GAS f32x4*)bo = b0; *(GAS f32x4*)(bo + 4) = b1; }
            v4u o; o.x = pk2(bflo(kp[i].x) * __expf(l0[0] - b0[0]), bfhi(kp[i].x) * __expf(l0[1] - b0[1])); o.y = pk2(bflo(kp[i].y) * __expf(l0[2] - b0[2]), bfhi(kp[i].y) * __expf(l0[3] - b0[3]));
            o.z = pk2(bflo(kp[i].z) * __expf(l1[0] - b1[0]), bfhi(kp[i].z) * __expf(l1[1] - b1[1])); o.w = pk2(bflo(kp[i].w) * __expf(l1[2] - b1[2]), bfhi(kp[i].w) * __expf(l1[3] - b1[3]));
            *(LAS v4u*)(ke + t * GL_QK_PITCH + d8 * 2) = o; }
        __syncthreads();
        f32x4 acc[8][2];
#pragma unroll
        for (int mt = 0; mt < 8; ++mt) { acc[mt][0] = (f32x4){0.f, 0.f, 0.f, 0.f}; acc[mt][1] = (f32x4){0.f, 0.f, 0.f, 0.f}; }
        const unsigned ke_a = lds_addr(ke) + GL_QK_PITCH * (8 * g + q4) + 8 * p, v_a = lds_addr(F.lds + GL_V) + GL_V_PITCH * (8 * g + q4) + 8 * p + 2 * (32 * F.wave);
#pragma unroll
        for (int ks = 0; ks < 2; ++ks) {
            TrHalf bh[2], ah[8];
#pragma unroll
            for (int nt = 0; nt < 2; ++nt) tr_issue(bh[nt], v_a + GL_V_PITCH * 32 * ks + 32 * nt, GL_V_PITCH * 4);
#pragma unroll
            for (int mt = 0; mt < 8; ++mt) tr_issue(ah[mt], ke_a + GL_QK_PITCH * 32 * ks + 32 * mt, GL_QK_PITCH * 4);
            tr_wait2(bh); tr_wait8(ah);
            const bf16x8v bv0 = tr_get(bh[0]), bv1 = tr_get(bh[1]);
#pragma unroll
            for (int mt = 0; mt < 8; ++mt) { const bf16x8v av = tr_get(ah[mt]);
                acc[mt][0] = __builtin_amdgcn_mfma_f32_16x16x32_bf16(av, bv0, acc[mt][0], 0, 0, 0); acc[mt][1] = __builtin_amdgcn_mfma_f32_16x16x32_bf16(av, bv1, acc[mt][1], 0, 0, 0); } }
        bf16* dst = GLA_DST(ws) + ((size_t)ch * GLA_NCH + n) * 256 * 128;
#pragma unroll
        for (int mt = 0; mt < 8; ++mt)
#pragma unroll
            for (int nt = 0; nt < 2; ++nt) { const int e = 32 * F.wave + 16 * nt + l15, d = 16 * mt + 4 * g; v2u w; w.x = pk2(acc[mt][nt][0], acc[mt][nt][1]); w.y = pk2(acc[mt][nt][2], acc[mt][nt][3]);
                *(GAS v2u*)(dst + (size_t)e * 128 + d) = w; }
    }
}
__device__ __forceinline__ void gla_g2(Frame& F) {
    unsigned char* const ws = PWS();
    const int NT = F.G * NTHR;
    for (int idx = F.bx * NTHR + F.tid; idx < 16 * 256 * 32; idx += NT) {
        const int ch = idx >> 13, e = (idx >> 5) & 255, d4 = (idx & 31) * 4;
        bf16* p = GLA_DST(ws) + (size_t)ch * GLA_NCH * 32768 + (size_t)e * 128 + d4; const float* dc = GLA_DEC(ws) + (size_t)ch * GLA_NCH * 128 + d4;
        f32x4 S = {0.f, 0.f, 0.f, 0.f};
#pragma unroll 17
        for (int n = 0; n < GLA_NCH; ++n) { const v2u x = *(const GAS v2u*)(p + (size_t)n * 32768); const f32x4 a = *(const GAS f32x4*)(dc + n * 128);
            v2u w; w.x = pk2(S[0], S[1]); w.y = pk2(S[2], S[3]); *(GAS v2u*)(p + (size_t)n * 32768) = w;
            S[0] = a[0] * S[0] + bflo(x.x); S[1] = a[1] * S[1] + bfhi(x.x); S[2] = a[2] * S[2] + bflo(x.y); S[3] = a[3] * S[3] + bfhi(x.y); }
    }
}
__device__ __forceinline__ void gla_g3(Frame& F, int L) {
    unsigned char* const ws = PWS(); const bf16* U = (const bf16*)(ws + WS_U);
    const float* wgf = PIN(8) + (size_t)L * 16 * 512; const float* bgf = PIN(9) + L * 512; const float* wgb = PIN(10) + (size_t)L * 16 * 512; const float* bgb = PIN(11) + L * 512;
    const float* ng = PIN(12) + L * 256;
    const int g = F.lane >> 4, q4 = (F.lane & 15) >> 2, p = F.lane & 3, l15 = F.lane & 15;
    for (int task = F.vcu; task < 8 * GLA_NCH; task += F.G) {
        const int cn = task % GLA_NCH, bh = task / GLA_NCH, h = bh & 3, b = bh >> 2;
        const int row0 = gla_chunk_row0(b, cn);
        __syncthreads();
        gla_stage_v(F, U, row0, h);
        v4u kp[2], qp[2];
#pragma unroll
        for (int i = 0; i < 2; ++i) { const int pc = F.tid + NTHR * i, t = pc >> 4, d8 = (pc & 15) * 8; const bf16* up = U + (size_t)(row0 + t) * NU + h * 128 + d8; kp[i] = *(const GAS v4u*)(up + U_GK); qp[i] = *(const GAS v4u*)(up + U_GQ); }
        { const float* bcg = GLA_BCG(ws) + ((size_t)(b * 4 + h) * GLA_NCH + cn) * 2 * 8192;
#pragma unroll
          for (int i = 0; i < 2; ++i) { const int pc = F.tid + NTHR * i, t = pc >> 4, d8 = (pc & 15) * 8;
#pragma unroll
              for (int dir = 0; dir < 2; ++dir) { const f32x4 b0 = *(const GAS f32x4*)(bcg + dir * 8192 + t * 128 + d8), b1 = *(const GAS f32x4*)(bcg + dir * 8192 + t * 128 + d8 + 4);
                  float ep[8], en[8];
#pragma unroll
                  for (int j = 0; j < 4; ++j) { ep[j] = __expf(b0[j]); ep[4 + j] = __expf(b1[j]); en[j] = __expf(-b0[j]); en[4 + j] = __expf(-b1[j]); }
                  v4u qo, ko;
                  qo.x = pk2(bflo(qp[i].x) * ep[0], bfhi(qp[i].x) * ep[1]); qo.y = pk2(bflo(qp[i].y) * ep[2], bfhi(qp[i].y) * ep[3]); qo.z = pk2(bflo(qp[i].z) * ep[4], bfhi(qp[i].z) * ep[5]); qo.w = pk2(bflo(qp[i].w) * ep[6], bfhi(qp[i].w) * ep[7]);
                  ko.x = pk2(bflo(kp[i].x) * en[0], bfhi(kp[i].x) * en[1]); ko.y = pk2(bflo(kp[i].y) * en[2], bfhi(kp[i].y) * en[3]); ko.z = pk2(bflo(kp[i].z) * en[4], bfhi(kp[i].z) * en[5]); ko.w = pk2(bflo(kp[i].w) * en[6], bfhi(kp[i].w) * en[7]);
                  *(LAS v4u*)(F.lds + GL_BC + (2 * dir) * 64 * GL_QK_PITCH + t * GL_QK_PITCH + d8 * 2) = qo; *(LAS v4u*)(F.lds + GL_BC + (2 * dir + 1) * 64 * GL_QK_PITCH + t * GL_QK_PITCH + d8 * 2) = ko; } } }
        __syncthreads();
        { const int dir = F.wave >> 2, nt = F.wave & 3;
          LAS unsigned char* qi = F.lds + GL_BC + (2 * dir) * 64 * GL_QK_PITCH; LAS unsigned char* ki = qi + 64 * GL_QK_PITCH;
          bf16x8v qf[4];
#pragma unroll
          for (int ks = 0; ks < 4; ++ks) qf[ks] = *(LAS bf16x8v*)(qi + (16 * nt + l15) * GL_QK_PITCH + (32 * ks + 8 * g) * 2);
#pragma unroll
          for (int mt = 0; mt < 4; ++mt) { f32x4 a = {0.f, 0.f, 0.f, 0.f};
              const bool live = dir ? (mt >= nt) : (mt <= nt);
              if (live) {
#pragma unroll
                  for (int ks = 0; ks < 4; ++ks) { const bf16x8v kf = *(LAS bf16x8v*)(ki + (16 * mt + l15) * GL_QK_PITCH + (32 * ks + 8 * g) * 2); a = __builtin_amdgcn_mfma_f32_16x16x32_bf16(kf, qf[ks], a, 0, 0, 0); } }
              const int tau = 16 * nt + l15, s0 = 16 * mt + 4 * g;
#pragma unroll
              for (int i = 0; i < 4; ++i) { const bool keep = dir ? (s0 + i >= tau) : (s0 + i <= tau); if (!keep) a[i] = 0.f; }
              v2u w; w.x = pk2(a[0], a[1]); w.y = pk2(a[2], a[3]);
              *(LAS v2u*)(F.lds + GL_A + dir * 64 * GL_A_PITCH + tau * GL_A_PITCH + s0 * 2) = w; } }
        __syncthreads();
        f32x4 acc[2][4];
#pragma unroll
        for (int mt = 0; mt < 2; ++mt)
#pragma unroll
            for (int nt = 0; nt < 4; ++nt) acc[mt][nt] = (f32x4){0.f, 0.f, 0.f, 0.f};
        { const unsigned v_a = lds_addr(F.lds + GL_V) + GL_V_PITCH * (8 * g + q4) + 8 * p + 2 * (32 * F.wave);
#pragma unroll
          for (int ks = 0; ks < 2; ++ks) { TrHalf vh[2];
#pragma unroll
              for (int mt = 0; mt < 2; ++mt) tr_issue(vh[mt], v_a + GL_V_PITCH * 32 * ks + 32 * mt, GL_V_PITCH * 4);
              tr_wait2(vh); const bf16x8v vf[2] = {tr_get(vh[0]), tr_get(vh[1])};
#pragma unroll
              for (int dir = 0; dir < 2; ++dir)
#pragma unroll
                  for (int nt = 0; nt < 4; ++nt) { const bf16x8v af = *(LAS bf16x8v*)(F.lds + GL_A + dir * 64 * GL_A_PITCH + (16 * nt + l15) * GL_A_PITCH + (32 * ks + 8 * g) * 2);
                      acc[0][nt] = __builtin_amdgcn_mfma_f32_16x16x32_bf16(vf[0], af, acc[0][nt], 0, 0, 0); acc[1][nt] = __builtin_amdgcn_mfma_f32_16x16x32_bf16(vf[1], af, acc[1][nt], 0, 0, 0); } } }
#pragma unroll
        for (int dir = 0; dir < 2; ++dir) { const int ch = (b * 2 + dir) * 4 + h, n = gla_scan_idx(cn, dir);
            const bf16* st = GLA_DST(ws) + ((size_t)ch * GLA_NCH + n) * 32768; LAS unsigned char* qi = F.lds + GL_BC + (2 * dir) * 64 * GL_QK_PITCH;
#pragma unroll
            for (int ks = 0; ks < 4; ++ks) { bf16x8v sf[2];
#pragma unroll
                for (int mt = 0; mt < 2; ++mt) sf[mt] = __builtin_bit_cast(bf16x8v, *(const GAS v4u*)(st + (size_t)(32 * F.wave + 16 * mt + l15) * 128 + 32 * ks + 8 * g));
#pragma unroll
                for (int nt = 0; nt < 4; ++nt) { const bf16x8v qf = *(LAS bf16x8v*)(qi + (16 * nt + l15) * GL_QK_PITCH + (32 * ks + 8 * g) * 2);
                    acc[0][nt] = __builtin_amdgcn_mfma_f32_16x16x32_bf16(sf[0], qf, acc[0][nt], 0, 0, 0); acc[1][nt] = __builtin_amdgcn_mfma_f32_16x16x32_bf16(sf[1], qf, acc[1][nt], 0, 0, 0); } } }
        LAS float* red = (LAS float*)(F.lds + GL_RED);
#pragma unroll
        for (int nt = 0; nt < 4; ++nt) { float s = 0.f;
#pragma unroll
            for (int mt = 0; mt < 2; ++mt)
#pragma unroll
                for (int i = 0; i < 4; ++i) s += acc[mt][nt][i] * acc[mt][nt][i];
            s += __shfl_xor(s, 16); s += __shfl_xor(s, 32);
            if (g == 0) red[F.wave * 64 + 16 * nt + l15] = s; }
        __syncthreads();
#pragma unroll
        for (int nt = 0; nt < 4; ++nt) { const int tau = 16 * nt + l15; float s = 0.f;
#pragma unroll
            for (int w = 0; w < 8; ++w) s += red[w * 64 + tau];
            const float rs = 1.0f / sqrtf(s * (1.0f / 256.0f) + LN_EPS); const size_t row = (size_t)(row0 + tau);
#pragma unroll
            for (int mt = 0; mt < 2; ++mt) { const int e = 32 * F.wave + 16 * mt + 4 * g;
                const v2u rw = *(const GAS v2u*)(U + row * NU + U_GR + h * 256 + e); const f32x4 g4 = *(const f32x4*)(ng + e);
                const float r0 = bflo(rw.x), r1 = bfhi(rw.x), r2 = bflo(rw.y), r3 = bfhi(rw.y);
                v2u w; w.x = pk2(acc[mt][nt][0] * rs * g4[0] * (r0 / (1.0f + __expf(-r0))), acc[mt][nt][1] * rs * g4[1] * (r1 / (1.0f + __expf(-r1))));
                w.y = pk2(acc[mt][nt][2] * rs * g4[2] * (r2 / (1.0f + __expf(-r2))), acc[mt][nt][3] * rs * g4[3] * (r3 / (1.0f + __expf(-r3))));
                *(GAS v2u*)(((bf16*)(ws + WS_Y + (size_t)MROWS * 1024 * 2)) + row * 1024 + h * 256 + e) = w; } }
    }
}

constexpr int NA_VPITCH = 272, NA_VIMG = 32 * NA_VPITCH, NA_WAVE_LDS = 10752;
template <bool CTXQ> __device__ __forceinline__ void na_task(const bf16* U, bf16* YN, LAS unsigned char* vimg, const LAS float* rpb, int lane, int b, int h, int r, int c0, int qrow0) {
    const int g = lane >> 4, q4 = (lane & 15) >> 2, p = lane & 3, l15 = lane & 15;
    const unsigned v_a = lds_addr(vimg) + NA_VPITCH * (4 * g + q4) + 8 * p;
    const int rs = min(max(r - 4, 0), 56), kc0 = min(max(c0 - 8, 0), 32), ctx0 = NLAT + CTXL * b;
    const int qc = c0 + l15, cs = min(max(qc - 8, 0), 48);
    constexpr int KB0 = CTXQ ? 8 : 0;
    bf16x8v qf[4];
#pragma unroll
    for (int ks = 0; ks < 4; ++ks) qf[ks] = __builtin_bit_cast(bf16x8v, *(const GAS v4u*)(U + (size_t)(qrow0 + l15) * NU + U_NQ + h * 128 + 32 * ks + 8 * g));
    f32x4 o[8];
#pragma unroll
    for (int mt = 0; mt < 8; ++mt) o[mt] = (f32x4){0.f, 0.f, 0.f, 0.f};
    float mrun = -INFINITY, lrun = 0.f;
    v4u kf[8], vv[8];
    const unsigned voffK = (unsigned)((l15 * NU + 8 * g) * 2), voffV = (unsigned)(((lane >> 4) * NU + (lane & 15) * 8) * 2);
#define NA_LOAD_BLOCK(tokexpr) do { int tok_ = (tokexpr); asm volatile("" : "+s"(tok_)); \
        const GAS char* kb_ = (const GAS char*)(U + (size_t)tok_ * NU + U_NK + h * 128); const GAS char* vb_ = (const GAS char*)(U + (size_t)tok_ * NU + U_NV + h * 128); \
        _Pragma("unroll") for (int i = 0; i < 8; ++i) kf[i] = *(const GAS v4u*)(kb_ + (size_t)(i >> 2) * (16 * NU * 2) + voffK + 64 * (i & 3)); \
        _Pragma("unroll") for (int i = 0; i < 8; ++i) vv[i] = *(const GAS v4u*)(vb_ + (size_t)i * (4 * NU * 2) + voffV); } while (0)
    NA_LOAD_BLOCK(KB0 < 8 ? b * SEQ + (rs + KB0) * 64 + kc0 : ctx0 + 32 * (KB0 - 8));
#pragma unroll 1
    for (int kb = KB0; kb < 16; ++kb) {
#pragma unroll
        for (int i = 0; i < 8; ++i) { const int id = lane + 64 * i; *(LAS v4u*)(vimg + (id >> 4) * NA_VPITCH + (id & 15) * 16) = vv[i]; }
        v4u kc_[8];
#pragma unroll
        for (int i = 0; i < 8; ++i) kc_[i] = kf[i];
        if (kb + 1 < 16) NA_LOAD_BLOCK((kb + 1) < 8 ? b * SEQ + (rs + kb + 1) * 64 + kc0 : ctx0 + 32 * (kb + 1 - 8));
        f32x4 s0 = {0.f, 0.f, 0.f, 0.f}, s1 = {0.f, 0.f, 0.f, 0.f};
#pragma unroll
        for (int ks = 0; ks < 4; ++ks) { s0 = __builtin_amdgcn_mfma_f32_16x16x32_bf16(__builtin_bit_cast(bf16x8v, kc_[ks]), qf[ks], s0, 0, 0, 0); s1 = __builtin_amdgcn_mfma_f32_16x16x32_bf16(__builtin_bit_cast(bf16x8v, kc_[4 + ks]), qf[ks], s1, 0, 0, 0); }
        if (!CTXQ && kb < 8) { int drow = rs + kb - r + 7; asm volatile("" : "+s"(drow)); const LAS float* rp = rpb + drow * 31 - qc + 15;
#pragma unroll
            for (int i = 0; i < 4; ++i) { const int k0 = kc0 + 4 * g + i, k1 = k0 + 16; const bool ok0 = k0 >= cs && k0 <= cs + 15, ok1 = k1 >= cs && k1 <= cs + 15;
                const float b0 = rp[ok0 ? k0 : qc], b1 = rp[ok1 ? k1 : qc];
                s0[i] = ok0 ? s0[i] + b0 : -INFINITY; s1[i] = ok1 ? s1[i] + b1 : -INFINITY; } }
        float mloc = fmaxf(fmaxf(fmaxf(s0[0], s0[1]), fmaxf(s0[2], s0[3])), fmaxf(fmaxf(s1[0], s1[1]), fmaxf(s1[2], s1[3])));
        mloc = fmaxf(mloc, __shfl_xor(mloc, 16)); mloc = fmaxf(mloc, __shfl_xor(mloc, 32));
        const float mnew = fmaxf(mrun, mloc), alpha = __expf(mrun - mnew); mrun = mnew;
        float ps = 0.f;
#pragma unroll
        for (int i = 0; i < 4; ++i) { s0[i] = __expf(s0[i] - mnew); s1[i] = __expf(s1[i] - mnew); ps += s0[i] + s1[i]; }
        lrun = lrun * alpha + ps;
#pragma unroll
        for (int mt = 0; mt < 8; ++mt) o[mt] *= alpha;
        v4u pw; pw.x = pk2(s0[0], s0[1]); pw.y = pk2(s0[2], s0[3]); pw.z = pk2(s1[0], s1[1]); pw.w = pk2(s1[2], s1[3]);
        const bf16x8v pf = __builtin_bit_cast(bf16x8v, pw);
        TrHalf vh[8];
#pragma unroll
        for (int mt = 0; mt < 8; ++mt) tr_issue(vh[mt], v_a + 32 * mt, NA_VPITCH * 16);
        tr_wait8(vh);
#pragma unroll
        for (int mt = 0; mt < 8; ++mt) o[mt] = __builtin_amdgcn_mfma_f32_16x16x32_bf16(tr_get(vh[mt]), pf, o[mt], 0, 0, 0);
        asm volatile("" ::: "memory"); __builtin_amdgcn_sched_barrier(0);
    }
#undef NA_LOAD_BLOCK
    lrun += __shfl_xor(lrun, 16); lrun += __shfl_xor(lrun, 32);
    const float inv = 1.0f / lrun;
    bf16* yp = YN + (size_t)(qrow0 + l15) * 1024 + h * 128 + 4 * g;
#pragma unroll
    for (int mt = 0; mt < 8; ++mt) { v2u w; w.x = pk2(o[mt][0] * inv, o[mt][1] * inv); w.y = pk2(o[mt][2] * inv, o[mt][3] * inv); *(GAS v2u*)(yp + 16 * mt) = w; }
}
__device__ __forceinline__ void na_mfma(Frame& F, int L) {
    unsigned char* const ws = PWS(); const bf16* U = (const bf16*)(ws + WS_U); bf16* YN = (bf16*)(ws + WS_Y + (size_t)MROWS * 2048 * 2);
    const float* rpbL = PIN(13) + (size_t)L * 8 * 15 * 31;
    LAS unsigned char* vimg = F.lds + RING_OFF + F.wave * NA_WAVE_LDS; LAS float* rpb = (LAS float*)(vimg + NA_VIMG);
    const int gw = F.vcu * NWAVES + F.wave, NGW = F.G * NWAVES;
    int hcur = -1;
    for (int task = gw; task < 2 * 8 * 64 * 4; task += NGW) {
        const int ct = task & 3, r = (task >> 2) & 63, h = (task >> 8) & 7, b = task >> 11;
        if (h != hcur) { hcur = h; for (int i = F.lane; i < 15 * 31; i += 64) rpb[i] = rpbL[h * 15 * 31 + i]; LDS_WAIT(); asm volatile("" ::: "memory"); }
        na_task<false>(U, YN, vimg, rpb, F.lane, b, h, r, 16 * ct, b * SEQ + r * 64 + 16 * ct);
    }
    if (L == 0) for (int tt = gw; tt < 2 * 8 * 16; tt += NGW) {
        const int qt = tt & 15, h = (tt >> 4) & 7, b = tt >> 7;
        na_task<true>(U, YN, vimg, rpb, F.lane, b, h, 0, 0, NLAT + CTXL * b + 16 * qt);
    }
}
#ifndef MK_ONE_LAUNCH
#define MK_ONE_LAUNCH 0
#endif
constexpr int PH_PER_LAYER = 11, NPH = 2 + DEPTH * PH_PER_LAYER;
enum { PL_WIN = 0, PL_MIXA, PL_MIXB, PL_MIXC, PL_BR, PL_WOUT, PL_LN1, PL_GATHER, PL_FFN1, PL_FFN2, PL_LN2 };
__device__ __forceinline__ bool in_range(int lo, int hi, int k) { asm volatile("" : "+s"(lo), "+s"(hi)); return lo <= k && k < hi; }
#ifndef PHMASK
#define PHMASK 0xFFFFFFFFu
#endif
#define IN(k) in_range(lo, hi, (k))
#define EN(bit) ((PHMASK >> (bit)) & 1u)
#ifndef DUPMASK
#define DUPMASK 0u
#endif
#define DUP(bit) ((DUPMASK >> (bit)) & 1u)
#define SEAM(k) do { if (IN((k) + 1)) GRID_BAR(); } while (0)
#if MK_ONE_LAUNCH
#define GRID_BAR() xcd_barrier(bar)
#else
#define GRID_BAR() do { if (F.tid == 0) __hip_atomic_store((gu32*)(PWS() + WS_CTL) + CW_TMO, 0xBADBA0u, RLX_AGENT); } while (0)
#endif
template <int L> __device__ __forceinline__ void layer_phases(const Args& A, LAS unsigned char* const ldsb, const XcdBarrier& bar, const int lo, const int hi) {
    LAS unsigned char* const ring = ldsb + RING_OFF;
        const int pb = 2 + PH_PER_LAYER * L, Mr = (L == 0) ? MROWS : NLAT;
        if (EN(2) && IN(pb + PL_WIN)) { Frame F = mkframe(ldsb, A.grid);
            unsigned char* const ws = PWS();
            lr_tiles(F, L);
            pg8::StaticOrder S; S.init(MROWS, NU, F.G, F.bx);
            if (L == 0) { pg8::Gemm g{((bf16*)(ws + WS_H)), w_in_t(ws, L), D, D}; pg8::EpiU E{((bf16*)(ws + WS_U)), NU, 1.0f};
                pg8::gemm_phase<pg8::EpiU, pg8::StaticOrder, true, true>(ring, g, S, E); }
            else { pg8::Gemm g{((bf16*)(ws + WS_ZB)), w_in_t(ws, L), D / 2, D / 2}; pg8::EpiU E{((bf16*)(ws + WS_U)), NU, 1.0f / FSC_WGU};
                pg8::gemm_phase<pg8::EpiU, pg8::StaticOrder, true, true, true>(ring, g, S, E); }
            SEAM(pb + PL_WIN);
        }
        if (EN(3) && IN(pb + PL_MIXA)) { Frame F = mkframe(ldsb, A.grid); gla_g1(F, L); mix_prep(F, L); if (DUP(3)) { __syncthreads(); gla_g1(F, L); mix_prep(F, L); } SEAM(pb + PL_MIXA); }
        if (EN(4) && IN(pb + PL_MIXB)) { Frame F = mkframe(ldsb, A.grid); gla_g2(F); { int nrep = 1 + (int)DUP(4); asm volatile("" : "+s"(nrep)); for (int rep = 0; rep < nrep; ++rep) { if (rep) __syncthreads(); na_mfma(F, L); } } if (DUP(13)) { VM_WAIT(); __syncthreads(); gla_g2(F); } SEAM(pb + PL_MIXB); }
        if (EN(5) && IN(pb + PL_MIXC)) { Frame F = mkframe(ldsb, A.grid); gla_g3(F, L); if (DUP(5)) { __syncthreads(); gla_g3(F, L); } SEAM(pb + PL_MIXC); }
        if (EN(6) && IN(pb + PL_BR)) { Frame F = mkframe(ldsb, A.grid);
            unsigned char* const ws = PWS(); const float* const gate_b = PIN(17) + (size_t)L * 3 * D;
            pg8::Gemm g{((bf16*)(ws + WS_Y)), w_br_t(ws, L, 0), 1024, 1024}; pg8::BranchOrder S; S.init(Mr, D, F.G, F.bx, MROWS / 256, D / 256);
            pg8::EpiGate E{((bf16*)(ws + WS_U)) + U_GATE, NU, gate_b, ((bf16*)(ws + WS_ZB))};
            pg8::gemm_phase<pg8::EpiGate, pg8::BranchOrder, true, true>(ring, g, S, E);
            SEAM(pb + PL_BR);
        }
        if (EN(7) && IN(pb + PL_WOUT)) { Frame F = mkframe(ldsb, A.grid);
            unsigned char* const ws = PWS(); const float* const modL = ((float*)(ws + WS_MOD)) + (size_t)L * 3 * 12288; const float* const xin = PIN(0); const float* const cin = PIN(2);
            { pg8::Gemm g{((bf16*)(ws + WS_ZB)), w_out_t(ws, L), D, D}; pg8::StaticOrder S; S.init(NLAT, D, F.G, F.bx);
              pg8::EpiRes<false> E{L == 0 ? xin : ((float*)(ws + WS_XL)), cin, modL + 2 * D, 12288, ((float*)(ws + WS_PRE)), ALPHA, 1.0f};
              pg8::gemm_phase<pg8::EpiRes<false>, pg8::StaticOrder, true, true>(ring, g, S, E); }
            if (L == 0) {
              pg8::Gemm g{((bf16*)(ws + WS_ZB)), w_out_t(ws, L), D, 256}; pg8::SplitOrder S; S.init(NLAT / 256, D / 256, 8, 256, F.G, F.bx, 0);
              pg8::EpiPartial<false> E{((float*)(ws + WS_PART)), NLAT / 256, 1.0f};
              pg8::gemm_phase<pg8::EpiPartial<false>, pg8::SplitOrder, false, false>(ring, g, S, E); }
            SEAM(pb + PL_WOUT);
        }
        if (EN(8) && IN(pb + PL_LN1)) { Frame F = mkframe(ldsb, A.grid); ln1_phase(F, L, Mr); SEAM(pb + PL_LN1); }
        if (L == 0) {
            if (EN(10) && IN(pb + PL_FFN1)) { Frame F = mkframe(ldsb, A.grid);
                unsigned char* const ws = PWS();
                pg8::Gemm g{((bf16*)(ws + WS_H)), (const bf16*)w_gu_t(ws, -1), D, D}; pg8::StaticOrder S; S.init(MROWS, NGU, F.G, F.bx);
                pg8::EpiSwiGLU E{((bf16*)(ws + WS_U)), FF};
                pg8::gemm_phase<pg8::EpiSwiGLU, pg8::StaticOrder, true, true>(ring, g, S, E);
                SEAM(pb + PL_FFN1);
            }
            if (EN(11) && IN(pb + PL_FFN2)) { Frame F = mkframe(ldsb, A.grid);
                unsigned char* const ws = PWS(); const float* const modL = ((float*)(ws + WS_MOD)) + (size_t)L * 3 * 12288;
                { pg8::Gemm g{((bf16*)(ws + WS_U)), (const bf16*)w_d_t(ws, -1), FF, FF}; pg8::StaticOrder S; S.init(NLAT, D, F.G, F.bx);
                  pg8::EpiRes<false> E{((float*)(ws + WS_XL)), ((float*)(ws + WS_XL)) + (size_t)NLAT * D, modL + 5 * D, 12288, ((float*)(ws + WS_PRE)), ALPHA, 1.0f};
                  pg8::gemm_phase<pg8::EpiRes<false>, pg8::StaticOrder, true, true>(ring, g, S, E); }
                { pg8::Gemm g{((bf16*)(ws + WS_U)), (const bf16*)w_d_t(ws, -1), FF, 512}; pg8::SplitOrder S; S.init(NLAT / 256, D / 256, 11, 512, F.G, F.bx, 0);
                  pg8::EpiPartial<false> E{((float*)(ws + WS_PART)), NLAT / 256, 1.0f};
                  pg8::gemm_phase<pg8::EpiPartial<false>, pg8::SplitOrder, false, false>(ring, g, S, E); }
                SEAM(pb + PL_FFN2);
            }
            if (EN(12) && IN(pb + PL_LN2)) { Frame F = mkframe(ldsb, A.grid); ln2_dense(F, L); if (DUP(12)) { __syncthreads(); ln2_dense(F, L); } SEAM(pb + PL_LN2); }
        } else {
            if (EN(10) && IN(pb + PL_FFN1)) { Frame F = mkframe(ldsb, A.grid);
                unsigned char* const ws = PWS();
                unsigned cnt[8]; int pp[9]; moe_prefix(ws, cnt, pp);
                pg8::Gemm g{((bf16*)(ws + WS_GLA)), (const bf16*)w_gu_t(ws, 0), D / 2, D / 2}; pg8::MoeOrder S; S.init(cnt, NGU / 256, F.G, F.bx, NLAT / 256);
                pg8::EpiSwiGLU8 E{ws + WS_U, FF, 1.0f / FSC_WGU, FSC_HID};
                pg8::gemm_phase<pg8::EpiSwiGLU8, pg8::MoeOrder, true, true, true>(ring, g, S, E);
                SEAM(pb + PL_FFN1);
            }
            if (EN(11) && IN(pb + PL_FFN2)) { Frame F = mkframe(ldsb, A.grid);
                unsigned char* const ws = PWS(); const float* const modL = ((float*)(ws + WS_MOD)) + (size_t)L * 3 * 12288;
                unsigned cnt[8]; int pp[9]; moe_prefix(ws, cnt, pp);
                pg8::Gemm g{((bf16*)(ws + WS_U)), (const bf16*)w_d_t(ws, 0), FF / 2, FF / 2}; pg8::MoeOrder S; S.init(cnt, D / 256, F.G, F.bx, 0);
                pg8::EpiBf16Plain E{((bf16*)(ws + WS_Z)), D, 1.0f / (FSC_HID * FSC_WD)};
                pg8::gemm_phase<pg8::EpiBf16Plain, pg8::MoeOrder, true, true, true>(ring, g, S, E);
                SEAM(pb + PL_FFN2);
            }
            if (EN(12) && IN(pb + PL_LN2)) { Frame F = mkframe(ldsb, A.grid); ln2_moe(F, L); }
        }
    }
__global__ void __launch_bounds__(NTHR, 2) fwd_kernel(Args A) {
    __shared__ __attribute__((aligned(16))) unsigned char lds[LDS_BYTES];
    LAS unsigned char* const ldsb = (LAS unsigned char*)lds;
    { Frame F = mkframe(ldsb, A.grid);
    for (int u = F.tid; u < (LDS_BYTES - LDSCTL_OFF) / 4; u += NTHR) ((LAS unsigned*)(F.lds + LDSCTL_OFF))[u] = 0u;
    __syncthreads();
    if (F.tid < 32) { const unsigned long long p = F.tid < 30 ? (unsigned long long)A.in[F.tid] : (F.tid == 30 ? (unsigned long long)A.out : (unsigned long long)A.ws);
        ((LAS unsigned long long*)(F.lds + PTAB_OFF))[F.tid] = p; }
    __syncthreads(); }
#if MK_ONE_LAUNCH
    XcdBarrier bar; { Frame F = mkframe(ldsb, A.grid); bar = xcd_barrier_post((unsigned*)(PWS() + WS_CTL) + CW_BAR, F.MISC + 8, (unsigned)A.grid); }
#else
    XcdBarrier bar; bar.bar = nullptr; bar.x = 0; bar.grid = 0; bar.st = nullptr;
#endif
    const int lo = A.ph_lo, hi = A.ph_hi;
    LAS unsigned char* const ring = ldsb + RING_OFF;

    if (EN(0) && IN(0)) { Frame F = mkframe(ldsb, A.grid); p0a_prologue(F); if (DUP(0)) { __syncthreads(); p0a_prologue(F); } SEAM(0); }
    if (EN(1) && IN(1)) { Frame F = mkframe(ldsb, A.grid); p0b_modulate(F); if (DUP(1)) { __syncthreads(); p0b_modulate(F); } SEAM(1); }
    layer_phases<0>(A, ldsb, bar, lo, hi);
    layer_phases<1>(A, ldsb, bar, lo, hi);
}

extern "C" void kernel_launch(void* const* d_in, const int* in_sizes, int n_in, void* d_out, int out_size, void* d_ws, size_t ws_size, hipStream_t stream) {
    static int grid = 0;
    if (grid == 0) {
        if (n_in != 30 || out_size != NLAT * D || ws_size < WS_END) { fprintf(stderr, "kernel_launch: unexpected shapes (n_in %d out %d ws %zu); nothing launched\n", n_in, out_size, ws_size); grid = -1; return; }
        int dev = 0, cus = 0, per_cu = 0;
        if (hipGetDevice(&dev) != hipSuccess || hipDeviceGetAttribute(&cus, hipDeviceAttributeMultiprocessorCount, dev) != hipSuccess) { grid = -1; return; }
        if (hipOccupancyMaxActiveBlocksPerMultiprocessor(&per_cu, (const void*)fwd_kernel, NTHR, 0) != hipSuccess || per_cu < 1) { fprintf(stderr, "kernel_launch: occupancy query says %d\n", per_cu); (void)hipGetLastError(); grid = -1; return; }
        grid = cus;
    }
    if (grid < 0) return;
    (void)hipMemsetAsync((char*)d_ws + WS_CTL, 0, CTL_ZERO_BYTES, stream);
    Args a{};
    for (int i = 0; i < 30; ++i) a.in[i] = (const float*)d_in[i];
    a.out = (float*)d_out; a.ws = (unsigned char*)d_ws; a.grid = grid;
#if MK_ONE_LAUNCH
    a.ph_lo = 0; a.ph_hi = NPH;
    hipLaunchKernelGGL(fwd_kernel, dim3(grid), dim3(NTHR), 0, stream, a);
#else
#ifndef NPH_RUN
#define NPH_RUN NPH
#endif
    for (int p = 0; p < NPH_RUN; ++p) {
        if (p == 2 + PL_GATHER || p == 2 + PH_PER_LAYER + PL_GATHER) continue;
        a.ph_lo = p; a.ph_hi = p + 1;
        hipLaunchKernelGGL(fwd_kernel, dim3(grid), dim3(NTHR), 0, stream, a);
    }
#endif
}
```

```cpp
#include <hip/hip_runtime.h>
#include <cstdio>

namespace pg8 {
#define PG8_LAS __attribute__((address_space(3)))
typedef unsigned short bf16_t;
typedef short bf16x8 __attribute__((ext_vector_type(8)));
typedef float f32x4 __attribute__((ext_vector_type(4)));
typedef unsigned u32x4 __attribute__((ext_vector_type(4)));
typedef unsigned u32x2 __attribute__((ext_vector_type(2)));
typedef float f32x2 __attribute__((ext_vector_type(2)));
typedef int i32x4 __attribute__((ext_vector_type(4)));
typedef int i32x8 __attribute__((ext_vector_type(8)));
constexpr int BM = 256, BK = 64, HALF = 128, HTB = HALF * BK * 2  , STAGE_BYTES = 8 * HTB, NXCD = 8, WGM = 2;

__host__ __device__ __forceinline__ int lds_byte(int r, int c) { const int st = (r >> 4) * 2 + (c >> 5), rr = r & 15, cc = c & 31, ob = rr * 64 + cc * 2; return st * 1024 + (ob ^ (((ob >> 9) & 1) << 5)); }
__host__ __device__ __forceinline__ void stage_rc(int b, int& R, int& C) { const int st = b / 1024, sb = b % 1024, swz = sb ^ (((sb >> 9) & 1) << 5); R = (st >> 1) * 16 + swz / 64; C = (st & 1) * 32 + (swz % 64) / 2; }
__host__ __device__ __forceinline__ int perm32(int rho) { const int n = rho >> 4, i = rho & 15; return 8 * (i >> 2) + 4 * n + (i & 3); }

struct Unit { int pm, pn, pa, pb, ko, aux, sk; };
struct Gemm { const bf16_t* A; const bf16_t* Bt; int K, KT; float* skpart; unsigned* skcnt; };

__device__ __forceinline__ int xcd_remap(int wgid, int nwg) { const int q = nwg / NXCD, r = nwg % NXCD, xcd = wgid % NXCD, off = wgid / NXCD; return (xcd < r ? xcd * (q + 1) : r * (q + 1) + (xcd - r) * q) + off; }
struct StaticOrder {
    int nM, nN, nwg, G, c;
    __host__ __device__ void init(int M, int N, int G_, int c_) { nM = M / BM; nN = N / BM; nwg = nM * nN; G = G_; c = c_; }
    __device__ __forceinline__ bool next(int i, Unit& u) const {
        const long L = (long)i * G + c; if (L >= nwg) return false;
        const int wgid = xcd_remap((int)L, nwg);
        const int nig = WGM * nN, gid = wgid / nig, fm = gid * WGM, gsz = (nM - fm) < WGM ? (nM - fm) : WGM;
        u.pm = fm + ((wgid % nig) % gsz); u.pn = (wgid % nig) / gsz; u.pa = u.pm; u.pb = u.pn; u.ko = 0; u.aux = 0; return true;
    }
    __device__ __forceinline__ void a_ready(const Unit&) const {}
    __device__ __forceinline__ void done(const Unit&) const {}
};
struct MoeOrder {
    int nN, G, c, nunits, abucket, lim; int pp[9];
    __device__ __forceinline__ void init(const unsigned* cnt, int nN_, int G_, int c_, int abucket_) { nN = nN_; G = G_; c = c_; abucket = abucket_; pp[0] = 0; lim = 1 << 30;
#pragma unroll
        for (int e = 0; e < 8; ++e) pp[e + 1] = pp[e] + (int)((cnt[e] + 255u) >> 8);
        nunits = pp[8] * nN; }
    __device__ __forceinline__ void decode(int wgid, Unit& u) const {
        int e = 0, base = 0, npe = pp[1];
#pragma unroll
        for (int k = 1; k < 8; ++k) { if (wgid >= pp[k] * nN) { e = k; base = pp[k]; npe = pp[k + 1] - pp[k]; } }
        if (npe < 1) npe = 1;
        const int local = wgid - base * nN;
        u.pm = base + local % npe; u.pn = local / npe; u.pa = abucket ? e * abucket + local % npe : u.pm; u.pb = e * nN + u.pn; u.ko = 0; u.aux = 0; u.sk = 0; }
    __device__ __forceinline__ bool next(int i, Unit& u) const {
        const long L = (long)i * G + c; if (L >= nunits || (int)(L / NXCD) >= lim) return false;
        decode(xcd_remap((int)L, nunits), u); return true;
    }
    __device__ __forceinline__ void a_ready(const Unit&) const {}
    __device__ __forceinline__ void done(const Unit&) const {}
};
struct MoeRemOrder {
    MoeOrder M; int S, ntp, rmax;
    __device__ __forceinline__ bool next(int i, Unit& u) const {
        const long L = (long)i * M.G + M.c; const int x = (int)(L % NXCD), lp = (int)(L / NXCD);
        const int q = M.nunits / NXCD, r = M.nunits % NXCD, nx = q + (x < r ? 1 : 0), rem = nx - M.lim;
        if (rem <= 0 || lp >= S * rem) return false;
        const int s = lp / rem, j = lp - s * rem, pq = ntp / S, pr = ntp % S, p0 = s * pq + (s < pr ? s : pr), pn = pq + (s < pr ? 1 : 0);
        M.decode((x < r ? x * (q + 1) : r * (q + 1) + (x - r) * q) + M.lim + j, u); u.ko = p0 * 2 * BK; u.sk = (x * rmax + j) | (s << 16) | (S << 20) | ((2 * pn) << 24); return true;
    }
    __device__ __forceinline__ void a_ready(const Unit&) const {}
    __device__ __forceinline__ void done(const Unit&) const {}
};

struct BranchOrder {
    StaticOrder S; int apanels, bpanels, nctx, pm0, nN;
    __device__ __forceinline__ void init(int M, int N, int G_, int c_, int apan, int bpan, int nctx_) { S.init(M, N, G_, c_); apanels = apan; bpanels = bpan; nctx = nctx_; pm0 = M / BM; nN = N / BM; }
    __device__ __forceinline__ bool next(int i, Unit& u) const {
        const int j = i / 3, b = i - 3 * j;
        if (S.next(j, u)) { u.pa = b * apanels + u.pm; u.pb = b * bpanels + u.pn; u.aux = b; return true; }
        const int nlat = S.c < S.nwg ? (S.nwg - S.c + S.G - 1) / S.G : 0, q = i - 3 * nlat; if (q < 0) return false;
        const long id = (long)q * S.G + S.c; if (id >= nctx) return false;
        const int t = (int)id / 3, bb = (int)id - 3 * t;
        u.pm = pm0 + t / nN; u.pn = t % nN; u.pa = bb * apanels + u.pm; u.pb = bb * bpanels + u.pn; u.ko = 0; u.aux = 4 + bb; return true;
    }
    __device__ __forceinline__ void a_ready(const Unit&) const {}
    __device__ __forceinline__ void done(const Unit&) const {}
};
struct SplitOrder {
    int pm0, nN, nsplit, KT, G, c, pa_base, asplit;
    __device__ __forceinline__ void init(int pm0_, int nN_, int nsplit_, int KT_, int G_, int c_, int pa_base_, int asplit_) { pm0 = pm0_; nN = nN_; nsplit = nsplit_; KT = KT_; G = G_; c = c_; pa_base = pa_base_; asplit = asplit_; }
    __device__ __forceinline__ bool next(int i, Unit& u) const {
        const long L = (long)i * G + c; if (L >= 2 * nN * nsplit) return false;
        const int s = (int)L % nsplit, tile = (int)L / nsplit;
        u.pm = pm0 + tile / nN; u.pn = tile % nN; u.pa = pa_base + (s / asplit) * 2 + tile / nN; u.pb = u.pn; u.ko = (s % asplit) * KT; u.aux = s; return true;
    }
    __device__ __forceinline__ void a_ready(const Unit&) const {}
    __device__ __forceinline__ void done(const Unit&) const {}
};

typedef __bf16 bf16x2n __attribute__((ext_vector_type(2)));
__device__ __forceinline__ unsigned cvt_pk_bf16(float lo, float hi) { const bf16x2n v = {(__bf16)lo, (__bf16)hi}; return __builtin_bit_cast(unsigned, v); }
__device__ __forceinline__ unsigned pk_fp8x4(float a, float b, float c, float d) { int v = __builtin_amdgcn_cvt_pk_fp8_f32(a, b, 0, false); v = __builtin_amdgcn_cvt_pk_fp8_f32(c, d, v, true); return (unsigned)v; }
__device__ __forceinline__ float clamp448(float x) { return fminf(fmaxf(x, -448.0f), 448.0f); }
__device__ __forceinline__ float bf_lo(unsigned w) { return __uint_as_float(w << 16); }
__device__ __forceinline__ float bf_hi(unsigned w) { return __uint_as_float(w & 0xffff0000u); }
__device__ __forceinline__ float fast_sigmoid(float x) { return __builtin_amdgcn_rcpf(1.0f + __expf(-x)); }

struct EpiBf16Plain {
    static constexpr bool PERM = true, AFTER_DRAIN = false;
    bf16_t* O; int ldc; float oscale;
    __device__ __forceinline__ void operator()(const f32x4 (&acc)[2][2][4][2], const Unit& u, int wr, int wc, int fr, int fq) const {
        const int row0 = u.pm * BM + wr * 64 + fr, col0 = u.pn * BM + wc * 32 + 8 * fq;
#pragma unroll
        for (int ai = 0; ai < 2; ++ai)
#pragma unroll
            for (int m = 0; m < 4; ++m) { bf16_t* rowp = O + (size_t)(row0 + ai * HALF + m * 16) * ldc + col0;
#pragma unroll
                for (int bj = 0; bj < 2; ++bj) { const f32x4 v0 = acc[ai][bj][m][0] * oscale, v1 = acc[ai][bj][m][1] * oscale;
                    u32x4 w; w.x = cvt_pk_bf16(v0[0], v0[1]); w.y = cvt_pk_bf16(v0[2], v0[3]); w.z = cvt_pk_bf16(v1[0], v1[1]); w.w = cvt_pk_bf16(v1[2], v1[3]);
                    *(u32x4*)(rowp + bj * HALF) = w; } }
    }
};
struct EpiU {
    static constexpr bool PERM = true, AFTER_DRAIN = false;
    bf16_t* O; int ldc; float oscale; unsigned char* G8; unsigned char* KF;
    __device__ __forceinline__ void operator()(const f32x4 (&acc)[2][2][4][2], const Unit& u, int wr, int wc, int fr, int fq) const {
        const int row0 = u.pm * BM + wr * 64 + fr, col0 = u.pn * BM + wc * 32 + 8 * fq;
        if (u.pn >= 36) {
            unsigned char* tp = G8 + ((size_t)(u.pm * 24 + (u.pn - 36)) * 8 * 512 + (size_t)((wr * 4 + wc) * 64 + fq * 16 + fr)) * 16;
#pragma unroll
            for (int ai = 0; ai < 2; ++ai)
#pragma unroll
                for (int m = 0; m < 4; ++m) { u32x4 w;
#pragma unroll
                    for (int bj = 0; bj < 2; ++bj) { const f32x4 v0 = acc[ai][bj][m][0] * oscale, v1 = acc[ai][bj][m][1] * oscale;
                        const unsigned lo = pk_fp8x4(clamp448(v0[0]), clamp448(v0[1]), clamp448(v0[2]), clamp448(v0[3])), hi = pk_fp8x4(clamp448(v1[0]), clamp448(v1[1]), clamp448(v1[2]), clamp448(v1[3]));
                        if (bj == 0) { w.x = lo; w.y = hi; } else { w.z = lo; w.w = hi; } }
                    *(u32x4*)(tp + (size_t)(ai * 4 + m) * 512 * 16) = w; }
            return; }
        const bool is_gq = (u.pn == 12 || u.pn == 13), is_gk = (u.pn == 14 || u.pn == 15), is_nq = (u.pn >= 24 && u.pn < 28), is_nk = (u.pn >= 28 && u.pn < 32);
        const float sc = ((is_gq || is_nq) ? 0.08838834764831845f : 1.0f) * oscale;
        const bool rope = (is_gq || is_gk) && u.pm < 32;
        float inv[4];
#pragma unroll
        for (int j = 0; j < 4; ++j) inv[j] = exp2f(-(float)((16 * wc + 4 * fq + j) & 31) * 0.41524101186092029f);
#pragma unroll
        for (int ai = 0; ai < 2; ++ai)
#pragma unroll
            for (int m = 0; m < 4; ++m) { const int row = row0 + ai * HALF + m * 16; bf16_t* rowp = O + (size_t)row * ldc + col0;
                const int t = row & 4095; const float pos = (wc < 2) ? (float)(t >> 6) : (float)(t & 63);
                float cs[4], sn[4];
                if (rope) {
#pragma unroll
                    for (int j = 0; j < 4; ++j) { const float ang = pos * inv[j]; cs[j] = __cosf(ang); sn[j] = __sinf(ang); } }
#pragma unroll
                for (int bj = 0; bj < 2; ++bj) { f32x4 v0 = acc[ai][bj][m][0] * sc, v1 = acc[ai][bj][m][1] * sc;
                    if (rope) { const f32x4 a = v0, b = v1;
                        v0[0] = a[0] * cs[0] - a[1] * sn[0]; v0[1] = a[0] * sn[0] + a[1] * cs[0]; v0[2] = a[2] * cs[1] - a[3] * sn[1]; v0[3] = a[2] * sn[1] + a[3] * cs[1];
                        v1[0] = b[0] * cs[2] - b[1] * sn[2]; v1[1] = b[0] * sn[2] + b[1] * cs[2]; v1[2] = b[2] * cs[3] - b[3] * sn[3]; v1[3] = b[2] * sn[3] + b[3] * cs[3]; }
                    u32x4 w; w.x = cvt_pk_bf16(v0[0], v0[1]); w.y = cvt_pk_bf16(v0[2], v0[3]); w.z = cvt_pk_bf16(v1[0], v1[1]); w.w = cvt_pk_bf16(v1[2], v1[3]);
                    if (is_nk) { const int c = col0 + bj * HALF - 7168, h = c >> 7, d = c & 127;
                        *(u32x4*)(KF + ((size_t)(h * 1088 + (row >> 3)) * 4 + (d >> 5)) * 512 + (row & 7) * 64 + ((d >> 3) & 3) * 16) = w; }
                    else *(u32x4*)(rowp + bj * HALF) = w; } }
    }
};
struct EpiF32Plain {
    static constexpr bool PERM = false, AFTER_DRAIN = false;
    float* C; int ldc; float oscale;
    __device__ __forceinline__ void operator()(const f32x4 (&acc)[2][2][4][2], const Unit& u, int wr, int wc, int fr, int fq) const {
        const int row0 = u.pm * BM + wr * 64 + fr, col0 = u.pn * BM + wc * 32 + 4 * fq;
#pragma unroll
        for (int ai = 0; ai < 2; ++ai)
#pragma unroll
            for (int m = 0; m < 4; ++m) { float* rowp = C + (size_t)(row0 + ai * HALF + m * 16) * ldc + col0;
#pragma unroll
                for (int bj = 0; bj < 2; ++bj)
#pragma unroll
                    for (int n = 0; n < 2; ++n) *(f32x4*)(rowp + bj * HALF + n * 16) = acc[ai][bj][m][n] * oscale; }
    }
};
template <bool SC> struct EpiPartial {
    static constexpr bool PERM = true, AFTER_DRAIN = false;
    float* P; int pm0; float oscale;
    __device__ __forceinline__ void operator()(const f32x4 (&acc)[2][2][4][2], const Unit& u, int wr, int wc, int fr, int fq) const {
        const int row0 = (u.pm - pm0) * BM + wr * 64 + fr, col0 = u.pn * BM + wc * 32 + 8 * fq; float* base = P + (size_t)u.aux * 512 * 2048;
#pragma unroll
        for (int ai = 0; ai < 2; ++ai)
#pragma unroll
            for (int m = 0; m < 4; ++m) { float* rowp = base + (size_t)(row0 + ai * HALF + m * 16) * 2048 + col0;
#pragma unroll
                for (int bj = 0; bj < 2; ++bj)
#pragma unroll
                    for (int n = 0; n < 2; ++n) *(f32x4*)(rowp + bj * HALF + n * 4) = SC ? acc[ai][bj][m][n] * oscale : acc[ai][bj][m][n]; }
    }
};
struct EpiGate {
    static constexpr bool PERM = true, AFTER_DRAIN = false;
    const unsigned char* Ug; int ldu;
    const float* gb;
    bf16_t* ZB;
    unsigned char* ZT;
    bf16_t* ZBP;
    __device__ __forceinline__ void operator()(const f32x4 (&acc)[2][2][4][2], const Unit& u, int wr, int wc, int fr, int fq) const {
        const int row0 = u.pm * BM + wr * 64 + fr, col0 = u.pn * BM + wc * 32 + 8 * fq, br = u.aux & 3; const bool first = u.aux == 0 || u.aux >= 4;
        const unsigned char* Ub = Ug + ((size_t)(u.pm * 24 + br * 8 + u.pn) * 8 * 512 + (size_t)((wr * 4 + wc) * 64 + fq * 16 + fr)) * 16; const float* gbb = gb + 2048 * br + col0;
        bf16_t* zb = (u.aux >= 4 ? ZBP + ((size_t)br * 512 - 8192) * 2048 : ZB) + col0;
        const bool tm_wr = u.aux < 2;
        unsigned char* zt = ZT + ((size_t)(u.pm * 8 + u.pn) * 16 * 512 + (size_t)((wr * 4 + wc) * 64 + fq * 16 + fr)) * 16;
        f32x4 b4[2][2];
#pragma unroll
        for (int bj = 0; bj < 2; ++bj)
#pragma unroll
            for (int n = 0; n < 2; ++n) b4[bj][n] = *(const f32x4*)(gbb + bj * HALF + n * 4);
#pragma unroll
        for (int ai = 0; ai < 2; ++ai) {
            u32x4 gl[4]; u32x4 zp[4][2];
#pragma unroll
            for (int m = 0; m < 4; ++m) { const size_t row = (size_t)(row0 + ai * HALF + m * 16); gl[m] = *(const u32x4*)(Ub + (size_t)(ai * 4 + m) * 512 * 16);
#pragma unroll
                for (int bj = 0; bj < 2; ++bj) { if (!first) zp[m][bj] = *(const u32x4*)(zt + (size_t)((ai * 4 + m) * 2 + bj) * 512 * 16); } }
            (void)0;
#pragma unroll
            for (int m = 0; m < 4; ++m) { const size_t row = (size_t)(row0 + ai * HALF + m * 16);
#pragma unroll
                for (int bj = 0; bj < 2; ++bj) { u32x2 g2; g2.x = bj ? gl[m].z : gl[m].x; g2.y = bj ? gl[m].w : gl[m].y; f32x4 v0 = acc[ai][bj][m][0], v1 = acc[ai][bj][m][1];
                    const f32x2 ga = __builtin_amdgcn_cvt_pk_f32_fp8((int)g2.x, false), gb2 = __builtin_amdgcn_cvt_pk_f32_fp8((int)g2.x, true), gc = __builtin_amdgcn_cvt_pk_f32_fp8((int)g2.y, false), gd = __builtin_amdgcn_cvt_pk_f32_fp8((int)g2.y, true);
                    v0[0] *= fast_sigmoid(ga[0] + b4[bj][0][0]); v0[1] *= fast_sigmoid(ga[1] + b4[bj][0][1]); v0[2] *= fast_sigmoid(gb2[0] + b4[bj][0][2]); v0[3] *= fast_sigmoid(gb2[1] + b4[bj][0][3]);
                    v1[0] *= fast_sigmoid(gc[0] + b4[bj][1][0]); v1[1] *= fast_sigmoid(gc[1] + b4[bj][1][1]); v1[2] *= fast_sigmoid(gd[0] + b4[bj][1][2]); v1[3] *= fast_sigmoid(gd[1] + b4[bj][1][3]);
                    if (!first) { const u32x4 z4 = zp[m][bj]; v0[0] += bf_lo(z4.x); v0[1] += bf_hi(z4.x); v0[2] += bf_lo(z4.y); v0[3] += bf_hi(z4.y); v1[0] += bf_lo(z4.z); v1[1] += bf_hi(z4.z); v1[2] += bf_lo(z4.w); v1[3] += bf_hi(z4.w); }
                    u32x4 w; w.x = cvt_pk_bf16(v0[0], v0[1]); w.y = cvt_pk_bf16(v0[2], v0[3]); w.z = cvt_pk_bf16(v1[0], v1[1]); w.w = cvt_pk_bf16(v1[2], v1[3]);
                    if (tm_wr) *(u32x4*)(zt + (size_t)((ai * 4 + m) * 2 + bj) * 512 * 16) = w; else *(u32x4*)(zb + row * 2048 + bj * HALF) = w; } }
            asm volatile("" ::: "memory"); }
    }
};
template <bool SC> struct EpiRes {
    static constexpr bool PERM = true, AFTER_DRAIN = false;
    const float* res_lat; const float* res_ctx; const float* gv; int gstride; float* out; float alpha, oscale;
    __device__ __forceinline__ void operator()(const f32x4 (&acc)[2][2][4][2], const Unit& u, int wr, int wc, int fr, int fq) const {
        const int grp = u.pm < 16 ? 0 : (u.pm < 32 ? 1 : 2);
        const int rl0 = wr * 64 + fr, col0 = u.pn * BM + wc * 32 + 8 * fq;
        const float* res = (u.pm < 32 ? res_lat + (size_t)u.pm * BM * 2048 : res_ctx + (size_t)(u.pm - 32) * BM * 2048) + col0;
        const float* g = gv + (size_t)grp * gstride + col0; float* o = out + (size_t)u.pm * BM * 2048 + col0;
        f32x4 g4[2][2];
#pragma unroll
        for (int bj = 0; bj < 2; ++bj)
#pragma unroll
            for (int n = 0; n < 2; ++n) g4[bj][n] = *(const f32x4*)(g + bj * HALF + n * 4);
#pragma unroll
        for (int q = 0; q < 4; ++q) {
            const int ai = q >> 1, m0 = (q & 1) * 2;
            f32x4 r4[2][2][2];
#pragma unroll
            for (int m = 0; m < 2; ++m)
#pragma unroll
                for (int bj = 0; bj < 2; ++bj)
#pragma unroll
                    for (int n = 0; n < 2; ++n) r4[m][bj][n] = *(const f32x4*)(res + (size_t)(rl0 + ai * HALF + (m0 + m) * 16) * 2048 + bj * HALF + n * 4);
#pragma unroll
            for (int m = 0; m < 2; ++m)
#pragma unroll
                for (int bj = 0; bj < 2; ++bj)
#pragma unroll
                    for (int n = 0; n < 2; ++n) *(f32x4*)(o + (size_t)(rl0 + ai * HALF + (m0 + m) * 16) * 2048 + bj * HALF + n * 4) = r4[m][bj][n] * alpha + g4[bj][n] * (SC ? acc[ai][bj][m0 + m][n] * oscale : acc[ai][bj][m0 + m][n]);
            asm volatile("" ::: "memory"); }
    }
};
template <bool SC> struct EpiDelta {
    static constexpr bool PERM = true, AFTER_DRAIN = false;
    const float* gv; int gstride; bf16_t* out; float oscale;
    __device__ __forceinline__ void operator()(const f32x4 (&acc)[2][2][4][2], const Unit& u, int wr, int wc, int fr, int fq) const {
        const int grp = u.pm < 16 ? 0 : (u.pm < 32 ? 1 : 2);
        const int row0 = u.pm * BM + wr * 64 + fr, col0 = u.pn * BM + wc * 32 + 8 * fq;
        const float* g = gv + (size_t)grp * gstride + col0;
        f32x4 g4[2][2];
#pragma unroll
        for (int bj = 0; bj < 2; ++bj)
#pragma unroll
            for (int n = 0; n < 2; ++n) { g4[bj][n] = *(const f32x4*)(g + bj * HALF + n * 4); if (SC) g4[bj][n] = g4[bj][n] * oscale; }
#pragma unroll
        for (int ai = 0; ai < 2; ++ai)
#pragma unroll
            for (int m = 0; m < 4; ++m) { bf16_t* rowp = out + (size_t)(row0 + ai * HALF + m * 16) * 2048 + col0;
#pragma unroll
                for (int bj = 0; bj < 2; ++bj) { const f32x4 v0 = acc[ai][bj][m][0] * g4[bj][0], v1 = acc[ai][bj][m][1] * g4[bj][1];
                    u32x4 w; w.x = cvt_pk_bf16(v0[0], v0[1]); w.y = cvt_pk_bf16(v0[2], v0[3]); w.z = cvt_pk_bf16(v1[0], v1[1]); w.w = cvt_pk_bf16(v1[2], v1[3]);
                    *(u32x4*)(rowp + bj * HALF) = w; } }
    }
};
struct EpiSwiGLU {
    static constexpr bool PERM = true, AFTER_DRAIN = false;
    bf16_t* O; int ldc;
    __device__ __forceinline__ void operator()(const f32x4 (&acc)[2][2][4][2], const Unit& u, int wr, int wc, int fr, int fq) const {
        const int row0 = u.pm * BM + wr * 64 + fr, col0 = u.pn * HALF + wc * 32 + 8 * fq;
#pragma unroll
        for (int ai = 0; ai < 2; ++ai)
#pragma unroll
            for (int m = 0; m < 4; ++m) { bf16_t* rowp = O + (size_t)(row0 + ai * HALF + m * 16) * ldc + col0;
                float h[8];
#pragma unroll
                for (int n = 0; n < 2; ++n)
#pragma unroll
                    for (int j = 0; j < 4; ++j) { const float gt = acc[ai][0][m][n][j], up = acc[ai][1][m][n][j]; h[n * 4 + j] = gt * fast_sigmoid(gt) * up; }
                u32x4 w; w.x = cvt_pk_bf16(h[0], h[1]); w.y = cvt_pk_bf16(h[2], h[3]); w.z = cvt_pk_bf16(h[4], h[5]); w.w = cvt_pk_bf16(h[6], h[7]);
                *(u32x4*)rowp = w; }
    }
};
struct EpiSwiGLU8 {
    static constexpr bool PERM = true, AFTER_DRAIN = false;
    unsigned char* O; int ldc; float oscale, hscale;
    __device__ __forceinline__ void operator()(const f32x4 (&acc)[2][2][4][2], const Unit& u, int wr, int wc, int fr, int fq) const {
        const int row0 = u.pm * BM + wr * 64 + fr, col0 = u.pn * HALF + wc * 32 + 8 * fq;
#pragma unroll
        for (int ai = 0; ai < 2; ++ai)
#pragma unroll
            for (int m = 0; m < 4; ++m) { unsigned char* rowp = O + (size_t)(row0 + ai * HALF + m * 16) * ldc + col0;
                float h[8];
#pragma unroll
                for (int n = 0; n < 2; ++n)
#pragma unroll
                    for (int j = 0; j < 4; ++j) { const float gt = acc[ai][0][m][n][j] * oscale, up = acc[ai][1][m][n][j] * oscale; h[n * 4 + j] = clamp448(gt * fast_sigmoid(gt) * up * hscale); }
                u32x2 w; w.x = pk_fp8x4(h[0], h[1], h[2], h[3]); w.y = pk_fp8x4(h[4], h[5], h[6], h[7]);
                *(u32x2*)rowp = w; }
    }
};

template <class Epi, class Sched, bool ALIGN_EPI = false, bool SP2 = false, bool F8 = false, bool SK = false>
__device__ __forceinline__ void gemm_phase(PG8_LAS unsigned char* lds, const Gemm g, const Sched& S, const Epi& E) {
    int tid_ = threadIdx.x; asm volatile("" : "+v"(tid_));
    const int tid = tid_, wid = __builtin_amdgcn_readfirstlane(tid >> 6), lane = tid & 63, wr = wid >> 2, wc = wid & 3, fr = lane & 15, fq = lane >> 4;
    const int K = g.K, nt0 = g.KT / BK;
    unsigned voffA[2], voffB[2];
#pragma unroll
    for (int i = 0; i < 2; ++i) { int R, C; stage_rc(tid * 16 + i * 8192, R, C); const int Rb = Epi::PERM ? ((R & ~31) + perm32(R & 31)) : R;
        voffA[i] = (unsigned)(R * K + C) * 2u; voffB[i] = (unsigned)(Rb * K + C) * 2u; }
    const size_t kstep = (size_t)(BK * 2);
    const size_t hstep = (size_t)HALF * K * 2;
    const size_t tstep = 2 * hstep;
    const unsigned ldsw = (unsigned)wid * 1024u;
    const int aoff = lds_byte(wr * 64 + fr, fq * 8), boff = lds_byte(wc * 32 + fr, fq * 8);
#define PG8_SA(b, h) (((b) * 2 + (h)) * HTB)
#define PG8_SB(b, h) ((4 + (b) * 2 + (h)) * HTB)
#define PG8_STAGE(bufoff, gbase, voff) do { _Pragma("unroll") for (int _i = 0; _i < 2; ++_i) \
        __builtin_amdgcn_global_load_lds((const unsigned*)((const char*)(gbase) + (voff)[_i]), (PG8_LAS unsigned*)(lds + (bufoff) + ldsw + _i * 8192), 16, 0, 0); } while (0)
#define PG8_CAT(p) __builtin_shufflevector(*(const PG8_LAS i32x4*)(p), *(const PG8_LAS i32x4*)((p) + 1024), 0, 1, 2, 3, 4, 5, 6, 7)
#define PG8_LDA(dst, b, h) do { _Pragma("unroll") for (int m = 0; m < 4; ++m) { if constexpr (F8) dst##8[m] = PG8_CAT(lds + PG8_SA(b, h) + aoff + m * 2048); else { _Pragma("unroll") for (int k = 0; k < 2; ++k) dst[m][k] = *(const PG8_LAS bf16x8*)(lds + PG8_SA(b, h) + aoff + m * 2048 + k * 1024); } } } while (0)
#define PG8_LDB(dst, b, h) do { _Pragma("unroll") for (int n = 0; n < 2; ++n) { if constexpr (F8) dst##8[n] = PG8_CAT(lds + PG8_SB(b, h) + boff + n * 2048); else { _Pragma("unroll") for (int k = 0; k < 2; ++k) dst[n][k] = *(const PG8_LAS bf16x8*)(lds + PG8_SB(b, h) + boff + n * 2048 + k * 1024); } } } while (0)
#define PG8_MMA(ai, bj, At, Bt) do { __builtin_amdgcn_s_setprio(1); _Pragma("unroll") for (int m = 0; m < 4; ++m) _Pragma("unroll") for (int n = 0; n < 2; ++n) { \
        if constexpr (F8) asm volatile("v_mfma_f32_16x16x128_f8f6f4 %0, %1, %2, %0" : "+v"(acc[ai][bj][m][n]) : "v"(Bt##8[n]), "v"(At##8[m]));       \
        else { _Pragma("unroll") for (int k = 0; k < 2; ++k) acc[ai][bj][m][n] = __builtin_amdgcn_mfma_f32_16x16x32_bf16(Bt[n][k], At[m][k], acc[ai][bj][m][n], 0, 0, 0); } } \
        __builtin_amdgcn_s_setprio(0); } while (0)
#define PG8_GAS __attribute__((address_space(1)))
#define PG8_WAIT_V(n) asm volatile("s_waitcnt vmcnt(" #n ")" ::: "memory")
#define PG8_WAIT_L(n) asm volatile("s_waitcnt lgkmcnt(" #n ")" ::: "memory")
#define PG8_BAR __builtin_amdgcn_s_barrier()
#define PG8_SCHED __builtin_amdgcn_sched_barrier(0)
    Unit cur, nxt; int ui = 0;
    if (!S.next(0, cur)) return;
    f32x4 acc[2][2][4][2];
#pragma unroll
    for (int a = 0; a < 2; ++a)
#pragma unroll
        for (int b = 0; b < 2; ++b)
#pragma unroll
            for (int m = 0; m < 4; ++m)
#pragma unroll
                for (int n = 0; n < 2; ++n) acc[a][b][m][n] = (f32x4){0.f, 0.f, 0.f, 0.f};
    const int f8one = 0x7f7f7f7f;
    bf16x8 At[4][2], B0[2][2], B1[2][2];
    i32x8 At8[4], B08[2], B18[2];
    const char* cA = (const char*)g.A + (size_t)cur.pa * tstep + (size_t)cur.ko * 2; const char* cB = (const char*)g.Bt + (size_t)cur.pb * tstep + (size_t)cur.ko * 2;
    S.a_ready(cur);
    if constexpr (SP2) {
        PG8_STAGE(PG8_SB(0, 0), cB, voffB); PG8_STAGE(PG8_SB(0, 1), cB + hstep, voffB); PG8_STAGE(PG8_SA(0, 0), cA, voffA); PG8_STAGE(PG8_SA(0, 1), cA + hstep, voffA);
        if (wr == 1) PG8_BAR;
        PG8_WAIT_V(2); PG8_BAR;
        PG8_STAGE(PG8_SB(1, 0), cB + kstep, voffB); PG8_STAGE(PG8_SA(1, 0), cA + kstep, voffA); PG8_STAGE(PG8_SB(1, 1), cB + hstep + kstep, voffB);
        PG8_WAIT_V(6); PG8_BAR;
    } else {
        PG8_STAGE(PG8_SB(0, 0), cB, voffB); PG8_STAGE(PG8_SA(0, 0), cA, voffA); PG8_STAGE(PG8_SB(0, 1), cB + hstep, voffB); PG8_STAGE(PG8_SA(0, 1), cA + hstep, voffA);
        if (wr == 1) PG8_BAR;
        PG8_WAIT_V(4); PG8_BAR;
        PG8_STAGE(PG8_SB(1, 0), cB + kstep, voffB); PG8_STAGE(PG8_SA(1, 0), cA + kstep, voffA); PG8_STAGE(PG8_SB(1, 1), cB + hstep + kstep, voffB);
        PG8_WAIT_V(6); PG8_BAR;
    }
    for (;;) {
        const bool has_next = S.next(ui + 1, nxt);
        const char* nA = has_next ? (const char*)g.A + (size_t)nxt.pa * tstep + (size_t)nxt.ko * 2 : cA; const char* nB = has_next ? (const char*)g.Bt + (size_t)nxt.pb * tstep + (size_t)nxt.ko * 2 : cB;
        const int nt = SK ? (int)(((unsigned)cur.sk >> 24) & 0xffu) : nt0;
        for (int t = 0; t < nt; t += 2) {
            const bool last = (t == nt - 2);
            const char* a1 = cA + (size_t)(t + 1) * kstep;
            const char* a2 = last ? nA : cA + (size_t)(t + 2) * kstep; const char* b2 = last ? nB : cB + (size_t)(t + 2) * kstep;
            const char* a3 = a2 + kstep; const char* b3 = b2 + kstep;
            if (last && has_next) S.a_ready(nxt);
            if constexpr (SP2) {
            PG8_LDB(B0, 0, 0); PG8_LDB(B1, 0, 1); PG8_SCHED; PG8_LDA(At, 0, 0); PG8_STAGE(PG8_SA(1, 1), a1 + hstep, voffA);
            PG8_WAIT_V(8); PG8_WAIT_L(0); PG8_BAR; PG8_MMA(0, 0, At, B0); PG8_MMA(0, 1, At, B1); PG8_BAR; PG8_SCHED;
            PG8_LDA(At, 0, 1); PG8_STAGE(PG8_SB(0, 0), b2, voffB); PG8_STAGE(PG8_SB(0, 1), b2 + hstep, voffB); PG8_STAGE(PG8_SA(0, 0), a2, voffA);
            PG8_WAIT_V(8); PG8_WAIT_L(0); PG8_BAR; PG8_MMA(1, 0, At, B0); PG8_MMA(1, 1, At, B1); PG8_BAR; PG8_SCHED;
            PG8_LDB(B0, 1, 0); PG8_LDB(B1, 1, 1); PG8_SCHED; PG8_LDA(At, 1, 0); PG8_STAGE(PG8_SA(0, 1), a2 + hstep, voffA);
            PG8_WAIT_V(8); PG8_WAIT_L(0); PG8_BAR; PG8_MMA(0, 0, At, B0); PG8_MMA(0, 1, At, B1); PG8_BAR; PG8_SCHED;
            PG8_LDA(At, 1, 1); PG8_STAGE(PG8_SB(1, 0), b3, voffB); PG8_STAGE(PG8_SB(1, 1), b3 + hstep, voffB); PG8_STAGE(PG8_SA(1, 0), a3, voffA);
            PG8_WAIT_V(8); PG8_WAIT_L(0); PG8_BAR; PG8_MMA(1, 0, At, B0); PG8_MMA(1, 1, At, B1); PG8_BAR; PG8_SCHED;
            } else {
            PG8_LDB(B0, 0, 0); PG8_SCHED; PG8_LDA(At, 0, 0); PG8_STAGE(PG8_SA(1, 1), a1 + hstep, voffA);
            PG8_WAIT_L(8); PG8_BAR; PG8_WAIT_L(0); PG8_MMA(0, 0, At, B0); PG8_BAR; PG8_SCHED;
            PG8_LDB(B1, 0, 1); PG8_STAGE(PG8_SB(0, 0), b2, voffB);
            PG8_BAR; PG8_WAIT_L(0); PG8_MMA(0, 1, At, B1); PG8_BAR;
            PG8_LDA(At, 0, 1); PG8_STAGE(PG8_SA(0, 0), a2, voffA);
            PG8_BAR; PG8_WAIT_L(0); PG8_MMA(1, 0, At, B0); PG8_BAR; PG8_SCHED;
            PG8_STAGE(PG8_SB(0, 1), b2 + hstep, voffB);
            PG8_WAIT_V(6); PG8_BAR; PG8_MMA(1, 1, At, B1); PG8_BAR;
            PG8_LDB(B0, 1, 0); PG8_SCHED; PG8_LDA(At, 1, 0); PG8_STAGE(PG8_SA(0, 1), a2 + hstep, voffA);
            PG8_WAIT_L(8); PG8_BAR; PG8_WAIT_L(0); PG8_MMA(0, 0, At, B0); PG8_BAR; PG8_SCHED;
            PG8_LDB(B1, 1, 1); PG8_STAGE(PG8_SB(1, 0), b3, voffB);
            PG8_BAR; PG8_WAIT_L(0); PG8_MMA(0, 1, At, B1); PG8_BAR;
            PG8_LDA(At, 1, 1); PG8_STAGE(PG8_SA(1, 0), a3, voffA);
            PG8_BAR; PG8_WAIT_L(0); PG8_MMA(1, 0, At, B0); PG8_BAR; PG8_SCHED;
            PG8_STAGE(PG8_SB(1, 1), b3 + hstep, voffB);
            PG8_WAIT_V(6); PG8_BAR; PG8_MMA(1, 1, At, B1); PG8_BAR;
            }
        }
        if constexpr (F8) asm volatile("s_nop 15\n\ts_nop 15\n\ts_nop 15" ::: "memory");
        if constexpr (ALIGN_EPI) { if (wr == 0) PG8_BAR; }
        if constexpr (SK) {
            const unsigned sk_ = (unsigned)cur.sk; const int ri_ = (int)(sk_ & 0xffffu), s_ = (int)((sk_ >> 16) & 15u), S_ = (int)((sk_ >> 20) & 15u);
            float* const part = g.skpart + (size_t)ri_ * (size_t)S_ * 65536; unsigned* const cntp = g.skcnt + ri_;
            { float* const ps = part + (size_t)s_ * 65536;
#pragma unroll
              for (int a = 0; a < 2; ++a)
#pragma unroll
                  for (int b = 0; b < 2; ++b)
#pragma unroll
                      for (int mh = 0; mh < 2; ++mh) { PG8_GAS f32x4* pg = (PG8_GAS f32x4*)(ps + (size_t)((a * 2 + b) * 2 + mh) * 8192) + tid * 4;
#pragma unroll
                          for (int q = 0; q < 4; ++q) pg[q] = acc[a][b][2 * mh + (q >> 1)][q & 1]; } }
            asm volatile("s_waitcnt vmcnt(0)" ::: "memory"); __syncthreads();
            if (s_ < S_ - 1) {
                if (tid == 0) { __builtin_amdgcn_fence(__ATOMIC_RELEASE, "agent"); asm volatile("s_waitcnt vmcnt(0)" ::: "memory"); (void)__hip_atomic_fetch_add(cntp, 1u, __ATOMIC_RELAXED, __HIP_MEMORY_SCOPE_AGENT); }
            } else {
                if (tid == 0) { unsigned sp_ = 0u; while (__hip_atomic_load(cntp, __ATOMIC_RELAXED, __HIP_MEMORY_SCOPE_AGENT) < (unsigned)(S_ - 1) && ++sp_ < (1u << 22)) __builtin_amdgcn_s_sleep(1);
                    __builtin_amdgcn_fence(__ATOMIC_ACQUIRE, "agent"); asm volatile("s_waitcnt vmcnt(0)" ::: "memory"); }
                __syncthreads();
                for (int s2 = 0; s2 < S_ - 1; ++s2) { const float* const ps = part + (size_t)s2 * 65536;
#pragma unroll
                    for (int a = 0; a < 2; ++a)
#pragma unroll
                        for (int b = 0; b < 2; ++b) { f32x4 t_[8];
#pragma unroll
                            for (int mh = 0; mh < 2; ++mh) { const PG8_GAS f32x4* pg = (const PG8_GAS f32x4*)(ps + (size_t)((a * 2 + b) * 2 + mh) * 8192) + tid * 4;
#pragma unroll
                                for (int q = 0; q < 4; ++q) t_[mh * 4 + q] = pg[q]; }
#pragma unroll
                            for (int mh = 0; mh < 2; ++mh)
#pragma unroll
                                for (int q = 0; q < 4; ++q) acc[a][b][2 * mh + (q >> 1)][q & 1] += t_[mh * 4 + q];
                            asm volatile("" ::: "memory"); } }
                E(acc, cur, wr, wc, fr, fq);
            }
        } else {
        if constexpr (!Epi::AFTER_DRAIN) { E(acc, cur, wr, wc, fr, fq); S.done(cur); }
        }
        if (!has_next) break;
#pragma unroll
        for (int a = 0; a < 2; ++a)
#pragma unroll
            for (int b = 0; b < 2; ++b)
#pragma unroll
                for (int m = 0; m < 4; ++m)
#pragma unroll
                    for (int n = 0; n < 2; ++n) acc[a][b][m][n] = (f32x4){0.f, 0.f, 0.f, 0.f};
        cur = nxt; cA = nA; cB = nB; ++ui;
        if constexpr (ALIGN_EPI) { if (wr == 1) PG8_BAR; }
    }
    PG8_WAIT_V(0);
    if constexpr (!ALIGN_EPI) { if (wr == 0) PG8_BAR; }
    PG8_BAR;
    if constexpr (Epi::AFTER_DRAIN) { E.fused(acc, cur, wr, wc, fr, fq, lds, wid, lane); S.done(cur); }
#undef PG8_SA
#undef PG8_SB
#undef PG8_STAGE
#undef PG8_CAT
#undef PG8_LDA
#undef PG8_LDB
#undef PG8_MMA
#undef PG8_WAIT_V
#undef PG8_WAIT_L
#undef PG8_BAR
#undef PG8_SCHED
#undef PG8_GAS
}
}

constexpr int NWAVES = 8, NTHR = 512;
constexpr int D = 2048, SEQ = 4096, NLAT = 8192, CTXL = 256, NCTX = 512, MROWS = 8704, DEPTH = 2;
constexpr int INC = 15392, NU = 15360;
constexpr int U_CB = 0, U_CC = 1024, U_CX = 2048, U_GQ = 3072, U_GK = 3584, U_GV = 4096, U_GR = 5120, U_NQ = 6144, U_NK = 7168, U_NV = 8192, U_GATE = 9216;
constexpr int LR_COL = 6144;
constexpr int FF = 5632, NGU = 2 * FF, NE = 8;
constexpr float LN_EPS = 1e-5f, ALPHA = 1.41421356237f;
constexpr float FSC_WGU = 64.0f, FSC_WD = 128.0f, FSC_HID = 4.0f;
constexpr int MOE_MAXP = 72;

constexpr size_t MiB = 1u << 20;
constexpr size_t WS_CTL = 0, CTL_ZERO_BYTES = 1 * MiB;
constexpr size_t WS_MOD = 1 * MiB;
constexpr size_t WS_WLR = 1 * MiB + 512 * 1024;
constexpr size_t WS_ROUTE = 2 * MiB;
constexpr size_t WS_TOK = 2 * MiB + 256 * 1024;
constexpr size_t WS_LR = 3 * MiB;
constexpr size_t WS_W = 8 * MiB;
constexpr size_t W_IN_B = (size_t)NU * D * 2, W_BR_B = (size_t)1024 * D * 2, W_OUT_B = (size_t)D * D * 2, W_LAYER_B = W_IN_B + 3 * W_BR_B + W_OUT_B;
constexpr size_t W_GU_B = (size_t)NGU * D * 2, W_D_B = (size_t)D * FF * 2, W_FFN_B = W_GU_B + W_D_B;
constexpr size_t WS_WFFN = WS_W + 2 * W_LAYER_B, WS_WMOE = WS_WFFN + W_FFN_B, WS_WEND = WS_WMOE + 8 * W_FFN_B;
constexpr size_t WS_XL = 762 * MiB;
constexpr size_t WS_H = 830 * MiB;
constexpr size_t WS_U = 864 * MiB;
constexpr size_t WS_Y = 1119 * MiB;
constexpr size_t WS_GLA = 1170 * MiB;
constexpr size_t WS_Z = 1306 * MiB;
constexpr size_t WS_ZB = 1374 * MiB;
constexpr size_t WS_PRE = 1408 * MiB;
constexpr size_t WS_PART = 1476 * MiB;
constexpr size_t WS_ZBP = 1572 * MiB;
constexpr size_t WS_UG8 = 1580 * MiB;
constexpr size_t WS_KF = 1540 * MiB;
constexpr size_t WS_END = 1632 * MiB;
static_assert(WS_WEND <= WS_XL && WS_XL + (size_t)MROWS * D * 4 <= WS_H && WS_H + (size_t)MROWS * D * 2 <= WS_U && WS_U + (size_t)MROWS * NU * 2 <= WS_Y, "ws map 1");
static_assert(WS_U + (size_t)MOE_MAXP * 256 * FF * 2 <= WS_Y && WS_Y + 3 * (size_t)MROWS * 1024 * 2 <= WS_GLA && WS_GLA + (size_t)MROWS * (4 * 512 + 2 * 1024) * 4 <= WS_Z, "ws map 2");
static_assert(WS_GLA + (size_t)MOE_MAXP * 256 * D * 2 <= WS_Z && WS_Z + (size_t)MOE_MAXP * 256 * D * 4 <= WS_END && WS_PRE + (size_t)MROWS * D * 4 <= WS_END, "ws map 3");
constexpr int CW_TMO = 0, CW_CODE = 1;
constexpr int CW_MOECNT = 64;
constexpr int CW_BAR = 4096, CW_SK = 16384;

constexpr int RING_OFF = 0, RING_BYTES = 131072;
constexpr int LDSCTL_OFF = RING_BYTES, MISC_OFF = LDSCTL_OFF + 320;
constexpr int LDS_BYTES = 147456;

#define GAS __attribute__((address_space(1)))
#define LAS __attribute__((address_space(3)))
typedef unsigned short bf16;
typedef unsigned v4u __attribute__((ext_vector_type(4)));
typedef unsigned v2u __attribute__((ext_vector_type(2)));
typedef float f32x4 __attribute__((ext_vector_type(4)));
typedef GAS unsigned gu32;
typedef short bf16x8v __attribute__((ext_vector_type(8)));
#define RLX_AGENT __ATOMIC_RELAXED, __HIP_MEMORY_SCOPE_AGENT
#define LDS_WAIT() asm volatile("s_waitcnt lgkmcnt(0)" ::: "memory")
#define VM_WAIT() asm volatile("s_waitcnt vmcnt(0)" ::: "memory")
__device__ __forceinline__ unsigned f2bf(float f) { unsigned u = __builtin_bit_cast(unsigned, f); return (u + 0x7fffu + ((u >> 16) & 1u)) >> 16; }
typedef __bf16 bf16x2_t __attribute__((ext_vector_type(2)));
__device__ __forceinline__ unsigned pk2(float lo, float hi) { const bf16x2_t v = {(__bf16)lo, (__bf16)hi}; return __builtin_bit_cast(unsigned, v); }
__device__ __forceinline__ float bflo(unsigned w) { return __uint_as_float(w << 16); }
__device__ __forceinline__ float bfhi(unsigned w) { return __uint_as_float(w & 0xffff0000u); }
__device__ __forceinline__ float bf1(bf16 b) { return __uint_as_float(((unsigned)b) << 16); }
__device__ __forceinline__ float wave_sum(float v) {
#pragma unroll
    for (int o = 1; o < 64; o <<= 1) v += __shfl_xor(v, o);
    return v;
}
__device__ __forceinline__ float wave_max(float v) {
#pragma unroll
    for (int o = 1; o < 64; o <<= 1) v = fmaxf(v, __shfl_xor(v, o));
    return v;
}

#define XB_TMO      128
#define XB_XCNT(j)  (256  + 64 * (j))
#define XB_XSUB(j)  (1280 + 64 * (j))
#define XB_XGEN(j)  (2304 + 64 * (j))
#define XB_TOP      3328
#define XB_TOPGEN   3392
#define XCD_BAR_WORDS 3456
#define XB_SPIN_CAP (1u << 18)

__device__ __forceinline__ unsigned xb_ld(unsigned* p)              { return __hip_atomic_load(p, __ATOMIC_RELAXED, __HIP_MEMORY_SCOPE_AGENT); }
__device__ __forceinline__ unsigned xb_add(unsigned* p, unsigned v) { return __hip_atomic_fetch_add(p, v, __ATOMIC_RELAXED, __HIP_MEMORY_SCOPE_AGENT); }
__device__ __forceinline__ unsigned xb_xcc_id() { return (unsigned)__builtin_amdgcn_s_getreg((3 << 11) | 20) & 0xFu; }
#define XB_SPIN(cond, bar) do { unsigned _sp = 0; while (cond) { __builtin_amdgcn_s_sleep(1); \
    if ((++_sp & 255u) == 0u) { if (xb_ld(&(bar)[XB_TMO])) break; if (_sp > XB_SPIN_CAP) { atomicAdd(&(bar)[XB_TMO], 1u); break; } } } } while (0)

struct XcdBarrier {
    unsigned* bar; unsigned x; unsigned grid;
    volatile LAS unsigned* st;
};

__device__ __forceinline__ XcdBarrier xcd_barrier_post(unsigned* bar, volatile LAS unsigned* st, unsigned grid) {
    XcdBarrier b; b.grid = grid; b.bar = bar; b.x = xb_xcc_id(); b.st = st;
    if (threadIdx.x == 0) (void)xb_add(&bar[XB_XCNT(b.x)], 1u);
    return b;
}
__device__ __forceinline__ void xcd_barrier_complete(unsigned* bar, unsigned x, unsigned& nloc, unsigned& nx, unsigned b_grid) {
    const unsigned G = b_grid;
    unsigned sum, cnt, mine, sp = 0u;
    for (;;) {
        sum = 0u; cnt = 0u; mine = 0u;
#pragma unroll
        for (unsigned j = 0; j < 16; ++j) { const unsigned c = xb_ld(&bar[XB_XCNT(j)]); sum += c; cnt += (c > 0u) ? 1u : 0u; mine = (j == x) ? c : mine; }
        if (sum == G) break;
        __builtin_amdgcn_s_sleep(1);
        if ((++sp & 255u) == 0u) { if (xb_ld(&bar[XB_TMO])) break; if (sp > XB_SPIN_CAP) { atomicAdd(&bar[XB_TMO], 1u); break; } }
    }
    nloc = mine > 0u ? mine : 1u; nx = cnt > 0u ? cnt : 1u;
}

__device__ __forceinline__ void xcd_barrier(const XcdBarrier& b) {
    asm volatile("s_waitcnt vmcnt(0)" ::: "memory");
    __syncthreads();
    if (threadIdx.x == 0) {
        unsigned* bar = b.bar;
        __builtin_amdgcn_s_waitcnt(0);
        unsigned nloc = b.st[0], nx = b.st[1];
        if (nloc == 0u) { xcd_barrier_complete(bar, b.x, nloc, nx, b.grid); b.st[0] = nloc; b.st[1] = nx; }
        const unsigned old = xb_add(&bar[XB_XSUB(b.x)], 1u);
        const unsigned gen = old / nloc;
        if (old + 1u == (gen + 1u) * nloc) {
            __builtin_amdgcn_fence(__ATOMIC_RELEASE, "agent");
            asm volatile("s_waitcnt vmcnt(0)" ::: "memory");
            const unsigned og = xb_add(&bar[XB_TOP], 1u);
            const unsigned tg = og / nx;
            if (og + 1u == (tg + 1u) * nx) xb_add(&bar[XB_TOPGEN], 1u);
            else XB_SPIN(xb_ld(&bar[XB_TOPGEN]) == tg, bar);
            __builtin_amdgcn_fence(__ATOMIC_ACQUIRE, "agent");
            xb_add(&bar[XB_XGEN(b.x)], 1u);
            asm volatile("s_waitcnt vmcnt(0)" ::: "memory");
        } else {
            XB_SPIN(xb_ld(&bar[XB_XGEN(b.x)]) == gen, bar);
            __builtin_amdgcn_fence(__ATOMIC_ACQUIRE, "agent");
            asm volatile("s_waitcnt vmcnt(0)" ::: "memory");
        }
    }
    __syncthreads();
}

struct Args { const float* in[30]; float* out; unsigned char* ws; int ph_lo, ph_hi, grid, pad; };
struct Frame {
    LAS unsigned char* lds;
    volatile LAS unsigned* MISC;
    int tid, lane, wave, vcu, G, bx;
};
__device__ __forceinline__ Frame mkframe(LAS unsigned char* lds, int grid) {
    Frame F; int t = threadIdx.x; asm volatile("" : "+v"(t)); int g = grid, bx = blockIdx.x; asm volatile("" : "+s"(g), "+s"(bx));
    F.lds = lds; F.MISC = (volatile LAS unsigned*)(lds + MISC_OFF); F.tid = t; F.lane = t & 63; F.wave = __builtin_amdgcn_readfirstlane(t >> 6); F.G = g; F.bx = bx;
    F.vcu = (g % 8 == 0) ? (bx % 8) * (g / 8) + bx / 8 : bx; return F;
}
constexpr int PTAB_OFF = LDSCTL_OFF + 1024, PT_OUT = 30, PT_WS = 31;
__device__ __forceinline__ unsigned long long ldp_raw(Frame& F, int i) {
    const volatile LAS unsigned* t = (const volatile LAS unsigned*)(F.lds + PTAB_OFF) + 2 * i; const unsigned lo = t[0], hi = t[1];
    return ((unsigned long long)(unsigned)__builtin_amdgcn_readfirstlane((int)hi) << 32) | (unsigned)__builtin_amdgcn_readfirstlane((int)lo);
}
#define PIN(i) ((const float*)(const GAS float*)ldp_raw(F, (i)))
#define POUT() ((float*)(GAS float*)ldp_raw(F, PT_OUT))
#define PWS() ((unsigned char*)(GAS unsigned char*)ldp_raw(F, PT_WS))
__device__ __forceinline__ bf16* w_in_t(unsigned char* ws, int L) { return (bf16*)(ws + WS_W + (size_t)L * W_LAYER_B); }
__device__ __forceinline__ bf16* w_br_t(unsigned char* ws, int L, int b) { return (bf16*)(ws + WS_W + (size_t)L * W_LAYER_B + W_IN_B + (size_t)b * W_BR_B); }
__device__ __forceinline__ bf16* w_out_t(unsigned char* ws, int L) { return (bf16*)(ws + WS_W + (size_t)L * W_LAYER_B + W_IN_B + 3 * W_BR_B); }
__device__ __forceinline__ unsigned char* w_gu_t(unsigned char* ws, int e) { return ws + (e < 0 ? WS_WFFN : WS_WMOE + (size_t)e * (W_GU_B / 2)); }
__device__ __forceinline__ unsigned char* w_d_t(unsigned char* ws, int e) { return ws + (e < 0 ? WS_WFFN + W_GU_B : WS_WMOE + 8 * W_GU_B + (size_t)e * (W_D_B / 2)); }

template <int MODE> __device__ __forceinline__ int conv_drow(int nb) {
    if (MODE == 0) return 32 * nb;
    if (MODE == 1) return nb < LR_COL / 32 ? 32 * nb : 32 * (nb - 1);
    if (MODE == 2) return 256 * (nb >> 2) + 32 * (nb & 3);
    return 256 * (nb >> 2) + 128 + 32 * (nb & 3);
}
__device__ __forceinline__ void conv_load(const float* W, int N, int nblk, int it, int lane, f32x4 (&w)[8]) {
    const int kb = it / nblk, nb = it % nblk; const float* p = W + (size_t)(64 * kb + (lane >> 3)) * N + 32 * nb + (lane & 7) * 4;
#pragma unroll
    for (int i = 0; i < 8; ++i) w[i] = __builtin_nontemporal_load((const GAS f32x4*)(p + (size_t)(8 * i) * N));
}
template <int MODE, bool F8> __device__ __forceinline__ void conv_finish(const f32x4 (&w)[8], LAS float* scr, int lane, int K, int nblk, int it, void* WT, float sc) {
    const int kb = it / nblk, nb = it % nblk, k0 = 64 * kb;
    if (MODE == 1 && nb == LR_COL / 32) return;
    const int drow = conv_drow<MODE>(nb);
#pragma unroll
    for (int i = 0; i < 8; ++i) { LAS float* s = scr + (8 * i + (lane >> 3)) * 33 + (lane & 7) * 4; s[0] = w[i][0]; s[1] = w[i][1]; s[2] = w[i][2]; s[3] = w[i][3]; }
    LDS_WAIT(); asm volatile("" ::: "memory");
    const int c = lane & 7;
#pragma unroll
    for (int j = 0; j < 4; ++j) { const int n = (lane >> 3) + 8 * j; const LAS float* s = scr + (8 * c) * 33 + n;
        if (F8) { v2u o; o.x = pg8::pk_fp8x4(s[0 * 33] * sc, s[1 * 33] * sc, s[2 * 33] * sc, s[3 * 33] * sc); o.y = pg8::pk_fp8x4(s[4 * 33] * sc, s[5 * 33] * sc, s[6 * 33] * sc, s[7 * 33] * sc);
            __builtin_nontemporal_store(o, (GAS v2u*)((unsigned char*)WT + (size_t)(drow + n) * K + k0 + 8 * c)); }
        else { v4u o; o.x = pk2(s[0 * 33], s[1 * 33]); o.y = pk2(s[2 * 33], s[3 * 33]); o.z = pk2(s[4 * 33], s[5 * 33]); o.w = pk2(s[6 * 33], s[7 * 33]);
            __builtin_nontemporal_store(o, (GAS v4u*)((bf16*)WT + (size_t)(drow + n) * K + k0 + 8 * c)); } }
    LDS_WAIT(); asm volatile("" ::: "memory");
}
template <int MODE, bool F8> __device__ __forceinline__ void conv_matrix_t(Frame& F, const float* W, int K, int N, void* WT, float sc) {
    LAS float* scr = (LAS float*)(F.lds + RING_OFF + F.wave * 16384);
    const int gw = F.vcu * NWAVES + F.wave, NGW = F.G * NWAVES, lane = F.lane;
    const int nblk = N / 32, nitems = (K / 64) * nblk;
    f32x4 w0[8], w1[8];
    if (gw < nitems) conv_load(W, N, nblk, gw, lane, w0);
    if (gw + NGW < nitems) conv_load(W, N, nblk, gw + NGW, lane, w1);
    for (int it = gw; it < nitems; it += 2 * NGW) {
        f32x4 n0[8], n1[8];
        if (it + 2 * NGW < nitems) conv_load(W, N, nblk, it + 2 * NGW, lane, n0);
        if (it + 3 * NGW < nitems) conv_load(W, N, nblk, it + 3 * NGW, lane, n1);
        conv_finish<MODE, F8>(w0, scr, lane, K, nblk, it, WT, sc);
        if (it + NGW < nitems) conv_finish<MODE, F8>(w1, scr, lane, K, nblk, it + NGW, WT, sc);
#pragma unroll
        for (int i = 0; i < 8; ++i) { w0[i] = n0[i]; w1[i] = n1[i]; }
    }
}
template <int MODE> __device__ __forceinline__ void conv_matrix8(Frame& F, const float* W, int K, int N, unsigned char* WT, float sc) { conv_matrix_t<MODE, true>(F, W, K, N, WT, sc); }
template <int MODE> __device__ __forceinline__ void conv_matrix(Frame& F, const float* W, int K, int N, bf16* WT) { conv_matrix_t<MODE, false>(F, W, K, N, WT, 1.0f); }
__device__ __forceinline__ void ada_item(Frame& F, unsigned char* ws, const float* cnd, const float* cctx, const float* ada_w, const float* ada_b, int item) {
    const int L = item / 96, c0 = (item % 96) * 128;
    LAS float* sc = (LAS float*)(F.lds + RING_OFF);
    LAS float* red = (LAS float*)(F.lds + RING_OFF + 24576);
    for (int i = F.tid; i < 3 * D; i += NTHR) { const int g = i / D, k = i % D; const float v = g < 2 ? cnd[g * D + k] : cctx[k]; sc[i] = v / (1.0f + __expf(-v)); }
    __syncthreads();
    const float* W = ada_w + (size_t)L * D * 12288 + c0 + 2 * F.lane;
    float a00 = 0.f, a01 = 0.f, a10 = 0.f, a11 = 0.f, a20 = 0.f, a21 = 0.f;
    const int kb = 256 * F.wave;
#pragma unroll 8
    for (int k = kb; k < kb + 256; ++k) { typedef float f32x2_ __attribute__((ext_vector_type(2))); const f32x2_ w = __builtin_nontemporal_load((const GAS f32x2_*)(W + (size_t)k * 12288)); const float s0 = sc[k], s1 = sc[D + k], s2 = sc[2 * D + k];
        a00 += s0 * w.x; a01 += s0 * w.y; a10 += s1 * w.x; a11 += s1 * w.y; a20 += s2 * w.x; a21 += s2 * w.y; }
    red[(F.wave * 3 + 0) * 128 + 2 * F.lane] = a00; red[(F.wave * 3 + 0) * 128 + 2 * F.lane + 1] = a01;
    red[(F.wave * 3 + 1) * 128 + 2 * F.lane] = a10; red[(F.wave * 3 + 1) * 128 + 2 * F.lane + 1] = a11;
    red[(F.wave * 3 + 2) * 128 + 2 * F.lane] = a20; red[(F.wave * 3 + 2) * 128 + 2 * F.lane + 1] = a21;
    __syncthreads();
    if (F.tid < 384) { const int g = F.tid / 128, cc = F.tid % 128; float s = 0.f;
#pragma unroll
        for (int w = 0; w < 8; ++w) s += red[(w * 3 + g) * 128 + cc];
        ((float*)(ws + WS_MOD))[((size_t)L * 3 + g) * 12288 + c0 + cc] = s + ada_b[L * 12288 + c0 + cc]; }
    __syncthreads();
}
__device__ __forceinline__ void p0a_prologue(Frame& F) {
    unsigned char* const ws = PWS();
    { const float* cnd = PIN(1); const float* cctx = PIN(3); const float* ada_w = PIN(4); const float* ada_b = PIN(5);
      for (int it = F.bx; it < 192; it += F.G) ada_item(F, ws, cnd, cctx, ada_w, ada_b, it); }
    const float* const w_in = PIN(6);
    { const int gt = F.bx * NTHR + F.tid, NGT = F.G * NTHR;
      for (int i = gt; i < DEPTH * D * 32; i += NGT) { const int o = i & 31, k = (i >> 5) % D, L = i / (32 * D); ((bf16*)(ws + WS_WLR))[((size_t)L * 32 + o) * D + k] = (bf16)f2bf(w_in[((size_t)L * D + k) * INC + LR_COL + o]); } }
    conv_matrix<1>(F, w_in, D, INC, w_in_t(ws, 0));
}
__device__ __forceinline__ void p0a_rest(Frame& F) {
    unsigned char* const ws = PWS();
    for (int b = 0; b < 3; ++b) conv_matrix<0>(F, (b == 0 ? PIN(14) : (b == 1 ? PIN(15) : PIN(16))), 1024, D, w_br_t(ws, 0, b));
    conv_matrix<0>(F, PIN(18), D, D, w_out_t(ws, 0));
    conv_matrix<2>(F, PIN(23), D, FF, (bf16*)w_gu_t(ws, -1)); conv_matrix<3>(F, PIN(24), D, FF, (bf16*)w_gu_t(ws, -1)); conv_matrix<0>(F, PIN(25), FF, D, (bf16*)w_d_t(ws, -1));
    conv_matrix_t<1, true>(F, PIN(6) + (size_t)D * INC, D, INC, w_in_t(ws, 1), FSC_WGU);
    for (int b = 0; b < 3; ++b) conv_matrix<0>(F, (b == 0 ? PIN(14) : (b == 1 ? PIN(15) : PIN(16))) + (size_t)1024 * D, 1024, D, w_br_t(ws, 1, b));
    conv_matrix<0>(F, PIN(18) + (size_t)D * D, D, D, w_out_t(ws, 1));
    for (int e = 0; e < NE; ++e) {
        conv_matrix8<2>(F, PIN(27) + (size_t)e * D * FF, D, FF, w_gu_t(ws, e), FSC_WGU); conv_matrix8<3>(F, PIN(28) + (size_t)e * D * FF, D, FF, w_gu_t(ws, e), FSC_WGU);
        conv_matrix8<0>(F, PIN(29) + (size_t)e * FF * D, FF, D, w_d_t(ws, e), FSC_WD);
    }
}

__device__ __forceinline__ int row_group(int r) { return r < SEQ ? 0 : (r < NLAT ? 1 : 2); }
__device__ __forceinline__ void load_row(const float* p, int lane, f32x4 (&v)[8]) {
#pragma unroll
    for (int j = 0; j < 8; ++j) v[j] = *(const GAS f32x4*)(p + 4 * lane + 256 * j);
}
__device__ __forceinline__ void load_row_bf16(const bf16* p, int lane, f32x4 (&v)[8]) {
#pragma unroll
    for (int j = 0; j < 8; ++j) { const v2u w = *(const GAS v2u*)(p + 4 * lane + 256 * j); v[j] = (f32x4){bflo(w.x), bfhi(w.x), bflo(w.y), bfhi(w.y)}; }
}
__device__ __forceinline__ void store_row(float* p, int lane, const f32x4 (&v)[8]) {
#pragma unroll
    for (int j = 0; j < 8; ++j) *(GAS f32x4*)(p + 4 * lane + 256 * j) = v[j];
}
__device__ __forceinline__ void store_row_bf16(bf16* p, int lane, const f32x4 (&v)[8]) {
#pragma unroll
    for (int j = 0; j < 8; ++j) { v2u w; w.x = pk2(v[j][0], v[j][1]); w.y = pk2(v[j][2], v[j][3]); *(GAS v2u*)(p + 4 * lane + 256 * j) = w; }
}
__device__ __forceinline__ void store_row_fp8(unsigned char* p, int lane, const f32x4 (&v)[8]) {
#pragma unroll
    for (int j = 0; j < 8; ++j) *(GAS unsigned*)(p + 4 * lane + 256 * j) = pg8::pk_fp8x4(pg8::clamp448(v[j][0]), pg8::clamp448(v[j][1]), pg8::clamp448(v[j][2]), pg8::clamp448(v[j][3]));
}
__device__ __forceinline__ void modulate(f32x4 (&v)[8], const float* shift, const float* scale, int lane) {
#pragma unroll
    for (int j = 0; j < 8; ++j) { const f32x4 sh = *(const f32x4*)(shift + 4 * lane + 256 * j), sc = *(const f32x4*)(scale + 4 * lane + 256 * j); v[j] = v[j] * (sc + 1.0f) + sh; }
}
__device__ __forceinline__ void layer_norm_row(f32x4 (&v)[8], const float* g, const float* b, int lane) {
    float s = 0.f;
#pragma unroll
    for (int j = 0; j < 8; ++j) s += (v[j][0] + v[j][1]) + (v[j][2] + v[j][3]);
    const float mean = wave_sum(s) * (1.0f / D); float q = 0.f;
#pragma unroll
    for (int j = 0; j < 8; ++j) { v[j] = v[j] - mean; q += (v[j][0] * v[j][0] + v[j][1] * v[j][1]) + (v[j][2] * v[j][2] + v[j][3] * v[j][3]); }
    const float rstd = 1.0f / sqrtf(wave_sum(q) * (1.0f / D) + LN_EPS);
#pragma unroll
    for (int j = 0; j < 8; ++j) { const f32x4 g4 = *(const f32x4*)(g + 4 * lane + 256 * j), b4 = *(const f32x4*)(b + 4 * lane + 256 * j); v[j] = v[j] * rstd * g4 + b4; }
}
__device__ __forceinline__ void lr_tiles(Frame& F, int L) {
    unsigned char* const ws = PWS(); const bf16* H = (const bf16*)(ws + WS_H); const bf16* W = (const bf16*)(ws + WS_WLR) + (size_t)L * 32 * D; float* LRo = (float*)(ws + WS_LR);
    const int g = F.lane >> 4, l15 = F.lane & 15;
    LAS f32x4* red = (LAS f32x4*)(F.lds + RING_OFF);
    for (int task = F.vcu; task < MROWS / 16; task += F.G) {
        const bf16* ap = H + (size_t)(16 * task + l15) * D + 256 * F.wave + 8 * g; const bf16* bp = W + (size_t)l15 * D + 256 * F.wave + 8 * g;
        v4u af[8], b0[8], b1[8];
#pragma unroll
        for (int ks = 0; ks < 8; ++ks) { af[ks] = *(const GAS v4u*)(ap + 32 * ks); b0[ks] = *(const GAS v4u*)(bp + 32 * ks); b1[ks] = *(const GAS v4u*)(bp + (size_t)16 * D + 32 * ks); }
        f32x4 a0 = {0.f, 0.f, 0.f, 0.f}, a1 = {0.f, 0.f, 0.f, 0.f};
#pragma unroll
        for (int ks = 0; ks < 8; ++ks) { a0 = __builtin_amdgcn_mfma_f32_16x16x32_bf16(__builtin_bit_cast(bf16x8v, af[ks]), __builtin_bit_cast(bf16x8v, b0[ks]), a0, 0, 0, 0);
                                         a1 = __builtin_amdgcn_mfma_f32_16x16x32_bf16(__builtin_bit_cast(bf16x8v, af[ks]), __builtin_bit_cast(bf16x8v, b1[ks]), a1, 0, 0, 0); }
        red[(F.wave * 2 + 0) * 64 + F.lane] = a0; red[(F.wave * 2 + 1) * 64 + F.lane] = a1;
        __syncthreads();
        if (F.wave < 2) { f32x4 s = red[F.wave * 64 + F.lane];
#pragma unroll
            for (int w = 1; w < 8; ++w) s += red[(w * 2 + F.wave) * 64 + F.lane];
#pragma unroll
            for (int i = 0; i < 4; ++i) LRo[(size_t)(16 * task + 4 * g + i) * 32 + l15 + 16 * F.wave] = s[i]; }
        __syncthreads();
    }
}
__device__ __forceinline__ void p0b_modulate(Frame& F) {
    unsigned char* const ws = PWS(); const float* const xin = PIN(0); const float* const cin = PIN(2);
    const int gw = F.vcu * NWAVES + F.wave, NGW = F.G * NWAVES;
    for (int r = gw; r < MROWS; r += 2 * NGW) {
        const int r1 = r + NGW; const bool has1 = r1 < MROWS;
        f32x4 a[8], b[8]; load_row(r < NLAT ? xin + (size_t)r * D : cin + (size_t)(r - NLAT) * D, F.lane, a);
        if (has1) load_row(r1 < NLAT ? xin + (size_t)r1 * D : cin + (size_t)(r1 - NLAT) * D, F.lane, b);
        { const float* m = ((float*)(ws + WS_MOD)) + (size_t)row_group(r) * 12288; modulate(a, m, m + D, F.lane); store_row_bf16(((bf16*)(ws + WS_H)) + (size_t)r * D, F.lane, a); }
        if (has1) { const float* m = ((float*)(ws + WS_MOD)) + (size_t)row_group(r1) * 12288; modulate(b, m, m + D, F.lane); store_row_bf16(((bf16*)(ws + WS_H)) + (size_t)r1 * D, F.lane, b); }
    }
}

__device__ __forceinline__ void mix_prep(Frame& F, int L) {
    unsigned char* const ws = PWS();
    const int gt = F.bx * NTHR + F.tid, NGT = F.G * NTHR;
    const float* cw = PIN(7) + (size_t)L * 3 * 1024;
    for (int i = gt; i < MROWS * 128; i += NGT) {
        const int r = i >> 7, c8 = (i & 127) * 8;
        const int t = r < NLAT ? (r & (SEQ - 1)) : ((r - NLAT) & (CTXL - 1)), T = r < NLAT ? SEQ : CTXL;
        float acc[8];
#pragma unroll
        for (int j = 0; j < 8; ++j) acc[j] = 0.f;
#pragma unroll
        for (int k = 0; k < 3; ++k) { const int tt = t + k - 1; if (tt < 0 || tt >= T) continue;
            const bf16* up = ((bf16*)(ws + WS_U)) + (size_t)(r + k - 1) * NU; const v4u a = *(const GAS v4u*)(up + U_CC + c8), b = *(const GAS v4u*)(up + U_CX + c8);
            const f32x4 w0 = *(const f32x4*)(cw + k * 1024 + c8), w1 = *(const f32x4*)(cw + k * 1024 + c8 + 4);
            acc[0] += w0[0] * bflo(a.x) * bflo(b.x); acc[1] += w0[1] * bfhi(a.x) * bfhi(b.x); acc[2] += w0[2] * bflo(a.y) * bflo(b.y); acc[3] += w0[3] * bfhi(a.y) * bfhi(b.y);
            acc[4] += w1[0] * bflo(a.z) * bflo(b.z); acc[5] += w1[1] * bfhi(a.z) * bfhi(b.z); acc[6] += w1[2] * bflo(a.w) * bflo(b.w); acc[7] += w1[3] * bfhi(a.w) * bfhi(b.w); }
        const v4u ab = *(const GAS v4u*)(((bf16*)(ws + WS_U)) + (size_t)r * NU + U_CB + c8);
        v4u o; o.x = pk2(acc[0] * bflo(ab.x), acc[1] * bfhi(ab.x)); o.y = pk2(acc[2] * bflo(ab.y), acc[3] * bfhi(ab.y)); o.z = pk2(acc[4] * bflo(ab.z), acc[5] * bfhi(ab.z)); o.w = pk2(acc[6] * bflo(ab.w), acc[7] * bfhi(ab.w));
        *(GAS v4u*)(((bf16*)(ws + WS_Y)) + (size_t)r * 1024 + c8) = o;
    }
}
template <bool RB> __device__ __forceinline__ void sum_partials(f32x4 (&v)[8], const float* P, int ns, const void* res_, const float* gvec, int lane) {
#pragma unroll
    for (int j = 0; j < 8; ++j) v[j] = (f32x4){0.f, 0.f, 0.f, 0.f};
    int s = 0;
    for (; s + 3 <= ns; s += 3) {
        f32x4 t[3][8];
#pragma unroll
        for (int k = 0; k < 3; ++k)
#pragma unroll
            for (int j = 0; j < 8; ++j) t[k][j] = *(const GAS f32x4*)(P + (size_t)(s + k) * 512 * D + 4 * lane + 256 * j);
#pragma unroll
        for (int j = 0; j < 8; ++j) v[j] += (t[0][j] + t[1][j]) + t[2][j]; }
    for (; s < ns; ++s) {
#pragma unroll
        for (int j = 0; j < 8; ++j) v[j] += *(const GAS f32x4*)(P + (size_t)s * 512 * D + 4 * lane + 256 * j); }
#pragma unroll
    for (int j = 0; j < 8; ++j) { f32x4 r4; if (RB) { const v2u w = *(const GAS v2u*)((const bf16*)res_ + 4 * lane + 256 * j); r4 = (f32x4){bflo(w.x), bfhi(w.x), bflo(w.y), bfhi(w.y)}; } else r4 = *(const GAS f32x4*)((const float*)res_ + 4 * lane + 256 * j);
        const f32x4 g4 = *(const f32x4*)(gvec + 4 * lane + 256 * j); v[j] = r4 * ALPHA + g4 * v[j]; }
}
__device__ __forceinline__ void load_res_delta(const float* res, const bf16* delta, int lane, f32x4 (&v)[8]) {
    v2u dl[8];
#pragma unroll
    for (int j = 0; j < 8; ++j) { v[j] = *(const GAS f32x4*)(res + 4 * lane + 256 * j); dl[j] = *(const GAS v2u*)(delta + 4 * lane + 256 * j); }
#pragma unroll
    for (int j = 0; j < 8; ++j) { v[j][0] = v[j][0] * ALPHA + bflo(dl[j].x); v[j][1] = v[j][1] * ALPHA + bfhi(dl[j].x); v[j][2] = v[j][2] * ALPHA + bflo(dl[j].y); v[j][3] = v[j][3] * ALPHA + bfhi(dl[j].y); }
}
__device__ __forceinline__ void load_resb_delta(const bf16* res, const bf16* delta, int lane, f32x4 (&v)[8]) {
    v2u rl[8], dl[8];
#pragma unroll
    for (int j = 0; j < 8; ++j) { rl[j] = *(const GAS v2u*)(res + 4 * lane + 256 * j); dl[j] = *(const GAS v2u*)(delta + 4 * lane + 256 * j); }
#pragma unroll
    for (int j = 0; j < 8; ++j) { v[j][0] = bflo(rl[j].x) * ALPHA + bflo(dl[j].x); v[j][1] = bfhi(rl[j].x) * ALPHA + bfhi(dl[j].x); v[j][2] = bflo(rl[j].y) * ALPHA + bflo(dl[j].y); v[j][3] = bfhi(rl[j].y) * ALPHA + bfhi(dl[j].y); }
}
__device__ __forceinline__ void ln1_load(unsigned char* ws, const float* xin, const float* cin, int L, int r, int lane, f32x4 (&v)[8]) {
    if (r < NLAT) { if (L == 0) load_res_delta(xin + (size_t)r * D, ((const bf16*)(ws + WS_PRE)) + (size_t)r * D, lane, v); else load_resb_delta(((const bf16*)(ws + WS_XL)) + (size_t)r * D, ((const bf16*)(ws + WS_PRE)) + (size_t)r * D, lane, v); }
    else sum_partials<false>(v, ((float*)(ws + WS_PART)) + (size_t)(r - NLAT) * D, 12, cin + (size_t)(r - NLAT) * D, ((float*)(ws + WS_MOD)) + ((size_t)L * 3 + 2) * 12288 + 2 * D, lane);
}
__device__ __forceinline__ void ln1_row(Frame& F, unsigned char* ws, const float* lng, const float* lnb, const LAS float* rtab, int L, int r, f32x4 (&v)[8]) {
    const float* m = ((float*)(ws + WS_MOD)) + ((size_t)L * 3 + row_group(r)) * 12288;
    layer_norm_row(v, lng, lnb, F.lane);
    store_row_bf16(((bf16*)(ws + WS_XL)) + (size_t)r * D, F.lane, v);
    modulate(v, m + 3 * D, m + 4 * D, F.lane);
    if (L == 0) { store_row_bf16(((bf16*)(ws + WS_H)) + (size_t)r * D, F.lane, v); return; }
    float lg[8];
#pragma unroll
    for (int e = 0; e < 8; ++e) lg[e] = 0.f;
#pragma unroll
    for (int j = 0; j < 8; ++j) {
#pragma unroll
        for (int i = 0; i < 4; ++i) { const LAS float* rp = rtab + (4 * F.lane + 256 * j + i) * 8; const f32x4 w0 = *(const LAS f32x4*)rp, w1 = *(const LAS f32x4*)(rp + 4); const float hv = v[j][i];
            lg[0] += hv * w0[0]; lg[1] += hv * w0[1]; lg[2] += hv * w0[2]; lg[3] += hv * w0[3]; lg[4] += hv * w1[0]; lg[5] += hv * w1[1]; lg[6] += hv * w1[2]; lg[7] += hv * w1[3]; }
        asm volatile("" ::: "memory"); }
#pragma unroll
    for (int e = 0; e < 8; ++e) lg[e] = wave_sum(lg[e]);
    int e0 = 0; float v0 = lg[0];
#pragma unroll
    for (int e = 1; e < 8; ++e) if (lg[e] > v0) { v0 = lg[e]; e0 = e; }
    int e1 = -1; float v1 = -INFINITY;
#pragma unroll
    for (int e = 0; e < 8; ++e) if (e != e0 && lg[e] > v1) { v1 = lg[e]; e1 = e; }
    unsigned p0 = 0u, p1 = 0u;
    if (F.lane == 0) {
        const float w0 = 1.0f / (1.0f + __expf(v1 - v0)), w1 = 1.0f - w0;
        p0 = __hip_atomic_fetch_add(((gu32*)(ws + WS_CTL)) + CW_MOECNT + 64 * e0, 1u, RLX_AGENT); p1 = __hip_atomic_fetch_add(((gu32*)(ws + WS_CTL)) + CW_MOECNT + 64 * e1, 1u, RLX_AGENT);
        unsigned* rt = ((unsigned*)(ws + WS_ROUTE)) + (size_t)r * 8; rt[0] = e0; rt[1] = p0; rt[2] = __float_as_uint(w0); rt[3] = e1; rt[4] = p1; rt[5] = __float_as_uint(w1);
    }
    p0 = (unsigned)__builtin_amdgcn_readfirstlane((int)p0); p1 = (unsigned)__builtin_amdgcn_readfirstlane((int)p1);
    store_row_fp8(ws + WS_GLA + ((size_t)e0 * NLAT + p0) * D, F.lane, v); store_row_fp8(ws + WS_GLA + ((size_t)e1 * NLAT + p1) * D, F.lane, v);
}
__device__ __forceinline__ void ln1_phase(Frame& F, int L, int M) {
    unsigned char* const ws = PWS(); const float* const lng = PIN(19) + L * D; const float* const lnb = PIN(20) + L * D; const float* const cin = PIN(2); const float* const xin = PIN(0);
    const int gw = F.vcu * NWAVES + F.wave, NGW = F.G * NWAVES;
    LAS float* rtab = (LAS float*)(F.lds + RING_OFF);
    if (L == 1) { const float* const router = PIN(26);
        for (int i = F.tid; i < D * 8 / 4; i += NTHR) *(LAS f32x4*)(rtab + 4 * i) = *(const GAS f32x4*)(router + 4 * i);
        __syncthreads(); }
    for (int r = gw; r < M; r += 2 * NGW) {
        const int r1 = r + NGW; const bool has1 = r1 < M;
        f32x4 a[8], b[8]; ln1_load(ws, xin, cin, L, r, F.lane, a); if (has1) ln1_load(ws, xin, cin, L, r1, F.lane, b);
        ln1_row(F, ws, lng, lnb, rtab, L, r, a); if (has1) ln1_row(F, ws, lng, lnb, rtab, L, r1, b);
    }
}
__device__ __forceinline__ void moe_prefix(unsigned char* ws, unsigned (&cnt)[8], int (&pp)[9]) {
    pp[0] = 0;
#pragma unroll
    for (int e = 0; e < 8; ++e) { cnt[e] = __hip_atomic_load(((gu32*)(ws + WS_CTL)) + CW_MOECNT + 64 * e, RLX_AGENT); pp[e + 1] = pp[e] + (int)((cnt[e] + 255u) >> 8); }
}
__device__ __forceinline__ void moe_gather(Frame& F) {
    unsigned char* const ws = PWS();
    const int gw = F.vcu * NWAVES + F.wave, NGW = F.G * NWAVES;
    unsigned cnt[8]; int pp[9]; moe_prefix(ws, cnt, pp);
    for (int s = gw; s < pp[8] * 256; s += NGW) {
        const int p = s >> 8; int e = 0, base = 0; unsigned ce = cnt[0];
#pragma unroll
        for (int k = 1; k < 8; ++k) if (p >= pp[k]) { e = k; base = pp[k]; ce = cnt[k]; }
        const unsigned pos = (unsigned)(s - base * 256);
        GAS v4u* dst = (GAS v4u*)(ws + WS_GLA + (size_t)s * D) + F.lane;
        if (pos < ce) { const int tkn = ((int*)(ws + WS_TOK))[e * NLAT + pos]; const GAS v4u* src = (const GAS v4u*)(ws + WS_H + (size_t)tkn * D) + F.lane;
#pragma unroll
            for (int j = 0; j < 2; ++j) dst[64 * j] = src[64 * j]; }
        else {
#pragma unroll
            for (int j = 0; j < 2; ++j) dst[64 * j] = (v4u){0u, 0u, 0u, 0u}; }
    }
}
__device__ __forceinline__ void ln2d_load(unsigned char* ws, int L, int r, int lane, f32x4 (&v)[8]) {
    if (r < NLAT) load_resb_delta(((const bf16*)(ws + WS_XL)) + (size_t)r * D, ((const bf16*)(ws + WS_PRE)) + (size_t)r * D, lane, v);
    else sum_partials<true>(v, ((float*)(ws + WS_PART)) + (size_t)(r - NLAT) * D, 11, ((const bf16*)(ws + WS_XL)) + (size_t)r * D, ((float*)(ws + WS_MOD)) + ((size_t)L * 3 + 2) * 12288 + 5 * D, lane);
}
__device__ __forceinline__ void ln2d_row(Frame& F, unsigned char* ws, const float* lng, const float* lnb, int L, int r, f32x4 (&v)[8]) {
    layer_norm_row(v, lng, lnb, F.lane);
    store_row_bf16(((bf16*)(ws + WS_XL)) + (size_t)r * D, F.lane, v);
    const float* m = ((float*)(ws + WS_MOD)) + ((size_t)(L + 1) * 3 + row_group(r)) * 12288;
    modulate(v, m, m + D, F.lane); store_row_bf16(((bf16*)(ws + WS_H)) + (size_t)r * D, F.lane, v); store_row_fp8(ws + WS_ZB + (size_t)r * D, F.lane, v);
}
__device__ __forceinline__ void ln2_dense(Frame& F, int L) {
    unsigned char* const ws = PWS(); const float* const lng = PIN(21) + L * D; const float* const lnb = PIN(22) + L * D;
    const int gw = F.vcu * NWAVES + F.wave, NGW = F.G * NWAVES;
    for (int r = gw; r < MROWS; r += NGW) { f32x4 a[8]; ln2d_load(ws, L, r, F.lane, a); ln2d_row(F, ws, lng, lnb, L, r, a); }
}
__device__ __forceinline__ void ln2_moe(Frame& F, int L) {
    unsigned char* const ws = PWS(); const float* const lng = PIN(21) + L * D; const float* const lnb = PIN(22) + L * D; float* const outp = POUT();
    const int gw = F.vcu * NWAVES + F.wave, NGW = F.G * NWAVES;
    unsigned cnt[8]; int pp[9]; moe_prefix(ws, cnt, pp);
    for (int r = gw; r < NLAT; r += NGW) {
        const unsigned* rt = ((unsigned*)(ws + WS_ROUTE)) + (size_t)r * 8; const int e0 = rt[0], e1 = rt[3]; const float w0 = __uint_as_float(rt[2]), w1 = __uint_as_float(rt[5]);
        int b0 = 0, b1 = 0;
#pragma unroll
        for (int k = 1; k < 8; ++k) { if (e0 >= k) b0 = pp[k]; if (e1 >= k) b1 = pp[k]; }
        const size_t s0 = (size_t)b0 * 256 + rt[1], s1 = (size_t)b1 * 256 + rt[4];
        f32x4 v[8], y0[8], y1[8]; load_row_bf16(((bf16*)(ws + WS_XL)) + (size_t)r * D, F.lane, v); load_row_bf16(((bf16*)(ws + WS_Z)) + s0 * D, F.lane, y0); load_row_bf16(((bf16*)(ws + WS_Z)) + s1 * D, F.lane, y1);
        const float* g2 = ((float*)(ws + WS_MOD)) + ((size_t)L * 3 + row_group(r)) * 12288 + 5 * D;
#pragma unroll
        for (int j = 0; j < 8; ++j) { const f32x4 g4 = *(const f32x4*)(g2 + 4 * F.lane + 256 * j); v[j] = v[j] * ALPHA + g4 * (y0[j] * w0 + y1[j] * w1); }
        layer_norm_row(v, lng, lnb, F.lane);
        store_row(outp + (size_t)r * D, F.lane, v);
    }
}

constexpr int GLA_NCH = 68;
constexpr size_t GLA_DST_BYTES = (size_t)16 * GLA_NCH * 256 * 128 * 2;
#define GLA_DST(ws) ((bf16*)((ws) + WS_GLA))
#define GLA_DEC(ws) ((float*)((ws) + WS_GLA + GLA_DST_BYTES))
#define GLA_BCG(ws) ((float*)((ws) + WS_GLA + GLA_DST_BYTES + (size_t)16 * GLA_NCH * 128 * 4))
__device__ __forceinline__ int gla_chunk_row0(int b, int cn) { return cn < 4 ? NLAT + CTXL * b + 64 * cn : SEQ * b + 64 * (cn - 4); }
__device__ __forceinline__ int gla_scan_idx(int cn, int dir) { return dir ? (cn < 4 ? 3 - cn : 71 - cn) : cn; }
__device__ __forceinline__ float log_sigmoid16(float z) { return (fminf(z, 0.f) - __logf(1.0f + __expf(-fabsf(z)))) * (1.0f / 16.0f); }
__device__ __forceinline__ bf16x8v tr_frag(unsigned addr, unsigned pitch4) {
    v2u lo, hi;
    asm volatile("ds_read_b64_tr_b16 %0, %2\n\tds_read_b64_tr_b16 %1, %3\n\ts_waitcnt lgkmcnt(0)" : "=&v"(lo), "=&v"(hi) : "v"(addr), "v"(addr + pitch4) : "memory");
    v4u r; r.x = lo.x; r.y = lo.y; r.z = hi.x; r.w = hi.y; return __builtin_bit_cast(bf16x8v, r);
}
struct TrHalf { v2u lo, hi; };
__device__ __forceinline__ void tr_issue(TrHalf& f, unsigned addr, unsigned pitch4) { asm volatile("ds_read_b64_tr_b16 %0, %2\n\tds_read_b64_tr_b16 %1, %3" : "=&v"(f.lo), "=&v"(f.hi) : "v"(addr), "v"(addr + pitch4) : "memory"); }
__device__ __forceinline__ bf16x8v tr_get(const TrHalf& f) { v4u r; r.x = f.lo.x; r.y = f.lo.y; r.z = f.hi.x; r.w = f.hi.y; return __builtin_bit_cast(bf16x8v, r); }
__device__ __forceinline__ void tr_wait2(TrHalf (&f)[2]) { asm volatile("s_waitcnt lgkmcnt(0)" : "+v"(f[0].lo), "+v"(f[0].hi), "+v"(f[1].lo), "+v"(f[1].hi) :: "memory"); }
__device__ __forceinline__ void tr_wait8(TrHalf (&f)[8]) { asm volatile("s_waitcnt lgkmcnt(0)" : "+v"(f[0].lo), "+v"(f[0].hi), "+v"(f[1].lo), "+v"(f[1].hi), "+v"(f[2].lo), "+v"(f[2].hi), "+v"(f[3].lo), "+v"(f[3].hi),
    "+v"(f[4].lo), "+v"(f[4].hi), "+v"(f[5].lo), "+v"(f[5].hi), "+v"(f[6].lo), "+v"(f[6].hi), "+v"(f[7].lo), "+v"(f[7].hi) :: "memory"); }
__device__ __forceinline__ unsigned lds_addr(LAS unsigned char* p) { return (unsigned)(size_t)p; }
constexpr int GL_BC = 0;
constexpr int GL_TOT = 65536;
constexpr int GL_V = 71680;
constexpr int GL_A = 105472;
constexpr int GL_STG = 105472;
constexpr int GL_RED = 124928;
constexpr int GL_QK_PITCH = 272, GL_V_PITCH = 528, GL_A_PITCH = 144;
static_assert(GL_STG + 25600 <= RING_BYTES && GL_V + 64 * GL_V_PITCH <= GL_A && GL_TOT + 4096 + 1024 <= GL_V && 4 * 64 * GL_QK_PITCH <= GL_V, "GLA LDS map");

__device__ __forceinline__ void gla_decays(Frame& F, unsigned char* ws, const float* wgf, const float* bgf, const float* wgb, const float* bgb, int row0, int h, int d0, int d1) {
    LAS float* lr = (LAS float*)(F.lds + GL_STG); LAS float* wg = lr + 64 * 32; LAS float* bg = wg + 2 * 16 * 128;
    LAS float* bc = (LAS float*)(F.lds + GL_BC); LAS float* tot = (LAS float*)(F.lds + GL_TOT);
    { const int t = F.tid >> 3, o4 = (F.tid & 7) * 4; *(LAS f32x4*)(lr + t * 32 + o4) = *(const GAS f32x4*)(((float*)(ws + WS_LR)) + (size_t)(row0 + t) * 32 + o4); }
    for (int i = F.tid; i < 1024; i += NTHR) { const int dir = i >> 9, o = (i >> 5) & 15, d4 = (i & 31) * 4; *(LAS f32x4*)(wg + (dir * 16 + o) * 128 + d4) = *(const GAS f32x4*)((dir ? wgb : wgf) + o * 512 + h * 128 + d4); }
    if (F.tid < 64) { const int dir = F.tid >> 5, d4 = (F.tid & 31) * 4; *(LAS f32x4*)(bg + dir * 128 + d4) = *(const GAS f32x4*)((dir ? bgb : bgf) + h * 128 + d4); }
    __syncthreads();
    { const int t = F.tid >> 3, dg = (F.tid & 7) * 16;
      for (int dir = d0; dir < d1; ++dir) {
          f32x4 z[4];
#pragma unroll
          for (int j = 0; j < 4; ++j) z[j] = *(LAS f32x4*)(bg + dir * 128 + dg + 4 * j);
#pragma unroll
          for (int o = 0; o < 16; ++o) { const float l = lr[t * 32 + dir * 16 + o];
#pragma unroll
              for (int j = 0; j < 4; ++j) z[j] += l * *(LAS f32x4*)(wg + (dir * 16 + o) * 128 + dg + 4 * j); }
#pragma unroll
          for (int j = 0; j < 4; ++j) { f32x4 g; g[0] = log_sigmoid16(z[j][0]); g[1] = log_sigmoid16(z[j][1]); g[2] = log_sigmoid16(z[j][2]); g[3] = log_sigmoid16(z[j][3]); *(LAS f32x4*)(bc + dir * 8192 + t * 128 + dg + 4 * j) = g; } } }
    __syncthreads();
    { const int d = F.tid & 127, seg = F.tid >> 7;
      for (int dir = d0; dir < d1; ++dir) { float a = 0.f;
#pragma unroll
          for (int i = 0; i < 16; ++i) { const int s = seg * 16 + i, t = dir ? 63 - s : s; a += bc[dir * 8192 + t * 128 + d]; bc[dir * 8192 + t * 128 + d] = a; }
          tot[(dir * 4 + seg) * 128 + d] = a; } }
    __syncthreads();
    { const int d = F.tid & 127, seg = F.tid >> 7;
      for (int dir = d0; dir < d1; ++dir) { float pre = 0.f, all = 0.f;
#pragma unroll
          for (int s2 = 0; s2 < 4; ++s2) { const float v = tot[(dir * 4 + s2) * 128 + d]; all += v; if (s2 < seg) pre += v; }
          if (seg == 0) tot[1024 + dir * 128 + d] = all;
          if (seg > 0) {
#pragma unroll
              for (int i = 0; i < 16; ++i) { const int s = seg * 16 + i, t = dir ? 63 - s : s; bc[dir * 8192 + t * 128 + d] += pre; } } } }
    __syncthreads();
}
__device__ __forceinline__ void gla_stage_v(Frame& F, const bf16* U, int row0, int h) {
#pragma unroll
    for (int i = 0; i < 4; ++i) { const int p = F.tid + NTHR * i, t = p >> 5, e8 = (p & 31) * 8;
        *(LAS v4u*)(F.lds + GL_V + t * GL_V_PITCH + e8 * 2) = *(const GAS v4u*)(U + (size_t)(row0 + t) * NU + U_GV + h * 256 + e8); }
}
__device__ __forceinline__ void gla_g1(Frame& F, int L) {
    unsigned char* const ws = PWS(); const bf16* U = (const bf16*)(ws + WS_U);
    const float* wgf = PIN(8) + (size_t)L * 16 * 512; const float* bgf = PIN(9) + L * 512; const float* wgb = PIN(10) + (size_t)L * 16 * 512; const float* bgb = PIN(11) + L * 512;
    const int g = F.lane >> 4, q4 = (F.lane & 15) >> 2, p = F.lane & 3, l15 = F.lane & 15;
    for (int task = F.vcu; task < 16 * GLA_NCH; task += F.G) {
        const int cn = task % GLA_NCH, ch = task / GLA_NCH, h = ch & 3, dir = (ch >> 2) & 1, b = ch >> 3;
        const int row0 = gla_chunk_row0(b, cn), n = gla_scan_idx(cn, dir);
        __syncthreads();
        gla_stage_v(F, U, row0, h);
        v4u kp[2];
#pragma unroll
        for (int i = 0; i < 2; ++i) { const int pc = F.tid + NTHR * i, t = pc >> 4, d8 = (pc & 15) * 8; kp[i] = *(const GAS v4u*)(U + (size_t)(row0 + t) * NU + U_GK + h * 128 + d8); }
        gla_decays(F, ws, wgf, bgf, wgb, bgb, row0, h, dir, dir + 1);
        LAS float* bc = (LAS float*)(F.lds + GL_BC) + dir * 8192; LAS float* bl = (LAS float*)(F.lds + GL_TOT) + 1024 + dir * 128;
        if (F.tid < 128) GLA_DEC(ws)[((size_t)ch * GLA_NCH + n) * 128 + F.tid] = __expf(bl[F.tid]);
        LAS unsigned char* ke = F.lds + GL_BC + (dir ? 0 : 32768);
#pragma unroll
        for (int i = 0; i < 2; ++i) { const int pc = F.tid + NTHR * i, t = pc >> 4, d8 = (pc & 15) * 8;
            const f32x4 b0 = *(LAS f32x4*)(bc + t * 128 + d8), b1 = *(LAS f32x4*)(bc + t * 128 + d8 + 4), l0 = *(LAS f32x4*)(bl + d8), l1 = *(LAS f32x4*)(bl + d8 + 4);
            { float* bo = GLA_BCG(ws) + ((((size_t)(b * 4 + h) * GLA_NCH + cn) * 2 + dir) * 64 + t) * 128 + d8; *(GAS f32x4*)bo = b0; *(GAS f32x4*)(bo + 4) = b1; }
            v4u o; o.x = pk2(bflo(kp[i].x) * __expf(l0[0] - b0[0]), bfhi(kp[i].x) * __expf(l0[1] - b0[1])); o.y = pk2(bflo(kp[i].y) * __expf(l0[2] - b0[2]), bfhi(kp[i].y) * __expf(l0[3] - b0[3]));
            o.z = pk2(bflo(kp[i].z) * __expf(l1[0] - b1[0]), bfhi(kp[i].z) * __expf(l1[1] - b1[1])); o.w = pk2(bflo(kp[i].w) * __expf(l1[2] - b1[2]), bfhi(kp[i].w) * __expf(l1[3] - b1[3]));
            *(LAS v4u*)(ke + t * GL_QK_PITCH + d8 * 2) = o; }
        __syncthreads();
        f32x4 acc[8][2];
#pragma unroll
        for (int mt = 0; mt < 8; ++mt) { acc[mt][0] = (f32x4){0.f, 0.f, 0.f, 0.f}; acc[mt][1] = (f32x4){0.f, 0.f, 0.f, 0.f}; }
        const unsigned ke_a = lds_addr(ke) + GL_QK_PITCH * (8 * g + q4) + 8 * p, v_a = lds_addr(F.lds + GL_V) + GL_V_PITCH * (8 * g + q4) + 8 * p + 2 * (32 * F.wave);
#pragma unroll
        for (int ks = 0; ks < 2; ++ks) {
            TrHalf bh[2], ah[8];
#pragma unroll
            for (int nt = 0; nt < 2; ++nt) tr_issue(bh[nt], v_a + GL_V_PITCH * 32 * ks + 32 * nt, GL_V_PITCH * 4);
#pragma unroll
            for (int mt = 0; mt < 8; ++mt) tr_issue(ah[mt], ke_a + GL_QK_PITCH * 32 * ks + 32 * mt, GL_QK_PITCH * 4);
            tr_wait2(bh); tr_wait8(ah);
            const bf16x8v bv0 = tr_get(bh[0]), bv1 = tr_get(bh[1]);
#pragma unroll
            for (int mt = 0; mt < 8; ++mt) { const bf16x8v av = tr_get(ah[mt]);
                acc[mt][0] = __builtin_amdgcn_mfma_f32_16x16x32_bf16(av, bv0, acc[mt][0], 0, 0, 0); acc[mt][1] = __builtin_amdgcn_mfma_f32_16x16x32_bf16(av, bv1, acc[mt][1], 0, 0, 0); } }
        bf16* dst = GLA_DST(ws) + ((size_t)ch * GLA_NCH + n) * 256 * 128;
#pragma unroll
        for (int mt = 0; mt < 8; ++mt)
#pragma unroll
            for (int nt = 0; nt < 2; ++nt) { const int e = 32 * F.wave + 16 * nt + l15, d = 16 * mt + 4 * g; v2u w; w.x = pk2(acc[mt][nt][0], acc[mt][nt][1]); w.y = pk2(acc[mt][nt][2], acc[mt][nt][3]);
                *(GAS v2u*)(dst + (size_t)e * 128 + d) = w; }
    }
}
__device__ __forceinline__ void gla_g2(Frame& F) {
    unsigned char* const ws = PWS();
    const int NT = F.G * NTHR;
    LAS float* decl = (LAS float*)(F.lds + RING_OFF + 90112);
    for (int base = F.bx * NTHR; base < 16 * 256 * 32; base += NT) {
        const int ch = base >> 13;
        __syncthreads();
        for (int i = F.tid; i < GLA_NCH * 32; i += NTHR) *(LAS f32x4*)(decl + 4 * i) = *(const GAS f32x4*)(GLA_DEC(ws) + (size_t)ch * GLA_NCH * 128 + 4 * i);
        __syncthreads();
        const int idx = base + F.tid, e = (idx >> 5) & 255, d4 = (idx & 31) * 4;
        bf16* p = GLA_DST(ws) + (size_t)ch * GLA_NCH * 32768 + (size_t)e * 128 + d4;
        f32x4 S = {0.f, 0.f, 0.f, 0.f};
#pragma unroll
        for (int hf = 0; hf < 2; ++hf) {
            v2u x[34];
#pragma unroll
            for (int i = 0; i < 34; ++i) x[i] = *(const GAS v2u*)(p + (size_t)(34 * hf + i) * 32768);
#pragma unroll
            for (int i = 0; i < 34; ++i) { const int n = 34 * hf + i; const f32x4 a = *(LAS f32x4*)(decl + n * 128 + d4);
                v2u w; w.x = pk2(S[0], S[1]); w.y = pk2(S[2], S[3]); *(GAS v2u*)(p + (size_t)n * 32768) = w;
                S[0] = a[0] * S[0] + bflo(x[i].x); S[1] = a[1] * S[1] + bfhi(x[i].x); S[2] = a[2] * S[2] + bflo(x[i].y); S[3] = a[3] * S[3] + bfhi(x[i].y); }
        }
    }
}
__device__ __forceinline__ void gla_g3(Frame& F, int L) {
    unsigned char* const ws = PWS(); const bf16* U = (const bf16*)(ws + WS_U);
    const float* wgf = PIN(8) + (size_t)L * 16 * 512; const float* bgf = PIN(9) + L * 512; const float* wgb = PIN(10) + (size_t)L * 16 * 512; const float* bgb = PIN(11) + L * 512;
    const float* ng = PIN(12) + L * 256;
    const int g = F.lane >> 4, q4 = (F.lane & 15) >> 2, p = F.lane & 3, l15 = F.lane & 15;
    for (int task = F.vcu; task < 8 * GLA_NCH; task += F.G) {
        const int cn = task % GLA_NCH, bh = task / GLA_NCH, h = bh & 3, b = bh >> 2;
        const int row0 = gla_chunk_row0(b, cn);
        __syncthreads();
        gla_stage_v(F, U, row0, h);
        v4u kp[2], qp[2];
#pragma unroll
        for (int i = 0; i < 2; ++i) { const int pc = F.tid + NTHR * i, t = pc >> 4, d8 = (pc & 15) * 8; const bf16* up = U + (size_t)(row0 + t) * NU + h * 128 + d8; kp[i] = *(const GAS v4u*)(up + U_GK); qp[i] = *(const GAS v4u*)(up + U_GQ); }
        { const float* bcg = GLA_BCG(ws) + ((size_t)(b * 4 + h) * GLA_NCH + cn) * 2 * 8192;
#pragma unroll
          for (int i = 0; i < 2; ++i) { const int pc = F.tid + NTHR * i, t = pc >> 4, d8 = (pc & 15) * 8;
#pragma unroll
              for (int dir = 0; dir < 2; ++dir) { const f32x4 b0 = *(const GAS f32x4*)(bcg + dir * 8192 + t * 128 + d8), b1 = *(const GAS f32x4*)(bcg + dir * 8192 + t * 128 + d8 + 4);
                  float ep[8], en[8];
#pragma unroll
                  for (int j = 0; j < 4; ++j) { ep[j] = __expf(b0[j]); ep[4 + j] = __expf(b1[j]); en[j] = __expf(-b0[j]); en[4 + j] = __expf(-b1[j]); }
                  v4u qo, ko;
                  qo.x = pk2(bflo(qp[i].x) * ep[0], bfhi(qp[i].x) * ep[1]); qo.y = pk2(bflo(qp[i].y) * ep[2], bfhi(qp[i].y) * ep[3]); qo.z = pk2(bflo(qp[i].z) * ep[4], bfhi(qp[i].z) * ep[5]); qo.w = pk2(bflo(qp[i].w) * ep[6], bfhi(qp[i].w) * ep[7]);
                  ko.x = pk2(bflo(kp[i].x) * en[0], bfhi(kp[i].x) * en[1]); ko.y = pk2(bflo(kp[i].y) * en[2], bfhi(kp[i].y) * en[3]); ko.z = pk2(bflo(kp[i].z) * en[4], bfhi(kp[i].z) * en[5]); ko.w = pk2(bflo(kp[i].w) * en[6], bfhi(kp[i].w) * en[7]);
                  *(LAS v4u*)(F.lds + GL_BC + (2 * dir) * 64 * GL_QK_PITCH + t * GL_QK_PITCH + d8 * 2) = qo; *(LAS v4u*)(F.lds + GL_BC + (2 * dir + 1) * 64 * GL_QK_PITCH + t * GL_QK_PITCH + d8 * 2) = ko; } } }
        __syncthreads();
        { const int dir = F.wave >> 2, nt = F.wave & 3;
          LAS unsigned char* qi = F.lds + GL_BC + (2 * dir) * 64 * GL_QK_PITCH; LAS unsigned char* ki = qi + 64 * GL_QK_PITCH;
          bf16x8v qf[4];
#pragma unroll
          for (int ks = 0; ks < 4; ++ks) qf[ks] = *(LAS bf16x8v*)(qi + (16 * nt + l15) * GL_QK_PITCH + (32 * ks + 8 * g) * 2);
#pragma unroll
          for (int mt = 0; mt < 4; ++mt) { f32x4 a = {0.f, 0.f, 0.f, 0.f};
              const bool live = dir ? (mt >= nt) : (mt <= nt);
              if (live) {
#pragma unroll
                  for (int ks = 0; ks < 4; ++ks) { const bf16x8v kf = *(LAS bf16x8v*)(ki + (16 * mt + l15) * GL_QK_PITCH + (32 * ks + 8 * g) * 2); a = __builtin_amdgcn_mfma_f32_16x16x32_bf16(kf, qf[ks], a, 0, 0, 0); } }
              const int tau = 16 * nt + l15, s0 = 16 * mt + 4 * g;
#pragma unroll
              for (int i = 0; i < 4; ++i) { const bool keep = dir ? (s0 + i >= tau) : (s0 + i <= tau); if (!keep) a[i] = 0.f; }
              v2u w; w.x = pk2(a[0], a[1]); w.y = pk2(a[2], a[3]);
              *(LAS v2u*)(F.lds + GL_A + dir * 64 * GL_A_PITCH + tau * GL_A_PITCH + s0 * 2) = w; } }
        __syncthreads();
        f32x4 acc[2][4];
#pragma unroll
        for (int mt = 0; mt < 2; ++mt)
#pragma unroll
            for (int nt = 0; nt < 4; ++nt) acc[mt][nt] = (f32x4){0.f, 0.f, 0.f, 0.f};
        { const unsigned v_a = lds_addr(F.lds + GL_V) + GL_V_PITCH * (8 * g + q4) + 8 * p + 2 * (32 * F.wave);
#pragma unroll
          for (int ks = 0; ks < 2; ++ks) { TrHalf vh[2];
#pragma unroll
              for (int mt = 0; mt < 2; ++mt) tr_issue(vh[mt], v_a + GL_V_PITCH * 32 * ks + 32 * mt, GL_V_PITCH * 4);
              tr_wait2(vh); const bf16x8v vf[2] = {tr_get(vh[0]), tr_get(vh[1])};
#pragma unroll
              for (int dir = 0; dir < 2; ++dir)
#pragma unroll
                  for (int nt = 0; nt < 4; ++nt) { const bf16x8v af = *(LAS bf16x8v*)(F.lds + GL_A + dir * 64 * GL_A_PITCH + (16 * nt + l15) * GL_A_PITCH + (32 * ks + 8 * g) * 2);
                      acc[0][nt] = __builtin_amdgcn_mfma_f32_16x16x32_bf16(vf[0], af, acc[0][nt], 0, 0, 0); acc[1][nt] = __builtin_amdgcn_mfma_f32_16x16x32_bf16(vf[1], af, acc[1][nt], 0, 0, 0); } } }
#pragma unroll
        for (int dir = 0; dir < 2; ++dir) { const int ch = (b * 2 + dir) * 4 + h, n = gla_scan_idx(cn, dir);
            const bf16* st = GLA_DST(ws) + ((size_t)ch * GLA_NCH + n) * 32768; LAS unsigned char* qi = F.lds + GL_BC + (2 * dir) * 64 * GL_QK_PITCH;
#pragma unroll
            for (int ks = 0; ks < 4; ++ks) { bf16x8v sf[2];
#pragma unroll
                for (int mt = 0; mt < 2; ++mt) sf[mt] = __builtin_bit_cast(bf16x8v, *(const GAS v4u*)(st + (size_t)(32 * F.wave + 16 * mt + l15) * 128 + 32 * ks + 8 * g));
#pragma unroll
                for (int nt = 0; nt < 4; ++nt) { const bf16x8v qf = *(LAS bf16x8v*)(qi + (16 * nt + l15) * GL_QK_PITCH + (32 * ks + 8 * g) * 2);
                    acc[0][nt] = __builtin_amdgcn_mfma_f32_16x16x32_bf16(sf[0], qf, acc[0][nt], 0, 0, 0); acc[1][nt] = __builtin_amdgcn_mfma_f32_16x16x32_bf16(sf[1], qf, acc[1][nt], 0, 0, 0); } } }
        LAS float* red = (LAS float*)(F.lds + GL_RED);
#pragma unroll
        for (int nt = 0; nt < 4; ++nt) { float s = 0.f;
#pragma unroll
            for (int mt = 0; mt < 2; ++mt)
#pragma unroll
                for (int i = 0; i < 4; ++i) s += acc[mt][nt][i] * acc[mt][nt][i];
            s += __shfl_xor(s, 16); s += __shfl_xor(s, 32);
            if (g == 0) red[F.wave * 64 + 16 * nt + l15] = s; }
        __syncthreads();
#pragma unroll
        for (int nt = 0; nt < 4; ++nt) { const int tau = 16 * nt + l15; float s = 0.f;
#pragma unroll
            for (int w = 0; w < 8; ++w) s += red[w * 64 + tau];
            const float rs = 1.0f / sqrtf(s * (1.0f / 256.0f) + LN_EPS); const size_t row = (size_t)(row0 + tau);
#pragma unroll
            for (int mt = 0; mt < 2; ++mt) { const int e = 32 * F.wave + 16 * mt + 4 * g;
                const v2u rw = *(const GAS v2u*)(U + row * NU + U_GR + h * 256 + e); const f32x4 g4 = *(const f32x4*)(ng + e);
                const float r0 = bflo(rw.x), r1 = bfhi(rw.x), r2 = bflo(rw.y), r3 = bfhi(rw.y);
                v2u w; w.x = pk2(acc[mt][nt][0] * rs * g4[0] * (r0 / (1.0f + __expf(-r0))), acc[mt][nt][1] * rs * g4[1] * (r1 / (1.0f + __expf(-r1))));
                w.y = pk2(acc[mt][nt][2] * rs * g4[2] * (r2 / (1.0f + __expf(-r2))), acc[mt][nt][3] * rs * g4[3] * (r3 / (1.0f + __expf(-r3))));
                *(GAS v2u*)(((bf16*)(ws + WS_Y + (size_t)MROWS * 1024 * 2)) + row * 1024 + h * 256 + e) = w; } }
    }
}

constexpr int NA_VPITCH = 272, NA_VIMG = 32 * NA_VPITCH, NA_WAVE_LDS = 10752;
template <bool CTXQ> __device__ __forceinline__ void na_task(const bf16* U, const unsigned char* KF, bf16* YN, LAS unsigned char* vimg, const LAS float* rpb, int lane, int b, int h, int r, int c0, int qrow0) {
    const int g = lane >> 4, q4 = (lane & 15) >> 2, p = lane & 3, l15 = lane & 15;
    const unsigned v_a = lds_addr(vimg) + NA_VPITCH * (4 * g + q4) + 8 * p;
    const int rs = min(max(r - 4, 0), 56), kc0 = min(max(c0 - 8, 0), 32), ctx0 = NLAT + CTXL * b;
    const int qc = c0 + l15, cs = min(max(qc - 8, 0), 48);
    constexpr int KB0 = CTXQ ? 8 : 0;
    bf16x8v qf[4];
#pragma unroll
    for (int ks = 0; ks < 4; ++ks) qf[ks] = __builtin_bit_cast(bf16x8v, *(const GAS v4u*)(U + (size_t)(qrow0 + l15) * NU + U_NQ + h * 128 + 32 * ks + 8 * g));
    f32x4 o[8];
#pragma unroll
    for (int mt = 0; mt < 8; ++mt) o[mt] = (f32x4){0.f, 0.f, 0.f, 0.f};
    float mrun = -INFINITY, lrun = 0.f;
    v4u kf[8], vv[8];
    const unsigned voffK = (unsigned)((l15 >> 3) * 2048 + (l15 & 7) * 64 + g * 16), voffV = (unsigned)(((lane >> 4) * NU + (lane & 15) * 8) * 2);
#define NA_LOAD_BLOCK(tokexpr) do { int tok_ = (tokexpr); asm volatile("" : "+s"(tok_)); \
        const GAS char* kb_ = (const GAS char*)(KF + ((size_t)(h * (MROWS / 8) + (tok_ >> 3)) * 4) * 512); const GAS char* vb_ = (const GAS char*)(U + (size_t)tok_ * NU + U_NV + h * 128); \
        _Pragma("unroll") for (int i = 0; i < 8; ++i) kf[i] = *(const GAS v4u*)(kb_ + (size_t)(i >> 2) * 4096 + voffK + 512 * (i & 3)); \
        _Pragma("unroll") for (int i = 0; i < 8; ++i) vv[i] = *(const GAS v4u*)(vb_ + (size_t)i * (4 * NU * 2) + voffV); } while (0)
    NA_LOAD_BLOCK(KB0 < 8 ? b * SEQ + (rs + KB0) * 64 + kc0 : ctx0 + 32 * (KB0 - 8));
#pragma unroll 1
    for (int kb = KB0; kb < 16; ++kb) {
#pragma unroll
        for (int i = 0; i < 8; ++i) { const int id = lane + 64 * i; *(LAS v4u*)(vimg + (id >> 4) * NA_VPITCH + (id & 15) * 16) = vv[i]; }
        v4u kc_[8];
#pragma unroll
        for (int i = 0; i < 8; ++i) kc_[i] = kf[i];
        if (kb + 1 < 16) NA_LOAD_BLOCK((kb + 1) < 8 ? b * SEQ + (rs + kb + 1) * 64 + kc0 : ctx0 + 32 * (kb + 1 - 8));
        f32x4 s0 = {0.f, 0.f, 0.f, 0.f}, s1 = {0.f, 0.f, 0.f, 0.f};
#pragma unroll
        for (int ks = 0; ks < 4; ++ks) { s0 = __builtin_amdgcn_mfma_f32_16x16x32_bf16(__builtin_bit_cast(bf16x8v, kc_[ks]), qf[ks], s0, 0, 0, 0); s1 = __builtin_amdgcn_mfma_f32_16x16x32_bf16(__builtin_bit_cast(bf16x8v, kc_[4 + ks]), qf[ks], s1, 0, 0, 0); }
        if (!CTXQ && kb < 8) { int drow = rs + kb - r + 7; asm volatile("" : "+s"(drow)); const LAS float* rp = rpb + drow * 31 - qc + 15;
#pragma unroll
            for (int i = 0; i < 4; ++i) { const int k0 = kc0 + 4 * g + i, k1 = k0 + 16; const bool ok0 = k0 >= cs && k0 <= cs + 15, ok1 = k1 >= cs && k1 <= cs + 15;
                const float b0 = rp[ok0 ? k0 : qc], b1 = rp[ok1 ? k1 : qc];
                s0[i] = ok0 ? s0[i] + b0 : -INFINITY; s1[i] = ok1 ? s1[i] + b1 : -INFINITY; } }
        float mloc = fmaxf(fmaxf(fmaxf(s0[0], s0[1]), fmaxf(s0[2], s0[3])), fmaxf(fmaxf(s1[0], s1[1]), fmaxf(s1[2], s1[3])));
        mloc = fmaxf(mloc, __shfl_xor(mloc, 16)); mloc = fmaxf(mloc, __shfl_xor(mloc, 32));
        const float mnew = fmaxf(mrun, mloc), alpha = __expf(mrun - mnew); mrun = mnew;
        float ps = 0.f;
#pragma unroll
        for (int i = 0; i < 4; ++i) { s0[i] = __expf(s0[i] - mnew); s1[i] = __expf(s1[i] - mnew); ps += s0[i] + s1[i]; }
        lrun = lrun * alpha + ps;
#pragma unroll
        for (int mt = 0; mt < 8; ++mt) o[mt] *= alpha;
        v4u pw; pw.x = pk2(s0[0], s0[1]); pw.y = pk2(s0[2], s0[3]); pw.z = pk2(s1[0], s1[1]); pw.w = pk2(s1[2], s1[3]);
        const bf16x8v pf = __builtin_bit_cast(bf16x8v, pw);
        TrHalf vh[8];
#pragma unroll
        for (int mt = 0; mt < 8; ++mt) tr_issue(vh[mt], v_a + 32 * mt, NA_VPITCH * 16);
        tr_wait8(vh);
#pragma unroll
        for (int mt = 0; mt < 8; ++mt) o[mt] = __builtin_amdgcn_mfma_f32_16x16x32_bf16(tr_get(vh[mt]), pf, o[mt], 0, 0, 0);
        asm volatile("" ::: "memory"); __builtin_amdgcn_sched_barrier(0);
    }
#undef NA_LOAD_BLOCK
    lrun += __shfl_xor(lrun, 16); lrun += __shfl_xor(lrun, 32);
    const float inv = 1.0f / lrun;
    bf16* yp = YN + (size_t)(qrow0 + l15) * 1024 + h * 128 + 4 * g;
#pragma unroll
    for (int mt = 0; mt < 8; ++mt) { v2u w; w.x = pk2(o[mt][0] * inv, o[mt][1] * inv); w.y = pk2(o[mt][2] * inv, o[mt][3] * inv); *(GAS v2u*)(yp + 16 * mt) = w; }
}
__device__ __forceinline__ void na_mfma(Frame& F, int L) {
    unsigned char* const ws = PWS(); const bf16* U = (const bf16*)(ws + WS_U); const unsigned char* KF = ws + WS_KF; bf16* YN = (bf16*)(ws + WS_Y + (size_t)MROWS * 2048 * 2);
    const float* rpbL = PIN(13) + (size_t)L * 8 * 15 * 31;
    LAS unsigned char* vimg = F.lds + RING_OFF + F.wave * NA_WAVE_LDS; LAS float* rpb = (LAS float*)(vimg + NA_VIMG);
    const int gw = F.vcu * NWAVES + F.wave, NGW = F.G * NWAVES;
    int hcur = -1;
    for (int task = gw; task < 2 * 8 * 64 * 4; task += NGW) {
        const int ct = task & 3, r = (task >> 2) & 63, h = (task >> 8) & 7, b = task >> 11;
        if (h != hcur) { hcur = h; for (int i = F.lane; i < 15 * 31; i += 64) rpb[i] = rpbL[h * 15 * 31 + i]; LDS_WAIT(); asm volatile("" ::: "memory"); }
        na_task<false>(U, KF, YN, vimg, rpb, F.lane, b, h, r, 16 * ct, b * SEQ + r * 64 + 16 * ct);
    }
    if (L == 0) for (int tt = gw; tt < 2 * 8 * 16; tt += NGW) {
        const int qt = tt & 15, h = (tt >> 4) & 7, b = tt >> 7;
        na_task<true>(U, KF, YN, vimg, rpb, F.lane, b, h, 0, 0, NLAT + CTXL * b + 16 * qt);
    }
}
#ifndef MK_ONE_LAUNCH
#define MK_ONE_LAUNCH 1
#endif
constexpr int PH_PER_LAYER = 11, NPH = 2 + DEPTH * PH_PER_LAYER;
enum { PL_WIN = 0, PL_MIXA, PL_MIXB, PL_MIXC, PL_BR, PL_WOUT, PL_LN1, PL_GATHER, PL_FFN1, PL_FFN2, PL_LN2 };
__device__ __forceinline__ bool in_range(int lo, int hi, int k) { asm volatile("" : "+s"(lo), "+s"(hi)); return lo <= k && k < hi; }
#ifndef PHMASK
#define PHMASK 0xFFFFFFFFu
#endif
#define IN(k) in_range(lo, hi, (k))
#define EN(bit) ((PHMASK >> (bit)) & 1u)
#ifndef DUPMASK
#define DUPMASK 0u
#endif
#define DUP(bit) ((DUPMASK >> (bit)) & 1u)
#define SEAM(k) do { if (IN((k) + 1)) GRID_BAR(); } while (0)
#ifndef NCOMP_NUM
#define NCOMP_NUM 20
#define NCOMP_DEN 32
#endif
#if MK_ONE_LAUNCH
#define GRID_BAR() xcd_barrier(bar)
#else
#define GRID_BAR() do { if (F.tid == 0) __hip_atomic_store((gu32*)(PWS() + WS_CTL) + CW_TMO, 0xBADBA0u, RLX_AGENT); } while (0)
#endif
template <int L> __device__ __forceinline__ void layer_phases(const Args& A, LAS unsigned char* const ldsb, const XcdBarrier& bar, const int lo, const int hi) {
    LAS unsigned char* const ring = ldsb + RING_OFF;
        const int pb = 2 + PH_PER_LAYER * L, Mr = (L == 0) ? MROWS : NLAT;
        if (EN(2) && IN(pb + PL_WIN)) { Frame F = mkframe(ldsb, A.grid);
            unsigned char* const ws = PWS();
            if (L == 0) {
                const int NCOMP = ((F.G * NCOMP_NUM / NCOMP_DEN) / 8) * 8;
                if (F.bx < NCOMP) { Frame Fg = F; Fg.G = NCOMP; Fg.vcu = (F.bx % 8) * (NCOMP / 8) + F.bx / 8;
                    lr_tiles(Fg, L);
                    pg8::StaticOrder S; S.init(MROWS, NU, NCOMP, F.bx);
                    pg8::Gemm g{((bf16*)(ws + WS_H)), w_in_t(ws, L), D, D}; pg8::EpiU E{((bf16*)(ws + WS_U)), NU, 1.0f, ws + WS_UG8, ws + WS_KF};
                    pg8::gemm_phase<pg8::EpiU, pg8::StaticOrder, true, true>(ring, g, S, E); }
                else { Frame Fc = F; Fc.G = F.G - NCOMP; Fc.vcu = F.bx - NCOMP; p0a_rest(Fc); }
            } else { lr_tiles(F, L);
                pg8::StaticOrder S; S.init(MROWS, NU, F.G, F.bx);
                pg8::Gemm g{((bf16*)(ws + WS_ZB)), w_in_t(ws, L), D / 2, D / 2}; pg8::EpiU E{((bf16*)(ws + WS_U)), NU, 1.0f / FSC_WGU, ws + WS_UG8, ws + WS_KF};
                pg8::gemm_phase<pg8::EpiU, pg8::StaticOrder, true, true, true>(ring, g, S, E); }
            SEAM(pb + PL_WIN);
        }
        if (EN(3) && IN(pb + PL_MIXA)) { Frame F = mkframe(ldsb, A.grid); gla_g1(F, L); mix_prep(F, L); if (DUP(3)) { __syncthreads(); gla_g1(F, L); mix_prep(F, L); } SEAM(pb + PL_MIXA); }
        if (EN(4) && IN(pb + PL_MIXB)) { Frame F = mkframe(ldsb, A.grid);
            int odd = (F.bx >> 3) & 1; asm volatile("" : "+s"(odd));
            for (int step = 0; step < 2; ++step) { if (step) __syncthreads(); if ((step ^ odd) == 0) gla_g2(F); else na_mfma(F, L); }
            SEAM(pb + PL_MIXB); }
        if (EN(5) && IN(pb + PL_MIXC)) { Frame F = mkframe(ldsb, A.grid); gla_g3(F, L); if (DUP(5)) { __syncthreads(); gla_g3(F, L); } SEAM(pb + PL_MIXC); }
        if (EN(6) && IN(pb + PL_BR)) { Frame F = mkframe(ldsb, A.grid);
            unsigned char* const ws = PWS(); const float* const gate_b = PIN(17) + (size_t)L * 3 * D;
            pg8::Gemm g{((bf16*)(ws + WS_Y)), w_br_t(ws, L, 0), 1024, 1024}; pg8::BranchOrder S; S.init(NLAT, D, F.G, F.bx, MROWS / 256, D / 256, L == 0 ? 48 : 0);
            pg8::EpiGate E{ws + WS_UG8, 6144, gate_b, ((bf16*)(ws + WS_ZB)), ws + WS_PRE, ((bf16*)(ws + WS_ZBP))};
            pg8::gemm_phase<pg8::EpiGate, pg8::BranchOrder, true, true>(ring, g, S, E);
            SEAM(pb + PL_BR);
        }
        if (EN(7) && IN(pb + PL_WOUT)) { Frame F = mkframe(ldsb, A.grid);
            unsigned char* const ws = PWS(); const float* const modL = ((float*)(ws + WS_MOD)) + (size_t)L * 3 * 12288; const float* const xin = PIN(0); const float* const cin = PIN(2);
            { pg8::Gemm g{((bf16*)(ws + WS_ZB)), w_out_t(ws, L), D, D}; pg8::StaticOrder S; S.init(NLAT, D, F.G, F.bx);
              pg8::EpiDelta<false> E{modL + 2 * D, 12288, ((bf16*)(ws + WS_PRE)), 1.0f};
              pg8::gemm_phase<pg8::EpiDelta<false>, pg8::StaticOrder, true, true>(ring, g, S, E); }
            if (L == 0) {
              pg8::Gemm g{((bf16*)(ws + WS_ZBP)), w_out_t(ws, L), D, 512}; pg8::SplitOrder S; S.init(NLAT / 256, D / 256, 12, 512, F.G, F.bx, 0, 4);
              pg8::EpiPartial<false> E{((float*)(ws + WS_PART)), NLAT / 256, 1.0f};
              pg8::gemm_phase<pg8::EpiPartial<false>, pg8::SplitOrder, false, false>(ring, g, S, E); }
            SEAM(pb + PL_WOUT);
        }
        if (EN(8) && IN(pb + PL_LN1)) { Frame F = mkframe(ldsb, A.grid); ln1_phase(F, L, Mr); SEAM(pb + PL_LN1); }
        if (L == 0) {
            if (EN(10) && IN(pb + PL_FFN1)) { Frame F = mkframe(ldsb, A.grid);
                unsigned char* const ws = PWS();
                pg8::Gemm g{((bf16*)(ws + WS_H)), (const bf16*)w_gu_t(ws, -1), D, D}; pg8::StaticOrder S; S.init(MROWS, NGU, F.G, F.bx);
                pg8::EpiSwiGLU E{((bf16*)(ws + WS_U)), FF};
                pg8::gemm_phase<pg8::EpiSwiGLU, pg8::StaticOrder, true, true>(ring, g, S, E);
                SEAM(pb + PL_FFN1);
            }
            if (EN(11) && IN(pb + PL_FFN2)) { Frame F = mkframe(ldsb, A.grid);
                unsigned char* const ws = PWS(); const float* const modL = ((float*)(ws + WS_MOD)) + (size_t)L * 3 * 12288;
                { pg8::Gemm g{((bf16*)(ws + WS_U)), (const bf16*)w_d_t(ws, -1), FF, FF}; pg8::StaticOrder S; S.init(NLAT, D, F.G, F.bx);
                  pg8::EpiDelta<false> E{modL + 5 * D, 12288, ((bf16*)(ws + WS_PRE)), 1.0f};
                  pg8::gemm_phase<pg8::EpiDelta<false>, pg8::StaticOrder, true, true>(ring, g, S, E); }
                { pg8::Gemm g{((bf16*)(ws + WS_U)), (const bf16*)w_d_t(ws, -1), FF, 512}; pg8::SplitOrder S; S.init(NLAT / 256, D / 256, 11, 512, F.G, F.bx, NLAT / 256, 11);
                  pg8::EpiPartial<false> E{((float*)(ws + WS_PART)), NLAT / 256, 1.0f};
                  pg8::gemm_phase<pg8::EpiPartial<false>, pg8::SplitOrder, false, false>(ring, g, S, E); }
                SEAM(pb + PL_FFN2);
            }
            if (EN(12) && IN(pb + PL_LN2)) { Frame F = mkframe(ldsb, A.grid); ln2_dense(F, L); if (DUP(12)) { __syncthreads(); ln2_dense(F, L); } SEAM(pb + PL_LN2); }
        } else {
            if (EN(10) && IN(pb + PL_FFN1)) { Frame F = mkframe(ldsb, A.grid);
                unsigned char* const ws = PWS();
                unsigned cnt[8]; int pp[9]; moe_prefix(ws, cnt, pp);
                pg8::Gemm g{((bf16*)(ws + WS_GLA)), (const bf16*)w_gu_t(ws, 0), D / 2, D / 2}; pg8::MoeOrder S; S.init(cnt, NGU / 256, F.G, F.bx, NLAT / 256);
                pg8::EpiSwiGLU8 E{ws + WS_U, FF, 1.0f / FSC_WGU, FSC_HID};
                pg8::gemm_phase<pg8::EpiSwiGLU8, pg8::MoeOrder, true, true, true>(ring, g, S, E);
                SEAM(pb + PL_FFN1);
            }
            if (EN(11) && IN(pb + PL_FFN2)) { Frame F = mkframe(ldsb, A.grid);
                unsigned char* const ws = PWS(); const float* const modL = ((float*)(ws + WS_MOD)) + (size_t)L * 3 * 12288;
                unsigned cnt[8]; int pp[9]; moe_prefix(ws, cnt, pp);
                pg8::Gemm g{((bf16*)(ws + WS_U)), (const bf16*)w_d_t(ws, 0), FF / 2, FF / 2}; pg8::MoeOrder S; S.init(cnt, D / 256, F.G, F.bx, 0);
                pg8::EpiBf16Plain E{((bf16*)(ws + WS_Z)), D, 1.0f / (FSC_HID * FSC_WD)};
                const int nfr = S.nunits / F.G, R = S.nunits - nfr * F.G; const bool split = (F.G % 8 == 0) && R > 0 && 2 * R <= F.G && R <= 128;
                if (split) S.lim = nfr * (F.G / 8);
                pg8::gemm_phase<pg8::EpiBf16Plain, pg8::MoeOrder, true, true, true>(ring, g, S, E);
                if (split) { pg8::MoeRemOrder RS; RS.M = S; RS.S = (4 * R <= F.G && R <= 64) ? 4 : 2; RS.ntp = FF / 2 / (2 * 64); RS.rmax = 32 / RS.S;
                    pg8::Gemm g2{((bf16*)(ws + WS_U)), (const bf16*)w_d_t(ws, 0), FF / 2, FF / 2, (float*)(ws + WS_PART), ((unsigned*)(ws + WS_CTL)) + CW_SK};
                    pg8::gemm_phase<pg8::EpiBf16Plain, pg8::MoeRemOrder, true, true, true, true>(ring, g2, RS, E); }
                SEAM(pb + PL_FFN2);
            }
            if (EN(12) && IN(pb + PL_LN2)) { Frame F = mkframe(ldsb, A.grid); ln2_moe(F, L); }
        }
    }
__global__ void __launch_bounds__(NTHR, 2) fwd_kernel(Args A) {
    __shared__ __attribute__((aligned(16))) unsigned char lds[LDS_BYTES];
    LAS unsigned char* const ldsb = (LAS unsigned char*)lds;
    { Frame F = mkframe(ldsb, A.grid);
    for (int u = F.tid; u < (LDS_BYTES - LDSCTL_OFF) / 4; u += NTHR) ((LAS unsigned*)(F.lds + LDSCTL_OFF))[u] = 0u;
    __syncthreads();
    if (F.tid < 32) { const unsigned long long p = F.tid < 30 ? (unsigned long long)A.in[F.tid] : (F.tid == 30 ? (unsigned long long)A.out : (unsigned long long)A.ws);
        ((LAS unsigned long long*)(F.lds + PTAB_OFF))[F.tid] = p; }
    __syncthreads(); }
#if MK_ONE_LAUNCH
    XcdBarrier bar; { Frame F = mkframe(ldsb, A.grid); bar = xcd_barrier_post((unsigned*)(PWS() + WS_CTL) + CW_BAR, F.MISC + 8, (unsigned)A.grid); }
#else
    XcdBarrier bar; bar.bar = nullptr; bar.x = 0; bar.grid = 0; bar.st = nullptr;
#endif
    const int lo = A.ph_lo, hi = A.ph_hi;
    LAS unsigned char* const ring = ldsb + RING_OFF;

    if (EN(0) && IN(0)) { Frame F = mkframe(ldsb, A.grid); p0a_prologue(F); if (DUP(0)) { __syncthreads(); p0a_prologue(F); } SEAM(0); }
    if (EN(1) && IN(1)) { Frame F = mkframe(ldsb, A.grid); p0b_modulate(F); if (DUP(1)) { __syncthreads(); p0b_modulate(F); } SEAM(1); }
    layer_phases<0>(A, ldsb, bar, lo, hi);
    layer_phases<1>(A, ldsb, bar, lo, hi);
}

extern "C" void kernel_launch(void* const* d_in, const int* in_sizes, int n_in, void* d_out, int out_size, void* d_ws, size_t ws_size, hipStream_t stream) {
    static int grid = 0;
    if (grid == 0) {
        if (n_in != 30 || out_size != NLAT * D || ws_size < WS_END) { fprintf(stderr, "kernel_launch: unexpected shapes (n_in %d out %d ws %zu); nothing launched\n", n_in, out_size, ws_size); grid = -1; return; }
        int dev = 0, cus = 0, per_cu = 0;
        if (hipGetDevice(&dev) != hipSuccess || hipDeviceGetAttribute(&cus, hipDeviceAttributeMultiprocessorCount, dev) != hipSuccess) { grid = -1; return; }
        if (hipOccupancyMaxActiveBlocksPerMultiprocessor(&per_cu, (const void*)fwd_kernel, NTHR, 0) != hipSuccess || per_cu < 1) { fprintf(stderr, "kernel_launch: occupancy query says %d\n", per_cu); (void)hipGetLastError(); grid = -1; return; }
        grid = cus;
    }
    if (grid < 0) return;
    (void)hipMemsetAsync((char*)d_ws + WS_CTL, 0, CTL_ZERO_BYTES, stream);
    Args a{};
    for (int i = 0; i < 30; ++i) a.in[i] = (const float*)d_in[i];
    a.out = (float*)d_out; a.ws = (unsigned char*)d_ws; a.grid = grid;
#if MK_ONE_LAUNCH
    a.ph_lo = 0; a.ph_hi = NPH;
    hipLaunchKernelGGL(fwd_kernel, dim3(grid), dim3(NTHR), 0, stream, a);
#else
#ifndef NPH_RUN
#define NPH_RUN NPH
#endif
    for (int p = 0; p < NPH_RUN; ++p) {
        if (p == 2 + PL_GATHER || p == 2 + PH_PER_LAYER + PL_GATHER) continue;
        a.ph_lo = p; a.ph_hi = p + 1;
        hipLaunchKernelGGL(fwd_kernel, dim3(grid), dim3(NTHR), 0, stream, a);
    }
#endif
}
```

```cpp
#include <hip/hip_runtime.h>
#include <cstdio>

namespace pg8 {
#define PG8_LAS __attribute__((address_space(3)))
typedef unsigned short bf16_t;
typedef short bf16x8 __attribute__((ext_vector_type(8)));
typedef float f32x4 __attribute__((ext_vector_type(4)));
typedef unsigned u32x4 __attribute__((ext_vector_type(4)));
typedef unsigned u32x2 __attribute__((ext_vector_type(2)));
typedef float f32x2 __attribute__((ext_vector_type(2)));
typedef int i32x4 __attribute__((ext_vector_type(4)));
typedef int i32x8 __attribute__((ext_vector_type(8)));
constexpr int BM = 256, BK = 64, HALF = 128, HTB = HALF * BK * 2  , STAGE_BYTES = 8 * HTB, NXCD = 8, WGM = 4;

__host__ __device__ __forceinline__ int lds_byte(int r, int c) { const int st = (r >> 4) * 2 + (c >> 5), rr = r & 15, cc = c & 31, ob = rr * 64 + cc * 2; return st * 1024 + (ob ^ (((ob >> 9) & 1) << 5)); }
__host__ __device__ __forceinline__ void stage_rc(int b, int& R, int& C) { const int st = b / 1024, sb = b % 1024, swz = sb ^ (((sb >> 9) & 1) << 5); R = (st >> 1) * 16 + swz / 64; C = (st & 1) * 32 + (swz % 64) / 2; }
__host__ __device__ __forceinline__ int perm32(int rho) { const int n = rho >> 4, i = rho & 15; return 8 * (i >> 2) + 4 * n + (i & 3); }

struct Unit { int pm, pn, pa, pb, ko, aux, sk; };
struct Gemm { const bf16_t* A; const bf16_t* Bt; int K, KT; float* skpart; unsigned* skcnt; };

__device__ __forceinline__ int xcd_remap(int wgid, int nwg) { const int q = nwg / NXCD, r = nwg % NXCD, xcd = wgid % NXCD, off = wgid / NXCD; return (xcd < r ? xcd * (q + 1) : r * (q + 1) + (xcd - r) * q) + off; }
struct StaticOrder {
    int nM, nN, nwg, G, c;
    __host__ __device__ void init(int M, int N, int G_, int c_) { nM = M / BM; nN = N / BM; nwg = nM * nN; G = G_; c = c_; }
    __device__ __forceinline__ bool next(int i, Unit& u) const {
        const long L = (long)i * G + c; if (L >= nwg) return false;
        const int wgid = xcd_remap((int)L, nwg);
        const int nig = WGM * nN, gid = wgid / nig, fm = gid * WGM, gsz = (nM - fm) < WGM ? (nM - fm) : WGM;
        u.pm = fm + ((wgid % nig) % gsz); u.pn = (wgid % nig) / gsz; u.pa = u.pm; u.pb = u.pn; u.ko = 0; u.aux = 0; return true;
    }
    __device__ __forceinline__ void a_ready(const Unit&) const {}
    __device__ __forceinline__ void done(const Unit&) const {}
};
struct MoeOrder {
    int nN, G, c, nunits, abucket, lim; int pp[9];
    __device__ __forceinline__ void init(const unsigned* cnt, int nN_, int G_, int c_, int abucket_) { nN = nN_; G = G_; c = c_; abucket = abucket_; pp[0] = 0; lim = 1 << 30;
#pragma unroll
        for (int e = 0; e < 8; ++e) pp[e + 1] = pp[e] + (int)((cnt[e] + 255u) >> 8);
        nunits = pp[8] * nN; }
    __device__ __forceinline__ void decode(int wgid, Unit& u) const {
        int e = 0, base = 0, npe = pp[1];
#pragma unroll
        for (int k = 1; k < 8; ++k) { if (wgid >= pp[k] * nN) { e = k; base = pp[k]; npe = pp[k + 1] - pp[k]; } }
        if (npe < 1) npe = 1;
        const int local = wgid - base * nN;
        const int nig = WGM * nN, gid = local / nig, fm = gid * WGM, gsz = (npe - fm) < WGM ? (npe - fm) : WGM, pl = fm + (local - gid * nig) % gsz;
        u.pm = base + pl; u.pn = (local - gid * nig) / gsz; u.pa = abucket ? e * abucket + pl : u.pm; u.pb = e * nN + u.pn; u.ko = 0; u.aux = 0; u.sk = 0; }
    __device__ __forceinline__ bool next(int i, Unit& u) const {
        const long L = (long)i * G + c; if (L >= nunits || (int)(L / NXCD) >= lim) return false;
        decode(xcd_remap((int)L, nunits), u); return true;
    }
    __device__ __forceinline__ void a_ready(const Unit&) const {}
    __device__ __forceinline__ void done(const Unit&) const {}
};
struct MoeRemOrder {
    MoeOrder M; int S, ntp, rmax;
    __device__ __forceinline__ bool next(int i, Unit& u) const {
        const long L = (long)i * M.G + M.c; const int x = (int)(L % NXCD), lp = (int)(L / NXCD);
        const int q = M.nunits / NXCD, r = M.nunits % NXCD, nx = q + (x < r ? 1 : 0), rem = nx - M.lim;
        if (rem <= 0 || lp >= S * rem) return false;
        const int s = lp / rem, j = lp - s * rem, pq = ntp / S, pr = ntp % S, p0 = s * pq + (s < pr ? s : pr), pn = pq + (s < pr ? 1 : 0);
        M.decode((x < r ? x * (q + 1) : r * (q + 1) + (x - r) * q) + M.lim + j, u); u.ko = p0 * 2 * BK; u.sk = (x * rmax + j) | (s << 16) | (S << 20) | ((2 * pn) << 24); return true;
    }
    __device__ __forceinline__ void a_ready(const Unit&) const {}
    __device__ __forceinline__ void done(const Unit&) const {}
};

struct BranchOrder {
    StaticOrder S; int apanels, bpanels, nctx, pm0, nN;
    __device__ __forceinline__ void init(int M, int N, int G_, int c_, int apan, int bpan, int nctx_) { S.init(M, N, G_, c_); apanels = apan; bpanels = bpan; nctx = nctx_; pm0 = M / BM; nN = N / BM; }
    __device__ __forceinline__ bool next(int i, Unit& u) const {
        const int j = i / 3, b = i - 3 * j;
        if (S.next(j, u)) { u.pa = b * apanels + u.pm; u.pb = b * bpanels + u.pn; u.aux = b; return true; }
        const int nlat = S.c < S.nwg ? (S.nwg - S.c + S.G - 1) / S.G : 0, q = i - 3 * nlat; if (q < 0) return false;
        const long id = (long)q * S.G + S.c; if (id >= nctx) return false;
        const int t = (int)id / 3, bb = (int)id - 3 * t;
        u.pm = pm0 + t / nN; u.pn = t % nN; u.pa = bb * apanels + u.pm; u.pb = bb * bpanels + u.pn; u.ko = 0; u.aux = 4 + bb; return true;
    }
    __device__ __forceinline__ void a_ready(const Unit&) const {}
    __device__ __forceinline__ void done(const Unit&) const {}
};
struct SplitOrder {
    int pm0, nN, nsplit, KT, G, c, pa_base, asplit;
    __device__ __forceinline__ void init(int pm0_, int nN_, int nsplit_, int KT_, int G_, int c_, int pa_base_, int asplit_) { pm0 = pm0_; nN = nN_; nsplit = nsplit_; KT = KT_; G = G_; c = c_; pa_base = pa_base_; asplit = asplit_; }
    __device__ __forceinline__ bool next(int i, Unit& u) const {
        const long L = (long)i * G + c; if (L >= 2 * nN * nsplit) return false;
        const int s = (int)L % nsplit, tile = (int)L / nsplit;
        u.pm = pm0 + tile / nN; u.pn = tile % nN; u.pa = pa_base + (s / asplit) * 2 + tile / nN; u.pb = u.pn; u.ko = (s % asplit) * KT; u.aux = s; return true;
    }
    __device__ __forceinline__ void a_ready(const Unit&) const {}
    __device__ __forceinline__ void done(const Unit&) const {}
};

typedef __bf16 bf16x2n __attribute__((ext_vector_type(2)));
__device__ __forceinline__ unsigned cvt_pk_bf16(float lo, float hi) { const bf16x2n v = {(__bf16)lo, (__bf16)hi}; return __builtin_bit_cast(unsigned, v); }
__device__ __forceinline__ unsigned pk_fp8x4(float a, float b, float c, float d) { int v = __builtin_amdgcn_cvt_pk_fp8_f32(a, b, 0, false); v = __builtin_amdgcn_cvt_pk_fp8_f32(c, d, v, true); return (unsigned)v; }
__device__ __forceinline__ float clamp448(float x) { return fminf(fmaxf(x, -448.0f), 448.0f); }
__device__ __forceinline__ float bf_lo(unsigned w) { return __uint_as_float(w << 16); }
__device__ __forceinline__ float bf_hi(unsigned w) { return __uint_as_float(w & 0xffff0000u); }
__device__ __forceinline__ float fast_sigmoid(float x) { return __builtin_amdgcn_rcpf(1.0f + __expf(-x)); }

struct EpiBf16Plain {
    static constexpr bool PERM = true, AFTER_DRAIN = false;
    bf16_t* O; int ldc; float oscale;
    __device__ __forceinline__ void operator()(const f32x4 (&acc)[2][2][4][2], const Unit& u, int wr, int wc, int fr, int fq) const {
        const int row0 = u.pm * BM + wr * 64 + fr, col0 = u.pn * BM + wc * 32 + 8 * fq;
#pragma unroll
        for (int ai = 0; ai < 2; ++ai)
#pragma unroll
            for (int m = 0; m < 4; ++m) { bf16_t* rowp = O + (size_t)(row0 + ai * HALF + m * 16) * ldc + col0;
#pragma unroll
                for (int bj = 0; bj < 2; ++bj) { const f32x4 v0 = acc[ai][bj][m][0] * oscale, v1 = acc[ai][bj][m][1] * oscale;
                    u32x4 w; w.x = cvt_pk_bf16(v0[0], v0[1]); w.y = cvt_pk_bf16(v0[2], v0[3]); w.z = cvt_pk_bf16(v1[0], v1[1]); w.w = cvt_pk_bf16(v1[2], v1[3]);
                    *(u32x4*)(rowp + bj * HALF) = w; } }
    }
};
struct EpiU {
    static constexpr bool PERM = true, AFTER_DRAIN = false;
    bf16_t* O; int ldc; float oscale; unsigned char* G8; unsigned char* KF;
    __device__ __forceinline__ void operator()(const f32x4 (&acc)[2][2][4][2], const Unit& u, int wr, int wc, int fr, int fq) const {
        const int row0 = u.pm * BM + wr * 64 + fr, col0 = u.pn * BM + wc * 32 + 8 * fq;
        if (u.pn >= 36) {
            unsigned char* tp = G8 + ((size_t)(u.pm * 24 + (u.pn - 36)) * 8 * 512 + (size_t)((wr * 4 + wc) * 64 + fq * 16 + fr)) * 16;
#pragma unroll
            for (int ai = 0; ai < 2; ++ai)
#pragma unroll
                for (int m = 0; m < 4; ++m) { u32x4 w;
#pragma unroll
                    for (int bj = 0; bj < 2; ++bj) { const f32x4 v0 = acc[ai][bj][m][0] * oscale, v1 = acc[ai][bj][m][1] * oscale;
                        const unsigned lo = pk_fp8x4(clamp448(v0[0]), clamp448(v0[1]), clamp448(v0[2]), clamp448(v0[3])), hi = pk_fp8x4(clamp448(v1[0]), clamp448(v1[1]), clamp448(v1[2]), clamp448(v1[3]));
                        if (bj == 0) { w.x = lo; w.y = hi; } else { w.z = lo; w.w = hi; } }
                    *(u32x4*)(tp + (size_t)(ai * 4 + m) * 512 * 16) = w; }
            return; }
        const bool is_gq = (u.pn == 12 || u.pn == 13), is_gk = (u.pn == 14 || u.pn == 15), is_nq = (u.pn >= 24 && u.pn < 28), is_nk = (u.pn >= 28 && u.pn < 32);
        const float sc = ((is_gq || is_nq) ? 0.08838834764831845f : 1.0f) * oscale;
        const bool rope = (is_gq || is_gk) && u.pm < 32;
        float inv[4];
#pragma unroll
        for (int j = 0; j < 4; ++j) inv[j] = exp2f(-(float)((16 * wc + 4 * fq + j) & 31) * 0.41524101186092029f);
#pragma unroll
        for (int ai = 0; ai < 2; ++ai)
#pragma unroll
            for (int m = 0; m < 4; ++m) { const int row = row0 + ai * HALF + m * 16; bf16_t* rowp = O + (size_t)row * ldc + col0;
                const int t = row & 4095; const float pos = (wc < 2) ? (float)(t >> 6) : (float)(t & 63);
                float cs[4], sn[4];
                if (rope) {
#pragma unroll
                    for (int j = 0; j < 4; ++j) { const float ang = pos * inv[j]; cs[j] = __cosf(ang); sn[j] = __sinf(ang); } }
#pragma unroll
                for (int bj = 0; bj < 2; ++bj) { f32x4 v0 = acc[ai][bj][m][0] * sc, v1 = acc[ai][bj][m][1] * sc;
                    if (rope) { const f32x4 a = v0, b = v1;
                        v0[0] = a[0] * cs[0] - a[1] * sn[0]; v0[1] = a[0] * sn[0] + a[1] * cs[0]; v0[2] = a[2] * cs[1] - a[3] * sn[1]; v0[3] = a[2] * sn[1] + a[3] * cs[1];
                        v1[0] = b[0] * cs[2] - b[1] * sn[2]; v1[1] = b[0] * sn[2] + b[1] * cs[2]; v1[2] = b[2] * cs[3] - b[3] * sn[3]; v1[3] = b[2] * sn[3] + b[3] * cs[3]; }
                    u32x4 w; w.x = cvt_pk_bf16(v0[0], v0[1]); w.y = cvt_pk_bf16(v0[2], v0[3]); w.z = cvt_pk_bf16(v1[0], v1[1]); w.w = cvt_pk_bf16(v1[2], v1[3]);
                    if (is_nk) { const int c = col0 + bj * HALF - 7168, h = c >> 7, d = c & 127;
                        *(u32x4*)(KF + ((size_t)(h * 1088 + (row >> 3)) * 4 + (d >> 5)) * 512 + (row & 7) * 64 + ((d >> 3) & 3) * 16) = w; }
                    else *(u32x4*)(rowp + bj * HALF) = w; } }
    }
};
struct EpiF32Plain {
    static constexpr bool PERM = false, AFTER_DRAIN = false;
    float* C; int ldc; float oscale;
    __device__ __forceinline__ void operator()(const f32x4 (&acc)[2][2][4][2], const Unit& u, int wr, int wc, int fr, int fq) const {
        const int row0 = u.pm * BM + wr * 64 + fr, col0 = u.pn * BM + wc * 32 + 4 * fq;
#pragma unroll
        for (int ai = 0; ai < 2; ++ai)
#pragma unroll
            for (int m = 0; m < 4; ++m) { float* rowp = C + (size_t)(row0 + ai * HALF + m * 16) * ldc + col0;
#pragma unroll
                for (int bj = 0; bj < 2; ++bj)
#pragma unroll
                    for (int n = 0; n < 2; ++n) *(f32x4*)(rowp + bj * HALF + n * 16) = acc[ai][bj][m][n] * oscale; }
    }
};
template <bool SC> struct EpiPartial {
    static constexpr bool PERM = true, AFTER_DRAIN = false;
    float* P; int pm0; float oscale;
    __device__ __forceinline__ void operator()(const f32x4 (&acc)[2][2][4][2], const Unit& u, int wr, int wc, int fr, int fq) const {
        const int row0 = (u.pm - pm0) * BM + wr * 64 + fr, col0 = u.pn * BM + wc * 32 + 8 * fq; float* base = P + (size_t)u.aux * 512 * 2048;
#pragma unroll
        for (int ai = 0; ai < 2; ++ai)
#pragma unroll
            for (int m = 0; m < 4; ++m) { float* rowp = base + (size_t)(row0 + ai * HALF + m * 16) * 2048 + col0;
#pragma unroll
                for (int bj = 0; bj < 2; ++bj)
#pragma unroll
                    for (int n = 0; n < 2; ++n) *(f32x4*)(rowp + bj * HALF + n * 4) = SC ? acc[ai][bj][m][n] * oscale : acc[ai][bj][m][n]; }
    }
};
struct EpiGate {
    static constexpr bool PERM = true, AFTER_DRAIN = false;
    const unsigned char* Ug; int ldu;
    const float* gb;
    bf16_t* ZB;
    unsigned char* ZT;
    bf16_t* ZBP;
    __device__ __forceinline__ void operator()(const f32x4 (&acc)[2][2][4][2], const Unit& u, int wr, int wc, int fr, int fq) const {
        const int row0 = u.pm * BM + wr * 64 + fr, col0 = u.pn * BM + wc * 32 + 8 * fq, br = u.aux & 3; const bool first = u.aux == 0 || u.aux >= 4;
        const unsigned char* Ub = Ug + ((size_t)(u.pm * 24 + br * 8 + u.pn) * 8 * 512 + (size_t)((wr * 4 + wc) * 64 + fq * 16 + fr)) * 16; const float* gbb = gb + 2048 * br + col0;
        bf16_t* zb = (u.aux >= 4 ? ZBP + ((size_t)br * 512 - 8192) * 2048 : ZB) + col0;
        const bool tm_wr = u.aux < 2;
        unsigned char* zt = ZT + ((size_t)(u.pm * 8 + u.pn) * 16 * 512 + (size_t)((wr * 4 + wc) * 64 + fq * 16 + fr)) * 16;
        f32x4 b4[2][2];
#pragma unroll
        for (int bj = 0; bj < 2; ++bj)
#pragma unroll
            for (int n = 0; n < 2; ++n) b4[bj][n] = *(const f32x4*)(gbb + bj * HALF + n * 4);
#pragma unroll
        for (int ai = 0; ai < 2; ++ai) {
            u32x4 gl[4]; u32x4 zp[4][2];
#pragma unroll
            for (int m = 0; m < 4; ++m) { const size_t row = (size_t)(row0 + ai * HALF + m * 16); gl[m] = *(const u32x4*)(Ub + (size_t)(ai * 4 + m) * 512 * 16);
#pragma unroll
                for (int bj = 0; bj < 2; ++bj) { if (!first) zp[m][bj] = *(const u32x4*)(zt + (size_t)((ai * 4 + m) * 2 + bj) * 512 * 16); } }
            (void)0;
#pragma unroll
            for (int m = 0; m < 4; ++m) { const size_t row = (size_t)(row0 + ai * HALF + m * 16);
#pragma unroll
                for (int bj = 0; bj < 2; ++bj) { u32x2 g2; g2.x = bj ? gl[m].z : gl[m].x; g2.y = bj ? gl[m].w : gl[m].y; f32x4 v0 = acc[ai][bj][m][0], v1 = acc[ai][bj][m][1];
                    const f32x2 ga = __builtin_amdgcn_cvt_pk_f32_fp8((int)g2.x, false), gb2 = __builtin_amdgcn_cvt_pk_f32_fp8((int)g2.x, true), gc = __builtin_amdgcn_cvt_pk_f32_fp8((int)g2.y, false), gd = __builtin_amdgcn_cvt_pk_f32_fp8((int)g2.y, true);
                    v0[0] *= fast_sigmoid(ga[0] + b4[bj][0][0]); v0[1] *= fast_sigmoid(ga[1] + b4[bj][0][1]); v0[2] *= fast_sigmoid(gb2[0] + b4[bj][0][2]); v0[3] *= fast_sigmoid(gb2[1] + b4[bj][0][3]);
                    v1[0] *= fast_sigmoid(gc[0] + b4[bj][1][0]); v1[1] *= fast_sigmoid(gc[1] + b4[bj][1][1]); v1[2] *= fast_sigmoid(gd[0] + b4[bj][1][2]); v1[3] *= fast_sigmoid(gd[1] + b4[bj][1][3]);
                    if (!first) { const u32x4 z4 = zp[m][bj]; v0[0] += bf_lo(z4.x); v0[1] += bf_hi(z4.x); v0[2] += bf_lo(z4.y); v0[3] += bf_hi(z4.y); v1[0] += bf_lo(z4.z); v1[1] += bf_hi(z4.z); v1[2] += bf_lo(z4.w); v1[3] += bf_hi(z4.w); }
                    u32x4 w; w.x = cvt_pk_bf16(v0[0], v0[1]); w.y = cvt_pk_bf16(v0[2], v0[3]); w.z = cvt_pk_bf16(v1[0], v1[1]); w.w = cvt_pk_bf16(v1[2], v1[3]);
                    if (tm_wr) *(u32x4*)(zt + (size_t)((ai * 4 + m) * 2 + bj) * 512 * 16) = w; else *(u32x4*)(zb + row * 2048 + bj * HALF) = w; } }
            asm volatile("" ::: "memory"); }
    }
};
template <bool SC> struct EpiRes {
    static constexpr bool PERM = true, AFTER_DRAIN = false;
    const float* res_lat; const float* res_ctx; const float* gv; int gstride; float* out; float alpha, oscale;
    __device__ __forceinline__ void operator()(const f32x4 (&acc)[2][2][4][2], const Unit& u, int wr, int wc, int fr, int fq) const {
        const int grp = u.pm < 16 ? 0 : (u.pm < 32 ? 1 : 2);
        const int rl0 = wr * 64 + fr, col0 = u.pn * BM + wc * 32 + 8 * fq;
        const float* res = (u.pm < 32 ? res_lat + (size_t)u.pm * BM * 2048 : res_ctx + (size_t)(u.pm - 32) * BM * 2048) + col0;
        const float* g = gv + (size_t)grp * gstride + col0; float* o = out + (size_t)u.pm * BM * 2048 + col0;
        f32x4 g4[2][2];
#pragma unroll
        for (int bj = 0; bj < 2; ++bj)
#pragma unroll
            for (int n = 0; n < 2; ++n) g4[bj][n] = *(const f32x4*)(g + bj * HALF + n * 4);
#pragma unroll
        for (int q = 0; q < 4; ++q) {
            const int ai = q >> 1, m0 = (q & 1) * 2;
            f32x4 r4[2][2][2];
#pragma unroll
            for (int m = 0; m < 2; ++m)
#pragma unroll
                for (int bj = 0; bj < 2; ++bj)
#pragma unroll
                    for (int n = 0; n < 2; ++n) r4[m][bj][n] = *(const f32x4*)(res + (size_t)(rl0 + ai * HALF + (m0 + m) * 16) * 2048 + bj * HALF + n * 4);
#pragma unroll
            for (int m = 0; m < 2; ++m)
#pragma unroll
                for (int bj = 0; bj < 2; ++bj)
#pragma unroll
                    for (int n = 0; n < 2; ++n) *(f32x4*)(o + (size_t)(rl0 + ai * HALF + (m0 + m) * 16) * 2048 + bj * HALF + n * 4) = r4[m][bj][n] * alpha + g4[bj][n] * (SC ? acc[ai][bj][m0 + m][n] * oscale : acc[ai][bj][m0 + m][n]);
            asm volatile("" ::: "memory"); }
    }
};
template <bool SC> struct EpiDelta {
    static constexpr bool PERM = true, AFTER_DRAIN = false;
    const float* gv; int gstride; bf16_t* out; float oscale;
    __device__ __forceinline__ void operator()(const f32x4 (&acc)[2][2][4][2], const Unit& u, int wr, int wc, int fr, int fq) const {
        const int grp = u.pm < 16 ? 0 : (u.pm < 32 ? 1 : 2);
        const int row0 = u.pm * BM + wr * 64 + fr, col0 = u.pn * BM + wc * 32 + 8 * fq;
        const float* g = gv + (size_t)grp * gstride + col0;
        f32x4 g4[2][2];
#pragma unroll
        for (int bj = 0; bj < 2; ++bj)
#pragma unroll
            for (int n = 0; n < 2; ++n) { g4[bj][n] = *(const f32x4*)(g + bj * HALF + n * 4); if (SC) g4[bj][n] = g4[bj][n] * oscale; }
#pragma unroll
        for (int ai = 0; ai < 2; ++ai)
#pragma unroll
            for (int m = 0; m < 4; ++m) { bf16_t* rowp = out + (size_t)(row0 + ai * HALF + m * 16) * 2048 + col0;
#pragma unroll
                for (int bj = 0; bj < 2; ++bj) { const f32x4 v0 = acc[ai][bj][m][0] * g4[bj][0], v1 = acc[ai][bj][m][1] * g4[bj][1];
                    u32x4 w; w.x = cvt_pk_bf16(v0[0], v0[1]); w.y = cvt_pk_bf16(v0[2], v0[3]); w.z = cvt_pk_bf16(v1[0], v1[1]); w.w = cvt_pk_bf16(v1[2], v1[3]);
                    *(u32x4*)(rowp + bj * HALF) = w; } }
    }
};
struct EpiSwiGLU {
    static constexpr bool PERM = true, AFTER_DRAIN = false;
    bf16_t* O; int ldc;
    __device__ __forceinline__ void operator()(const f32x4 (&acc)[2][2][4][2], const Unit& u, int wr, int wc, int fr, int fq) const {
        const int row0 = u.pm * BM + wr * 64 + fr, col0 = u.pn * HALF + wc * 32 + 8 * fq;
#pragma unroll
        for (int ai = 0; ai < 2; ++ai)
#pragma unroll
            for (int m = 0; m < 4; ++m) { bf16_t* rowp = O + (size_t)(row0 + ai * HALF + m * 16) * ldc + col0;
                float h[8];
#pragma unroll
                for (int n = 0; n < 2; ++n)
#pragma unroll
                    for (int j = 0; j < 4; ++j) { const float gt = acc[ai][0][m][n][j], up = acc[ai][1][m][n][j]; h[n * 4 + j] = gt * fast_sigmoid(gt) * up; }
                u32x4 w; w.x = cvt_pk_bf16(h[0], h[1]); w.y = cvt_pk_bf16(h[2], h[3]); w.z = cvt_pk_bf16(h[4], h[5]); w.w = cvt_pk_bf16(h[6], h[7]);
                *(u32x4*)rowp = w; }
    }
};
struct EpiSwiGLU8 {
    static constexpr bool PERM = true, AFTER_DRAIN = false;
    unsigned char* O; int ldc; float oscale, hscale;
    __device__ __forceinline__ void operator()(const f32x4 (&acc)[2][2][4][2], const Unit& u, int wr, int wc, int fr, int fq) const {
        const int row0 = u.pm * BM + wr * 64 + fr, col0 = u.pn * HALF + wc * 32 + 8 * fq;
#pragma unroll
        for (int ai = 0; ai < 2; ++ai)
#pragma unroll
            for (int m = 0; m < 4; ++m) { unsigned char* rowp = O + (size_t)(row0 + ai * HALF + m * 16) * ldc + col0;
                float h[8];
#pragma unroll
                for (int n = 0; n < 2; ++n)
#pragma unroll
                    for (int j = 0; j < 4; ++j) { const float gt = acc[ai][0][m][n][j] * oscale, up = acc[ai][1][m][n][j] * oscale; h[n * 4 + j] = clamp448(gt * fast_sigmoid(gt) * up * hscale); }
                u32x2 w; w.x = pk_fp8x4(h[0], h[1], h[2], h[3]); w.y = pk_fp8x4(h[4], h[5], h[6], h[7]);
                *(u32x2*)rowp = w; }
    }
};

template <class Epi, class Sched, bool ALIGN_EPI = false, bool SP2 = false, bool F8 = false, bool SK = false>
__device__ __forceinline__ void gemm_phase(PG8_LAS unsigned char* lds, const Gemm g, const Sched& S, const Epi& E) {
    int tid_ = threadIdx.x; asm volatile("" : "+v"(tid_));
    const int tid = tid_, wid = __builtin_amdgcn_readfirstlane(tid >> 6), lane = tid & 63, wr = wid >> 2, wc = wid & 3, fr = lane & 15, fq = lane >> 4;
    const int K = g.K, nt0 = g.KT / BK;
    unsigned voffA[2], voffB[2];
#pragma unroll
    for (int i = 0; i < 2; ++i) { int R, C; stage_rc(tid * 16 + i * 8192, R, C); const int Rb = Epi::PERM ? ((R & ~31) + perm32(R & 31)) : R;
        voffA[i] = (unsigned)(R * K + C) * 2u; voffB[i] = (unsigned)(Rb * K + C) * 2u; }
    const size_t kstep = (size_t)(BK * 2);
    const size_t hstep = (size_t)HALF * K * 2;
    const size_t tstep = 2 * hstep;
    const unsigned ldsw = (unsigned)wid * 1024u;
    const int aoff = lds_byte(wr * 64 + fr, fq * 8), boff = lds_byte(wc * 32 + fr, fq * 8);
#define PG8_SA(b, h) (((b) * 2 + (h)) * HTB)
#define PG8_SB(b, h) ((4 + (b) * 2 + (h)) * HTB)
#define PG8_STAGE(bufoff, gbase, voff) do { _Pragma("unroll") for (int _i = 0; _i < 2; ++_i) \
        __builtin_amdgcn_global_load_lds((const unsigned*)((const char*)(gbase) + (voff)[_i]), (PG8_LAS unsigned*)(lds + (bufoff) + ldsw + _i * 8192), 16, 0, 0); } while (0)
#define PG8_CAT(p) __builtin_shufflevector(*(const PG8_LAS i32x4*)(p), *(const PG8_LAS i32x4*)((p) + 1024), 0, 1, 2, 3, 4, 5, 6, 7)
#define PG8_LDA(dst, b, h) do { _Pragma("unroll") for (int m = 0; m < 4; ++m) { if constexpr (F8) dst##8[m] = PG8_CAT(lds + PG8_SA(b, h) + aoff + m * 2048); else { _Pragma("unroll") for (int k = 0; k < 2; ++k) dst[m][k] = *(const PG8_LAS bf16x8*)(lds + PG8_SA(b, h) + aoff + m * 2048 + k * 1024); } } } while (0)
#define PG8_LDB(dst, b, h) do { _Pragma("unroll") for (int n = 0; n < 2; ++n) { if constexpr (F8) dst##8[n] = PG8_CAT(lds + PG8_SB(b, h) + boff + n * 2048); else { _Pragma("unroll") for (int k = 0; k < 2; ++k) dst[n][k] = *(const PG8_LAS bf16x8*)(lds + PG8_SB(b, h) + boff + n * 2048 + k * 1024); } } } while (0)
#define PG8_MMA(ai, bj, At, Bt) do { __builtin_amdgcn_s_setprio(1); _Pragma("unroll") for (int m = 0; m < 4; ++m) _Pragma("unroll") for (int n = 0; n < 2; ++n) { \
        if constexpr (F8) asm volatile("v_mfma_f32_16x16x128_f8f6f4 %0, %1, %2, %0" : "+v"(acc[ai][bj][m][n]) : "v"(Bt##8[n]), "v"(At##8[m]));       \
        else { _Pragma("unroll") for (int k = 0; k < 2; ++k) acc[ai][bj][m][n] = __builtin_amdgcn_mfma_f32_16x16x32_bf16(Bt[n][k], At[m][k], acc[ai][bj][m][n], 0, 0, 0); } } \
        __builtin_amdgcn_s_setprio(0); } while (0)
#define PG8_GAS __attribute__((address_space(1)))
#define PG8_WAIT_V(n) asm volatile("s_waitcnt vmcnt(" #n ")" ::: "memory")
#define PG8_WAIT_L(n) asm volatile("s_waitcnt lgkmcnt(" #n ")" ::: "memory")
#define PG8_BAR __builtin_amdgcn_s_barrier()
#define PG8_SCHED __builtin_amdgcn_sched_barrier(0)
    Unit cur, nxt; int ui = 0;
    if (!S.next(0, cur)) return;
    f32x4 acc[2][2][4][2];
#pragma unroll
    for (int a = 0; a < 2; ++a)
#pragma unroll
        for (int b = 0; b < 2; ++b)
#pragma unroll
            for (int m = 0; m < 4; ++m)
#pragma unroll
                for (int n = 0; n < 2; ++n) acc[a][b][m][n] = (f32x4){0.f, 0.f, 0.f, 0.f};
    const int f8one = 0x7f7f7f7f;
    bf16x8 At[4][2], B0[2][2], B1[2][2];
    i32x8 At8[4], B08[2], B18[2];
    const char* cA = (const char*)g.A + (size_t)cur.pa * tstep + (size_t)cur.ko * 2; const char* cB = (const char*)g.Bt + (size_t)cur.pb * tstep + (size_t)cur.ko * 2;
    S.a_ready(cur);
    if constexpr (SP2) {
        PG8_STAGE(PG8_SB(0, 0), cB, voffB); PG8_STAGE(PG8_SB(0, 1), cB + hstep, voffB); PG8_STAGE(PG8_SA(0, 0), cA, voffA); PG8_STAGE(PG8_SA(0, 1), cA + hstep, voffA);
        if (wr == 1) PG8_BAR;
        PG8_WAIT_V(2); PG8_BAR;
        PG8_STAGE(PG8_SB(1, 0), cB + kstep, voffB); PG8_STAGE(PG8_SA(1, 0), cA + kstep, voffA); PG8_STAGE(PG8_SB(1, 1), cB + hstep + kstep, voffB);
        PG8_WAIT_V(6); PG8_BAR;
    } else {
        PG8_STAGE(PG8_SB(0, 0), cB, voffB); PG8_STAGE(PG8_SA(0, 0), cA, voffA); PG8_STAGE(PG8_SB(0, 1), cB + hstep, voffB); PG8_STAGE(PG8_SA(0, 1), cA + hstep, voffA);
        if (wr == 1) PG8_BAR;
        PG8_WAIT_V(4); PG8_BAR;
        PG8_STAGE(PG8_SB(1, 0), cB + kstep, voffB); PG8_STAGE(PG8_SA(1, 0), cA + kstep, voffA); PG8_STAGE(PG8_SB(1, 1), cB + hstep + kstep, voffB);
        PG8_WAIT_V(6); PG8_BAR;
    }
    for (;;) {
        const bool has_next = S.next(ui + 1, nxt);
        const char* nA = has_next ? (const char*)g.A + (size_t)nxt.pa * tstep + (size_t)nxt.ko * 2 : cA; const char* nB = has_next ? (const char*)g.Bt + (size_t)nxt.pb * tstep + (size_t)nxt.ko * 2 : cB;
        const int nt = SK ? (int)(((unsigned)cur.sk >> 24) & 0xffu) : nt0;
        for (int t = 0; t < nt; t += 2) {
            const bool last = (t == nt - 2);
            const char* a1 = cA + (size_t)(t + 1) * kstep;
            const char* a2 = last ? nA : cA + (size_t)(t + 2) * kstep; const char* b2 = last ? nB : cB + (size_t)(t + 2) * kstep;
            const char* a3 = a2 + kstep; const char* b3 = b2 + kstep;
            if (last && has_next) S.a_ready(nxt);
            if constexpr (SP2) {
            PG8_LDB(B0, 0, 0); PG8_LDB(B1, 0, 1); PG8_SCHED; PG8_LDA(At, 0, 0); PG8_STAGE(PG8_SA(1, 1), a1 + hstep, voffA);
            PG8_WAIT_V(8); PG8_WAIT_L(0); PG8_BAR; PG8_MMA(0, 0, At, B0); PG8_MMA(0, 1, At, B1); PG8_BAR; PG8_SCHED;
            PG8_LDA(At, 0, 1); PG8_STAGE(PG8_SB(0, 0), b2, voffB); PG8_STAGE(PG8_SB(0, 1), b2 + hstep, voffB); PG8_STAGE(PG8_SA(0, 0), a2, voffA);
            PG8_WAIT_V(8); PG8_WAIT_L(0); PG8_BAR; PG8_MMA(1, 0, At, B0); PG8_MMA(1, 1, At, B1); PG8_BAR; PG8_SCHED;
            PG8_LDB(B0, 1, 0); PG8_LDB(B1, 1, 1); PG8_SCHED; PG8_LDA(At, 1, 0); PG8_STAGE(PG8_SA(0, 1), a2 + hstep, voffA);
            PG8_WAIT_V(8); PG8_WAIT_L(0); PG8_BAR; PG8_MMA(0, 0, At, B0); PG8_MMA(0, 1, At, B1); PG8_BAR; PG8_SCHED;
            PG8_LDA(At, 1, 1); PG8_STAGE(PG8_SB(1, 0), b3, voffB); PG8_STAGE(PG8_SB(1, 1), b3 + hstep, voffB); PG8_STAGE(PG8_SA(1, 0), a3, voffA);
            PG8_WAIT_V(8); PG8_WAIT_L(0); PG8_BAR; PG8_MMA(1, 0, At, B0); PG8_MMA(1, 1, At, B1); PG8_BAR; PG8_SCHED;
            } else {
            PG8_LDB(B0, 0, 0); PG8_SCHED; PG8_LDA(At, 0, 0); PG8_STAGE(PG8_SA(1, 1), a1 + hstep, voffA);
            PG8_WAIT_L(8); PG8_BAR; PG8_WAIT_L(0); PG8_MMA(0, 0, At, B0); PG8_BAR; PG8_SCHED;
            PG8_LDB(B1, 0, 1); PG8_STAGE(PG8_SB(0, 0), b2, voffB);
            PG8_BAR; PG8_WAIT_L(0); PG8_MMA(0, 1, At, B1); PG8_BAR;
            PG8_LDA(At, 0, 1); PG8_STAGE(PG8_SA(0, 0), a2, voffA);
            PG8_BAR; PG8_WAIT_L(0); PG8_MMA(1, 0, At, B0); PG8_BAR; PG8_SCHED;
            PG8_STAGE(PG8_SB(0, 1), b2 + hstep, voffB);
            PG8_WAIT_V(6); PG8_BAR; PG8_MMA(1, 1, At, B1); PG8_BAR;
            PG8_LDB(B0, 1, 0); PG8_SCHED; PG8_LDA(At, 1, 0); PG8_STAGE(PG8_SA(0, 1), a2 + hstep, voffA);
            PG8_WAIT_L(8); PG8_BAR; PG8_WAIT_L(0); PG8_MMA(0, 0, At, B0); PG8_BAR; PG8_SCHED;
            PG8_LDB(B1, 1, 1); PG8_STAGE(PG8_SB(1, 0), b3, voffB);
            PG8_BAR; PG8_WAIT_L(0); PG8_MMA(0, 1, At, B1); PG8_BAR;
            PG8_LDA(At, 1, 1); PG8_STAGE(PG8_SA(1, 0), a3, voffA);
            PG8_BAR; PG8_WAIT_L(0); PG8_MMA(1, 0, At, B0); PG8_BAR; PG8_SCHED;
            PG8_STAGE(PG8_SB(1, 1), b3 + hstep, voffB);
            PG8_WAIT_V(6); PG8_BAR; PG8_MMA(1, 1, At, B1); PG8_BAR;
            }
        }
        if constexpr (F8) asm volatile("s_nop 15\n\ts_nop 15\n\ts_nop 15" ::: "memory");
        if constexpr (ALIGN_EPI) { if (wr == 0) PG8_BAR; }
        if constexpr (SK) {
            const unsigned sk_ = (unsigned)cur.sk; const int ri_ = (int)(sk_ & 0xffffu), s_ = (int)((sk_ >> 16) & 15u), S_ = (int)((sk_ >> 20) & 15u);
            float* const part = g.skpart + (size_t)ri_ * (size_t)S_ * 65536; unsigned* const cntp = g.skcnt + ri_;
            { float* const ps = part + (size_t)s_ * 65536;
#pragma unroll
              for (int a = 0; a < 2; ++a)
#pragma unroll
                  for (int b = 0; b < 2; ++b)
#pragma unroll
                      for (int mh = 0; mh < 2; ++mh) { PG8_GAS f32x4* pg = (PG8_GAS f32x4*)(ps + (size_t)((a * 2 + b) * 2 + mh) * 8192) + tid * 4;
#pragma unroll
                          for (int q = 0; q < 4; ++q) pg[q] = acc[a][b][2 * mh + (q >> 1)][q & 1]; } }
            asm volatile("s_waitcnt vmcnt(0)" ::: "memory"); __syncthreads();
            if (s_ < S_ - 1) {
                if (tid == 0) { __builtin_amdgcn_fence(__ATOMIC_RELEASE, "agent"); asm volatile("s_waitcnt vmcnt(0)" ::: "memory"); (void)__hip_atomic_fetch_add(cntp, 1u, __ATOMIC_RELAXED, __HIP_MEMORY_SCOPE_AGENT); }
            } else {
                if (tid == 0) { unsigned sp_ = 0u; while (__hip_atomic_load(cntp, __ATOMIC_RELAXED, __HIP_MEMORY_SCOPE_AGENT) < (unsigned)(S_ - 1) && ++sp_ < (1u << 22)) __builtin_amdgcn_s_sleep(1);
                    __builtin_amdgcn_fence(__ATOMIC_ACQUIRE, "agent"); asm volatile("s_waitcnt vmcnt(0)" ::: "memory"); }
                __syncthreads();
                for (int s2 = 0; s2 < S_ - 1; ++s2) { const float* const ps = part + (size_t)s2 * 65536;
#pragma unroll
                    for (int a = 0; a < 2; ++a)
#pragma unroll
                        for (int b = 0; b < 2; ++b) { f32x4 t_[8];
#pragma unroll
                            for (int mh = 0; mh < 2; ++mh) { const PG8_GAS f32x4* pg = (const PG8_GAS f32x4*)(ps + (size_t)((a * 2 + b) * 2 + mh) * 8192) + tid * 4;
#pragma unroll
                                for (int q = 0; q < 4; ++q) t_[mh * 4 + q] = pg[q]; }
#pragma unroll
                            for (int mh = 0; mh < 2; ++mh)
#pragma unroll
                                for (int q = 0; q < 4; ++q) acc[a][b][2 * mh + (q >> 1)][q & 1] += t_[mh * 4 + q];
                            asm volatile("" ::: "memory"); } }
                E(acc, cur, wr, wc, fr, fq);
            }
        } else {
        if constexpr (!Epi::AFTER_DRAIN) { E(acc, cur, wr, wc, fr, fq); S.done(cur); }
        }
        if (!has_next) break;
#pragma unroll
        for (int a = 0; a < 2; ++a)
#pragma unroll
            for (int b = 0; b < 2; ++b)
#pragma unroll
                for (int m = 0; m < 4; ++m)
#pragma unroll
                    for (int n = 0; n < 2; ++n) acc[a][b][m][n] = (f32x4){0.f, 0.f, 0.f, 0.f};
        cur = nxt; cA = nA; cB = nB; ++ui;
        if constexpr (ALIGN_EPI) { if (wr == 1) PG8_BAR; }
    }
    PG8_WAIT_V(0);
    if constexpr (!ALIGN_EPI) { if (wr == 0) PG8_BAR; }
    PG8_BAR;
    if constexpr (Epi::AFTER_DRAIN) { E.fused(acc, cur, wr, wc, fr, fq, lds, wid, lane); S.done(cur); }
#undef PG8_SA
#undef PG8_SB
#undef PG8_STAGE
#undef PG8_CAT
#undef PG8_LDA
#undef PG8_LDB
#undef PG8_MMA
#undef PG8_WAIT_V
#undef PG8_WAIT_L
#undef PG8_BAR
#undef PG8_SCHED
#undef PG8_GAS
}
}

constexpr int NWAVES = 8, NTHR = 512;
constexpr int D = 2048, SEQ = 4096, NLAT = 8192, CTXL = 256, NCTX = 512, MROWS = 8704, DEPTH = 2;
constexpr int INC = 15392, NU = 15360;
constexpr int U_CB = 0, U_CC = 1024, U_CX = 2048, U_GQ = 3072, U_GK = 3584, U_GV = 4096, U_GR = 5120, U_NQ = 6144, U_NK = 7168, U_NV = 8192, U_GATE = 9216;
constexpr int LR_COL = 6144;
constexpr int FF = 5632, NGU = 2 * FF, NE = 8;
constexpr float LN_EPS = 1e-5f, ALPHA = 1.41421356237f;
constexpr float FSC_WGU = 64.0f, FSC_WD = 128.0f, FSC_HID = 4.0f;
constexpr int MOE_MAXP = 72;

constexpr size_t MiB = 1u << 20;
constexpr size_t WS_CTL = 0, CTL_ZERO_BYTES = 1 * MiB;
constexpr size_t WS_MOD = 1 * MiB;
constexpr size_t WS_WLR = 1 * MiB + 512 * 1024;
constexpr size_t WS_ROUTE = 2 * MiB;
constexpr size_t WS_TOK = 2 * MiB + 256 * 1024;
constexpr size_t WS_LR = 3 * MiB;
constexpr size_t WS_W = 8 * MiB;
constexpr size_t W_IN_B = (size_t)NU * D * 2, W_BR_B = (size_t)1024 * D * 2, W_OUT_B = (size_t)D * D * 2, W_LAYER_B = W_IN_B + 3 * W_BR_B + W_OUT_B;
constexpr size_t W_GU_B = (size_t)NGU * D * 2, W_D_B = (size_t)D * FF * 2, W_FFN_B = W_GU_B + W_D_B;
constexpr size_t WS_WFFN = WS_W + 2 * W_LAYER_B, WS_WMOE = WS_WFFN + W_FFN_B, WS_WEND = WS_WMOE + 8 * W_FFN_B;
constexpr size_t WS_XL = 762 * MiB;
constexpr size_t WS_H = 830 * MiB;
constexpr size_t WS_U = 864 * MiB;
constexpr size_t WS_Y = 1119 * MiB;
constexpr size_t WS_GLA = 1170 * MiB;
constexpr size_t WS_Z = 1306 * MiB;
constexpr size_t WS_ZB = 1374 * MiB;
constexpr size_t WS_PRE = 1408 * MiB;
constexpr size_t WS_PART = 1476 * MiB;
constexpr size_t WS_ZBP = 1572 * MiB;
constexpr size_t WS_UG8 = 1580 * MiB;
constexpr size_t WS_KF = 1540 * MiB;
constexpr size_t WS_END = 1632 * MiB;
static_assert(WS_WEND <= WS_XL && WS_XL + (size_t)MROWS * D * 4 <= WS_H && WS_H + (size_t)MROWS * D * 2 <= WS_U && WS_U + (size_t)MROWS * NU * 2 <= WS_Y, "ws map 1");
static_assert(WS_U + (size_t)MOE_MAXP * 256 * FF * 2 <= WS_Y && WS_Y + 3 * (size_t)MROWS * 1024 * 2 <= WS_GLA && WS_GLA + (size_t)MROWS * (4 * 512 + 2 * 1024) * 4 <= WS_Z, "ws map 2");
static_assert(WS_GLA + (size_t)MOE_MAXP * 256 * D * 2 <= WS_Z && WS_Z + (size_t)MOE_MAXP * 256 * D * 4 <= WS_END && WS_PRE + (size_t)MROWS * D * 4 <= WS_END, "ws map 3");
constexpr int CW_TMO = 0, CW_CODE = 1;
constexpr int CW_MOECNT = 64;
constexpr int CW_BAR = 4096, CW_SK = 16384;

constexpr int RING_OFF = 0, RING_BYTES = 131072;
constexpr int LDSCTL_OFF = RING_BYTES, MISC_OFF = LDSCTL_OFF + 320;
constexpr int LDS_BYTES = 147456;

#define GAS __attribute__((address_space(1)))
#define LAS __attribute__((address_space(3)))
typedef unsigned short bf16;
typedef unsigned v4u __attribute__((ext_vector_type(4)));
typedef unsigned v2u __attribute__((ext_vector_type(2)));
typedef float f32x4 __attribute__((ext_vector_type(4)));
typedef GAS unsigned gu32;
typedef short bf16x8v __attribute__((ext_vector_type(8)));
#define RLX_AGENT __ATOMIC_RELAXED, __HIP_MEMORY_SCOPE_AGENT
#define LDS_WAIT() asm volatile("s_waitcnt lgkmcnt(0)" ::: "memory")
#define VM_WAIT() asm volatile("s_waitcnt vmcnt(0)" ::: "memory")
__device__ __forceinline__ unsigned f2bf(float f) { unsigned u = __builtin_bit_cast(unsigned, f); return (u + 0x7fffu + ((u >> 16) & 1u)) >> 16; }
typedef __bf16 bf16x2_t __attribute__((ext_vector_type(2)));
__device__ __forceinline__ unsigned pk2(float lo, float hi) { const bf16x2_t v = {(__bf16)lo, (__bf16)hi}; return __builtin_bit_cast(unsigned, v); }
__device__ __forceinline__ float bflo(unsigned w) { return __uint_as_float(w << 16); }
__device__ __forceinline__ float bfhi(unsigned w) { return __uint_as_float(w & 0xffff0000u); }
__device__ __forceinline__ float bf1(bf16 b) { return __uint_as_float(((unsigned)b) << 16); }
__device__ __forceinline__ float wave_sum(float v) {
#pragma unroll
    for (int o = 1; o < 64; o <<= 1) v += __shfl_xor(v, o);
    return v;
}
__device__ __forceinline__ float wave_max(float v) {
#pragma unroll
    for (int o = 1; o < 64; o <<= 1) v = fmaxf(v, __shfl_xor(v, o));
    return v;
}

#define XB_TMO      128
#define XB_XCNT(j)  (256  + 64 * (j))
#define XB_XSUB(j)  (1280 + 64 * (j))
#define XB_XGEN(j)  (2304 + 64 * (j))
#define XB_TOP      3328
#define XB_TOPGEN   3392
#define XCD_BAR_WORDS 3456
#define XB_SPIN_CAP (1u << 18)

__device__ __forceinline__ unsigned xb_ld(unsigned* p)              { return __hip_atomic_load(p, __ATOMIC_RELAXED, __HIP_MEMORY_SCOPE_AGENT); }
__device__ __forceinline__ unsigned xb_add(unsigned* p, unsigned v) { return __hip_atomic_fetch_add(p, v, __ATOMIC_RELAXED, __HIP_MEMORY_SCOPE_AGENT); }
__device__ __forceinline__ unsigned xb_xcc_id() { return (unsigned)__builtin_amdgcn_s_getreg((3 << 11) | 20) & 0xFu; }
#define XB_SPIN(cond, bar) do { unsigned _sp = 0; while (cond) { __builtin_amdgcn_s_sleep(1); \
    if ((++_sp & 255u) == 0u) { if (xb_ld(&(bar)[XB_TMO])) break; if (_sp > XB_SPIN_CAP) { atomicAdd(&(bar)[XB_TMO], 1u); break; } } } } while (0)

struct XcdBarrier {
    unsigned* bar; unsigned x; unsigned grid;
    volatile LAS unsigned* st;
};

__device__ __forceinline__ XcdBarrier xcd_barrier_post(unsigned* bar, volatile LAS unsigned* st, unsigned grid) {
    XcdBarrier b; b.grid = grid; b.bar = bar; b.x = xb_xcc_id(); b.st = st;
    if (threadIdx.x == 0) (void)xb_add(&bar[XB_XCNT(b.x)], 1u);
    return b;
}
__device__ __forceinline__ void xcd_barrier_complete(unsigned* bar, unsigned x, unsigned& nloc, unsigned& nx, unsigned b_grid) {
    const unsigned G = b_grid;
    unsigned sum, cnt, mine, sp = 0u;
    for (;;) {
        sum = 0u; cnt = 0u; mine = 0u;
#pragma unroll
        for (unsigned j = 0; j < 16; ++j) { const unsigned c = xb_ld(&bar[XB_XCNT(j)]); sum += c; cnt += (c > 0u) ? 1u : 0u; mine = (j == x) ? c : mine; }
        if (sum == G) break;
        __builtin_amdgcn_s_sleep(1);
        if ((++sp & 255u) == 0u) { if (xb_ld(&bar[XB_TMO])) break; if (sp > XB_SPIN_CAP) { atomicAdd(&bar[XB_TMO], 1u); break; } }
    }
    nloc = mine > 0u ? mine : 1u; nx = cnt > 0u ? cnt : 1u;
}

__device__ __forceinline__ void xcd_barrier(const XcdBarrier& b) {
    asm volatile("s_waitcnt vmcnt(0)" ::: "memory");
    __syncthreads();
    if (threadIdx.x == 0) {
        unsigned* bar = b.bar;
        __builtin_amdgcn_s_waitcnt(0);
        unsigned nloc = b.st[0], nx = b.st[1];
        if (nloc == 0u) { xcd_barrier_complete(bar, b.x, nloc, nx, b.grid); b.st[0] = nloc; b.st[1] = nx; }
        const unsigned old = xb_add(&bar[XB_XSUB(b.x)], 1u);
        const unsigned gen = old / nloc;
        if (old + 1u == (gen + 1u) * nloc) {
            __builtin_amdgcn_fence(__ATOMIC_RELEASE, "agent");
            asm volatile("s_waitcnt vmcnt(0)" ::: "memory");
            const unsigned og = xb_add(&bar[XB_TOP], 1u);
            const unsigned tg = og / nx;
            if (og + 1u == (tg + 1u) * nx) xb_add(&bar[XB_TOPGEN], 1u);
            else XB_SPIN(xb_ld(&bar[XB_TOPGEN]) == tg, bar);
            __builtin_amdgcn_fence(__ATOMIC_ACQUIRE, "agent");
            xb_add(&bar[XB_XGEN(b.x)], 1u);
            asm volatile("s_waitcnt vmcnt(0)" ::: "memory");
        } else {
            XB_SPIN(xb_ld(&bar[XB_XGEN(b.x)]) == gen, bar);
            __builtin_amdgcn_fence(__ATOMIC_ACQUIRE, "agent");
            asm volatile("s_waitcnt vmcnt(0)" ::: "memory");
        }
    }
    __syncthreads();
}

struct Args { const float* in[30]; float* out; unsigned char* ws; int ph_lo, ph_hi, grid, pad; };
struct Frame {
    LAS unsigned char* lds;
    volatile LAS unsigned* MISC;
    int tid, lane, wave, vcu, G, bx;
};
__device__ __forceinline__ Frame mkframe(LAS unsigned char* lds, int grid) {
    Frame F; int t = threadIdx.x; asm volatile("" : "+v"(t)); int g = grid, bx = blockIdx.x; asm volatile("" : "+s"(g), "+s"(bx));
    F.lds = lds; F.MISC = (volatile LAS unsigned*)(lds + MISC_OFF); F.tid = t; F.lane = t & 63; F.wave = __builtin_amdgcn_readfirstlane(t >> 6); F.G = g; F.bx = bx;
    F.vcu = (g % 8 == 0) ? (bx % 8) * (g / 8) + bx / 8 : bx; return F;
}
constexpr int PTAB_OFF = LDSCTL_OFF + 1024, PT_OUT = 30, PT_WS = 31;
__device__ __forceinline__ unsigned long long ldp_raw(Frame& F, int i) {
    const volatile LAS unsigned* t = (const volatile LAS unsigned*)(F.lds + PTAB_OFF) + 2 * i; const unsigned lo = t[0], hi = t[1];
    return ((unsigned long long)(unsigned)__builtin_amdgcn_readfirstlane((int)hi) << 32) | (unsigned)__builtin_amdgcn_readfirstlane((int)lo);
}
#define PIN(i) ((const float*)(const GAS float*)ldp_raw(F, (i)))
#define POUT() ((float*)(GAS float*)ldp_raw(F, PT_OUT))
#define PWS() ((unsigned char*)(GAS unsigned char*)ldp_raw(F, PT_WS))
__device__ __forceinline__ bf16* w_in_t(unsigned char* ws, int L) { return (bf16*)(ws + WS_W + (size_t)L * W_LAYER_B); }
__device__ __forceinline__ bf16* w_br_t(unsigned char* ws, int L, int b) { return (bf16*)(ws + WS_W + (size_t)L * W_LAYER_B + W_IN_B + (size_t)b * W_BR_B); }
__device__ __forceinline__ bf16* w_out_t(unsigned char* ws, int L) { return (bf16*)(ws + WS_W + (size_t)L * W_LAYER_B + W_IN_B + 3 * W_BR_B); }
__device__ __forceinline__ unsigned char* w_gu_t(unsigned char* ws, int e) { return ws + (e < 0 ? WS_WFFN : WS_WMOE + (size_t)e * (W_GU_B / 2)); }
__device__ __forceinline__ unsigned char* w_d_t(unsigned char* ws, int e) { return ws + (e < 0 ? WS_WFFN + W_GU_B : WS_WMOE + 8 * W_GU_B + (size_t)e * (W_D_B / 2)); }

template <int MODE> __device__ __forceinline__ int conv_drow(int nb) {
    if (MODE == 0) return 32 * nb;
    if (MODE == 1) return nb < LR_COL / 32 ? 32 * nb : 32 * (nb - 1);
    if (MODE == 2) return 256 * (nb >> 2) + 32 * (nb & 3);
    return 256 * (nb >> 2) + 128 + 32 * (nb & 3);
}
__device__ __forceinline__ void conv_load(const float* W, int N, int nblk, int it, int lane, f32x4 (&w)[8]) {
    const int kb = it / nblk, nb = it % nblk; const float* p = W + (size_t)(64 * kb + (lane >> 3)) * N + 32 * nb + (lane & 7) * 4;
#pragma unroll
    for (int i = 0; i < 8; ++i) w[i] = __builtin_nontemporal_load((const GAS f32x4*)(p + (size_t)(8 * i) * N));
}
template <int MODE, bool F8> __device__ __forceinline__ void conv_finish(const f32x4 (&w)[8], LAS float* scr, int lane, int K, int nblk, int it, void* WT, float sc) {
    const int kb = it / nblk, nb = it % nblk, k0 = 64 * kb;
    if (MODE == 1 && nb == LR_COL / 32) return;
    const int drow = conv_drow<MODE>(nb);
#pragma unroll
    for (int i = 0; i < 8; ++i) { LAS float* s = scr + (8 * i + (lane >> 3)) * 33 + (lane & 7) * 4; s[0] = w[i][0]; s[1] = w[i][1]; s[2] = w[i][2]; s[3] = w[i][3]; }
    LDS_WAIT(); asm volatile("" ::: "memory");
    const int c = lane & 7;
#pragma unroll
    for (int j = 0; j < 4; ++j) { const int n = (lane >> 3) + 8 * j; const LAS float* s = scr + (8 * c) * 33 + n;
        if (F8) { v2u o; o.x = pg8::pk_fp8x4(s[0 * 33] * sc, s[1 * 33] * sc, s[2 * 33] * sc, s[3 * 33] * sc); o.y = pg8::pk_fp8x4(s[4 * 33] * sc, s[5 * 33] * sc, s[6 * 33] * sc, s[7 * 33] * sc);
            __builtin_nontemporal_store(o, (GAS v2u*)((unsigned char*)WT + (size_t)(drow + n) * K + k0 + 8 * c)); }
        else { v4u o; o.x = pk2(s[0 * 33], s[1 * 33]); o.y = pk2(s[2 * 33], s[3 * 33]); o.z = pk2(s[4 * 33], s[5 * 33]); o.w = pk2(s[6 * 33], s[7 * 33]);
            __builtin_nontemporal_store(o, (GAS v4u*)((bf16*)WT + (size_t)(drow + n) * K + k0 + 8 * c)); } }
    LDS_WAIT(); asm volatile("" ::: "memory");
}
template <int MODE, bool F8> __device__ __forceinline__ void conv_matrix_t(Frame& F, const float* W, int K, int N, void* WT, float sc) {
    LAS float* scr = (LAS float*)(F.lds + RING_OFF + F.wave * 16384);
    const int gw = F.vcu * NWAVES + F.wave, NGW = F.G * NWAVES, lane = F.lane;
    const int nblk = N / 32, nitems = (K / 64) * nblk;
    f32x4 w0[8], w1[8];
    if (gw < nitems) conv_load(W, N, nblk, gw, lane, w0);
    if (gw + NGW < nitems) conv_load(W, N, nblk, gw + NGW, lane, w1);
    for (int it = gw; it < nitems; it += 2 * NGW) {
        f32x4 n0[8], n1[8];
        if (it + 2 * NGW < nitems) conv_load(W, N, nblk, it + 2 * NGW, lane, n0);
        if (it + 3 * NGW < nitems) conv_load(W, N, nblk, it + 3 * NGW, lane, n1);
        conv_finish<MODE, F8>(w0, scr, lane, K, nblk, it, WT, sc);
        if (it + NGW < nitems) conv_finish<MODE, F8>(w1, scr, lane, K, nblk, it + NGW, WT, sc);
#pragma unroll
        for (int i = 0; i < 8; ++i) { w0[i] = n0[i]; w1[i] = n1[i]; }
    }
}
template <int MODE> __device__ __forceinline__ void conv_matrix8(Frame& F, const float* W, int K, int N, unsigned char* WT, float sc) { conv_matrix_t<MODE, true>(F, W, K, N, WT, sc); }
template <int MODE> __device__ __forceinline__ void conv_matrix(Frame& F, const float* W, int K, int N, bf16* WT) { conv_matrix_t<MODE, false>(F, W, K, N, WT, 1.0f); }
__device__ __forceinline__ void ada_item(Frame& F, unsigned char* ws, const float* cnd, const float* cctx, const float* ada_w, const float* ada_b, int item) {
    const int L = item / 96, c0 = (item % 96) * 128;
    LAS float* sc = (LAS float*)(F.lds + RING_OFF);
    LAS float* red = (LAS float*)(F.lds + RING_OFF + 24576);
    for (int i = F.tid; i < 3 * D; i += NTHR) { const int g = i / D, k = i % D; const float v = g < 2 ? cnd[g * D + k] : cctx[k]; sc[i] = v / (1.0f + __expf(-v)); }
    __syncthreads();
    const float* W = ada_w + (size_t)L * D * 12288 + c0 + 2 * F.lane;
    float a00 = 0.f, a01 = 0.f, a10 = 0.f, a11 = 0.f, a20 = 0.f, a21 = 0.f;
    const int kb = 256 * F.wave;
#pragma unroll 8
    for (int k = kb; k < kb + 256; ++k) { typedef float f32x2_ __attribute__((ext_vector_type(2))); const f32x2_ w = __builtin_nontemporal_load((const GAS f32x2_*)(W + (size_t)k * 12288)); const float s0 = sc[k], s1 = sc[D + k], s2 = sc[2 * D + k];
        a00 += s0 * w.x; a01 += s0 * w.y; a10 += s1 * w.x; a11 += s1 * w.y; a20 += s2 * w.x; a21 += s2 * w.y; }
    red[(F.wave * 3 + 0) * 128 + 2 * F.lane] = a00; red[(F.wave * 3 + 0) * 128 + 2 * F.lane + 1] = a01;
    red[(F.wave * 3 + 1) * 128 + 2 * F.lane] = a10; red[(F.wave * 3 + 1) * 128 + 2 * F.lane + 1] = a11;
    red[(F.wave * 3 + 2) * 128 + 2 * F.lane] = a20; red[(F.wave * 3 + 2) * 128 + 2 * F.lane + 1] = a21;
    __syncthreads();
    if (F.tid < 384) { const int g = F.tid / 128, cc = F.tid % 128; float s = 0.f;
#pragma unroll
        for (int w = 0; w < 8; ++w) s += red[(w * 3 + g) * 128 + cc];
        ((float*)(ws + WS_MOD))[((size_t)L * 3 + g) * 12288 + c0 + cc] = s + ada_b[L * 12288 + c0 + cc]; }
    __syncthreads();
}
__device__ __forceinline__ void p0a_prologue(Frame& F) {
    unsigned char* const ws = PWS();
    { const float* cnd = PIN(1); const float* cctx = PIN(3); const float* ada_w = PIN(4); const float* ada_b = PIN(5);
      for (int it = F.bx; it < 192; it += F.G) ada_item(F, ws, cnd, cctx, ada_w, ada_b, it); }
    const float* const w_in = PIN(6);
    { const int gt = F.bx * NTHR + F.tid, NGT = F.G * NTHR;
      for (int i = gt; i < DEPTH * D * 32; i += NGT) { const int o = i & 31, k = (i >> 5) % D, L = i / (32 * D); ((bf16*)(ws + WS_WLR))[((size_t)L * 32 + o) * D + k] = (bf16)f2bf(w_in[((size_t)L * D + k) * INC + LR_COL + o]); } }
    conv_matrix<1>(F, w_in, D, INC, w_in_t(ws, 0));
}
__device__ __forceinline__ void p0a_rest(Frame& F) {
    unsigned char* const ws = PWS();
    for (int b = 0; b < 3; ++b) conv_matrix<0>(F, (b == 0 ? PIN(14) : (b == 1 ? PIN(15) : PIN(16))), 1024, D, w_br_t(ws, 0, b));
    conv_matrix<0>(F, PIN(18), D, D, w_out_t(ws, 0));
    conv_matrix<2>(F, PIN(23), D, FF, (bf16*)w_gu_t(ws, -1)); conv_matrix<3>(F, PIN(24), D, FF, (bf16*)w_gu_t(ws, -1)); conv_matrix<0>(F, PIN(25), FF, D, (bf16*)w_d_t(ws, -1));
    conv_matrix_t<1, true>(F, PIN(6) + (size_t)D * INC, D, INC, w_in_t(ws, 1), FSC_WGU);
    for (int b = 0; b < 3; ++b) conv_matrix<0>(F, (b == 0 ? PIN(14) : (b == 1 ? PIN(15) : PIN(16))) + (size_t)1024 * D, 1024, D, w_br_t(ws, 1, b));
    conv_matrix<0>(F, PIN(18) + (size_t)D * D, D, D, w_out_t(ws, 1));
    for (int e = 0; e < NE; ++e) {
        conv_matrix8<2>(F, PIN(27) + (size_t)e * D * FF, D, FF, w_gu_t(ws, e), FSC_WGU); conv_matrix8<3>(F, PIN(28) + (size_t)e * D * FF, D, FF, w_gu_t(ws, e), FSC_WGU);
        conv_matrix8<0>(F, PIN(29) + (size_t)e * FF * D, FF, D, w_d_t(ws, e), FSC_WD);
    }
}

__device__ __forceinline__ int row_group(int r) { return r < SEQ ? 0 : (r < NLAT ? 1 : 2); }
__device__ __forceinline__ void load_row(const float* p, int lane, f32x4 (&v)[8]) {
#pragma unroll
    for (int j = 0; j < 8; ++j) v[j] = *(const GAS f32x4*)(p + 4 * lane + 256 * j);
}
__device__ __forceinline__ void load_row_bf16(const bf16* p, int lane, f32x4 (&v)[8]) {
#pragma unroll
    for (int j = 0; j < 8; ++j) { const v2u w = *(const GAS v2u*)(p + 4 * lane + 256 * j); v[j] = (f32x4){bflo(w.x), bfhi(w.x), bflo(w.y), bfhi(w.y)}; }
}
__device__ __forceinline__ void store_row(float* p, int lane, const f32x4 (&v)[8]) {
#pragma unroll
    for (int j = 0; j < 8; ++j) *(GAS f32x4*)(p + 4 * lane + 256 * j) = v[j];
}
__device__ __forceinline__ void store_row_bf16(bf16* p, int lane, const f32x4 (&v)[8]) {
#pragma unroll
    for (int j = 0; j < 8; ++j) { v2u w; w.x = pk2(v[j][0], v[j][1]); w.y = pk2(v[j][2], v[j][3]); *(GAS v2u*)(p + 4 * lane + 256 * j) = w; }
}
__device__ __forceinline__ void store_row_fp8(unsigned char* p, int lane, const f32x4 (&v)[8]) {
#pragma unroll
    for (int j = 0; j < 8; ++j) *(GAS unsigned*)(p + 4 * lane + 256 * j) = pg8::pk_fp8x4(pg8::clamp448(v[j][0]), pg8::clamp448(v[j][1]), pg8::clamp448(v[j][2]), pg8::clamp448(v[j][3]));
}
__device__ __forceinline__ void modulate(f32x4 (&v)[8], const float* shift, const float* scale, int lane) {
#pragma unroll
    for (int j = 0; j < 8; ++j) { const f32x4 sh = *(const f32x4*)(shift + 4 * lane + 256 * j), sc = *(const f32x4*)(scale + 4 * lane + 256 * j); v[j] = v[j] * (sc + 1.0f) + sh; }
}
__device__ __forceinline__ void layer_norm_row(f32x4 (&v)[8], const float* g, const float* b, int lane) {
    float s = 0.f;
#pragma unroll
    for (int j = 0; j < 8; ++j) s += (v[j][0] + v[j][1]) + (v[j][2] + v[j][3]);
    const float mean = wave_sum(s) * (1.0f / D); float q = 0.f;
#pragma unroll
    for (int j = 0; j < 8; ++j) { v[j] = v[j] - mean; q += (v[j][0] * v[j][0] + v[j][1] * v[j][1]) + (v[j][2] * v[j][2] + v[j][3] * v[j][3]); }
    const float rstd = 1.0f / sqrtf(wave_sum(q) * (1.0f / D) + LN_EPS);
#pragma unroll
    for (int j = 0; j < 8; ++j) { const f32x4 g4 = *(const f32x4*)(g + 4 * lane + 256 * j), b4 = *(const f32x4*)(b + 4 * lane + 256 * j); v[j] = v[j] * rstd * g4 + b4; }
}
__device__ __forceinline__ void lr_tiles(Frame& F, int L) {
    unsigned char* const ws = PWS(); const bf16* H = (const bf16*)(ws + WS_H); const bf16* W = (const bf16*)(ws + WS_WLR) + (size_t)L * 32 * D; float* LRo = (float*)(ws + WS_LR);
    const int g = F.lane >> 4, l15 = F.lane & 15;
    LAS f32x4* red = (LAS f32x4*)(F.lds + RING_OFF);
    for (int task = F.vcu; task < MROWS / 16; task += F.G) {
        const bf16* ap = H + (size_t)(16 * task + l15) * D + 256 * F.wave + 8 * g; const bf16* bp = W + (size_t)l15 * D + 256 * F.wave + 8 * g;
        v4u af[8], b0[8], b1[8];
#pragma unroll
        for (int ks = 0; ks < 8; ++ks) { af[ks] = *(const GAS v4u*)(ap + 32 * ks); b0[ks] = *(const GAS v4u*)(bp + 32 * ks); b1[ks] = *(const GAS v4u*)(bp + (size_t)16 * D + 32 * ks); }
        f32x4 a0 = {0.f, 0.f, 0.f, 0.f}, a1 = {0.f, 0.f, 0.f, 0.f};
#pragma unroll
        for (int ks = 0; ks < 8; ++ks) { a0 = __builtin_amdgcn_mfma_f32_16x16x32_bf16(__builtin_bit_cast(bf16x8v, af[ks]), __builtin_bit_cast(bf16x8v, b0[ks]), a0, 0, 0, 0);
                                         a1 = __builtin_amdgcn_mfma_f32_16x16x32_bf16(__builtin_bit_cast(bf16x8v, af[ks]), __builtin_bit_cast(bf16x8v, b1[ks]), a1, 0, 0, 0); }
        red[(F.wave * 2 + 0) * 64 + F.lane] = a0; red[(F.wave * 2 + 1) * 64 + F.lane] = a1;
        __syncthreads();
        if (F.wave < 2) { f32x4 s = red[F.wave * 64 + F.lane];
#pragma unroll
            for (int w = 1; w < 8; ++w) s += red[(w * 2 + F.wave) * 64 + F.lane];
#pragma unroll
            for (int i = 0; i < 4; ++i) LRo[(size_t)(16 * task + 4 * g + i) * 32 + l15 + 16 * F.wave] = s[i]; }
        __syncthreads();
    }
}
__device__ __forceinline__ void p0b_modulate(Frame& F) {
    unsigned char* const ws = PWS(); const float* const xin = PIN(0); const float* const cin = PIN(2);
    const int gw = F.vcu * NWAVES + F.wave, NGW = F.G * NWAVES;
    for (int r = gw; r < MROWS; r += 2 * NGW) {
        const int r1 = r + NGW; const bool has1 = r1 < MROWS;
        f32x4 a[8], b[8]; load_row(r < NLAT ? xin + (size_t)r * D : cin + (size_t)(r - NLAT) * D, F.lane, a);
        if (has1) load_row(r1 < NLAT ? xin + (size_t)r1 * D : cin + (size_t)(r1 - NLAT) * D, F.lane, b);
        { const float* m = ((float*)(ws + WS_MOD)) + (size_t)row_group(r) * 12288; modulate(a, m, m + D, F.lane); store_row_bf16(((bf16*)(ws + WS_H)) + (size_t)r * D, F.lane, a); }
        if (has1) { const float* m = ((float*)(ws + WS_MOD)) + (size_t)row_group(r1) * 12288; modulate(b, m, m + D, F.lane); store_row_bf16(((bf16*)(ws + WS_H)) + (size_t)r1 * D, F.lane, b); }
    }
}

__device__ __forceinline__ void mix_prep(Frame& F, int L) {
    unsigned char* const ws = PWS();
    const int gt = F.bx * NTHR + F.tid, NGT = F.G * NTHR;
    const float* cw = PIN(7) + (size_t)L * 3 * 1024;
    for (int i = gt; i < MROWS * 128; i += NGT) {
        const int r = i >> 7, c8 = (i & 127) * 8;
        const int t = r < NLAT ? (r & (SEQ - 1)) : ((r - NLAT) & (CTXL - 1)), T = r < NLAT ? SEQ : CTXL;
        float acc[8];
#pragma unroll
        for (int j = 0; j < 8; ++j) acc[j] = 0.f;
#pragma unroll
        for (int k = 0; k < 3; ++k) { const int tt = t + k - 1; if (tt < 0 || tt >= T) continue;
            const bf16* up = ((bf16*)(ws + WS_U)) + (size_t)(r + k - 1) * NU; const v4u a = *(const GAS v4u*)(up + U_CC + c8), b = *(const GAS v4u*)(up + U_CX + c8);
            const f32x4 w0 = *(const f32x4*)(cw + k * 1024 + c8), w1 = *(const f32x4*)(cw + k * 1024 + c8 + 4);
            acc[0] += w0[0] * bflo(a.x) * bflo(b.x); acc[1] += w0[1] * bfhi(a.x) * bfhi(b.x); acc[2] += w0[2] * bflo(a.y) * bflo(b.y); acc[3] += w0[3] * bfhi(a.y) * bfhi(b.y);
            acc[4] += w1[0] * bflo(a.z) * bflo(b.z); acc[5] += w1[1] * bfhi(a.z) * bfhi(b.z); acc[6] += w1[2] * bflo(a.w) * bflo(b.w); acc[7] += w1[3] * bfhi(a.w) * bfhi(b.w); }
        const v4u ab = *(const GAS v4u*)(((bf16*)(ws + WS_U)) + (size_t)r * NU + U_CB + c8);
        v4u o; o.x = pk2(acc[0] * bflo(ab.x), acc[1] * bfhi(ab.x)); o.y = pk2(acc[2] * bflo(ab.y), acc[3] * bfhi(ab.y)); o.z = pk2(acc[4] * bflo(ab.z), acc[5] * bfhi(ab.z)); o.w = pk2(acc[6] * bflo(ab.w), acc[7] * bfhi(ab.w));
        *(GAS v4u*)(((bf16*)(ws + WS_Y)) + (size_t)r * 1024 + c8) = o;
    }
}
template <bool RB> __device__ __forceinline__ void sum_partials(f32x4 (&v)[8], const float* P, int ns, const void* res_, const float* gvec, int lane) {
#pragma unroll
    for (int j = 0; j < 8; ++j) v[j] = (f32x4){0.f, 0.f, 0.f, 0.f};
    int s = 0;
    for (; s + 3 <= ns; s += 3) {
        f32x4 t[3][8];
#pragma unroll
        for (int k = 0; k < 3; ++k)
#pragma unroll
            for (int j = 0; j < 8; ++j) t[k][j] = *(const GAS f32x4*)(P + (size_t)(s + k) * 512 * D + 4 * lane + 256 * j);
#pragma unroll
        for (int j = 0; j < 8; ++j) v[j] += (t[0][j] + t[1][j]) + t[2][j]; }
    for (; s < ns; ++s) {
#pragma unroll
        for (int j = 0; j < 8; ++j) v[j] += *(const GAS f32x4*)(P + (size_t)s * 512 * D + 4 * lane + 256 * j); }
#pragma unroll
    for (int j = 0; j < 8; ++j) { f32x4 r4; if (RB) { const v2u w = *(const GAS v2u*)((const bf16*)res_ + 4 * lane + 256 * j); r4 = (f32x4){bflo(w.x), bfhi(w.x), bflo(w.y), bfhi(w.y)}; } else r4 = *(const GAS f32x4*)((const float*)res_ + 4 * lane + 256 * j);
        const f32x4 g4 = *(const f32x4*)(gvec + 4 * lane + 256 * j); v[j] = r4 * ALPHA + g4 * v[j]; }
}
__device__ __forceinline__ void load_res_delta(const float* res, const bf16* delta, int lane, f32x4 (&v)[8]) {
    v2u dl[8];
#pragma unroll
    for (int j = 0; j < 8; ++j) { v[j] = *(const GAS f32x4*)(res + 4 * lane + 256 * j); dl[j] = *(const GAS v2u*)(delta + 4 * lane + 256 * j); }
#pragma unroll
    for (int j = 0; j < 8; ++j) { v[j][0] = v[j][0] * ALPHA + bflo(dl[j].x); v[j][1] = v[j][1] * ALPHA + bfhi(dl[j].x); v[j][2] = v[j][2] * ALPHA + bflo(dl[j].y); v[j][3] = v[j][3] * ALPHA + bfhi(dl[j].y); }
}
__device__ __forceinline__ void load_resb_delta(const bf16* res, const bf16* delta, int lane, f32x4 (&v)[8]) {
    v2u rl[8], dl[8];
#pragma unroll
    for (int j = 0; j < 8; ++j) { rl[j] = *(const GAS v2u*)(res + 4 * lane + 256 * j); dl[j] = *(const GAS v2u*)(delta + 4 * lane + 256 * j); }
#pragma unroll
    for (int j = 0; j < 8; ++j) { v[j][0] = bflo(rl[j].x) * ALPHA + bflo(dl[j].x); v[j][1] = bfhi(rl[j].x) * ALPHA + bfhi(dl[j].x); v[j][2] = bflo(rl[j].y) * ALPHA + bflo(dl[j].y); v[j][3] = bfhi(rl[j].y) * ALPHA + bfhi(dl[j].y); }
}
__device__ __forceinline__ void ln1_load(unsigned char* ws, const float* xin, const float* cin, int L, int r, int lane, f32x4 (&v)[8]) {
    if (r < NLAT) { if (L == 0) load_res_delta(xin + (size_t)r * D, ((const bf16*)(ws + WS_PRE)) + (size_t)r * D, lane, v); else load_resb_delta(((const bf16*)(ws + WS_XL)) + (size_t)r * D, ((const bf16*)(ws + WS_PRE)) + (size_t)r * D, lane, v); }
    else sum_partials<false>(v, ((float*)(ws + WS_PART)) + (size_t)(r - NLAT) * D, 12, cin + (size_t)(r - NLAT) * D, ((float*)(ws + WS_MOD)) + ((size_t)L * 3 + 2) * 12288 + 2 * D, lane);
}
__device__ __forceinline__ void ln1_row(Frame& F, unsigned char* ws, const float* lng, const float* lnb, const LAS float* rtab, int L, int r, f32x4 (&v)[8]) {
    const float* m = ((float*)(ws + WS_MOD)) + ((size_t)L * 3 + row_group(r)) * 12288;
    layer_norm_row(v, lng, lnb, F.lane);
    store_row_bf16(((bf16*)(ws + WS_XL)) + (size_t)r * D, F.lane, v);
    modulate(v, m + 3 * D, m + 4 * D, F.lane);
    if (L == 0) { store_row_bf16(((bf16*)(ws + WS_H)) + (size_t)r * D, F.lane, v); return; }
    float lg[8];
#pragma unroll
    for (int e = 0; e < 8; ++e) lg[e] = 0.f;
#pragma unroll
    for (int j = 0; j < 8; ++j) {
#pragma unroll
        for (int i = 0; i < 4; ++i) { const LAS float* rp = rtab + (4 * F.lane + 256 * j + i) * 8; const f32x4 w0 = *(const LAS f32x4*)rp, w1 = *(const LAS f32x4*)(rp + 4); const float hv = v[j][i];
            lg[0] += hv * w0[0]; lg[1] += hv * w0[1]; lg[2] += hv * w0[2]; lg[3] += hv * w0[3]; lg[4] += hv * w1[0]; lg[5] += hv * w1[1]; lg[6] += hv * w1[2]; lg[7] += hv * w1[3]; }
        asm volatile("" ::: "memory"); }
#pragma unroll
    for (int e = 0; e < 8; ++e) lg[e] = wave_sum(lg[e]);
    int e0 = 0; float v0 = lg[0];
#pragma unroll
    for (int e = 1; e < 8; ++e) if (lg[e] > v0) { v0 = lg[e]; e0 = e; }
    int e1 = -1; float v1 = -INFINITY;
#pragma unroll
    for (int e = 0; e < 8; ++e) if (e != e0 && lg[e] > v1) { v1 = lg[e]; e1 = e; }
    unsigned p0 = 0u, p1 = 0u;
    if (F.lane == 0) {
        const float w0 = 1.0f / (1.0f + __expf(v1 - v0)), w1 = 1.0f - w0;
        p0 = __hip_atomic_fetch_add(((gu32*)(ws + WS_CTL)) + CW_MOECNT + 64 * e0, 1u, RLX_AGENT); p1 = __hip_atomic_fetch_add(((gu32*)(ws + WS_CTL)) + CW_MOECNT + 64 * e1, 1u, RLX_AGENT);
        unsigned* rt = ((unsigned*)(ws + WS_ROUTE)) + (size_t)r * 8; rt[0] = e0; rt[1] = p0; rt[2] = __float_as_uint(w0); rt[3] = e1; rt[4] = p1; rt[5] = __float_as_uint(w1);
    }
    p0 = (unsigned)__builtin_amdgcn_readfirstlane((int)p0); p1 = (unsigned)__builtin_amdgcn_readfirstlane((int)p1);
    store_row_fp8(ws + WS_GLA + ((size_t)e0 * NLAT + p0) * D, F.lane, v); store_row_fp8(ws + WS_GLA + ((size_t)e1 * NLAT + p1) * D, F.lane, v);
}
__device__ __forceinline__ void ln1_phase(Frame& F, int L, int M) {
    unsigned char* const ws = PWS(); const float* const lng = PIN(19) + L * D; const float* const lnb = PIN(20) + L * D; const float* const cin = PIN(2); const float* const xin = PIN(0);
    const int gw = F.vcu * NWAVES + F.wave, NGW = F.G * NWAVES;
    LAS float* rtab = (LAS float*)(F.lds + RING_OFF);
    if (L == 1) { const float* const router = PIN(26);
        for (int i = F.tid; i < D * 8 / 4; i += NTHR) *(LAS f32x4*)(rtab + 4 * i) = *(const GAS f32x4*)(router + 4 * i);
        __syncthreads(); }
    for (int r = gw; r < M; r += 2 * NGW) {
        const int r1 = r + NGW; const bool has1 = r1 < M;
        f32x4 a[8], b[8]; ln1_load(ws, xin, cin, L, r, F.lane, a); if (has1) ln1_load(ws, xin, cin, L, r1, F.lane, b);
        ln1_row(F, ws, lng, lnb, rtab, L, r, a); if (has1) ln1_row(F, ws, lng, lnb, rtab, L, r1, b);
    }
}
__device__ __forceinline__ void moe_prefix(unsigned char* ws, unsigned (&cnt)[8], int (&pp)[9]) {
    pp[0] = 0;
#pragma unroll
    for (int e = 0; e < 8; ++e) { cnt[e] = __hip_atomic_load(((gu32*)(ws + WS_CTL)) + CW_MOECNT + 64 * e, RLX_AGENT); pp[e + 1] = pp[e] + (int)((cnt[e] + 255u) >> 8); }
}
__device__ __forceinline__ void moe_gather(Frame& F) {
    unsigned char* const ws = PWS();
    const int gw = F.vcu * NWAVES + F.wave, NGW = F.G * NWAVES;
    unsigned cnt[8]; int pp[9]; moe_prefix(ws, cnt, pp);
    for (int s = gw; s < pp[8] * 256; s += NGW) {
        const int p = s >> 8; int e = 0, base = 0; unsigned ce = cnt[0];
#pragma unroll
        for (int k = 1; k < 8; ++k) if (p >= pp[k]) { e = k; base = pp[k]; ce = cnt[k]; }
        const unsigned pos = (unsigned)(s - base * 256);
        GAS v4u* dst = (GAS v4u*)(ws + WS_GLA + (size_t)s * D) + F.lane;
        if (pos < ce) { const int tkn = ((int*)(ws + WS_TOK))[e * NLAT + pos]; const GAS v4u* src = (const GAS v4u*)(ws + WS_H + (size_t)tkn * D) + F.lane;
#pragma unroll
            for (int j = 0; j < 2; ++j) dst[64 * j] = src[64 * j]; }
        else {
#pragma unroll
            for (int j = 0; j < 2; ++j) dst[64 * j] = (v4u){0u, 0u, 0u, 0u}; }
    }
}
__device__ __forceinline__ void ln2d_load(unsigned char* ws, int L, int r, int lane, f32x4 (&v)[8]) {
    if (r < NLAT) load_resb_delta(((const bf16*)(ws + WS_XL)) + (size_t)r * D, ((const bf16*)(ws + WS_PRE)) + (size_t)r * D, lane, v);
    else sum_partials<true>(v, ((float*)(ws + WS_PART)) + (size_t)(r - NLAT) * D, 11, ((const bf16*)(ws + WS_XL)) + (size_t)r * D, ((float*)(ws + WS_MOD)) + ((size_t)L * 3 + 2) * 12288 + 5 * D, lane);
}
__device__ __forceinline__ void ln2d_row(Frame& F, unsigned char* ws, const float* lng, const float* lnb, int L, int r, f32x4 (&v)[8]) {
    layer_norm_row(v, lng, lnb, F.lane);
    store_row_bf16(((bf16*)(ws + WS_XL)) + (size_t)r * D, F.lane, v);
    const float* m = ((float*)(ws + WS_MOD)) + ((size_t)(L + 1) * 3 + row_group(r)) * 12288;
    modulate(v, m, m + D, F.lane); store_row_bf16(((bf16*)(ws + WS_H)) + (size_t)r * D, F.lane, v); store_row_fp8(ws + WS_ZB + (size_t)r * D, F.lane, v);
}
__device__ __forceinline__ void ln2_dense(Frame& F, int L) {
    unsigned char* const ws = PWS(); const float* const lng = PIN(21) + L * D; const float* const lnb = PIN(22) + L * D;
    const int gw = F.vcu * NWAVES + F.wave, NGW = F.G * NWAVES;
    for (int r = gw; r < MROWS; r += NGW) { f32x4 a[8]; ln2d_load(ws, L, r, F.lane, a); ln2d_row(F, ws, lng, lnb, L, r, a); }
}
__device__ __forceinline__ void ln2_moe(Frame& F, int L) {
    unsigned char* const ws = PWS(); const float* const lng = PIN(21) + L * D; const float* const lnb = PIN(22) + L * D; float* const outp = POUT();
    const int gw = F.vcu * NWAVES + F.wave, NGW = F.G * NWAVES;
    unsigned cnt[8]; int pp[9]; moe_prefix(ws, cnt, pp);
    for (int r = gw; r < NLAT; r += NGW) {
        const unsigned* rt = ((unsigned*)(ws + WS_ROUTE)) + (size_t)r * 8; const int e0 = rt[0], e1 = rt[3]; const float w0 = __uint_as_float(rt[2]), w1 = __uint_as_float(rt[5]);
        int b0 = 0, b1 = 0;
#pragma unroll
        for (int k = 1; k < 8; ++k) { if (e0 >= k) b0 = pp[k]; if (e1 >= k) b1 = pp[k]; }
        const size_t s0 = (size_t)b0 * 256 + rt[1], s1 = (size_t)b1 * 256 + rt[4];
        f32x4 v[8], y0[8], y1[8]; load_row_bf16(((bf16*)(ws + WS_XL)) + (size_t)r * D, F.lane, v); load_row_bf16(((bf16*)(ws + WS_Z)) + s0 * D, F.lane, y0); load_row_bf16(((bf16*)(ws + WS_Z)) + s1 * D, F.lane, y1);
        const float* g2 = ((float*)(ws + WS_MOD)) + ((size_t)L * 3 + row_group(r)) * 12288 + 5 * D;
#pragma unroll
        for (int j = 0; j < 8; ++j) { const f32x4 g4 = *(const f32x4*)(g2 + 4 * F.lane + 256 * j); v[j] = v[j] * ALPHA + g4 * (y0[j] * w0 + y1[j] * w1); }
        layer_norm_row(v, lng, lnb, F.lane);
        store_row(outp + (size_t)r * D, F.lane, v);
    }
}

constexpr int GLA_NCH = 68;
constexpr size_t GLA_DST_BYTES = (size_t)16 * GLA_NCH * 256 * 128 * 2;
#define GLA_DST(ws) ((bf16*)((ws) + WS_GLA))
#define GLA_DEC(ws) ((float*)((ws) + WS_GLA + GLA_DST_BYTES))
#define GLA_BCG(ws) ((float*)((ws) + WS_GLA + GLA_DST_BYTES + (size_t)16 * GLA_NCH * 128 * 4))
__device__ __forceinline__ int gla_chunk_row0(int b, int cn) { return cn < 4 ? NLAT + CTXL * b + 64 * cn : SEQ * b + 64 * (cn - 4); }
__device__ __forceinline__ int gla_scan_idx(int cn, int dir) { return dir ? (cn < 4 ? 3 - cn : 71 - cn) : cn; }
__device__ __forceinline__ float log_sigmoid16(float z) { return (fminf(z, 0.f) - __logf(1.0f + __expf(-fabsf(z)))) * (1.0f / 16.0f); }
__device__ __forceinline__ bf16x8v tr_frag(unsigned addr, unsigned pitch4) {
    v2u lo, hi;
    asm volatile("ds_read_b64_tr_b16 %0, %2\n\tds_read_b64_tr_b16 %1, %3\n\ts_waitcnt lgkmcnt(0)" : "=&v"(lo), "=&v"(hi) : "v"(addr), "v"(addr + pitch4) : "memory");
    v4u r; r.x = lo.x; r.y = lo.y; r.z = hi.x; r.w = hi.y; return __builtin_bit_cast(bf16x8v, r);
}
struct TrHalf { v2u lo, hi; };
__device__ __forceinline__ void tr_issue(TrHalf& f, unsigned addr, unsigned pitch4) { asm volatile("ds_read_b64_tr_b16 %0, %2\n\tds_read_b64_tr_b16 %1, %3" : "=&v"(f.lo), "=&v"(f.hi) : "v"(addr), "v"(addr + pitch4) : "memory"); }
__device__ __forceinline__ bf16x8v tr_get(const TrHalf& f) { v4u r; r.x = f.lo.x; r.y = f.lo.y; r.z = f.hi.x; r.w = f.hi.y; return __builtin_bit_cast(bf16x8v, r); }
__device__ __forceinline__ void tr_wait2(TrHalf (&f)[2]) { asm volatile("s_waitcnt lgkmcnt(0)" : "+v"(f[0].lo), "+v"(f[0].hi), "+v"(f[1].lo), "+v"(f[1].hi) :: "memory"); }
__device__ __forceinline__ void tr_wait8(TrHalf (&f)[8]) { asm volatile("s_waitcnt lgkmcnt(0)" : "+v"(f[0].lo), "+v"(f[0].hi), "+v"(f[1].lo), "+v"(f[1].hi), "+v"(f[2].lo), "+v"(f[2].hi), "+v"(f[3].lo), "+v"(f[3].hi),
    "+v"(f[4].lo), "+v"(f[4].hi), "+v"(f[5].lo), "+v"(f[5].hi), "+v"(f[6].lo), "+v"(f[6].hi), "+v"(f[7].lo), "+v"(f[7].hi) :: "memory"); }
__device__ __forceinline__ unsigned lds_addr(LAS unsigned char* p) { return (unsigned)(size_t)p; }
constexpr int GL_BC = 0;
constexpr int GL_TOT = 65536;
constexpr int GL_V = 71680;
constexpr int GL_A = 105472;
constexpr int GL_STG = 105472;
constexpr int GL_RED = 124928;
constexpr int GL_QK_PITCH = 272, GL_V_PITCH = 528, GL_A_PITCH = 144;
static_assert(GL_STG + 25600 <= RING_BYTES && GL_V + 64 * GL_V_PITCH <= GL_A && GL_TOT + 4096 + 1024 <= GL_V && 4 * 64 * GL_QK_PITCH <= GL_V, "GLA LDS map");

__device__ __forceinline__ void gla_decays(Frame& F, unsigned char* ws, const float* wgf, const float* bgf, const float* wgb, const float* bgb, int row0, int h, int d0, int d1) {
    LAS float* lr = (LAS float*)(F.lds + GL_STG); LAS float* wg = lr + 64 * 32; LAS float* bg = wg + 2 * 16 * 128;
    LAS float* bc = (LAS float*)(F.lds + GL_BC); LAS float* tot = (LAS float*)(F.lds + GL_TOT);
    { const int t = F.tid >> 3, o4 = (F.tid & 7) * 4; *(LAS f32x4*)(lr + t * 32 + o4) = *(const GAS f32x4*)(((float*)(ws + WS_LR)) + (size_t)(row0 + t) * 32 + o4); }
    for (int i = F.tid; i < 1024; i += NTHR) { const int dir = i >> 9, o = (i >> 5) & 15, d4 = (i & 31) * 4; *(LAS f32x4*)(wg + (dir * 16 + o) * 128 + d4) = *(const GAS f32x4*)((dir ? wgb : wgf) + o * 512 + h * 128 + d4); }
    if (F.tid < 64) { const int dir = F.tid >> 5, d4 = (F.tid & 31) * 4; *(LAS f32x4*)(bg + dir * 128 + d4) = *(const GAS f32x4*)((dir ? bgb : bgf) + h * 128 + d4); }
    __syncthreads();
    { const int t = F.tid >> 3, dg = (F.tid & 7) * 16;
      for (int dir = d0; dir < d1; ++dir) {
          f32x4 z[4];
#pragma unroll
          for (int j = 0; j < 4; ++j) z[j] = *(LAS f32x4*)(bg + dir * 128 + dg + 4 * j);
#pragma unroll
          for (int o = 0; o < 16; ++o) { const float l = lr[t * 32 + dir * 16 + o];
#pragma unroll
              for (int j = 0; j < 4; ++j) z[j] += l * *(LAS f32x4*)(wg + (dir * 16 + o) * 128 + dg + 4 * j); }
#pragma unroll
          for (int j = 0; j < 4; ++j) { f32x4 g; g[0] = log_sigmoid16(z[j][0]); g[1] = log_sigmoid16(z[j][1]); g[2] = log_sigmoid16(z[j][2]); g[3] = log_sigmoid16(z[j][3]); *(LAS f32x4*)(bc + dir * 8192 + t * 128 + dg + 4 * j) = g; } } }
    __syncthreads();
    { const int d = F.tid & 127, seg = F.tid >> 7;
      for (int dir = d0; dir < d1; ++dir) { float a = 0.f;
#pragma unroll
          for (int i = 0; i < 16; ++i) { const int s = seg * 16 + i, t = dir ? 63 - s : s; a += bc[dir * 8192 + t * 128 + d]; bc[dir * 8192 + t * 128 + d] = a; }
          tot[(dir * 4 + seg) * 128 + d] = a; } }
    __syncthreads();
    { const int d = F.tid & 127, seg = F.tid >> 7;
      for (int dir = d0; dir < d1; ++dir) { float pre = 0.f, all = 0.f;
#pragma unroll
          for (int s2 = 0; s2 < 4; ++s2) { const float v = tot[(dir * 4 + s2) * 128 + d]; all += v; if (s2 < seg) pre += v; }
          if (seg == 0) tot[1024 + dir * 128 + d] = all;
          if (seg > 0) {
#pragma unroll
              for (int i = 0; i < 16; ++i) { const int s = seg * 16 + i, t = dir ? 63 - s : s; bc[dir * 8192 + t * 128 + d] += pre; } } } }
    __syncthreads();
}
__device__ __forceinline__ void gla_stage_v(Frame& F, const bf16* U, int row0, int h) {
#pragma unroll
    for (int i = 0; i < 4; ++i) { const int p = F.tid + NTHR * i, t = p >> 5, e8 = (p & 31) * 8;
        *(LAS v4u*)(F.lds + GL_V + t * GL_V_PITCH + e8 * 2) = *(const GAS v4u*)(U + (size_t)(row0 + t) * NU + U_GV + h * 256 + e8); }
}
__device__ __forceinline__ void gla_g1(Frame& F, int L) {
    unsigned char* const ws = PWS(); const bf16* U = (const bf16*)(ws + WS_U);
    const float* wgf = PIN(8) + (size_t)L * 16 * 512; const float* bgf = PIN(9) + L * 512; const float* wgb = PIN(10) + (size_t)L * 16 * 512; const float* bgb = PIN(11) + L * 512;
    const int g = F.lane >> 4, q4 = (F.lane & 15) >> 2, p = F.lane & 3, l15 = F.lane & 15;
    for (int task = F.vcu; task < 16 * GLA_NCH; task += F.G) {
        const int cn = task % GLA_NCH, ch = task / GLA_NCH, h = ch & 3, dir = (ch >> 2) & 1, b = ch >> 3;
        const int row0 = gla_chunk_row0(b, cn), n = gla_scan_idx(cn, dir);
        __syncthreads();
        gla_stage_v(F, U, row0, h);
        v4u kp[2];
#pragma unroll
        for (int i = 0; i < 2; ++i) { const int pc = F.tid + NTHR * i, t = pc >> 4, d8 = (pc & 15) * 8; kp[i] = *(const GAS v4u*)(U + (size_t)(row0 + t) * NU + U_GK + h * 128 + d8); }
        gla_decays(F, ws, wgf, bgf, wgb, bgb, row0, h, dir, dir + 1);
        LAS float* bc = (LAS float*)(F.lds + GL_BC) + dir * 8192; LAS float* bl = (LAS float*)(F.lds + GL_TOT) + 1024 + dir * 128;
        if (F.tid < 128) GLA_DEC(ws)[((size_t)ch * GLA_NCH + n) * 128 + F.tid] = __expf(bl[F.tid]);
        LAS unsigned char* ke = F.lds + GL_BC + (dir ? 0 : 32768);
#pragma unroll
        for (int i = 0; i < 2; ++i) { const int pc = F.tid + NTHR * i, t = pc >> 4, d8 = (pc & 15) * 8;
            const f32x4 b0 = *(LAS f32x4*)(bc + t * 128 + d8), b1 = *(LAS f32x4*)(bc + t * 128 + d8 + 4), l0 = *(LAS f32x4*)(bl + d8), l1 = *(LAS f32x4*)(bl + d8 + 4);
            { float* bo = GLA_BCG(ws) + ((((size_t)(b * 4 + h) * GLA_NCH + cn) * 2 + dir) * 64 + t) * 128 + d8; *(GAS f32x4*)bo = b0; *(GAS f32x4*)(bo + 4) = b1; }
            v4u o; o.x = pk2(bflo(kp[i].x) * __expf(l0[0] - b0[0]), bfhi(kp[i].x) * __expf(l0[1] - b0[1])); o.y = pk2(bflo(kp[i].y) * __expf(l0[2] - b0[2]), bfhi(kp[i].y) * __expf(l0[3] - b0[3]));
            o.z = pk2(bflo(kp[i].z) * __expf(l1[0] - b1[0]), bfhi(kp[i].z) * __expf(l1[1] - b1[1])); o.w = pk2(bflo(kp[i].w) * __expf(l1[2] - b1[2]), bfhi(kp[i].w) * __expf(l1[3] - b1[3]));
            *(LAS v4u*)(ke + t * GL_QK_PITCH + d8 * 2) = o; }
        __syncthreads();
        f32x4 acc[8][2];
#pragma unroll
        for (int mt = 0; mt < 8; ++mt) { acc[mt][0] = (f32x4){0.f, 0.f, 0.f, 0.f}; acc[mt][1] = (f32x4){0.f, 0.f, 0.f, 0.f}; }
        const unsigned ke_a = lds_addr(ke) + GL_QK_PITCH * (8 * g + q4) + 8 * p, v_a = lds_addr(F.lds + GL_V) + GL_V_PITCH * (8 * g + q4) + 8 * p + 2 * (32 * F.wave);
#pragma unroll
        for (int ks = 0; ks < 2; ++ks) {
            TrHalf bh[2], ah[8];
#pragma unroll
            for (int nt = 0; nt < 2; ++nt) tr_issue(bh[nt], v_a + GL_V_PITCH * 32 * ks + 32 * nt, GL_V_PITCH * 4);
#pragma unroll
            for (int mt = 0; mt < 8; ++mt) tr_issue(ah[mt], ke_a + GL_QK_PITCH * 32 * ks + 32 * mt, GL_QK_PITCH * 4);
            tr_wait2(bh); tr_wait8(ah);
            const bf16x8v bv0 = tr_get(bh[0]), bv1 = tr_get(bh[1]);
#pragma unroll
            for (int mt = 0; mt < 8; ++mt) { const bf16x8v av = tr_get(ah[mt]);
                acc[mt][0] = __builtin_amdgcn_mfma_f32_16x16x32_bf16(av, bv0, acc[mt][0], 0, 0, 0); acc[mt][1] = __builtin_amdgcn_mfma_f32_16x16x32_bf16(av, bv1, acc[mt][1], 0, 0, 0); } }
        bf16* dst = GLA_DST(ws) + ((size_t)ch * GLA_NCH + n) * 256 * 128;
#pragma unroll
        for (int mt = 0; mt < 8; ++mt)
#pragma unroll
            for (int nt = 0; nt < 2; ++nt) { const int e = 32 * F.wave + 16 * nt + l15, d = 16 * mt + 4 * g; v2u w; w.x = pk2(acc[mt][nt][0], acc[mt][nt][1]); w.y = pk2(acc[mt][nt][2], acc[mt][nt][3]);
                *(GAS v2u*)(dst + (size_t)e * 128 + d) = w; }
    }
}
__device__ __forceinline__ void gla_g2(Frame& F) {
    unsigned char* const ws = PWS();
    const int NT = F.G * NTHR;
    LAS float* decl = (LAS float*)(F.lds + RING_OFF + 90112);
    for (int base = F.bx * NTHR; base < 16 * 256 * 32; base += NT) {
        const int ch = base >> 13;
        __syncthreads();
        for (int i = F.tid; i < GLA_NCH * 32; i += NTHR) *(LAS f32x4*)(decl + 4 * i) = *(const GAS f32x4*)(GLA_DEC(ws) + (size_t)ch * GLA_NCH * 128 + 4 * i);
        __syncthreads();
        const int idx = base + F.tid, e = (idx >> 5) & 255, d4 = (idx & 31) * 4;
        bf16* p = GLA_DST(ws) + (size_t)ch * GLA_NCH * 32768 + (size_t)e * 128 + d4;
        f32x4 S = {0.f, 0.f, 0.f, 0.f};
#pragma unroll
        for (int hf = 0; hf < 2; ++hf) {
            v2u x[34];
#pragma unroll
            for (int i = 0; i < 34; ++i) x[i] = *(const GAS v2u*)(p + (size_t)(34 * hf + i) * 32768);
#pragma unroll
            for (int i = 0; i < 34; ++i) { const int n = 34 * hf + i; const f32x4 a = *(LAS f32x4*)(decl + n * 128 + d4);
                v2u w; w.x = pk2(S[0], S[1]); w.y = pk2(S[2], S[3]); *(GAS v2u*)(p + (size_t)n * 32768) = w;
                S[0] = a[0] * S[0] + bflo(x[i].x); S[1] = a[1] * S[1] + bfhi(x[i].x); S[2] = a[2] * S[2] + bflo(x[i].y); S[3] = a[3] * S[3] + bfhi(x[i].y); }
        }
    }
}
__device__ __forceinline__ void gla_g3(Frame& F, int L) {
    unsigned char* const ws = PWS(); const bf16* U = (const bf16*)(ws + WS_U);
    const float* wgf = PIN(8) + (size_t)L * 16 * 512; const float* bgf = PIN(9) + L * 512; const float* wgb = PIN(10) + (size_t)L * 16 * 512; const float* bgb = PIN(11) + L * 512;
    const float* ng = PIN(12) + L * 256;
    const int g = F.lane >> 4, q4 = (F.lane & 15) >> 2, p = F.lane & 3, l15 = F.lane & 15;
    for (int task = F.vcu; task < 8 * GLA_NCH; task += F.G) {
        const int cn = task % GLA_NCH, bh = task / GLA_NCH, h = bh & 3, b = bh >> 2;
        const int row0 = gla_chunk_row0(b, cn);
        __syncthreads();
        gla_stage_v(F, U, row0, h);
        v4u kp[2], qp[2];
#pragma unroll
        for (int i = 0; i < 2; ++i) { const int pc = F.tid + NTHR * i, t = pc >> 4, d8 = (pc & 15) * 8; const bf16* up = U + (size_t)(row0 + t) * NU + h * 128 + d8; kp[i] = *(const GAS v4u*)(up + U_GK); qp[i] = *(const GAS v4u*)(up + U_GQ); }
        { const float* bcg = GLA_BCG(ws) + ((size_t)(b * 4 + h) * GLA_NCH + cn) * 2 * 8192;
#pragma unroll
          for (int i = 0; i < 2; ++i) { const int pc = F.tid + NTHR * i, t = pc >> 4, d8 = (pc & 15) * 8;
#pragma unroll
              for (int dir = 0; dir < 2; ++dir) { const f32x4 b0 = *(const GAS f32x4*)(bcg + dir * 8192 + t * 128 + d8), b1 = *(const GAS f32x4*)(bcg + dir * 8192 + t * 128 + d8 + 4);
                  float ep[8], en[8];
#pragma unroll
                  for (int j = 0; j < 4; ++j) { ep[j] = __expf(b0[j]); ep[4 + j] = __expf(b1[j]); en[j] = __expf(-b0[j]); en[4 + j] = __expf(-b1[j]); }
                  v4u qo, ko;
                  qo.x = pk2(bflo(qp[i].x) * ep[0], bfhi(qp[i].x) * ep[1]); qo.y = pk2(bflo(qp[i].y) * ep[2], bfhi(qp[i].y) * ep[3]); qo.z = pk2(bflo(qp[i].z) * ep[4], bfhi(qp[i].z) * ep[5]); qo.w = pk2(bflo(qp[i].w) * ep[6], bfhi(qp[i].w) * ep[7]);
                  ko.x = pk2(bflo(kp[i].x) * en[0], bfhi(kp[i].x) * en[1]); ko.y = pk2(bflo(kp[i].y) * en[2], bfhi(kp[i].y) * en[3]); ko.z = pk2(bflo(kp[i].z) * en[4], bfhi(kp[i].z) * en[5]); ko.w = pk2(bflo(kp[i].w) * en[6], bfhi(kp[i].w) * en[7]);
                  *(LAS v4u*)(F.lds + GL_BC + (2 * dir) * 64 * GL_QK_PITCH + t * GL_QK_PITCH + d8 * 2) = qo; *(LAS v4u*)(F.lds + GL_BC + (2 * dir + 1) * 64 * GL_QK_PITCH + t * GL_QK_PITCH + d8 * 2) = ko; } } }
        __syncthreads();
        { const int dir = F.wave >> 2, nt = F.wave & 3;
          LAS unsigned char* qi = F.lds + GL_BC + (2 * dir) * 64 * GL_QK_PITCH; LAS unsigned char* ki = qi + 64 * GL_QK_PITCH;
          bf16x8v qf[4];
#pragma unroll
          for (int ks = 0; ks < 4; ++ks) qf[ks] = *(LAS bf16x8v*)(qi + (16 * nt + l15) * GL_QK_PITCH + (32 * ks + 8 * g) * 2);
#pragma unroll
          for (int mt = 0; mt < 4; ++mt) { f32x4 a = {0.f, 0.f, 0.f, 0.f};
              const bool live = dir ? (mt >= nt) : (mt <= nt);
              if (live) {
#pragma unroll
                  for (int ks = 0; ks < 4; ++ks) { const bf16x8v kf = *(LAS bf16x8v*)(ki + (16 * mt + l15) * GL_QK_PITCH + (32 * ks + 8 * g) * 2); a = __builtin_amdgcn_mfma_f32_16x16x32_bf16(kf, qf[ks], a, 0, 0, 0); } }
              const int tau = 16 * nt + l15, s0 = 16 * mt + 4 * g;
#pragma unroll
              for (int i = 0; i < 4; ++i) { const bool keep = dir ? (s0 + i >= tau) : (s0 + i <= tau); if (!keep) a[i] = 0.f; }
              v2u w; w.x = pk2(a[0], a[1]); w.y = pk2(a[2], a[3]);
              *(LAS v2u*)(F.lds + GL_A + dir * 64 * GL_A_PITCH + tau * GL_A_PITCH + s0 * 2) = w; } }
        __syncthreads();
        f32x4 acc[2][4];
#pragma unroll
        for (int mt = 0; mt < 2; ++mt)
#pragma unroll
            for (int nt = 0; nt < 4; ++nt) acc[mt][nt] = (f32x4){0.f, 0.f, 0.f, 0.f};
        { const unsigned v_a = lds_addr(F.lds + GL_V) + GL_V_PITCH * (8 * g + q4) + 8 * p + 2 * (32 * F.wave);
#pragma unroll
          for (int ks = 0; ks < 2; ++ks) { TrHalf vh[2];
#pragma unroll
              for (int mt = 0; mt < 2; ++mt) tr_issue(vh[mt], v_a + GL_V_PITCH * 32 * ks + 32 * mt, GL_V_PITCH * 4);
              tr_wait2(vh); const bf16x8v vf[2] = {tr_get(vh[0]), tr_get(vh[1])};
#pragma unroll
              for (int dir = 0; dir < 2; ++dir)
#pragma unroll
                  for (int nt = 0; nt < 4; ++nt) { const bf16x8v af = *(LAS bf16x8v*)(F.lds + GL_A + dir * 64 * GL_A_PITCH + (16 * nt + l15) * GL_A_PITCH + (32 * ks + 8 * g) * 2);
                      acc[0][nt] = __builtin_amdgcn_mfma_f32_16x16x32_bf16(vf[0], af, acc[0][nt], 0, 0, 0); acc[1][nt] = __builtin_amdgcn_mfma_f32_16x16x32_bf16(vf[1], af, acc[1][nt], 0, 0, 0); } } }
#pragma unroll
        for (int dir = 0; dir < 2; ++dir) { const int ch = (b * 2 + dir) * 4 + h, n = gla_scan_idx(cn, dir);
            const bf16* st = GLA_DST(ws) + ((size_t)ch * GLA_NCH + n) * 32768; LAS unsigned char* qi = F.lds + GL_BC + (2 * dir) * 64 * GL_QK_PITCH;
#pragma unroll
            for (int ks = 0; ks < 4; ++ks) { bf16x8v sf[2];
#pragma unroll
                for (int mt = 0; mt < 2; ++mt) sf[mt] = __builtin_bit_cast(bf16x8v, *(const GAS v4u*)(st + (size_t)(32 * F.wave + 16 * mt + l15) * 128 + 32 * ks + 8 * g));
#pragma unroll
                for (int nt = 0; nt < 4; ++nt) { const bf16x8v qf = *(LAS bf16x8v*)(qi + (16 * nt + l15) * GL_QK_PITCH + (32 * ks + 8 * g) * 2);
                    acc[0][nt] = __builtin_amdgcn_mfma_f32_16x16x32_bf16(sf[0], qf, acc[0][nt], 0, 0, 0); acc[1][nt] = __builtin_amdgcn_mfma_f32_16x16x32_bf16(sf[1], qf, acc[1][nt], 0, 0, 0); } } }
        LAS float* red = (LAS float*)(F.lds + GL_RED);
#pragma unroll
        for (int nt = 0; nt < 4; ++nt) { float s = 0.f;
#pragma unroll
            for (int mt = 0; mt < 2; ++mt)
#pragma unroll
                for (int i = 0; i < 4; ++i) s += acc[mt][nt][i] * acc[mt][nt][i];
            s += __shfl_xor(s, 16); s += __shfl_xor(s, 32);
            if (g == 0) red[F.wave * 64 + 16 * nt + l15] = s; }
        __syncthreads();
#pragma unroll
        for (int nt = 0; nt < 4; ++nt) { const int tau = 16 * nt + l15; float s = 0.f;
#pragma unroll
            for (int w = 0; w < 8; ++w) s += red[w * 64 + tau];
            const float rs = 1.0f / sqrtf(s * (1.0f / 256.0f) + LN_EPS); const size_t row = (size_t)(row0 + tau);
#pragma unroll
            for (int mt = 0; mt < 2; ++mt) { const int e = 32 * F.wave + 16 * mt + 4 * g;
                const v2u rw = *(const GAS v2u*)(U + row * NU + U_GR + h * 256 + e); const f32x4 g4 = *(const f32x4*)(ng + e);
                const float r0 = bflo(rw.x), r1 = bfhi(rw.x), r2 = bflo(rw.y), r3 = bfhi(rw.y);
                v2u w; w.x = pk2(acc[mt][nt][0] * rs * g4[0] * (r0 / (1.0f + __expf(-r0))), acc[mt][nt][1] * rs * g4[1] * (r1 / (1.0f + __expf(-r1))));
                w.y = pk2(acc[mt][nt][2] * rs * g4[2] * (r2 / (1.0f + __expf(-r2))), acc[mt][nt][3] * rs * g4[3] * (r3 / (1.0f + __expf(-r3))));
                *(GAS v2u*)(((bf16*)(ws + WS_Y + (size_t)MROWS * 1024 * 2)) + row * 1024 + h * 256 + e) = w; } }
    }
}

constexpr int NA_VPITCH = 272, NA_VIMG = 32 * NA_VPITCH, NA_WAVE_LDS = 10752;
template <bool CTXQ> __device__ __forceinline__ void na_task(const bf16* U, const unsigned char* KF, bf16* YN, LAS unsigned char* vimg, const LAS float* rpb, int lane, int b, int h, int r, int c0, int qrow0) {
    const int g = lane >> 4, q4 = (lane & 15) >> 2, p = lane & 3, l15 = lane & 15;
    const unsigned v_a = lds_addr(vimg) + NA_VPITCH * (4 * g + q4) + 8 * p;
    const int rs = min(max(r - 4, 0), 56), kc0 = min(max(c0 - 8, 0), 32), ctx0 = NLAT + CTXL * b;
    const int qc = c0 + l15, cs = min(max(qc - 8, 0), 48);
    constexpr int KB0 = CTXQ ? 8 : 0;
    bf16x8v qf[4];
#pragma unroll
    for (int ks = 0; ks < 4; ++ks) qf[ks] = __builtin_bit_cast(bf16x8v, *(const GAS v4u*)(U + (size_t)(qrow0 + l15) * NU + U_NQ + h * 128 + 32 * ks + 8 * g));
    f32x4 o[8];
#pragma unroll
    for (int mt = 0; mt < 8; ++mt) o[mt] = (f32x4){0.f, 0.f, 0.f, 0.f};
    float mrun = -INFINITY, lrun = 0.f;
    v4u kf[8], vv[8];
    const unsigned voffK = (unsigned)((l15 >> 3) * 2048 + (l15 & 7) * 64 + g * 16), voffV = (unsigned)(((lane >> 4) * NU + (lane & 15) * 8) * 2);
#define NA_LOAD_BLOCK(tokexpr) do { int tok_ = (tokexpr); asm volatile("" : "+s"(tok_)); \
        const GAS char* kb_ = (const GAS char*)(KF + ((size_t)(h * (MROWS / 8) + (tok_ >> 3)) * 4) * 512); const GAS char* vb_ = (const GAS char*)(U + (size_t)tok_ * NU + U_NV + h * 128); \
        _Pragma("unroll") for (int i = 0; i < 8; ++i) kf[i] = *(const GAS v4u*)(kb_ + (size_t)(i >> 2) * 4096 + voffK + 512 * (i & 3)); \
        _Pragma("unroll") for (int i = 0; i < 8; ++i) vv[i] = *(const GAS v4u*)(vb_ + (size_t)i * (4 * NU * 2) + voffV); } while (0)
    NA_LOAD_BLOCK(KB0 < 8 ? b * SEQ + (rs + KB0) * 64 + kc0 : ctx0 + 32 * (KB0 - 8));
#pragma unroll 1
    for (int kb = KB0; kb < 16; ++kb) {
#pragma unroll
        for (int i = 0; i < 8; ++i) { const int id = lane + 64 * i; *(LAS v4u*)(vimg + (id >> 4) * NA_VPITCH + (id & 15) * 16) = vv[i]; }
        v4u kc_[8];
#pragma unroll
        for (int i = 0; i < 8; ++i) kc_[i] = kf[i];
        if (kb + 1 < 16) NA_LOAD_BLOCK((kb + 1) < 8 ? b * SEQ + (rs + kb + 1) * 64 + kc0 : ctx0 + 32 * (kb + 1 - 8));
        f32x4 s0 = {0.f, 0.f, 0.f, 0.f}, s1 = {0.f, 0.f, 0.f, 0.f};
#pragma unroll
        for (int ks = 0; ks < 4; ++ks) { s0 = __builtin_amdgcn_mfma_f32_16x16x32_bf16(__builtin_bit_cast(bf16x8v, kc_[ks]), qf[ks], s0, 0, 0, 0); s1 = __builtin_amdgcn_mfma_f32_16x16x32_bf16(__builtin_bit_cast(bf16x8v, kc_[4 + ks]), qf[ks], s1, 0, 0, 0); }
        if (!CTXQ && kb < 8) { int drow = rs + kb - r + 7; asm volatile("" : "+s"(drow)); const LAS float* rp = rpb + drow * 31 - qc + 15;
#pragma unroll
            for (int i = 0; i < 4; ++i) { const int k0 = kc0 + 4 * g + i, k1 = k0 + 16; const bool ok0 = k0 >= cs && k0 <= cs + 15, ok1 = k1 >= cs && k1 <= cs + 15;
                const float b0 = rp[ok0 ? k0 : qc], b1 = rp[ok1 ? k1 : qc];
                s0[i] = ok0 ? s0[i] + b0 : -INFINITY; s1[i] = ok1 ? s1[i] + b1 : -INFINITY; } }
        float mloc = fmaxf(fmaxf(fmaxf(s0[0], s0[1]), fmaxf(s0[2], s0[3])), fmaxf(fmaxf(s1[0], s1[1]), fmaxf(s1[2], s1[3])));
        mloc = fmaxf(mloc, __shfl_xor(mloc, 16)); mloc = fmaxf(mloc, __shfl_xor(mloc, 32));
        const float mnew = fmaxf(mrun, mloc), alpha = __expf(mrun - mnew); mrun = mnew;
        float ps = 0.f;
#pragma unroll
        for (int i = 0; i < 4; ++i) { s0[i] = __expf(s0[i] - mnew); s1[i] = __expf(s1[i] - mnew); ps += s0[i] + s1[i]; }
        lrun = lrun * alpha + ps;
#pragma unroll
        for (int mt = 0; mt < 8; ++mt) o[mt] *= alpha;
        v4u pw; pw.x = pk2(s0[0], s0[1]); pw.y = pk2(s0[2], s0[3]); pw.z = pk2(s1[0], s1[1]); pw.w = pk2(s1[2], s1[3]);
        const bf16x8v pf = __builtin_bit_cast(bf16x8v, pw);
        TrHalf vh[8];
#pragma unroll
        for (int mt = 0; mt < 8; ++mt) tr_issue(vh[mt], v_a + 32 * mt, NA_VPITCH * 16);
        tr_wait8(vh);
#pragma unroll
        for (int mt = 0; mt < 8; ++mt) o[mt] = __builtin_amdgcn_mfma_f32_16x16x32_bf16(tr_get(vh[mt]), pf, o[mt], 0, 0, 0);
        asm volatile("" ::: "memory"); __builtin_amdgcn_sched_barrier(0);
    }
#undef NA_LOAD_BLOCK
    lrun += __shfl_xor(lrun, 16); lrun += __shfl_xor(lrun, 32);
    const float inv = 1.0f / lrun;
    bf16* yp = YN + (size_t)(qrow0 + l15) * 1024 + h * 128 + 4 * g;
#pragma unroll
    for (int mt = 0; mt < 8; ++mt) { v2u w; w.x = pk2(o[mt][0] * inv, o[mt][1] * inv); w.y = pk2(o[mt][2] * inv, o[mt][3] * inv); *(GAS v2u*)(yp + 16 * mt) = w; }
}
__device__ __forceinline__ void na_mfma(Frame& F, int L) {
    unsigned char* const ws = PWS(); const bf16* U = (const bf16*)(ws + WS_U); const unsigned char* KF = ws + WS_KF; bf16* YN = (bf16*)(ws + WS_Y + (size_t)MROWS * 2048 * 2);
    const float* rpbL = PIN(13) + (size_t)L * 8 * 15 * 31;
    LAS unsigned char* vimg = F.lds + RING_OFF + F.wave * NA_WAVE_LDS; LAS float* rpb = (LAS float*)(vimg + NA_VIMG);
    const int gw = F.vcu * NWAVES + F.wave, NGW = F.G * NWAVES;
    int hcur = -1;
    for (int task = gw; task < 2 * 8 * 64 * 4; task += NGW) {
        const int ct = task & 3, r = (task >> 2) & 63, h = (task >> 8) & 7, b = task >> 11;
        if (h != hcur) { hcur = h; for (int i = F.lane; i < 15 * 31; i += 64) rpb[i] = rpbL[h * 15 * 31 + i]; LDS_WAIT(); asm volatile("" ::: "memory"); }
        na_task<false>(U, KF, YN, vimg, rpb, F.lane, b, h, r, 16 * ct, b * SEQ + r * 64 + 16 * ct);
    }
    if (L == 0) for (int tt = gw; tt < 2 * 8 * 16; tt += NGW) {
        const int qt = tt & 15, h = (tt >> 4) & 7, b = tt >> 7;
        na_task<true>(U, KF, YN, vimg, rpb, F.lane, b, h, 0, 0, NLAT + CTXL * b + 16 * qt);
    }
}
#ifndef MK_ONE_LAUNCH
#define MK_ONE_LAUNCH 1
#endif
constexpr int PH_PER_LAYER = 11, NPH = 2 + DEPTH * PH_PER_LAYER;
enum { PL_WIN = 0, PL_MIXA, PL_MIXB, PL_MIXC, PL_BR, PL_WOUT, PL_LN1, PL_GATHER, PL_FFN1, PL_FFN2, PL_LN2 };
__device__ __forceinline__ bool in_range(int lo, int hi, int k) { asm volatile("" : "+s"(lo), "+s"(hi)); return lo <= k && k < hi; }
#ifndef PHMASK
#define PHMASK 0xFFFFFFFFu
#endif
#define IN(k) in_range(lo, hi, (k))
#define EN(bit) ((PHMASK >> (bit)) & 1u)
#ifndef DUPMASK
#define DUPMASK 0u
#endif
#define DUP(bit) ((DUPMASK >> (bit)) & 1u)
#define SEAM(k) do { if (IN((k) + 1)) GRID_BAR(); } while (0)
#ifndef NCOMP_NUM
#define NCOMP_NUM 20
#define NCOMP_DEN 32
#endif
#if MK_ONE_LAUNCH
#define GRID_BAR() xcd_barrier(bar)
#else
#define GRID_BAR() do { if (F.tid == 0) __hip_atomic_store((gu32*)(PWS() + WS_CTL) + CW_TMO, 0xBADBA0u, RLX_AGENT); } while (0)
#endif
template <int L> __device__ __forceinline__ void layer_phases(const Args& A, LAS unsigned char* const ldsb, const XcdBarrier& bar, const int lo, const int hi) {
    LAS unsigned char* const ring = ldsb + RING_OFF;
        const int pb = 2 + PH_PER_LAYER * L, Mr = (L == 0) ? MROWS : NLAT;
        if (EN(2) && IN(pb + PL_WIN)) { Frame F = mkframe(ldsb, A.grid);
            unsigned char* const ws = PWS();
            if (L == 0) {
                const int NCOMP = ((F.G * NCOMP_NUM / NCOMP_DEN) / 8) * 8;
                if (F.bx < NCOMP) { Frame Fg = F; Fg.G = NCOMP; Fg.vcu = (F.bx % 8) * (NCOMP / 8) + F.bx / 8;
                    lr_tiles(Fg, L);
                    pg8::StaticOrder S; S.init(MROWS, NU, NCOMP, F.bx);
                    pg8::Gemm g{((bf16*)(ws + WS_H)), w_in_t(ws, L), D, D}; pg8::EpiU E{((bf16*)(ws + WS_U)), NU, 1.0f, ws + WS_UG8, ws + WS_KF};
                    pg8::gemm_phase<pg8::EpiU, pg8::StaticOrder, true, true>(ring, g, S, E); }
                else { Frame Fc = F; Fc.G = F.G - NCOMP; Fc.vcu = F.bx - NCOMP; p0a_rest(Fc); }
            } else { lr_tiles(F, L);
                pg8::StaticOrder S; S.init(MROWS, NU, F.G, F.bx);
                pg8::Gemm g{((bf16*)(ws + WS_ZB)), w_in_t(ws, L), D / 2, D / 2}; pg8::EpiU E{((bf16*)(ws + WS_U)), NU, 1.0f / FSC_WGU, ws + WS_UG8, ws + WS_KF};
                pg8::gemm_phase<pg8::EpiU, pg8::StaticOrder, true, true, true>(ring, g, S, E); }
            SEAM(pb + PL_WIN);
        }
        if (EN(3) && IN(pb + PL_MIXA)) { Frame F = mkframe(ldsb, A.grid); gla_g1(F, L); mix_prep(F, L); if (DUP(3)) { __syncthreads(); gla_g1(F, L); mix_prep(F, L); } SEAM(pb + PL_MIXA); }
        if (EN(4) && IN(pb + PL_MIXB)) { Frame F = mkframe(ldsb, A.grid);
            int odd = (F.bx >> 3) & 1; asm volatile("" : "+s"(odd));
            for (int step = 0; step < 2; ++step) { if (step) __syncthreads(); if ((step ^ odd) == 0) gla_g2(F); else na_mfma(F, L); }
            SEAM(pb + PL_MIXB); }
        if (EN(5) && IN(pb + PL_MIXC)) { Frame F = mkframe(ldsb, A.grid); gla_g3(F, L); if (DUP(5)) { __syncthreads(); gla_g3(F, L); } SEAM(pb + PL_MIXC); }
        if (EN(6) && IN(pb + PL_BR)) { Frame F = mkframe(ldsb, A.grid);
            unsigned char* const ws = PWS(); const float* const gate_b = PIN(17) + (size_t)L * 3 * D;
            pg8::Gemm g{((bf16*)(ws + WS_Y)), w_br_t(ws, L, 0), 1024, 1024}; pg8::BranchOrder S; S.init(NLAT, D, F.G, F.bx, MROWS / 256, D / 256, L == 0 ? 48 : 0);
            pg8::EpiGate E{ws + WS_UG8, 6144, gate_b, ((bf16*)(ws + WS_ZB)), ws + WS_PRE, ((bf16*)(ws + WS_ZBP))};
            pg8::gemm_phase<pg8::EpiGate, pg8::BranchOrder, true, true>(ring, g, S, E);
            SEAM(pb + PL_BR);
        }
        if (EN(7) && IN(pb + PL_WOUT)) { Frame F = mkframe(ldsb, A.grid);
            unsigned char* const ws = PWS(); const float* const modL = ((float*)(ws + WS_MOD)) + (size_t)L * 3 * 12288; const float* const xin = PIN(0); const float* const cin = PIN(2);
            { pg8::Gemm g{((bf16*)(ws + WS_ZB)), w_out_t(ws, L), D, D}; pg8::StaticOrder S; S.init(NLAT, D, F.G, F.bx);
              pg8::EpiDelta<false> E{modL + 2 * D, 12288, ((bf16*)(ws + WS_PRE)), 1.0f};
              pg8::gemm_phase<pg8::EpiDelta<false>, pg8::StaticOrder, true, true>(ring, g, S, E); }
            if (L == 0) {
              pg8::Gemm g{((bf16*)(ws + WS_ZBP)), w_out_t(ws, L), D, 512}; pg8::SplitOrder S; S.init(NLAT / 256, D / 256, 12, 512, F.G, F.bx, 0, 4);
              pg8::EpiPartial<false> E{((float*)(ws + WS_PART)), NLAT / 256, 1.0f};
              pg8::gemm_phase<pg8::EpiPartial<false>, pg8::SplitOrder, false, false>(ring, g, S, E); }
            SEAM(pb + PL_WOUT);
        }
        if (EN(8) && IN(pb + PL_LN1)) { Frame F = mkframe(ldsb, A.grid); ln1_phase(F, L, Mr); SEAM(pb + PL_LN1); }
        if (L == 0) {
            if (EN(10) && IN(pb + PL_FFN1)) { Frame F = mkframe(ldsb, A.grid);
                unsigned char* const ws = PWS();
                pg8::Gemm g{((bf16*)(ws + WS_H)), (const bf16*)w_gu_t(ws, -1), D, D}; pg8::StaticOrder S; S.init(MROWS, NGU, F.G, F.bx);
                pg8::EpiSwiGLU E{((bf16*)(ws + WS_U)), FF};
                pg8::gemm_phase<pg8::EpiSwiGLU, pg8::StaticOrder, true, true>(ring, g, S, E);
                SEAM(pb + PL_FFN1);
            }
            if (EN(11) && IN(pb + PL_FFN2)) { Frame F = mkframe(ldsb, A.grid);
                unsigned char* const ws = PWS(); const float* const modL = ((float*)(ws + WS_MOD)) + (size_t)L * 3 * 12288;
                { pg8::Gemm g{((bf16*)(ws + WS_U)), (const bf16*)w_d_t(ws, -1), FF, FF}; pg8::StaticOrder S; S.init(NLAT, D, F.G, F.bx);
                  pg8::EpiDelta<false> E{modL + 5 * D, 12288, ((bf16*)(ws + WS_PRE)), 1.0f};
                  pg8::gemm_phase<pg8::EpiDelta<false>, pg8::StaticOrder, true, true>(ring, g, S, E); }
                { pg8::Gemm g{((bf16*)(ws + WS_U)), (const bf16*)w_d_t(ws, -1), FF, 512}; pg8::SplitOrder S; S.init(NLAT / 256, D / 256, 11, 512, F.G, F.bx, NLAT / 256, 11);
                  pg8::EpiPartial<false> E{((float*)(ws + WS_PART)), NLAT / 256, 1.0f};
                  pg8::gemm_phase<pg8::EpiPartial<false>, pg8::SplitOrder, false, false>(ring, g, S, E); }
                SEAM(pb + PL_FFN2);
            }
            if (EN(12) && IN(pb + PL_LN2)) { Frame F = mkframe(ldsb, A.grid); ln2_dense(F, L); if (DUP(12)) { __syncthreads(); ln2_dense(F, L); } SEAM(pb + PL_LN2); }
        } else {
            if (EN(10) && IN(pb + PL_FFN1)) { Frame F = mkframe(ldsb, A.grid);
                unsigned char* const ws = PWS();
                unsigned cnt[8]; int pp[9]; moe_prefix(ws, cnt, pp);
                pg8::Gemm g{((bf16*)(ws + WS_GLA)), (const bf16*)w_gu_t(ws, 0), D / 2, D / 2}; pg8::MoeOrder S; S.init(cnt, NGU / 256, F.G, F.bx, NLAT / 256);
                pg8::EpiSwiGLU8 E{ws + WS_U, FF, 1.0f / FSC_WGU, FSC_HID};
                pg8::gemm_phase<pg8::EpiSwiGLU8, pg8::MoeOrder, true, true, true>(ring, g, S, E);
                SEAM(pb + PL_FFN1);
            }
            if (EN(11) && IN(pb + PL_FFN2)) { Frame F = mkframe(ldsb, A.grid);
                unsigned char* const ws = PWS(); const float* const modL = ((float*)(ws + WS_MOD)) + (size_t)L * 3 * 12288;
                unsigned cnt[8]; int pp[9]; moe_prefix(ws, cnt, pp);
                pg8::Gemm g{((bf16*)(ws + WS_U)), (const bf16*)w_d_t(ws, 0), FF / 2, FF / 2}; pg8::MoeOrder S; S.init(cnt, D / 256, F.G, F.bx, 0);
                pg8::EpiBf16Plain E{((bf16*)(ws + WS_Z)), D, 1.0f / (FSC_HID * FSC_WD)};
                const int nfr = S.nunits / F.G, R = S.nunits - nfr * F.G; const bool split = (F.G % 8 == 0) && R > 0 && 2 * R <= F.G && R <= 128;
                if (split) S.lim = nfr * (F.G / 8);
                pg8::gemm_phase<pg8::EpiBf16Plain, pg8::MoeOrder, true, true, true>(ring, g, S, E);
                if (split) { pg8::MoeRemOrder RS; RS.M = S; RS.S = (4 * R <= F.G && R <= 64) ? 4 : 2; RS.ntp = FF / 2 / (2 * 64); RS.rmax = 32 / RS.S;
                    pg8::Gemm g2{((bf16*)(ws + WS_U)), (const bf16*)w_d_t(ws, 0), FF / 2, FF / 2, (float*)(ws + WS_PART), ((unsigned*)(ws + WS_CTL)) + CW_SK};
                    pg8::gemm_phase<pg8::EpiBf16Plain, pg8::MoeRemOrder, true, true, true, true>(ring, g2, RS, E); }
                SEAM(pb + PL_FFN2);
            }
            if (EN(12) && IN(pb + PL_LN2)) { Frame F = mkframe(ldsb, A.grid); ln2_moe(F, L); }
        }
    }
__global__ void __launch_bounds__(NTHR, 2) fwd_kernel(Args A) {
    __shared__ __attribute__((aligned(16))) unsigned char lds[LDS_BYTES];
    LAS unsigned char* const ldsb = (LAS unsigned char*)lds;
    { Frame F = mkframe(ldsb, A.grid);
    for (int u = F.tid; u < (LDS_BYTES - LDSCTL_OFF) / 4; u += NTHR) ((LAS unsigned*)(F.lds + LDSCTL_OFF))[u] = 0u;
    __syncthreads();
    if (F.tid < 32) { const unsigned long long p = F.tid < 30 ? (unsigned long long)A.in[F.tid] : (F.tid == 30 ? (unsigned long long)A.out : (unsigned long long)A.ws);
        ((LAS unsigned long long*)(F.lds + PTAB_OFF))[F.tid] = p; }
    __syncthreads(); }
#if MK_ONE_LAUNCH
    XcdBarrier bar; { Frame F = mkframe(ldsb, A.grid); bar = xcd_barrier_post((unsigned*)(PWS() + WS_CTL) + CW_BAR, F.MISC + 8, (unsigned)A.grid); }
#else
    XcdBarrier bar; bar.bar = nullptr; bar.x = 0; bar.grid = 0; bar.st = nullptr;
#endif
    const int lo = A.ph_lo, hi = A.ph_hi;
    LAS unsigned char* const ring = ldsb + RING_OFF;

    if (EN(0) && IN(0)) { Frame F = mkframe(ldsb, A.grid); p0a_prologue(F); if (DUP(0)) { __syncthreads(); p0a_prologue(F); } SEAM(0); }
    if (EN(1) && IN(1)) { Frame F = mkframe(ldsb, A.grid); p0b_modulate(F); if (DUP(1)) { __syncthreads(); p0b_modulate(F); } SEAM(1); }
    layer_phases<0>(A, ldsb, bar, lo, hi);
    layer_phases<1>(A, ldsb, bar, lo, hi);
}

extern "C" void kernel_launch(void* const* d_in, const int* in_sizes, int n_in, void* d_out, int out_size, void* d_ws, size_t ws_size, hipStream_t stream) {
    static int grid = 0;
    if (grid == 0) {
        if (n_in != 30 || out_size != NLAT * D || ws_size < WS_END) { fprintf(stderr, "kernel_launch: unexpected shapes (n_in %d out %d ws %zu); nothing launched\n", n_in, out_size, ws_size); grid = -1; return; }
        int dev = 0, cus = 0, per_cu = 0;
        if (hipGetDevice(&dev) != hipSuccess || hipDeviceGetAttribute(&cus, hipDeviceAttributeMultiprocessorCount, dev) != hipSuccess) { grid = -1; return; }
        if (hipOccupancyMaxActiveBlocksPerMultiprocessor(&per_cu, (const void*)fwd_kernel, NTHR, 0) != hipSuccess || per_cu < 1) { fprintf(stderr, "kernel_launch: occupancy query says %d\n", per_cu); (void)hipGetLastError(); grid = -1; return; }
        grid = cus;
    }
    if (grid < 0) return;
    (void)hipMemsetAsync((char*)d_ws + WS_CTL, 0, CTL_ZERO_BYTES, stream);
    Args a{};
    for (int i = 0; i < 30; ++i) a.in[i] = (const float*)d_in[i];
    a.out = (float*)d_out; a.ws = (unsigned char*)d_ws; a.grid = grid;
#if MK_ONE_LAUNCH
    a.ph_lo = 0; a.ph_hi = NPH;
    hipLaunchKernelGGL(fwd_kernel, dim3(grid), dim3(NTHR), 0, stream, a);
#else
#ifndef NPH_RUN
#define NPH_RUN NPH
#endif
    for (int p = 0; p < NPH_RUN; ++p) {
        if (p == 2 + PL_GATHER || p == 2 + PH_PER_LAYER + PL_GATHER) continue;
        a.ph_lo = p; a.ph_hi = p + 1;
        hipLaunchKernelGGL(fwd_kernel, dim3(grid), dim3(NTHR), 0, stream, a);
    }
#endif
}
```
